# Optimizing an MI355X kernel written in HIP

```python
import numpy as np
import jax
import jax.numpy as jnp
from jax import lax

D_MODEL = 1024
BATCH = 16
SEQ = 2048
DEPTH = 2

CTX_LEN = 256
GRID_W = 64
N_EVEN = (DEPTH + 1) // 2
N_ODD = DEPTH // 2
RMS_EPS = 1e-6
LN_EPS = 1e-5
ADA_CHUNKS = 6

GLA_HEADS = 4
GLA_DK = 64
GLA_DV = 128
GLA_LOWRANK = 16
GLA_GATE_NORM = 16.0
GLA_CHUNK = 64
ROPE_BASE = 10000.0
GLA_QK = GLA_HEADS * GLA_DK
GLA_V = GLA_HEADS * GLA_DV

CONV_CH = 512
CONV_WIDTH = 31

AB_SPLIT = (GLA_QK, GLA_QK, GLA_V, GLA_V, GLA_LOWRANK, GLA_LOWRANK, CONV_CH, CONV_CH)
AB_IN = sum(AB_SPLIT)
AB_MIX = GLA_V + CONV_CH

NA_HEADS = 16
NA_DH = 64
NA_WIN_ROWS = 8
NA_WIN_COLS = 16
NA_QCOLS = 16
NA_KCOLS = 32

N_EXPERTS = 256
TOP_K = 8
N_GROUPS = 8
TOPK_GROUPS = 4
D_EXPERT = 256
D_SHARED = 256
ROUTE_SCALE = 2.5
MOE_BLOCK = 128

kernel_name = 'hybrid_gla_conformer_natten_moe_dit'


def rms_norm(h, g):
    hf = h.astype(jnp.float32)
    hf = hf * lax.rsqrt(jnp.mean(hf * hf, axis=-1, keepdims=True) + RMS_EPS)
    return (hf * g.astype(jnp.float32)).astype(h.dtype)


def layer_norm(h, g, b):
    hf = h.astype(jnp.float32)
    mu = jnp.mean(hf, axis=-1, keepdims=True)
    var = jnp.mean(jnp.square(hf - mu), axis=-1, keepdims=True)
    out = (hf - mu) * lax.rsqrt(var + LN_EPS) * g.astype(jnp.float32) + b.astype(jnp.float32)
    return out.astype(h.dtype)


def axial_rope(t, rows, cols):
    half = t.shape[-1] // 2
    nf = half // 2
    inv = ROPE_BASE ** (-jnp.arange(nf, dtype=jnp.float32) / nf)

    def rot(u, pos):
        ang = pos[:, None] * inv[None, :]
        cos, sin = jnp.cos(ang), jnp.sin(ang)
        u1, u2 = u[..., :nf], u[..., nf:]
        return jnp.concatenate([u1 * cos - u2 * sin, u1 * sin + u2 * cos], axis=-1)

    return jnp.concatenate([rot(t[..., :half], rows), rot(t[..., half:], cols)], axis=-1)


def gla_chunked(q, k, v, logd, s0):
    B, H, T, dk = q.shape
    dv = v.shape[-1]
    L = GLA_CHUNK
    n = T // L
    q, k, logd = (t.reshape(B, H, n, L, dk) for t in (q, k, logd))
    v = v.reshape(B, H, n, L, dv)
    b = jnp.cumsum(logd, axis=3)
    b_mid = b[:, :, :, L // 2 - 1:L // 2, :]
    qe = q * jnp.exp(b - b_mid)
    ke = k * jnp.exp(b_mid - b)
    a = jnp.einsum('bhntk,bhnsk->bhnts', qe, ke)
    lower = jnp.tril(jnp.ones((L, L), dtype=bool))
    a = jnp.where(lower, a, 0.0)
    o_intra = jnp.einsum('bhnts,bhnsv->bhntv', a, v)
    b_last = b[:, :, :, -1:, :]
    q_in = q * jnp.exp(b)
    k_out = k * jnp.exp(b_last - b)
    dec = jnp.exp(b_last[:, :, :, 0, :])

    def step(s, inp):
        qi, ko, vi, di = inp
        o = jnp.einsum('bhtk,bhkv->bhtv', qi, s)
        s = s * di[..., None] + jnp.einsum('bhtk,bhtv->bhkv', ko, vi)
        return s, o

    mv = lambda t: jnp.moveaxis(t, 2, 0)
    s_fin, o_inter = lax.scan(step, s0, (mv(q_in), mv(k_out), mv(v), mv(dec)))
    o = o_intra + jnp.moveaxis(o_inter, 0, 2)
    return o.reshape(B, H, T, dv), s_fin


def depthwise_conv(u, w, b):
    ch = u.shape[-1]
    out = lax.conv_general_dilated(
        u, w[:, None, :].astype(u.dtype), window_strides=(1,),
        padding=[(CONV_WIDTH // 2, CONV_WIDTH // 2)],
        dimension_numbers=('NWC', 'WIO', 'NWC'), feature_group_count=ch)
    return out + b


def gla_conv_project(h, w_in, dw_f, db_f, dw_b, db_b):
    B, T, _ = h.shape
    z = h @ w_in
    q, k, v, g, lr_f, lr_b, glu_a, glu_b = jnp.split(z, list(np.cumsum(AB_SPLIT)[:-1]), axis=-1)
    heads = lambda t, d: t.reshape(B, T, GLA_HEADS, d).transpose(0, 2, 1, 3).astype(jnp.float32)
    q = heads(q, GLA_DK) * (GLA_DK ** -0.5)
    k = heads(k, GLA_DK)
    v = heads(v, GLA_DV)
    logd_f = heads(jax.nn.log_sigmoid((lr_f @ dw_f + db_f).astype(jnp.float32)) / GLA_GATE_NORM, GLA_DK)
    logd_b = heads(jax.nn.log_sigmoid((lr_b @ dw_b + db_b).astype(jnp.float32)) / GLA_GATE_NORM, GLA_DK)
    u = glu_a * jax.nn.sigmoid(glu_b)
    return q, k, v, logd_f, logd_b, g, u


def ab_mixer(hx, hc, w_in, w_out, dw_f, db_f, dw_b, db_b, gla_g, conv_w, conv_b, ln_g, ln_b):
    B, S, _ = hx.shape
    qx, kx, vx, lfx, lbx, gx, ux = gla_conv_project(hx, w_in, dw_f, db_f, dw_b, db_b)
    qc, kc, vc, lfc, lbc, gc, uc = gla_conv_project(hc, w_in, dw_f, db_f, dw_b, db_b)
    t = jnp.arange(S)
    rows = (t // GRID_W).astype(jnp.float32)
    cols = (t % GRID_W).astype(jnp.float32)
    qx = axial_rope(qx, rows, cols)
    kx = axial_rope(kx, rows, cols)
    zero = jnp.zeros((B, GLA_HEADS, GLA_DK, GLA_DV), jnp.float32)
    fl = lambda a: jnp.flip(a, axis=2)
    oc_f, sc_f = gla_chunked(qc, kc, vc, lfc, zero)
    ox_f, _ = gla_chunked(qx, kx, vx, lfx, sc_f)
    oc_b, sc_b = gla_chunked(fl(qc), fl(kc), fl(vc), fl(lbc), zero)
    ox_b, _ = gla_chunked(fl(qx), fl(kx), fl(vx), fl(lbx), sc_b)

    def finish(o, g, u):
        T = o.shape[2]
        o = o * lax.rsqrt(jnp.mean(o * o, axis=-1, keepdims=True) + RMS_EPS)
        o = o.transpose(0, 2, 1, 3) * gla_g.astype(jnp.float32).reshape(GLA_HEADS, GLA_DV)
        a_out = o.reshape(B, T, GLA_V).astype(g.dtype) * jax.nn.silu(g)
        cv = depthwise_conv(u, conv_w, conv_b)
        cv = jax.nn.silu(layer_norm(cv, ln_g, ln_b))
        return jnp.concatenate([a_out, cv], axis=-1) @ w_out

    return finish(ox_f + fl(ox_b), gx, ux), finish(oc_f + fl(oc_b), gc, uc)


def na_mixer(hx, hc, w_in, w_out, rpb, need_ctx):
    B, S, _ = hx.shape
    C = hc.shape[1]
    n_rows = S // GRID_W
    wr = min(NA_WIN_ROWS, n_rows)
    H, dh = NA_HEADS, NA_DH
    scale = dh ** -0.5

    def qkv(h):
        T = h.shape[1]
        z = (h @ w_in).reshape(B, T, 3, H, dh)
        return [z[:, :, j].transpose(0, 2, 1, 3) for j in range(3)]

    q, k, v = qkv(hx)
    qc, kc, vc = qkv(hc)

    n_cb = GRID_W // NA_QCOLS
    qcols = np.arange(GRID_W).reshape(n_cb, NA_QCOLS)
    cstart = np.clip(qcols - NA_WIN_COLS // 2, 0, GRID_W - NA_WIN_COLS)
    band = np.minimum(cstart[:, 0], GRID_W - NA_KCOLS)
    kcols = band[:, None] + np.arange(NA_KCOLS)[None, :]
    col_ok = (kcols[:, None, :] >= cstart[:, :, None]) & (kcols[:, None, :] < cstart[:, :, None] + NA_WIN_COLS)
    col_idx = np.clip(kcols[:, None, :] - qcols[:, :, None] + NA_WIN_COLS - 1, 0, 2 * NA_WIN_COLS - 2)
    rpb_c = rpb[:, :, col_idx]
    nw = wr * NA_KCOLS
    mask = jnp.asarray(np.repeat(col_ok[:, :, None, :], wr, axis=2).reshape(n_cb, NA_QCOLS, nw))

    qg = q.reshape(B, H, n_rows, GRID_W, dh)
    kg = k.reshape(B, H, n_rows, GRID_W, dh)
    vg = v.reshape(B, H, n_rows, GRID_W, dh)

    def row_block(r):
        r0 = jnp.clip(r - wr // 2, 0, n_rows - wr)
        qb = lax.dynamic_index_in_dim(qg, r, axis=2, keepdims=False).reshape(B, H, n_cb, NA_QCOLS, dh)

        def band_of(t):
            t = lax.dynamic_slice_in_dim(t, r0, wr, axis=2)[:, :, :, kcols]
            return t.transpose(0, 1, 3, 2, 4, 5).reshape(B, H, n_cb, nw, dh)

        kb, vb = band_of(kg), band_of(vg)
        ridx = r0 + jnp.arange(wr) - r + NA_WIN_ROWS - 1
        bias = rpb_c[:, ridx].transpose(0, 2, 3, 1, 4).reshape(H, n_cb, NA_QCOLS, nw)
        s_win = jnp.einsum('bhcqd,bhckd->bhcqk', qb, kb).astype(jnp.float32) * scale + bias.astype(jnp.float32)
        s_win = jnp.where(mask, s_win, -jnp.inf)
        s_ctx = jnp.einsum('bhcqd,bhkd->bhcqk', qb, kc).astype(jnp.float32) * scale
        p = jax.nn.softmax(jnp.concatenate([s_win, s_ctx], axis=-1), axis=-1).astype(vb.dtype)
        o = (jnp.einsum('bhcqk,bhckd->bhcqd', p[..., :nw], vb)
             + jnp.einsum('bhcqk,bhkd->bhcqd', p[..., nw:], vc))
        return o.reshape(B, H, GRID_W, dh)

    o = lax.map(row_block, jnp.arange(n_rows))
    yx = o.transpose(1, 0, 3, 2, 4).reshape(B, S, H * dh) @ w_out
    yc = None
    if need_ctx:
        sc = jnp.einsum('bhqd,bhkd->bhqk', qc, kc).astype(jnp.float32) * scale
        oc = jnp.einsum('bhqk,bhkd->bhqd', jax.nn.softmax(sc, axis=-1).astype(vc.dtype), vc)
        yc = oc.transpose(0, 2, 1, 3).reshape(B, C, H * dh) @ w_out
    return yx, yc


def moe_ffn(h, router_w, router_b, w_gate, w_up, w_down, ws_gate, ws_up, ws_down):
    N, D = h.shape
    E = w_gate.shape[0]
    scores = jax.nn.sigmoid(h.astype(jnp.float32) @ router_w.astype(jnp.float32))
    biased = scores + router_b.astype(jnp.float32)
    grp = biased.reshape(N, N_GROUPS, E // N_GROUPS)
    grp_score = jnp.sum(lax.top_k(grp, 2)[0], axis=-1)
    _, grp_idx = lax.top_k(grp_score, TOPK_GROUPS)
    grp_keep = jnp.sum(jax.nn.one_hot(grp_idx, N_GROUPS, dtype=jnp.float32), axis=1) > 0
    masked = jnp.where(grp_keep[:, :, None], grp, -jnp.inf).reshape(N, E)
    _, e_idx = lax.top_k(masked, TOP_K)
    gates = jnp.take_along_axis(scores, e_idx, axis=-1)
    gates = gates / jnp.sum(gates, axis=-1, keepdims=True) * ROUTE_SCALE

    y0 = ((jax.nn.silu(h @ ws_gate) * (h @ ws_up)) @ ws_down).astype(jnp.float32)

    A = N * TOP_K
    flat_e = e_idx.reshape(-1)
    flat_tok = jnp.repeat(jnp.arange(N, dtype=jnp.int32), TOP_K)
    flat_w = gates.reshape(-1)
    order = jnp.argsort(flat_e)
    se, stok, sw = flat_e[order], flat_tok[order], flat_w[order]
    counts = jnp.bincount(flat_e, length=E)
    starts = jnp.cumsum(counts) - counts
    padded = (counts + MOE_BLOCK - 1) // MOE_BLOCK * MOE_BLOCK
    pend = jnp.cumsum(padded)
    pstart = pend - padded
    pos = pstart[se] + jnp.arange(A, dtype=jnp.int32) - starts[se]
    P = -(-(A + E * (MOE_BLOCK - 1)) // MOE_BLOCK) * MOE_BLOCK
    nb = P // MOE_BLOCK
    slot_tok = jnp.zeros((P,), jnp.int32).at[pos].set(stok)
    slot_w = jnp.zeros((P,), jnp.float32).at[pos].set(sw)
    block_e = jnp.minimum(jnp.searchsorted(pend, jnp.arange(nb, dtype=jnp.int32) * MOE_BLOCK, side='right'), E - 1)

    def add_block(y, blk):
        tok, wt, e = blk
        xb = h[tok]
        hid = jax.nn.silu(xb @ w_gate[e]) * (xb @ w_up[e])
        out = (hid @ w_down[e]).astype(jnp.float32) * wt[:, None]
        return y.at[tok].add(out), None

    y, _ = lax.scan(add_block, y0, (slot_tok.reshape(nb, MOE_BLOCK), slot_w.reshape(nb, MOE_BLOCK), block_e))
    return y.astype(h.dtype)


def setup_inputs(seed: int = 0) -> dict:
    key = jax.random.key(seed)
    ks = jax.random.split(key, 40)
    D = D_MODEL

    def nrm(i, shape, std):
        return std * jax.random.normal(ks[i], shape, jnp.float32)

    def gain(i, shape):
        return 1.0 + nrm(i, shape, 0.02)

    return {
        'x': nrm(0, (BATCH, SEQ, D), 1.0),
        'c': nrm(1, (BATCH, D), 1.0),
        'ctx': nrm(2, (BATCH, CTX_LEN, D), 1.0),
        'c_ctx': nrm(3, (D,), 1.0),
        'ada_w': nrm(4, (DEPTH, D, ADA_CHUNKS * D), 0.2 * D ** -0.5),
        'ada_b': nrm(5, (DEPTH, ADA_CHUNKS * D), 0.02),
        'g_pre_mix': gain(6, (DEPTH, D)),
        'g_post_mix': gain(7, (DEPTH, D)),
        'g_pre_ffn': gain(8, (DEPTH, D)),
        'g_post_ffn': gain(9, (DEPTH, D)),
        'ab_w_in': nrm(10, (N_EVEN, D, AB_IN), D ** -0.5),
        'ab_w_out': nrm(11, (N_EVEN, AB_MIX, D), AB_MIX ** -0.5),
        'gla_dw_f': nrm(12, (N_EVEN, GLA_LOWRANK, GLA_QK), GLA_LOWRANK ** -0.5),
        'gla_db_f': nrm(13, (N_EVEN, GLA_QK), 0.1),
        'gla_dw_b': nrm(14, (N_EVEN, GLA_LOWRANK, GLA_QK), GLA_LOWRANK ** -0.5),
        'gla_db_b': nrm(15, (N_EVEN, GLA_QK), 0.1),
        'gla_norm_g': gain(16, (N_EVEN, GLA_V)),
        'conv_w': nrm(17, (N_EVEN, CONV_WIDTH, CONV_CH), CONV_WIDTH ** -0.5),
        'conv_b': nrm(18, (N_EVEN, CONV_CH), 0.02),
        'conv_ln_g': gain(19, (N_EVEN, CONV_CH)),
        'conv_ln_b': nrm(20, (N_EVEN, CONV_CH), 0.02),
        'na_w_in': nrm(21, (N_ODD, D, 3 * NA_HEADS * NA_DH), D ** -0.5),
        'na_w_out': nrm(22, (N_ODD, NA_HEADS * NA_DH, D), (NA_HEADS * NA_DH) ** -0.5),
        'na_rpb': nrm(23, (N_ODD, NA_HEADS, 2 * NA_WIN_ROWS - 1, 2 * NA_WIN_COLS - 1), 0.1),
        'moe_router_w': nrm(24, (DEPTH, D, N_EXPERTS), D ** -0.5),
        'moe_router_b': nrm(25, (DEPTH, N_EXPERTS), 0.01),
        'moe_w_gate': nrm(26, (DEPTH, N_EXPERTS, D, D_EXPERT), D ** -0.5),
        'moe_w_up': nrm(27, (DEPTH, N_EXPERTS, D, D_EXPERT), D ** -0.5),
        'moe_w_down': nrm(28, (DEPTH, N_EXPERTS, D_EXPERT, D), D_EXPERT ** -0.5),
        'moe_ws_gate': nrm(29, (DEPTH, D, D_SHARED), D ** -0.5),
        'moe_ws_up': nrm(30, (DEPTH, D, D_SHARED), D ** -0.5),
        'moe_ws_down': nrm(31, (DEPTH, D_SHARED, D), D_SHARED ** -0.5),
    }


def reference(x, c, ctx, c_ctx, ada_w, ada_b, g_pre_mix, g_post_mix, g_pre_ffn, g_post_ffn,
              ab_w_in, ab_w_out, gla_dw_f, gla_db_f, gla_dw_b, gla_db_b, gla_norm_g,
              conv_w, conv_b, conv_ln_g, conv_ln_b, na_w_in, na_w_out, na_rpb,
              moe_router_w, moe_router_b, moe_w_gate, moe_w_up, moe_w_down,
              moe_ws_gate, moe_ws_up, moe_ws_down):
    B, S, D = x.shape
    C = ctx.shape[1]
    for layer in range(DEPTH):
        last = layer == DEPTH - 1
        i = layer // 2
        mod_x = jax.nn.silu(c) @ ada_w[layer] + ada_b[layer]
        mod_c = jax.nn.silu(c_ctx) @ ada_w[layer] + ada_b[layer]
        shx1, scx1, gx1, shx2, scx2, gx2 = jnp.split(mod_x[:, None, :], ADA_CHUNKS, axis=-1)
        shc1, scc1, gc1, shc2, scc2, gc2 = jnp.split(mod_c[None, None, :], ADA_CHUNKS, axis=-1)

        hx = rms_norm(x, g_pre_mix[layer]) * (1.0 + scx1) + shx1
        hc = rms_norm(ctx, g_pre_mix[layer]) * (1.0 + scc1) + shc1
        if layer % 2 == 0:
            yx, yc = ab_mixer(hx, hc, ab_w_in[i], ab_w_out[i], gla_dw_f[i], gla_db_f[i], gla_dw_b[i], gla_db_b[i],
                              gla_norm_g[i], conv_w[i], conv_b[i], conv_ln_g[i], conv_ln_b[i])
        else:
            yx, yc = na_mixer(hx, hc, na_w_in[i], na_w_out[i], na_rpb[i], not last)
        x = x + gx1 * rms_norm(yx, g_post_mix[layer])
        if not last:
            ctx = ctx + gc1 * rms_norm(yc, g_post_mix[layer])

        hx = (rms_norm(x, g_pre_ffn[layer]) * (1.0 + scx2) + shx2).reshape(B * S, D)
        if last:
            tokens = hx
        else:
            hc = (rms_norm(ctx, g_pre_ffn[layer]) * (1.0 + scc2) + shc2).reshape(B * C, D)
            tokens = jnp.concatenate([hx, hc], axis=0)
        yt = moe_ffn(tokens, moe_router_w[layer], moe_router_b[layer], moe_w_gate[layer], moe_w_up[layer],
                     moe_w_down[layer], moe_ws_gate[layer], moe_ws_up[layer], moe_ws_down[layer])
        x = x + gx2 * rms_norm(yt[:B * S].reshape(B, S, D), g_post_ffn[layer])
        if not last:
            ctx = ctx + gc2 * rms_norm(yt[B * S:].reshape(B, C, D), g_post_ffn[layer])
    return x
```

```cpp
#include <hip/hip_runtime.h>
#include <cstdio>
#include <cstdint>

#ifndef MK_ONE_LAUNCH
#define MK_ONE_LAUNCH 0
#endif
#ifndef MK_LAST_PHASE
#define MK_LAST_PHASE 99
#endif

#define GAS __attribute__((address_space(1)))
#define LAS __attribute__((address_space(3)))
typedef unsigned short bf16_t;
typedef short bf16x8 __attribute__((ext_vector_type(8)));
typedef float f32x4 __attribute__((ext_vector_type(4)));
typedef float f32x2 __attribute__((ext_vector_type(2)));
typedef unsigned u32x4 __attribute__((ext_vector_type(4)));
typedef unsigned u32x2 __attribute__((ext_vector_type(2)));

constexpr int D = 1024, BATCH = 16, SEQ = 2048, CTXL = 256, GRIDW = 64;
constexpr int NX = BATCH * SEQ, NC = BATCH * CTXL, NT = NX + NC;
constexpr int ADA = 6 * D;
constexpr int GLA_H = 4, GLA_DK = 64, GLA_DV = 128, GLA_QK = 256, GLA_V = 512, CONV_CH = 512, CONV_W = 31;
constexpr int AB_IN = 2592, AB_INP = 2816;
constexpr int NA_H = 16, NA_DH = 64;
constexpr int NEXP = 256, TOPK = 8, DEXP = 256;
constexpr int NEXPS = NEXP + 1;
constexpr int PMAX = NT * TOPK + NEXP * 255 + NT;
static_assert(PMAX % 256 == 0, "PMAX");
constexpr float RMS_EPS = 1e-6f, LN_EPS = 1e-5f;

constexpr size_t MiB = 1u << 20;
constexpr size_t al(size_t x) { return (x + 4095) & ~(size_t)4095; }
constexpr size_t WS_CTL = 0, CTL_BYTES = 1 * MiB;
constexpr size_t WS_MODX = WS_CTL + CTL_BYTES;
constexpr size_t WS_MODC = WS_MODX + al((size_t)2 * 16 * ADA * 4);
constexpr size_t WS_ROPE = WS_MODC + al((size_t)2 * ADA * 4);
constexpr size_t WS_XW = WS_ROPE + al(64 * 16 * 8);
constexpr size_t WS_H = WS_XW + al((size_t)NT * D * 4);
constexpr size_t WS_WIN0 = WS_H + al((size_t)NT * D * 2);
constexpr size_t WS_WOUT0 = WS_WIN0 + al((size_t)AB_INP * D * 2);
constexpr size_t WS_WQKV1 = WS_WOUT0 + al((size_t)D * D * 2);
constexpr size_t WS_WOUT1 = WS_WQKV1 + al((size_t)3 * D * D * 2);
constexpr size_t WS_WR = WS_WOUT1 + al((size_t)D * D * 2);
constexpr size_t WS_WGU = WS_WR + al((size_t)2 * NEXP * D * 2);
constexpr size_t WS_WDN = WS_WGU + al((size_t)NEXPS * 512 * D * 2);
constexpr size_t WS_T = WS_WDN + al((size_t)NEXPS * D * 256 * 2);
constexpr size_t T_QB = WS_T;
constexpr size_t T_KB = T_QB + al((size_t)NT * 256 * 2);
constexpr size_t T_VB = T_KB + al((size_t)NT * 256 * 2);
constexpr size_t T_GB = T_VB + al((size_t)NT * 512 * 2);
constexpr size_t T_UB = T_GB + al((size_t)NT * 512 * 2);
constexpr size_t T_LR = T_UB + al((size_t)NT * 512 * 2);
constexpr size_t T_OF = T_LR + al((size_t)NT * 32 * 4);
constexpr size_t T_OB = T_OF + al((size_t)NT * 512 * 2);
constexpr size_t T_CAT = T_OB + al((size_t)NT * 512 * 2);
constexpr size_t T_Y = T_CAT + al((size_t)NT * D * 2);
constexpr size_t T_END0 = T_Y + al((size_t)NT * D * 2);
constexpr size_t T_QKV = WS_T;
static_assert(T_QKV + (size_t)3 * NT * D * 2 <= T_CAT, "qkv overlay");
constexpr size_t M_AE = WS_T;
constexpr size_t M_AR = M_AE + al((size_t)NT * 8 * 4);
constexpr size_t M_AG = M_AR + al((size_t)NT * 8 * 4);
constexpr size_t M_TS = M_AG + al((size_t)NT * 8 * 4);
constexpr size_t M_ST = M_TS + al((size_t)NT * 8 * 4);
constexpr size_t M_HID = M_ST + al((size_t)PMAX * 4);
constexpr size_t M_OUT = M_HID + al((size_t)PMAX * 256 * 2);
constexpr size_t M_END = M_OUT + al((size_t)PMAX * D * 2);
constexpr size_t WS_END = (M_END > T_END0 ? M_END : T_END0);
static_assert(WS_END <= (size_t)2040 * MiB, "workspace map must fit 2 GiB");

constexpr int CW_BAR = 4096;
constexpr int CW_CNT = 16384;
constexpr int CW_CUR = 16384 + 512;

constexpr int RING_BYTES = 131072;
constexpr int AUX_OFF = RING_BYTES, AUX_BYTES = 20480;
constexpr int MISC_OFF = AUX_OFF + AUX_BYTES;
constexpr int LDS_BYTES = MISC_OFF + 1024;
constexpr int NWAVES = 8, NTHREADS = 512;

#define LDS_WAIT() asm volatile("s_waitcnt lgkmcnt(0)" ::: "memory")
#define VM_WAIT() asm volatile("s_waitcnt vmcnt(0)" ::: "memory")

__device__ __forceinline__ unsigned f2bf(float f) { unsigned u = __builtin_bit_cast(unsigned, f); return (u + 0x7fffu + ((u >> 16) & 1u)) >> 16; }
__device__ __forceinline__ unsigned pk2(float lo, float hi) { return f2bf(lo) | (f2bf(hi) << 16); }
__device__ __forceinline__ float bf2f(unsigned short b) { return __builtin_bit_cast(float, (unsigned)b << 16); }
__device__ __forceinline__ float bflo(unsigned w) { return __builtin_bit_cast(float, w << 16); }
__device__ __forceinline__ float bfhi(unsigned w) { return __builtin_bit_cast(float, w & 0xffff0000u); }
__device__ __forceinline__ float wave_sum(float v) {
#pragma unroll
    for (int o = 1; o < 64; o <<= 1) v += __shfl_xor(v, o);
    return v;
}
__device__ __forceinline__ float sigmoidf_(float x) { return 1.0f / (1.0f + __expf(-x)); }
__device__ __forceinline__ float siluf_(float x) { return x / (1.0f + __expf(-x)); }

#define XB_TMO      128
#define XB_XCNT(j)  (256  + 64 * (j))
#define XB_XSUB(j)  (1280 + 64 * (j))
#define XB_XGEN(j)  (2304 + 64 * (j))
#define XB_TOP      3328
#define XB_TOPGEN   3392
#define XCD_BAR_WORDS 3456
#define XB_SPIN_CAP (1u << 18)

__device__ __forceinline__ unsigned xb_ld(unsigned* p)              { return __hip_atomic_load(p, __ATOMIC_RELAXED, __HIP_MEMORY_SCOPE_AGENT); }
__device__ __forceinline__ unsigned xb_add(unsigned* p, unsigned v) { return __hip_atomic_fetch_add(p, v, __ATOMIC_RELAXED, __HIP_MEMORY_SCOPE_AGENT); }
__device__ __forceinline__ unsigned xb_xcc_id() { return (unsigned)__builtin_amdgcn_s_getreg((3 << 11) | 20) & 0xFu; }
#define XB_SPIN(cond, bar) do { unsigned _sp = 0; while (cond) { __builtin_amdgcn_s_sleep(1); \
    if ((++_sp & 255u) == 0u) { if (xb_ld(&(bar)[XB_TMO])) break; if (_sp > XB_SPIN_CAP) { atomicAdd(&(bar)[XB_TMO], 1u); break; } } } } while (0)

struct XcdBarrier { unsigned* bar; unsigned x; volatile LAS unsigned* st; };

__device__ __forceinline__ XcdBarrier xcd_barrier_post(unsigned* bar, volatile LAS unsigned* st) {
    XcdBarrier b; b.bar = bar; b.x = xb_xcc_id(); b.st = st;
    if (threadIdx.x == 0) (void)xb_add(&bar[XB_XCNT(b.x)], 1u);
    return b;
}
__device__ __forceinline__ void xcd_barrier_complete(unsigned* bar, unsigned x, unsigned& nloc, unsigned& nx) {
    const unsigned G = gridDim.x * gridDim.y * gridDim.z;
    unsigned sum, cnt, mine, sp = 0u;
    for (;;) {
        sum = 0u; cnt = 0u; mine = 0u;
#pragma unroll
        for (unsigned j = 0; j < 16; ++j) { const unsigned c = xb_ld(&bar[XB_XCNT(j)]); sum += c; cnt += (c > 0u) ? 1u : 0u; mine = (j == x) ? c : mine; }
        if (sum == G) break;
        __builtin_amdgcn_s_sleep(1);
        if ((++sp & 255u) == 0u) { if (xb_ld(&bar[XB_TMO])) break; if (sp > XB_SPIN_CAP) { atomicAdd(&bar[XB_TMO], 1u); break; } }
    }
    nloc = mine > 0u ? mine : 1u; nx = cnt > 0u ? cnt : 1u;
}
__device__ __forceinline__ void xcd_barrier(const XcdBarrier& b) {
    asm volatile("s_waitcnt vmcnt(0)" ::: "memory");
    __syncthreads();
    if (threadIdx.x == 0) {
        unsigned* bar = b.bar;
        __builtin_amdgcn_s_waitcnt(0);
        unsigned nloc = b.st[0], nx = b.st[1];
        if (nloc == 0u) { xcd_barrier_complete(bar, b.x, nloc, nx); b.st[0] = nloc; b.st[1] = nx; }
        const unsigned old = xb_add(&bar[XB_XSUB(b.x)], 1u);
        const unsigned gen = old / nloc;
        if (old + 1u == (gen + 1u) * nloc) {
            __builtin_amdgcn_fence(__ATOMIC_RELEASE, "agent");
            asm volatile("s_waitcnt vmcnt(0)" ::: "memory");
            const unsigned og = xb_add(&bar[XB_TOP], 1u);
            const unsigned tg = og / nx;
            if (og + 1u == (tg + 1u) * nx) xb_add(&bar[XB_TOPGEN], 1u);
            else XB_SPIN(xb_ld(&bar[XB_TOPGEN]) == tg, bar);
            __builtin_amdgcn_fence(__ATOMIC_ACQUIRE, "agent");
            xb_add(&bar[XB_XGEN(b.x)], 1u);
            asm volatile("s_waitcnt vmcnt(0)" ::: "memory");
        } else {
            XB_SPIN(xb_ld(&bar[XB_XGEN(b.x)]) == gen, bar);
            __builtin_amdgcn_fence(__ATOMIC_ACQUIRE, "agent");
            asm volatile("s_waitcnt vmcnt(0)" ::: "memory");
        }
    }
    __syncthreads();
}

namespace pg8 {
constexpr int BM = 256, BK = 64, HALF = 128, HTB = HALF * BK * 2, STAGE_BYTES = 8 * HTB, NXCD = 8, WGM = 8;
__host__ __device__ __forceinline__ int lds_byte(int r, int c) { const int st = (r >> 4) * 2 + (c >> 5), rr = r & 15, cc = c & 31, ob = rr * 64 + cc * 2; return st * 1024 + (ob ^ (((ob >> 9) & 1) << 5)); }
__host__ __device__ __forceinline__ void stage_rc(int b, int& R, int& C) { const int st = b / 1024, sb = b % 1024, swz = sb ^ (((sb >> 9) & 1) << 5); R = (st >> 1) * 16 + swz / 64; C = (st & 1) * 32 + (swz % 64) / 2; }
__host__ __device__ __forceinline__ int perm32(int rho) { const int n = rho >> 4, i = rho & 15; return 8 * (i >> 2) + 4 * n + (i & 3); }

struct Unit { int a, b, orow, ocol, aux; };

__device__ __forceinline__ bool static_order(int L, int nM, int nN, int& pm, int& pn) {
    const int nwg = nM * nN; if (L >= nwg) return false;
    int wgid = L; { const int q = nwg / NXCD, r = nwg % NXCD, xcd = wgid % NXCD, off = wgid / NXCD; wgid = (xcd < r ? xcd * (q + 1) : r * (q + 1) + (xcd - r) * q) + off; }
    const int nig = WGM * nN, gid = wgid / nig, fm = gid * WGM, gsz = (nM - fm) < WGM ? (nM - fm) : WGM;
    pm = fm + ((wgid % nig) % gsz); pn = (wgid % nig) / gsz; return true;
}

template <class Epi, class Sched, bool ALIGN_EPI>
__device__ __forceinline__ void gemm_phase(LAS unsigned char* lds, const int K, const Sched& S, const Epi& E) {
    const int tid = threadIdx.x, wid = __builtin_amdgcn_readfirstlane(tid >> 6), lane = tid & 63, wr = wid >> 2, wc = wid & 3, fr = lane & 15, fq = lane >> 4;
    const int nt = K / BK;
    int Rr[2], Cc[2]; unsigned voffB[2];
#pragma unroll
    for (int i = 0; i < 2; ++i) { int R, C; stage_rc(tid * 16 + i * 8192, R, C); Rr[i] = R; Cc[i] = C; const int Rb = Epi::PERM ? ((R & ~31) + perm32(R & 31)) : R; voffB[i] = (unsigned)(Rb * K + C) * 2u; }
    const size_t kstep = (size_t)(BK * 2);
    const size_t hstepB = (size_t)HALF * K * 2;
    const unsigned ldsw = (unsigned)wid * 1024u;
    const int aoff = lds_byte(wr * 64 + fr, fq * 8), boff = lds_byte(wc * 32 + fr, fq * 8);
#define PG8_SA(b, h) (((b) * 2 + (h)) * HTB)
#define PG8_SB(b, h) ((4 + (b) * 2 + (h)) * HTB)
#define PG8_STAGE(bufoff, gbase, voff) do { _Pragma("unroll") for (int _i = 0; _i < 2; ++_i) \
        __builtin_amdgcn_global_load_lds((const unsigned*)((const char*)(gbase) + (voff)[_i]), (LAS unsigned*)(lds + (bufoff) + ldsw + _i * 8192), 16, 0, 0); } while (0)
#define PG8_LDA(dst, b, h) do { _Pragma("unroll") for (int m = 0; m < 4; ++m) _Pragma("unroll") for (int k = 0; k < 2; ++k) dst[m][k] = *(const LAS bf16x8*)(lds + PG8_SA(b, h) + aoff + m * 2048 + k * 1024); } while (0)
#define PG8_LDB(dst, b, h) do { _Pragma("unroll") for (int n = 0; n < 2; ++n) _Pragma("unroll") for (int k = 0; k < 2; ++k) dst[n][k] = *(const LAS bf16x8*)(lds + PG8_SB(b, h) + boff + n * 2048 + k * 1024); } while (0)
#define PG8_MMA(ai, bj, At, Bt) do { __builtin_amdgcn_s_setprio(1); _Pragma("unroll") for (int m = 0; m < 4; ++m) _Pragma("unroll") for (int n = 0; n < 2; ++n) _Pragma("unroll") for (int k = 0; k < 2; ++k) \
        acc[ai][bj][m][n] = __builtin_amdgcn_mfma_f32_16x16x32_bf16(Bt[n][k], At[m][k], acc[ai][bj][m][n], 0, 0, 0); __builtin_amdgcn_s_setprio(0); } while (0)
#define PG8_WAIT_V(n) asm volatile("s_waitcnt vmcnt(" #n ")" ::: "memory")
#define PG8_WAIT_L(n) asm volatile("s_waitcnt lgkmcnt(" #n ")" ::: "memory")
#define PG8_BAR __builtin_amdgcn_s_barrier()
#define PG8_SCHED __builtin_amdgcn_sched_barrier(0)
    Unit cur, nxt; int ui = 0;
    if (!S.next(0, cur)) return;
    f32x4 acc[2][2][4][2];
#pragma unroll
    for (int a = 0; a < 2; ++a)
#pragma unroll
        for (int b = 0; b < 2; ++b)
#pragma unroll
            for (int m = 0; m < 4; ++m)
#pragma unroll
                for (int n = 0; n < 2; ++n) acc[a][b][m][n] = (f32x4){0.f, 0.f, 0.f, 0.f};
    bf16x8 At[4][2], B0[2][2], B1[2][2];
    unsigned co0[2], co1[2], no0[2], no1[2];
    S.a_off(cur, Rr, Cc, co0, co1);
    const char* const Ab = S.a_base();
    const char* cB = S.b_ptr(cur);
    PG8_STAGE(PG8_SB(0, 0), cB, voffB); PG8_STAGE(PG8_SB(0, 1), cB + hstepB, voffB); PG8_STAGE(PG8_SA(0, 0), Ab, co0); PG8_STAGE(PG8_SA(0, 1), Ab, co1);
    if (wr == 1) PG8_BAR;
    PG8_WAIT_V(2); PG8_BAR;
    PG8_STAGE(PG8_SB(1, 0), cB + kstep, voffB); PG8_STAGE(PG8_SA(1, 0), Ab + kstep, co0); PG8_STAGE(PG8_SB(1, 1), cB + hstepB + kstep, voffB);
    PG8_WAIT_V(6); PG8_BAR;
    for (;;) {
        const bool has_next = S.next(ui + 1, nxt);
        const char* nB = has_next ? S.b_ptr(nxt) : cB;
#pragma nounroll
        for (int t = 0; t < nt; t += 2) {
            const bool last = (t == nt - 2);
            if (last) { if (has_next) S.a_off(nxt, Rr, Cc, no0, no1); else { no0[0] = co0[0]; no0[1] = co0[1]; no1[0] = co1[0]; no1[1] = co1[1]; } }
            const char* a1 = Ab + (size_t)(t + 1) * kstep;
            const char* a2 = last ? Ab : Ab + (size_t)(t + 2) * kstep; const char* b2 = last ? nB : cB + (size_t)(t + 2) * kstep;
            const char* a3 = a2 + kstep; const char* b3 = b2 + kstep;
            unsigned x0[2], x1[2];
            x0[0] = last ? no0[0] : co0[0]; x0[1] = last ? no0[1] : co0[1]; x1[0] = last ? no1[0] : co1[0]; x1[1] = last ? no1[1] : co1[1];
            PG8_LDB(B0, 0, 0); PG8_LDB(B1, 0, 1); PG8_SCHED; PG8_LDA(At, 0, 0); PG8_STAGE(PG8_SA(1, 1), a1, co1);
            PG8_WAIT_V(8); PG8_WAIT_L(0); PG8_BAR; PG8_MMA(0, 0, At, B0); PG8_MMA(0, 1, At, B1); PG8_BAR; PG8_SCHED;
            PG8_LDA(At, 0, 1); PG8_STAGE(PG8_SB(0, 0), b2, voffB); PG8_STAGE(PG8_SB(0, 1), b2 + hstepB, voffB); PG8_STAGE(PG8_SA(0, 0), a2, x0);
            PG8_WAIT_V(8); PG8_WAIT_L(0); PG8_BAR; PG8_MMA(1, 0, At, B0); PG8_MMA(1, 1, At, B1); PG8_BAR; PG8_SCHED;
            PG8_LDB(B0, 1, 0); PG8_LDB(B1, 1, 1); PG8_SCHED; PG8_LDA(At, 1, 0); PG8_STAGE(PG8_SA(0, 1), a2, x1);
            PG8_WAIT_V(8); PG8_WAIT_L(0); PG8_BAR; PG8_MMA(0, 0, At, B0); PG8_MMA(0, 1, At, B1); PG8_BAR; PG8_SCHED;
            PG8_LDA(At, 1, 1); PG8_STAGE(PG8_SB(1, 0), b3, voffB); PG8_STAGE(PG8_SB(1, 1), b3 + hstepB, voffB); PG8_STAGE(PG8_SA(1, 0), a3, x0);
            PG8_WAIT_V(8); PG8_WAIT_L(0); PG8_BAR; PG8_MMA(1, 0, At, B0); PG8_MMA(1, 1, At, B1); PG8_BAR; PG8_SCHED;
        }
        if constexpr (ALIGN_EPI) { if (wr == 0) PG8_BAR; }
        if constexpr (!Epi::AFTER_DRAIN) { E(acc, cur, wr, wc, fr, fq); }
        if (!has_next) break;
#pragma unroll
        for (int a = 0; a < 2; ++a)
#pragma unroll
            for (int b = 0; b < 2; ++b)
#pragma unroll
                for (int m = 0; m < 4; ++m)
#pragma unroll
                    for (int n = 0; n < 2; ++n) acc[a][b][m][n] = (f32x4){0.f, 0.f, 0.f, 0.f};
        cur = nxt; cB = nB; co0[0] = no0[0]; co0[1] = no0[1]; co1[0] = no1[0]; co1[1] = no1[1]; ++ui;
        if constexpr (ALIGN_EPI) { if (wr == 1) PG8_BAR; }
    }
    PG8_WAIT_V(0);
    if constexpr (!ALIGN_EPI) { if (wr == 0) PG8_BAR; }
    PG8_BAR;
    if constexpr (Epi::AFTER_DRAIN) { E.fused(acc, cur, wr, wc, fr, fq, lds, wid, lane); }
#undef PG8_SA
#undef PG8_SB
#undef PG8_STAGE
#undef PG8_LDA
#undef PG8_LDB
#undef PG8_MMA
#undef PG8_WAIT_V
#undef PG8_WAIT_L
#undef PG8_BAR
#undef PG8_SCHED
}
}
using pg8::Unit;

__device__ __forceinline__ unsigned cvt_pk_bf16(float lo, float hi) { unsigned r; asm volatile("v_cvt_pk_bf16_f32 %0, %1, %2" : "=v"(r) : "v"(lo), "v"(hi)); return r; }

struct SchedDense {
    const char* A; const char* Bt; int K; int nM0, nN0, nM1, nN1, pn1off; int G, c;
    __device__ __forceinline__ bool next(int i, Unit& u) const {
        const int L = i * G + c; int pm, pn;
        const int n0 = nM0 * nN0;
        if (L < n0) { pg8::static_order(L, nM0, nN0, pm, pn); }
        else { if (!pg8::static_order(L - n0, nM1, nN1, pm, pn)) return false; pm += nM0; pn += pn1off; }
        u.a = pm; u.b = pn * 256; u.orow = pm * 256; u.ocol = pn * 256; u.aux = pn; return true;
    }
    __device__ __forceinline__ const char* a_base() const { return A; }
    __device__ __forceinline__ const char* b_ptr(const Unit& u) const { return Bt + (size_t)u.b * K * 2; }
    __device__ __forceinline__ void a_off(const Unit& u, const int (&R)[2], const int (&C)[2], unsigned (&o0)[2], unsigned (&o1)[2]) const {
#pragma unroll
        for (int i = 0; i < 2; ++i) { o0[i] = (unsigned)((u.a * 256 + R[i]) * K + C[i]) * 2u; o1[i] = o0[i] + (unsigned)(128 * K * 2); }
    }
};

struct EpiBf16 {
    static constexpr bool PERM = true, AFTER_DRAIN = false;
    bf16_t* O; int ldc; int split_cols; size_t split_stride;
    __device__ __forceinline__ void operator()(const f32x4 (&acc)[2][2][4][2], const Unit& u, int wr, int wc, int fr, int fq) const {
        const int row0 = u.orow + wr * 64 + fr; int colt = u.ocol; bf16_t* base = O;
        if (split_cols) { const int t = colt / split_cols; base += (size_t)t * split_stride; colt -= t * split_cols; }
        const int col0 = colt + wc * 32 + 8 * fq;
#pragma unroll
        for (int ai = 0; ai < 2; ++ai)
#pragma unroll
            for (int m = 0; m < 4; ++m) { bf16_t* rowp = base + (size_t)(row0 + ai * 128 + m * 16) * ldc + col0;
#pragma unroll
                for (int bj = 0; bj < 2; ++bj) { const f32x4 v0 = acc[ai][bj][m][0], v1 = acc[ai][bj][m][1];
                    u32x4 w; w.x = cvt_pk_bf16(v0[0], v0[1]); w.y = cvt_pk_bf16(v0[2], v0[3]); w.z = cvt_pk_bf16(v1[0], v1[1]); w.w = cvt_pk_bf16(v1[2], v1[3]);
                    *(u32x4*)(rowp + bj * 128) = w; } }
    }
};

struct EpiInproj {
    static constexpr bool PERM = false, AFTER_DRAIN = false;
    bf16_t *qb, *kb, *vb, *gb, *ub; float* lr; const f32x2* rope;
    __device__ __forceinline__ void operator()(const f32x4 (&acc)[2][2][4][2], const Unit& u, int wr, int wc, int fr, int fq) const {
        const int pn = u.aux; const int row0 = u.orow + wr * 64 + fr;
        if (pn <= 1) {
            bf16_t* dst = pn == 0 ? qb : kb; const float sc = pn == 0 ? 0.125f : 1.0f;
#pragma unroll
            for (int ai = 0; ai < 2; ++ai)
#pragma unroll
                for (int m = 0; m < 4; ++m) {
                    const int row = row0 + ai * 128 + m * 16; const bool lat = row < NX;
                    const int s = row & (SEQ - 1); const int pos = (wc & 1) ? (s & 63) : (s >> 6);
                    f32x2 cs[4];
                    if (lat) {
#pragma unroll
                        for (int e = 0; e < 4; ++e) cs[e] = rope[pos * 16 + 4 * fq + e];
                    } else {
#pragma unroll
                        for (int e = 0; e < 4; ++e) cs[e] = (f32x2){1.f, 0.f};
                    }
#pragma unroll
                    for (int bj = 0; bj < 2; ++bj) {
                        const f32x4 u1 = acc[ai][bj][m][0], u2 = acc[ai][bj][m][1]; f32x4 o1, o2;
#pragma unroll
                        for (int e = 0; e < 4; ++e) { o1[e] = (u1[e] * cs[e].x - u2[e] * cs[e].y) * sc; o2[e] = (u1[e] * cs[e].y + u2[e] * cs[e].x) * sc; }
                        bf16_t* p = dst + (size_t)row * 256 + bj * 128 + wc * 32 + 4 * fq;
                        u32x2 w1, w2; w1.x = cvt_pk_bf16(o1[0], o1[1]); w1.y = cvt_pk_bf16(o1[2], o1[3]); w2.x = cvt_pk_bf16(o2[0], o2[1]); w2.y = cvt_pk_bf16(o2[2], o2[3]);
                        *(u32x2*)p = w1; *(u32x2*)(p + 16) = w2;
                    }
                }
        } else if (pn <= 5) {
            bf16_t* dst = pn <= 3 ? vb : gb; const int cb = (pn & 1) ? 256 : 0;
#pragma unroll
            for (int ai = 0; ai < 2; ++ai)
#pragma unroll
                for (int m = 0; m < 4; ++m) { const int row = row0 + ai * 128 + m * 16;
#pragma unroll
                    for (int bj = 0; bj < 2; ++bj)
#pragma unroll
                        for (int n = 0; n < 2; ++n) { const f32x4 v = acc[ai][bj][m][n]; u32x2 w; w.x = cvt_pk_bf16(v[0], v[1]); w.y = cvt_pk_bf16(v[2], v[3]);
                            *(u32x2*)(dst + (size_t)row * 512 + cb + bj * 128 + wc * 32 + n * 16 + 4 * fq) = w; } }
        } else if (pn <= 9) {
            const int cb = (pn - 6) * 128;
#pragma unroll
            for (int ai = 0; ai < 2; ++ai)
#pragma unroll
                for (int m = 0; m < 4; ++m) { const int row = row0 + ai * 128 + m * 16;
#pragma unroll
                    for (int n = 0; n < 2; ++n) { const f32x4 a = acc[ai][0][m][n], b = acc[ai][1][m][n]; f32x4 o;
#pragma unroll
                        for (int e = 0; e < 4; ++e) o[e] = a[e] * sigmoidf_(b[e]);
                        u32x2 w; w.x = cvt_pk_bf16(o[0], o[1]); w.y = cvt_pk_bf16(o[2], o[3]);
                        *(u32x2*)(ub + (size_t)row * 512 + cb + wc * 32 + n * 16 + 4 * fq) = w; } }
        } else {
            if (wc == 0) {
#pragma unroll
                for (int ai = 0; ai < 2; ++ai)
#pragma unroll
                    for (int m = 0; m < 4; ++m) { const int row = row0 + ai * 128 + m * 16;
#pragma unroll
                        for (int n = 0; n < 2; ++n) *(f32x4*)(lr + (size_t)row * 32 + n * 16 + 4 * fq) = acc[ai][0][m][n]; }
            }
        }
    }
};

struct Args { const float* in[32]; float* out; unsigned char* ws; int ph_lo, ph_hi; };

struct Frame {
    LAS unsigned char* lds; volatile LAS unsigned* MISC; unsigned* ctl; unsigned char* ws;
    int tid, lane, wave, G, vcu;
};

__device__ __forceinline__ void cvt_item(const float* __restrict__ src, int ld, int col0, int ncols, int k0, bf16_t* dst, int ldd, int drow0, LAS unsigned* T, int lane) {
    const bool okc = lane < ncols;
    const float* p = src + (size_t)k0 * ld + col0 + (okc ? lane : 0);
    float v[64];
#pragma unroll
    for (int k = 0; k < 64; ++k) v[k] = p[(size_t)k * ld];
#pragma unroll
    for (int kp = 0; kp < 32; ++kp) T[lane * 33 + kp] = okc ? pk2(v[2 * kp], v[2 * kp + 1]) : 0u;
    LDS_WAIT(); asm volatile("" ::: "memory");
    const int c = lane & 7;
#pragma unroll
    for (int it = 0; it < 8; ++it) { const int n = (lane >> 3) + 8 * it;
        u32x4 o; o.x = T[n * 33 + 4 * c]; o.y = T[n * 33 + 4 * c + 1]; o.z = T[n * 33 + 4 * c + 2]; o.w = T[n * 33 + 4 * c + 3];
        if (n < ncols) *(u32x4*)(dst + (size_t)(drow0 + n) * ldd + k0 + 8 * c) = o; }
    LDS_WAIT(); asm volatile("" ::: "memory");
}
__device__ __forceinline__ void cvt_matrix_item(const float* src, int ld, int col0, int ncols, int K, bf16_t* dst, int drow0, int item, LAS unsigned* T, int lane) {
    const int ncg = (ncols + 63) >> 6; const int kt = item / ncg, cg = item - kt * ncg;
    const int nc = ncols - cg * 64 < 64 ? ncols - cg * 64 : 64;
    cvt_item(src, ld, col0 + cg * 64, nc, kt * 64, dst, K, drow0 + cg * 64, T, lane);
}

constexpr int MOE_CVT_ITEMS = NEXPS * 192;
__device__ __forceinline__ void cvt_moe_item(const Args& a, int layer, int item, unsigned char* ws, LAS unsigned* T, int lane) {
    const int e = item / 192, r = item - e * 192;
    bf16_t* wgu = (bf16_t*)(ws + WS_WGU) + (size_t)e * 512 * D; bf16_t* wdn = (bf16_t*)(ws + WS_WDN) + (size_t)e * D * 256;
    if (r < 128) {
        const int gi = r >> 4, kt = r & 15; const int up = gi >> 2, g4 = gi & 3;
        const float* src = e < NEXP ? (up ? a.in[27] : a.in[26]) + ((size_t)layer * NEXP + e) * D * DEXP : (up ? a.in[30] : a.in[29]) + (size_t)layer * D * DEXP;
        cvt_item(src, DEXP, 64 * g4, 64, kt * 64, wgu, D, 256 * (g4 >> 1) + 64 * (g4 & 1) + 128 * up, T, lane);
    } else {
        const int q = r - 128; const int cg = q >> 2, kt = q & 3;
        const float* src = e < NEXP ? a.in[28] + ((size_t)layer * NEXP + e) * DEXP * D : a.in[31] + (size_t)layer * DEXP * D;
        cvt_item(src, D, 64 * cg, 64, kt * 64, wdn, DEXP, 64 * cg, T, lane);
    }
}

__device__ __forceinline__ float row_rms_scale(const f32x4 (&v)[4]) {
    float s = 0.f;
#pragma unroll
    for (int j = 0; j < 4; ++j) s += (v[j].x * v[j].x + v[j].y * v[j].y) + (v[j].z * v[j].z + v[j].w * v[j].w);
    return rsqrtf(wave_sum(s) * (1.0f / D) + RMS_EPS);
}
__device__ __forceinline__ f32x4 ld4(const float* p) { return *(const f32x4*)p; }

struct RowPhase {
    const float* xin_lat; const float* xin_ctx;
    float* xout_lat; float* xout_ctx;
    int nrows;
    int ysrc; const bf16_t* y;
    const bf16_t* mo; const int* tslot; const float* tgate; int sharedbase;
    const float* gpost; const float* modx; const float* modc; int gate_chunk;
    bool doH; bf16_t* H; const float* gpre; int sc_chunk, sh_chunk; const float* modxH; const float* modcH;
};
__device__ __forceinline__ void row_phase(const Frame& F, const RowPhase& P) {
    const int gw = F.vcu * NWAVES + F.wave, NGW = F.G * NWAVES, lane = F.lane;
    for (int row = gw; row < P.nrows; row += NGW) {
        const bool lat = row < NX; const int b = lat ? (row >> 11) : 0;
        const float* mod = lat ? P.modx + (size_t)b * ADA : P.modc;
        const float* xr = lat ? P.xin_lat + (size_t)row * D : P.xin_ctx + (size_t)(row - NX) * D;
        f32x4 x[4];
#pragma unroll
        for (int j = 0; j < 4; ++j) x[j] = ld4(xr + 4 * lane + 256 * j);
        if (P.ysrc) {
            f32x4 y[4];
            if (P.ysrc == 1) {
#pragma unroll
                for (int j = 0; j < 4; ++j) { const u32x2 w = *(const u32x2*)(P.y + (size_t)row * D + 4 * lane + 256 * j); y[j] = (f32x4){bflo(w.x), bfhi(w.x), bflo(w.y), bfhi(w.y)}; }
            } else {
#pragma unroll
                for (int j = 0; j < 4; ++j) { const u32x2 w = *(const u32x2*)(P.mo + (size_t)(P.sharedbase + row) * D + 4 * lane + 256 * j); y[j] = (f32x4){bflo(w.x), bfhi(w.x), bflo(w.y), bfhi(w.y)}; }
#pragma unroll
                for (int k = 0; k < TOPK; ++k) { const int sl = P.tslot[(size_t)row * 8 + k]; const float g = P.tgate[(size_t)row * 8 + k];
#pragma unroll
                    for (int j = 0; j < 4; ++j) { const u32x2 w = *(const u32x2*)(P.mo + (size_t)sl * D + 4 * lane + 256 * j);
                        y[j].x += g * bflo(w.x); y[j].y += g * bfhi(w.x); y[j].z += g * bflo(w.y); y[j].w += g * bfhi(w.y); } }
            }
            const float rs = row_rms_scale(y);
#pragma unroll
            for (int j = 0; j < 4; ++j) { const f32x4 gp = ld4(P.gpost + 4 * lane + 256 * j), gt = ld4(mod + P.gate_chunk * D + 4 * lane + 256 * j); x[j] = x[j] + gt * (y[j] * rs * gp); }
            float* xo = lat ? P.xout_lat + (size_t)row * D : P.xout_ctx + (size_t)(row - NX) * D;
#pragma unroll
            for (int j = 0; j < 4; ++j) *(f32x4*)(xo + 4 * lane + 256 * j) = x[j];
        }
        if (P.doH) {
            const float rs = row_rms_scale(x); const float* modh = lat ? P.modxH + (size_t)b * ADA : P.modcH;
#pragma unroll
            for (int j = 0; j < 4; ++j) { const f32x4 gp = ld4(P.gpre + 4 * lane + 256 * j), sc = ld4(modh + P.sc_chunk * D + 4 * lane + 256 * j), sh = ld4(modh + P.sh_chunk * D + 4 * lane + 256 * j);
                const f32x4 h = x[j] * rs * gp * (sc + 1.0f) + sh; u32x2 w; w.x = pk2(h.x, h.y); w.y = pk2(h.z, h.w);
                *(u32x2*)(P.H + (size_t)row * D + 4 * lane + 256 * j) = w; }
        }
    }
}

__device__ __forceinline__ void p0_ada(const Frame& F, const Args& a) {
    LAS float* sc = (LAS float*)F.lds;
    if ((int)blockIdx.x >= 96) return;
    for (int i = F.tid; i < 17 * D; i += NTHREADS) { const int r = i >> 10, k = i & 1023; const float v = r < 16 ? a.in[1][r * D + k] : a.in[3][k]; sc[i] = siluf_(v); }
    __syncthreads();
    const int item = blockIdx.x; const int layer = item / 48, cg = item % 48;
    const int cq = F.tid & 31, kl = F.tid >> 5;
    const float* W = a.in[4] + (size_t)layer * D * ADA + cg * 128 + cq * 4;
    f32x4 acc[17];
#pragma unroll
    for (int r = 0; r < 17; ++r) acc[r] = (f32x4){0.f, 0.f, 0.f, 0.f};
    for (int k = kl; k < D; k += 16) {
        const f32x4 w = ld4(W + (size_t)k * ADA);
#pragma unroll
        for (int r = 0; r < 17; ++r) { const float s = sc[r * D + k]; acc[r] = acc[r] + w * s; }
    }
#pragma unroll
    for (int r = 0; r < 17; ++r) { acc[r].x += __shfl_xor(acc[r].x, 32); acc[r].y += __shfl_xor(acc[r].y, 32); acc[r].z += __shfl_xor(acc[r].z, 32); acc[r].w += __shfl_xor(acc[r].w, 32); }
    __syncthreads();
    LAS f32x4* red = (LAS f32x4*)F.lds;
    if (F.lane < 32) {
#pragma unroll
        for (int r = 0; r < 17; ++r) red[(F.wave * 17 + r) * 32 + cq] = acc[r];
    }
    __syncthreads();
    for (int i = F.tid; i < 17 * 32; i += NTHREADS) { const int r = i >> 5, q = i & 31; f32x4 s = red[r * 32 + q];
#pragma unroll
        for (int w = 1; w < 8; ++w) s = s + red[(w * 17 + r) * 32 + q];
        const int col = cg * 128 + q * 4; s = s + ld4(a.in[5] + (size_t)layer * ADA + col);
        float* dst = r < 16 ? (float*)(F.ws + WS_MODX) + ((size_t)layer * 16 + r) * ADA + col : (float*)(F.ws + WS_MODC) + (size_t)layer * ADA + col;
        *(f32x4*)dst = s; }
    __syncthreads();
}

__device__ __forceinline__ void p0_convert(const Frame& F, const Args& a) {
    LAS unsigned* T = (LAS unsigned*)(F.lds + 70 * 1024) + F.wave * (64 * 33);
    const int gw = F.vcu * NWAVES + F.wave, NGW = F.G * NWAVES, lane = F.lane;
    bf16_t* win0 = (bf16_t*)(F.ws + WS_WIN0); bf16_t* wout0 = (bf16_t*)(F.ws + WS_WOUT0); bf16_t* wqkv1 = (bf16_t*)(F.ws + WS_WQKV1); bf16_t* wout1 = (bf16_t*)(F.ws + WS_WOUT1); bf16_t* wr = (bf16_t*)(F.ws + WS_WR);
    constexpr int I_IN = 16 * (4 + 4 + 8 + 8 + 1 + 16);
    constexpr int I_SQ = 16 * 16, I_QKV = 16 * 48, I_R = 16 * 4;
    constexpr int NIT = I_IN + I_SQ + I_QKV + I_SQ + 2 * I_R;
    for (int it = gw; it < NIT + MOE_CVT_ITEMS; it += NGW) {
        int r = it;
        if (r < I_IN) {
            const int kt = r & 15, g = r >> 4; int col0, nc = 64, drow;
            if (g < 24) { col0 = 64 * g; drow = 64 * g; }
            else if (g == 24) { col0 = 1536; nc = 32; drow = 2560; }
            else { const int s = g - 25; const int isb = s >> 3, q = s & 7;
                col0 = 1568 + 512 * isb + 64 * q; drow = 1536 + 256 * (q >> 1) + 128 * isb + 64 * (q & 1); }
            cvt_item(a.in[10], AB_IN, col0, nc, kt * 64, win0, D, drow, T, lane); continue; }
        r -= I_IN;
        if (r < I_SQ) { cvt_matrix_item(a.in[11], D, 0, D, D, wout0, 0, r, T, lane); continue; } r -= I_SQ;
        if (r < I_QKV) { cvt_matrix_item(a.in[21], 3 * D, 0, 3 * D, D, wqkv1, 0, r, T, lane); continue; } r -= I_QKV;
        if (r < I_SQ) { cvt_matrix_item(a.in[22], D, 0, D, D, wout1, 0, r, T, lane); continue; } r -= I_SQ;
        if (r < 2 * I_R) { const int l = r / I_R; cvt_matrix_item(a.in[24] + (size_t)l * D * NEXP, NEXP, 0, NEXP, D, wr + (size_t)l * NEXP * D, 0, r % I_R, T, lane); continue; } r -= 2 * I_R;
        cvt_moe_item(a, 0, r, F.ws, T, lane);
    }
    { u32x4 z = (u32x4){0u, 0u, 0u, 0u}; const size_t n16 = (size_t)(AB_INP - AB_IN) * D * 2 / 16; u32x4* p = (u32x4*)(win0 + (size_t)AB_IN * D);
      for (size_t i = (size_t)blockIdx.x * NTHREADS + F.tid; i < n16; i += (size_t)F.G * NTHREADS) p[i] = z; }
    if (blockIdx.x == 0) { f32x2* rt = (f32x2*)(F.ws + WS_ROPE);
        for (int i = F.tid; i < 64 * 16; i += NTHREADS) { const int pos = i >> 4, f = i & 15; const float inv = powf(10000.0f, -(float)f / 16.0f); const float ang = (float)pos * inv; rt[i] = (f32x2){cosf(ang), sinf(ang)}; } }
}


constexpr int GP = 144;
constexpr int GARR = 64 * GP;
constexpr int G_QE = 0, G_KE = GARR, G_QIN = 2 * GARR, G_KOT = 3 * GARR, G_VT = 4 * GARR, G_PAR = 5 * GARR;
constexpr int G_A = 2 * G_PAR, G_ST = G_A + GARR, G_DEC = G_ST + GARR, G_DW = G_DEC + 512, G_DB = G_DW + 4096, G_END = G_DB + 256;
static_assert(G_END <= RING_BYTES, "gla lds");
struct GlaRaw { u32x4 q, k, v; f32x4 lr[4]; };
__device__ __forceinline__ int gla_row(int n, int p, int b, int d) {
    const bool isctx = n < 4; const int j = isctx ? n : n - 4; int pos = j * 64 + p;
    if (d) pos = (isctx ? CTXL : SEQ) - 1 - pos;
    return isctx ? NX + b * CTXL + pos : b * SEQ + pos;
}
__device__ __forceinline__ void gla_load(GlaRaw& R, int n, int lane, int w, int b, int h, int d, int vh, const bf16_t* qb, const bf16_t* kb, const bf16_t* vb, const float* lr) {
    const int row = gla_row(n, lane, b, d);
    R.q = *(const u32x4*)(qb + (size_t)row * 256 + h * 64 + 8 * w);
    R.k = *(const u32x4*)(kb + (size_t)row * 256 + h * 64 + 8 * w);
    R.v = *(const u32x4*)(vb + (size_t)row * 512 + h * 128 + vh * 64 + 8 * w);
#pragma unroll
    for (int i = 0; i < 4; ++i) R.lr[i] = *(const f32x4*)(lr + (size_t)row * 32 + d * 16 + 4 * i);
}
__device__ __forceinline__ void unpack8(const u32x4& w, float (&f)[8]) { f[0] = bflo(w.x); f[1] = bfhi(w.x); f[2] = bflo(w.y); f[3] = bfhi(w.y); f[4] = bflo(w.z); f[5] = bfhi(w.z); f[6] = bflo(w.w); f[7] = bfhi(w.w); }
__device__ __forceinline__ void gla_phase(const Frame& F, const Args& a) {
    LAS unsigned char* L = F.lds; const int lane = F.lane, w = F.wave, r16 = lane & 15, g4 = lane >> 4;
    const bf16_t* qb = (const bf16_t*)(F.ws + T_QB); const bf16_t* kb = (const bf16_t*)(F.ws + T_KB); const bf16_t* vb = (const bf16_t*)(F.ws + T_VB); const float* lrb = (const float*)(F.ws + T_LR);
    for (int it = blockIdx.x; it < 256; it += F.G) {
        const int b = it >> 4, h = (it >> 2) & 3, d = (it >> 1) & 1, vh = it & 1;
        bf16_t* ob = (bf16_t*)(F.ws + (d ? T_OB : T_OF));
        const float* dw = d ? a.in[14] : a.in[12]; const float* db = d ? a.in[15] : a.in[13];
        __syncthreads();
        for (int i = F.tid; i < 16 * 64; i += NTHREADS) ((LAS float*)(L + G_DW))[i] = dw[(i >> 6) * GLA_QK + h * 64 + (i & 63)];
        if (F.tid < 64) ((LAS float*)(L + G_DB))[F.tid] = db[h * 64 + F.tid];
        for (int i = F.tid; i < GARR / 4; i += NTHREADS) ((LAS unsigned*)(L + G_ST))[i] = 0u;
        f32x4 Sacc[2] = {(f32x4){0.f, 0.f, 0.f, 0.f}, (f32x4){0.f, 0.f, 0.f, 0.f}};
        GlaRaw R; gla_load(R, 0, lane, w, b, h, d, vh, qb, kb, vb, lrb);
        __syncthreads();
        for (int n = 0; n < 36; ++n) {
            LAS unsigned char* PB = L + (n & 1) * G_PAR;
            {
                float z[8], q[8], k[8], v[8];
                unpack8(R.q, q); unpack8(R.k, k); unpack8(R.v, v);
                const LAS float* DW = (const LAS float*)(L + G_DW); const LAS float* DB = (const LAS float*)(L + G_DB);
#pragma unroll
                for (int j = 0; j < 8; ++j) z[j] = DB[8 * w + j];
#pragma unroll
                for (int r = 0; r < 16; ++r) { const float x = R.lr[r >> 2][r & 3]; const f32x4 w0 = *(const LAS f32x4*)(DW + r * 64 + 8 * w), w1 = *(const LAS f32x4*)(DW + r * 64 + 8 * w + 4);
                    z[0] += x * w0.x; z[1] += x * w0.y; z[2] += x * w0.z; z[3] += x * w0.w; z[4] += x * w1.x; z[5] += x * w1.y; z[6] += x * w1.z; z[7] += x * w1.w; }
                u32x4 wqe, wke, wqi; unsigned short ko[8];
                float qe[8], ke[8], qi[8];
#pragma unroll
                for (int j = 0; j < 8; ++j) {
                    float ld = (fminf(z[j], 0.f) - __logf(1.0f + __expf(-fabsf(z[j])))) * (1.0f / 16.0f);
#pragma unroll
                    for (int o = 1; o < 64; o <<= 1) { const float t = __shfl_up(ld, o); if (lane >= o) ld += t; }
                    const float bm = __shfl(ld, 31), bl = __shfl(ld, 63);
                    qe[j] = q[j] * __expf(ld - bm); ke[j] = k[j] * __expf(bm - ld); qi[j] = q[j] * __expf(ld); ko[j] = (unsigned short)f2bf(k[j] * __expf(bl - ld));
                    if (lane == 0) ((LAS float*)(L + G_DEC))[(n & 1) * 64 + 8 * w + j] = __expf(bl);
                }
                wqe = (u32x4){pk2(qe[0], qe[1]), pk2(qe[2], qe[3]), pk2(qe[4], qe[5]), pk2(qe[6], qe[7])};
                wke = (u32x4){pk2(ke[0], ke[1]), pk2(ke[2], ke[3]), pk2(ke[4], ke[5]), pk2(ke[6], ke[7])};
                wqi = (u32x4){pk2(qi[0], qi[1]), pk2(qi[2], qi[3]), pk2(qi[4], qi[5]), pk2(qi[6], qi[7])};
                *(LAS u32x4*)(PB + G_QE + lane * GP + 16 * w) = wqe; *(LAS u32x4*)(PB + G_KE + lane * GP + 16 * w) = wke; *(LAS u32x4*)(PB + G_QIN + lane * GP + 16 * w) = wqi;
#pragma unroll
                for (int j = 0; j < 8; ++j) { *(LAS unsigned short*)(PB + G_KOT + (8 * w + j) * GP + 2 * lane) = ko[j]; *(LAS unsigned short*)(PB + G_VT + (8 * w + j) * GP + 2 * lane) = (unsigned short)f2bf(v[j]); }
            }
            if (n + 1 < 36) gla_load(R, n + 1, lane, w, b, h, d, vh, qb, kb, vb, lrb);
            __syncthreads();
#pragma unroll
            for (int i = 0; i < 2; ++i) { const int tI = 2 * w + i, st = tI >> 2, pt = tI & 3;
                f32x4 c = (f32x4){0.f, 0.f, 0.f, 0.f};
                if (st <= pt) {
#pragma unroll
                    for (int ks = 0; ks < 2; ++ks) { const bf16x8 af = *(const LAS bf16x8*)(PB + G_KE + (16 * st + r16) * GP + (32 * ks + 8 * g4) * 2), bfr = *(const LAS bf16x8*)(PB + G_QE + (16 * pt + r16) * GP + (32 * ks + 8 * g4) * 2);
                        c = __builtin_amdgcn_mfma_f32_16x16x32_bf16(af, bfr, c, 0, 0, 0); }
                    const int p = 16 * pt + r16, s0 = 16 * st + 4 * g4;
#pragma unroll
                    for (int e = 0; e < 4; ++e) if (s0 + e > p) c[e] = 0.f;
                }
                u32x2 o; o.x = pk2(c[0], c[1]); o.y = pk2(c[2], c[3]);
                *(LAS u32x2*)(L + G_A + (16 * pt + r16) * GP + (16 * st + 4 * g4) * 2) = o; }
            __syncthreads();
#pragma unroll
            for (int i = 0; i < 2; ++i) { const int tI = 2 * w + i, vt = tI >> 2, pt = tI & 3;
                f32x4 c = (f32x4){0.f, 0.f, 0.f, 0.f};
#pragma unroll
                for (int ks = 0; ks < 2; ++ks) {
                    const bf16x8 a1 = *(const LAS bf16x8*)(PB + G_VT + (16 * vt + r16) * GP + (32 * ks + 8 * g4) * 2), b1 = *(const LAS bf16x8*)(L + G_A + (16 * pt + r16) * GP + (32 * ks + 8 * g4) * 2);
                    c = __builtin_amdgcn_mfma_f32_16x16x32_bf16(a1, b1, c, 0, 0, 0);
                    const bf16x8 a2 = *(const LAS bf16x8*)(L + G_ST + (16 * vt + r16) * GP + (32 * ks + 8 * g4) * 2), b2 = *(const LAS bf16x8*)(PB + G_QIN + (16 * pt + r16) * GP + (32 * ks + 8 * g4) * 2);
                    c = __builtin_amdgcn_mfma_f32_16x16x32_bf16(a2, b2, c, 0, 0, 0); }
                const int row = gla_row(n, 16 * pt + r16, b, d);
                u32x2 o; o.x = pk2(c[0], c[1]); o.y = pk2(c[2], c[3]);
                *(u32x2*)(ob + (size_t)row * 512 + h * 128 + vh * 64 + 16 * vt + 4 * g4) = o; }
            __syncthreads();
#pragma unroll
            for (int i = 0; i < 2; ++i) { const int tI = 2 * w + i, ct = tI >> 2, vt = tI & 3;
                const f32x4 dc = *(const LAS f32x4*)(L + G_DEC + ((n & 1) * 64 + 16 * ct + 4 * g4) * 4);
                f32x4 c = Sacc[i] * dc;
#pragma unroll
                for (int ks = 0; ks < 2; ++ks) { const bf16x8 af = *(const LAS bf16x8*)(PB + G_KOT + (16 * ct + r16) * GP + (32 * ks + 8 * g4) * 2), bfr = *(const LAS bf16x8*)(PB + G_VT + (16 * vt + r16) * GP + (32 * ks + 8 * g4) * 2);
                    c = __builtin_amdgcn_mfma_f32_16x16x32_bf16(af, bfr, c, 0, 0, 0); }
                Sacc[i] = c;
                u32x2 o; o.x = pk2(c[0], c[1]); o.y = pk2(c[2], c[3]);
                *(LAS u32x2*)(L + G_ST + (16 * vt + r16) * GP + (16 * ct + 4 * g4) * 2) = o; }
        }
    }
    __syncthreads();
}

__device__ __forceinline__ void finish_conv_phase(const Frame& F, const Args& a) {
    const int lane = F.lane; bf16_t* cat = (bf16_t*)(F.ws + T_CAT);
    {
        const bf16_t* of = (const bf16_t*)(F.ws + T_OF); const bf16_t* obk = (const bf16_t*)(F.ws + T_OB); const bf16_t* gb = (const bf16_t*)(F.ws + T_GB);
        const int gw = F.vcu * NWAVES + F.wave, NGW = F.G * NWAVES;
        float gg[8];
#pragma unroll
        for (int j = 0; j < 8; ++j) gg[j] = a.in[16][8 * lane + j];
        for (int row = gw; row < NT; row += NGW) {
            float x[8], y[8], g[8];
            unpack8(*(const u32x4*)(of + (size_t)row * 512 + 8 * lane), x); unpack8(*(const u32x4*)(obk + (size_t)row * 512 + 8 * lane), y); unpack8(*(const u32x4*)(gb + (size_t)row * 512 + 8 * lane), g);
            float ss = 0.f;
#pragma unroll
            for (int j = 0; j < 8; ++j) { x[j] += y[j]; ss += x[j] * x[j]; }
            ss += __shfl_xor(ss, 1); ss += __shfl_xor(ss, 2); ss += __shfl_xor(ss, 4); ss += __shfl_xor(ss, 8);
            const float rs = rsqrtf(ss * (1.0f / 128.0f) + RMS_EPS);
#pragma unroll
            for (int j = 0; j < 8; ++j) x[j] = x[j] * rs * gg[j] * siluf_(g[j]);
            *(u32x4*)(cat + (size_t)row * D + 8 * lane) = (u32x4){pk2(x[0], x[1]), pk2(x[2], x[3]), pk2(x[4], x[5]), pk2(x[6], x[7])};
        }
    }
    {
        const bf16_t* ub = (const bf16_t*)(F.ws + T_UB); LAS float* tile = (LAS float*)F.lds;
        const int c = F.tid;
        float wv[CONV_W];
#pragma unroll
        for (int j = 0; j < CONV_W; ++j) wv[j] = a.in[17][j * CONV_CH + c];
        const float cb = a.in[18][c];
        float lg[8], lb[8];
#pragma unroll
        for (int i = 0; i < 8; ++i) { lg[i] = a.in[19][lane + 64 * i]; lb[i] = a.in[20][lane + 64 * i]; }
        for (int ti = blockIdx.x; ti < NT / 32; ti += F.G) {
            const int row0 = ti * 32; const bool lat = row0 < NX;
            const int t0 = lat ? (row0 & (SEQ - 1)) : ((row0 - NX) & (CTXL - 1)); const int len = lat ? SEQ : CTXL; const int sbase = row0 - t0;
            float in[62];
#pragma unroll
            for (int i = 0; i < 62; ++i) { const int t = t0 - 15 + i; in[i] = (t >= 0 && t < len) ? bf2f(ub[(size_t)(sbase + t) * 512 + c]) : 0.f; }
            __syncthreads();
#pragma unroll
            for (int t = 0; t < 32; ++t) { float s = cb;
#pragma unroll
                for (int j = 0; j < CONV_W; ++j) s += wv[j] * in[t + j];
                tile[t * 512 + c] = s; }
            __syncthreads();
#pragma unroll
            for (int q = 0; q < 4; ++q) { const int t = 4 * F.wave + q; float v[8]; float s = 0.f;
#pragma unroll
                for (int i = 0; i < 8; ++i) { v[i] = tile[t * 512 + lane + 64 * i]; s += v[i]; }
                const float mu = wave_sum(s) * (1.0f / 512.0f); float qq = 0.f;
#pragma unroll
                for (int i = 0; i < 8; ++i) { v[i] -= mu; qq += v[i] * v[i]; }
                const float rstd = rsqrtf(wave_sum(qq) * (1.0f / 512.0f) + LN_EPS);
#pragma unroll
                for (int i = 0; i < 8; ++i) { const float y = v[i] * rstd * lg[i] + lb[i]; cat[(size_t)(row0 + t) * D + 512 + lane + 64 * i] = (bf16_t)f2bf(siluf_(y)); } }
        }
        __syncthreads();
    }
}


constexpr int CW_TST = 20480;
constexpr int AUX_TST = AUX_OFF, AUX_TILEE = AUX_OFF + 1040, AUX_IDX = AUX_OFF + 1104;
static_assert(AUX_IDX + 16 * 1024 <= MISC_OFF, "aux lds");

struct EpiRouter {
    static constexpr bool PERM = false, AFTER_DRAIN = true;
    const float* rbias; int* asg_e; int* asg_r; float* asg_g; unsigned* counts;
    __device__ __forceinline__ void operator()(const f32x4 (&)[2][2][4][2], const Unit&, int, int, int, int) const {}
    __device__ __forceinline__ void fused(const f32x4 (&acc)[2][2][4][2], const Unit& u, int wr, int wc, int fr, int fq, LAS unsigned char* lds, int wid, int lane) const {
        LAS float* SC = (LAS float*)lds;
        LAS unsigned* lcnt = (LAS unsigned*)(lds + 66560); LAS unsigned* lbase = lcnt + 256;
        LAS int* selE = (LAS int*)(lbase + 256); LAS int* selR = selE + 2048;
        const int tid = wid * 64 + lane;
        if (tid < 256) lcnt[tid] = 0u;
        const f32x4 rb = *(const f32x4*)(rbias + 4 * lane);
        const float NINF = -__builtin_inff();
#pragma unroll
        for (int ai = 0; ai < 2; ++ai)
#pragma unroll
            for (int mm = 0; mm < 2; ++mm) {
                LDS_WAIT(); __builtin_amdgcn_s_barrier(); asm volatile("" ::: "memory");
#pragma unroll
                for (int mi = 0; mi < 2; ++mi) { const int lr = 32 * wr + 16 * mi + fr;
#pragma unroll
                    for (int bj = 0; bj < 2; ++bj)
#pragma unroll
                        for (int n = 0; n < 2; ++n) *(LAS f32x4*)(SC + lr * 260 + 128 * bj + 32 * wc + 16 * n + 4 * fq) = acc[ai][bj][2 * mm + mi][n]; }
                LDS_WAIT(); __builtin_amdgcn_s_barrier(); asm volatile("" ::: "memory");
                for (int q = 0; q < 8; ++q) {
                    const int lr = 8 * wid + q; const int rit = 128 * ai + 64 * (lr >> 5) + 16 * (2 * mm + ((lr >> 4) & 1)) + (lr & 15);
                    const f32x4 lg = *(const LAS f32x4*)(SC + lr * 260 + 4 * lane);
                    float s[4], cd[4];
#pragma unroll
                    for (int j = 0; j < 4; ++j) { s[j] = 1.0f / (1.0f + __expf(-lg[j])); cd[j] = s[j] + rb[j]; }
                    float m1 = fmaxf(cd[0], cd[1]), m2 = fminf(cd[0], cd[1]);
                    { const float x = cd[2]; const float n1 = fmaxf(m1, x); m2 = fmaxf(fminf(m1, x), m2); m1 = n1; }
                    { const float x = cd[3]; const float n1 = fmaxf(m1, x); m2 = fmaxf(fminf(m1, x), m2); m1 = n1; }
#pragma unroll
                    for (int o = 1; o < 8; o <<= 1) { const float a1 = __shfl_xor(m1, o), a2 = __shfl_xor(m2, o); const float n1 = fmaxf(m1, a1); m2 = fmaxf(fminf(m1, a1), fmaxf(m2, a2)); m1 = n1; }
                    const float gs = m1 + m2; const int mygrp = lane >> 3; int rank = 0;
#pragma unroll
                    for (int g = 0; g < 8; ++g) { const float og = __shfl(gs, 8 * g); rank += (og > gs || (og == gs && g < mygrp)) ? 1 : 0; }
                    if (rank >= 4) { cd[0] = NINF; cd[1] = NINF; cd[2] = NINF; cd[3] = NINF; }
                    int myE = 0; float myG = 0.f; float gsum = 0.f;
#pragma unroll
                    for (int k = 0; k < TOPK; ++k) {
                        float bv = cd[0]; int bi = 0;
                        if (cd[1] > bv) { bv = cd[1]; bi = 1; } if (cd[2] > bv) { bv = cd[2]; bi = 2; } if (cd[3] > bv) { bv = cd[3]; bi = 3; }
                        float v = bv; int ix = 4 * lane + bi;
#pragma unroll
                        for (int o = 32; o >= 1; o >>= 1) { const float ov = __shfl_xor(v, o); const int oi = __shfl_xor(ix, o); if (ov > v || (ov == v && oi < ix)) { v = ov; ix = oi; } }
                        const int sl = ix & 3; const float mys = sl == 0 ? s[0] : (sl == 1 ? s[1] : (sl == 2 ? s[2] : s[3]));
                        const float gv = __shfl(mys, ix >> 2);
                        gsum += gv;
                        if (lane == k) { myE = ix; myG = gv; }
                        if (lane == (ix >> 2)) { if (sl == 0) cd[0] = NINF; else if (sl == 1) cd[1] = NINF; else if (sl == 2) cd[2] = NINF; else cd[3] = NINF; }
                    }
                    if (lane < TOPK) { const unsigned r = __hip_atomic_fetch_add(&lcnt[myE], 1u, __ATOMIC_RELAXED, __HIP_MEMORY_SCOPE_WORKGROUP); selE[rit * 8 + lane] = myE; selR[rit * 8 + lane] = (int)r; asg_g[(size_t)(u.orow + rit) * 8 + lane] = myG / gsum * 2.5f; }
                }
            }
        LDS_WAIT(); __builtin_amdgcn_s_barrier(); asm volatile("" ::: "memory");
        if (tid < 256) { const unsigned c = lcnt[tid]; lbase[tid] = c ? atomicAdd(&counts[tid], c) : 0u; }
        LDS_WAIT(); __builtin_amdgcn_s_barrier(); asm volatile("" ::: "memory");
        for (int i = tid; i < 2048; i += NTHREADS) { const int e = selE[i]; asg_e[(size_t)u.orow * 8 + i] = e; asg_r[(size_t)u.orow * 8 + i] = (int)lbase[e] + selR[i]; }
    }
};

__device__ __forceinline__ void moe_place(const Frame& F, int layer, int ntok) {
    LAS int* cnt = (LAS int*)F.lds; LAS int* tst = cnt + 256;
    const unsigned* counts = F.ctl + CW_CNT + layer * 256;
    const int* asg_e = (const int*)(F.ws + M_AE); const int* asg_r = (const int*)(F.ws + M_AR); int* tslot = (int*)(F.ws + M_TS); int* stok = (int*)(F.ws + M_ST);
    __syncthreads();
    if (F.tid < 256) cnt[F.tid] = (int)counts[F.tid];
    __syncthreads();
    if (F.tid == 0) { int acc = 0; for (int e = 0; e < 256; ++e) { tst[e] = acc; acc += (cnt[e] + 255) >> 8; } tst[256] = acc; }
    __syncthreads();
    const int ntr = tst[256];
    if (blockIdx.x == 0) for (int i = F.tid; i < 257; i += NTHREADS) F.ctl[CW_TST + layer * 320 + i] = (unsigned)tst[i];
    const int gt = blockIdx.x * NTHREADS + F.tid, gs = F.G * NTHREADS;
    for (int i = gt; i < ntok * 8; i += gs) { const int e = asg_e[i]; const int slot = tst[e] * 256 + asg_r[i]; stok[slot] = i >> 3; tslot[i] = slot; }
    for (int e = blockIdx.x; e < 256; e += F.G) { const int s0 = tst[e] * 256 + cnt[e], s1 = tst[e + 1] * 256; for (int s = s0 + F.tid; s < s1; s += NTHREADS) stok[s] = 0; }
    for (int i = gt; i < ntok; i += gs) stok[ntr * 256 + i] = i;
    __syncthreads();
}

__device__ __forceinline__ int moe_tiles_setup(const Frame& F, int layer, int ntok, int c, bool want_idx) {
    LAS int* tst = (LAS int*)(F.lds + AUX_TST); LAS int* tileE = (LAS int*)(F.lds + AUX_TILEE); LAS int* idxl = (LAS int*)(F.lds + AUX_IDX);
    __syncthreads();
    for (int i = F.tid; i < 257; i += NTHREADS) tst[i] = (int)F.ctl[CW_TST + layer * 320 + i];
    __syncthreads();
    const int ntr = tst[256], ntiles = ntr + ntok / 256;
    int nj = c < ntiles ? (ntiles - c + F.G - 1) / F.G : 0; if (nj > 16) nj = 16;
    if (F.tid < nj) { const int rt = c + F.tid * F.G; int e;
        if (rt >= ntr) e = NEXP; else { int lo = 0, hi = 255; while (lo < hi) { const int mid = (lo + hi + 1) >> 1; if (tst[mid] <= rt) lo = mid; else hi = mid - 1; } e = lo; }
        tileE[F.tid] = e; }
    if (want_idx) { const int* stok = (const int*)(F.ws + M_ST); for (int i = F.tid; i < nj * 256; i += NTHREADS) idxl[i] = stok[(size_t)(c + (i >> 8) * F.G) * 256 + (i & 255)]; }
    __syncthreads();
    return nj;
}
struct SchedMoeGU {
    const char* A; const char* W; const LAS int* tileE; const LAS int* idxl; int nj, G, c;
    __device__ __forceinline__ bool next(int i, Unit& u) const {
        const int j = i >> 1; if (j >= nj) return false; const int col = i & 1; const int e = tileE[j]; const int rt = c + j * G;
        u.a = j; u.b = e * 512 + col * 256; u.orow = rt * 256; u.ocol = col * 128; u.aux = e; return true; }
    __device__ __forceinline__ const char* a_base() const { return A; }
    __device__ __forceinline__ const char* b_ptr(const Unit& u) const { return W + (size_t)u.b * D * 2; }
    __device__ __forceinline__ void a_off(const Unit& u, const int (&R)[2], const int (&C)[2], unsigned (&o0)[2], unsigned (&o1)[2]) const {
#pragma unroll
        for (int i = 0; i < 2; ++i) { const int t0 = idxl[u.a * 256 + R[i]], t1 = idxl[u.a * 256 + 128 + R[i]]; o0[i] = (unsigned)t0 * (unsigned)(D * 2) + (unsigned)C[i] * 2u; o1[i] = (unsigned)t1 * (unsigned)(D * 2) + (unsigned)C[i] * 2u; }
    }
};
struct EpiGateUp {
    static constexpr bool PERM = true, AFTER_DRAIN = false;
    bf16_t* hid;
    __device__ __forceinline__ void operator()(const f32x4 (&acc)[2][2][4][2], const Unit& u, int wr, int wc, int fr, int fq) const {
        const int row0 = u.orow + wr * 64 + fr, col0 = u.ocol + wc * 32 + 8 * fq;
#pragma unroll
        for (int ai = 0; ai < 2; ++ai)
#pragma unroll
            for (int m = 0; m < 4; ++m) { float h[8];
#pragma unroll
                for (int n = 0; n < 2; ++n)
#pragma unroll
                    for (int e = 0; e < 4; ++e) { const float g = acc[ai][0][m][n][e], up = acc[ai][1][m][n][e]; h[4 * n + e] = g / (1.0f + __expf(-g)) * up; }
                u32x4 w; w.x = cvt_pk_bf16(h[0], h[1]); w.y = cvt_pk_bf16(h[2], h[3]); w.z = cvt_pk_bf16(h[4], h[5]); w.w = cvt_pk_bf16(h[6], h[7]);
                *(u32x4*)(hid + (size_t)(row0 + ai * 128 + m * 16) * DEXP + col0) = w; }
    }
};
struct SchedMoeDN {
    const char* A; const char* W; const LAS int* tileE; int nj, G, c;
    __device__ __forceinline__ bool next(int i, Unit& u) const {
        const int j = i >> 2; if (j >= nj) return false; const int col = i & 3; const int e = tileE[j]; const int rt = c + j * G;
        u.a = rt; u.b = e * 1024 + col * 256; u.orow = rt * 256; u.ocol = col * 256; u.aux = e; return true; }
    __device__ __forceinline__ const char* a_base() const { return A; }
    __device__ __forceinline__ const char* b_ptr(const Unit& u) const { return W + (size_t)u.b * DEXP * 2; }
    __device__ __forceinline__ void a_off(const Unit& u, const int (&R)[2], const int (&C)[2], unsigned (&o0)[2], unsigned (&o1)[2]) const {
#pragma unroll
        for (int i = 0; i < 2; ++i) { o0[i] = (unsigned)((u.a * 256 + R[i]) * DEXP + C[i]) * 2u; o1[i] = o0[i] + (unsigned)(128 * DEXP * 2); }
    }
};


constexpr int NA_VP = 160, NA_VL = 0, NA_VC = 576 * NA_VP, NA_RPB = NA_VC + 256 * NA_VP, NA_END = NA_RPB + 1888;
static_assert(NA_END <= MISC_OFF, "na lds");
typedef short s16x4 __attribute__((ext_vector_type(4)));
__device__ __forceinline__ void na_phase(const Frame& F, const Args& a) {
    LAS unsigned char* L = F.lds; const int lane = F.lane, w = F.wave, r16 = lane & 15, g4 = lane >> 4;
    const bf16_t* qbuf = (const bf16_t*)(F.ws + T_QKV); const bf16_t* kbuf = qbuf + (size_t)NT * D; const bf16_t* vbuf = kbuf + (size_t)NT * D; bf16_t* cat = (bf16_t*)(F.ws + T_CAT);
    const int rr = w >> 2, cb = w & 3; const int band = cb == 0 ? 0 : (cb == 1 ? 8 : (cb == 2 ? 24 : 32));
    const float NINF = -__builtin_inff();
    for (int bh = blockIdx.x; bh < BATCH * NA_H; bh += F.G) {
        const int b = bh >> 4, h = bh & 15;
        __syncthreads();
        for (int i = F.tid; i < 465; i += NTHREADS) ((LAS float*)(L + NA_RPB))[i] = a.in[23][h * 465 + i];
        for (int i = F.tid; i < 256 * 8; i += NTHREADS) { const int key = i >> 3, ch = i & 7; *(LAS u32x4*)(L + NA_VC + key * NA_VP + ch * 16) = *(const u32x4*)(vbuf + (size_t)(NX + b * CTXL + key) * D + h * 64 + ch * 8); }
        for (int rp = 0; rp < 16; ++rp) {
            int R0 = 2 * rp - 4; R0 = R0 < 0 ? 0 : (R0 > 24 ? 24 : R0);
            __syncthreads();
            for (int i = F.tid; i < 576 * 8; i += NTHREADS) { const int key = i >> 3, ch = i & 7; const int gr = R0 + (key >> 6);
                if (gr < 32) *(LAS u32x4*)(L + NA_VL + key * NA_VP + ch * 16) = *(const u32x4*)(vbuf + (size_t)(b * SEQ + gr * 64 + (key & 63)) * D + h * 64 + ch * 8); }
            const int r = 2 * rp + rr; int r0 = r - 4; r0 = r0 < 0 ? 0 : (r0 > 24 ? 24 : r0);
            const int qrow = b * SEQ + r * 64 + 16 * cb + r16;
            bf16x8 qf[2];
#pragma unroll
            for (int ks = 0; ks < 2; ++ks) qf[ks] = *(const bf16x8*)(qbuf + (size_t)qrow * D + h * 64 + 32 * ks + 8 * g4);
            __syncthreads();
            const int qc = 16 * cb + r16; int cs = qc - 8; cs = cs < 0 ? 0 : (cs > 48 ? 48 : cs);
            f32x4 O[4]; float m_run = NINF, sum = 0.f;
#pragma unroll
            for (int mt = 0; mt < 4; ++mt) O[mt] = (f32x4){0.f, 0.f, 0.f, 0.f};
#pragma nounroll
            for (int half = 0; half < 2; ++half) {
                const bf16_t* kb0 = half == 0 ? kbuf + (size_t)(b * SEQ + r0 * 64 + band + r16) * D + h * 64 + 8 * g4 : kbuf + (size_t)(NX + b * CTXL + r16) * D + h * 64 + 8 * g4;
                float S[16][4];
                bf16x8 kf[2][4][2];
#pragma unroll
                for (int i = 0; i < 4; ++i) { const size_t o = half == 0 ? (size_t)((i >> 1) * 64 + 16 * (i & 1)) * D : (size_t)(16 * i) * D; kf[0][i][0] = *(const bf16x8*)(kb0 + o); kf[0][i][1] = *(const bf16x8*)(kb0 + o + 32); }
                float mx = NINF;
#pragma unroll
                for (int g = 0; g < 4; ++g) {
                    if (g < 3) {
#pragma unroll
                        for (int i = 0; i < 4; ++i) { const int t = 4 * (g + 1) + i; const size_t o = half == 0 ? (size_t)((t >> 1) * 64 + 16 * (t & 1)) * D : (size_t)(16 * t) * D;
                            kf[(g + 1) & 1][i][0] = *(const bf16x8*)(kb0 + o); kf[(g + 1) & 1][i][1] = *(const bf16x8*)(kb0 + o + 32); }
                    }
#pragma unroll
                    for (int i = 0; i < 4; ++i) { const int t = 4 * g + i;
                        f32x4 c = (f32x4){0.f, 0.f, 0.f, 0.f};
                        c = __builtin_amdgcn_mfma_f32_16x16x32_bf16(kf[g & 1][i][0], qf[0], c, 0, 0, 0); c = __builtin_amdgcn_mfma_f32_16x16x32_bf16(kf[g & 1][i][1], qf[1], c, 0, 0, 0);
                        if (half == 0) { const int ridx = r0 + (t >> 1) - r + 7;
#pragma unroll
                            for (int e = 0; e < 4; ++e) { const int kc = band + 16 * (t & 1) + 4 * g4 + e; const bool ok = kc >= cs && kc < cs + 16; int ci = kc - qc + 15; ci = ci < 0 ? 0 : (ci > 30 ? 30 : ci);
                                S[t][e] = ok ? c[e] * 0.125f + ((const LAS float*)(L + NA_RPB))[ridx * 31 + ci] : NINF; }
                        } else {
#pragma unroll
                            for (int e = 0; e < 4; ++e) S[t][e] = c[e] * 0.125f;
                        }
#pragma unroll
                        for (int e = 0; e < 4; ++e) mx = fmaxf(mx, S[t][e]);
                    }
                    __builtin_amdgcn_sched_barrier(0);
                }
                mx = fmaxf(mx, __shfl_xor(mx, 16)); mx = fmaxf(mx, __shfl_xor(mx, 32));
                const float m_new = fmaxf(m_run, mx); const float alpha = __expf(m_run - m_new); m_run = m_new;
                float ps = 0.f;
#pragma unroll
                for (int t = 0; t < 16; ++t)
#pragma unroll
                    for (int e = 0; e < 4; ++e) { const float p = __expf(S[t][e] - m_new); S[t][e] = p; ps += p; }
                ps += __shfl_xor(ps, 16); ps += __shfl_xor(ps, 32);
                sum = sum * alpha + ps;
#pragma unroll
                for (int mt = 0; mt < 4; ++mt) O[mt] = O[mt] * alpha;
                const int base0h = half == 0 ? NA_VL + ((r0 - R0) * 64 + band) * NA_VP : NA_VC; const int jstep = half == 0 ? 64 * NA_VP : 32 * NA_VP;
                const int lo = (4 * g4 + (r16 >> 2)) * NA_VP + 8 * (r16 & 3);
#pragma unroll
                for (int j = 0; j < 8; ++j) {
                    bf16x8 pb; { const u32x4 ww = (u32x4){pk2(S[2 * j][0], S[2 * j][1]), pk2(S[2 * j][2], S[2 * j][3]), pk2(S[2 * j + 1][0], S[2 * j + 1][1]), pk2(S[2 * j + 1][2], S[2 * j + 1][3])}; pb = __builtin_bit_cast(bf16x8, ww); }
                    const int base0 = base0h + j * jstep, base1 = base0 + 16 * NA_VP;
#pragma unroll
                    for (int mt = 0; mt < 4; ++mt) {
                        const s16x4 a0 = __builtin_amdgcn_ds_read_tr16_b64_v4i16((LAS s16x4*)(L + base0 + lo + 32 * mt));
                        const s16x4 a1 = __builtin_amdgcn_ds_read_tr16_b64_v4i16((LAS s16x4*)(L + base1 + lo + 32 * mt));
                        const bf16x8 av = (bf16x8){a0[0], a0[1], a0[2], a0[3], a1[0], a1[1], a1[2], a1[3]};
                        O[mt] = __builtin_amdgcn_mfma_f32_16x16x32_bf16(av, pb, O[mt], 0, 0, 0);
                    }
                }
            }
            const float inv = 1.0f / sum;
#pragma unroll
            for (int mt = 0; mt < 4; ++mt) { u32x2 o; o.x = pk2(O[mt][0] * inv, O[mt][1] * inv); o.y = pk2(O[mt][2] * inv, O[mt][3] * inv);
                *(u32x2*)(cat + (size_t)qrow * D + h * 64 + 16 * mt + 4 * g4) = o; }
        }
    }
    __syncthreads();
}

#if MK_ONE_LAUNCH
#define GRID_BAR() xcd_barrier(bar)
#else
#define GRID_BAR() do { } while (0)
#endif
#define IN(k) (lo <= (k) && (k) < hi && (k) <= MK_LAST_PHASE)
#define SEAM(k) do { if (IN(k) && IN((k) + 1)) GRID_BAR(); } while (0)
template <int LAYER>
__device__ __forceinline__ void layer_tail(const Frame& F, const Args& args, const int lo, const int hi, const XcdBarrier& bar) {
    unsigned char* ws = args.ws;
    const float* modx = (const float*)(ws + WS_MODX); const float* modc = (const float*)(ws + WS_MODC);
    float* xw = (float*)(ws + WS_XW); bf16_t* Hb = (bf16_t*)(ws + WS_H);
    constexpr int mb = LAYER ? 16 : 7; constexpr int ntok = LAYER ? NX : NT;
    const float* lmodx = modx + (size_t)LAYER * 16 * ADA; const float* lmodc = modc + (size_t)LAYER * ADA;
    if (IN(LAYER ? 14 : 5)) {
        SchedDense S{(const char*)(ws + T_CAT), (const char*)(ws + (LAYER ? WS_WOUT1 : WS_WOUT0)), D, ntok / 256, D / 256, 0, 1, 0, F.G, (int)blockIdx.x};
        EpiBf16 E{(bf16_t*)(ws + T_Y), D, 0, 0};
        pg8::gemm_phase<EpiBf16, SchedDense, true>(F.lds, D, S, E);
    }
    SEAM(LAYER ? 14 : 5);
    if (IN(LAYER ? 15 : 6)) {
        RowPhase P{}; P.xin_lat = LAYER ? xw : args.in[0]; P.xin_ctx = LAYER ? xw + (size_t)NX * D : args.in[2]; P.xout_lat = xw; P.xout_ctx = xw + (size_t)NX * D; P.nrows = ntok; P.ysrc = 1; P.y = (const bf16_t*)(ws + T_Y);
        P.gpost = args.in[7] + LAYER * D; P.modx = lmodx; P.modc = lmodc; P.gate_chunk = 2;
        P.doH = true; P.H = Hb; P.gpre = args.in[8] + LAYER * D; P.sc_chunk = 4; P.sh_chunk = 3; P.modxH = lmodx; P.modcH = lmodc;
        row_phase(F, P);
    }
    SEAM(LAYER ? 15 : 6);
    if (IN(mb)) {
        SchedDense S{(const char*)Hb, (const char*)(ws + WS_WR) + (size_t)LAYER * NEXP * D * 2, D, ntok / 256, 1, 0, 1, 0, F.G, (int)blockIdx.x};
        EpiRouter E{args.in[25] + LAYER * NEXP, (int*)(ws + M_AE), (int*)(ws + M_AR), (float*)(ws + M_AG), F.ctl + CW_CNT + LAYER * 256};
        pg8::gemm_phase<EpiRouter, SchedDense, false>(F.lds, D, S, E);
    }
    SEAM(mb);
    if (IN(mb + 1)) moe_place(F, LAYER, ntok);
    SEAM(mb + 1);
    if (IN(mb + 2)) {
        const int nj = moe_tiles_setup(F, LAYER, ntok, F.vcu, true);
        SchedMoeGU S{(const char*)Hb, (const char*)(ws + WS_WGU), (const LAS int*)(F.lds + AUX_TILEE), (const LAS int*)(F.lds + AUX_IDX), nj, F.G, F.vcu};
        EpiGateUp E{(bf16_t*)(ws + M_HID)};
        pg8::gemm_phase<EpiGateUp, SchedMoeGU, true>(F.lds, D, S, E);
    }
    SEAM(mb + 2);
    if (IN(mb + 3)) {
        const int nj = moe_tiles_setup(F, LAYER, ntok, F.vcu, false);
        SchedMoeDN S{(const char*)(ws + M_HID), (const char*)(ws + WS_WDN), (const LAS int*)(F.lds + AUX_TILEE), nj, F.G, F.vcu};
        EpiBf16 E{(bf16_t*)(ws + M_OUT), D, 0, 0};
        pg8::gemm_phase<EpiBf16, SchedMoeDN, true>(F.lds, DEXP, S, E);
    }
    SEAM(mb + 3);
    if (IN(mb + 4)) {
        RowPhase P{}; P.xin_lat = xw; P.xin_ctx = xw + (size_t)NX * D; P.xout_lat = LAYER ? args.out : xw; P.xout_ctx = xw + (size_t)NX * D; P.nrows = ntok; P.ysrc = 2;
        P.mo = (const bf16_t*)(ws + M_OUT); P.tslot = (const int*)(ws + M_TS); P.tgate = (const float*)(ws + M_AG); P.sharedbase = (int)F.ctl[CW_TST + LAYER * 320 + 256] * 256;
        P.gpost = args.in[9] + LAYER * D; P.modx = lmodx; P.modc = lmodc; P.gate_chunk = 5;
        P.doH = LAYER == 0; P.H = Hb; P.gpre = args.in[6] + D; P.sc_chunk = 1; P.sh_chunk = 0; P.modxH = modx + (size_t)16 * ADA; P.modcH = modc + ADA;
        row_phase(F, P);
        if (LAYER == 0) {
            LAS unsigned* T = (LAS unsigned*)F.lds + F.wave * (64 * 33);
            const int gw = F.vcu * NWAVES + F.wave, NGW = F.G * NWAVES;
            for (int it = gw; it < MOE_CVT_ITEMS; it += NGW) cvt_moe_item(args, 1, it, F.ws, T, F.lane);
        }
    }
    SEAM(mb + 4);
}

__global__ void __launch_bounds__(NTHREADS, 2) mk_fwd(Args args) {
    extern __shared__ __attribute__((aligned(16))) unsigned char lds_raw[];
    Frame F;
    F.lds = (LAS unsigned char*)lds_raw; F.MISC = (volatile LAS unsigned*)(F.lds + MISC_OFF);
    F.tid = threadIdx.x; F.lane = F.tid & 63; F.wave = __builtin_amdgcn_readfirstlane(F.tid >> 6);
    F.G = gridDim.x; { const int bx = blockIdx.x; F.vcu = (F.G % 8 == 0) ? (bx % 8) * (F.G / 8) + bx / 8 : bx; }
    F.ws = args.ws; F.ctl = (unsigned*)(args.ws + WS_CTL);
    for (int u = F.tid; u < (LDS_BYTES - MISC_OFF) / 4; u += NTHREADS) ((LAS unsigned*)(F.lds + MISC_OFF))[u] = 0u;
    __syncthreads();
    XcdBarrier bar; bar.bar = F.ctl + CW_BAR; bar.x = 0; bar.st = nullptr;
#if MK_ONE_LAUNCH
    bar = xcd_barrier_post(F.ctl + CW_BAR, F.MISC + 8);
#endif
    const int lo = args.ph_lo, hi = args.ph_hi;
    unsigned char* ws = args.ws;
    const float* modx = (const float*)(ws + WS_MODX); const float* modc = (const float*)(ws + WS_MODC);
    float* xw = (float*)(ws + WS_XW); bf16_t* Hb = (bf16_t*)(ws + WS_H);

    if (IN(0)) { p0_ada(F, args); p0_convert(F, args); }
    SEAM(0);
    {
        if (IN(1)) {
            RowPhase P{}; P.xin_lat = args.in[0]; P.xin_ctx = args.in[2]; P.nrows = NT; P.ysrc = 0; P.modx = modx; P.modc = modc;
            P.doH = true; P.H = Hb; P.gpre = args.in[6]; P.sc_chunk = 1; P.sh_chunk = 0; P.modxH = modx; P.modcH = modc;
            row_phase(F, P);
        }
        SEAM(1);
        if (IN(2)) {
            SchedDense S{(const char*)Hb, (const char*)(ws + WS_WIN0), D, NT / 256, AB_INP / 256, 0, 1, 0, F.G, (int)blockIdx.x};
            EpiInproj E{(bf16_t*)(ws + T_QB), (bf16_t*)(ws + T_KB), (bf16_t*)(ws + T_VB), (bf16_t*)(ws + T_GB), (bf16_t*)(ws + T_UB), (float*)(ws + T_LR), (const f32x2*)(ws + WS_ROPE)};
            pg8::gemm_phase<EpiInproj, SchedDense, true>(F.lds, D, S, E);
        }
        SEAM(2);
        if (IN(3)) gla_phase(F, args);
        SEAM(3);
        if (IN(4)) finish_conv_phase(F, args);
        SEAM(4);

    }
    layer_tail<0>(F, args, lo, hi, bar);
    {
        if (IN(12)) {
            SchedDense S{(const char*)Hb, (const char*)(ws + WS_WQKV1), D, NX / 256, 12, NC / 256, 8, 4, F.G, (int)blockIdx.x};
            EpiBf16 E{(bf16_t*)(ws + T_QKV), D, D, (size_t)NT * D};
            pg8::gemm_phase<EpiBf16, SchedDense, true>(F.lds, D, S, E);
        }
        SEAM(12);
        if (IN(13)) na_phase(F, args);
        SEAM(13);

    }
    layer_tail<1>(F, args, lo, hi, bar);
#undef IN
#undef SEAM
}

extern "C" void kernel_launch(void* const* d_in, const int* in_sizes, int n_in, void* d_out, int out_size, void* d_ws, size_t ws_size, hipStream_t stream) {
    static int grid = 0;
    if (grid == 0) {
        if (n_in != 32 || out_size != NX * D || ws_size < WS_END) { fprintf(stderr, "kernel_launch: unexpected problem (n_in %d, out %d, ws %zu < %zu)\n", n_in, out_size, ws_size, (size_t)WS_END); grid = -1; return; }
        int dev = 0, cus = 0, per_cu = 0;
        if (hipGetDevice(&dev) != hipSuccess || hipDeviceGetAttribute(&cus, hipDeviceAttributeMultiprocessorCount, dev) != hipSuccess) { grid = -1; return; }
        if (hipFuncSetAttribute((const void*)mk_fwd, hipFuncAttributeMaxDynamicSharedMemorySize, LDS_BYTES) != hipSuccess) { fprintf(stderr, "kernel_launch: hipFuncSetAttribute failed\n"); grid = -1; return; }
        if (hipOccupancyMaxActiveBlocksPerMultiprocessor(&per_cu, (const void*)mk_fwd, NTHREADS, LDS_BYTES) != hipSuccess || per_cu < 1) fprintf(stderr, "kernel_launch: occupancy query says %d\n", per_cu);
        (void)hipGetLastError();
        grid = cus;
    }
    if (grid < 0) return;
    (void)hipMemsetAsync((char*)d_ws + WS_CTL, 0, CTL_BYTES, stream);
    Args a{};
    for (int i = 0; i < 32; ++i) a.in[i] = (const float*)d_in[i];
    a.out = (float*)d_out; a.ws = (unsigned char*)d_ws;
#if MK_ONE_LAUNCH
    a.ph_lo = 0; a.ph_hi = 64;
    hipLaunchKernelGGL(mk_fwd, dim3(grid), dim3(NTHREADS), LDS_BYTES, stream, a);
#else
    for (int p = 0; p <= 20; ++p) { if (p > MK_LAST_PHASE) break; a.ph_lo = p; a.ph_hi = p + 1; hipLaunchKernelGGL(mk_fwd, dim3(grid), dim3(NTHREADS), LDS_BYTES, stream, a); }
#endif
}
```

```cpp
#include <hip/hip_runtime.h>
#include <cstdio>
#include <cstdint>

#ifndef MK_ONE_LAUNCH
#define MK_ONE_LAUNCH 1
#endif
#ifndef MK_LAST_PHASE
#define MK_LAST_PHASE 99
#endif

#ifndef MK_REP
#define MK_REP (-1)
#endif
#define REPEAT_IF(k) _Pragma("unroll") for (int _r = 0; _r < ((k) == MK_REP ? 2 : 1); ++_r)
#define REP_BAR() do { if (_r) GRID_BAR(); } while (0)

#define GAS __attribute__((address_space(1)))
#define LAS __attribute__((address_space(3)))
typedef unsigned short bf16_t;
typedef short bf16x8 __attribute__((ext_vector_type(8)));
typedef float f32x4 __attribute__((ext_vector_type(4)));
typedef float f32x2 __attribute__((ext_vector_type(2)));
typedef unsigned u32x4 __attribute__((ext_vector_type(4)));
typedef unsigned u32x2 __attribute__((ext_vector_type(2)));

constexpr int D = 1024, BATCH = 16, SEQ = 2048, CTXL = 256, GRIDW = 64;
constexpr int NX = BATCH * SEQ, NC = BATCH * CTXL, NT = NX + NC;
constexpr int ADA = 6 * D;
constexpr int GLA_H = 4, GLA_DK = 64, GLA_DV = 128, GLA_QK = 256, GLA_V = 512, CONV_CH = 512, CONV_W = 31;
constexpr int AB_IN = 2592, AB_INP = 2816;
constexpr int NA_H = 16, NA_DH = 64;
constexpr int NEXP = 256, TOPK = 8, DEXP = 256;
constexpr int NEXPS = NEXP + 1;
constexpr int PMAX = NT * TOPK + NEXP * 255 + NT;
static_assert(PMAX % 256 == 0, "PMAX");
constexpr float RMS_EPS = 1e-6f, LN_EPS = 1e-5f;
constexpr float F8_SCALE = 32.0f, F8_INV = 1.0f / 32.0f;

constexpr size_t MiB = 1u << 20;
constexpr size_t al(size_t x) { return (x + 4095) & ~(size_t)4095; }
constexpr size_t WS_CTL = 0, CTL_BYTES = 1 * MiB;
constexpr size_t WS_MODX = WS_CTL + CTL_BYTES;
constexpr size_t WS_MODC = WS_MODX + al((size_t)2 * 16 * ADA * 4);
constexpr size_t WS_ROPE = WS_MODC + al((size_t)2 * ADA * 4);
constexpr size_t WS_XW = WS_ROPE + al(64 * 16 * 8);
constexpr size_t WS_H = WS_XW + al((size_t)NT * D * 4);
constexpr size_t WS_WIN0 = WS_H + al((size_t)NT * D * 2);
constexpr size_t WS_WOUT0 = WS_WIN0 + al((size_t)AB_INP * D * 2);
constexpr size_t WS_WQKV1 = WS_WOUT0 + al((size_t)D * D * 2);
constexpr size_t WS_WOUT1 = WS_WQKV1 + al((size_t)3 * D * D * 2);
constexpr size_t WS_WR = WS_WOUT1 + al((size_t)D * D * 2);
constexpr size_t WS_WGU = WS_WR + al((size_t)2 * NEXP * D * 2);
constexpr size_t WS_WDN = WS_WGU + al((size_t)NEXPS * 512 * D * 2);
constexpr size_t WS_T = WS_WDN + al((size_t)NEXPS * D * 256 * 2);
constexpr size_t T_QB = WS_T;
constexpr size_t T_KB = T_QB + al((size_t)NT * 256 * 2);
constexpr size_t T_VB = T_KB + al((size_t)NT * 256 * 2);
constexpr size_t T_GB = T_VB + al((size_t)NT * 512 * 2);
constexpr size_t T_UB = T_GB + al((size_t)NT * 512 * 2);
constexpr size_t T_LR = T_UB + al((size_t)NT * 512 * 2);
constexpr size_t T_OF = T_LR + al((size_t)NT * 32 * 4);
constexpr size_t T_OB = T_OF + al((size_t)NT * 512 * 2);
constexpr size_t T_CAT = T_OB + al((size_t)NT * 512 * 2);
constexpr size_t T_Y = T_CAT + al((size_t)NT * D * 2);
constexpr size_t T_END0 = T_Y + al((size_t)NT * D * 2);
constexpr size_t T_QKV = WS_T;
static_assert(T_QKV + (size_t)3 * NT * D * 2 <= T_CAT, "qkv overlay");
constexpr size_t M_AE = WS_T;
constexpr size_t M_AR = M_AE + al((size_t)NT * 8 * 4);
constexpr size_t M_AG = M_AR + al((size_t)NT * 8 * 4);
constexpr size_t M_TS = M_AG + al((size_t)NT * 8 * 4);
constexpr size_t M_ST = M_TS + al((size_t)NT * 8 * 4);
constexpr size_t M_HID = M_ST + al((size_t)PMAX * 4);
constexpr size_t M_OUT = M_HID + al((size_t)PMAX * 256 * 2);
constexpr int MO_LD = 1024;
constexpr size_t M_END = M_OUT + al((size_t)PMAX * MO_LD * 2);
constexpr size_t WS_END = (M_END > T_END0 ? M_END : T_END0);
static_assert(WS_END <= (size_t)2040 * MiB, "workspace map must fit 2 GiB");

constexpr int CW_BAR = 4096;
constexpr int CW_CNT = 16384;
constexpr int CW_CUR = 16384 + 512;

constexpr int RING_BYTES = 131072;
constexpr int AUX_OFF = RING_BYTES, AUX_BYTES = 31744;
constexpr int MISC_OFF = AUX_OFF + AUX_BYTES;
constexpr int LDS_BYTES = MISC_OFF + 1024;
constexpr int NWAVES = 8, NTHREADS = 512;

#define LDS_WAIT() asm volatile("s_waitcnt lgkmcnt(0)" ::: "memory")
#define VM_WAIT() asm volatile("s_waitcnt vmcnt(0)" ::: "memory")

__device__ __forceinline__ unsigned f2bf(float f) { unsigned u = __builtin_bit_cast(unsigned, f); return (u + 0x7fffu + ((u >> 16) & 1u)) >> 16; }
__device__ __forceinline__ unsigned pk2(float lo, float hi) { return f2bf(lo) | (f2bf(hi) << 16); }
__device__ __forceinline__ float bf2f(unsigned short b) { return __builtin_bit_cast(float, (unsigned)b << 16); }
__device__ __forceinline__ float bflo(unsigned w) { return __builtin_bit_cast(float, w << 16); }
__device__ __forceinline__ float bfhi(unsigned w) { return __builtin_bit_cast(float, w & 0xffff0000u); }
__device__ __forceinline__ float wave_sum(float v) {
#pragma unroll
    for (int o = 1; o < 64; o <<= 1) v += __shfl_xor(v, o);
    return v;
}
__device__ __forceinline__ float sigmoidf_(float x) { return 1.0f / (1.0f + __expf(-x)); }
__device__ __forceinline__ float siluf_(float x) { return x / (1.0f + __expf(-x)); }

__device__ __forceinline__ void lds_barrier() { asm volatile("s_waitcnt lgkmcnt(0)" ::: "memory"); __builtin_amdgcn_s_barrier(); asm volatile("" ::: "memory"); }
#define XB_TMO      128
#define XB_XCNT(j)  (256  + 64 * (j))
#define XB_XSUB(j)  (1280 + 64 * (j))
#define XB_XGEN(j)  (2304 + 64 * (j))
#define XB_TOP      3328
#define XB_TOPGEN   3392
#define XCD_BAR_WORDS 3456
#define XB_SPIN_CAP (1u << 18)

__device__ __forceinline__ unsigned xb_ld(unsigned* p)              { return __hip_atomic_load(p, __ATOMIC_RELAXED, __HIP_MEMORY_SCOPE_AGENT); }
__device__ __forceinline__ unsigned xb_add(unsigned* p, unsigned v) { return __hip_atomic_fetch_add(p, v, __ATOMIC_RELAXED, __HIP_MEMORY_SCOPE_AGENT); }
__device__ __forceinline__ unsigned xb_xcc_id() { return (unsigned)__builtin_amdgcn_s_getreg((3 << 11) | 20) & 0xFu; }
#define XB_SPIN(cond, bar) do { unsigned _sp = 0; while (cond) { __builtin_amdgcn_s_sleep(1); \
    if ((++_sp & 255u) == 0u) { if (xb_ld(&(bar)[XB_TMO])) break; if (_sp > XB_SPIN_CAP) { atomicAdd(&(bar)[XB_TMO], 1u); break; } } } } while (0)

struct XcdBarrier { unsigned* bar; unsigned x; volatile LAS unsigned* st; };

__device__ __forceinline__ XcdBarrier xcd_barrier_post(unsigned* bar, volatile LAS unsigned* st) {
    XcdBarrier b; b.bar = bar; b.x = xb_xcc_id(); b.st = st;
    if (threadIdx.x == 0) (void)xb_add(&bar[XB_XCNT(b.x)], 1u);
    return b;
}
__device__ __forceinline__ void xcd_barrier_complete(unsigned* bar, unsigned x, unsigned& nloc, unsigned& nx) {
    const unsigned G = gridDim.x * gridDim.y * gridDim.z;
    unsigned sum, cnt, mine, sp = 0u;
    for (;;) {
        sum = 0u; cnt = 0u; mine = 0u;
#pragma unroll
        for (unsigned j = 0; j < 16; ++j) { const unsigned c = xb_ld(&bar[XB_XCNT(j)]); sum += c; cnt += (c > 0u) ? 1u : 0u; mine = (j == x) ? c : mine; }
        if (sum == G) break;
        __builtin_amdgcn_s_sleep(1);
        if ((++sp & 255u) == 0u) { if (xb_ld(&bar[XB_TMO])) break; if (sp > XB_SPIN_CAP) { atomicAdd(&bar[XB_TMO], 1u); break; } }
    }
    nloc = mine > 0u ? mine : 1u; nx = cnt > 0u ? cnt : 1u;
}
__device__ __forceinline__ void xcd_barrier(const XcdBarrier& b) {
    asm volatile("s_waitcnt vmcnt(0)" ::: "memory");
    __syncthreads();
    if (threadIdx.x == 0) {
        unsigned* bar = b.bar;
        __builtin_amdgcn_s_waitcnt(0);
        unsigned nloc = b.st[0], nx = b.st[1];
        if (nloc == 0u) { xcd_barrier_complete(bar, b.x, nloc, nx); b.st[0] = nloc; b.st[1] = nx; }
        const unsigned old = xb_add(&bar[XB_XSUB(b.x)], 1u);
        const unsigned gen = old / nloc;
        if (old + 1u == (gen + 1u) * nloc) {
            __builtin_amdgcn_fence(__ATOMIC_RELEASE, "agent");
            asm volatile("s_waitcnt vmcnt(0)" ::: "memory");
            const unsigned og = xb_add(&bar[XB_TOP], 1u);
            const unsigned tg = og / nx;
            if (og + 1u == (tg + 1u) * nx) xb_add(&bar[XB_TOPGEN], 1u);
            else XB_SPIN(xb_ld(&bar[XB_TOPGEN]) == tg, bar);
            __builtin_amdgcn_fence(__ATOMIC_ACQUIRE, "agent");
            xb_add(&bar[XB_XGEN(b.x)], 1u);
            asm volatile("s_waitcnt vmcnt(0)" ::: "memory");
        } else {
            XB_SPIN(xb_ld(&bar[XB_XGEN(b.x)]) == gen, bar);
            __builtin_amdgcn_fence(__ATOMIC_ACQUIRE, "agent");
            asm volatile("s_waitcnt vmcnt(0)" ::: "memory");
        }
    }
    __syncthreads();
}

namespace pg8 {
constexpr int BM = 256, BK = 64, HALF = 128, HTB = HALF * BK * 2, STAGE_BYTES = 8 * HTB, NXCD = 8, WGM = 8;
__host__ __device__ __forceinline__ int lds_byte(int r, int c) { const int st = (r >> 4) * 2 + (c >> 5), rr = r & 15, cc = c & 31, ob = rr * 64 + cc * 2; return st * 1024 + (ob ^ (((ob >> 9) & 1) << 5)); }
__host__ __device__ __forceinline__ void stage_rc(int b, int& R, int& C) { const int st = b / 1024, sb = b % 1024, swz = sb ^ (((sb >> 9) & 1) << 5); R = (st >> 1) * 16 + swz / 64; C = (st & 1) * 32 + (swz % 64) / 2; }
__host__ __device__ __forceinline__ int perm32(int rho) { const int n = rho >> 4, i = rho & 15; return 8 * (i >> 2) + 4 * n + (i & 3); }

struct Unit { int a, b, orow, ocol, aux; };

__device__ __forceinline__ bool static_order(int L, int nM, int nN, int& pm, int& pn) {
    const int nwg = nM * nN; if (L >= nwg) return false;
    int wgid = L; { const int q = nwg / NXCD, r = nwg % NXCD, xcd = wgid % NXCD, off = wgid / NXCD; wgid = (xcd < r ? xcd * (q + 1) : r * (q + 1) + (xcd - r) * q) + off; }
    const int nig = WGM * nN, gid = wgid / nig, fm = gid * WGM, gsz = (nM - fm) < WGM ? (nM - fm) : WGM;
    pm = fm + ((wgid % nig) % gsz); pn = (wgid % nig) / gsz; return true;
}

template <class Epi, class Sched, bool ALIGN_EPI>
__device__ __forceinline__ void gemm_phase(LAS unsigned char* lds, const int K, const Sched& S, const Epi& E) {
    const int tid = threadIdx.x, wid = __builtin_amdgcn_readfirstlane(tid >> 6), lane = tid & 63, wr = wid >> 2, wc = wid & 3, fr = lane & 15, fq = lane >> 4;
    const int nt = K / BK;
    int Rr[2], Cc[2]; unsigned voffB[2];
#pragma unroll
    for (int i = 0; i < 2; ++i) { int R, C; stage_rc(tid * 16 + i * 8192, R, C); Rr[i] = R; Cc[i] = C; const int Rb = Epi::PERM ? ((R & ~31) + perm32(R & 31)) : R; voffB[i] = (unsigned)(Rb * K + C) * 2u; }
    const size_t kstep = (size_t)(BK * 2);
    const size_t hstepB = (size_t)HALF * K * 2;
    const unsigned ldsw = (unsigned)wid * 1024u;
    const int aoff = lds_byte(wr * 64 + fr, fq * 8), boff = lds_byte(wc * 32 + fr, fq * 8);
#define PG8_SA(b, h) (((b) * 2 + (h)) * HTB)
#define PG8_SB(b, h) ((4 + (b) * 2 + (h)) * HTB)
#define PG8_STAGE(bufoff, gbase, voff) do { _Pragma("unroll") for (int _i = 0; _i < 2; ++_i) \
        __builtin_amdgcn_global_load_lds((const unsigned*)((const char*)(gbase) + (voff)[_i]), (LAS unsigned*)(lds + (bufoff) + ldsw + _i * 8192), 16, 0, 0); } while (0)
#define PG8_LDA(dst, b, h) do { _Pragma("unroll") for (int m = 0; m < 4; ++m) _Pragma("unroll") for (int k = 0; k < 2; ++k) dst[m][k] = *(const LAS bf16x8*)(lds + PG8_SA(b, h) + aoff + m * 2048 + k * 1024); } while (0)
#define PG8_LDB(dst, b, h) do { _Pragma("unroll") for (int n = 0; n < 2; ++n) _Pragma("unroll") for (int k = 0; k < 2; ++k) dst[n][k] = *(const LAS bf16x8*)(lds + PG8_SB(b, h) + boff + n * 2048 + k * 1024); } while (0)
#define PG8_MMA(ai, bj, At, Bt) do { __builtin_amdgcn_s_setprio(1); _Pragma("unroll") for (int m = 0; m < 4; ++m) _Pragma("unroll") for (int n = 0; n < 2; ++n) _Pragma("unroll") for (int k = 0; k < 2; ++k) \
        acc[ai][bj][m][n] = __builtin_amdgcn_mfma_f32_16x16x32_bf16(Bt[n][k], At[m][k], acc[ai][bj][m][n], 0, 0, 0); __builtin_amdgcn_s_setprio(0); } while (0)
#define PG8_WAIT_V(n) asm volatile("s_waitcnt vmcnt(" #n ")" ::: "memory")
#define PG8_WAIT_L(n) asm volatile("s_waitcnt lgkmcnt(" #n ")" ::: "memory")
#define PG8_BAR __builtin_amdgcn_s_barrier()
#define PG8_SCHED __builtin_amdgcn_sched_barrier(0)
    Unit cur, nxt; int ui = 0;
    if (!S.next(0, cur)) return;
    f32x4 acc[2][2][4][2];
#pragma unroll
    for (int a = 0; a < 2; ++a)
#pragma unroll
        for (int b = 0; b < 2; ++b)
#pragma unroll
            for (int m = 0; m < 4; ++m)
#pragma unroll
                for (int n = 0; n < 2; ++n) acc[a][b][m][n] = (f32x4){0.f, 0.f, 0.f, 0.f};
    bf16x8 At[4][2], B0[2][2], B1[2][2];
    unsigned co0[2], co1[2], no0[2], no1[2];
    S.a_off(cur, Rr, Cc, co0, co1);
    const char* const Ab = S.a_base();
    const char* cB = S.b_ptr(cur);
    PG8_STAGE(PG8_SB(0, 0), cB, voffB); PG8_STAGE(PG8_SB(0, 1), cB + hstepB, voffB); PG8_STAGE(PG8_SA(0, 0), Ab, co0); PG8_STAGE(PG8_SA(0, 1), Ab, co1);
    if (wr == 1) PG8_BAR;
    PG8_WAIT_V(2); PG8_BAR;
    PG8_STAGE(PG8_SB(1, 0), cB + kstep, voffB); PG8_STAGE(PG8_SA(1, 0), Ab + kstep, co0); PG8_STAGE(PG8_SB(1, 1), cB + hstepB + kstep, voffB);
    PG8_WAIT_V(6); PG8_BAR;
    for (;;) {
        const bool has_next = S.next(ui + 1, nxt);
        const char* nB = has_next ? S.b_ptr(nxt) : cB;
#pragma nounroll
        for (int t = 0; t < nt; t += 2) {
            const bool last = (t == nt - 2);
            if (last) { if (has_next) S.a_off(nxt, Rr, Cc, no0, no1); else { no0[0] = co0[0]; no0[1] = co0[1]; no1[0] = co1[0]; no1[1] = co1[1]; } }
            const char* a1 = Ab + (size_t)(t + 1) * kstep;
            const char* a2 = last ? Ab : Ab + (size_t)(t + 2) * kstep; const char* b2 = last ? nB : cB + (size_t)(t + 2) * kstep;
            const char* a3 = a2 + kstep; const char* b3 = b2 + kstep;
            unsigned x0[2], x1[2];
            x0[0] = last ? no0[0] : co0[0]; x0[1] = last ? no0[1] : co0[1]; x1[0] = last ? no1[0] : co1[0]; x1[1] = last ? no1[1] : co1[1];
            PG8_LDB(B0, 0, 0); PG8_LDB(B1, 0, 1); PG8_SCHED; PG8_LDA(At, 0, 0); PG8_STAGE(PG8_SA(1, 1), a1, co1);
            PG8_WAIT_V(8); PG8_WAIT_L(0); PG8_BAR; PG8_MMA(0, 0, At, B0); PG8_MMA(0, 1, At, B1); PG8_BAR; PG8_SCHED;
            PG8_LDA(At, 0, 1); PG8_STAGE(PG8_SB(0, 0), b2, voffB); PG8_STAGE(PG8_SB(0, 1), b2 + hstepB, voffB); PG8_STAGE(PG8_SA(0, 0), a2, x0);
            PG8_WAIT_V(8); PG8_WAIT_L(0); PG8_BAR; PG8_MMA(1, 0, At, B0); PG8_MMA(1, 1, At, B1); PG8_BAR; PG8_SCHED;
            PG8_LDB(B0, 1, 0); PG8_LDB(B1, 1, 1); PG8_SCHED; PG8_LDA(At, 1, 0); PG8_STAGE(PG8_SA(0, 1), a2, x1);
            PG8_WAIT_V(8); PG8_WAIT_L(0); PG8_BAR; PG8_MMA(0, 0, At, B0); PG8_MMA(0, 1, At, B1); PG8_BAR; PG8_SCHED;
            PG8_LDA(At, 1, 1); PG8_STAGE(PG8_SB(1, 0), b3, voffB); PG8_STAGE(PG8_SB(1, 1), b3 + hstepB, voffB); PG8_STAGE(PG8_SA(1, 0), a3, x0);
            PG8_WAIT_V(8); PG8_WAIT_L(0); PG8_BAR; PG8_MMA(1, 0, At, B0); PG8_MMA(1, 1, At, B1); PG8_BAR; PG8_SCHED;
        }
        if constexpr (ALIGN_EPI) { if (wr == 0) PG8_BAR; }
        if constexpr (!Epi::AFTER_DRAIN) { E(acc, cur, wr, wc, fr, fq); }
        if (!has_next) break;
#pragma unroll
        for (int a = 0; a < 2; ++a)
#pragma unroll
            for (int b = 0; b < 2; ++b)
#pragma unroll
                for (int m = 0; m < 4; ++m)
#pragma unroll
                    for (int n = 0; n < 2; ++n) acc[a][b][m][n] = (f32x4){0.f, 0.f, 0.f, 0.f};
        cur = nxt; cB = nB; co0[0] = no0[0]; co0[1] = no0[1]; co1[0] = no1[0]; co1[1] = no1[1]; ++ui;
        if constexpr (ALIGN_EPI) { if (wr == 1) PG8_BAR; }
    }
    PG8_WAIT_V(0);
    if constexpr (!ALIGN_EPI) { if (wr == 0) PG8_BAR; }
    PG8_BAR;
    if constexpr (Epi::AFTER_DRAIN) { E.fused(acc, cur, wr, wc, fr, fq, lds, wid, lane); }
#undef PG8_SA
#undef PG8_SB
#undef PG8_STAGE
#undef PG8_LDA
#undef PG8_LDB
#undef PG8_MMA
#undef PG8_WAIT_V
#undef PG8_WAIT_L
#undef PG8_BAR
#undef PG8_SCHED
}
}
using pg8::Unit;

__device__ __forceinline__ unsigned cvt_pk_bf16(float lo, float hi) { unsigned r; asm volatile("v_cvt_pk_bf16_f32 %0, %1, %2" : "=v"(r) : "v"(lo), "v"(hi)); return r; }

struct SchedDense {
    const char* A; const char* Bt; int K; int nM0, nN0, nM1, nN1, pn1off; int G, c;
    __device__ __forceinline__ bool next(int i, Unit& u) const {
        const int L = i * G + c; int pm, pn;
        const int n0 = nM0 * nN0;
        if (L < n0) { pg8::static_order(L, nM0, nN0, pm, pn); }
        else { if (!pg8::static_order(L - n0, nM1, nN1, pm, pn)) return false; pm += nM0; pn += pn1off; }
        u.a = pm; u.b = pn * 256; u.orow = pm * 256; u.ocol = pn * 256; u.aux = pn; return true;
    }
    __device__ __forceinline__ const char* a_base() const { return A; }
    __device__ __forceinline__ const char* b_ptr(const Unit& u) const { return Bt + (size_t)u.b * K * 2; }
    __device__ __forceinline__ void a_off(const Unit& u, const int (&R)[2], const int (&C)[2], unsigned (&o0)[2], unsigned (&o1)[2]) const {
#pragma unroll
        for (int i = 0; i < 2; ++i) { o0[i] = (unsigned)((u.a * 256 + R[i]) * K + C[i]) * 2u; o1[i] = o0[i] + (unsigned)(128 * K * 2); }
    }
};

struct EpiBf16 {
    static constexpr bool PERM = true, AFTER_DRAIN = false;
    bf16_t* O; int ldc; int split_cols; size_t split_stride; float scale0 = 1.0f;
    __device__ __forceinline__ void operator()(const f32x4 (&acc)[2][2][4][2], const Unit& u, int wr, int wc, int fr, int fq) const {
        const int lane = fr + 16 * fq; const int srcb = ((lane >> 2) + 16 * (lane & 3)) << 2;
        const int row0 = u.orow + wr * 64 + (lane >> 2); int colt = u.ocol; bf16_t* base = O;
        float sc = 1.0f;
        if (split_cols) { const int t = colt / split_cols; base += (size_t)t * split_stride; colt -= t * split_cols; if (t == 0) sc = scale0; }
        const int col0 = colt + wc * 32 + 8 * (lane & 3);
#pragma unroll
        for (int ai = 0; ai < 2; ++ai)
#pragma unroll
            for (int m = 0; m < 4; ++m) { bf16_t* rowp = base + (size_t)(row0 + ai * 128 + m * 16) * ldc + col0;
#pragma unroll
                for (int bj = 0; bj < 2; ++bj) { const f32x4 v0 = acc[ai][bj][m][0] * sc, v1 = acc[ai][bj][m][1] * sc;
                    u32x4 w; w.x = cvt_pk_bf16(v0[0], v0[1]); w.y = cvt_pk_bf16(v0[2], v0[3]); w.z = cvt_pk_bf16(v1[0], v1[1]); w.w = cvt_pk_bf16(v1[2], v1[3]);
                    u32x4 t; t.x = (unsigned)__builtin_amdgcn_ds_bpermute(srcb, (int)w.x); t.y = (unsigned)__builtin_amdgcn_ds_bpermute(srcb, (int)w.y); t.z = (unsigned)__builtin_amdgcn_ds_bpermute(srcb, (int)w.z); t.w = (unsigned)__builtin_amdgcn_ds_bpermute(srcb, (int)w.w);
                    *(u32x4*)(rowp + bj * 128) = t; } }
    }
};
struct EpiF8 {
    static constexpr bool PERM = true, AFTER_DRAIN = false;
    unsigned char* O;
    __device__ __forceinline__ int nst(const Unit&, int) const { return 16; }
    __device__ __forceinline__ void operator()(const f32x4 (&acc)[2][2][4][2], const Unit& u, int wr, int wc, int fr, int fq) const {
        const int lane = fr + 16 * fq; const int srcb = ((lane >> 2) + 16 * (lane & 3)) << 2;
        const int row0 = u.orow + wr * 64 + (lane >> 2), col0 = u.ocol + wc * 32 + 8 * (lane & 3);
#pragma unroll
        for (int ai = 0; ai < 2; ++ai)
#pragma unroll
            for (int m = 0; m < 4; ++m) { unsigned char* rowp = O + (size_t)(row0 + ai * 128 + m * 16) * D + col0;
#pragma unroll
                for (int bj = 0; bj < 2; ++bj) { const f32x4 v0 = acc[ai][bj][m][0] * F8_SCALE, v1 = acc[ai][bj][m][1] * F8_SCALE;
                    int w0 = __builtin_amdgcn_cvt_pk_fp8_f32(v0[0], v0[1], 0, false); w0 = __builtin_amdgcn_cvt_pk_fp8_f32(v0[2], v0[3], w0, true);
                    int w1 = __builtin_amdgcn_cvt_pk_fp8_f32(v1[0], v1[1], 0, false); w1 = __builtin_amdgcn_cvt_pk_fp8_f32(v1[2], v1[3], w1, true);
                    u32x2 t; t.x = (unsigned)__builtin_amdgcn_ds_bpermute(srcb, w0); t.y = (unsigned)__builtin_amdgcn_ds_bpermute(srcb, w1);
                    *(u32x2*)(rowp + bj * 128) = t; } }
    }
};
template <int MODE> struct EpiBf16X {
    static constexpr bool PERM = true, AFTER_DRAIN = false;
    bf16_t* O; int ldc;
    __device__ __forceinline__ void operator()(const f32x4 (&acc)[2][2][4][2], const Unit& u, int wr, int wc, int fr, int fq) const {
        const int lane = fr + 16 * fq; const int srcb = ((lane >> 2) + 16 * (lane & 3)) << 2;
        const int row0 = u.orow + wr * 64 + (lane >> 2); const int col0 = u.ocol + wc * 32 + 8 * (lane & 3);
#pragma unroll
        for (int ai = 0; ai < 2; ++ai)
#pragma unroll
            for (int m = 0; m < 4; ++m) { bf16_t* rowp = O + (size_t)(row0 + ai * 128 + m * 16) * ldc + col0;
#pragma unroll
                for (int bj = 0; bj < 2; ++bj) { const f32x4 v0 = acc[ai][bj][m][0], v1 = acc[ai][bj][m][1];
                    u32x4 w; w.x = cvt_pk_bf16(v0[0], v0[1]); w.y = cvt_pk_bf16(v0[2], v0[3]); w.z = cvt_pk_bf16(v1[0], v1[1]); w.w = cvt_pk_bf16(v1[2], v1[3]);
                    u32x4 t; t.x = (unsigned)__builtin_amdgcn_ds_bpermute(srcb, (int)w.x); t.y = (unsigned)__builtin_amdgcn_ds_bpermute(srcb, (int)w.y); t.z = (unsigned)__builtin_amdgcn_ds_bpermute(srcb, (int)w.z); t.w = (unsigned)__builtin_amdgcn_ds_bpermute(srcb, (int)w.w);
                    if (MODE == 1) { if (bj == 0) *(u32x4*)(rowp + bj * 128) = t; else asm volatile("" :: "v"(t)); }
                    if (MODE == 2) { bf16_t* p = O + (wr * 128 + ai * 64 + m * 16 + bj * 8 + wc * 2) * 256 + 8 * lane; *(u32x4*)p = t; }
                } }
    }
};
struct EpiNull {
    static constexpr bool PERM = true, AFTER_DRAIN = false;
    __device__ __forceinline__ void operator()(const f32x4 (&acc)[2][2][4][2], const Unit& u, int wr, int wc, int fr, int fq) const {
#pragma unroll
        for (int ai = 0; ai < 2; ++ai)
#pragma unroll
            for (int bj = 0; bj < 2; ++bj)
#pragma unroll
                for (int m = 0; m < 4; ++m)
#pragma unroll
                    for (int n = 0; n < 2; ++n) asm volatile("" :: "v"(acc[ai][bj][m][n]));
    }
};
struct EpiBf16NS {
    static constexpr bool PERM = true, AFTER_DRAIN = false;
    __device__ __forceinline__ void operator()(const f32x4 (&acc)[2][2][4][2], const Unit& u, int wr, int wc, int fr, int fq) const {
#pragma unroll
        for (int ai = 0; ai < 2; ++ai)
#pragma unroll
            for (int m = 0; m < 4; ++m) {
#pragma unroll
                for (int bj = 0; bj < 2; ++bj) { const f32x4 v0 = acc[ai][bj][m][0], v1 = acc[ai][bj][m][1];
                    u32x4 w; w.x = cvt_pk_bf16(v0[0], v0[1]); w.y = cvt_pk_bf16(v0[2], v0[3]); w.z = cvt_pk_bf16(v1[0], v1[1]); w.w = cvt_pk_bf16(v1[2], v1[3]);
                    asm volatile("" :: "v"(w)); } }
    }
};
struct EpiInproj {
    static constexpr bool PERM = false, AFTER_DRAIN = false;
    bf16_t *qb, *kb, *vb, *gb, *ub; float* lr; const f32x2* rope;
    __device__ __forceinline__ void operator()(const f32x4 (&acc)[2][2][4][2], const Unit& u, int wr, int wc, int fr, int fq) const {
        const int pn = u.aux; const int row0 = u.orow + wr * 64 + fr;
        if (pn <= 1) {
            bf16_t* dst = pn == 0 ? qb : kb; const float sc = pn == 0 ? 0.125f : 1.0f;
#pragma unroll
            for (int ai = 0; ai < 2; ++ai)
#pragma unroll
                for (int m = 0; m < 4; ++m) {
                    const int row = row0 + ai * 128 + m * 16; const bool lat = row < NX;
                    const int s = row & (SEQ - 1); const int pos = (wc & 1) ? (s & 63) : (s >> 6);
                    f32x2 cs[4];
                    if (lat) {
#pragma unroll
                        for (int e = 0; e < 4; ++e) cs[e] = rope[pos * 16 + 4 * fq + e];
                    } else {
#pragma unroll
                        for (int e = 0; e < 4; ++e) cs[e] = (f32x2){1.f, 0.f};
                    }
#pragma unroll
                    for (int bj = 0; bj < 2; ++bj) {
                        const f32x4 u1 = acc[ai][bj][m][0], u2 = acc[ai][bj][m][1]; f32x4 o1, o2;
#pragma unroll
                        for (int e = 0; e < 4; ++e) { o1[e] = (u1[e] * cs[e].x - u2[e] * cs[e].y) * sc; o2[e] = (u1[e] * cs[e].y + u2[e] * cs[e].x) * sc; }
                        bf16_t* p = dst + (size_t)row * 256 + bj * 128 + wc * 32 + 4 * fq;
                        u32x2 w1, w2; w1.x = cvt_pk_bf16(o1[0], o1[1]); w1.y = cvt_pk_bf16(o1[2], o1[3]); w2.x = cvt_pk_bf16(o2[0], o2[1]); w2.y = cvt_pk_bf16(o2[2], o2[3]);
                        *(u32x2*)p = w1; *(u32x2*)(p + 16) = w2;
                    }
                }
        } else if (pn <= 5) {
            bf16_t* dst = pn <= 3 ? vb : gb; const int cb = (pn & 1) ? 256 : 0;
#pragma unroll
            for (int ai = 0; ai < 2; ++ai)
#pragma unroll
                for (int m = 0; m < 4; ++m) { const int row = row0 + ai * 128 + m * 16;
#pragma unroll
                    for (int bj = 0; bj < 2; ++bj)
#pragma unroll
                        for (int n = 0; n < 2; ++n) { const f32x4 v = acc[ai][bj][m][n]; u32x2 w; w.x = cvt_pk_bf16(v[0], v[1]); w.y = cvt_pk_bf16(v[2], v[3]);
                            *(u32x2*)(dst + (size_t)row * 512 + cb + bj * 128 + wc * 32 + n * 16 + 4 * fq) = w; } }
        } else if (pn <= 9) {
            const int cb = (pn - 6) * 128;
#pragma unroll
            for (int ai = 0; ai < 2; ++ai)
#pragma unroll
                for (int m = 0; m < 4; ++m) { const int row = row0 + ai * 128 + m * 16;
#pragma unroll
                    for (int n = 0; n < 2; ++n) { const f32x4 a = acc[ai][0][m][n], b = acc[ai][1][m][n]; f32x4 o;
#pragma unroll
                        for (int e = 0; e < 4; ++e) o[e] = a[e] * sigmoidf_(b[e]);
                        u32x2 w; w.x = cvt_pk_bf16(o[0], o[1]); w.y = cvt_pk_bf16(o[2], o[3]);
                        *(u32x2*)(ub + (size_t)row * 512 + cb + wc * 32 + n * 16 + 4 * fq) = w; } }
        } else {
            if (wc == 0) {
#pragma unroll
                for (int ai = 0; ai < 2; ++ai)
#pragma unroll
                    for (int m = 0; m < 4; ++m) { const int row = row0 + ai * 128 + m * 16;
#pragma unroll
                        for (int n = 0; n < 2; ++n) *(f32x4*)(lr + (size_t)row * 32 + n * 16 + 4 * fq) = acc[ai][0][m][n]; }
            }
        }
    }
};

struct Args { const float* in[32]; float* out; unsigned char* ws; int ph_lo, ph_hi; };

struct Frame {
    LAS unsigned char* lds; volatile LAS unsigned* MISC; unsigned* ctl; unsigned char* ws;
    int tid, lane, wave, G, vcu;
};

__device__ __forceinline__ void cvt_item(const float* __restrict__ src, int ld, int col0, int ncols, int k0, bf16_t* dst, int ldd, int drow0, LAS unsigned* T, int lane) {
    const bool okc = lane < ncols;
    const float* p = src + (size_t)k0 * ld + col0 + (okc ? lane : 0);
    float v[64];
#pragma unroll
    for (int k = 0; k < 64; ++k) v[k] = p[(size_t)k * ld];
#pragma unroll
    for (int kp = 0; kp < 32; ++kp) T[lane * 33 + kp] = okc ? pk2(v[2 * kp], v[2 * kp + 1]) : 0u;
    LDS_WAIT(); asm volatile("" ::: "memory");
    const int c = lane & 7;
#pragma unroll
    for (int it = 0; it < 8; ++it) { const int n = (lane >> 3) + 8 * it;
        u32x4 o; o.x = T[n * 33 + 4 * c]; o.y = T[n * 33 + 4 * c + 1]; o.z = T[n * 33 + 4 * c + 2]; o.w = T[n * 33 + 4 * c + 3];
        if (n < ncols) *(u32x4*)(dst + (size_t)(drow0 + n) * ldd + k0 + 8 * c) = o; }
    LDS_WAIT(); asm volatile("" ::: "memory");
}
__device__ __forceinline__ void cvt_matrix_item(const float* src, int ld, int col0, int ncols, int K, bf16_t* dst, int drow0, int item, LAS unsigned* T, int lane) {
    const int ncg = (ncols + 63) >> 6; const int kt = item / ncg, cg = item - kt * ncg;
    const int nc = ncols - cg * 64 < 64 ? ncols - cg * 64 : 64;
    cvt_item(src, ld, col0 + cg * 64, nc, kt * 64, dst, K, drow0 + cg * 64, T, lane);
}

constexpr int MOE_CVT_ITEMS = NEXPS * 192;
__device__ __forceinline__ void cvt_moe_item(const Args& a, int layer, int item, unsigned char* ws, LAS unsigned* T, int lane) {
    const int e = item / 192, r = item - e * 192;
    bf16_t* wgu = (bf16_t*)(ws + WS_WGU) + (size_t)e * 512 * D; bf16_t* wdn = (bf16_t*)(ws + WS_WDN) + (size_t)e * D * 256;
    if (r < 128) {
        const int gi = r >> 4, kt = r & 15; const int up = gi >> 2, g4 = gi & 3;
        const float* src = e < NEXP ? (up ? a.in[27] : a.in[26]) + ((size_t)layer * NEXP + e) * D * DEXP : (up ? a.in[30] : a.in[29]) + (size_t)layer * D * DEXP;
        cvt_item(src, DEXP, 64 * g4, 64, kt * 64, wgu, D, 256 * (g4 >> 1) + 64 * (g4 & 1) + 128 * up, T, lane);
    } else {
        const int q = r - 128; const int cg = q >> 2, kt = q & 3;
        const float* src = e < NEXP ? a.in[28] + ((size_t)layer * NEXP + e) * DEXP * D : a.in[31] + (size_t)layer * DEXP * D;
        cvt_item(src, D, 64 * cg, 64, kt * 64, wdn, DEXP, 64 * cg, T, lane);
    }
}

__device__ __forceinline__ float row_rms_scale(const f32x4 (&v)[4]) {
    float s = 0.f;
#pragma unroll
    for (int j = 0; j < 4; ++j) s += (v[j].x * v[j].x + v[j].y * v[j].y) + (v[j].z * v[j].z + v[j].w * v[j].w);
    return rsqrtf(wave_sum(s) * (1.0f / D) + RMS_EPS);
}
__device__ __forceinline__ f32x4 ld4(const float* p) { return *(const f32x4*)p; }

struct RowPhase {
    const float* xin_lat; const float* xin_ctx;
    float* xout_lat; float* xout_ctx;
    int nrows;
    int ysrc; const bf16_t* y;
    const unsigned char* mo8; const int* tslot; const float* tgate; int sharedbase;
    const float* gpost; const float* modx; const float* modc; int gate_chunk;
    bool doH; bf16_t* H; const float* gpre; int sc_chunk, sh_chunk; const float* modxH; const float* modcH;
};
__device__ __forceinline__ void row_phase(const Frame& F, const RowPhase& P) {
    const int gw = F.vcu * NWAVES + F.wave, NGW = F.G * NWAVES, lane = F.lane;
    for (int row = gw; row < P.nrows; row += NGW) {
        const bool lat = row < NX; const int b = lat ? (row >> 11) : 0;
        const float* mod = lat ? P.modx + (size_t)b * ADA : P.modc;
        const float* xr = lat ? P.xin_lat + (size_t)row * D : P.xin_ctx + (size_t)(row - NX) * D;
        f32x4 x[4];
#pragma unroll
        for (int j = 0; j < 4; ++j) x[j] = ld4(xr + 4 * lane + 256 * j);
        if (P.ysrc) {
            f32x4 y[4];
            if (P.ysrc == 1) {
#pragma unroll
                for (int j = 0; j < 4; ++j) { const u32x2 w = *(const u32x2*)(P.y + (size_t)row * D + 4 * lane + 256 * j); y[j] = (f32x4){bflo(w.x), bfhi(w.x), bflo(w.y), bfhi(w.y)}; }
            } else {
#pragma unroll
                for (int j = 0; j < 4; ++j) { const int w = *(const int*)(P.mo8 + (size_t)(P.sharedbase + row) * D + 4 * lane + 256 * j); const f32x2 lo = __builtin_amdgcn_cvt_pk_f32_fp8(w, false), hi = __builtin_amdgcn_cvt_pk_f32_fp8(w, true); y[j] = (f32x4){lo.x, lo.y, hi.x, hi.y} * F8_INV; }
#pragma unroll
                for (int k = 0; k < TOPK; ++k) { const int sl = P.tslot[(size_t)row * 8 + k]; const float g = P.tgate[(size_t)row * 8 + k] * F8_INV;
#pragma unroll
                    for (int j = 0; j < 4; ++j) { const int w = *(const int*)(P.mo8 + (size_t)sl * D + 4 * lane + 256 * j); const f32x2 lo = __builtin_amdgcn_cvt_pk_f32_fp8(w, false), hi = __builtin_amdgcn_cvt_pk_f32_fp8(w, true);
                        y[j].x += g * lo.x; y[j].y += g * lo.y; y[j].z += g * hi.x; y[j].w += g * hi.y; } }
            }
            const float rs = row_rms_scale(y);
#pragma unroll
            for (int j = 0; j < 4; ++j) { const f32x4 gp = ld4(P.gpost + 4 * lane + 256 * j), gt = ld4(mod + P.gate_chunk * D + 4 * lane + 256 * j); x[j] = x[j] + gt * (y[j] * rs * gp); }
            float* xo = lat ? P.xout_lat + (size_t)row * D : P.xout_ctx + (size_t)(row - NX) * D;
#pragma unroll
            for (int j = 0; j < 4; ++j) *(f32x4*)(xo + 4 * lane + 256 * j) = x[j];
        }
        if (P.doH) {
            const float rs = row_rms_scale(x); const float* modh = lat ? P.modxH + (size_t)b * ADA : P.modcH;
#pragma unroll
            for (int j = 0; j < 4; ++j) { const f32x4 gp = ld4(P.gpre + 4 * lane + 256 * j), sc = ld4(modh + P.sc_chunk * D + 4 * lane + 256 * j), sh = ld4(modh + P.sh_chunk * D + 4 * lane + 256 * j);
                const f32x4 h = x[j] * rs * gp * (sc + 1.0f) + sh; u32x2 w; w.x = pk2(h.x, h.y); w.y = pk2(h.z, h.w);
                *(u32x2*)(P.H + (size_t)row * D + 4 * lane + 256 * j) = w; }
        }
    }
}


#ifndef MK_STAG
#define MK_STAG 0
#endif
__device__ __forceinline__ void stagger_delay(const Frame& F, int step) {
    if (step <= 0) return;
    const unsigned long long t0 = __builtin_amdgcn_s_memrealtime(); const unsigned long long d = (unsigned long long)((F.vcu & 7) * step);
    while (__builtin_amdgcn_s_memrealtime() - t0 < d) __builtin_amdgcn_s_sleep(4);
}
__device__ __forceinline__ void p0_ada(const Frame& F, const Args& a) {
    LAS float* sc = (LAS float*)F.lds;
    if ((int)blockIdx.x >= 96) return;
    for (int i = F.tid; i < 17 * D; i += NTHREADS) { const int r = i >> 10, k = i & 1023; const float v = r < 16 ? a.in[1][r * D + k] : a.in[3][k]; sc[i] = siluf_(v); }
    __syncthreads();
    const int item = blockIdx.x; const int layer = item / 48, cg = item % 48;
    const int cq = F.tid & 31, kl = F.tid >> 5;
    const float* W = a.in[4] + (size_t)layer * D * ADA + cg * 128 + cq * 4;
    f32x4 acc[17];
#pragma unroll
    for (int r = 0; r < 17; ++r) acc[r] = (f32x4){0.f, 0.f, 0.f, 0.f};
    for (int k = kl; k < D; k += 16) {
        const f32x4 w = ld4(W + (size_t)k * ADA);
#pragma unroll
        for (int r = 0; r < 17; ++r) { const float s = sc[r * D + k]; acc[r] = acc[r] + w * s; }
    }
#pragma unroll
    for (int r = 0; r < 17; ++r) { acc[r].x += __shfl_xor(acc[r].x, 32); acc[r].y += __shfl_xor(acc[r].y, 32); acc[r].z += __shfl_xor(acc[r].z, 32); acc[r].w += __shfl_xor(acc[r].w, 32); }
    __syncthreads();
    LAS f32x4* red = (LAS f32x4*)F.lds;
    if (F.lane < 32) {
#pragma unroll
        for (int r = 0; r < 17; ++r) red[(F.wave * 17 + r) * 32 + cq] = acc[r];
    }
    __syncthreads();
    for (int i = F.tid; i < 17 * 32; i += NTHREADS) { const int r = i >> 5, q = i & 31; f32x4 s = red[r * 32 + q];
#pragma unroll
        for (int w = 1; w < 8; ++w) s = s + red[(w * 17 + r) * 32 + q];
        const int col = cg * 128 + q * 4; s = s + ld4(a.in[5] + (size_t)layer * ADA + col);
        float* dst = r < 16 ? (float*)(F.ws + WS_MODX) + ((size_t)layer * 16 + r) * ADA + col : (float*)(F.ws + WS_MODC) + (size_t)layer * ADA + col;
        *(f32x4*)dst = s; }
    __syncthreads();
}

__device__ __forceinline__ void p0_convert(const Frame& F, const Args& a) {
    LAS unsigned* T = (LAS unsigned*)(F.lds + 70 * 1024) + F.wave * (64 * 33);
    const int gw = F.vcu * NWAVES + F.wave, NGW = F.G * NWAVES, lane = F.lane;
    bf16_t* win0 = (bf16_t*)(F.ws + WS_WIN0); bf16_t* wout0 = (bf16_t*)(F.ws + WS_WOUT0); bf16_t* wqkv1 = (bf16_t*)(F.ws + WS_WQKV1); bf16_t* wout1 = (bf16_t*)(F.ws + WS_WOUT1); bf16_t* wr = (bf16_t*)(F.ws + WS_WR);
    constexpr int I_IN = 16 * (4 + 4 + 8 + 8 + 1 + 16);
    constexpr int I_SQ = 16 * 16, I_QKV = 16 * 48, I_R = 16 * 4;
    constexpr int NIT = I_IN + I_SQ + I_QKV + I_SQ + 2 * I_R;
    for (int it = gw; it < NIT + MOE_CVT_ITEMS; it += NGW) {
        int r = it;
        if (r < I_IN) {
            const int kt = r & 15, g = r >> 4; int col0, nc = 64, drow;
            if (g < 24) { col0 = 64 * g; drow = 64 * g; }
            else if (g == 24) { col0 = 1536; nc = 32; drow = 2560; }
            else { const int s = g - 25; const int isb = s >> 3, q = s & 7;
                col0 = 1568 + 512 * isb + 64 * q; drow = 1536 + 256 * (q >> 1) + 128 * isb + 64 * (q & 1); }
            cvt_item(a.in[10], AB_IN, col0, nc, kt * 64, win0, D, drow, T, lane); continue; }
        r -= I_IN;
        if (r < I_SQ) { cvt_matrix_item(a.in[11], D, 0, D, D, wout0, 0, r, T, lane); continue; } r -= I_SQ;
        if (r < I_QKV) { cvt_matrix_item(a.in[21], 3 * D, 0, 3 * D, D, wqkv1, 0, r, T, lane); continue; } r -= I_QKV;
        if (r < I_SQ) { cvt_matrix_item(a.in[22], D, 0, D, D, wout1, 0, r, T, lane); continue; } r -= I_SQ;
        if (r < 2 * I_R) { const int l = r / I_R; cvt_matrix_item(a.in[24] + (size_t)l * D * NEXP, NEXP, 0, NEXP, D, wr + (size_t)l * NEXP * D, 0, r % I_R, T, lane); continue; } r -= 2 * I_R;
        cvt_moe_item(a, 0, r, F.ws, T, lane);
    }
    { u32x4 z = (u32x4){0u, 0u, 0u, 0u}; const size_t n16 = (size_t)(AB_INP - AB_IN) * D * 2 / 16; u32x4* p = (u32x4*)(win0 + (size_t)AB_IN * D);
      for (size_t i = (size_t)blockIdx.x * NTHREADS + F.tid; i < n16; i += (size_t)F.G * NTHREADS) p[i] = z; }
    if (blockIdx.x == 0) { f32x2* rt = (f32x2*)(F.ws + WS_ROPE);
        for (int i = F.tid; i < 64 * 16; i += NTHREADS) { const int pos = i >> 4, f = i & 15; const float inv = powf(10000.0f, -(float)f / 16.0f); const float ang = (float)pos * inv; rt[i] = (f32x2){cosf(ang), sinf(ang)}; } }
}


constexpr int GP = 144;
constexpr int GARR = 64 * GP;
constexpr int G_QE = 0, G_KE = GARR, G_QIN = 2 * GARR, G_KOT = 3 * GARR, G_VT = 4 * GARR, G_PAR = 5 * GARR;
constexpr int G_A = 2 * G_PAR, G_ST = G_A + GARR, G_DEC = G_ST + GARR, G_DW = G_DEC + 512, G_DB = G_DW + 4096, G_END = G_DB + 256;
static_assert(G_END <= RING_BYTES, "gla lds");
struct GlaRaw { u32x4 q, k, v; f32x4 lr[4]; };
__device__ __forceinline__ int gla_row(int n, int p, int b, int d) {
    const bool isctx = n < 4; const int j = isctx ? n : n - 4; int pos = j * 64 + p;
    if (d) pos = (isctx ? CTXL : SEQ) - 1 - pos;
    return isctx ? NX + b * CTXL + pos : b * SEQ + pos;
}
__device__ __forceinline__ void gla_load(GlaRaw& R, int n, int lane, int w, int b, int h, int d, int vh, const bf16_t* qb, const bf16_t* kb, const bf16_t* vb, const float* lr) {
    const int row = gla_row(n, lane, b, d);
    R.q = *(const u32x4*)(qb + (size_t)row * 256 + h * 64 + 8 * w);
    R.k = *(const u32x4*)(kb + (size_t)row * 256 + h * 64 + 8 * w);
    R.v = *(const u32x4*)(vb + (size_t)row * 512 + h * 128 + vh * 64 + 8 * w);
#pragma unroll
    for (int i = 0; i < 4; ++i) R.lr[i] = *(const f32x4*)(lr + (size_t)row * 32 + d * 16 + 4 * i);
}
__device__ __forceinline__ void unpack8(const u32x4& w, float (&f)[8]) { f[0] = bflo(w.x); f[1] = bfhi(w.x); f[2] = bflo(w.y); f[3] = bfhi(w.y); f[4] = bflo(w.z); f[5] = bfhi(w.z); f[6] = bflo(w.w); f[7] = bfhi(w.w); }
__device__ __forceinline__ void gla_phase(const Frame& F, const Args& a) {
    LAS unsigned char* L = F.lds; const int lane = F.lane, w = F.wave, r16 = lane & 15, g4 = lane >> 4;
    const bf16_t* qb = (const bf16_t*)(F.ws + T_QB); const bf16_t* kb = (const bf16_t*)(F.ws + T_KB); const bf16_t* vb = (const bf16_t*)(F.ws + T_VB); const float* lrb = (const float*)(F.ws + T_LR);
    for (int it = blockIdx.x; it < 256; it += F.G) {
        const int b = it >> 4, h = (it >> 2) & 3, d = (it >> 1) & 1, vh = it & 1;
        bf16_t* ob = (bf16_t*)(F.ws + (d ? T_OB : T_OF));
        const float* dw = d ? a.in[14] : a.in[12]; const float* db = d ? a.in[15] : a.in[13];
        __syncthreads();
        for (int i = F.tid; i < 16 * 64; i += NTHREADS) ((LAS float*)(L + G_DW))[i] = dw[(i >> 6) * GLA_QK + h * 64 + (i & 63)];
        if (F.tid < 64) ((LAS float*)(L + G_DB))[F.tid] = db[h * 64 + F.tid];
        for (int i = F.tid; i < GARR / 4; i += NTHREADS) ((LAS unsigned*)(L + G_ST))[i] = 0u;
        f32x4 Sacc[2] = {(f32x4){0.f, 0.f, 0.f, 0.f}, (f32x4){0.f, 0.f, 0.f, 0.f}};
        GlaRaw R; gla_load(R, 0, lane, w, b, h, d, vh, qb, kb, vb, lrb);
        __syncthreads();
        for (int n = 0; n < 36; ++n) {
            LAS unsigned char* PB = L + (n & 1) * G_PAR;
            {
                float z[8], q[8], k[8], v[8];
                unpack8(R.q, q); unpack8(R.k, k); unpack8(R.v, v);
                const LAS float* DW = (const LAS float*)(L + G_DW); const LAS float* DB = (const LAS float*)(L + G_DB);
#pragma unroll
                for (int j = 0; j < 8; ++j) z[j] = DB[8 * w + j];
#pragma unroll
                for (int r = 0; r < 16; ++r) { const float x = R.lr[r >> 2][r & 3]; const f32x4 w0 = *(const LAS f32x4*)(DW + r * 64 + 8 * w), w1 = *(const LAS f32x4*)(DW + r * 64 + 8 * w + 4);
                    z[0] += x * w0.x; z[1] += x * w0.y; z[2] += x * w0.z; z[3] += x * w0.w; z[4] += x * w1.x; z[5] += x * w1.y; z[6] += x * w1.z; z[7] += x * w1.w; }
                u32x4 wqe, wke, wqi; unsigned short ko[8];
                float qe[8], ke[8], qi[8];
#pragma unroll
                for (int j = 0; j < 8; ++j) {
                    float ld = (fminf(z[j], 0.f) - __logf(1.0f + __expf(-fabsf(z[j])))) * (1.0f / 16.0f);
#pragma unroll
                    for (int o = 1; o < 64; o <<= 1) { const float t = __shfl_up(ld, o); if (lane >= o) ld += t; }
                    const float bm = __shfl(ld, 31), bl = __shfl(ld, 63);
                    qe[j] = q[j] * __expf(ld - bm); ke[j] = k[j] * __expf(bm - ld); qi[j] = q[j] * __expf(ld); ko[j] = (unsigned short)f2bf(k[j] * __expf(bl - ld));
                    if (lane == 0) ((LAS float*)(L + G_DEC))[(n & 1) * 64 + 8 * w + j] = __expf(bl);
                }
                wqe = (u32x4){pk2(qe[0], qe[1]), pk2(qe[2], qe[3]), pk2(qe[4], qe[5]), pk2(qe[6], qe[7])};
                wke = (u32x4){pk2(ke[0], ke[1]), pk2(ke[2], ke[3]), pk2(ke[4], ke[5]), pk2(ke[6], ke[7])};
                wqi = (u32x4){pk2(qi[0], qi[1]), pk2(qi[2], qi[3]), pk2(qi[4], qi[5]), pk2(qi[6], qi[7])};
                *(LAS u32x4*)(PB + G_QE + lane * GP + 16 * w) = wqe; *(LAS u32x4*)(PB + G_KE + lane * GP + 16 * w) = wke; *(LAS u32x4*)(PB + G_QIN + lane * GP + 16 * w) = wqi;
#pragma unroll
                for (int j = 0; j < 8; ++j) { *(LAS unsigned short*)(PB + G_KOT + (8 * w + j) * GP + 2 * lane) = ko[j]; *(LAS unsigned short*)(PB + G_VT + (8 * w + j) * GP + 2 * lane) = (unsigned short)f2bf(v[j]); }
            }
            if (n + 1 < 36) gla_load(R, n + 1, lane, w, b, h, d, vh, qb, kb, vb, lrb);
            lds_barrier();
#pragma unroll
            for (int i = 0; i < 2; ++i) { const int tI = 2 * w + i, st = tI >> 2, pt = tI & 3;
                f32x4 c = (f32x4){0.f, 0.f, 0.f, 0.f};
                if (st <= pt) {
#pragma unroll
                    for (int ks = 0; ks < 2; ++ks) { const bf16x8 af = *(const LAS bf16x8*)(PB + G_KE + (16 * st + r16) * GP + (32 * ks + 8 * g4) * 2), bfr = *(const LAS bf16x8*)(PB + G_QE + (16 * pt + r16) * GP + (32 * ks + 8 * g4) * 2);
                        c = __builtin_amdgcn_mfma_f32_16x16x32_bf16(af, bfr, c, 0, 0, 0); }
                    const int p = 16 * pt + r16, s0 = 16 * st + 4 * g4;
#pragma unroll
                    for (int e = 0; e < 4; ++e) if (s0 + e > p) c[e] = 0.f;
                }
                u32x2 o; o.x = pk2(c[0], c[1]); o.y = pk2(c[2], c[3]);
                *(LAS u32x2*)(L + G_A + (16 * pt + r16) * GP + (16 * st + 4 * g4) * 2) = o; }
            lds_barrier();
#pragma unroll
            for (int i = 0; i < 2; ++i) { const int tI = 2 * w + i, vt = tI >> 2, pt = tI & 3;
                f32x4 c = (f32x4){0.f, 0.f, 0.f, 0.f};
#pragma unroll
                for (int ks = 0; ks < 2; ++ks) {
                    const bf16x8 a1 = *(const LAS bf16x8*)(PB + G_VT + (16 * vt + r16) * GP + (32 * ks + 8 * g4) * 2), b1 = *(const LAS bf16x8*)(L + G_A + (16 * pt + r16) * GP + (32 * ks + 8 * g4) * 2);
                    c = __builtin_amdgcn_mfma_f32_16x16x32_bf16(a1, b1, c, 0, 0, 0);
                    const bf16x8 a2 = *(const LAS bf16x8*)(L + G_ST + (16 * vt + r16) * GP + (32 * ks + 8 * g4) * 2), b2 = *(const LAS bf16x8*)(PB + G_QIN + (16 * pt + r16) * GP + (32 * ks + 8 * g4) * 2);
                    c = __builtin_amdgcn_mfma_f32_16x16x32_bf16(a2, b2, c, 0, 0, 0); }
                const int row = gla_row(n, 16 * pt + r16, b, d);
                u32x2 o; o.x = pk2(c[0], c[1]); o.y = pk2(c[2], c[3]);
                *(u32x2*)(ob + (size_t)row * 512 + h * 128 + vh * 64 + 16 * vt + 4 * g4) = o; }
            lds_barrier();
#pragma unroll
            for (int i = 0; i < 2; ++i) { const int tI = 2 * w + i, ct = tI >> 2, vt = tI & 3;
                const f32x4 dc = *(const LAS f32x4*)(L + G_DEC + ((n & 1) * 64 + 16 * ct + 4 * g4) * 4);
                f32x4 c = Sacc[i] * dc;
#pragma unroll
                for (int ks = 0; ks < 2; ++ks) { const bf16x8 af = *(const LAS bf16x8*)(PB + G_KOT + (16 * ct + r16) * GP + (32 * ks + 8 * g4) * 2), bfr = *(const LAS bf16x8*)(PB + G_VT + (16 * vt + r16) * GP + (32 * ks + 8 * g4) * 2);
                    c = __builtin_amdgcn_mfma_f32_16x16x32_bf16(af, bfr, c, 0, 0, 0); }
                Sacc[i] = c;
                u32x2 o; o.x = pk2(c[0], c[1]); o.y = pk2(c[2], c[3]);
                *(LAS u32x2*)(L + G_ST + (16 * vt + r16) * GP + (16 * ct + 4 * g4) * 2) = o; }
        }
    }
    __syncthreads();
}

__device__ __forceinline__ void finish_conv_phase(const Frame& F, const Args& a) {
    const int lane = F.lane; bf16_t* cat = (bf16_t*)(F.ws + T_CAT);
    {
        const bf16_t* of = (const bf16_t*)(F.ws + T_OF); const bf16_t* obk = (const bf16_t*)(F.ws + T_OB); const bf16_t* gb = (const bf16_t*)(F.ws + T_GB);
        const int gw = F.vcu * NWAVES + F.wave, NGW = F.G * NWAVES;
        float gg[8];
#pragma unroll
        for (int j = 0; j < 8; ++j) gg[j] = a.in[16][8 * lane + j];
        for (int row = gw; row < NT; row += NGW) {
            float x[8], y[8], g[8];
            unpack8(*(const u32x4*)(of + (size_t)row * 512 + 8 * lane), x); unpack8(*(const u32x4*)(obk + (size_t)row * 512 + 8 * lane), y); unpack8(*(const u32x4*)(gb + (size_t)row * 512 + 8 * lane), g);
            float ss = 0.f;
#pragma unroll
            for (int j = 0; j < 8; ++j) { x[j] += y[j]; ss += x[j] * x[j]; }
            ss += __shfl_xor(ss, 1); ss += __shfl_xor(ss, 2); ss += __shfl_xor(ss, 4); ss += __shfl_xor(ss, 8);
            const float rs = rsqrtf(ss * (1.0f / 128.0f) + RMS_EPS);
#pragma unroll
            for (int j = 0; j < 8; ++j) x[j] = x[j] * rs * gg[j] * siluf_(g[j]);
            *(u32x4*)(cat + (size_t)row * D + 8 * lane) = (u32x4){pk2(x[0], x[1]), pk2(x[2], x[3]), pk2(x[4], x[5]), pk2(x[6], x[7])};
        }
    }
    {
        const bf16_t* ub = (const bf16_t*)(F.ws + T_UB); LAS float* tile = (LAS float*)F.lds;
        const int c = F.tid;
        float wv[CONV_W];
#pragma unroll
        for (int j = 0; j < CONV_W; ++j) wv[j] = a.in[17][j * CONV_CH + c];
        const float cb = a.in[18][c];
        float lg[8], lb[8];
#pragma unroll
        for (int i = 0; i < 8; ++i) { lg[i] = a.in[19][lane + 64 * i]; lb[i] = a.in[20][lane + 64 * i]; }
        for (int ti = blockIdx.x; ti < NT / 32; ti += F.G) {
            const int row0 = ti * 32; const bool lat = row0 < NX;
            const int t0 = lat ? (row0 & (SEQ - 1)) : ((row0 - NX) & (CTXL - 1)); const int len = lat ? SEQ : CTXL; const int sbase = row0 - t0;
            float in[62];
            unsigned short raw[62];
#pragma unroll
            for (int i = 0; i < 62; ++i) { int t = t0 - 15 + i; t = t < 0 ? 0 : (t >= len ? len - 1 : t); raw[i] = ub[(size_t)(sbase + t) * 512 + c]; }
#pragma unroll
            for (int i = 0; i < 62; ++i) { const int t = t0 - 15 + i; in[i] = (t >= 0 && t < len) ? bf2f(raw[i]) : 0.f; }
            __syncthreads();
#pragma unroll
            for (int t = 0; t < 32; ++t) { float s = cb;
#pragma unroll
                for (int j = 0; j < CONV_W; ++j) s += wv[j] * in[t + j];
                tile[t * 512 + c] = s; }
            __syncthreads();
#pragma unroll
            for (int q = 0; q < 4; ++q) { const int t = 4 * F.wave + q; float v[8]; float s = 0.f;
#pragma unroll
                for (int i = 0; i < 8; ++i) { v[i] = tile[t * 512 + lane + 64 * i]; s += v[i]; }
                const float mu = wave_sum(s) * (1.0f / 512.0f); float qq = 0.f;
#pragma unroll
                for (int i = 0; i < 8; ++i) { v[i] -= mu; qq += v[i] * v[i]; }
                const float rstd = rsqrtf(wave_sum(qq) * (1.0f / 512.0f) + LN_EPS);
#pragma unroll
                for (int i = 0; i < 8; ++i) { const float y = v[i] * rstd * lg[i] + lb[i]; cat[(size_t)(row0 + t) * D + 512 + lane + 64 * i] = (bf16_t)f2bf(siluf_(y)); } }
        }
        __syncthreads();
    }
}


constexpr int CW_TST = 20480;
constexpr int AUX_TST = AUX_OFF, AUX_TILEE = AUX_OFF + 1040, AUX_IDX = AUX_OFF + 1168;
constexpr int MOE_MAXU = 32, MOE_MAXIDX = 16;
static_assert(AUX_IDX + MOE_MAXIDX * 1024 <= MISC_OFF, "aux lds");

struct EpiRouter {
    static constexpr bool PERM = false, AFTER_DRAIN = true;
    const float* rbias; int* asg_e; int* asg_r; float* asg_g; unsigned* counts;
    __device__ __forceinline__ void operator()(const f32x4 (&)[2][2][4][2], const Unit&, int, int, int, int) const {}
    __device__ __forceinline__ void fused(const f32x4 (&acc)[2][2][4][2], const Unit& u, int wr, int wc, int fr, int fq, LAS unsigned char* lds, int wid, int lane) const {
        LAS float* SC = (LAS float*)lds;
        LAS unsigned* lcnt = (LAS unsigned*)(lds + 66560); LAS unsigned* lbase = lcnt + 256;
        LAS int* selE = (LAS int*)(lbase + 256); LAS int* selR = selE + 2048;
        const int tid = wid * 64 + lane;
        if (tid < 256) lcnt[tid] = 0u;
        const f32x4 rb = *(const f32x4*)(rbias + 4 * lane);
        const float NINF = -__builtin_inff();
#pragma unroll
        for (int ai = 0; ai < 2; ++ai)
#pragma unroll
            for (int mm = 0; mm < 2; ++mm) {
                LDS_WAIT(); __builtin_amdgcn_s_barrier(); asm volatile("" ::: "memory");
#pragma unroll
                for (int mi = 0; mi < 2; ++mi) { const int lr = 32 * wr + 16 * mi + fr;
#pragma unroll
                    for (int bj = 0; bj < 2; ++bj)
#pragma unroll
                        for (int n = 0; n < 2; ++n) *(LAS f32x4*)(SC + lr * 260 + 128 * bj + 32 * wc + 16 * n + 4 * fq) = acc[ai][bj][2 * mm + mi][n]; }
                LDS_WAIT(); __builtin_amdgcn_s_barrier(); asm volatile("" ::: "memory");
                for (int q = 0; q < 8; ++q) {
                    const int lr = 8 * wid + q; const int rit = 128 * ai + 64 * (lr >> 5) + 16 * (2 * mm + ((lr >> 4) & 1)) + (lr & 15);
                    const f32x4 lg = *(const LAS f32x4*)(SC + lr * 260 + 4 * lane);
                    float s[4], cd[4];
#pragma unroll
                    for (int j = 0; j < 4; ++j) { s[j] = 1.0f / (1.0f + __expf(-lg[j])); cd[j] = s[j] + rb[j]; }
                    float m1 = fmaxf(cd[0], cd[1]), m2 = fminf(cd[0], cd[1]);
                    { const float x = cd[2]; const float n1 = fmaxf(m1, x); m2 = fmaxf(fminf(m1, x), m2); m1 = n1; }
                    { const float x = cd[3]; const float n1 = fmaxf(m1, x); m2 = fmaxf(fminf(m1, x), m2); m1 = n1; }
#pragma unroll
                    for (int o = 1; o < 8; o <<= 1) { const float a1 = __shfl_xor(m1, o), a2 = __shfl_xor(m2, o); const float n1 = fmaxf(m1, a1); m2 = fmaxf(fminf(m1, a1), fmaxf(m2, a2)); m1 = n1; }
                    const float gs = m1 + m2; const int mygrp = lane >> 3; int rank = 0;
#pragma unroll
                    for (int g = 0; g < 8; ++g) { const float og = __shfl(gs, 8 * g); rank += (og > gs || (og == gs && g < mygrp)) ? 1 : 0; }
                    if (rank >= 4) { cd[0] = NINF; cd[1] = NINF; cd[2] = NINF; cd[3] = NINF; }
                    int myE = 0; float myG = 0.f; float gsum = 0.f;
#pragma unroll
                    for (int k = 0; k < TOPK; ++k) {
                        float bv = cd[0]; int bi = 0;
                        if (cd[1] > bv) { bv = cd[1]; bi = 1; } if (cd[2] > bv) { bv = cd[2]; bi = 2; } if (cd[3] > bv) { bv = cd[3]; bi = 3; }
                        float v = bv; int ix = 4 * lane + bi;
#pragma unroll
                        for (int o = 32; o >= 1; o >>= 1) { const float ov = __shfl_xor(v, o); const int oi = __shfl_xor(ix, o); if (ov > v || (ov == v && oi < ix)) { v = ov; ix = oi; } }
                        const int sl = ix & 3; const float mys = sl == 0 ? s[0] : (sl == 1 ? s[1] : (sl == 2 ? s[2] : s[3]));
                        const float gv = __shfl(mys, ix >> 2);
                        gsum += gv;
                        if (lane == k) { myE = ix; myG = gv; }
                        if (lane == (ix >> 2)) { if (sl == 0) cd[0] = NINF; else if (sl == 1) cd[1] = NINF; else if (sl == 2) cd[2] = NINF; else cd[3] = NINF; }
                    }
                    if (lane < TOPK) { const unsigned r = __hip_atomic_fetch_add(&lcnt[myE], 1u, __ATOMIC_RELAXED, __HIP_MEMORY_SCOPE_WORKGROUP); selE[rit * 8 + lane] = myE; selR[rit * 8 + lane] = (int)r; asg_g[(size_t)(u.orow + rit) * 8 + lane] = myG / gsum * 2.5f; }
                }
            }
        LDS_WAIT(); __builtin_amdgcn_s_barrier(); asm volatile("" ::: "memory");
        if (tid < 256) { const unsigned c = lcnt[tid]; lbase[tid] = c ? atomicAdd(&counts[tid], c) : 0u; }
        LDS_WAIT(); __builtin_amdgcn_s_barrier(); asm volatile("" ::: "memory");
        for (int i = tid; i < 2048; i += NTHREADS) { const int e = selE[i]; asg_e[(size_t)u.orow * 8 + i] = e; asg_r[(size_t)u.orow * 8 + i] = (int)lbase[e] + selR[i]; }
    }
};

__device__ __forceinline__ void moe_place(const Frame& F, int layer, int ntok) {
    LAS int* cnt = (LAS int*)F.lds; LAS int* tst = cnt + 256;
    const unsigned* counts = F.ctl + CW_CNT + layer * 256;
    const int* asg_e = (const int*)(F.ws + M_AE); const int* asg_r = (const int*)(F.ws + M_AR); int* tslot = (int*)(F.ws + M_TS); int* stok = (int*)(F.ws + M_ST);
    __syncthreads();
    if (F.tid < 256) cnt[F.tid] = (int)counts[F.tid];
    __syncthreads();
    if (F.tid == 0) { int acc = 0; for (int e = 0; e < 256; ++e) { tst[e] = acc; acc += (cnt[e] + 255) >> 8; } tst[256] = acc; }
    __syncthreads();
    const int ntr = tst[256];
    if (blockIdx.x == 0) for (int i = F.tid; i < 257; i += NTHREADS) F.ctl[CW_TST + layer * 320 + i] = (unsigned)tst[i];
    const int gt = blockIdx.x * NTHREADS + F.tid, gs = F.G * NTHREADS;
    for (int i = gt; i < ntok * 8; i += gs) { const int e = asg_e[i]; const int slot = tst[e] * 256 + asg_r[i]; stok[slot] = i >> 3; tslot[i] = slot; }
    for (int e = blockIdx.x; e < 256; e += F.G) { const int s0 = tst[e] * 256 + cnt[e], s1 = tst[e + 1] * 256; for (int s = s0 + F.tid; s < s1; s += NTHREADS) stok[s] = 0; }
    for (int i = gt; i < ntok; i += gs) stok[ntr * 256 + i] = i;
    __syncthreads();
}

template <int NCOL>
__device__ __forceinline__ int moe_units_setup(const Frame& F, int layer, int ntok, int c, bool want_idx) {
    LAS int* tst = (LAS int*)(F.lds + AUX_TST); LAS int* tileE = (LAS int*)(F.lds + AUX_TILEE); LAS int* idxl = (LAS int*)(F.lds + AUX_IDX);
    __syncthreads();
    for (int i = F.tid; i < 257; i += NTHREADS) tst[i] = (int)F.ctl[CW_TST + layer * 320 + i];
    __syncthreads();
    const int ntr = tst[256], nunits = (ntr + ntok / 256) * NCOL;
    int nu = c < nunits ? (nunits - c + F.G - 1) / F.G : 0; if (nu > MOE_MAXU) nu = MOE_MAXU; if (want_idx && nu > MOE_MAXIDX) nu = MOE_MAXIDX;
    if (F.tid < nu) { const int rt = (c + F.tid * F.G) / NCOL; int e;
        if (rt >= ntr) e = NEXP; else { int lo = 0, hi = 255; while (lo < hi) { const int mid = (lo + hi + 1) >> 1; if (tst[mid] <= rt) lo = mid; else hi = mid - 1; } e = lo; }
        tileE[F.tid] = e; }
    if (want_idx) { const int* stok = (const int*)(F.ws + M_ST); for (int i = F.tid; i < nu * 256; i += NTHREADS) idxl[i] = stok[(size_t)((c + (i >> 8) * F.G) / NCOL) * 256 + (i & 255)]; }
    __syncthreads();
    return nu;
}
struct SchedMoeGU {
    const char* A; const char* W; const LAS int* tileE; const LAS int* idxl; int nu, G, c;
    __device__ __forceinline__ bool next(int i, Unit& u) const {
        if (i >= nu) return false; const int un = c + i * G; const int rt = un >> 1, col = un & 1; const int e = tileE[i];
        u.a = i; u.b = e * 512 + col * 256; u.orow = rt * 256; u.ocol = col * 128; u.aux = e; return true; }
    __device__ __forceinline__ const char* a_base() const { return A; }
    __device__ __forceinline__ const char* b_ptr(const Unit& u) const { return W + (size_t)u.b * D * 2; }
    __device__ __forceinline__ void a_off(const Unit& u, const int (&R)[2], const int (&C)[2], unsigned (&o0)[2], unsigned (&o1)[2]) const {
#pragma unroll
        for (int i = 0; i < 2; ++i) { const int t0 = idxl[u.a * 256 + R[i]], t1 = idxl[u.a * 256 + 128 + R[i]]; o0[i] = (unsigned)t0 * (unsigned)(D * 2) + (unsigned)C[i] * 2u; o1[i] = (unsigned)t1 * (unsigned)(D * 2) + (unsigned)C[i] * 2u; }
    }
};
struct EpiGateUp {
    static constexpr bool PERM = true, AFTER_DRAIN = false;
    bf16_t* hid;
    __device__ __forceinline__ void operator()(const f32x4 (&acc)[2][2][4][2], const Unit& u, int wr, int wc, int fr, int fq) const {
        const int lane = fr + 16 * fq; const int srcb = ((lane >> 2) + 16 * (lane & 3)) << 2;
        const int row0 = u.orow + wr * 64 + (lane >> 2), col0 = u.ocol + wc * 32 + 8 * (lane & 3);
#pragma unroll
        for (int ai = 0; ai < 2; ++ai)
#pragma unroll
            for (int m = 0; m < 4; ++m) { float h[8];
#pragma unroll
                for (int n = 0; n < 2; ++n)
#pragma unroll
                    for (int e = 0; e < 4; ++e) { const float g = acc[ai][0][m][n][e], up = acc[ai][1][m][n][e]; h[4 * n + e] = g / (1.0f + __expf(-g)) * up; }
                u32x4 w; w.x = cvt_pk_bf16(h[0], h[1]); w.y = cvt_pk_bf16(h[2], h[3]); w.z = cvt_pk_bf16(h[4], h[5]); w.w = cvt_pk_bf16(h[6], h[7]);
                u32x4 t; t.x = (unsigned)__builtin_amdgcn_ds_bpermute(srcb, (int)w.x); t.y = (unsigned)__builtin_amdgcn_ds_bpermute(srcb, (int)w.y); t.z = (unsigned)__builtin_amdgcn_ds_bpermute(srcb, (int)w.z); t.w = (unsigned)__builtin_amdgcn_ds_bpermute(srcb, (int)w.w);
                *(u32x4*)(hid + (size_t)(row0 + ai * 128 + m * 16) * DEXP + col0) = t; }
    }
};
struct SchedMoeDN {
    const char* A; const char* W; const LAS int* tileE; int nu, G, c;
    __device__ __forceinline__ bool next(int i, Unit& u) const {
        if (i >= nu) return false; const int un = c + i * G; const int rt = un >> 2, col = un & 3; const int e = tileE[i];
        u.a = rt; u.b = e * 1024 + col * 256; u.orow = rt * 256; u.ocol = col * 256; u.aux = e; return true; }
    __device__ __forceinline__ const char* a_base() const { return A; }
    __device__ __forceinline__ const char* b_ptr(const Unit& u) const { return W + (size_t)u.b * DEXP * 2; }
    __device__ __forceinline__ void a_off(const Unit& u, const int (&R)[2], const int (&C)[2], unsigned (&o0)[2], unsigned (&o1)[2]) const {
#pragma unroll
        for (int i = 0; i < 2; ++i) { o0[i] = (unsigned)((u.a * 256 + R[i]) * DEXP + C[i]) * 2u; o1[i] = o0[i] + (unsigned)(128 * DEXP * 2); }
    }
};

constexpr int NA_RING = 11, NA_VR = 0, NA_VC = NA_RING * 64 * 128, NA_KC = NA_VC + 256 * 128, NA_RPB = NA_KC + 256 * 128, NA_END = NA_RPB + 15 * 128;
static_assert(NA_END <= MISC_OFF, "na lds");
typedef short s16x4 __attribute__((ext_vector_type(4)));
__device__ __forceinline__ int na_voff(int row, int ch) { return row * 128 + ((((ch >> 1) ^ ((row >> 1) & 3)) << 5) | ((ch & 1) << 4)); }
__device__ __forceinline__ int na_koff(int row, int ch) { return row * 128 + ((ch ^ (row & 7)) << 4); }
template <bool CTX, int TB>
__device__ __forceinline__ void na_seg(LAS unsigned char* L, bf16x8 (&kf)[8][2], const char* knext, unsigned loff, const bf16x8 (&qf)[2], int seg, int r16, int g4, int r0, int band, const int (&boff)[2][4], int rbase,
                                       const int (&voff)[4], f32x4 (&O)[4], float& m_run, float& sum) {
    const float NINF = -__builtin_inff();
    float S[8][4]; float mx = NINF;
#pragma unroll
    for (int t = 0; t < 8; ++t) {
        f32x4 c = (f32x4){0.f, 0.f, 0.f, 0.f};
        if (CTX) {
            const int key = 128 * seg + 16 * t + r16;
            const bf16x8 k0 = *(const LAS bf16x8*)(L + NA_KC + na_koff(key, g4)), k1 = *(const LAS bf16x8*)(L + NA_KC + na_koff(key, 4 + g4));
            c = __builtin_amdgcn_mfma_f32_16x16x32_bf16(k0, qf[0], c, 0, 0, 0); c = __builtin_amdgcn_mfma_f32_16x16x32_bf16(k1, qf[1], c, 0, 0, 0);
#pragma unroll
            for (int e = 0; e < 4; ++e) S[t][e] = c[e];
        } else {
            c = __builtin_amdgcn_mfma_f32_16x16x32_bf16(kf[t][0], qf[0], c, 0, 0, 0); c = __builtin_amdgcn_mfma_f32_16x16x32_bf16(kf[t][1], qf[1], c, 0, 0, 0);
#pragma unroll
            for (int e = 0; e < 4; ++e) S[t][e] = c[e] + *(const LAS float*)(L + rbase + ((TB + t) >> 1) * 128 + boff[t & 1][e]);
        }
        mx = fmaxf(mx, fmaxf(fmaxf(S[t][0], S[t][1]), fmaxf(S[t][2], S[t][3])));
    }
    if (!CTX && TB == 0) {
#pragma unroll
        for (int t = 0; t < 8; ++t) { const char* bt = knext + (size_t)((t >> 1) * 64 + 16 * (t & 1)) * D * 2; kf[t][0] = *(const bf16x8*)(bt + loff); kf[t][1] = *(const bf16x8*)(bt + loff + 64); }
    }
    mx = fmaxf(mx, __shfl_xor(mx, 16)); mx = fmaxf(mx, __shfl_xor(mx, 32));
    const float m_new = fmaxf(m_run, mx); const float alpha = __builtin_amdgcn_exp2f(m_run - m_new); m_run = m_new;
    float ps = 0.f;
#pragma unroll
    for (int t = 0; t < 8; ++t)
#pragma unroll
        for (int e = 0; e < 4; ++e) { const float p = __builtin_amdgcn_exp2f(S[t][e] - m_new); S[t][e] = p; ps += p; }
    ps += __shfl_xor(ps, 16); ps += __shfl_xor(ps, 32);
    sum = sum * alpha + ps;
#pragma unroll
    for (int mt = 0; mt < 4; ++mt) O[mt] = O[mt] * alpha;
#pragma unroll
    for (int j = 0; j < 4; ++j) {
        bf16x8 pb; { const u32x4 ww = (u32x4){cvt_pk_bf16(S[2 * j][0], S[2 * j][1]), cvt_pk_bf16(S[2 * j][2], S[2 * j][3]), cvt_pk_bf16(S[2 * j + 1][0], S[2 * j + 1][1]), cvt_pk_bf16(S[2 * j + 1][2], S[2 * j + 1][3])}; pb = __builtin_bit_cast(bf16x8, ww); }
        int ub;
        if (CTX) ub = NA_VC + (128 * seg + 32 * j) * 128; else ub = NA_VR + (((r0 + TB / 2 + j) % NA_RING) * 64 + band) * 128;
#pragma unroll
        for (int mt = 0; mt < 4; ++mt) {
            const s16x4 a0 = __builtin_amdgcn_ds_read_tr16_b64_v4i16((LAS s16x4*)(L + ub + voff[mt]));
            const s16x4 a1 = __builtin_amdgcn_ds_read_tr16_b64_v4i16((LAS s16x4*)(L + ub + voff[mt] + 16 * 128));
            const bf16x8 av = (bf16x8){a0[0], a0[1], a0[2], a0[3], a1[0], a1[1], a1[2], a1[3]};
            O[mt] = __builtin_amdgcn_mfma_f32_16x16x32_bf16(av, pb, O[mt], 0, 0, 0);
        }
    }
}
__device__ __forceinline__ void na_phase(const Frame& F, const Args& a) {
    LAS unsigned char* L = F.lds; const int lane = F.lane, w = F.wave, r16 = lane & 15, g4 = lane >> 4;
    const bf16_t* qbuf = (const bf16_t*)(F.ws + T_QKV); const bf16_t* kbuf = qbuf + (size_t)NT * D; const bf16_t* vbuf = kbuf + (size_t)NT * D; bf16_t* cat = (bf16_t*)(F.ws + T_CAT);
    const int rr = w >> 2, cb = w & 3; const int band = cb == 0 ? 0 : (cb == 1 ? 8 : (cb == 2 ? 24 : 32));
    const float NINF = -__builtin_inff();
    const int pkey = F.tid >> 3, pch = F.tid & 7;
    int boff[2][4], voff[4];
    { const int qc = 16 * cb + r16; int cs = qc - 8; cs = cs < 0 ? 0 : (cs > 48 ? 48 : cs);
#pragma unroll
      for (int hc = 0; hc < 2; ++hc)
#pragma unroll
          for (int e = 0; e < 4; ++e) { const int kc = band + 16 * hc + 4 * g4 + e; const bool ok = kc >= cs && kc < cs + 16; boff[hc][e] = (ok ? kc - qc + 15 : 31) * 4; }
      const int rl = 4 * g4 + (r16 >> 2), sw = (rl >> 1) & 3;
#pragma unroll
      for (int mt = 0; mt < 4; ++mt) voff[mt] = rl * 128 + ((mt ^ sw) << 5) + 8 * (r16 & 3); }
    for (int bh = blockIdx.x; bh < BATCH * NA_H; bh += F.G) {
        const int b = bh >> 4, h = bh & 15;
        __syncthreads();
        for (int i = F.tid; i < 15 * 32; i += NTHREADS) { const int ri = i >> 5, ci = i & 31; ((LAS float*)(L + NA_RPB))[i] = ci < 31 ? a.in[23][h * 465 + ri * 31 + ci] * 1.4426950408889634f : NINF; }
        for (int i = F.tid; i < 256 * 8; i += NTHREADS) { const int key = i >> 3, ch = i & 7; const size_t g = (size_t)(NX + b * CTXL + key) * D + h * 64 + ch * 8;
            *(LAS u32x4*)(L + NA_VC + na_voff(key, ch)) = *(const u32x4*)(vbuf + g); *(LAS u32x4*)(L + NA_KC + na_koff(key, ch)) = *(const u32x4*)(kbuf + g); }
        for (int gr = 0; gr < 9; ++gr) *(LAS u32x4*)(L + NA_VR + na_voff(gr * 64 + pkey, pch)) = *(const u32x4*)(vbuf + (size_t)(b * SEQ + gr * 64 + pkey) * D + h * 64 + pch * 8);
        for (int rp = 0; rp < 16; ++rp) {
            int R0 = 2 * rp - 4; R0 = R0 < 0 ? 0 : (R0 > 24 ? 24 : R0);
            int R0n = 2 * rp - 2; R0n = R0n < 0 ? 0 : (R0n > 24 ? 24 : R0n);
            const bool newrows = (rp < 15) && (R0n != R0);
            u32x4 nv0 = (u32x4){0u, 0u, 0u, 0u}, nv1 = nv0;
            if (newrows) { nv0 = *(const u32x4*)(vbuf + (size_t)(b * SEQ + (R0 + 9) * 64 + pkey) * D + h * 64 + pch * 8); if (R0 + 10 < 32) nv1 = *(const u32x4*)(vbuf + (size_t)(b * SEQ + (R0 + 10) * 64 + pkey) * D + h * 64 + pch * 8); }
            const int r = 2 * rp + rr; int r0 = r - 4; r0 = r0 < 0 ? 0 : (r0 > 24 ? 24 : r0);
            const int qrow = b * SEQ + r * 64 + 16 * cb + r16;
            bf16x8 qf[2];
#pragma unroll
            for (int ks = 0; ks < 2; ++ks) qf[ks] = *(const bf16x8*)(qbuf + (size_t)qrow * D + h * 64 + 32 * ks + 8 * g4);
            bf16x8 kf[8][2];
            const char* kb0 = (const char*)kbuf + ((size_t)(b * SEQ + r0 * 64 + band) * D + h * 64) * 2;
            const unsigned loff = (unsigned)(r16 * D + 8 * g4) * 2u;
#pragma unroll
            for (int t = 0; t < 8; ++t) { const char* bt = kb0 + (size_t)((t >> 1) * 64 + 16 * (t & 1)) * D * 2; kf[t][0] = *(const bf16x8*)(bt + loff); kf[t][1] = *(const bf16x8*)(bt + loff + 64); }
            const char* kb1 = kb0 + (size_t)(4 * 64) * D * 2;
            lds_barrier();
            const int rbase = NA_RPB + (r0 - r + 7) * 128;
            f32x4 O[4]; float m_run = NINF, sum = 0.f;
#pragma unroll
            for (int mt = 0; mt < 4; ++mt) O[mt] = (f32x4){0.f, 0.f, 0.f, 0.f};
#pragma nounroll
            for (int seg = 0; seg < 2; ++seg) na_seg<true, 0>(L, kf, kb1, loff, qf, seg, r16, g4, r0, band, boff, rbase, voff, O, m_run, sum);
            na_seg<false, 0>(L, kf, kb1, loff, qf, 0, r16, g4, r0, band, boff, rbase, voff, O, m_run, sum);
            na_seg<false, 8>(L, kf, kb1, loff, qf, 0, r16, g4, r0, band, boff, rbase, voff, O, m_run, sum);
            const float inv = 1.0f / sum;
#pragma unroll
            for (int mt = 0; mt < 4; ++mt) { u32x2 o; o.x = pk2(O[mt][0] * inv, O[mt][1] * inv); o.y = pk2(O[mt][2] * inv, O[mt][3] * inv);
                *(u32x2*)(cat + (size_t)qrow * D + h * 64 + 16 * mt + 4 * g4) = o; }
            if (newrows) { *(LAS u32x4*)(L + NA_VR + na_voff(((R0 + 9) % NA_RING) * 64 + pkey, pch)) = nv0; *(LAS u32x4*)(L + NA_VR + na_voff(((R0 + 10) % NA_RING) * 64 + pkey, pch)) = nv1; }
        }
    }
    __syncthreads();
}

#if MK_ONE_LAUNCH
#define GRID_BAR() xcd_barrier(bar)
#else
#define GRID_BAR() do { } while (0)
#endif
#define IN(k) (lo <= (k) && (k) < hi && (k) <= MK_LAST_PHASE)
#define SEAM(k) do { if (IN(k) && IN((k) + 1)) GRID_BAR(); } while (0)
template <int LAYER>
__device__ __forceinline__ void layer_tail(const Frame& F, const Args& args, const int lo, const int hi, const XcdBarrier& bar) {
    unsigned char* ws = args.ws;
    const float* modx = (const float*)(ws + WS_MODX); const float* modc = (const float*)(ws + WS_MODC);
    float* xw = (float*)(ws + WS_XW); bf16_t* Hb = (bf16_t*)(ws + WS_H);
    constexpr int mb = LAYER ? 16 : 7; constexpr int ntok = LAYER ? NX : NT;
    const float* lmodx = modx + (size_t)LAYER * 16 * ADA; const float* lmodc = modc + (size_t)LAYER * ADA;
    if (IN(LAYER ? 14 : 5)) REPEAT_IF(LAYER ? 14 : 5) { REP_BAR();
        SchedDense S{(const char*)(ws + T_CAT), (const char*)(ws + (LAYER ? WS_WOUT1 : WS_WOUT0)), D, ntok / 256, D / 256, 0, 1, 0, F.G, (int)blockIdx.x};
        EpiBf16 E{(bf16_t*)(ws + T_Y), D, 0, 0};
        stagger_delay(F, MK_STAG); pg8::gemm_phase<EpiBf16, SchedDense, true>(F.lds, D, S, E);
    }
    SEAM(LAYER ? 14 : 5);
    if (IN(LAYER ? 15 : 6)) REPEAT_IF(LAYER ? 15 : 6) { REP_BAR();
        RowPhase P{}; P.xin_lat = LAYER ? xw : args.in[0]; P.xin_ctx = LAYER ? xw + (size_t)NX * D : args.in[2]; P.xout_lat = xw; P.xout_ctx = xw + (size_t)NX * D; P.nrows = ntok; P.ysrc = 1; P.y = (const bf16_t*)(ws + T_Y);
        P.gpost = args.in[7] + LAYER * D; P.modx = lmodx; P.modc = lmodc; P.gate_chunk = 2;
        P.doH = true; P.H = Hb; P.gpre = args.in[8] + LAYER * D; P.sc_chunk = 4; P.sh_chunk = 3; P.modxH = lmodx; P.modcH = lmodc;
        row_phase(F, P);
    }
    SEAM(LAYER ? 15 : 6);
    if (IN(mb)) REPEAT_IF(mb) { REP_BAR();
        SchedDense S{(const char*)Hb, (const char*)(ws + WS_WR) + (size_t)LAYER * NEXP * D * 2, D, ntok / 256, 1, 0, 1, 0, F.G, (int)blockIdx.x};
        EpiRouter E{args.in[25] + LAYER * NEXP, (int*)(ws + M_AE), (int*)(ws + M_AR), (float*)(ws + M_AG), F.ctl + CW_CNT + LAYER * 256};
        pg8::gemm_phase<EpiRouter, SchedDense, false>(F.lds, D, S, E);
    }
    SEAM(mb);
    if (IN(mb + 1)) REPEAT_IF(mb + 1) { REP_BAR(); moe_place(F, LAYER, ntok); }
    SEAM(mb + 1);
    if (IN(mb + 2)) REPEAT_IF(mb + 2) { REP_BAR();
        const int nj = moe_units_setup<2>(F, LAYER, ntok, F.vcu, true);
        SchedMoeGU S{(const char*)Hb, (const char*)(ws + WS_WGU), (const LAS int*)(F.lds + AUX_TILEE), (const LAS int*)(F.lds + AUX_IDX), nj, F.G, F.vcu};
        EpiGateUp E{(bf16_t*)(ws + M_HID)};
        stagger_delay(F, MK_STAG); pg8::gemm_phase<EpiGateUp, SchedMoeGU, true>(F.lds, D, S, E);
    }
    SEAM(mb + 2);
    if (IN(mb + 3)) REPEAT_IF(mb + 3) { REP_BAR();
        const int nj = moe_units_setup<4>(F, LAYER, ntok, F.vcu, false);
        SchedMoeDN S{(const char*)(ws + M_HID), (const char*)(ws + WS_WDN), (const LAS int*)(F.lds + AUX_TILEE), nj, F.G, F.vcu};
        EpiF8 E{(unsigned char*)(ws + M_OUT)};
        stagger_delay(F, MK_STAG); pg8::gemm_phase<EpiF8, SchedMoeDN, true>(F.lds, DEXP, S, E);
    }
    SEAM(mb + 3);
    if (IN(mb + 4)) REPEAT_IF(mb + 4) { REP_BAR();
        RowPhase P{}; P.xin_lat = xw; P.xin_ctx = xw + (size_t)NX * D; P.xout_lat = LAYER ? args.out : xw; P.xout_ctx = xw + (size_t)NX * D; P.nrows = ntok; P.ysrc = 2;
        P.mo8 = (const unsigned char*)(ws + M_OUT); P.tslot = (const int*)(ws + M_TS); P.tgate = (const float*)(ws + M_AG); P.sharedbase = (int)__hip_atomic_load(F.ctl + CW_TST + LAYER * 320 + 256, __ATOMIC_RELAXED, __HIP_MEMORY_SCOPE_AGENT) * 256;
        P.gpost = args.in[9] + LAYER * D; P.modx = lmodx; P.modc = lmodc; P.gate_chunk = 5;
        P.doH = LAYER == 0; P.H = Hb; P.gpre = args.in[6] + D; P.sc_chunk = 1; P.sh_chunk = 0; P.modxH = modx + (size_t)16 * ADA; P.modcH = modc + ADA;
        row_phase(F, P);
        if (LAYER == 0) {
            LAS unsigned* T = (LAS unsigned*)F.lds + F.wave * (64 * 33);
            const int gw = F.vcu * NWAVES + F.wave, NGW = F.G * NWAVES;
            for (int it = gw; it < MOE_CVT_ITEMS; it += NGW) cvt_moe_item(args, 1, it, F.ws, T, F.lane);
        }
    }
    SEAM(mb + 4);
}

__global__ void __launch_bounds__(NTHREADS, 2) mk_fwd(Args args) {
    extern __shared__ __attribute__((aligned(16))) unsigned char lds_raw[];
    Frame F;
    F.lds = (LAS unsigned char*)lds_raw; F.MISC = (volatile LAS unsigned*)(F.lds + MISC_OFF);
    F.tid = threadIdx.x; F.lane = F.tid & 63; F.wave = __builtin_amdgcn_readfirstlane(F.tid >> 6);
    F.G = gridDim.x; { const int bx = blockIdx.x; F.vcu = (F.G % 8 == 0) ? (bx % 8) * (F.G / 8) + bx / 8 : bx; }
    F.ws = args.ws; F.ctl = (unsigned*)(args.ws + WS_CTL);
    for (int u = F.tid; u < (LDS_BYTES - MISC_OFF) / 4; u += NTHREADS) ((LAS unsigned*)(F.lds + MISC_OFF))[u] = 0u;
    __syncthreads();
    XcdBarrier bar; bar.bar = F.ctl + CW_BAR; bar.x = 0; bar.st = nullptr;
#if MK_ONE_LAUNCH
    bar = xcd_barrier_post(F.ctl + CW_BAR, F.MISC + 8);
#endif
    const int lo = args.ph_lo, hi = args.ph_hi;
    unsigned char* ws = args.ws;
    const float* modx = (const float*)(ws + WS_MODX); const float* modc = (const float*)(ws + WS_MODC);
    float* xw = (float*)(ws + WS_XW); bf16_t* Hb = (bf16_t*)(ws + WS_H);

    if (IN(0)) REPEAT_IF(0) { REP_BAR(); p0_ada(F, args); p0_convert(F, args); }
    SEAM(0);
    {
        if (IN(1)) REPEAT_IF(1) { REP_BAR();
            RowPhase P{}; P.xin_lat = args.in[0]; P.xin_ctx = args.in[2]; P.nrows = NT; P.ysrc = 0; P.modx = modx; P.modc = modc;
            P.doH = true; P.H = Hb; P.gpre = args.in[6]; P.sc_chunk = 1; P.sh_chunk = 0; P.modxH = modx; P.modcH = modc;
            row_phase(F, P);
        }
        SEAM(1);
        if (IN(2)) REPEAT_IF(2) { REP_BAR();
            SchedDense S{(const char*)Hb, (const char*)(ws + WS_WIN0), D, NT / 256, AB_INP / 256, 0, 1, 0, F.G, (int)blockIdx.x};
            EpiInproj E{(bf16_t*)(ws + T_QB), (bf16_t*)(ws + T_KB), (bf16_t*)(ws + T_VB), (bf16_t*)(ws + T_GB), (bf16_t*)(ws + T_UB), (float*)(ws + T_LR), (const f32x2*)(ws + WS_ROPE)};
            stagger_delay(F, MK_STAG); pg8::gemm_phase<EpiInproj, SchedDense, true>(F.lds, D, S, E);
        }
        SEAM(2);
        if (IN(3)) REPEAT_IF(3) { REP_BAR(); gla_phase(F, args); }
        SEAM(3);
        if (IN(4)) REPEAT_IF(4) { REP_BAR(); finish_conv_phase(F, args); }
        SEAM(4);

    }
    layer_tail<0>(F, args, lo, hi, bar);
    {
        if (IN(12)) REPEAT_IF(12) { REP_BAR();
            SchedDense S{(const char*)Hb, (const char*)(ws + WS_WQKV1), D, NX / 256, 12, NC / 256, 8, 4, F.G, (int)blockIdx.x};
            EpiBf16 E{(bf16_t*)(ws + T_QKV), D, D, (size_t)NT * D, 0.125f * 1.4426950408889634f};
            stagger_delay(F, MK_STAG); pg8::gemm_phase<EpiBf16, SchedDense, true>(F.lds, D, S, E);
        }
        SEAM(12);
        if (IN(13)) REPEAT_IF(13) { REP_BAR(); na_phase(F, args); }
        SEAM(13);

    }
    layer_tail<1>(F, args, lo, hi, bar);

#undef IN
#undef SEAM
}

extern "C" void kernel_launch(void* const* d_in, const int* in_sizes, int n_in, void* d_out, int out_size, void* d_ws, size_t ws_size, hipStream_t stream) {
    static int grid = 0;
    if (grid == 0) {
        if (n_in != 32 || out_size != NX * D || ws_size < WS_END) { fprintf(stderr, "kernel_launch: unexpected problem (n_in %d, out %d, ws %zu < %zu)\n", n_in, out_size, ws_size, (size_t)WS_END); grid = -1; return; }
        int dev = 0, cus = 0, per_cu = 0;
        if (hipGetDevice(&dev) != hipSuccess || hipDeviceGetAttribute(&cus, hipDeviceAttributeMultiprocessorCount, dev) != hipSuccess) { grid = -1; return; }
        if (hipFuncSetAttribute((const void*)mk_fwd, hipFuncAttributeMaxDynamicSharedMemorySize, LDS_BYTES) != hipSuccess) { fprintf(stderr, "kernel_launch: hipFuncSetAttribute failed\n"); grid = -1; return; }
        if (hipOccupancyMaxActiveBlocksPerMultiprocessor(&per_cu, (const void*)mk_fwd, NTHREADS, LDS_BYTES) != hipSuccess || per_cu < 1) fprintf(stderr, "kernel_launch: occupancy query says %d\n", per_cu);
        (void)hipGetLastError();
        grid = cus;
    }
    if (grid < 0) return;
    (void)hipMemsetAsync((char*)d_ws + WS_CTL, 0, CTL_BYTES, stream);
    Args a{};
    for (int i = 0; i < 32; ++i) a.in[i] = (const float*)d_in[i];
    a.out = (float*)d_out; a.ws = (unsigned char*)d_ws;
#if MK_ONE_LAUNCH
    a.ph_lo = 0; a.ph_hi = 64;
    hipLaunchKernelGGL(mk_fwd, dim3(grid), dim3(NTHREADS), LDS_BYTES, stream, a);
#else
    for (int p = 0; p <= 20; ++p) { if (p > MK_LAST_PHASE) break; a.ph_lo = p; a.ph_hi = p + 1; hipLaunchKernelGGL(mk_fwd, dim3(grid), dim3(NTHREADS), LDS_BYTES, stream, a); }
#endif
}
```

```cpp
#include <hip/hip_runtime.h>
#include <cstdio>
#include <cstdint>

#ifndef MK_ONE_LAUNCH
#define MK_ONE_LAUNCH 1
#endif
#ifndef MK_LAST_PHASE
#define MK_LAST_PHASE 99
#endif

#ifndef MK_REP
#define MK_REP (-1)
#endif
#define REPEAT_IF(k) _Pragma("unroll") for (int _r = 0; _r < ((k) == MK_REP ? 2 : 1); ++_r)
#define REP_BAR() do { if (_r) GRID_BAR(); } while (0)

#define GAS __attribute__((address_space(1)))
#define LAS __attribute__((address_space(3)))
typedef unsigned short bf16_t;
typedef short bf16x8 __attribute__((ext_vector_type(8)));
typedef float f32x4 __attribute__((ext_vector_type(4)));
typedef float f32x2 __attribute__((ext_vector_type(2)));
typedef unsigned u32x4 __attribute__((ext_vector_type(4)));
typedef unsigned u32x2 __attribute__((ext_vector_type(2)));

constexpr int D = 1024, BATCH = 16, SEQ = 2048, CTXL = 256, GRIDW = 64;
constexpr int NX = BATCH * SEQ, NC = BATCH * CTXL, NT = NX + NC;
constexpr int ADA = 6 * D;
constexpr int GLA_H = 4, GLA_DK = 64, GLA_DV = 128, GLA_QK = 256, GLA_V = 512, CONV_CH = 512, CONV_W = 31;
constexpr int AB_IN = 2592, AB_INP = 2816;
constexpr int NA_H = 16, NA_DH = 64;
constexpr int NEXP = 256, TOPK = 8, DEXP = 256;
constexpr int NEXPS = NEXP + 1;
constexpr int PMAX = NT * TOPK + NEXP * 255 + NT;
static_assert(PMAX % 256 == 0, "PMAX");
constexpr float RMS_EPS = 1e-6f, LN_EPS = 1e-5f;
constexpr float F8_SCALE = 32.0f, F8_INV = 1.0f / 32.0f;

constexpr size_t MiB = 1u << 20;
constexpr size_t al(size_t x) { return (x + 4095) & ~(size_t)4095; }
constexpr size_t WS_CTL = 0, CTL_BYTES = 1 * MiB;
constexpr size_t WS_MODX = WS_CTL + CTL_BYTES;
constexpr size_t WS_MODC = WS_MODX + al((size_t)2 * 16 * ADA * 4);
constexpr size_t WS_ROPE = WS_MODC + al((size_t)2 * ADA * 4);
constexpr size_t WS_XW = WS_ROPE + al(64 * 16 * 8);
constexpr size_t WS_H = WS_XW + al((size_t)NT * D * 4);
constexpr size_t WS_WIN0 = WS_H + al((size_t)NT * D * 2);
constexpr size_t WS_WOUT0 = WS_WIN0 + al((size_t)AB_INP * D * 2);
constexpr size_t WS_WQKV1 = WS_WOUT0 + al((size_t)D * D * 2);
constexpr size_t WS_WOUT1 = WS_WQKV1 + al((size_t)3 * D * D * 2);
constexpr size_t WS_WR = WS_WOUT1 + al((size_t)D * D * 2);
constexpr size_t WGU_BYTES = al((size_t)NEXPS * 512 * D * 2), WDN_BYTES = al((size_t)NEXPS * D * 256 * 2);
constexpr size_t WS_WGU = WS_WR + al((size_t)2 * NEXP * D * 2);
constexpr size_t WS_WDN = WS_WGU + 2 * WGU_BYTES;
constexpr size_t WS_T = WS_WDN + 2 * WDN_BYTES;
constexpr size_t T_QB = WS_T;
constexpr size_t T_KB = T_QB + al((size_t)NT * 256 * 2);
constexpr size_t T_VB = T_KB + al((size_t)NT * 256 * 2);
constexpr size_t T_GB = T_VB + al((size_t)NT * 512 * 2);
constexpr size_t T_UB = T_GB + al((size_t)NT * 512 * 2);
constexpr size_t T_LR = T_UB + al((size_t)NT * 512 * 2);
constexpr size_t T_OF = T_LR + al((size_t)NT * 32 * 4);
constexpr size_t T_OB = T_OF + al((size_t)NT * 512 * 2);
constexpr size_t T_CAT = T_OB + al((size_t)NT * 512 * 2);
constexpr size_t T_Y = T_CAT + al((size_t)NT * D * 2);
constexpr size_t T_GLA = T_Y + al((size_t)NT * D * 2);
constexpr int GI_A = 0, GI_QIN = 8192, GI_KOT = 16384, GI_VT = 24576, GI_DEC = 40960, GI_BYTES = 41216;
constexpr size_t T_END0 = T_GLA + al((size_t)BATCH * GLA_H * 2 * 36 * GI_BYTES + 1024);
constexpr size_t T_QKV = WS_T;
static_assert(T_QKV + (size_t)3 * NT * D * 2 <= T_CAT, "qkv overlay");
constexpr size_t M_AE = WS_T;
constexpr size_t M_AR = M_AE + al((size_t)NT * 8 * 4);
constexpr size_t M_AG = M_AR + al((size_t)NT * 8 * 4);
constexpr size_t M_TS = M_AG + al((size_t)NT * 8 * 4);
constexpr size_t M_ST = M_TS + al((size_t)NT * 8 * 4);
constexpr size_t M_HID = M_ST + al((size_t)PMAX * 4);
constexpr size_t M_OUT = M_HID + al((size_t)PMAX * 256 * 2);
constexpr int MO_LD = 1024;
constexpr size_t M_END = M_OUT + al((size_t)PMAX * D);
constexpr size_t WS_END = (M_END > T_END0 ? M_END : T_END0);
static_assert(WS_END <= (size_t)2040 * MiB, "workspace map must fit 2 GiB");

constexpr int CW_BAR = 4096;
constexpr int CW_CNT = 16384;
constexpr int CW_CUR = 16384 + 512;

constexpr int RING_BYTES = 131072;
constexpr int AUX_OFF = RING_BYTES, AUX_BYTES = 31744;
constexpr int MISC_OFF = AUX_OFF + AUX_BYTES;
constexpr int LDS_BYTES = MISC_OFF + 1024;
constexpr int NWAVES = 8, NTHREADS = 512;

#define LDS_WAIT() asm volatile("s_waitcnt lgkmcnt(0)" ::: "memory")
#define VM_WAIT() asm volatile("s_waitcnt vmcnt(0)" ::: "memory")

__device__ __forceinline__ unsigned f2bf(float f) { unsigned u = __builtin_bit_cast(unsigned, f); return (u + 0x7fffu + ((u >> 16) & 1u)) >> 16; }
__device__ __forceinline__ unsigned pk2(float lo, float hi) { return f2bf(lo) | (f2bf(hi) << 16); }
__device__ __forceinline__ float bf2f(unsigned short b) { return __builtin_bit_cast(float, (unsigned)b << 16); }
__device__ __forceinline__ float bflo(unsigned w) { return __builtin_bit_cast(float, w << 16); }
__device__ __forceinline__ float bfhi(unsigned w) { return __builtin_bit_cast(float, w & 0xffff0000u); }
__device__ __forceinline__ float wave_sum(float v) {
#pragma unroll
    for (int o = 1; o < 64; o <<= 1) v += __shfl_xor(v, o);
    return v;
}
__device__ __forceinline__ float sigmoidf_(float x) { return 1.0f / (1.0f + __expf(-x)); }
__device__ __forceinline__ float siluf_(float x) { return x / (1.0f + __expf(-x)); }

__device__ __forceinline__ void lds_barrier() { asm volatile("s_waitcnt lgkmcnt(0)" ::: "memory"); __builtin_amdgcn_s_barrier(); asm volatile("" ::: "memory"); }
#define XB_TMO      128
#define XB_XCNT(j)  (256  + 64 * (j))
#define XB_XSUB(j)  (1280 + 64 * (j))
#define XB_XGEN(j)  (2304 + 64 * (j))
#define XB_TOP      3328
#define XB_TOPGEN   3392
#define XCD_BAR_WORDS 3456
#define XB_SPIN_CAP (1u << 18)

__device__ __forceinline__ unsigned xb_ld(unsigned* p)              { return __hip_atomic_load(p, __ATOMIC_RELAXED, __HIP_MEMORY_SCOPE_AGENT); }
__device__ __forceinline__ unsigned xb_add(unsigned* p, unsigned v) { return __hip_atomic_fetch_add(p, v, __ATOMIC_RELAXED, __HIP_MEMORY_SCOPE_AGENT); }
__device__ __forceinline__ unsigned xb_xcc_id() { return (unsigned)__builtin_amdgcn_s_getreg((3 << 11) | 20) & 0xFu; }
#define XB_SPIN(cond, bar) do { unsigned _sp = 0; while (cond) { __builtin_amdgcn_s_sleep(1); \
    if ((++_sp & 255u) == 0u) { if (xb_ld(&(bar)[XB_TMO])) break; if (_sp > XB_SPIN_CAP) { atomicAdd(&(bar)[XB_TMO], 1u); break; } } } } while (0)

struct XcdBarrier { unsigned* bar; unsigned x; volatile LAS unsigned* st; };

__device__ __forceinline__ XcdBarrier xcd_barrier_post(unsigned* bar, volatile LAS unsigned* st) {
    XcdBarrier b; b.bar = bar; b.x = xb_xcc_id(); b.st = st;
    if (threadIdx.x == 0) (void)xb_add(&bar[XB_XCNT(b.x)], 1u);
    return b;
}
__device__ __forceinline__ void xcd_barrier_complete(unsigned* bar, unsigned x, unsigned& nloc, unsigned& nx) {
    const unsigned G = gridDim.x * gridDim.y * gridDim.z;
    unsigned sum, cnt, mine, sp = 0u;
    for (;;) {
        sum = 0u; cnt = 0u; mine = 0u;
#pragma unroll
        for (unsigned j = 0; j < 16; ++j) { const unsigned c = xb_ld(&bar[XB_XCNT(j)]); sum += c; cnt += (c > 0u) ? 1u : 0u; mine = (j == x) ? c : mine; }
        if (sum == G) break;
        __builtin_amdgcn_s_sleep(1);
        if ((++sp & 255u) == 0u) { if (xb_ld(&bar[XB_TMO])) break; if (sp > XB_SPIN_CAP) { atomicAdd(&bar[XB_TMO], 1u); break; } }
    }
    nloc = mine > 0u ? mine : 1u; nx = cnt > 0u ? cnt : 1u;
}
__device__ __forceinline__ void xcd_barrier(const XcdBarrier& b) {
    asm volatile("s_waitcnt vmcnt(0)" ::: "memory");
    __syncthreads();
    if (threadIdx.x == 0) {
        unsigned* bar = b.bar;
        __builtin_amdgcn_s_waitcnt(0);
        unsigned nloc = b.st[0], nx = b.st[1];
        if (nloc == 0u) { xcd_barrier_complete(bar, b.x, nloc, nx); b.st[0] = nloc; b.st[1] = nx; }
        const unsigned old = xb_add(&bar[XB_XSUB(b.x)], 1u);
        const unsigned gen = old / nloc;
        if (old + 1u == (gen + 1u) * nloc) {
            __builtin_amdgcn_fence(__ATOMIC_RELEASE, "agent");
            asm volatile("s_waitcnt vmcnt(0)" ::: "memory");
            const unsigned og = xb_add(&bar[XB_TOP], 1u);
            const unsigned tg = og / nx;
            if (og + 1u == (tg + 1u) * nx) xb_add(&bar[XB_TOPGEN], 1u);
            else XB_SPIN(xb_ld(&bar[XB_TOPGEN]) == tg, bar);
            __builtin_amdgcn_fence(__ATOMIC_ACQUIRE, "agent");
            xb_add(&bar[XB_XGEN(b.x)], 1u);
            asm volatile("s_waitcnt vmcnt(0)" ::: "memory");
        } else {
            XB_SPIN(xb_ld(&bar[XB_XGEN(b.x)]) == gen, bar);
            __builtin_amdgcn_fence(__ATOMIC_ACQUIRE, "agent");
            asm volatile("s_waitcnt vmcnt(0)" ::: "memory");
        }
    }
    __syncthreads();
}

namespace pg8 {
constexpr int BM = 256, BK = 64, HALF = 128, HTB = HALF * BK * 2, STAGE_BYTES = 8 * HTB, NXCD = 8, WGM = 8;
__host__ __device__ __forceinline__ int lds_byte(int r, int c) { const int st = (r >> 4) * 2 + (c >> 5), rr = r & 15, cc = c & 31, ob = rr * 64 + cc * 2; return st * 1024 + (ob ^ (((ob >> 9) & 1) << 5)); }
__host__ __device__ __forceinline__ void stage_rc(int b, int& R, int& C) { const int st = b / 1024, sb = b % 1024, swz = sb ^ (((sb >> 9) & 1) << 5); R = (st >> 1) * 16 + swz / 64; C = (st & 1) * 32 + (swz % 64) / 2; }
__host__ __device__ __forceinline__ int perm32(int rho) { const int n = rho >> 4, i = rho & 15; return 8 * (i >> 2) + 4 * n + (i & 3); }

struct Unit { int a, b, orow, ocol, aux; };

__device__ __forceinline__ bool static_order(int L, int nM, int nN, int& pm, int& pn) {
    const int nwg = nM * nN; if (L >= nwg) return false;
    int wgid = L; { const int q = nwg / NXCD, r = nwg % NXCD, xcd = wgid % NXCD, off = wgid / NXCD; wgid = (xcd < r ? xcd * (q + 1) : r * (q + 1) + (xcd - r) * q) + off; }
    const int nig = WGM * nN, gid = wgid / nig, fm = gid * WGM, gsz = (nM - fm) < WGM ? (nM - fm) : WGM;
    pm = fm + ((wgid % nig) % gsz); pn = (wgid % nig) / gsz; return true;
}

template <class Epi, class Sched, bool ALIGN_EPI>
__device__ __forceinline__ void gemm_phase(LAS unsigned char* lds, const int K, const Sched& S, const Epi& E) {
    const int tid = threadIdx.x, wid = __builtin_amdgcn_readfirstlane(tid >> 6), lane = tid & 63, wr = wid >> 2, wc = wid & 3, fr = lane & 15, fq = lane >> 4;
    const int nt = K / BK;
    int Rr[2], Cc[2]; unsigned voffB[2];
#pragma unroll
    for (int i = 0; i < 2; ++i) { int R, C; stage_rc(tid * 16 + i * 8192, R, C); Rr[i] = R; Cc[i] = C; const int Rb = Epi::PERM ? ((R & ~31) + perm32(R & 31)) : R; voffB[i] = (unsigned)(Rb * K + C) * 2u; }
    const size_t kstep = (size_t)(BK * 2);
    const size_t hstepB = (size_t)HALF * K * 2;
    const unsigned ldsw = (unsigned)wid * 1024u;
    const int aoff = lds_byte(wr * 64 + fr, fq * 8), boff = lds_byte(wc * 32 + fr, fq * 8);
#define PG8_SA(b, h) (((b) * 2 + (h)) * HTB)
#define PG8_SB(b, h) ((4 + (b) * 2 + (h)) * HTB)
#define PG8_STAGE(bufoff, gbase, voff) do { _Pragma("unroll") for (int _i = 0; _i < 2; ++_i) \
        __builtin_amdgcn_global_load_lds((const unsigned*)((const char*)(gbase) + (voff)[_i]), (LAS unsigned*)(lds + (bufoff) + ldsw + _i * 8192), 16, 0, 0); } while (0)
#define PG8_LDA(dst, b, h) do { _Pragma("unroll") for (int m = 0; m < 4; ++m) _Pragma("unroll") for (int k = 0; k < 2; ++k) dst[m][k] = *(const LAS bf16x8*)(lds + PG8_SA(b, h) + aoff + m * 2048 + k * 1024); } while (0)
#define PG8_LDB(dst, b, h) do { _Pragma("unroll") for (int n = 0; n < 2; ++n) _Pragma("unroll") for (int k = 0; k < 2; ++k) dst[n][k] = *(const LAS bf16x8*)(lds + PG8_SB(b, h) + boff + n * 2048 + k * 1024); } while (0)
#define PG8_MMA(ai, bj, At, Bt) do { __builtin_amdgcn_s_setprio(1); _Pragma("unroll") for (int m = 0; m < 4; ++m) _Pragma("unroll") for (int n = 0; n < 2; ++n) _Pragma("unroll") for (int k = 0; k < 2; ++k) \
        acc[ai][bj][m][n] = __builtin_amdgcn_mfma_f32_16x16x32_bf16(Bt[n][k], At[m][k], acc[ai][bj][m][n], 0, 0, 0); __builtin_amdgcn_s_setprio(0); } while (0)
#define PG8_WAIT_V(n) asm volatile("s_waitcnt vmcnt(" #n ")" ::: "memory")
#define PG8_WAIT_L(n) asm volatile("s_waitcnt lgkmcnt(" #n ")" ::: "memory")
#define PG8_BAR __builtin_amdgcn_s_barrier()
#define PG8_SCHED __builtin_amdgcn_sched_barrier(0)
    Unit cur, nxt; int ui = 0;
    if (!S.next(0, cur)) return;
    f32x4 acc[2][2][4][2];
#pragma unroll
    for (int a = 0; a < 2; ++a)
#pragma unroll
        for (int b = 0; b < 2; ++b)
#pragma unroll
            for (int m = 0; m < 4; ++m)
#pragma unroll
                for (int n = 0; n < 2; ++n) acc[a][b][m][n] = (f32x4){0.f, 0.f, 0.f, 0.f};
    bf16x8 At[4][2], B0[2][2], B1[2][2];
    unsigned co0[2], co1[2], no0[2], no1[2];
    S.a_off(cur, Rr, Cc, co0, co1);
    const char* const Ab = S.a_base();
    const char* cB = S.b_ptr(cur);
    PG8_STAGE(PG8_SB(0, 0), cB, voffB); PG8_STAGE(PG8_SB(0, 1), cB + hstepB, voffB); PG8_STAGE(PG8_SA(0, 0), Ab, co0); PG8_STAGE(PG8_SA(0, 1), Ab, co1);
    if (wr == 1) PG8_BAR;
    PG8_WAIT_V(2); PG8_BAR;
    PG8_STAGE(PG8_SB(1, 0), cB + kstep, voffB); PG8_STAGE(PG8_SA(1, 0), Ab + kstep, co0); PG8_STAGE(PG8_SB(1, 1), cB + hstepB + kstep, voffB);
    PG8_WAIT_V(6); PG8_BAR;
    for (;;) {
        const bool has_next = S.next(ui + 1, nxt);
        const char* nB = has_next ? S.b_ptr(nxt) : cB;
#pragma nounroll
        for (int t = 0; t < nt; t += 2) {
            const bool last = (t == nt - 2);
            if (last) { if (has_next) S.a_off(nxt, Rr, Cc, no0, no1); else { no0[0] = co0[0]; no0[1] = co0[1]; no1[0] = co1[0]; no1[1] = co1[1]; } }
            const char* a1 = Ab + (size_t)(t + 1) * kstep;
            const char* a2 = last ? Ab : Ab + (size_t)(t + 2) * kstep; const char* b2 = last ? nB : cB + (size_t)(t + 2) * kstep;
            const char* a3 = a2 + kstep; const char* b3 = b2 + kstep;
            unsigned x0[2], x1[2];
            x0[0] = last ? no0[0] : co0[0]; x0[1] = last ? no0[1] : co0[1]; x1[0] = last ? no1[0] : co1[0]; x1[1] = last ? no1[1] : co1[1];
            PG8_LDB(B0, 0, 0); PG8_LDB(B1, 0, 1); PG8_SCHED; PG8_LDA(At, 0, 0); PG8_STAGE(PG8_SA(1, 1), a1, co1);
            PG8_WAIT_V(8); PG8_WAIT_L(0); PG8_BAR; PG8_MMA(0, 0, At, B0); PG8_MMA(0, 1, At, B1); PG8_BAR; PG8_SCHED;
            PG8_LDA(At, 0, 1); PG8_STAGE(PG8_SB(0, 0), b2, voffB); PG8_STAGE(PG8_SB(0, 1), b2 + hstepB, voffB); PG8_STAGE(PG8_SA(0, 0), a2, x0);
            PG8_WAIT_V(8); PG8_WAIT_L(0); PG8_BAR; PG8_MMA(1, 0, At, B0); PG8_MMA(1, 1, At, B1); PG8_BAR; PG8_SCHED;
            PG8_LDB(B0, 1, 0); PG8_LDB(B1, 1, 1); PG8_SCHED; PG8_LDA(At, 1, 0); PG8_STAGE(PG8_SA(0, 1), a2, x1);
            PG8_WAIT_V(8); PG8_WAIT_L(0); PG8_BAR; PG8_MMA(0, 0, At, B0); PG8_MMA(0, 1, At, B1); PG8_BAR; PG8_SCHED;
            PG8_LDA(At, 1, 1); PG8_STAGE(PG8_SB(1, 0), b3, voffB); PG8_STAGE(PG8_SB(1, 1), b3 + hstepB, voffB); PG8_STAGE(PG8_SA(1, 0), a3, x0);
            PG8_WAIT_V(8); PG8_WAIT_L(0); PG8_BAR; PG8_MMA(1, 0, At, B0); PG8_MMA(1, 1, At, B1); PG8_BAR; PG8_SCHED;
        }
        if constexpr (ALIGN_EPI) { if (wr == 0) PG8_BAR; }
        if constexpr (!Epi::AFTER_DRAIN) { E(acc, cur, wr, wc, fr, fq); }
        if (!has_next) break;
#pragma unroll
        for (int a = 0; a < 2; ++a)
#pragma unroll
            for (int b = 0; b < 2; ++b)
#pragma unroll
                for (int m = 0; m < 4; ++m)
#pragma unroll
                    for (int n = 0; n < 2; ++n) acc[a][b][m][n] = (f32x4){0.f, 0.f, 0.f, 0.f};
        cur = nxt; cB = nB; co0[0] = no0[0]; co0[1] = no0[1]; co1[0] = no1[0]; co1[1] = no1[1]; ++ui;
        if constexpr (ALIGN_EPI) { if (wr == 1) PG8_BAR; }
    }
    PG8_WAIT_V(0);
    if constexpr (!ALIGN_EPI) { if (wr == 0) PG8_BAR; }
    PG8_BAR;
    if constexpr (Epi::AFTER_DRAIN) { E.fused(acc, cur, wr, wc, fr, fq, lds, wid, lane); }
#undef PG8_SA
#undef PG8_SB
#undef PG8_STAGE
#undef PG8_LDA
#undef PG8_LDB
#undef PG8_MMA
#undef PG8_WAIT_V
#undef PG8_WAIT_L
#undef PG8_BAR
#undef PG8_SCHED
}
}
using pg8::Unit;

__device__ __forceinline__ unsigned cvt_pk_bf16(float lo, float hi) { unsigned r; asm volatile("v_cvt_pk_bf16_f32 %0, %1, %2" : "=v"(r) : "v"(lo), "v"(hi)); return r; }

struct SchedDense {
    const char* A; const char* Bt; int K; int nM0, nN0, nM1, nN1, pn1off; int G, c;
    __device__ __forceinline__ bool next(int i, Unit& u) const {
        const int L = i * G + c; int pm, pn;
        const int n0 = nM0 * nN0;
        if (L < n0) { pg8::static_order(L, nM0, nN0, pm, pn); }
        else { if (!pg8::static_order(L - n0, nM1, nN1, pm, pn)) return false; pm += nM0; pn += pn1off; }
        u.a = pm; u.b = pn * 256; u.orow = pm * 256; u.ocol = pn * 256; u.aux = pn; return true;
    }
    __device__ __forceinline__ const char* a_base() const { return A; }
    __device__ __forceinline__ const char* b_ptr(const Unit& u) const { return Bt + (size_t)u.b * K * 2; }
    __device__ __forceinline__ void a_off(const Unit& u, const int (&R)[2], const int (&C)[2], unsigned (&o0)[2], unsigned (&o1)[2]) const {
#pragma unroll
        for (int i = 0; i < 2; ++i) { o0[i] = (unsigned)((u.a * 256 + R[i]) * K + C[i]) * 2u; o1[i] = o0[i] + (unsigned)(128 * K * 2); }
    }
};

struct EpiBf16 {
    static constexpr bool PERM = true, AFTER_DRAIN = false;
    bf16_t* O; int ldc; int split_cols; size_t split_stride; float scale0 = 1.0f;
    __device__ __forceinline__ void operator()(const f32x4 (&acc)[2][2][4][2], const Unit& u, int wr, int wc, int fr, int fq) const {
        const int lane = fr + 16 * fq; const int srcb = ((lane >> 2) + 16 * (lane & 3)) << 2;
        const int row0 = u.orow + wr * 64 + (lane >> 2); int colt = u.ocol; bf16_t* base = O;
        float sc = 1.0f;
        if (split_cols) { const int t = colt / split_cols; base += (size_t)t * split_stride; colt -= t * split_cols; if (t == 0) sc = scale0; }
        const int col0 = colt + wc * 32 + 8 * (lane & 3);
#pragma unroll
        for (int ai = 0; ai < 2; ++ai)
#pragma unroll
            for (int m = 0; m < 4; ++m) { bf16_t* rowp = base + (size_t)(row0 + ai * 128 + m * 16) * ldc + col0;
#pragma unroll
                for (int bj = 0; bj < 2; ++bj) { const f32x4 v0 = acc[ai][bj][m][0] * sc, v1 = acc[ai][bj][m][1] * sc;
                    u32x4 w; w.x = cvt_pk_bf16(v0[0], v0[1]); w.y = cvt_pk_bf16(v0[2], v0[3]); w.z = cvt_pk_bf16(v1[0], v1[1]); w.w = cvt_pk_bf16(v1[2], v1[3]);
                    u32x4 t; t.x = (unsigned)__builtin_amdgcn_ds_bpermute(srcb, (int)w.x); t.y = (unsigned)__builtin_amdgcn_ds_bpermute(srcb, (int)w.y); t.z = (unsigned)__builtin_amdgcn_ds_bpermute(srcb, (int)w.z); t.w = (unsigned)__builtin_amdgcn_ds_bpermute(srcb, (int)w.w);
                    *(u32x4*)(rowp + bj * 128) = t; } }
    }
};
struct EpiF8 {
    static constexpr bool PERM = true, AFTER_DRAIN = false;
    unsigned char* O;
    __device__ __forceinline__ int nst(const Unit&, int) const { return 16; }
    __device__ __forceinline__ void operator()(const f32x4 (&acc)[2][2][4][2], const Unit& u, int wr, int wc, int fr, int fq) const {
        const int lane = fr + 16 * fq; const int srcb = ((lane >> 2) + 16 * (lane & 3)) << 2;
        const int row0 = u.orow + wr * 64 + (lane >> 2), col0 = u.ocol + wc * 32 + 8 * (lane & 3);
#pragma unroll
        for (int ai = 0; ai < 2; ++ai)
#pragma unroll
            for (int m = 0; m < 4; ++m) { unsigned char* rowp = O + (size_t)(row0 + ai * 128 + m * 16) * D + col0;
#pragma unroll
                for (int bj = 0; bj < 2; ++bj) { const f32x4 v0 = acc[ai][bj][m][0] * F8_SCALE, v1 = acc[ai][bj][m][1] * F8_SCALE;
                    int w0 = __builtin_amdgcn_cvt_pk_fp8_f32(v0[0], v0[1], 0, false); w0 = __builtin_amdgcn_cvt_pk_fp8_f32(v0[2], v0[3], w0, true);
                    int w1 = __builtin_amdgcn_cvt_pk_fp8_f32(v1[0], v1[1], 0, false); w1 = __builtin_amdgcn_cvt_pk_fp8_f32(v1[2], v1[3], w1, true);
                    u32x2 t; t.x = (unsigned)__builtin_amdgcn_ds_bpermute(srcb, w0); t.y = (unsigned)__builtin_amdgcn_ds_bpermute(srcb, w1);
                    *(u32x2*)(rowp + bj * 128) = t; } }
    }
};
template <int MODE> struct EpiBf16X {
    static constexpr bool PERM = true, AFTER_DRAIN = false;
    bf16_t* O; int ldc;
    __device__ __forceinline__ void operator()(const f32x4 (&acc)[2][2][4][2], const Unit& u, int wr, int wc, int fr, int fq) const {
        const int lane = fr + 16 * fq; const int srcb = ((lane >> 2) + 16 * (lane & 3)) << 2;
        const int row0 = u.orow + wr * 64 + (lane >> 2); const int col0 = u.ocol + wc * 32 + 8 * (lane & 3);
#pragma unroll
        for (int ai = 0; ai < 2; ++ai)
#pragma unroll
            for (int m = 0; m < 4; ++m) { bf16_t* rowp = O + (size_t)(row0 + ai * 128 + m * 16) * ldc + col0;
#pragma unroll
                for (int bj = 0; bj < 2; ++bj) { const f32x4 v0 = acc[ai][bj][m][0], v1 = acc[ai][bj][m][1];
                    u32x4 w; w.x = cvt_pk_bf16(v0[0], v0[1]); w.y = cvt_pk_bf16(v0[2], v0[3]); w.z = cvt_pk_bf16(v1[0], v1[1]); w.w = cvt_pk_bf16(v1[2], v1[3]);
                    u32x4 t; t.x = (unsigned)__builtin_amdgcn_ds_bpermute(srcb, (int)w.x); t.y = (unsigned)__builtin_amdgcn_ds_bpermute(srcb, (int)w.y); t.z = (unsigned)__builtin_amdgcn_ds_bpermute(srcb, (int)w.z); t.w = (unsigned)__builtin_amdgcn_ds_bpermute(srcb, (int)w.w);
                    if (MODE == 1) { if (bj == 0) *(u32x4*)(rowp + bj * 128) = t; else asm volatile("" :: "v"(t)); }
                    if (MODE == 2) { bf16_t* p = O + (wr * 128 + ai * 64 + m * 16 + bj * 8 + wc * 2) * 256 + 8 * lane; *(u32x4*)p = t; }
                } }
    }
};
struct EpiNull {
    static constexpr bool PERM = true, AFTER_DRAIN = false;
    __device__ __forceinline__ void operator()(const f32x4 (&acc)[2][2][4][2], const Unit& u, int wr, int wc, int fr, int fq) const {
#pragma unroll
        for (int ai = 0; ai < 2; ++ai)
#pragma unroll
            for (int bj = 0; bj < 2; ++bj)
#pragma unroll
                for (int m = 0; m < 4; ++m)
#pragma unroll
                    for (int n = 0; n < 2; ++n) asm volatile("" :: "v"(acc[ai][bj][m][n]));
    }
};
struct EpiBf16NS {
    static constexpr bool PERM = true, AFTER_DRAIN = false;
    __device__ __forceinline__ void operator()(const f32x4 (&acc)[2][2][4][2], const Unit& u, int wr, int wc, int fr, int fq) const {
#pragma unroll
        for (int ai = 0; ai < 2; ++ai)
#pragma unroll
            for (int m = 0; m < 4; ++m) {
#pragma unroll
                for (int bj = 0; bj < 2; ++bj) { const f32x4 v0 = acc[ai][bj][m][0], v1 = acc[ai][bj][m][1];
                    u32x4 w; w.x = cvt_pk_bf16(v0[0], v0[1]); w.y = cvt_pk_bf16(v0[2], v0[3]); w.z = cvt_pk_bf16(v1[0], v1[1]); w.w = cvt_pk_bf16(v1[2], v1[3]);
                    asm volatile("" :: "v"(w)); } }
    }
};
struct EpiInproj {
    static constexpr bool PERM = false, AFTER_DRAIN = false;
    bf16_t *qb, *kb, *vb, *gb, *ub; float* lr; const f32x2* rope;
    __device__ __forceinline__ void operator()(const f32x4 (&acc)[2][2][4][2], const Unit& u, int wr, int wc, int fr, int fq) const {
        const int pn = u.aux; const int row0 = u.orow + wr * 64 + fr;
        if (pn <= 1) {
            bf16_t* dst = pn == 0 ? qb : kb; const float sc = pn == 0 ? 0.125f : 1.0f;
#pragma unroll
            for (int ai = 0; ai < 2; ++ai)
#pragma unroll
                for (int m = 0; m < 4; ++m) {
                    const int row = row0 + ai * 128 + m * 16; const bool lat = row < NX;
                    const int s = row & (SEQ - 1); const int pos = (wc & 1) ? (s & 63) : (s >> 6);
                    f32x2 cs[4];
                    if (lat) {
#pragma unroll
                        for (int e = 0; e < 4; ++e) cs[e] = rope[pos * 16 + 4 * fq + e];
                    } else {
#pragma unroll
                        for (int e = 0; e < 4; ++e) cs[e] = (f32x2){1.f, 0.f};
                    }
#pragma unroll
                    for (int bj = 0; bj < 2; ++bj) {
                        const f32x4 u1 = acc[ai][bj][m][0], u2 = acc[ai][bj][m][1]; f32x4 o1, o2;
#pragma unroll
                        for (int e = 0; e < 4; ++e) { o1[e] = (u1[e] * cs[e].x - u2[e] * cs[e].y) * sc; o2[e] = (u1[e] * cs[e].y + u2[e] * cs[e].x) * sc; }
                        bf16_t* p = dst + (size_t)row * 256 + bj * 128 + wc * 32 + 4 * fq;
                        u32x2 w1, w2; w1.x = cvt_pk_bf16(o1[0], o1[1]); w1.y = cvt_pk_bf16(o1[2], o1[3]); w2.x = cvt_pk_bf16(o2[0], o2[1]); w2.y = cvt_pk_bf16(o2[2], o2[3]);
                        *(u32x2*)p = w1; *(u32x2*)(p + 16) = w2;
                    }
                }
        } else if (pn <= 5) {
            bf16_t* dst = pn <= 3 ? vb : gb; const int cb = (pn & 1) ? 256 : 0;
#pragma unroll
            for (int ai = 0; ai < 2; ++ai)
#pragma unroll
                for (int m = 0; m < 4; ++m) { const int row = row0 + ai * 128 + m * 16;
#pragma unroll
                    for (int bj = 0; bj < 2; ++bj)
#pragma unroll
                        for (int n = 0; n < 2; ++n) { const f32x4 v = acc[ai][bj][m][n]; u32x2 w; w.x = cvt_pk_bf16(v[0], v[1]); w.y = cvt_pk_bf16(v[2], v[3]);
                            *(u32x2*)(dst + (size_t)row * 512 + cb + bj * 128 + wc * 32 + n * 16 + 4 * fq) = w; } }
        } else if (pn <= 9) {
            const int cb = (pn - 6) * 128;
#pragma unroll
            for (int ai = 0; ai < 2; ++ai)
#pragma unroll
                for (int m = 0; m < 4; ++m) { const int row = row0 + ai * 128 + m * 16;
#pragma unroll
                    for (int n = 0; n < 2; ++n) { const f32x4 a = acc[ai][0][m][n], b = acc[ai][1][m][n]; f32x4 o;
#pragma unroll
                        for (int e = 0; e < 4; ++e) o[e] = a[e] * sigmoidf_(b[e]);
                        u32x2 w; w.x = cvt_pk_bf16(o[0], o[1]); w.y = cvt_pk_bf16(o[2], o[3]);
                        *(u32x2*)(ub + (size_t)row * 512 + cb + wc * 32 + n * 16 + 4 * fq) = w; } }
        } else {
            if (wc == 0) {
#pragma unroll
                for (int ai = 0; ai < 2; ++ai)
#pragma unroll
                    for (int m = 0; m < 4; ++m) { const int row = row0 + ai * 128 + m * 16;
#pragma unroll
                        for (int n = 0; n < 2; ++n) *(f32x4*)(lr + (size_t)row * 32 + n * 16 + 4 * fq) = acc[ai][0][m][n]; }
            }
        }
    }
};

struct Args { const float* in[32]; float* out; unsigned char* ws; int ph_lo, ph_hi; };

struct Frame {
    LAS unsigned char* lds; volatile LAS unsigned* MISC; unsigned* ctl; unsigned char* ws;
    int tid, lane, wave, G, vcu;
};

__device__ __forceinline__ void cvt_item(const float* __restrict__ src, int ld, int col0, int ncols, int k0, bf16_t* dst, int ldd, int drow0, LAS unsigned* T, int lane) {
    const bool okc = lane < ncols;
    const float* p = src + (size_t)k0 * ld + col0 + (okc ? lane : 0);
    float v[64];
#pragma unroll
    for (int k = 0; k < 64; ++k) v[k] = __builtin_nontemporal_load(p + (size_t)k * ld);
#pragma unroll
    for (int kp = 0; kp < 32; ++kp) T[lane * 33 + kp] = okc ? pk2(v[2 * kp], v[2 * kp + 1]) : 0u;
    LDS_WAIT(); asm volatile("" ::: "memory");
    const int c = lane & 7;
#pragma unroll
    for (int it = 0; it < 8; ++it) { const int n = (lane >> 3) + 8 * it;
        u32x4 o; o.x = T[n * 33 + 4 * c]; o.y = T[n * 33 + 4 * c + 1]; o.z = T[n * 33 + 4 * c + 2]; o.w = T[n * 33 + 4 * c + 3];
        if (n < ncols) __builtin_nontemporal_store(o, (u32x4*)(dst + (size_t)(drow0 + n) * ldd + k0 + 8 * c)); }
    LDS_WAIT(); asm volatile("" ::: "memory");
}
__device__ __forceinline__ void cvt_matrix_item(const float* src, int ld, int col0, int ncols, int K, bf16_t* dst, int drow0, int item, LAS unsigned* T, int lane) {
    const int ncg = (ncols + 63) >> 6; const int kt = item / ncg, cg = item - kt * ncg;
    const int nc = ncols - cg * 64 < 64 ? ncols - cg * 64 : 64;
    cvt_item(src, ld, col0 + cg * 64, nc, kt * 64, dst, K, drow0 + cg * 64, T, lane);
}

constexpr int MOE_CVT_ITEMS = NEXPS * 192;
__device__ __forceinline__ void cvt_moe_item(const Args& a, int layer, int item, unsigned char* ws, LAS unsigned* T, int lane) {
    const int e = item / 192, r = item - e * 192;
    bf16_t* wgu = (bf16_t*)(ws + WS_WGU + (size_t)layer * WGU_BYTES) + (size_t)e * 512 * D; bf16_t* wdn = (bf16_t*)(ws + WS_WDN + (size_t)layer * WDN_BYTES) + (size_t)e * D * 256;
    if (r < 128) {
        const int gi = r >> 4, kt = r & 15; const int up = gi >> 2, g4 = gi & 3;
        const float* src = e < NEXP ? (up ? a.in[27] : a.in[26]) + ((size_t)layer * NEXP + e) * D * DEXP : (up ? a.in[30] : a.in[29]) + (size_t)layer * D * DEXP;
        cvt_item(src, DEXP, 64 * g4, 64, kt * 64, wgu, D, 256 * (g4 >> 1) + 64 * (g4 & 1) + 128 * up, T, lane);
    } else {
        const int q = r - 128; const int cg = q >> 2, kt = q & 3;
        const float* src = e < NEXP ? a.in[28] + ((size_t)layer * NEXP + e) * DEXP * D : a.in[31] + (size_t)layer * DEXP * D;
        cvt_item(src, D, 64 * cg, 64, kt * 64, wdn, DEXP, 64 * cg, T, lane);
    }
}

__device__ __forceinline__ float row_rms_scale(const f32x4 (&v)[4]) {
    float s = 0.f;
#pragma unroll
    for (int j = 0; j < 4; ++j) s += (v[j].x * v[j].x + v[j].y * v[j].y) + (v[j].z * v[j].z + v[j].w * v[j].w);
    return rsqrtf(wave_sum(s) * (1.0f / D) + RMS_EPS);
}
__device__ __forceinline__ f32x4 ld4(const float* p) { return *(const f32x4*)p; }

struct RowPhase {
    const float* xin_lat; const float* xin_ctx;
    float* xout_lat; float* xout_ctx;
    int nrows;
    int ysrc; const bf16_t* y;
    const unsigned char* mo8; const int* tslot; const float* tgate; int sharedbase;
    const float* gpost; const float* modx; const float* modc; int gate_chunk;
    bool doH; bf16_t* H; const float* gpre; int sc_chunk, sh_chunk; const float* modxH; const float* modcH;
};
__device__ __forceinline__ void row_phase(const Frame& F, const RowPhase& P) {
    const int gw = F.vcu * NWAVES + F.wave, NGW = F.G * NWAVES, lane = F.lane;
    for (int row = gw; row < P.nrows; row += NGW) {
        const bool lat = row < NX; const int b = lat ? (row >> 11) : 0;
        const float* mod = lat ? P.modx + (size_t)b * ADA : P.modc;
        const float* xr = lat ? P.xin_lat + (size_t)row * D : P.xin_ctx + (size_t)(row - NX) * D;
        f32x4 x[4];
#pragma unroll
        for (int j = 0; j < 4; ++j) x[j] = ld4(xr + 4 * lane + 256 * j);
        if (P.ysrc) {
            f32x4 y[4];
            if (P.ysrc == 1) {
#pragma unroll
                for (int j = 0; j < 4; ++j) { const u32x2 w = __builtin_nontemporal_load((const u32x2*)(P.y + (size_t)row * D + 4 * lane + 256 * j)); y[j] = (f32x4){bflo(w.x), bfhi(w.x), bflo(w.y), bfhi(w.y)}; }
            } else {
#pragma unroll
                for (int j = 0; j < 4; ++j) { const int w = __builtin_nontemporal_load((const int*)(P.mo8 + (size_t)(P.sharedbase + row) * D + 4 * lane + 256 * j)); const f32x2 lo = __builtin_amdgcn_cvt_pk_f32_fp8(w, false), hi = __builtin_amdgcn_cvt_pk_f32_fp8(w, true); y[j] = (f32x4){lo.x, lo.y, hi.x, hi.y} * F8_INV; }
#pragma unroll
                for (int k = 0; k < TOPK; ++k) { const int sl = P.tslot[(size_t)row * 8 + k]; const float g = P.tgate[(size_t)row * 8 + k] * F8_INV;
#pragma unroll
                    for (int j = 0; j < 4; ++j) { const int w = __builtin_nontemporal_load((const int*)(P.mo8 + (size_t)sl * D + 4 * lane + 256 * j)); const f32x2 lo = __builtin_amdgcn_cvt_pk_f32_fp8(w, false), hi = __builtin_amdgcn_cvt_pk_f32_fp8(w, true);
                        y[j].x += g * lo.x; y[j].y += g * lo.y; y[j].z += g * hi.x; y[j].w += g * hi.y; } }
            }
            const float rs = row_rms_scale(y);
#pragma unroll
            for (int j = 0; j < 4; ++j) { const f32x4 gp = ld4(P.gpost + 4 * lane + 256 * j), gt = ld4(mod + P.gate_chunk * D + 4 * lane + 256 * j); x[j] = x[j] + gt * (y[j] * rs * gp); }
            float* xo = lat ? P.xout_lat + (size_t)row * D : P.xout_ctx + (size_t)(row - NX) * D;
#pragma unroll
            for (int j = 0; j < 4; ++j) *(f32x4*)(xo + 4 * lane + 256 * j) = x[j];
        }
        if (P.doH) {
            const float rs = row_rms_scale(x); const float* modh = lat ? P.modxH + (size_t)b * ADA : P.modcH;
#pragma unroll
            for (int j = 0; j < 4; ++j) { const f32x4 gp = ld4(P.gpre + 4 * lane + 256 * j), sc = ld4(modh + P.sc_chunk * D + 4 * lane + 256 * j), sh = ld4(modh + P.sh_chunk * D + 4 * lane + 256 * j);
                const f32x4 h = x[j] * rs * gp * (sc + 1.0f) + sh; u32x2 w; w.x = pk2(h.x, h.y); w.y = pk2(h.z, h.w);
                *(u32x2*)(P.H + (size_t)row * D + 4 * lane + 256 * j) = w; }
        }
    }
}


constexpr int FILL_PER_WAVE_S = 10, FILL_PER_WAVE_L = 14;
constexpr int F0_P2 = 208 * 8 * FILL_PER_WAVE_S, F0_P5 = 192 * 8 * FILL_PER_WAVE_S, F0_P7 = 112 * 8 * FILL_PER_WAVE_L;
constexpr int F0_BULK = MOE_CVT_ITEMS - F0_P2 - F0_P5 - F0_P7;
constexpr int F1_P12 = 128 * 8 * FILL_PER_WAVE_S, F1_P16 = 128 * 8 * FILL_PER_WAVE_L;
__device__ __forceinline__ void cvt_moe_range(const Frame& F, const Args& a, int layer, int lo, int hi, int rank, int nranks) {
    LAS unsigned* T = (LAS unsigned*)F.lds + F.wave * (64 * 33);
    for (int it = lo + rank * NWAVES + F.wave; it < hi; it += nranks * NWAVES) cvt_moe_item(a, layer, it, F.ws, T, F.lane);
}
__device__ __forceinline__ void fill1_ranges(const Frame& F, int ntr0, int& s9, int& s10) {
    const int nu9 = (ntr0 + NT / 256) * 2, nu10 = (ntr0 + NT / 256) * 4;
    const int l9 = (nu9 % F.G) ? F.G - nu9 % F.G : 0, l10 = (nu10 % F.G) ? F.G - nu10 % F.G : 0;
    s9 = l9 * NWAVES * FILL_PER_WAVE_S; s10 = l10 * NWAVES * (FILL_PER_WAVE_S / 3);
}

#ifndef MK_STAG
#define MK_STAG 0
#endif
__device__ __forceinline__ void stagger_delay(const Frame& F, int step) {
    if (step <= 0) return;
    const unsigned long long t0 = __builtin_amdgcn_s_memrealtime(); const unsigned long long d = (unsigned long long)((F.vcu & 7) * step);
    while (__builtin_amdgcn_s_memrealtime() - t0 < d) __builtin_amdgcn_s_sleep(4);
}
__device__ __forceinline__ void p0_ada(const Frame& F, const Args& a) {
    LAS float* sc = (LAS float*)F.lds;
    if ((int)blockIdx.x >= 96) return;
    for (int i = F.tid; i < 17 * D; i += NTHREADS) { const int r = i >> 10, k = i & 1023; const float v = r < 16 ? a.in[1][r * D + k] : a.in[3][k]; sc[i] = siluf_(v); }
    __syncthreads();
    const int item = blockIdx.x; const int layer = item / 48, cg = item % 48;
    const int cq = F.tid & 31, kl = F.tid >> 5;
    const float* W = a.in[4] + (size_t)layer * D * ADA + cg * 128 + cq * 4;
    f32x4 acc[17];
#pragma unroll
    for (int r = 0; r < 17; ++r) acc[r] = (f32x4){0.f, 0.f, 0.f, 0.f};
    for (int k = kl; k < D; k += 16) {
        const f32x4 w = ld4(W + (size_t)k * ADA);
#pragma unroll
        for (int r = 0; r < 17; ++r) { const float s = sc[r * D + k]; acc[r] = acc[r] + w * s; }
    }
#pragma unroll
    for (int r = 0; r < 17; ++r) { acc[r].x += __shfl_xor(acc[r].x, 32); acc[r].y += __shfl_xor(acc[r].y, 32); acc[r].z += __shfl_xor(acc[r].z, 32); acc[r].w += __shfl_xor(acc[r].w, 32); }
    __syncthreads();
    LAS f32x4* red = (LAS f32x4*)F.lds;
    if (F.lane < 32) {
#pragma unroll
        for (int r = 0; r < 17; ++r) red[(F.wave * 17 + r) * 32 + cq] = acc[r];
    }
    __syncthreads();
    for (int i = F.tid; i < 17 * 32; i += NTHREADS) { const int r = i >> 5, q = i & 31; f32x4 s = red[r * 32 + q];
#pragma unroll
        for (int w = 1; w < 8; ++w) s = s + red[(w * 17 + r) * 32 + q];
        const int col = cg * 128 + q * 4; s = s + ld4(a.in[5] + (size_t)layer * ADA + col);
        float* dst = r < 16 ? (float*)(F.ws + WS_MODX) + ((size_t)layer * 16 + r) * ADA + col : (float*)(F.ws + WS_MODC) + (size_t)layer * ADA + col;
        *(f32x4*)dst = s; }
    __syncthreads();
}

__device__ __forceinline__ void p0_convert(const Frame& F, const Args& a) {
    LAS unsigned* T = (LAS unsigned*)(F.lds + 70 * 1024) + F.wave * (64 * 33);
    const int gw = F.vcu * NWAVES + F.wave, NGW = F.G * NWAVES, lane = F.lane;
    bf16_t* win0 = (bf16_t*)(F.ws + WS_WIN0); bf16_t* wout0 = (bf16_t*)(F.ws + WS_WOUT0); bf16_t* wqkv1 = (bf16_t*)(F.ws + WS_WQKV1); bf16_t* wout1 = (bf16_t*)(F.ws + WS_WOUT1); bf16_t* wr = (bf16_t*)(F.ws + WS_WR);
    constexpr int I_IN = 16 * (4 + 4 + 8 + 8 + 1 + 16);
    constexpr int I_SQ = 16 * 16, I_QKV = 16 * 48, I_R = 16 * 4;
    constexpr int NIT = I_IN + I_SQ + I_QKV + I_SQ + 2 * I_R;
    for (int it = gw; it < NIT + F0_BULK; it += NGW) {
        int r = it;
        if (r < I_IN) {
            const int kt = r & 15, g = r >> 4; int col0, nc = 64, drow;
            if (g < 24) { col0 = 64 * g; drow = 64 * g; }
            else if (g == 24) { col0 = 1536; nc = 32; drow = 2560; }
            else { const int s = g - 25; const int isb = s >> 3, q = s & 7;
                col0 = 1568 + 512 * isb + 64 * q; drow = 1536 + 256 * (q >> 1) + 128 * isb + 64 * (q & 1); }
            cvt_item(a.in[10], AB_IN, col0, nc, kt * 64, win0, D, drow, T, lane); continue; }
        r -= I_IN;
        if (r < I_SQ) { cvt_matrix_item(a.in[11], D, 0, D, D, wout0, 0, r, T, lane); continue; } r -= I_SQ;
        if (r < I_QKV) { cvt_matrix_item(a.in[21], 3 * D, 0, 3 * D, D, wqkv1, 0, r, T, lane); continue; } r -= I_QKV;
        if (r < I_SQ) { cvt_matrix_item(a.in[22], D, 0, D, D, wout1, 0, r, T, lane); continue; } r -= I_SQ;
        if (r < 2 * I_R) { const int l = r / I_R; cvt_matrix_item(a.in[24] + (size_t)l * D * NEXP, NEXP, 0, NEXP, D, wr + (size_t)l * NEXP * D, 0, r % I_R, T, lane); continue; } r -= 2 * I_R;
        cvt_moe_item(a, 0, r, F.ws, T, lane);
    }
    { u32x4 z = (u32x4){0u, 0u, 0u, 0u}; const size_t n16 = (size_t)(AB_INP - AB_IN) * D * 2 / 16; u32x4* p = (u32x4*)(win0 + (size_t)AB_IN * D);
      for (size_t i = (size_t)blockIdx.x * NTHREADS + F.tid; i < n16; i += (size_t)F.G * NTHREADS) p[i] = z; }
    if (blockIdx.x == 0) { f32x2* rt = (f32x2*)(F.ws + WS_ROPE);
        for (int i = F.tid; i < 64 * 16; i += NTHREADS) { const int pos = i >> 4, f = i & 15; const float inv = powf(10000.0f, -(float)f / 16.0f); const float ang = (float)pos * inv; rt[i] = (f32x2){cosf(ang), sinf(ang)}; } }
}


__device__ __forceinline__ int gsw(int row, int ch) { return row * 128 + ((ch ^ (row & 7)) << 4); }
__device__ __forceinline__ int gla_row(int n, int p, int b, int d) {
    const bool isctx = n < 4; const int j = isctx ? n : n - 4; int pos = j * 64 + p;
    if (d) pos = (isctx ? CTXL : SEQ) - 1 - pos;
    return isctx ? NX + b * CTXL + pos : b * SEQ + pos;
}
struct GlaRaw { u32x4 q, k, v0, v1; f32x4 lr[4]; };
__device__ __forceinline__ void gla_load(GlaRaw& R, int n, int lane, int w, int b, int h, int d, const bf16_t* qb, const bf16_t* kb, const bf16_t* vb, const float* lr) {
    const int row = gla_row(n, lane, b, d);
    R.q = *(const u32x4*)(qb + (size_t)row * 256 + h * 64 + 8 * w);
    R.k = *(const u32x4*)(kb + (size_t)row * 256 + h * 64 + 8 * w);
    R.v0 = *(const u32x4*)(vb + (size_t)row * 512 + h * 128 + 8 * w);
    R.v1 = *(const u32x4*)(vb + (size_t)row * 512 + h * 128 + 64 + 8 * w);
#pragma unroll
    for (int i = 0; i < 4; ++i) R.lr[i] = *(const f32x4*)(lr + (size_t)row * 32 + d * 16 + 4 * i);
}
__device__ __forceinline__ void unpack8(const u32x4& w, float (&f)[8]) { f[0] = bflo(w.x); f[1] = bfhi(w.x); f[2] = bflo(w.y); f[3] = bfhi(w.y); f[4] = bflo(w.z); f[5] = bfhi(w.z); f[6] = bflo(w.w); f[7] = bfhi(w.w); }
constexpr int GPL_QE = 0, GPL_KE = 8192, GPL_OUT = 16384, GPL_BUF = 16384 + GI_BYTES + 256, GPL_DW = 2 * GPL_BUF, GPL_DB = GPL_DW + 4096, GPL_END = GPL_DB + 256;
static_assert(GPL_END <= RING_BYTES && (GPL_BUF % 16) == 0, "gla prep lds");
__device__ __forceinline__ void gla_prep_phase(const Frame& F, const Args& a) {
    LAS unsigned char* L = F.lds; const int lane = F.lane, w = F.wave, r16 = lane & 15, g4 = lane >> 4;
    const bf16_t* qb = (const bf16_t*)(F.ws + T_QB); const bf16_t* kb = (const bf16_t*)(F.ws + T_KB); const bf16_t* vb = (const bf16_t*)(F.ws + T_VB); const float* lrb = (const float*)(F.ws + T_LR);
    for (int cc = blockIdx.x; cc < 256; cc += F.G) {
        const int sq = cc & 127, b = sq >> 3, h = (sq >> 1) & 3, d = sq & 1;
        const float* dw = d ? a.in[14] : a.in[12]; const float* db = d ? a.in[15] : a.in[13];
        __syncthreads();
        for (int i = F.tid; i < 16 * 64; i += NTHREADS) ((LAS float*)(L + GPL_DW))[i] = dw[(i >> 6) * GLA_QK + h * 64 + (i & 63)];
        if (F.tid < 64) ((LAS float*)(L + GPL_DB))[F.tid] = db[h * 64 + F.tid];
        GlaRaw R; gla_load(R, cc >> 7, lane, w, b, h, d, qb, kb, vb, lrb);
        __syncthreads();
        for (int k = 0; k < 18; ++k) {
            const int n = (cc >> 7) + 2 * k;
            LAS unsigned char* PB = L + (k & 1) * GPL_BUF; LAS unsigned char* OUT = PB + GPL_OUT;
            {
                float z[8], q[8], kk[8], v0[8], v1[8];
                unpack8(R.q, q); unpack8(R.k, kk); unpack8(R.v0, v0); unpack8(R.v1, v1);
                const LAS float* DW = (const LAS float*)(L + GPL_DW); const LAS float* DB = (const LAS float*)(L + GPL_DB);
#pragma unroll
                for (int j = 0; j < 8; ++j) z[j] = DB[8 * w + j];
#pragma unroll
                for (int r = 0; r < 16; ++r) { const float x = R.lr[r >> 2][r & 3]; const f32x4 w0 = *(const LAS f32x4*)(DW + r * 64 + 8 * w), w1 = *(const LAS f32x4*)(DW + r * 64 + 8 * w + 4);
                    z[0] += x * w0.x; z[1] += x * w0.y; z[2] += x * w0.z; z[3] += x * w0.w; z[4] += x * w1.x; z[5] += x * w1.y; z[6] += x * w1.z; z[7] += x * w1.w; }
                float qe[8], ke[8], qi[8]; unsigned short ko[8];
#pragma unroll
                for (int j = 0; j < 8; ++j) {
                    float ld = (fminf(z[j], 0.f) - __logf(1.0f + __expf(-fabsf(z[j])))) * (1.0f / 16.0f);
#pragma unroll
                    for (int o = 1; o < 64; o <<= 1) { const float t = __shfl_up(ld, o); if (lane >= o) ld += t; }
                    const float bm = __shfl(ld, 31), bl = __shfl(ld, 63);
                    qe[j] = q[j] * __expf(ld - bm); ke[j] = kk[j] * __expf(bm - ld); qi[j] = q[j] * __expf(ld); ko[j] = (unsigned short)f2bf(kk[j] * __expf(bl - ld));
                    if (lane == 0) ((LAS float*)(OUT + GI_DEC))[8 * w + j] = __expf(bl);
                }
                *(LAS u32x4*)(PB + GPL_QE + gsw(lane, w)) = (u32x4){pk2(qe[0], qe[1]), pk2(qe[2], qe[3]), pk2(qe[4], qe[5]), pk2(qe[6], qe[7])};
                *(LAS u32x4*)(PB + GPL_KE + gsw(lane, w)) = (u32x4){pk2(ke[0], ke[1]), pk2(ke[2], ke[3]), pk2(ke[4], ke[5]), pk2(ke[6], ke[7])};
                *(LAS u32x4*)(OUT + GI_QIN + gsw(lane, w)) = (u32x4){pk2(qi[0], qi[1]), pk2(qi[2], qi[3]), pk2(qi[4], qi[5]), pk2(qi[6], qi[7])};
#pragma unroll
                for (int j = 0; j < 8; ++j) { const int rw = 8 * w + j;
                    *(LAS unsigned short*)(OUT + GI_KOT + gsw(rw, lane >> 3) + (lane & 7) * 2) = ko[j];
                    *(LAS unsigned short*)(OUT + GI_VT + gsw(rw, lane >> 3) + (lane & 7) * 2) = (unsigned short)f2bf(v0[j]);
                    *(LAS unsigned short*)(OUT + GI_VT + gsw(64 + rw, lane >> 3) + (lane & 7) * 2) = (unsigned short)f2bf(v1[j]); }
            }
            if (k + 1 < 18) gla_load(R, n + 2, lane, w, b, h, d, qb, kb, vb, lrb);
            lds_barrier();
#pragma unroll
            for (int i = 0; i < 2; ++i) { const int tI = 2 * w + i, st = tI >> 2, pt = tI & 3;
                f32x4 c = (f32x4){0.f, 0.f, 0.f, 0.f};
                if (st <= pt) {
#pragma unroll
                    for (int ks = 0; ks < 2; ++ks) { const bf16x8 af = *(const LAS bf16x8*)(PB + GPL_KE + gsw(16 * st + r16, 4 * ks + g4)), bfr = *(const LAS bf16x8*)(PB + GPL_QE + gsw(16 * pt + r16, 4 * ks + g4));
                        c = __builtin_amdgcn_mfma_f32_16x16x32_bf16(af, bfr, c, 0, 0, 0); }
                    const int p = 16 * pt + r16, s0 = 16 * st + 4 * g4;
#pragma unroll
                    for (int e = 0; e < 4; ++e) if (s0 + e > p) c[e] = 0.f;
                }
                u32x2 o; o.x = pk2(c[0], c[1]); o.y = pk2(c[2], c[3]);
                *(LAS u32x2*)(OUT + GI_A + gsw(16 * pt + r16, 2 * st + (g4 >> 1)) + (g4 & 1) * 8) = o; }
            lds_barrier();
            { unsigned char* rec = F.ws + T_GLA + (size_t)(sq * 36 + n) * GI_BYTES;
              for (int i = F.tid; i < GI_BYTES / 16; i += NTHREADS) *(u32x4*)(rec + i * 16) = *(const LAS u32x4*)(OUT + i * 16); }
        }
    }
    __syncthreads();
}
constexpr int GSL_IN = 33792  , GSL_ST = 3 * GSL_IN, GSL_END = GSL_ST + 2 * 8192;
static_assert(GSL_END <= RING_BYTES, "gla seq lds");
__device__ __forceinline__ void gla_seq_phase(const Frame& F, const Args& a) {
    LAS unsigned char* L = F.lds; const int lane = F.lane, w = F.wave, r16 = lane & 15, g4 = lane >> 4, tid = F.tid;
    for (int it = blockIdx.x; it < 256; it += F.G) {
        const int sq = it >> 1, vh = it & 1, b = sq >> 3, h = (sq >> 1) & 3, d = sq & 1;
        bf16_t* ob = (bf16_t*)(F.ws + (d ? T_OB : T_OF));
        const unsigned char* rec0 = F.ws + T_GLA + (size_t)(sq * 36) * GI_BYTES;
        __syncthreads();
        for (int i = tid; i < 2 * 8192 / 4; i += NTHREADS) ((LAS unsigned*)(L + GSL_ST))[i] = 0u;
        f32x4 Sacc[2] = {(f32x4){0.f, 0.f, 0.f, 0.f}, (f32x4){0.f, 0.f, 0.f, 0.f}};
#define GLA_DMA(n_) do { const unsigned char* r_ = rec0 + (size_t)(n_) * GI_BYTES; LAS unsigned char* d_ = L + ((n_) % 3) * GSL_IN; \
            __builtin_amdgcn_global_load_lds((const unsigned*)(r_ + GI_A + tid * 16), (LAS unsigned*)(d_ + w * 1024), 16, 0, 0); \
            __builtin_amdgcn_global_load_lds((const unsigned*)(r_ + GI_QIN + tid * 16), (LAS unsigned*)(d_ + 8192 + w * 1024), 16, 0, 0); \
            __builtin_amdgcn_global_load_lds((const unsigned*)(r_ + GI_KOT + tid * 16), (LAS unsigned*)(d_ + 16384 + w * 1024), 16, 0, 0); \
            __builtin_amdgcn_global_load_lds((const unsigned*)(r_ + GI_VT + vh * 8192 + tid * 16), (LAS unsigned*)(d_ + 24576 + w * 1024), 16, 0, 0); \
            __builtin_amdgcn_global_load_lds((const unsigned*)(r_ + GI_DEC + lane * 16), (LAS unsigned*)(d_ + 32768), 16, 0, 0); } while (0)
        GLA_DMA(0); GLA_DMA(1);
        for (int n = 0; n < 36; ++n) {
            LAS unsigned char* IN = L + (n % 3) * GSL_IN; LAS unsigned char* STr = L + GSL_ST + (n & 1) * 8192; LAS unsigned char* STw = L + GSL_ST + ((n + 1) & 1) * 8192;
            if (n == 0) asm volatile("s_waitcnt vmcnt(5)" ::: "memory"); else if (n < 35) asm volatile("s_waitcnt vmcnt(7)" ::: "memory"); else asm volatile("s_waitcnt vmcnt(2)" ::: "memory");
            lds_barrier();
            if (n + 2 < 36) GLA_DMA(n + 2);
#pragma unroll
            for (int i = 0; i < 2; ++i) { const int tI = 2 * w + i, vt = tI >> 2, pt = tI & 3;
                f32x4 c = (f32x4){0.f, 0.f, 0.f, 0.f};
#pragma unroll
                for (int ks = 0; ks < 2; ++ks) {
                    const bf16x8 a1 = *(const LAS bf16x8*)(IN + 24576 + gsw(16 * vt + r16, 4 * ks + g4)), b1 = *(const LAS bf16x8*)(IN + gsw(16 * pt + r16, 4 * ks + g4));
                    c = __builtin_amdgcn_mfma_f32_16x16x32_bf16(a1, b1, c, 0, 0, 0);
                    const bf16x8 a2 = *(const LAS bf16x8*)(STr + gsw(16 * vt + r16, 4 * ks + g4)), b2 = *(const LAS bf16x8*)(IN + 8192 + gsw(16 * pt + r16, 4 * ks + g4));
                    c = __builtin_amdgcn_mfma_f32_16x16x32_bf16(a2, b2, c, 0, 0, 0); }
                const int row = gla_row(n, 16 * pt + r16, b, d);
                u32x2 o; o.x = pk2(c[0], c[1]); o.y = pk2(c[2], c[3]);
                *(u32x2*)(ob + (size_t)row * 512 + h * 128 + vh * 64 + 16 * vt + 4 * g4) = o; }
#pragma unroll
            for (int i = 0; i < 2; ++i) { const int tI = 2 * w + i, ct = tI >> 2, vt = tI & 3;
                const f32x4 dc = *(const LAS f32x4*)(IN + 32768 + (16 * ct + 4 * g4) * 4);
                f32x4 c = Sacc[i] * dc;
#pragma unroll
                for (int ks = 0; ks < 2; ++ks) { const bf16x8 af = *(const LAS bf16x8*)(IN + 16384 + gsw(16 * ct + r16, 4 * ks + g4)), bfr = *(const LAS bf16x8*)(IN + 24576 + gsw(16 * vt + r16, 4 * ks + g4));
                    c = __builtin_amdgcn_mfma_f32_16x16x32_bf16(af, bfr, c, 0, 0, 0); }
                Sacc[i] = c;
                u32x2 o; o.x = pk2(c[0], c[1]); o.y = pk2(c[2], c[3]);
                *(LAS u32x2*)(STw + gsw(16 * vt + r16, 2 * ct + (g4 >> 1)) + (g4 & 1) * 8) = o; }
        }
#undef GLA_DMA
        asm volatile("s_waitcnt vmcnt(0)" ::: "memory");
    }
    __syncthreads();
}

__device__ __forceinline__ void finish_conv_phase(const Frame& F, const Args& a) {
    const int lane = F.lane; bf16_t* cat = (bf16_t*)(F.ws + T_CAT);
    {
        const bf16_t* of = (const bf16_t*)(F.ws + T_OF); const bf16_t* obk = (const bf16_t*)(F.ws + T_OB); const bf16_t* gb = (const bf16_t*)(F.ws + T_GB);
        const int gw = F.vcu * NWAVES + F.wave, NGW = F.G * NWAVES;
        float gg[8];
#pragma unroll
        for (int j = 0; j < 8; ++j) gg[j] = a.in[16][8 * lane + j];
        for (int row = gw; row < NT; row += NGW) {
            float x[8], y[8], g[8];
            unpack8(*(const u32x4*)(of + (size_t)row * 512 + 8 * lane), x); unpack8(*(const u32x4*)(obk + (size_t)row * 512 + 8 * lane), y); unpack8(*(const u32x4*)(gb + (size_t)row * 512 + 8 * lane), g);
            float ss = 0.f;
#pragma unroll
            for (int j = 0; j < 8; ++j) { x[j] += y[j]; ss += x[j] * x[j]; }
            ss += __shfl_xor(ss, 1); ss += __shfl_xor(ss, 2); ss += __shfl_xor(ss, 4); ss += __shfl_xor(ss, 8);
            const float rs = rsqrtf(ss * (1.0f / 128.0f) + RMS_EPS);
#pragma unroll
            for (int j = 0; j < 8; ++j) x[j] = x[j] * rs * gg[j] * siluf_(g[j]);
            *(u32x4*)(cat + (size_t)row * D + 8 * lane) = (u32x4){pk2(x[0], x[1]), pk2(x[2], x[3]), pk2(x[4], x[5]), pk2(x[6], x[7])};
        }
    }
    {
        const bf16_t* ub = (const bf16_t*)(F.ws + T_UB); LAS float* tile = (LAS float*)F.lds;
        const int c = F.tid;
        float wv[CONV_W];
#pragma unroll
        for (int j = 0; j < CONV_W; ++j) wv[j] = a.in[17][j * CONV_CH + c];
        const float cb = a.in[18][c];
        float lg[8], lb[8];
#pragma unroll
        for (int i = 0; i < 8; ++i) { lg[i] = a.in[19][lane + 64 * i]; lb[i] = a.in[20][lane + 64 * i]; }
        for (int ti = blockIdx.x; ti < NT / 32; ti += F.G) {
            const int row0 = ti * 32; const bool lat = row0 < NX;
            const int t0 = lat ? (row0 & (SEQ - 1)) : ((row0 - NX) & (CTXL - 1)); const int len = lat ? SEQ : CTXL; const int sbase = row0 - t0;
            float in[62];
            unsigned short raw[62];
#pragma unroll
            for (int i = 0; i < 62; ++i) { int t = t0 - 15 + i; t = t < 0 ? 0 : (t >= len ? len - 1 : t); raw[i] = ub[(size_t)(sbase + t) * 512 + c]; }
#pragma unroll
            for (int i = 0; i < 62; ++i) { const int t = t0 - 15 + i; in[i] = (t >= 0 && t < len) ? bf2f(raw[i]) : 0.f; }
            __syncthreads();
#pragma unroll
            for (int t = 0; t < 32; ++t) { float s = cb;
#pragma unroll
                for (int j = 0; j < CONV_W; ++j) s += wv[j] * in[t + j];
                tile[t * 512 + c] = s; }
            __syncthreads();
#pragma unroll
            for (int q = 0; q < 4; ++q) { const int t = 4 * F.wave + q; float v[8]; float s = 0.f;
#pragma unroll
                for (int i = 0; i < 8; ++i) { v[i] = tile[t * 512 + lane + 64 * i]; s += v[i]; }
                const float mu = wave_sum(s) * (1.0f / 512.0f); float qq = 0.f;
#pragma unroll
                for (int i = 0; i < 8; ++i) { v[i] -= mu; qq += v[i] * v[i]; }
                const float rstd = rsqrtf(wave_sum(qq) * (1.0f / 512.0f) + LN_EPS);
#pragma unroll
                for (int i = 0; i < 8; ++i) { const float y = v[i] * rstd * lg[i] + lb[i]; cat[(size_t)(row0 + t) * D + 512 + lane + 64 * i] = (bf16_t)f2bf(siluf_(y)); } }
        }
        __syncthreads();
    }
}


constexpr int CW_TST = 20480;
constexpr int AUX_TST = AUX_OFF, AUX_TILEE = AUX_OFF + 1040, AUX_IDX = AUX_OFF + 1168;
constexpr int MOE_MAXU = 32, MOE_MAXIDX = 16;
static_assert(AUX_IDX + MOE_MAXIDX * 1024 <= MISC_OFF, "aux lds");

struct EpiRouter {
    static constexpr bool PERM = false, AFTER_DRAIN = true;
    const float* rbias; int* asg_e; int* asg_r; float* asg_g; unsigned* counts;
    __device__ __forceinline__ void operator()(const f32x4 (&)[2][2][4][2], const Unit&, int, int, int, int) const {}
    __device__ __forceinline__ void fused(const f32x4 (&acc)[2][2][4][2], const Unit& u, int wr, int wc, int fr, int fq, LAS unsigned char* lds, int wid, int lane) const {
        LAS float* SC = (LAS float*)lds;
        LAS unsigned* lcnt = (LAS unsigned*)(lds + 66560); LAS unsigned* lbase = lcnt + 256;
        LAS int* selE = (LAS int*)(lbase + 256); LAS int* selR = selE + 2048;
        const int tid = wid * 64 + lane;
        if (tid < 256) lcnt[tid] = 0u;
        const f32x4 rb = *(const f32x4*)(rbias + 4 * lane);
        const float NINF = -__builtin_inff();
#pragma unroll
        for (int ai = 0; ai < 2; ++ai)
#pragma unroll
            for (int mm = 0; mm < 2; ++mm) {
                LDS_WAIT(); __builtin_amdgcn_s_barrier(); asm volatile("" ::: "memory");
#pragma unroll
                for (int mi = 0; mi < 2; ++mi) { const int lr = 32 * wr + 16 * mi + fr;
#pragma unroll
                    for (int bj = 0; bj < 2; ++bj)
#pragma unroll
                        for (int n = 0; n < 2; ++n) *(LAS f32x4*)(SC + lr * 260 + 128 * bj + 32 * wc + 16 * n + 4 * fq) = acc[ai][bj][2 * mm + mi][n]; }
                LDS_WAIT(); __builtin_amdgcn_s_barrier(); asm volatile("" ::: "memory");
                for (int q = 0; q < 8; ++q) {
                    const int lr = 8 * wid + q; const int rit = 128 * ai + 64 * (lr >> 5) + 16 * (2 * mm + ((lr >> 4) & 1)) + (lr & 15);
                    const f32x4 lg = *(const LAS f32x4*)(SC + lr * 260 + 4 * lane);
                    float s[4], cd[4];
#pragma unroll
                    for (int j = 0; j < 4; ++j) { s[j] = 1.0f / (1.0f + __expf(-lg[j])); cd[j] = s[j] + rb[j]; }
                    float m1 = fmaxf(cd[0], cd[1]), m2 = fminf(cd[0], cd[1]);
                    { const float x = cd[2]; const float n1 = fmaxf(m1, x); m2 = fmaxf(fminf(m1, x), m2); m1 = n1; }
                    { const float x = cd[3]; const float n1 = fmaxf(m1, x); m2 = fmaxf(fminf(m1, x), m2); m1 = n1; }
#pragma unroll
                    for (int o = 1; o < 8; o <<= 1) { const float a1 = __shfl_xor(m1, o), a2 = __shfl_xor(m2, o); const float n1 = fmaxf(m1, a1); m2 = fmaxf(fminf(m1, a1), fmaxf(m2, a2)); m1 = n1; }
                    const float gs = m1 + m2; const int mygrp = lane >> 3; int rank = 0;
#pragma unroll
                    for (int g = 0; g < 8; ++g) { const float og = __shfl(gs, 8 * g); rank += (og > gs || (og == gs && g < mygrp)) ? 1 : 0; }
                    if (rank >= 4) { cd[0] = NINF; cd[1] = NINF; cd[2] = NINF; cd[3] = NINF; }
                    int myE = 0; float myG = 0.f; float gsum = 0.f;
#pragma unroll
                    for (int k = 0; k < TOPK; ++k) {
                        float bv = cd[0]; int bi = 0;
                        if (cd[1] > bv) { bv = cd[1]; bi = 1; } if (cd[2] > bv) { bv = cd[2]; bi = 2; } if (cd[3] > bv) { bv = cd[3]; bi = 3; }
                        float v = bv; int ix = 4 * lane + bi;
#pragma unroll
                        for (int o = 32; o >= 1; o >>= 1) { const float ov = __shfl_xor(v, o); const int oi = __shfl_xor(ix, o); if (ov > v || (ov == v && oi < ix)) { v = ov; ix = oi; } }
                        const int sl = ix & 3; const float mys = sl == 0 ? s[0] : (sl == 1 ? s[1] : (sl == 2 ? s[2] : s[3]));
                        const float gv = __shfl(mys, ix >> 2);
                        gsum += gv;
                        if (lane == k) { myE = ix; myG = gv; }
                        if (lane == (ix >> 2)) { if (sl == 0) cd[0] = NINF; else if (sl == 1) cd[1] = NINF; else if (sl == 2) cd[2] = NINF; else cd[3] = NINF; }
                    }
                    if (lane < TOPK) { const unsigned r = __hip_atomic_fetch_add(&lcnt[myE], 1u, __ATOMIC_RELAXED, __HIP_MEMORY_SCOPE_WORKGROUP); selE[rit * 8 + lane] = myE; selR[rit * 8 + lane] = (int)r; asg_g[(size_t)(u.orow + rit) * 8 + lane] = myG / gsum * 2.5f; }
                }
            }
        LDS_WAIT(); __builtin_amdgcn_s_barrier(); asm volatile("" ::: "memory");
        if (tid < 256) { const unsigned c = lcnt[tid]; lbase[tid] = c ? atomicAdd(&counts[tid], c) : 0u; }
        LDS_WAIT(); __builtin_amdgcn_s_barrier(); asm volatile("" ::: "memory");
        for (int i = tid; i < 2048; i += NTHREADS) { const int e = selE[i]; asg_e[(size_t)u.orow * 8 + i] = e; asg_r[(size_t)u.orow * 8 + i] = (int)lbase[e] + selR[i]; }
    }
};

__device__ __forceinline__ void moe_place(const Frame& F, int layer, int ntok) {
    LAS int* cnt = (LAS int*)F.lds; LAS int* tst = cnt + 256;
    const unsigned* counts = F.ctl + CW_CNT + layer * 256;
    const int* asg_e = (const int*)(F.ws + M_AE); const int* asg_r = (const int*)(F.ws + M_AR); int* tslot = (int*)(F.ws + M_TS); int* stok = (int*)(F.ws + M_ST);
    __syncthreads();
    if (F.tid < 256) cnt[F.tid] = (int)counts[F.tid];
    __syncthreads();
    if (F.tid == 0) { int acc = 0; for (int e = 0; e < 256; ++e) { tst[e] = acc; acc += (cnt[e] + 255) >> 8; } tst[256] = acc; }
    __syncthreads();
    const int ntr = tst[256];
    if (blockIdx.x == 0) for (int i = F.tid; i < 257; i += NTHREADS) F.ctl[CW_TST + layer * 320 + i] = (unsigned)tst[i];
    const int gt = blockIdx.x * NTHREADS + F.tid, gs = F.G * NTHREADS;
    for (int i = gt; i < ntok * 8; i += gs) { const int e = asg_e[i]; const int slot = tst[e] * 256 + asg_r[i]; stok[slot] = i >> 3; tslot[i] = slot; }
    for (int e = blockIdx.x; e < 256; e += F.G) { const int s0 = tst[e] * 256 + cnt[e], s1 = tst[e + 1] * 256; for (int s = s0 + F.tid; s < s1; s += NTHREADS) stok[s] = 0; }
    for (int i = gt; i < ntok; i += gs) stok[ntr * 256 + i] = i;
    __syncthreads();
}

template <int NCOL>
__device__ __forceinline__ int moe_units_setup(const Frame& F, int layer, int ntok, int c, bool want_idx) {
    LAS int* tst = (LAS int*)(F.lds + AUX_TST); LAS int* tileE = (LAS int*)(F.lds + AUX_TILEE); LAS int* idxl = (LAS int*)(F.lds + AUX_IDX);
    __syncthreads();
    for (int i = F.tid; i < 257; i += NTHREADS) tst[i] = (int)F.ctl[CW_TST + layer * 320 + i];
    __syncthreads();
    const int ntr = tst[256], nunits = (ntr + ntok / 256) * NCOL;
    int nu = c < nunits ? (nunits - c + F.G - 1) / F.G : 0; if (nu > MOE_MAXU) nu = MOE_MAXU; if (want_idx && nu > MOE_MAXIDX) nu = MOE_MAXIDX;
    if (F.tid < nu) { const int rt = (c + F.tid * F.G) / NCOL; int e;
        if (rt >= ntr) e = NEXP; else { int lo = 0, hi = 255; while (lo < hi) { const int mid = (lo + hi + 1) >> 1; if (tst[mid] <= rt) lo = mid; else hi = mid - 1; } e = lo; }
        tileE[F.tid] = e; }
    if (want_idx) { const int* stok = (const int*)(F.ws + M_ST); for (int i = F.tid; i < nu * 256; i += NTHREADS) idxl[i] = stok[(size_t)((c + (i >> 8) * F.G) / NCOL) * 256 + (i & 255)]; }
    __syncthreads();
    return nu;
}
struct SchedMoeGU {
    const char* A; const char* W; const LAS int* tileE; const LAS int* idxl; int nu, G, c;
    __device__ __forceinline__ bool next(int i, Unit& u) const {
        if (i >= nu) return false; const int un = c + i * G; const int rt = un >> 1, col = un & 1; const int e = tileE[i];
        u.a = i; u.b = e * 512 + col * 256; u.orow = rt * 256; u.ocol = col * 128; u.aux = e; return true; }
    __device__ __forceinline__ const char* a_base() const { return A; }
    __device__ __forceinline__ const char* b_ptr(const Unit& u) const { return W + (size_t)u.b * D * 2; }
    __device__ __forceinline__ void a_off(const Unit& u, const int (&R)[2], const int (&C)[2], unsigned (&o0)[2], unsigned (&o1)[2]) const {
#pragma unroll
        for (int i = 0; i < 2; ++i) { const int t0 = idxl[u.a * 256 + R[i]], t1 = idxl[u.a * 256 + 128 + R[i]]; o0[i] = (unsigned)t0 * (unsigned)(D * 2) + (unsigned)C[i] * 2u; o1[i] = (unsigned)t1 * (unsigned)(D * 2) + (unsigned)C[i] * 2u; }
    }
};
struct EpiGateUp {
    static constexpr bool PERM = true, AFTER_DRAIN = false;
    bf16_t* hid;
    __device__ __forceinline__ void operator()(const f32x4 (&acc)[2][2][4][2], const Unit& u, int wr, int wc, int fr, int fq) const {
        const int lane = fr + 16 * fq; const int srcb = ((lane >> 2) + 16 * (lane & 3)) << 2;
        const int row0 = u.orow + wr * 64 + (lane >> 2), col0 = u.ocol + wc * 32 + 8 * (lane & 3);
#pragma unroll
        for (int ai = 0; ai < 2; ++ai)
#pragma unroll
            for (int m = 0; m < 4; ++m) { float h[8];
#pragma unroll
                for (int n = 0; n < 2; ++n)
#pragma unroll
                    for (int e = 0; e < 4; ++e) { const float g = acc[ai][0][m][n][e], up = acc[ai][1][m][n][e]; h[4 * n + e] = g / (1.0f + __expf(-g)) * up; }
                u32x4 w; w.x = cvt_pk_bf16(h[0], h[1]); w.y = cvt_pk_bf16(h[2], h[3]); w.z = cvt_pk_bf16(h[4], h[5]); w.w = cvt_pk_bf16(h[6], h[7]);
                u32x4 t; t.x = (unsigned)__builtin_amdgcn_ds_bpermute(srcb, (int)w.x); t.y = (unsigned)__builtin_amdgcn_ds_bpermute(srcb, (int)w.y); t.z = (unsigned)__builtin_amdgcn_ds_bpermute(srcb, (int)w.z); t.w = (unsigned)__builtin_amdgcn_ds_bpermute(srcb, (int)w.w);
                *(u32x4*)(hid + (size_t)(row0 + ai * 128 + m * 16) * DEXP + col0) = t; }
    }
};
struct SchedMoeDN {
    const char* A; const char* W; const LAS int* tileE; int nu, G, c;
    __device__ __forceinline__ bool next(int i, Unit& u) const {
        if (i >= nu) return false; const int un = c + i * G; const int rt = un >> 2, col = un & 3; const int e = tileE[i];
        u.a = rt; u.b = e * 1024 + col * 256; u.orow = rt * 256; u.ocol = col * 256; u.aux = e; return true; }
    __device__ __forceinline__ const char* a_base() const { return A; }
    __device__ __forceinline__ const char* b_ptr(const Unit& u) const { return W + (size_t)u.b * DEXP * 2; }
    __device__ __forceinline__ void a_off(const Unit& u, const int (&R)[2], const int (&C)[2], unsigned (&o0)[2], unsigned (&o1)[2]) const {
#pragma unroll
        for (int i = 0; i < 2; ++i) { o0[i] = (unsigned)((u.a * 256 + R[i]) * DEXP + C[i]) * 2u; o1[i] = o0[i] + (unsigned)(128 * DEXP * 2); }
    }
};

constexpr int NA_RING = 11, NA_VR = 0, NA_VC = NA_RING * 64 * 128, NA_KC = NA_VC + 256 * 128, NA_RPB = NA_KC + 256 * 128, NA_END = NA_RPB + 15 * 128;
static_assert(NA_END <= MISC_OFF, "na lds");
typedef short s16x4 __attribute__((ext_vector_type(4)));
__device__ __forceinline__ int na_voff(int row, int ch) { return row * 128 + ((((ch >> 1) ^ ((row >> 1) & 3)) << 5) | ((ch & 1) << 4)); }
__device__ __forceinline__ int na_koff(int row, int ch) { return row * 128 + ((ch ^ (row & 7)) << 4); }
template <bool CTX, int TB>
__device__ __forceinline__ void na_seg(LAS unsigned char* L, bf16x8 (&kf)[8][2], const char* knext, unsigned loff, const bf16x8 (&qf)[2], int seg, int r16, int g4, int r0, int band, const int (&boff)[2][4], int rbase,
                                       const int (&voff)[4], f32x4 (&O)[4], float& m_run, float& sum) {
    const float NINF = -__builtin_inff();
    float S[8][4]; float mx = NINF;
#pragma unroll
    for (int t = 0; t < 8; ++t) {
        f32x4 c = (f32x4){0.f, 0.f, 0.f, 0.f};
        if (CTX) {
            const int key = 128 * seg + 16 * t + r16;
            const bf16x8 k0 = *(const LAS bf16x8*)(L + NA_KC + na_koff(key, g4)), k1 = *(const LAS bf16x8*)(L + NA_KC + na_koff(key, 4 + g4));
            c = __builtin_amdgcn_mfma_f32_16x16x32_bf16(k0, qf[0], c, 0, 0, 0); c = __builtin_amdgcn_mfma_f32_16x16x32_bf16(k1, qf[1], c, 0, 0, 0);
#pragma unroll
            for (int e = 0; e < 4; ++e) S[t][e] = c[e];
        } else {
            c = __builtin_amdgcn_mfma_f32_16x16x32_bf16(kf[t][0], qf[0], c, 0, 0, 0); c = __builtin_amdgcn_mfma_f32_16x16x32_bf16(kf[t][1], qf[1], c, 0, 0, 0);
#pragma unroll
            for (int e = 0; e < 4; ++e) S[t][e] = c[e] + *(const LAS float*)(L + rbase + ((TB + t) >> 1) * 128 + boff[t & 1][e]);
        }
        mx = fmaxf(mx, fmaxf(fmaxf(S[t][0], S[t][1]), fmaxf(S[t][2], S[t][3])));
    }
    if (!CTX && TB == 0) {
#pragma unroll
        for (int t = 0; t < 8; ++t) { const char* bt = knext + (size_t)((t >> 1) * 64 + 16 * (t & 1)) * D * 2; kf[t][0] = *(const bf16x8*)(bt + loff); kf[t][1] = *(const bf16x8*)(bt + loff + 64); }
    }
    mx = fmaxf(mx, __shfl_xor(mx, 16)); mx = fmaxf(mx, __shfl_xor(mx, 32));
    const float m_new = fmaxf(m_run, mx); const float alpha = __builtin_amdgcn_exp2f(m_run - m_new); m_run = m_new;
    float ps = 0.f;
#pragma unroll
    for (int t = 0; t < 8; ++t)
#pragma unroll
        for (int e = 0; e < 4; ++e) { const float p = __builtin_amdgcn_exp2f(S[t][e] - m_new); S[t][e] = p; ps += p; }
    ps += __shfl_xor(ps, 16); ps += __shfl_xor(ps, 32);
    sum = sum * alpha + ps;
#pragma unroll
    for (int mt = 0; mt < 4; ++mt) O[mt] = O[mt] * alpha;
#pragma unroll
    for (int j = 0; j < 4; ++j) {
        bf16x8 pb; { const u32x4 ww = (u32x4){cvt_pk_bf16(S[2 * j][0], S[2 * j][1]), cvt_pk_bf16(S[2 * j][2], S[2 * j][3]), cvt_pk_bf16(S[2 * j + 1][0], S[2 * j + 1][1]), cvt_pk_bf16(S[2 * j + 1][2], S[2 * j + 1][3])}; pb = __builtin_bit_cast(bf16x8, ww); }
        int ub;
        if (CTX) ub = NA_VC + (128 * seg + 32 * j) * 128; else ub = NA_VR + (((r0 + TB / 2 + j) % NA_RING) * 64 + band) * 128;
#pragma unroll
        for (int mt = 0; mt < 4; ++mt) {
            const s16x4 a0 = __builtin_amdgcn_ds_read_tr16_b64_v4i16((LAS s16x4*)(L + ub + voff[mt]));
            const s16x4 a1 = __builtin_amdgcn_ds_read_tr16_b64_v4i16((LAS s16x4*)(L + ub + voff[mt] + 16 * 128));
            const bf16x8 av = (bf16x8){a0[0], a0[1], a0[2], a0[3], a1[0], a1[1], a1[2], a1[3]};
            O[mt] = __builtin_amdgcn_mfma_f32_16x16x32_bf16(av, pb, O[mt], 0, 0, 0);
        }
    }
}
__device__ __forceinline__ void na_phase(const Frame& F, const Args& a) {
    LAS unsigned char* L = F.lds; const int lane = F.lane, w = F.wave, r16 = lane & 15, g4 = lane >> 4;
    const bf16_t* qbuf = (const bf16_t*)(F.ws + T_QKV); const bf16_t* kbuf = qbuf + (size_t)NT * D; const bf16_t* vbuf = kbuf + (size_t)NT * D; bf16_t* cat = (bf16_t*)(F.ws + T_CAT);
    const int rr = w >> 2, cb = w & 3; const int band = cb == 0 ? 0 : (cb == 1 ? 8 : (cb == 2 ? 24 : 32));
    const float NINF = -__builtin_inff();
    const int pkey = F.tid >> 3, pch = F.tid & 7;
    int boff[2][4], voff[4];
    { const int qc = 16 * cb + r16; int cs = qc - 8; cs = cs < 0 ? 0 : (cs > 48 ? 48 : cs);
#pragma unroll
      for (int hc = 0; hc < 2; ++hc)
#pragma unroll
          for (int e = 0; e < 4; ++e) { const int kc = band + 16 * hc + 4 * g4 + e; const bool ok = kc >= cs && kc < cs + 16; boff[hc][e] = (ok ? kc - qc + 15 : 31) * 4; }
      const int rl = 4 * g4 + (r16 >> 2), sw = (rl >> 1) & 3;
#pragma unroll
      for (int mt = 0; mt < 4; ++mt) voff[mt] = rl * 128 + ((mt ^ sw) << 5) + 8 * (r16 & 3); }
    for (int bh = blockIdx.x; bh < BATCH * NA_H; bh += F.G) {
        const int b = bh >> 4, h = bh & 15;
        __syncthreads();
        for (int i = F.tid; i < 15 * 32; i += NTHREADS) { const int ri = i >> 5, ci = i & 31; ((LAS float*)(L + NA_RPB))[i] = ci < 31 ? a.in[23][h * 465 + ri * 31 + ci] * 1.4426950408889634f : NINF; }
        for (int i = F.tid; i < 256 * 8; i += NTHREADS) { const int key = i >> 3, ch = i & 7; const size_t g = (size_t)(NX + b * CTXL + key) * D + h * 64 + ch * 8;
            *(LAS u32x4*)(L + NA_VC + na_voff(key, ch)) = *(const u32x4*)(vbuf + g); *(LAS u32x4*)(L + NA_KC + na_koff(key, ch)) = *(const u32x4*)(kbuf + g); }
        for (int gr = 0; gr < 9; ++gr) *(LAS u32x4*)(L + NA_VR + na_voff(gr * 64 + pkey, pch)) = *(const u32x4*)(vbuf + (size_t)(b * SEQ + gr * 64 + pkey) * D + h * 64 + pch * 8);
        for (int rp = 0; rp < 16; ++rp) {
            int R0 = 2 * rp - 4; R0 = R0 < 0 ? 0 : (R0 > 24 ? 24 : R0);
            int R0n = 2 * rp - 2; R0n = R0n < 0 ? 0 : (R0n > 24 ? 24 : R0n);
            const bool newrows = (rp < 15) && (R0n != R0);
            u32x4 nv0 = (u32x4){0u, 0u, 0u, 0u}, nv1 = nv0;
            if (newrows) { nv0 = *(const u32x4*)(vbuf + (size_t)(b * SEQ + (R0 + 9) * 64 + pkey) * D + h * 64 + pch * 8); if (R0 + 10 < 32) nv1 = *(const u32x4*)(vbuf + (size_t)(b * SEQ + (R0 + 10) * 64 + pkey) * D + h * 64 + pch * 8); }
            const int r = 2 * rp + rr; int r0 = r - 4; r0 = r0 < 0 ? 0 : (r0 > 24 ? 24 : r0);
            const int qrow = b * SEQ + r * 64 + 16 * cb + r16;
            bf16x8 qf[2];
#pragma unroll
            for (int ks = 0; ks < 2; ++ks) qf[ks] = *(const bf16x8*)(qbuf + (size_t)qrow * D + h * 64 + 32 * ks + 8 * g4);
            bf16x8 kf[8][2];
            const char* kb0 = (const char*)kbuf + ((size_t)(b * SEQ + r0 * 64 + band) * D + h * 64) * 2;
            const unsigned loff = (unsigned)(r16 * D + 8 * g4) * 2u;
#pragma unroll
            for (int t = 0; t < 8; ++t) { const char* bt = kb0 + (size_t)((t >> 1) * 64 + 16 * (t & 1)) * D * 2; kf[t][0] = *(const bf16x8*)(bt + loff); kf[t][1] = *(const bf16x8*)(bt + loff + 64); }
            const char* kb1 = kb0 + (size_t)(4 * 64) * D * 2;
            lds_barrier();
            const int rbase = NA_RPB + (r0 - r + 7) * 128;
            f32x4 O[4]; float m_run = NINF, sum = 0.f;
#pragma unroll
            for (int mt = 0; mt < 4; ++mt) O[mt] = (f32x4){0.f, 0.f, 0.f, 0.f};
#pragma nounroll
            for (int seg = 0; seg < 2; ++seg) na_seg<true, 0>(L, kf, kb1, loff, qf, seg, r16, g4, r0, band, boff, rbase, voff, O, m_run, sum);
            na_seg<false, 0>(L, kf, kb1, loff, qf, 0, r16, g4, r0, band, boff, rbase, voff, O, m_run, sum);
            na_seg<false, 8>(L, kf, kb1, loff, qf, 0, r16, g4, r0, band, boff, rbase, voff, O, m_run, sum);
            const float inv = 1.0f / sum;
#pragma unroll
            for (int mt = 0; mt < 4; ++mt) { u32x2 o; o.x = pk2(O[mt][0] * inv, O[mt][1] * inv); o.y = pk2(O[mt][2] * inv, O[mt][3] * inv);
                *(u32x2*)(cat + (size_t)qrow * D + h * 64 + 16 * mt + 4 * g4) = o; }
            if (newrows) { *(LAS u32x4*)(L + NA_VR + na_voff(((R0 + 9) % NA_RING) * 64 + pkey, pch)) = nv0; *(LAS u32x4*)(L + NA_VR + na_voff(((R0 + 10) % NA_RING) * 64 + pkey, pch)) = nv1; }
        }
    }
    __syncthreads();
}

#if MK_ONE_LAUNCH
#define GRID_BAR() xcd_barrier(bar)
#else
#define GRID_BAR() do { } while (0)
#endif
#define IN(k) (lo <= (k) && (k) < hi && (k) <= MK_LAST_PHASE)
#define SEAM(k) do { if (IN(k) && IN((k) + 1)) GRID_BAR(); } while (0)
template <int LAYER>
__device__ __forceinline__ void layer_tail(const Frame& F, const Args& args, const int lo, const int hi, const XcdBarrier& bar) {
    unsigned char* ws = args.ws;
    const float* modx = (const float*)(ws + WS_MODX); const float* modc = (const float*)(ws + WS_MODC);
    float* xw = (float*)(ws + WS_XW); bf16_t* Hb = (bf16_t*)(ws + WS_H);
    constexpr int mb = LAYER ? 16 : 7; constexpr int ntok = LAYER ? NX : NT;
    const float* lmodx = modx + (size_t)LAYER * 16 * ADA; const float* lmodc = modc + (size_t)LAYER * ADA;
    if (IN(LAYER ? 14 : 5)) REPEAT_IF(LAYER ? 14 : 5) { REP_BAR();
        SchedDense S{(const char*)(ws + T_CAT), (const char*)(ws + (LAYER ? WS_WOUT1 : WS_WOUT0)), D, ntok / 256, D / 256, 0, 1, 0, F.G, (int)blockIdx.x};
        EpiBf16 E{(bf16_t*)(ws + T_Y), D, 0, 0};
        pg8::gemm_phase<EpiBf16, SchedDense, true>(F.lds, D, S, E);
        if (LAYER == 0 && (int)blockIdx.x >= 64) cvt_moe_range(F, args, 0, F0_BULK + F0_P2, F0_BULK + F0_P2 + F0_P5, (int)blockIdx.x - 64, 192);
    }
    SEAM(LAYER ? 14 : 5);
    if (IN(LAYER ? 15 : 6)) REPEAT_IF(LAYER ? 15 : 6) { REP_BAR();
        RowPhase P{}; P.xin_lat = LAYER ? xw : args.in[0]; P.xin_ctx = LAYER ? xw + (size_t)NX * D : args.in[2]; P.xout_lat = xw; P.xout_ctx = xw + (size_t)NX * D; P.nrows = ntok; P.ysrc = 1; P.y = (const bf16_t*)(ws + T_Y);
        P.gpost = args.in[7] + LAYER * D; P.modx = lmodx; P.modc = lmodc; P.gate_chunk = 2;
        P.doH = true; P.H = Hb; P.gpre = args.in[8] + LAYER * D; P.sc_chunk = 4; P.sh_chunk = 3; P.modxH = lmodx; P.modcH = lmodc;
        row_phase(F, P);
    }
    SEAM(LAYER ? 15 : 6);
    if (IN(mb)) REPEAT_IF(mb) { REP_BAR();
        SchedDense S{(const char*)Hb, (const char*)(ws + WS_WR) + (size_t)LAYER * NEXP * D * 2, D, ntok / 256, 1, 0, 1, 0, F.G, (int)blockIdx.x};
        EpiRouter E{args.in[25] + LAYER * NEXP, (int*)(ws + M_AE), (int*)(ws + M_AR), (float*)(ws + M_AG), F.ctl + CW_CNT + LAYER * 256};
        pg8::gemm_phase<EpiRouter, SchedDense, false>(F.lds, D, S, E);
        if (LAYER == 0) { if ((int)blockIdx.x >= 144) cvt_moe_range(F, args, 0, F0_BULK + F0_P2 + F0_P5, MOE_CVT_ITEMS, (int)blockIdx.x - 144, 112); }
        else { if ((int)blockIdx.x >= 128) cvt_moe_range(F, args, 1, MOE_CVT_ITEMS - F1_P16, MOE_CVT_ITEMS, (int)blockIdx.x - 128, 128); }
    }
    SEAM(mb);
    if (IN(mb + 1)) REPEAT_IF(mb + 1) { REP_BAR(); moe_place(F, LAYER, ntok); }
    SEAM(mb + 1);
    if (IN(mb + 2)) REPEAT_IF(mb + 2) { REP_BAR();
        const int nj = moe_units_setup<2>(F, LAYER, ntok, F.vcu, true);
        SchedMoeGU S{(const char*)Hb, (const char*)(ws + WS_WGU + (size_t)LAYER * WGU_BYTES), (const LAS int*)(F.lds + AUX_TILEE), (const LAS int*)(F.lds + AUX_IDX), nj, F.G, F.vcu};
        EpiGateUp E{(bf16_t*)(ws + M_HID)};
        pg8::gemm_phase<EpiGateUp, SchedMoeGU, true>(F.lds, D, S, E);
        if (LAYER == 0) { const int ntr0 = ((const LAS int*)(F.lds + AUX_TST))[256]; int s9, s10; fill1_ranges(F, ntr0, s9, s10); const int nu = (ntr0 + NT / 256) * 2, hv = nu % F.G;
            if (hv && F.vcu >= hv) cvt_moe_range(F, args, 1, 0, s9, F.vcu - hv, F.G - hv); }
    }
    SEAM(mb + 2);
    if (IN(mb + 3)) REPEAT_IF(mb + 3) { REP_BAR();
        const int nj = moe_units_setup<4>(F, LAYER, ntok, F.vcu, false);
        SchedMoeDN S{(const char*)(ws + M_HID), (const char*)(ws + WS_WDN + (size_t)LAYER * WDN_BYTES), (const LAS int*)(F.lds + AUX_TILEE), nj, F.G, F.vcu};
        EpiF8 E{(unsigned char*)(ws + M_OUT)};
        pg8::gemm_phase<EpiF8, SchedMoeDN, true>(F.lds, DEXP, S, E);
        if (LAYER == 0) { const int ntr0 = ((const LAS int*)(F.lds + AUX_TST))[256]; int s9, s10; fill1_ranges(F, ntr0, s9, s10); const int nu = (ntr0 + NT / 256) * 4, hv = nu % F.G;
            if (hv && F.vcu >= hv) cvt_moe_range(F, args, 1, s9, s9 + s10, F.vcu - hv, F.G - hv); }
    }
    SEAM(mb + 3);
    if (IN(mb + 4)) REPEAT_IF(mb + 4) { REP_BAR();
        RowPhase P{}; P.xin_lat = xw; P.xin_ctx = xw + (size_t)NX * D; P.xout_lat = LAYER ? args.out : xw; P.xout_ctx = xw + (size_t)NX * D; P.nrows = ntok; P.ysrc = 2;
        P.mo8 = (const unsigned char*)(ws + M_OUT); P.tslot = (const int*)(ws + M_TS); P.tgate = (const float*)(ws + M_AG); P.sharedbase = (int)__hip_atomic_load(F.ctl + CW_TST + LAYER * 320 + 256, __ATOMIC_RELAXED, __HIP_MEMORY_SCOPE_AGENT) * 256;
        P.gpost = args.in[9] + LAYER * D; P.modx = lmodx; P.modc = lmodc; P.gate_chunk = 5;
        P.doH = LAYER == 0; P.H = Hb; P.gpre = args.in[6] + D; P.sc_chunk = 1; P.sh_chunk = 0; P.modxH = modx + (size_t)16 * ADA; P.modcH = modc + ADA;
        row_phase(F, P);
        if (LAYER == 0) {
            const int ntr0 = (int)__hip_atomic_load(F.ctl + CW_TST + 256, __ATOMIC_RELAXED, __HIP_MEMORY_SCOPE_AGENT); int s9, s10; fill1_ranges(F, ntr0, s9, s10);
            cvt_moe_range(F, args, 1, s9 + s10, MOE_CVT_ITEMS - F1_P12 - F1_P16, F.vcu, F.G);
        }
    }
    SEAM(mb + 4);
}

__global__ void __launch_bounds__(NTHREADS, 2) mk_fwd(Args args) {
    extern __shared__ __attribute__((aligned(16))) unsigned char lds_raw[];
    Frame F;
    F.lds = (LAS unsigned char*)lds_raw; F.MISC = (volatile LAS unsigned*)(F.lds + MISC_OFF);
    F.tid = threadIdx.x; F.lane = F.tid & 63; F.wave = __builtin_amdgcn_readfirstlane(F.tid >> 6);
    F.G = gridDim.x; { const int bx = blockIdx.x; F.vcu = (F.G % 8 == 0) ? (bx % 8) * (F.G / 8) + bx / 8 : bx; }
    F.ws = args.ws; F.ctl = (unsigned*)(args.ws + WS_CTL);
    for (int u = F.tid; u < (LDS_BYTES - MISC_OFF) / 4; u += NTHREADS) ((LAS unsigned*)(F.lds + MISC_OFF))[u] = 0u;
    __syncthreads();
    XcdBarrier bar; bar.bar = F.ctl + CW_BAR; bar.x = 0; bar.st = nullptr;
#if MK_ONE_LAUNCH
    bar = xcd_barrier_post(F.ctl + CW_BAR, F.MISC + 8);
#endif
    const int lo = args.ph_lo, hi = args.ph_hi;
    unsigned char* ws = args.ws;
    const float* modx = (const float*)(ws + WS_MODX); const float* modc = (const float*)(ws + WS_MODC);
    float* xw = (float*)(ws + WS_XW); bf16_t* Hb = (bf16_t*)(ws + WS_H);

    if (IN(0)) REPEAT_IF(0) { REP_BAR(); p0_ada(F, args); p0_convert(F, args); }
    SEAM(0);
    {
        if (IN(1)) REPEAT_IF(1) { REP_BAR();
            RowPhase P{}; P.xin_lat = args.in[0]; P.xin_ctx = args.in[2]; P.nrows = NT; P.ysrc = 0; P.modx = modx; P.modc = modc;
            P.doH = true; P.H = Hb; P.gpre = args.in[6]; P.sc_chunk = 1; P.sh_chunk = 0; P.modxH = modx; P.modcH = modc;
            row_phase(F, P);
        }
        SEAM(1);
        if (IN(2)) REPEAT_IF(2) { REP_BAR();
            SchedDense S{(const char*)Hb, (const char*)(ws + WS_WIN0), D, NT / 256, AB_INP / 256, 0, 1, 0, F.G, (int)blockIdx.x};
            EpiInproj E{(bf16_t*)(ws + T_QB), (bf16_t*)(ws + T_KB), (bf16_t*)(ws + T_VB), (bf16_t*)(ws + T_GB), (bf16_t*)(ws + T_UB), (float*)(ws + T_LR), (const f32x2*)(ws + WS_ROPE)};
            pg8::gemm_phase<EpiInproj, SchedDense, true>(F.lds, D, S, E);
            if ((int)blockIdx.x >= 48) cvt_moe_range(F, args, 0, F0_BULK, F0_BULK + F0_P2, (int)blockIdx.x - 48, 208);
        }
        SEAM(2);
        if (IN(3)) REPEAT_IF(3) { REP_BAR(); gla_prep_phase(F, args); }
        if (IN(3) && IN(22)) GRID_BAR();
        if (IN(22)) REPEAT_IF(22) { REP_BAR(); gla_seq_phase(F, args); }
        if (IN(22) && IN(4)) GRID_BAR();
        if (IN(4)) REPEAT_IF(4) { REP_BAR(); finish_conv_phase(F, args); }
        SEAM(4);

    }
    layer_tail<0>(F, args, lo, hi, bar);
    {
        if (IN(12)) REPEAT_IF(12) { REP_BAR();
            SchedDense S{(const char*)Hb, (const char*)(ws + WS_WQKV1), D, NX / 256, 12, NC / 256, 8, 4, F.G, (int)blockIdx.x};
            EpiBf16 E{(bf16_t*)(ws + T_QKV), D, D, (size_t)NT * D, 0.125f * 1.4426950408889634f};
            pg8::gemm_phase<EpiBf16, SchedDense, true>(F.lds, D, S, E);
            if ((int)blockIdx.x >= 128) cvt_moe_range(F, args, 1, MOE_CVT_ITEMS - F1_P16 - F1_P12, MOE_CVT_ITEMS - F1_P16, (int)blockIdx.x - 128, 128);
        }
        SEAM(12);
        if (IN(13)) REPEAT_IF(13) { REP_BAR(); na_phase(F, args); }
        SEAM(13);

    }
    layer_tail<1>(F, args, lo, hi, bar);

#undef IN
#undef SEAM
}

extern "C" void kernel_launch(void* const* d_in, const int* in_sizes, int n_in, void* d_out, int out_size, void* d_ws, size_t ws_size, hipStream_t stream) {
    static int grid = 0;
    if (grid == 0) {
        if (n_in != 32 || out_size != NX * D || ws_size < WS_END) { fprintf(stderr, "kernel_launch: unexpected problem (n_in %d, out %d, ws %zu < %zu)\n", n_in, out_size, ws_size, (size_t)WS_END); grid = -1; return; }
        int dev = 0, cus = 0, per_cu = 0;
        if (hipGetDevice(&dev) != hipSuccess || hipDeviceGetAttribute(&cus, hipDeviceAttributeMultiprocessorCount, dev) != hipSuccess) { grid = -1; return; }
        if (hipFuncSetAttribute((const void*)mk_fwd, hipFuncAttributeMaxDynamicSharedMemorySize, LDS_BYTES) != hipSuccess) { fprintf(stderr, "kernel_launch: hipFuncSetAttribute failed\n"); grid = -1; return; }
        if (hipOccupancyMaxActiveBlocksPerMultiprocessor(&per_cu, (const void*)mk_fwd, NTHREADS, LDS_BYTES) != hipSuccess || per_cu < 1) fprintf(stderr, "kernel_launch: occupancy query says %d\n", per_cu);
        (void)hipGetLastError();
        grid = cus;
    }
    if (grid < 0) return;
    (void)hipMemsetAsync((char*)d_ws + WS_CTL, 0, CTL_BYTES, stream);
    Args a{};
    for (int i = 0; i < 32; ++i) a.in[i] = (const float*)d_in[i];
    a.out = (float*)d_out; a.ws = (unsigned char*)d_ws;
#if MK_ONE_LAUNCH
    a.ph_lo = 0; a.ph_hi = 64;
    hipLaunchKernelGGL(mk_fwd, dim3(grid), dim3(NTHREADS), LDS_BYTES, stream, a);
#else
    for (int p = 0; p <= 20; ++p) { if (p > MK_LAST_PHASE) break; a.ph_lo = p; a.ph_hi = p + 1; hipLaunchKernelGGL(mk_fwd, dim3(grid), dim3(NTHREADS), LDS_BYTES, stream, a); }
#endif
}
```

```cpp
#include <hip/hip_runtime.h>
#include <cstdio>
#include <cstdint>

#ifndef MK_ONE_LAUNCH
#define MK_ONE_LAUNCH 1
#endif
#ifndef MK_LAST_PHASE
#define MK_LAST_PHASE 99
#endif

#ifndef MK_REP
#define MK_REP (-1)
#endif
#define REPEAT_IF(k) _Pragma("unroll") for (int _r = 0; _r < ((k) == MK_REP ? 2 : 1); ++_r)
#define REP_BAR() do { if (_r) GRID_BAR(); } while (0)

#define GAS __attribute__((address_space(1)))
#define LAS __attribute__((address_space(3)))
typedef unsigned short bf16_t;
typedef short bf16x8 __attribute__((ext_vector_type(8)));
typedef float f32x4 __attribute__((ext_vector_type(4)));
typedef float f32x2 __attribute__((ext_vector_type(2)));
typedef unsigned u32x4 __attribute__((ext_vector_type(4)));
typedef unsigned u32x2 __attribute__((ext_vector_type(2)));

constexpr int D = 1024, BATCH = 16, SEQ = 2048, CTXL = 256, GRIDW = 64;
constexpr int NX = BATCH * SEQ, NC = BATCH * CTXL, NT = NX + NC;
constexpr int ADA = 6 * D;
constexpr int GLA_H = 4, GLA_DK = 64, GLA_DV = 128, GLA_QK = 256, GLA_V = 512, CONV_CH = 512, CONV_W = 31;
constexpr int AB_IN = 2592, AB_INP = 2816;
constexpr int NA_H = 16, NA_DH = 64;
constexpr int NEXP = 256, TOPK = 8, DEXP = 256;
constexpr int NEXPS = NEXP + 1;
constexpr int PMAX = NT * TOPK + NEXP * 255 + NT;
static_assert(PMAX % 256 == 0, "PMAX");
constexpr float RMS_EPS = 1e-6f, LN_EPS = 1e-5f;
constexpr float F8_SCALE = 16.0f, F8_INV = 1.0f / 16.0f;

constexpr size_t MiB = 1u << 20;
constexpr size_t al(size_t x) { return (x + 4095) & ~(size_t)4095; }
constexpr size_t WS_CTL = 0, CTL_BYTES = 1 * MiB;
constexpr size_t WS_MODX = WS_CTL + CTL_BYTES;
constexpr size_t WS_MODC = WS_MODX + al((size_t)2 * 16 * ADA * 4);
constexpr size_t WS_ROPE = WS_MODC + al((size_t)2 * ADA * 4);
constexpr size_t WS_XW = WS_ROPE + al(64 * 16 * 8);
constexpr size_t WS_H = WS_XW + al((size_t)NT * D * 4);
constexpr size_t WS_WIN0 = WS_H + al((size_t)NT * D * 2);
constexpr size_t WS_WOUT0 = WS_WIN0 + al((size_t)AB_INP * D * 2);
constexpr size_t WS_WQKV1 = WS_WOUT0 + al((size_t)D * D * 2);
constexpr size_t WS_WOUT1 = WS_WQKV1 + al((size_t)3 * D * D * 2);
constexpr size_t WS_WR = WS_WOUT1 + al((size_t)D * D * 2);
constexpr size_t WGU_BYTES = al((size_t)NEXPS * 512 * D * 2), WDN_BYTES = al((size_t)NEXPS * D * 256 * 2);
constexpr size_t WS_WGU = WS_WR + al((size_t)2 * NEXP * D * 2);
constexpr size_t WS_WDN = WS_WGU + 2 * WGU_BYTES;
constexpr size_t WS_T = WS_WDN + 2 * WDN_BYTES;
constexpr size_t T_QB = WS_T;
constexpr size_t T_KB = T_QB + al((size_t)NT * 256 * 2);
constexpr size_t T_VB = T_KB + al((size_t)NT * 256 * 2);
constexpr size_t T_GB = T_VB + al((size_t)NT * 512 * 2);
constexpr size_t T_UB = T_GB + al((size_t)NT * 512 * 2);
constexpr size_t T_LR = T_UB + al((size_t)NT * 512 * 2);
constexpr size_t T_OF = T_LR + al((size_t)NT * 32 * 4);
constexpr size_t T_OB = T_OF + al((size_t)NT * 512 * 2);
constexpr size_t T_CAT = T_OB + al((size_t)NT * 512 * 2);
constexpr size_t T_Y = T_CAT + al((size_t)NT * D * 2);
constexpr size_t T_GLA = T_Y + al((size_t)NT * D * 2);
constexpr int GI_A = 0, GI_QIN = 8192, GI_KOT = 16384, GI_VT = 24576, GI_DEC = 40960, GI_BYTES = 41216;
constexpr size_t T_END0 = T_GLA + al((size_t)BATCH * GLA_H * 2 * 36 * GI_BYTES + 1024);
constexpr size_t T_QKV = WS_T;
static_assert(T_QKV + (size_t)3 * NT * D * 2 <= T_CAT, "qkv overlay");
constexpr size_t M_AE = WS_T;
constexpr size_t M_AR = M_AE + al((size_t)NT * 8 * 4);
constexpr size_t M_AG = M_AR + al((size_t)NT * 8 * 4);
constexpr size_t M_TS = M_AG + al((size_t)NT * 8 * 4);
constexpr size_t M_ST = M_TS + al((size_t)NT * 8 * 4);
constexpr size_t M_HID = M_ST + al((size_t)PMAX * 4);
constexpr size_t M_OUT = M_HID + al((size_t)PMAX * 256 * 2);
constexpr int MO_LD = 1024;
constexpr size_t M_END = M_OUT + al((size_t)PMAX * D);
constexpr size_t WS_END = (M_END > T_END0 ? M_END : T_END0);
static_assert(WS_END <= (size_t)2040 * MiB, "workspace map must fit 2 GiB");

constexpr int CW_BAR = 4096;
constexpr int CW_CNT = 16384;
constexpr int CW_CUR = 16384 + 512;

constexpr int RING_BYTES = 131072;
constexpr int AUX_OFF = RING_BYTES, AUX_BYTES = 31744;
constexpr int MISC_OFF = AUX_OFF + AUX_BYTES;
constexpr int LDS_BYTES = MISC_OFF + 1024;
constexpr int NWAVES = 8, NTHREADS = 512;

#define LDS_WAIT() asm volatile("s_waitcnt lgkmcnt(0)" ::: "memory")
#define VM_WAIT() asm volatile("s_waitcnt vmcnt(0)" ::: "memory")

__device__ __forceinline__ unsigned f2bf(float f) { unsigned u = __builtin_bit_cast(unsigned, f); return (u + 0x7fffu + ((u >> 16) & 1u)) >> 16; }
__device__ __forceinline__ unsigned pk2(float lo, float hi) { return f2bf(lo) | (f2bf(hi) << 16); }
__device__ __forceinline__ float bf2f(unsigned short b) { return __builtin_bit_cast(float, (unsigned)b << 16); }
__device__ __forceinline__ float bflo(unsigned w) { return __builtin_bit_cast(float, w << 16); }
__device__ __forceinline__ float bfhi(unsigned w) { return __builtin_bit_cast(float, w & 0xffff0000u); }
__device__ __forceinline__ float wave_sum(float v) {
#pragma unroll
    for (int o = 1; o < 64; o <<= 1) v += __shfl_xor(v, o);
    return v;
}
__device__ __forceinline__ float sigmoidf_(float x) { return 1.0f / (1.0f + __expf(-x)); }
__device__ __forceinline__ float siluf_(float x) { return x / (1.0f + __expf(-x)); }

__device__ __forceinline__ void lds_barrier() { asm volatile("s_waitcnt lgkmcnt(0)" ::: "memory"); __builtin_amdgcn_s_barrier(); asm volatile("" ::: "memory"); }
#define XB_TMO      128
#define XB_XCNT(j)  (256  + 64 * (j))
#define XB_XSUB(j)  (1280 + 64 * (j))
#define XB_XGEN(j)  (2304 + 64 * (j))
#define XB_TOP      3328
#define XB_TOPGEN   3392
#define XCD_BAR_WORDS 3456
#define XB_SPIN_CAP (1u << 18)

__device__ __forceinline__ unsigned xb_ld(unsigned* p)              { return __hip_atomic_load(p, __ATOMIC_RELAXED, __HIP_MEMORY_SCOPE_AGENT); }
__device__ __forceinline__ unsigned xb_add(unsigned* p, unsigned v) { return __hip_atomic_fetch_add(p, v, __ATOMIC_RELAXED, __HIP_MEMORY_SCOPE_AGENT); }
__device__ __forceinline__ unsigned xb_xcc_id() { return (unsigned)__builtin_amdgcn_s_getreg((3 << 11) | 20) & 0xFu; }
#define XB_SPIN(cond, bar) do { unsigned _sp = 0; while (cond) { __builtin_amdgcn_s_sleep(1); \
    if ((++_sp & 255u) == 0u) { if (xb_ld(&(bar)[XB_TMO])) break; if (_sp > XB_SPIN_CAP) { atomicAdd(&(bar)[XB_TMO], 1u); break; } } } } while (0)

struct XcdBarrier { unsigned* bar; unsigned x; volatile LAS unsigned* st; };

__device__ __forceinline__ XcdBarrier xcd_barrier_post(unsigned* bar, volatile LAS unsigned* st) {
    XcdBarrier b; b.bar = bar; b.x = xb_xcc_id(); b.st = st;
    if (threadIdx.x == 0) (void)xb_add(&bar[XB_XCNT(b.x)], 1u);
    return b;
}
__device__ __forceinline__ void xcd_barrier_complete(unsigned* bar, unsigned x, unsigned& nloc, unsigned& nx) {
    const unsigned G = gridDim.x * gridDim.y * gridDim.z;
    unsigned sum, cnt, mine, sp = 0u;
    for (;;) {
        sum = 0u; cnt = 0u; mine = 0u;
#pragma unroll
        for (unsigned j = 0; j < 16; ++j) { const unsigned c = xb_ld(&bar[XB_XCNT(j)]); sum += c; cnt += (c > 0u) ? 1u : 0u; mine = (j == x) ? c : mine; }
        if (sum == G) break;
        __builtin_amdgcn_s_sleep(1);
        if ((++sp & 255u) == 0u) { if (xb_ld(&bar[XB_TMO])) break; if (sp > XB_SPIN_CAP) { atomicAdd(&bar[XB_TMO], 1u); break; } }
    }
    nloc = mine > 0u ? mine : 1u; nx = cnt > 0u ? cnt : 1u;
}
__device__ __forceinline__ void xcd_barrier(const XcdBarrier& b) {
    asm volatile("s_waitcnt vmcnt(0)" ::: "memory");
    __syncthreads();
    if (threadIdx.x == 0) {
        unsigned* bar = b.bar;
        __builtin_amdgcn_s_waitcnt(0);
        unsigned nloc = b.st[0], nx = b.st[1];
        if (nloc == 0u) { xcd_barrier_complete(bar, b.x, nloc, nx); b.st[0] = nloc; b.st[1] = nx; }
        const unsigned old = xb_add(&bar[XB_XSUB(b.x)], 1u);
        const unsigned gen = old / nloc;
        if (old + 1u == (gen + 1u) * nloc) {
            __builtin_amdgcn_fence(__ATOMIC_RELEASE, "agent");
            asm volatile("s_waitcnt vmcnt(0)" ::: "memory");
            const unsigned og = xb_add(&bar[XB_TOP], 1u);
            const unsigned tg = og / nx;
            if (og + 1u == (tg + 1u) * nx) xb_add(&bar[XB_TOPGEN], 1u);
            else XB_SPIN(xb_ld(&bar[XB_TOPGEN]) == tg, bar);
            __builtin_amdgcn_fence(__ATOMIC_ACQUIRE, "agent");
            xb_add(&bar[XB_XGEN(b.x)], 1u);
            asm volatile("s_waitcnt vmcnt(0)" ::: "memory");
        } else {
            XB_SPIN(xb_ld(&bar[XB_XGEN(b.x)]) == gen, bar);
            __builtin_amdgcn_fence(__ATOMIC_ACQUIRE, "agent");
            asm volatile("s_waitcnt vmcnt(0)" ::: "memory");
        }
    }
    __syncthreads();
}

namespace pg8 {
constexpr int BM = 256, BK = 64, HALF = 128, HTB = HALF * BK * 2, STAGE_BYTES = 8 * HTB, NXCD = 8, WGM = 8;
__host__ __device__ __forceinline__ int lds_byte(int r, int c) { const int st = (r >> 4) * 2 + (c >> 5), rr = r & 15, cc = c & 31, ob = rr * 64 + cc * 2; return st * 1024 + (ob ^ (((ob >> 9) & 1) << 5)); }
__host__ __device__ __forceinline__ void stage_rc(int b, int& R, int& C) { const int st = b / 1024, sb = b % 1024, swz = sb ^ (((sb >> 9) & 1) << 5); R = (st >> 1) * 16 + swz / 64; C = (st & 1) * 32 + (swz % 64) / 2; }
__host__ __device__ __forceinline__ int perm32(int rho) { const int n = rho >> 4, i = rho & 15; return 8 * (i >> 2) + 4 * n + (i & 3); }

struct Unit { int a, b, orow, ocol, aux; };

__device__ __forceinline__ bool static_order(int L, int nM, int nN, int& pm, int& pn) {
    const int nwg = nM * nN; if (L >= nwg) return false;
    int wgid = L; { const int q = nwg / NXCD, r = nwg % NXCD, xcd = wgid % NXCD, off = wgid / NXCD; wgid = (xcd < r ? xcd * (q + 1) : r * (q + 1) + (xcd - r) * q) + off; }
    const int nig = WGM * nN, gid = wgid / nig, fm = gid * WGM, gsz = (nM - fm) < WGM ? (nM - fm) : WGM;
    pm = fm + ((wgid % nig) % gsz); pn = (wgid % nig) / gsz; return true;
}

template <class Epi, class Sched, bool ALIGN_EPI>
__device__ __forceinline__ void gemm_phase(LAS unsigned char* lds, const int K, const Sched& S, const Epi& E) {
    const int tid = threadIdx.x, wid = __builtin_amdgcn_readfirstlane(tid >> 6), lane = tid & 63, wr = wid >> 2, wc = wid & 3, fr = lane & 15, fq = lane >> 4;
    const int nt = K / BK;
    int Rr[2], Cc[2]; unsigned voffB[2];
#pragma unroll
    for (int i = 0; i < 2; ++i) { int R, C; stage_rc(tid * 16 + i * 8192, R, C); Rr[i] = R; Cc[i] = C; const int Rb = Epi::PERM ? ((R & ~31) + perm32(R & 31)) : R; voffB[i] = (unsigned)(Rb * K + C) * 2u; }
    const size_t kstep = (size_t)(BK * 2);
    const size_t hstepB = (size_t)HALF * K * 2;
    const unsigned ldsw = (unsigned)wid * 1024u;
    const int aoff = lds_byte(wr * 64 + fr, fq * 8), boff = lds_byte(wc * 32 + fr, fq * 8);
#define PG8_SA(b, h) (((b) * 2 + (h)) * HTB)
#define PG8_SB(b, h) ((4 + (b) * 2 + (h)) * HTB)
#define PG8_STAGE(bufoff, gbase, voff) do { _Pragma("unroll") for (int _i = 0; _i < 2; ++_i) \
        __builtin_amdgcn_global_load_lds((const unsigned*)((const char*)(gbase) + (voff)[_i]), (LAS unsigned*)(lds + (bufoff) + ldsw + _i * 8192), 16, 0, 0); } while (0)
#define PG8_LDA(dst, b, h) do { _Pragma("unroll") for (int m = 0; m < 4; ++m) _Pragma("unroll") for (int k = 0; k < 2; ++k) dst[m][k] = *(const LAS bf16x8*)(lds + PG8_SA(b, h) + aoff + m * 2048 + k * 1024); } while (0)
#define PG8_LDB(dst, b, h) do { _Pragma("unroll") for (int n = 0; n < 2; ++n) _Pragma("unroll") for (int k = 0; k < 2; ++k) dst[n][k] = *(const LAS bf16x8*)(lds + PG8_SB(b, h) + boff + n * 2048 + k * 1024); } while (0)
#define PG8_MMA(ai, bj, At, Bt) do { __builtin_amdgcn_s_setprio(1); _Pragma("unroll") for (int m = 0; m < 4; ++m) _Pragma("unroll") for (int n = 0; n < 2; ++n) _Pragma("unroll") for (int k = 0; k < 2; ++k) \
        acc[ai][bj][m][n] = __builtin_amdgcn_mfma_f32_16x16x32_bf16(Bt[n][k], At[m][k], acc[ai][bj][m][n], 0, 0, 0); __builtin_amdgcn_s_setprio(0); } while (0)
#define PG8_WAIT_V(n) asm volatile("s_waitcnt vmcnt(" #n ")" ::: "memory")
#define PG8_WAIT_L(n) asm volatile("s_waitcnt lgkmcnt(" #n ")" ::: "memory")
#define PG8_BAR __builtin_amdgcn_s_barrier()
#define PG8_SCHED __builtin_amdgcn_sched_barrier(0)
    Unit cur, nxt; int ui = 0;
    if (!S.next(0, cur)) return;
    f32x4 acc[2][2][4][2];
#pragma unroll
    for (int a = 0; a < 2; ++a)
#pragma unroll
        for (int b = 0; b < 2; ++b)
#pragma unroll
            for (int m = 0; m < 4; ++m)
#pragma unroll
                for (int n = 0; n < 2; ++n) acc[a][b][m][n] = (f32x4){0.f, 0.f, 0.f, 0.f};
    bf16x8 At[4][2], B0[2][2], B1[2][2];
    unsigned co0[2], co1[2], no0[2], no1[2];
    S.a_off(cur, Rr, Cc, co0, co1);
    const char* const Ab = S.a_base();
    const char* cB = S.b_ptr(cur);
    PG8_STAGE(PG8_SB(0, 0), cB, voffB); PG8_STAGE(PG8_SB(0, 1), cB + hstepB, voffB); PG8_STAGE(PG8_SA(0, 0), Ab, co0); PG8_STAGE(PG8_SA(0, 1), Ab, co1);
    if (wr == 1) PG8_BAR;
    PG8_WAIT_V(2); PG8_BAR;
    PG8_STAGE(PG8_SB(1, 0), cB + kstep, voffB); PG8_STAGE(PG8_SA(1, 0), Ab + kstep, co0); PG8_STAGE(PG8_SB(1, 1), cB + hstepB + kstep, voffB);
    PG8_WAIT_V(6); PG8_BAR;
    for (;;) {
        const bool has_next = S.next(ui + 1, nxt);
        const char* nB = has_next ? S.b_ptr(nxt) : cB;
#pragma nounroll
        for (int t = 0; t < nt; t += 2) {
            const bool last = (t == nt - 2);
            if (last) { if (has_next) S.a_off(nxt, Rr, Cc, no0, no1); else { no0[0] = co0[0]; no0[1] = co0[1]; no1[0] = co1[0]; no1[1] = co1[1]; } }
            const char* a1 = Ab + (size_t)(t + 1) * kstep;
            const char* a2 = last ? Ab : Ab + (size_t)(t + 2) * kstep; const char* b2 = last ? nB : cB + (size_t)(t + 2) * kstep;
            const char* a3 = a2 + kstep; const char* b3 = b2 + kstep;
            unsigned x0[2], x1[2];
            x0[0] = last ? no0[0] : co0[0]; x0[1] = last ? no0[1] : co0[1]; x1[0] = last ? no1[0] : co1[0]; x1[1] = last ? no1[1] : co1[1];
            PG8_LDB(B0, 0, 0); PG8_LDB(B1, 0, 1); PG8_SCHED; PG8_LDA(At, 0, 0); PG8_STAGE(PG8_SA(1, 1), a1, co1);
            PG8_WAIT_V(8); PG8_WAIT_L(0); PG8_BAR; PG8_MMA(0, 0, At, B0); PG8_MMA(0, 1, At, B1); PG8_BAR; PG8_SCHED;
            PG8_LDA(At, 0, 1); PG8_STAGE(PG8_SB(0, 0), b2, voffB); PG8_STAGE(PG8_SB(0, 1), b2 + hstepB, voffB); PG8_STAGE(PG8_SA(0, 0), a2, x0);
            PG8_WAIT_V(8); PG8_WAIT_L(0); PG8_BAR; PG8_MMA(1, 0, At, B0); PG8_MMA(1, 1, At, B1); PG8_BAR; PG8_SCHED;
            PG8_LDB(B0, 1, 0); PG8_LDB(B1, 1, 1); PG8_SCHED; PG8_LDA(At, 1, 0); PG8_STAGE(PG8_SA(0, 1), a2, x1);
            PG8_WAIT_V(8); PG8_WAIT_L(0); PG8_BAR; PG8_MMA(0, 0, At, B0); PG8_MMA(0, 1, At, B1); PG8_BAR; PG8_SCHED;
            PG8_LDA(At, 1, 1); PG8_STAGE(PG8_SB(1, 0), b3, voffB); PG8_STAGE(PG8_SB(1, 1), b3 + hstepB, voffB); PG8_STAGE(PG8_SA(1, 0), a3, x0);
            PG8_WAIT_V(8); PG8_WAIT_L(0); PG8_BAR; PG8_MMA(1, 0, At, B0); PG8_MMA(1, 1, At, B1); PG8_BAR; PG8_SCHED;
        }
        if constexpr (ALIGN_EPI) { if (wr == 0) PG8_BAR; }
        if constexpr (!Epi::AFTER_DRAIN) { E(acc, cur, wr, wc, fr, fq); }
        if (!has_next) break;
#pragma unroll
        for (int a = 0; a < 2; ++a)
#pragma unroll
            for (int b = 0; b < 2; ++b)
#pragma unroll
                for (int m = 0; m < 4; ++m)
#pragma unroll
                    for (int n = 0; n < 2; ++n) acc[a][b][m][n] = (f32x4){0.f, 0.f, 0.f, 0.f};
        cur = nxt; cB = nB; co0[0] = no0[0]; co0[1] = no0[1]; co1[0] = no1[0]; co1[1] = no1[1]; ++ui;
        if constexpr (ALIGN_EPI) { if (wr == 1) PG8_BAR; }
    }
    PG8_WAIT_V(0);
    if constexpr (!ALIGN_EPI) { if (wr == 0) PG8_BAR; }
    PG8_BAR;
    if constexpr (Epi::AFTER_DRAIN) { E.fused(acc, cur, wr, wc, fr, fq, lds, wid, lane); }
#undef PG8_SA
#undef PG8_SB
#undef PG8_STAGE
#undef PG8_LDA
#undef PG8_LDB
#undef PG8_MMA
#undef PG8_WAIT_V
#undef PG8_WAIT_L
#undef PG8_BAR
#undef PG8_SCHED
}
}
using pg8::Unit;

__device__ __forceinline__ unsigned cvt_pk_bf16(float lo, float hi) { unsigned r; asm volatile("v_cvt_pk_bf16_f32 %0, %1, %2" : "=v"(r) : "v"(lo), "v"(hi)); return r; }

struct SchedDense {
    const char* A; const char* Bt; int K; int nM0, nN0, nM1, nN1, pn1off; int G, c;
    __device__ __forceinline__ bool next(int i, Unit& u) const {
        const int L = i * G + c; int pm, pn;
        const int n0 = nM0 * nN0;
        if (L < n0) { pg8::static_order(L, nM0, nN0, pm, pn); }
        else { if (!pg8::static_order(L - n0, nM1, nN1, pm, pn)) return false; pm += nM0; pn += pn1off; }
        u.a = pm; u.b = pn * 256; u.orow = pm * 256; u.ocol = pn * 256; u.aux = pn; return true;
    }
    __device__ __forceinline__ const char* a_base() const { return A; }
    __device__ __forceinline__ const char* b_ptr(const Unit& u) const { return Bt + (size_t)u.b * K * 2; }
    __device__ __forceinline__ void a_off(const Unit& u, const int (&R)[2], const int (&C)[2], unsigned (&o0)[2], unsigned (&o1)[2]) const {
#pragma unroll
        for (int i = 0; i < 2; ++i) { o0[i] = (unsigned)((u.a * 256 + R[i]) * K + C[i]) * 2u; o1[i] = o0[i] + (unsigned)(128 * K * 2); }
    }
};

struct EpiBf16 {
    static constexpr bool PERM = true, AFTER_DRAIN = false;
    bf16_t* O; int ldc; int split_cols; size_t split_stride; float scale0 = 1.0f;
    __device__ __forceinline__ void operator()(const f32x4 (&acc)[2][2][4][2], const Unit& u, int wr, int wc, int fr, int fq) const {
        const int lane = fr + 16 * fq; const int srcb = ((lane >> 2) + 16 * (lane & 3)) << 2;
        const int row0 = u.orow + wr * 64 + (lane >> 2); int colt = u.ocol; bf16_t* base = O;
        float sc = 1.0f;
        if (split_cols) { const int t = colt / split_cols; base += (size_t)t * split_stride; colt -= t * split_cols; if (t == 0) sc = scale0; }
        const int col0 = colt + wc * 32 + 8 * (lane & 3);
#pragma unroll
        for (int ai = 0; ai < 2; ++ai)
#pragma unroll
            for (int m = 0; m < 4; ++m) { bf16_t* rowp = base + (size_t)(row0 + ai * 128 + m * 16) * ldc + col0;
#pragma unroll
                for (int bj = 0; bj < 2; ++bj) { const f32x4 v0 = acc[ai][bj][m][0] * sc, v1 = acc[ai][bj][m][1] * sc;
                    u32x4 w; w.x = cvt_pk_bf16(v0[0], v0[1]); w.y = cvt_pk_bf16(v0[2], v0[3]); w.z = cvt_pk_bf16(v1[0], v1[1]); w.w = cvt_pk_bf16(v1[2], v1[3]);
                    u32x4 t; t.x = (unsigned)__builtin_amdgcn_ds_bpermute(srcb, (int)w.x); t.y = (unsigned)__builtin_amdgcn_ds_bpermute(srcb, (int)w.y); t.z = (unsigned)__builtin_amdgcn_ds_bpermute(srcb, (int)w.z); t.w = (unsigned)__builtin_amdgcn_ds_bpermute(srcb, (int)w.w);
                    *(u32x4*)(rowp + bj * 128) = t; } }
    }
};
struct EpiF8 {
    static constexpr bool PERM = true, AFTER_DRAIN = false;
    unsigned char* O;
    __device__ __forceinline__ int nst(const Unit&, int) const { return 16; }
    __device__ __forceinline__ void operator()(const f32x4 (&acc)[2][2][4][2], const Unit& u, int wr, int wc, int fr, int fq) const {
        const int lane = fr + 16 * fq; const int srcb = ((lane >> 2) + 16 * (lane & 3)) << 2;
        const int row0 = u.orow + wr * 64 + (lane >> 2), col0 = u.ocol + wc * 32 + 8 * (lane & 3);
#pragma unroll
        for (int ai = 0; ai < 2; ++ai)
#pragma unroll
            for (int m = 0; m < 4; ++m) { unsigned char* rowp = O + (size_t)(row0 + ai * 128 + m * 16) * D + col0;
#pragma unroll
                for (int bj = 0; bj < 2; ++bj) { const f32x4 v0 = acc[ai][bj][m][0] * F8_SCALE, v1 = acc[ai][bj][m][1] * F8_SCALE;
                    int w0 = __builtin_amdgcn_cvt_pk_fp8_f32(v0[0], v0[1], 0, false); w0 = __builtin_amdgcn_cvt_pk_fp8_f32(v0[2], v0[3], w0, true);
                    int w1 = __builtin_amdgcn_cvt_pk_fp8_f32(v1[0], v1[1], 0, false); w1 = __builtin_amdgcn_cvt_pk_fp8_f32(v1[2], v1[3], w1, true);
                    u32x2 t; t.x = (unsigned)__builtin_amdgcn_ds_bpermute(srcb, w0); t.y = (unsigned)__builtin_amdgcn_ds_bpermute(srcb, w1);
                    *(u32x2*)(rowp + bj * 128) = t; } }
    }
};
template <int MODE> struct EpiBf16X {
    static constexpr bool PERM = true, AFTER_DRAIN = false;
    bf16_t* O; int ldc;
    __device__ __forceinline__ void operator()(const f32x4 (&acc)[2][2][4][2], const Unit& u, int wr, int wc, int fr, int fq) const {
        const int lane = fr + 16 * fq; const int srcb = ((lane >> 2) + 16 * (lane & 3)) << 2;
        const int row0 = u.orow + wr * 64 + (lane >> 2); const int col0 = u.ocol + wc * 32 + 8 * (lane & 3);
#pragma unroll
        for (int ai = 0; ai < 2; ++ai)
#pragma unroll
            for (int m = 0; m < 4; ++m) { bf16_t* rowp = O + (size_t)(row0 + ai * 128 + m * 16) * ldc + col0;
#pragma unroll
                for (int bj = 0; bj < 2; ++bj) { const f32x4 v0 = acc[ai][bj][m][0], v1 = acc[ai][bj][m][1];
                    u32x4 w; w.x = cvt_pk_bf16(v0[0], v0[1]); w.y = cvt_pk_bf16(v0[2], v0[3]); w.z = cvt_pk_bf16(v1[0], v1[1]); w.w = cvt_pk_bf16(v1[2], v1[3]);
                    u32x4 t; t.x = (unsigned)__builtin_amdgcn_ds_bpermute(srcb, (int)w.x); t.y = (unsigned)__builtin_amdgcn_ds_bpermute(srcb, (int)w.y); t.z = (unsigned)__builtin_amdgcn_ds_bpermute(srcb, (int)w.z); t.w = (unsigned)__builtin_amdgcn_ds_bpermute(srcb, (int)w.w);
                    if (MODE == 1) { if (bj == 0) *(u32x4*)(rowp + bj * 128) = t; else asm volatile("" :: "v"(t)); }
                    if (MODE == 2) { bf16_t* p = O + (wr * 128 + ai * 64 + m * 16 + bj * 8 + wc * 2) * 256 + 8 * lane; *(u32x4*)p = t; }
                } }
    }
};
struct EpiNull {
    static constexpr bool PERM = true, AFTER_DRAIN = false;
    __device__ __forceinline__ void operator()(const f32x4 (&acc)[2][2][4][2], const Unit& u, int wr, int wc, int fr, int fq) const {
#pragma unroll
        for (int ai = 0; ai < 2; ++ai)
#pragma unroll
            for (int bj = 0; bj < 2; ++bj)
#pragma unroll
                for (int m = 0; m < 4; ++m)
#pragma unroll
                    for (int n = 0; n < 2; ++n) asm volatile("" :: "v"(acc[ai][bj][m][n]));
    }
};
struct EpiBf16NS {
    static constexpr bool PERM = true, AFTER_DRAIN = false;
    __device__ __forceinline__ void operator()(const f32x4 (&acc)[2][2][4][2], const Unit& u, int wr, int wc, int fr, int fq) const {
#pragma unroll
        for (int ai = 0; ai < 2; ++ai)
#pragma unroll
            for (int m = 0; m < 4; ++m) {
#pragma unroll
                for (int bj = 0; bj < 2; ++bj) { const f32x4 v0 = acc[ai][bj][m][0], v1 = acc[ai][bj][m][1];
                    u32x4 w; w.x = cvt_pk_bf16(v0[0], v0[1]); w.y = cvt_pk_bf16(v0[2], v0[3]); w.z = cvt_pk_bf16(v1[0], v1[1]); w.w = cvt_pk_bf16(v1[2], v1[3]);
                    asm volatile("" :: "v"(w)); } }
    }
};
struct EpiInproj {
    static constexpr bool PERM = false, AFTER_DRAIN = false;
    bf16_t *qb, *kb, *vb, *gb, *ub; float* lr; const f32x2* rope;
    __device__ __forceinline__ void operator()(const f32x4 (&acc)[2][2][4][2], const Unit& u, int wr, int wc, int fr, int fq) const {
        const int pn = u.aux; const int row0 = u.orow + wr * 64 + fr;
        if (pn <= 1) {
            bf16_t* dst = pn == 0 ? qb : kb; const float sc = pn == 0 ? 0.125f : 1.0f;
#pragma unroll
            for (int ai = 0; ai < 2; ++ai)
#pragma unroll
                for (int m = 0; m < 4; ++m) {
                    const int row = row0 + ai * 128 + m * 16; const bool lat = row < NX;
                    const int s = row & (SEQ - 1); const int pos = (wc & 1) ? (s & 63) : (s >> 6);
                    f32x2 cs[4];
                    if (lat) {
#pragma unroll
                        for (int e = 0; e < 4; ++e) cs[e] = rope[pos * 16 + 4 * fq + e];
                    } else {
#pragma unroll
                        for (int e = 0; e < 4; ++e) cs[e] = (f32x2){1.f, 0.f};
                    }
#pragma unroll
                    for (int bj = 0; bj < 2; ++bj) {
                        const f32x4 u1 = acc[ai][bj][m][0], u2 = acc[ai][bj][m][1]; f32x4 o1, o2;
#pragma unroll
                        for (int e = 0; e < 4; ++e) { o1[e] = (u1[e] * cs[e].x - u2[e] * cs[e].y) * sc; o2[e] = (u1[e] * cs[e].y + u2[e] * cs[e].x) * sc; }
                        bf16_t* p = dst + (size_t)row * 256 + bj * 128 + wc * 32 + 4 * fq;
                        u32x2 w1, w2; w1.x = cvt_pk_bf16(o1[0], o1[1]); w1.y = cvt_pk_bf16(o1[2], o1[3]); w2.x = cvt_pk_bf16(o2[0], o2[1]); w2.y = cvt_pk_bf16(o2[2], o2[3]);
                        *(u32x2*)p = w1; *(u32x2*)(p + 16) = w2;
                    }
                }
        } else if (pn <= 5) {
            bf16_t* dst = pn <= 3 ? vb : gb; const int cb = (pn & 1) ? 256 : 0;
#pragma unroll
            for (int ai = 0; ai < 2; ++ai)
#pragma unroll
                for (int m = 0; m < 4; ++m) { const int row = row0 + ai * 128 + m * 16;
#pragma unroll
                    for (int bj = 0; bj < 2; ++bj)
#pragma unroll
                        for (int n = 0; n < 2; ++n) { const f32x4 v = acc[ai][bj][m][n]; u32x2 w; w.x = cvt_pk_bf16(v[0], v[1]); w.y = cvt_pk_bf16(v[2], v[3]);
                            *(u32x2*)(dst + (size_t)row * 512 + cb + bj * 128 + wc * 32 + n * 16 + 4 * fq) = w; } }
        } else if (pn <= 9) {
            const int cb = (pn - 6) * 128;
#pragma unroll
            for (int ai = 0; ai < 2; ++ai)
#pragma unroll
                for (int m = 0; m < 4; ++m) { const int row = row0 + ai * 128 + m * 16;
#pragma unroll
                    for (int n = 0; n < 2; ++n) { const f32x4 a = acc[ai][0][m][n], b = acc[ai][1][m][n]; f32x4 o;
#pragma unroll
                        for (int e = 0; e < 4; ++e) o[e] = a[e] * sigmoidf_(b[e]);
                        u32x2 w; w.x = cvt_pk_bf16(o[0], o[1]); w.y = cvt_pk_bf16(o[2], o[3]);
                        *(u32x2*)(ub + (size_t)row * 512 + cb + wc * 32 + n * 16 + 4 * fq) = w; } }
        } else {
            if (wc == 0) {
#pragma unroll
                for (int ai = 0; ai < 2; ++ai)
#pragma unroll
                    for (int m = 0; m < 4; ++m) { const int row = row0 + ai * 128 + m * 16;
#pragma unroll
                        for (int n = 0; n < 2; ++n) *(f32x4*)(lr + (size_t)row * 32 + n * 16 + 4 * fq) = acc[ai][0][m][n]; }
            }
        }
    }
};

struct Args { const float* in[32]; float* out; unsigned char* ws; int ph_lo, ph_hi; };

struct Frame {
    LAS unsigned char* lds; volatile LAS unsigned* MISC; unsigned* ctl; unsigned char* ws;
    int tid, lane, wave, G, vcu;
};

__device__ __forceinline__ void cvt_item(const float* __restrict__ src, int ld, int col0, int ncols, int k0, bf16_t* dst, int ldd, int drow0, LAS unsigned* T, int lane) {
    const bool okc = lane < ncols;
    const float* p = src + (size_t)k0 * ld + col0 + (okc ? lane : 0);
    float v[64];
#pragma unroll
    for (int k = 0; k < 64; ++k) v[k] = __builtin_nontemporal_load(p + (size_t)k * ld);
#pragma unroll
    for (int kp = 0; kp < 32; ++kp) T[lane * 33 + kp] = okc ? pk2(v[2 * kp], v[2 * kp + 1]) : 0u;
    LDS_WAIT(); asm volatile("" ::: "memory");
    const int c = lane & 7;
#pragma unroll
    for (int it = 0; it < 8; ++it) { const int n = (lane >> 3) + 8 * it;
        u32x4 o; o.x = T[n * 33 + 4 * c]; o.y = T[n * 33 + 4 * c + 1]; o.z = T[n * 33 + 4 * c + 2]; o.w = T[n * 33 + 4 * c + 3];
        if (n < ncols) __builtin_nontemporal_store(o, (u32x4*)(dst + (size_t)(drow0 + n) * ldd + k0 + 8 * c)); }
    LDS_WAIT(); asm volatile("" ::: "memory");
}
__device__ __forceinline__ void cvt_matrix_item(const float* src, int ld, int col0, int ncols, int K, bf16_t* dst, int drow0, int item, LAS unsigned* T, int lane) {
    const int ncg = (ncols + 63) >> 6; const int kt = item / ncg, cg = item - kt * ncg;
    const int nc = ncols - cg * 64 < 64 ? ncols - cg * 64 : 64;
    cvt_item(src, ld, col0 + cg * 64, nc, kt * 64, dst, K, drow0 + cg * 64, T, lane);
}

constexpr int MOE_CVT_ITEMS = NEXPS * 192;
__device__ __forceinline__ void cvt_moe_item(const Args& a, int layer, int item, unsigned char* ws, LAS unsigned* T, int lane) {
    const int e = item / 192, r = item - e * 192;
    bf16_t* wgu = (bf16_t*)(ws + WS_WGU + (size_t)layer * WGU_BYTES) + (size_t)e * 512 * D; bf16_t* wdn = (bf16_t*)(ws + WS_WDN + (size_t)layer * WDN_BYTES) + (size_t)e * D * 256;
    if (r < 128) {
        const int gi = r >> 4, kt = r & 15; const int up = gi >> 2, g4 = gi & 3;
        const float* src = e < NEXP ? (up ? a.in[27] : a.in[26]) + ((size_t)layer * NEXP + e) * D * DEXP : (up ? a.in[30] : a.in[29]) + (size_t)layer * D * DEXP;
        cvt_item(src, DEXP, 64 * g4, 64, kt * 64, wgu, D, 256 * (g4 >> 1) + 64 * (g4 & 1) + 128 * up, T, lane);
    } else {
        const int q = r - 128; const int cg = q >> 2, kt = q & 3;
        const float* src = e < NEXP ? a.in[28] + ((size_t)layer * NEXP + e) * DEXP * D : a.in[31] + (size_t)layer * DEXP * D;
        cvt_item(src, D, 64 * cg, 64, kt * 64, wdn, DEXP, 64 * cg, T, lane);
    }
}

__device__ __forceinline__ float row_rms_scale(const f32x4 (&v)[4]) {
    float s = 0.f;
#pragma unroll
    for (int j = 0; j < 4; ++j) s += (v[j].x * v[j].x + v[j].y * v[j].y) + (v[j].z * v[j].z + v[j].w * v[j].w);
    return rsqrtf(wave_sum(s) * (1.0f / D) + RMS_EPS);
}
__device__ __forceinline__ f32x4 ld4(const float* p) { return *(const f32x4*)p; }

struct RowPhase {
    const float* xin_lat; const float* xin_ctx;
    float* xout_lat; float* xout_ctx;
    int nrows;
    int ysrc; const bf16_t* y;
    const unsigned char* mo8; const int* tslot; const float* tgate; int sharedbase;
    const float* gpost; const float* modx; const float* modc; int gate_chunk;
    bool doH; bf16_t* H; const float* gpre; int sc_chunk, sh_chunk; const float* modxH; const float* modcH;
};
__device__ __forceinline__ void row_phase(const Frame& F, const RowPhase& P) {
    const int gw = F.vcu * NWAVES + F.wave, NGW = F.G * NWAVES, lane = F.lane;
    for (int row = gw; row < P.nrows; row += NGW) {
        const bool lat = row < NX; const int b = lat ? (row >> 11) : 0;
        const float* mod = lat ? P.modx + (size_t)b * ADA : P.modc;
        const float* xr = lat ? P.xin_lat + (size_t)row * D : P.xin_ctx + (size_t)(row - NX) * D;
        f32x4 x[4];
#pragma unroll
        for (int j = 0; j < 4; ++j) x[j] = ld4(xr + 4 * lane + 256 * j);
        if (P.ysrc) {
            f32x4 y[4];
            if (P.ysrc == 1) {
#pragma unroll
                for (int j = 0; j < 4; ++j) { const u32x2 w = __builtin_nontemporal_load((const u32x2*)(P.y + (size_t)row * D + 4 * lane + 256 * j)); y[j] = (f32x4){bflo(w.x), bfhi(w.x), bflo(w.y), bfhi(w.y)}; }
            } else {
#pragma unroll
                for (int j = 0; j < 4; ++j) { const int w = __builtin_nontemporal_load((const int*)(P.mo8 + (size_t)(P.sharedbase + row) * D + 4 * lane + 256 * j)); const f32x2 lo = __builtin_amdgcn_cvt_pk_f32_fp8(w, false), hi = __builtin_amdgcn_cvt_pk_f32_fp8(w, true); y[j] = (f32x4){lo.x, lo.y, hi.x, hi.y} * F8_INV; }
#pragma unroll
                for (int k = 0; k < TOPK; ++k) { const int sl = P.tslot[(size_t)row * 8 + k]; const float g = P.tgate[(size_t)row * 8 + k] * F8_INV;
#pragma unroll
                    for (int j = 0; j < 4; ++j) { const int w = __builtin_nontemporal_load((const int*)(P.mo8 + (size_t)sl * D + 4 * lane + 256 * j)); const f32x2 lo = __builtin_amdgcn_cvt_pk_f32_fp8(w, false), hi = __builtin_amdgcn_cvt_pk_f32_fp8(w, true);
                        y[j].x += g * lo.x; y[j].y += g * lo.y; y[j].z += g * hi.x; y[j].w += g * hi.y; } }
            }
            const float rs = row_rms_scale(y);
#pragma unroll
            for (int j = 0; j < 4; ++j) { const f32x4 gp = ld4(P.gpost + 4 * lane + 256 * j), gt = ld4(mod + P.gate_chunk * D + 4 * lane + 256 * j); x[j] = x[j] + gt * (y[j] * rs * gp); }
            float* xo = lat ? P.xout_lat + (size_t)row * D : P.xout_ctx + (size_t)(row - NX) * D;
#pragma unroll
            for (int j = 0; j < 4; ++j) *(f32x4*)(xo + 4 * lane + 256 * j) = x[j];
        }
        if (P.doH) {
            const float rs = row_rms_scale(x); const float* modh = lat ? P.modxH + (size_t)b * ADA : P.modcH;
#pragma unroll
            for (int j = 0; j < 4; ++j) { const f32x4 gp = ld4(P.gpre + 4 * lane + 256 * j), sc = ld4(modh + P.sc_chunk * D + 4 * lane + 256 * j), sh = ld4(modh + P.sh_chunk * D + 4 * lane + 256 * j);
                const f32x4 h = x[j] * rs * gp * (sc + 1.0f) + sh; u32x2 w; w.x = pk2(h.x, h.y); w.y = pk2(h.z, h.w);
                *(u32x2*)(P.H + (size_t)row * D + 4 * lane + 256 * j) = w; }
        }
    }
}


constexpr int FILL_PER_WAVE_S = 10, FILL_PER_WAVE_L = 14;
constexpr int F0_P2 = 208 * 8 * FILL_PER_WAVE_S, F0_P5 = 192 * 8 * FILL_PER_WAVE_S, F0_P7 = 112 * 8 * FILL_PER_WAVE_L;
constexpr int F0_BULK = MOE_CVT_ITEMS - F0_P2 - F0_P5 - F0_P7;
constexpr int F1_P12 = 128 * 8 * FILL_PER_WAVE_S, F1_P16 = 128 * 8 * FILL_PER_WAVE_L;
__device__ __forceinline__ void cvt_moe_range(const Frame& F, const Args& a, int layer, int lo, int hi, int rank, int nranks) {
    LAS unsigned* T = (LAS unsigned*)F.lds + F.wave * (64 * 33);
    for (int it = lo + rank * NWAVES + F.wave; it < hi; it += nranks * NWAVES) cvt_moe_item(a, layer, it, F.ws, T, F.lane);
}
__device__ __forceinline__ void fill1_ranges(const Frame& F, int ntr0, int& s9, int& s10) {
    const int nu9 = (ntr0 + NT / 256) * 2, nu10 = (ntr0 + NT / 256) * 4;
    const int l9 = (nu9 % F.G) ? F.G - nu9 % F.G : 0, l10 = (nu10 % F.G) ? F.G - nu10 % F.G : 0;
    s9 = l9 * NWAVES * FILL_PER_WAVE_S; s10 = l10 * NWAVES * (FILL_PER_WAVE_S / 3);
    if (F.G != 256) { s9 = 0; s10 = 0; }
}

#ifndef MK_STAG
#define MK_STAG 0
#endif
__device__ __forceinline__ void stagger_delay(const Frame& F, int step) {
    if (step <= 0) return;
    const unsigned long long t0 = __builtin_amdgcn_s_memrealtime(); const unsigned long long d = (unsigned long long)((F.vcu & 7) * step);
    while (__builtin_amdgcn_s_memrealtime() - t0 < d) __builtin_amdgcn_s_sleep(4);
}
__device__ __forceinline__ void p0_ada(const Frame& F, const Args& a) {
    LAS float* sc = (LAS float*)F.lds;
    if ((int)blockIdx.x >= 96) return;
    for (int i = F.tid; i < 17 * D; i += NTHREADS) { const int r = i >> 10, k = i & 1023; const float v = r < 16 ? a.in[1][r * D + k] : a.in[3][k]; sc[i] = siluf_(v); }
    __syncthreads();
    const int item = blockIdx.x; const int layer = item / 48, cg = item % 48;
    const int cq = F.tid & 31, kl = F.tid >> 5;
    const float* W = a.in[4] + (size_t)layer * D * ADA + cg * 128 + cq * 4;
    f32x4 acc[17];
#pragma unroll
    for (int r = 0; r < 17; ++r) acc[r] = (f32x4){0.f, 0.f, 0.f, 0.f};
    for (int k = kl; k < D; k += 16) {
        const f32x4 w = ld4(W + (size_t)k * ADA);
#pragma unroll
        for (int r = 0; r < 17; ++r) { const float s = sc[r * D + k]; acc[r] = acc[r] + w * s; }
    }
#pragma unroll
    for (int r = 0; r < 17; ++r) { acc[r].x += __shfl_xor(acc[r].x, 32); acc[r].y += __shfl_xor(acc[r].y, 32); acc[r].z += __shfl_xor(acc[r].z, 32); acc[r].w += __shfl_xor(acc[r].w, 32); }
    __syncthreads();
    LAS f32x4* red = (LAS f32x4*)F.lds;
    if (F.lane < 32) {
#pragma unroll
        for (int r = 0; r < 17; ++r) red[(F.wave * 17 + r) * 32 + cq] = acc[r];
    }
    __syncthreads();
    for (int i = F.tid; i < 17 * 32; i += NTHREADS) { const int r = i >> 5, q = i & 31; f32x4 s = red[r * 32 + q];
#pragma unroll
        for (int w = 1; w < 8; ++w) s = s + red[(w * 17 + r) * 32 + q];
        const int col = cg * 128 + q * 4; s = s + ld4(a.in[5] + (size_t)layer * ADA + col);
        float* dst = r < 16 ? (float*)(F.ws + WS_MODX) + ((size_t)layer * 16 + r) * ADA + col : (float*)(F.ws + WS_MODC) + (size_t)layer * ADA + col;
        *(f32x4*)dst = s; }
    __syncthreads();
}

__device__ __forceinline__ void p0_convert(const Frame& F, const Args& a) {
    LAS unsigned* T = (LAS unsigned*)(F.lds + 70 * 1024) + F.wave * (64 * 33);
    const int gw = F.vcu * NWAVES + F.wave, NGW = F.G * NWAVES, lane = F.lane;
    bf16_t* win0 = (bf16_t*)(F.ws + WS_WIN0); bf16_t* wout0 = (bf16_t*)(F.ws + WS_WOUT0); bf16_t* wqkv1 = (bf16_t*)(F.ws + WS_WQKV1); bf16_t* wout1 = (bf16_t*)(F.ws + WS_WOUT1); bf16_t* wr = (bf16_t*)(F.ws + WS_WR);
    constexpr int I_IN = 16 * (4 + 4 + 8 + 8 + 1 + 16);
    constexpr int I_SQ = 16 * 16, I_QKV = 16 * 48, I_R = 16 * 4;
    constexpr int NIT = I_IN + I_SQ + I_QKV + I_SQ + 2 * I_R;
    const int nbulk0 = F.G == 256 ? F0_BULK : MOE_CVT_ITEMS;
    for (int it = gw; it < NIT + nbulk0; it += NGW) {
        int r = it;
        if (r < I_IN) {
            const int kt = r & 15, g = r >> 4; int col0, nc = 64, drow;
            if (g < 24) { col0 = 64 * g; drow = 64 * g; }
            else if (g == 24) { col0 = 1536; nc = 32; drow = 2560; }
            else { const int s = g - 25; const int isb = s >> 3, q = s & 7;
                col0 = 1568 + 512 * isb + 64 * q; drow = 1536 + 256 * (q >> 1) + 128 * isb + 64 * (q & 1); }
            cvt_item(a.in[10], AB_IN, col0, nc, kt * 64, win0, D, drow, T, lane); continue; }
        r -= I_IN;
        if (r < I_SQ) { cvt_matrix_item(a.in[11], D, 0, D, D, wout0, 0, r, T, lane); continue; } r -= I_SQ;
        if (r < I_QKV) { cvt_matrix_item(a.in[21], 3 * D, 0, 3 * D, D, wqkv1, 0, r, T, lane); continue; } r -= I_QKV;
        if (r < I_SQ) { cvt_matrix_item(a.in[22], D, 0, D, D, wout1, 0, r, T, lane); continue; } r -= I_SQ;
        if (r < 2 * I_R) { const int l = r / I_R; cvt_matrix_item(a.in[24] + (size_t)l * D * NEXP, NEXP, 0, NEXP, D, wr + (size_t)l * NEXP * D, 0, r % I_R, T, lane); continue; } r -= 2 * I_R;
        cvt_moe_item(a, 0, r, F.ws, T, lane);
    }
    { u32x4 z = (u32x4){0u, 0u, 0u, 0u}; const size_t n16 = (size_t)(AB_INP - AB_IN) * D * 2 / 16; u32x4* p = (u32x4*)(win0 + (size_t)AB_IN * D);
      for (size_t i = (size_t)blockIdx.x * NTHREADS + F.tid; i < n16; i += (size_t)F.G * NTHREADS) p[i] = z; }
    if (blockIdx.x == 0) { f32x2* rt = (f32x2*)(F.ws + WS_ROPE);
        for (int i = F.tid; i < 64 * 16; i += NTHREADS) { const int pos = i >> 4, f = i & 15; const float inv = powf(10000.0f, -(float)f / 16.0f); const float ang = (float)pos * inv; rt[i] = (f32x2){cosf(ang), sinf(ang)}; } }
}


__device__ __forceinline__ int gsw(int row, int ch) { return row * 128 + ((ch ^ (row & 7)) << 4); }
__device__ __forceinline__ int gla_row(int n, int p, int b, int d) {
    const bool isctx = n < 4; const int j = isctx ? n : n - 4; int pos = j * 64 + p;
    if (d) pos = (isctx ? CTXL : SEQ) - 1 - pos;
    return isctx ? NX + b * CTXL + pos : b * SEQ + pos;
}
struct GlaRaw { u32x4 q, k, v0, v1; f32x4 lr[4]; };
__device__ __forceinline__ void gla_load(GlaRaw& R, int n, int lane, int w, int b, int h, int d, const bf16_t* qb, const bf16_t* kb, const bf16_t* vb, const float* lr) {
    const int row = gla_row(n, lane, b, d);
    R.q = *(const u32x4*)(qb + (size_t)row * 256 + h * 64 + 8 * w);
    R.k = *(const u32x4*)(kb + (size_t)row * 256 + h * 64 + 8 * w);
    R.v0 = *(const u32x4*)(vb + (size_t)row * 512 + h * 128 + 8 * w);
    R.v1 = *(const u32x4*)(vb + (size_t)row * 512 + h * 128 + 64 + 8 * w);
#pragma unroll
    for (int i = 0; i < 4; ++i) R.lr[i] = *(const f32x4*)(lr + (size_t)row * 32 + d * 16 + 4 * i);
}
__device__ __forceinline__ void unpack8(const u32x4& w, float (&f)[8]) { f[0] = bflo(w.x); f[1] = bfhi(w.x); f[2] = bflo(w.y); f[3] = bfhi(w.y); f[4] = bflo(w.z); f[5] = bfhi(w.z); f[6] = bflo(w.w); f[7] = bfhi(w.w); }
constexpr int GPL_QE = 0, GPL_KE = 8192, GPL_OUT = 16384, GPL_BUF = 16384 + GI_BYTES + 256, GPL_DW = 2 * GPL_BUF, GPL_DB = GPL_DW + 4096, GPL_END = GPL_DB + 256;
static_assert(GPL_END <= RING_BYTES && (GPL_BUF % 16) == 0, "gla prep lds");
__device__ __forceinline__ void gla_prep_phase(const Frame& F, const Args& a) {
    LAS unsigned char* L = F.lds; const int lane = F.lane, w = F.wave, r16 = lane & 15, g4 = lane >> 4;
    const bf16_t* qb = (const bf16_t*)(F.ws + T_QB); const bf16_t* kb = (const bf16_t*)(F.ws + T_KB); const bf16_t* vb = (const bf16_t*)(F.ws + T_VB); const float* lrb = (const float*)(F.ws + T_LR);
    for (int cc = blockIdx.x; cc < 256; cc += F.G) {
        const int sq = cc & 127, b = sq >> 3, h = (sq >> 1) & 3, d = sq & 1;
        const float* dw = d ? a.in[14] : a.in[12]; const float* db = d ? a.in[15] : a.in[13];
        __syncthreads();
        for (int i = F.tid; i < 16 * 64; i += NTHREADS) ((LAS float*)(L + GPL_DW))[i] = dw[(i >> 6) * GLA_QK + h * 64 + (i & 63)];
        if (F.tid < 64) ((LAS float*)(L + GPL_DB))[F.tid] = db[h * 64 + F.tid];
        GlaRaw R; gla_load(R, cc >> 7, lane, w, b, h, d, qb, kb, vb, lrb);
        __syncthreads();
        for (int k = 0; k < 18; ++k) {
            const int n = (cc >> 7) + 2 * k;
            LAS unsigned char* PB = L + (k & 1) * GPL_BUF; LAS unsigned char* OUT = PB + GPL_OUT;
            {
                float z[8], q[8], kk[8], v0[8], v1[8];
                unpack8(R.q, q); unpack8(R.k, kk); unpack8(R.v0, v0); unpack8(R.v1, v1);
                const LAS float* DW = (const LAS float*)(L + GPL_DW); const LAS float* DB = (const LAS float*)(L + GPL_DB);
#pragma unroll
                for (int j = 0; j < 8; ++j) z[j] = DB[8 * w + j];
#pragma unroll
                for (int r = 0; r < 16; ++r) { const float x = R.lr[r >> 2][r & 3]; const f32x4 w0 = *(const LAS f32x4*)(DW + r * 64 + 8 * w), w1 = *(const LAS f32x4*)(DW + r * 64 + 8 * w + 4);
                    z[0] += x * w0.x; z[1] += x * w0.y; z[2] += x * w0.z; z[3] += x * w0.w; z[4] += x * w1.x; z[5] += x * w1.y; z[6] += x * w1.z; z[7] += x * w1.w; }
                float qe[8], ke[8], qi[8]; unsigned short ko[8]; float ld[8];
#pragma unroll
                for (int j = 0; j < 8; ++j) ld[j] = (fminf(z[j], 0.f) - __logf(1.0f + __expf(-fabsf(z[j])))) * (1.0f / 16.0f);
#pragma unroll
                for (int o = 1; o < 64; o <<= 1) { float t[8];
#pragma unroll
                    for (int j = 0; j < 8; ++j) t[j] = __shfl_up(ld[j], o);
#pragma unroll
                    for (int j = 0; j < 8; ++j) ld[j] += (lane >= o) ? t[j] : 0.f; }
                float decv = 0.f;
#pragma unroll
                for (int j = 0; j < 8; ++j) {
                    const float bm = __builtin_bit_cast(float, __builtin_amdgcn_readlane(__builtin_bit_cast(int, ld[j]), 31)), bl = __builtin_bit_cast(float, __builtin_amdgcn_readlane(__builtin_bit_cast(int, ld[j]), 63));
                    const float e1 = __expf(ld[j] - bm), e2 = __expf(bm - ld[j]);
                    qe[j] = q[j] * e1; ke[j] = kk[j] * e2; qi[j] = q[j] * __expf(ld[j]); ko[j] = (unsigned short)f2bf(kk[j] * __expf(bl - ld[j]));
                    decv = (lane == j) ? __expf(bl) : decv;
                }
                if (lane < 8) ((LAS float*)(OUT + GI_DEC))[8 * w + lane] = decv;
                *(LAS u32x4*)(PB + GPL_QE + gsw(lane, w)) = (u32x4){pk2(qe[0], qe[1]), pk2(qe[2], qe[3]), pk2(qe[4], qe[5]), pk2(qe[6], qe[7])};
                *(LAS u32x4*)(PB + GPL_KE + gsw(lane, w)) = (u32x4){pk2(ke[0], ke[1]), pk2(ke[2], ke[3]), pk2(ke[4], ke[5]), pk2(ke[6], ke[7])};
                *(LAS u32x4*)(OUT + GI_QIN + gsw(lane, w)) = (u32x4){pk2(qi[0], qi[1]), pk2(qi[2], qi[3]), pk2(qi[4], qi[5]), pk2(qi[6], qi[7])};
#pragma unroll
                for (int j = 0; j < 8; ++j) { const int rw = 8 * w + j;
                    *(LAS unsigned short*)(OUT + GI_KOT + gsw(rw, lane >> 3) + (lane & 7) * 2) = ko[j];
                    *(LAS unsigned short*)(OUT + GI_VT + gsw(rw, lane >> 3) + (lane & 7) * 2) = (unsigned short)f2bf(v0[j]);
                    *(LAS unsigned short*)(OUT + GI_VT + gsw(64 + rw, lane >> 3) + (lane & 7) * 2) = (unsigned short)f2bf(v1[j]); }
            }
            if (k + 1 < 18) gla_load(R, n + 2, lane, w, b, h, d, qb, kb, vb, lrb);
            lds_barrier();
#pragma unroll
            for (int i = 0; i < 2; ++i) { const int tI = 2 * w + i, st = tI >> 2, pt = tI & 3;
                f32x4 c = (f32x4){0.f, 0.f, 0.f, 0.f};
                if (st <= pt) {
#pragma unroll
                    for (int ks = 0; ks < 2; ++ks) { const bf16x8 af = *(const LAS bf16x8*)(PB + GPL_KE + gsw(16 * st + r16, 4 * ks + g4)), bfr = *(const LAS bf16x8*)(PB + GPL_QE + gsw(16 * pt + r16, 4 * ks + g4));
                        c = __builtin_amdgcn_mfma_f32_16x16x32_bf16(af, bfr, c, 0, 0, 0); }
                    const int p = 16 * pt + r16, s0 = 16 * st + 4 * g4;
#pragma unroll
                    for (int e = 0; e < 4; ++e) if (s0 + e > p) c[e] = 0.f;
                }
                u32x2 o; o.x = pk2(c[0], c[1]); o.y = pk2(c[2], c[3]);
                *(LAS u32x2*)(OUT + GI_A + gsw(16 * pt + r16, 2 * st + (g4 >> 1)) + (g4 & 1) * 8) = o; }
            lds_barrier();
            { unsigned char* rec = F.ws + T_GLA + (size_t)(sq * 36 + n) * GI_BYTES;
              for (int i = F.tid; i < GI_BYTES / 16; i += NTHREADS) *(u32x4*)(rec + i * 16) = *(const LAS u32x4*)(OUT + i * 16); }
        }
    }
    __syncthreads();
}
constexpr int GSL_IN = 33792  , GSL_ST = 3 * GSL_IN, GSL_END = GSL_ST + 2 * 8192;
static_assert(GSL_END <= RING_BYTES, "gla seq lds");
__device__ __forceinline__ void gla_seq_phase(const Frame& F, const Args& a) {
    LAS unsigned char* L = F.lds; const int lane = F.lane, w = F.wave, r16 = lane & 15, g4 = lane >> 4, tid = F.tid;
    for (int it = blockIdx.x; it < 256; it += F.G) {
        const int sq = it >> 1, vh = it & 1, b = sq >> 3, h = (sq >> 1) & 3, d = sq & 1;
        bf16_t* ob = (bf16_t*)(F.ws + (d ? T_OB : T_OF));
        const unsigned char* rec0 = F.ws + T_GLA + (size_t)(sq * 36) * GI_BYTES;
        __syncthreads();
        for (int i = tid; i < 2 * 8192 / 4; i += NTHREADS) ((LAS unsigned*)(L + GSL_ST))[i] = 0u;
        f32x4 Sacc[2] = {(f32x4){0.f, 0.f, 0.f, 0.f}, (f32x4){0.f, 0.f, 0.f, 0.f}};
#define GLA_DMA(n_) do { const unsigned char* r_ = rec0 + (size_t)(n_) * GI_BYTES; LAS unsigned char* d_ = L + ((n_) % 3) * GSL_IN; \
            __builtin_amdgcn_global_load_lds((const unsigned*)(r_ + GI_A + tid * 16), (LAS unsigned*)(d_ + w * 1024), 16, 0, 0); \
            __builtin_amdgcn_global_load_lds((const unsigned*)(r_ + GI_QIN + tid * 16), (LAS unsigned*)(d_ + 8192 + w * 1024), 16, 0, 0); \
            __builtin_amdgcn_global_load_lds((const unsigned*)(r_ + GI_KOT + tid * 16), (LAS unsigned*)(d_ + 16384 + w * 1024), 16, 0, 0); \
            __builtin_amdgcn_global_load_lds((const unsigned*)(r_ + GI_VT + vh * 8192 + tid * 16), (LAS unsigned*)(d_ + 24576 + w * 1024), 16, 0, 0); \
            __builtin_amdgcn_global_load_lds((const unsigned*)(r_ + GI_DEC + lane * 16), (LAS unsigned*)(d_ + 32768), 16, 0, 0); } while (0)
        GLA_DMA(0); GLA_DMA(1);
        for (int n = 0; n < 36; ++n) {
            LAS unsigned char* IN = L + (n % 3) * GSL_IN; LAS unsigned char* STr = L + GSL_ST + (n & 1) * 8192; LAS unsigned char* STw = L + GSL_ST + ((n + 1) & 1) * 8192;
            if (n == 0) asm volatile("s_waitcnt vmcnt(5)" ::: "memory"); else if (n < 35) asm volatile("s_waitcnt vmcnt(7)" ::: "memory"); else asm volatile("s_waitcnt vmcnt(2)" ::: "memory");
            lds_barrier();
            if (n + 2 < 36) GLA_DMA(n + 2);
#pragma unroll
            for (int i = 0; i < 2; ++i) { const int tI = 2 * w + i, vt = tI >> 2, pt = tI & 3;
                f32x4 c = (f32x4){0.f, 0.f, 0.f, 0.f};
#pragma unroll
                for (int ks = 0; ks < 2; ++ks) {
                    const bf16x8 a1 = *(const LAS bf16x8*)(IN + 24576 + gsw(16 * vt + r16, 4 * ks + g4)), b1 = *(const LAS bf16x8*)(IN + gsw(16 * pt + r16, 4 * ks + g4));
                    c = __builtin_amdgcn_mfma_f32_16x16x32_bf16(a1, b1, c, 0, 0, 0);
                    const bf16x8 a2 = *(const LAS bf16x8*)(STr + gsw(16 * vt + r16, 4 * ks + g4)), b2 = *(const LAS bf16x8*)(IN + 8192 + gsw(16 * pt + r16, 4 * ks + g4));
                    c = __builtin_amdgcn_mfma_f32_16x16x32_bf16(a2, b2, c, 0, 0, 0); }
                const int row = gla_row(n, 16 * pt + r16, b, d);
                u32x2 o; o.x = pk2(c[0], c[1]); o.y = pk2(c[2], c[3]);
                *(u32x2*)(ob + (size_t)row * 512 + h * 128 + vh * 64 + 16 * vt + 4 * g4) = o; }
#pragma unroll
            for (int i = 0; i < 2; ++i) { const int tI = 2 * w + i, ct = tI >> 2, vt = tI & 3;
                const f32x4 dc = *(const LAS f32x4*)(IN + 32768 + (16 * ct + 4 * g4) * 4);
                f32x4 c = Sacc[i] * dc;
#pragma unroll
                for (int ks = 0; ks < 2; ++ks) { const bf16x8 af = *(const LAS bf16x8*)(IN + 16384 + gsw(16 * ct + r16, 4 * ks + g4)), bfr = *(const LAS bf16x8*)(IN + 24576 + gsw(16 * vt + r16, 4 * ks + g4));
                    c = __builtin_amdgcn_mfma_f32_16x16x32_bf16(af, bfr, c, 0, 0, 0); }
                Sacc[i] = c;
                u32x2 o; o.x = pk2(c[0], c[1]); o.y = pk2(c[2], c[3]);
                *(LAS u32x2*)(STw + gsw(16 * vt + r16, 2 * ct + (g4 >> 1)) + (g4 & 1) * 8) = o; }
        }
#undef GLA_DMA
        asm volatile("s_waitcnt vmcnt(0)" ::: "memory");
    }
    __syncthreads();
}

__device__ __forceinline__ void finish_conv_phase(const Frame& F, const Args& a) {
    const int lane = F.lane; bf16_t* cat = (bf16_t*)(F.ws + T_CAT);
    {
        const bf16_t* of = (const bf16_t*)(F.ws + T_OF); const bf16_t* obk = (const bf16_t*)(F.ws + T_OB); const bf16_t* gb = (const bf16_t*)(F.ws + T_GB);
        const int gw = F.vcu * NWAVES + F.wave, NGW = F.G * NWAVES;
        float gg[8];
#pragma unroll
        for (int j = 0; j < 8; ++j) gg[j] = a.in[16][8 * lane + j];
        for (int row = gw; row < NT; row += NGW) {
            float x[8], y[8], g[8];
            unpack8(*(const u32x4*)(of + (size_t)row * 512 + 8 * lane), x); unpack8(*(const u32x4*)(obk + (size_t)row * 512 + 8 * lane), y); unpack8(*(const u32x4*)(gb + (size_t)row * 512 + 8 * lane), g);
            float ss = 0.f;
#pragma unroll
            for (int j = 0; j < 8; ++j) { x[j] += y[j]; ss += x[j] * x[j]; }
            ss += __shfl_xor(ss, 1); ss += __shfl_xor(ss, 2); ss += __shfl_xor(ss, 4); ss += __shfl_xor(ss, 8);
            const float rs = rsqrtf(ss * (1.0f / 128.0f) + RMS_EPS);
#pragma unroll
            for (int j = 0; j < 8; ++j) x[j] = x[j] * rs * gg[j] * siluf_(g[j]);
            *(u32x4*)(cat + (size_t)row * D + 8 * lane) = (u32x4){pk2(x[0], x[1]), pk2(x[2], x[3]), pk2(x[4], x[5]), pk2(x[6], x[7])};
        }
    }
    {
        const bf16_t* ub = (const bf16_t*)(F.ws + T_UB); LAS float* tile = (LAS float*)F.lds;
        const int c = F.tid;
        float wv[CONV_W];
#pragma unroll
        for (int j = 0; j < CONV_W; ++j) wv[j] = a.in[17][j * CONV_CH + c];
        const float cb = a.in[18][c];
        float lg[8], lb[8];
#pragma unroll
        for (int i = 0; i < 8; ++i) { lg[i] = a.in[19][lane + 64 * i]; lb[i] = a.in[20][lane + 64 * i]; }
        for (int ti = blockIdx.x; ti < NT / 32; ti += F.G) {
            const int row0 = ti * 32; const bool lat = row0 < NX;
            const int t0 = lat ? (row0 & (SEQ - 1)) : ((row0 - NX) & (CTXL - 1)); const int len = lat ? SEQ : CTXL; const int sbase = row0 - t0;
            float in[62];
            unsigned short raw[62];
#pragma unroll
            for (int i = 0; i < 62; ++i) { int t = t0 - 15 + i; t = t < 0 ? 0 : (t >= len ? len - 1 : t); raw[i] = ub[(size_t)(sbase + t) * 512 + c]; }
#pragma unroll
            for (int i = 0; i < 62; ++i) { const int t = t0 - 15 + i; in[i] = (t >= 0 && t < len) ? bf2f(raw[i]) : 0.f; }
            __syncthreads();
#pragma unroll
            for (int t = 0; t < 32; ++t) { float s = cb;
#pragma unroll
                for (int j = 0; j < CONV_W; ++j) s += wv[j] * in[t + j];
                tile[t * 512 + c] = s; }
            __syncthreads();
#pragma unroll
            for (int q = 0; q < 4; ++q) { const int t = 4 * F.wave + q; float v[8]; float s = 0.f;
#pragma unroll
                for (int i = 0; i < 8; ++i) { v[i] = tile[t * 512 + lane + 64 * i]; s += v[i]; }
                const float mu = wave_sum(s) * (1.0f / 512.0f); float qq = 0.f;
#pragma unroll
                for (int i = 0; i < 8; ++i) { v[i] -= mu; qq += v[i] * v[i]; }
                const float rstd = rsqrtf(wave_sum(qq) * (1.0f / 512.0f) + LN_EPS);
#pragma unroll
                for (int i = 0; i < 8; ++i) { const float y = v[i] * rstd * lg[i] + lb[i]; cat[(size_t)(row0 + t) * D + 512 + lane + 64 * i] = (bf16_t)f2bf(siluf_(y)); } }
        }
        __syncthreads();
    }
}


constexpr int CW_TST = 20480;
constexpr int AUX_TST = AUX_OFF, AUX_TILEE = AUX_OFF + 1040, AUX_IDX = AUX_OFF + 1168;
constexpr int MOE_MAXU = 32, MOE_MAXIDX = 16;
static_assert(AUX_IDX + MOE_MAXIDX * 1024 <= MISC_OFF, "aux lds");

struct EpiRouter {
    static constexpr bool PERM = false, AFTER_DRAIN = true;
    const float* rbias; int* asg_e; int* asg_r; float* asg_g; unsigned* counts;
    __device__ __forceinline__ void operator()(const f32x4 (&)[2][2][4][2], const Unit&, int, int, int, int) const {}
    __device__ __forceinline__ void fused(const f32x4 (&acc)[2][2][4][2], const Unit& u, int wr, int wc, int fr, int fq, LAS unsigned char* lds, int wid, int lane) const {
        LAS float* SC = (LAS float*)lds;
        LAS unsigned* lcnt = (LAS unsigned*)(lds + 66560); LAS unsigned* lbase = lcnt + 256;
        LAS int* selE = (LAS int*)(lbase + 256); LAS int* selR = selE + 2048;
        const int tid = wid * 64 + lane;
        if (tid < 256) lcnt[tid] = 0u;
        const f32x4 rb = *(const f32x4*)(rbias + 4 * lane);
        const float NINF = -__builtin_inff();
#pragma unroll
        for (int ai = 0; ai < 2; ++ai)
#pragma unroll
            for (int mm = 0; mm < 2; ++mm) {
                LDS_WAIT(); __builtin_amdgcn_s_barrier(); asm volatile("" ::: "memory");
#pragma unroll
                for (int mi = 0; mi < 2; ++mi) { const int lr = 32 * wr + 16 * mi + fr;
#pragma unroll
                    for (int bj = 0; bj < 2; ++bj)
#pragma unroll
                        for (int n = 0; n < 2; ++n) *(LAS f32x4*)(SC + lr * 260 + 128 * bj + 32 * wc + 16 * n + 4 * fq) = acc[ai][bj][2 * mm + mi][n]; }
                LDS_WAIT(); __builtin_amdgcn_s_barrier(); asm volatile("" ::: "memory");
                for (int q = 0; q < 8; ++q) {
                    const int lr = 8 * wid + q; const int rit = 128 * ai + 64 * (lr >> 5) + 16 * (2 * mm + ((lr >> 4) & 1)) + (lr & 15);
                    const f32x4 lg = *(const LAS f32x4*)(SC + lr * 260 + 4 * lane);
                    float s[4], cd[4];
#pragma unroll
                    for (int j = 0; j < 4; ++j) { s[j] = 1.0f / (1.0f + __expf(-lg[j])); cd[j] = s[j] + rb[j]; }
                    float m1 = fmaxf(cd[0], cd[1]), m2 = fminf(cd[0], cd[1]);
                    { const float x = cd[2]; const float n1 = fmaxf(m1, x); m2 = fmaxf(fminf(m1, x), m2); m1 = n1; }
                    { const float x = cd[3]; const float n1 = fmaxf(m1, x); m2 = fmaxf(fminf(m1, x), m2); m1 = n1; }
#pragma unroll
                    for (int o = 1; o < 8; o <<= 1) { const float a1 = __shfl_xor(m1, o), a2 = __shfl_xor(m2, o); const float n1 = fmaxf(m1, a1); m2 = fmaxf(fminf(m1, a1), fmaxf(m2, a2)); m1 = n1; }
                    const float gs = m1 + m2; const int mygrp = lane >> 3; int rank = 0;
#pragma unroll
                    for (int g = 0; g < 8; ++g) { const float og = __shfl(gs, 8 * g); rank += (og > gs || (og == gs && g < mygrp)) ? 1 : 0; }
                    if (rank >= 4) { cd[0] = NINF; cd[1] = NINF; cd[2] = NINF; cd[3] = NINF; }
                    int myE = 0; float myG = 0.f; float gsum = 0.f;
#pragma unroll
                    for (int k = 0; k < TOPK; ++k) {
                        float bv = cd[0]; int bi = 0;
                        if (cd[1] > bv) { bv = cd[1]; bi = 1; } if (cd[2] > bv) { bv = cd[2]; bi = 2; } if (cd[3] > bv) { bv = cd[3]; bi = 3; }
                        float v = bv; int ix = 4 * lane + bi;
#pragma unroll
                        for (int o = 32; o >= 1; o >>= 1) { const float ov = __shfl_xor(v, o); const int oi = __shfl_xor(ix, o); if (ov > v || (ov == v && oi < ix)) { v = ov; ix = oi; } }
                        const int sl = ix & 3; const float mys = sl == 0 ? s[0] : (sl == 1 ? s[1] : (sl == 2 ? s[2] : s[3]));
                        const float gv = __shfl(mys, ix >> 2);
                        gsum += gv;
                        if (lane == k) { myE = ix; myG = gv; }
                        if (lane == (ix >> 2)) { if (sl == 0) cd[0] = NINF; else if (sl == 1) cd[1] = NINF; else if (sl == 2) cd[2] = NINF; else cd[3] = NINF; }
                    }
                    if (lane < TOPK) { const unsigned r = __hip_atomic_fetch_add(&lcnt[myE], 1u, __ATOMIC_RELAXED, __HIP_MEMORY_SCOPE_WORKGROUP); selE[rit * 8 + lane] = myE; selR[rit * 8 + lane] = (int)r; asg_g[(size_t)(u.orow + rit) * 8 + lane] = myG / gsum * 2.5f; }
                }
            }
        LDS_WAIT(); __builtin_amdgcn_s_barrier(); asm volatile("" ::: "memory");
        if (tid < 256) { const unsigned c = lcnt[tid]; lbase[tid] = c ? atomicAdd(&counts[tid], c) : 0u; }
        LDS_WAIT(); __builtin_amdgcn_s_barrier(); asm volatile("" ::: "memory");
        for (int i = tid; i < 2048; i += NTHREADS) { const int e = selE[i]; asg_e[(size_t)u.orow * 8 + i] = e; asg_r[(size_t)u.orow * 8 + i] = (int)lbase[e] + selR[i]; }
    }
};

__device__ __forceinline__ void moe_place(const Frame& F, int layer, int ntok) {
    LAS int* cnt = (LAS int*)F.lds; LAS int* tst = cnt + 256;
    const unsigned* counts = F.ctl + CW_CNT + layer * 256;
    const int* asg_e = (const int*)(F.ws + M_AE); const int* asg_r = (const int*)(F.ws + M_AR); int* tslot = (int*)(F.ws + M_TS); int* stok = (int*)(F.ws + M_ST);
    __syncthreads();
    if (F.tid < 256) cnt[F.tid] = (int)counts[F.tid];
    __syncthreads();
    if (F.tid == 0) { int acc = 0; for (int e = 0; e < 256; ++e) { tst[e] = acc; acc += (cnt[e] + 255) >> 8; } tst[256] = acc; }
    __syncthreads();
    const int ntr = tst[256];
    if (blockIdx.x == 0) for (int i = F.tid; i < 257; i += NTHREADS) F.ctl[CW_TST + layer * 320 + i] = (unsigned)tst[i];
    const int gt = blockIdx.x * NTHREADS + F.tid, gs = F.G * NTHREADS;
    for (int i = gt; i < ntok * 8; i += gs) { const int e = asg_e[i]; const int slot = tst[e] * 256 + asg_r[i]; stok[slot] = i >> 3; tslot[i] = slot; }
    for (int e = blockIdx.x; e < 256; e += F.G) { const int s0 = tst[e] * 256 + cnt[e], s1 = tst[e + 1] * 256; for (int s = s0 + F.tid; s < s1; s += NTHREADS) stok[s] = 0; }
    for (int i = gt; i < ntok; i += gs) stok[ntr * 256 + i] = i;
    __syncthreads();
}

template <int NCOL>
__device__ __forceinline__ int moe_units_setup(const Frame& F, int layer, int ntok, int c, bool want_idx) {
    LAS int* tst = (LAS int*)(F.lds + AUX_TST); LAS int* tileE = (LAS int*)(F.lds + AUX_TILEE); LAS int* idxl = (LAS int*)(F.lds + AUX_IDX);
    __syncthreads();
    for (int i = F.tid; i < 257; i += NTHREADS) tst[i] = (int)F.ctl[CW_TST + layer * 320 + i];
    __syncthreads();
    const int ntr = tst[256], nunits = (ntr + ntok / 256) * NCOL;
    int nu = c < nunits ? (nunits - c + F.G - 1) / F.G : 0; if (nu > MOE_MAXU) nu = MOE_MAXU; if (want_idx && nu > MOE_MAXIDX) nu = MOE_MAXIDX;
    if (F.tid < nu) { const int rt = (c + F.tid * F.G) / NCOL; int e;
        if (rt >= ntr) e = NEXP; else { int lo = 0, hi = 255; while (lo < hi) { const int mid = (lo + hi + 1) >> 1; if (tst[mid] <= rt) lo = mid; else hi = mid - 1; } e = lo; }
        tileE[F.tid] = e; }
    if (want_idx) { const int* stok = (const int*)(F.ws + M_ST); for (int i = F.tid; i < nu * 256; i += NTHREADS) idxl[i] = stok[(size_t)((c + (i >> 8) * F.G) / NCOL) * 256 + (i & 255)]; }
    __syncthreads();
    return nu;
}
struct SchedMoeGU {
    const char* A; const char* W; const LAS int* tileE; const LAS int* idxl; int nu, G, c;
    __device__ __forceinline__ bool next(int i, Unit& u) const {
        if (i >= nu) return false; const int un = c + i * G; const int rt = un >> 1, col = un & 1; const int e = tileE[i];
        u.a = i; u.b = e * 512 + col * 256; u.orow = rt * 256; u.ocol = col * 128; u.aux = e; return true; }
    __device__ __forceinline__ const char* a_base() const { return A; }
    __device__ __forceinline__ const char* b_ptr(const Unit& u) const { return W + (size_t)u.b * D * 2; }
    __device__ __forceinline__ void a_off(const Unit& u, const int (&R)[2], const int (&C)[2], unsigned (&o0)[2], unsigned (&o1)[2]) const {
#pragma unroll
        for (int i = 0; i < 2; ++i) { const int t0 = idxl[u.a * 256 + R[i]], t1 = idxl[u.a * 256 + 128 + R[i]]; o0[i] = (unsigned)t0 * (unsigned)(D * 2) + (unsigned)C[i] * 2u; o1[i] = (unsigned)t1 * (unsigned)(D * 2) + (unsigned)C[i] * 2u; }
    }
};
struct EpiGateUp {
    static constexpr bool PERM = true, AFTER_DRAIN = false;
    bf16_t* hid;
    __device__ __forceinline__ void operator()(const f32x4 (&acc)[2][2][4][2], const Unit& u, int wr, int wc, int fr, int fq) const {
        const int lane = fr + 16 * fq; const int srcb = ((lane >> 2) + 16 * (lane & 3)) << 2;
        const int row0 = u.orow + wr * 64 + (lane >> 2), col0 = u.ocol + wc * 32 + 8 * (lane & 3);
#pragma unroll
        for (int ai = 0; ai < 2; ++ai)
#pragma unroll
            for (int m = 0; m < 4; ++m) { float h[8];
#pragma unroll
                for (int n = 0; n < 2; ++n)
#pragma unroll
                    for (int e = 0; e < 4; ++e) { const float g = acc[ai][0][m][n][e], up = acc[ai][1][m][n][e]; h[4 * n + e] = g / (1.0f + __expf(-g)) * up; }
                u32x4 w; w.x = cvt_pk_bf16(h[0], h[1]); w.y = cvt_pk_bf16(h[2], h[3]); w.z = cvt_pk_bf16(h[4], h[5]); w.w = cvt_pk_bf16(h[6], h[7]);
                u32x4 t; t.x = (unsigned)__builtin_amdgcn_ds_bpermute(srcb, (int)w.x); t.y = (unsigned)__builtin_amdgcn_ds_bpermute(srcb, (int)w.y); t.z = (unsigned)__builtin_amdgcn_ds_bpermute(srcb, (int)w.z); t.w = (unsigned)__builtin_amdgcn_ds_bpermute(srcb, (int)w.w);
                *(u32x4*)(hid + (size_t)(row0 + ai * 128 + m * 16) * DEXP + col0) = t; }
    }
};
struct SchedMoeDN {
    const char* A; const char* W; const LAS int* tileE; int nu, G, c;
    __device__ __forceinline__ bool next(int i, Unit& u) const {
        if (i >= nu) return false; const int un = c + i * G; const int rt = un >> 2, col = un & 3; const int e = tileE[i];
        u.a = rt; u.b = e * 1024 + col * 256; u.orow = rt * 256; u.ocol = col * 256; u.aux = e; return true; }
    __device__ __forceinline__ const char* a_base() const { return A; }
    __device__ __forceinline__ const char* b_ptr(const Unit& u) const { return W + (size_t)u.b * DEXP * 2; }
    __device__ __forceinline__ void a_off(const Unit& u, const int (&R)[2], const int (&C)[2], unsigned (&o0)[2], unsigned (&o1)[2]) const {
#pragma unroll
        for (int i = 0; i < 2; ++i) { o0[i] = (unsigned)((u.a * 256 + R[i]) * DEXP + C[i]) * 2u; o1[i] = o0[i] + (unsigned)(128 * DEXP * 2); }
    }
};

constexpr int NA_RING = 11, NA_VR = 0, NA_VC = NA_RING * 64 * 128, NA_KC = NA_VC + 256 * 128, NA_RPB = NA_KC + 256 * 128, NA_END = NA_RPB + 15 * 128;
static_assert(NA_END <= MISC_OFF, "na lds");
typedef short s16x4 __attribute__((ext_vector_type(4)));
__device__ __forceinline__ int na_voff(int row, int ch) { return row * 128 + ((((ch >> 1) ^ ((row >> 1) & 3)) << 5) | ((ch & 1) << 4)); }
__device__ __forceinline__ int na_koff(int row, int ch) { return row * 128 + ((ch ^ (row & 7)) << 4); }
template <bool CTX, int TB>
__device__ __forceinline__ void na_seg(LAS unsigned char* L, bf16x8 (&kf)[8][2], const char* knext, unsigned loff, const bf16x8 (&qf)[2], int seg, int r16, int g4, int r0, int band, const int (&boff)[2][4], int rbase,
                                       const int (&voff)[4], f32x4 (&O)[4], float& m_run, float& sum) {
    const float NINF = -__builtin_inff();
    float S[8][4]; float mx = NINF;
#pragma unroll
    for (int t = 0; t < 8; ++t) {
        f32x4 c = (f32x4){0.f, 0.f, 0.f, 0.f};
        if (CTX) {
            const int key = 128 * seg + 16 * t + r16;
            const bf16x8 k0 = *(const LAS bf16x8*)(L + NA_KC + na_koff(key, g4)), k1 = *(const LAS bf16x8*)(L + NA_KC + na_koff(key, 4 + g4));
            c = __builtin_amdgcn_mfma_f32_16x16x32_bf16(k0, qf[0], c, 0, 0, 0); c = __builtin_amdgcn_mfma_f32_16x16x32_bf16(k1, qf[1], c, 0, 0, 0);
#pragma unroll
            for (int e = 0; e < 4; ++e) S[t][e] = c[e];
        } else {
            c = __builtin_amdgcn_mfma_f32_16x16x32_bf16(kf[t][0], qf[0], c, 0, 0, 0); c = __builtin_amdgcn_mfma_f32_16x16x32_bf16(kf[t][1], qf[1], c, 0, 0, 0);
#pragma unroll
            for (int e = 0; e < 4; ++e) S[t][e] = c[e] + *(const LAS float*)(L + rbase + ((TB + t) >> 1) * 128 + boff[t & 1][e]);
        }
        mx = fmaxf(mx, fmaxf(fmaxf(S[t][0], S[t][1]), fmaxf(S[t][2], S[t][3])));
    }
    if (!CTX && TB == 0) {
#pragma unroll
        for (int t = 0; t < 8; ++t) { const char* bt = knext + (size_t)((t >> 1) * 64 + 16 * (t & 1)) * D * 2; kf[t][0] = *(const bf16x8*)(bt + loff); kf[t][1] = *(const bf16x8*)(bt + loff + 64); }
    }
    mx = fmaxf(mx, __shfl_xor(mx, 16)); mx = fmaxf(mx, __shfl_xor(mx, 32));
    const float m_new = fmaxf(m_run, mx); const float alpha = __builtin_amdgcn_exp2f(m_run - m_new); m_run = m_new;
    float ps = 0.f;
#pragma unroll
    for (int t = 0; t < 8; ++t)
#pragma unroll
        for (int e = 0; e < 4; ++e) { const float p = __builtin_amdgcn_exp2f(S[t][e] - m_new); S[t][e] = p; ps += p; }
    ps += __shfl_xor(ps, 16); ps += __shfl_xor(ps, 32);
    sum = sum * alpha + ps;
#pragma unroll
    for (int mt = 0; mt < 4; ++mt) O[mt] = O[mt] * alpha;
#pragma unroll
    for (int j = 0; j < 4; ++j) {
        bf16x8 pb; { const u32x4 ww = (u32x4){cvt_pk_bf16(S[2 * j][0], S[2 * j][1]), cvt_pk_bf16(S[2 * j][2], S[2 * j][3]), cvt_pk_bf16(S[2 * j + 1][0], S[2 * j + 1][1]), cvt_pk_bf16(S[2 * j + 1][2], S[2 * j + 1][3])}; pb = __builtin_bit_cast(bf16x8, ww); }
        int ub;
        if (CTX) ub = NA_VC + (128 * seg + 32 * j) * 128; else ub = NA_VR + (((r0 + TB / 2 + j) % NA_RING) * 64 + band) * 128;
#pragma unroll
        for (int mt = 0; mt < 4; ++mt) {
            const s16x4 a0 = __builtin_amdgcn_ds_read_tr16_b64_v4i16((LAS s16x4*)(L + ub + voff[mt]));
            const s16x4 a1 = __builtin_amdgcn_ds_read_tr16_b64_v4i16((LAS s16x4*)(L + ub + voff[mt] + 16 * 128));
            const bf16x8 av = (bf16x8){a0[0], a0[1], a0[2], a0[3], a1[0], a1[1], a1[2], a1[3]};
            O[mt] = __builtin_amdgcn_mfma_f32_16x16x32_bf16(av, pb, O[mt], 0, 0, 0);
        }
    }
}
__device__ __forceinline__ void na_phase(const Frame& F, const Args& a) {
    LAS unsigned char* L = F.lds; const int lane = F.lane, w = F.wave, r16 = lane & 15, g4 = lane >> 4;
    const bf16_t* qbuf = (const bf16_t*)(F.ws + T_QKV); const bf16_t* kbuf = qbuf + (size_t)NT * D; const bf16_t* vbuf = kbuf + (size_t)NT * D; bf16_t* cat = (bf16_t*)(F.ws + T_CAT);
    const int rr = w >> 2, cb = w & 3; const int band = cb == 0 ? 0 : (cb == 1 ? 8 : (cb == 2 ? 24 : 32));
    const float NINF = -__builtin_inff();
    const int pkey = F.tid >> 3, pch = F.tid & 7;
    int boff[2][4], voff[4];
    { const int qc = 16 * cb + r16; int cs = qc - 8; cs = cs < 0 ? 0 : (cs > 48 ? 48 : cs);
#pragma unroll
      for (int hc = 0; hc < 2; ++hc)
#pragma unroll
          for (int e = 0; e < 4; ++e) { const int kc = band + 16 * hc + 4 * g4 + e; const bool ok = kc >= cs && kc < cs + 16; boff[hc][e] = (ok ? kc - qc + 15 : 31) * 4; }
      const int rl = 4 * g4 + (r16 >> 2), sw = (rl >> 1) & 3;
#pragma unroll
      for (int mt = 0; mt < 4; ++mt) voff[mt] = rl * 128 + ((mt ^ sw) << 5) + 8 * (r16 & 3); }
    for (int bh = blockIdx.x; bh < BATCH * NA_H; bh += F.G) {
        const int b = bh >> 4, h = bh & 15;
        __syncthreads();
        for (int i = F.tid; i < 15 * 32; i += NTHREADS) { const int ri = i >> 5, ci = i & 31; ((LAS float*)(L + NA_RPB))[i] = ci < 31 ? a.in[23][h * 465 + ri * 31 + ci] * 1.4426950408889634f : NINF; }
        for (int i = F.tid; i < 256 * 8; i += NTHREADS) { const int key = i >> 3, ch = i & 7; const size_t g = (size_t)(NX + b * CTXL + key) * D + h * 64 + ch * 8;
            *(LAS u32x4*)(L + NA_VC + na_voff(key, ch)) = *(const u32x4*)(vbuf + g); *(LAS u32x4*)(L + NA_KC + na_koff(key, ch)) = *(const u32x4*)(kbuf + g); }
        for (int gr = 0; gr < 9; ++gr) *(LAS u32x4*)(L + NA_VR + na_voff(gr * 64 + pkey, pch)) = *(const u32x4*)(vbuf + (size_t)(b * SEQ + gr * 64 + pkey) * D + h * 64 + pch * 8);
        for (int rp = 0; rp < 16; ++rp) {
            int R0 = 2 * rp - 4; R0 = R0 < 0 ? 0 : (R0 > 24 ? 24 : R0);
            int R0n = 2 * rp - 2; R0n = R0n < 0 ? 0 : (R0n > 24 ? 24 : R0n);
            const bool newrows = (rp < 15) && (R0n != R0);
            u32x4 nv0 = (u32x4){0u, 0u, 0u, 0u}, nv1 = nv0;
            if (newrows) { nv0 = *(const u32x4*)(vbuf + (size_t)(b * SEQ + (R0 + 9) * 64 + pkey) * D + h * 64 + pch * 8); if (R0 + 10 < 32) nv1 = *(const u32x4*)(vbuf + (size_t)(b * SEQ + (R0 + 10) * 64 + pkey) * D + h * 64 + pch * 8); }
            const int r = 2 * rp + rr; int r0 = r - 4; r0 = r0 < 0 ? 0 : (r0 > 24 ? 24 : r0);
            const int qrow = b * SEQ + r * 64 + 16 * cb + r16;
            bf16x8 qf[2];
#pragma unroll
            for (int ks = 0; ks < 2; ++ks) qf[ks] = *(const bf16x8*)(qbuf + (size_t)qrow * D + h * 64 + 32 * ks + 8 * g4);
            bf16x8 kf[8][2];
            const char* kb0 = (const char*)kbuf + ((size_t)(b * SEQ + r0 * 64 + band) * D + h * 64) * 2;
            const unsigned loff = (unsigned)(r16 * D + 8 * g4) * 2u;
#pragma unroll
            for (int t = 0; t < 8; ++t) { const char* bt = kb0 + (size_t)((t >> 1) * 64 + 16 * (t & 1)) * D * 2; kf[t][0] = *(const bf16x8*)(bt + loff); kf[t][1] = *(const bf16x8*)(bt + loff + 64); }
            const char* kb1 = kb0 + (size_t)(4 * 64) * D * 2;
            lds_barrier();
            const int rbase = NA_RPB + (r0 - r + 7) * 128;
            f32x4 O[4]; float m_run = NINF, sum = 0.f;
#pragma unroll
            for (int mt = 0; mt < 4; ++mt) O[mt] = (f32x4){0.f, 0.f, 0.f, 0.f};
#pragma nounroll
            for (int seg = 0; seg < 2; ++seg) na_seg<true, 0>(L, kf, kb1, loff, qf, seg, r16, g4, r0, band, boff, rbase, voff, O, m_run, sum);
            na_seg<false, 0>(L, kf, kb1, loff, qf, 0, r16, g4, r0, band, boff, rbase, voff, O, m_run, sum);
            na_seg<false, 8>(L, kf, kb1, loff, qf, 0, r16, g4, r0, band, boff, rbase, voff, O, m_run, sum);
            const float inv = 1.0f / sum;
#pragma unroll
            for (int mt = 0; mt < 4; ++mt) { u32x2 o; o.x = pk2(O[mt][0] * inv, O[mt][1] * inv); o.y = pk2(O[mt][2] * inv, O[mt][3] * inv);
                *(u32x2*)(cat + (size_t)qrow * D + h * 64 + 16 * mt + 4 * g4) = o; }
            if (newrows) { *(LAS u32x4*)(L + NA_VR + na_voff(((R0 + 9) % NA_RING) * 64 + pkey, pch)) = nv0; *(LAS u32x4*)(L + NA_VR + na_voff(((R0 + 10) % NA_RING) * 64 + pkey, pch)) = nv1; }
        }
    }
    __syncthreads();
}

#if MK_ONE_LAUNCH
#define GRID_BAR() xcd_barrier(bar)
#else
#define GRID_BAR() do { } while (0)
#endif
#define IN(k) (lo <= (k) && (k) < hi && (k) <= MK_LAST_PHASE)
#define SEAM(k) do { if (IN(k) && IN((k) + 1)) GRID_BAR(); } while (0)
template <int LAYER>
__device__ __forceinline__ void layer_tail(const Frame& F, const Args& args, const int lo, const int hi, const XcdBarrier& bar) {
    unsigned char* ws = args.ws;
    const float* modx = (const float*)(ws + WS_MODX); const float* modc = (const float*)(ws + WS_MODC);
    float* xw = (float*)(ws + WS_XW); bf16_t* Hb = (bf16_t*)(ws + WS_H);
    constexpr int mb = LAYER ? 16 : 7; constexpr int ntok = LAYER ? NX : NT;
    const float* lmodx = modx + (size_t)LAYER * 16 * ADA; const float* lmodc = modc + (size_t)LAYER * ADA;
    if (IN(LAYER ? 14 : 5)) REPEAT_IF(LAYER ? 14 : 5) { REP_BAR();
        SchedDense S{(const char*)(ws + T_CAT), (const char*)(ws + (LAYER ? WS_WOUT1 : WS_WOUT0)), D, ntok / 256, D / 256, 0, 1, 0, F.G, (int)blockIdx.x};
        EpiBf16 E{(bf16_t*)(ws + T_Y), D, 0, 0};
        pg8::gemm_phase<EpiBf16, SchedDense, true>(F.lds, D, S, E);
        if (LAYER == 0 && F.G == 256 && (int)blockIdx.x >= 64) cvt_moe_range(F, args, 0, F0_BULK + F0_P2, F0_BULK + F0_P2 + F0_P5, (int)blockIdx.x - 64, 192);
    }
    SEAM(LAYER ? 14 : 5);
    if (IN(LAYER ? 15 : 6)) REPEAT_IF(LAYER ? 15 : 6) { REP_BAR();
        RowPhase P{}; P.xin_lat = LAYER ? xw : args.in[0]; P.xin_ctx = LAYER ? xw + (size_t)NX * D : args.in[2]; P.xout_lat = xw; P.xout_ctx = xw + (size_t)NX * D; P.nrows = ntok; P.ysrc = 1; P.y = (const bf16_t*)(ws + T_Y);
        P.gpost = args.in[7] + LAYER * D; P.modx = lmodx; P.modc = lmodc; P.gate_chunk = 2;
        P.doH = true; P.H = Hb; P.gpre = args.in[8] + LAYER * D; P.sc_chunk = 4; P.sh_chunk = 3; P.modxH = lmodx; P.modcH = lmodc;
        row_phase(F, P);
    }
    SEAM(LAYER ? 15 : 6);
    if (IN(mb)) REPEAT_IF(mb) { REP_BAR();
        SchedDense S{(const char*)Hb, (const char*)(ws + WS_WR) + (size_t)LAYER * NEXP * D * 2, D, ntok / 256, 1, 0, 1, 0, F.G, (int)blockIdx.x};
        EpiRouter E{args.in[25] + LAYER * NEXP, (int*)(ws + M_AE), (int*)(ws + M_AR), (float*)(ws + M_AG), F.ctl + CW_CNT + LAYER * 256};
        pg8::gemm_phase<EpiRouter, SchedDense, false>(F.lds, D, S, E);
        if (F.G != 256) { } else if (LAYER == 0) { if ((int)blockIdx.x >= 144) cvt_moe_range(F, args, 0, F0_BULK + F0_P2 + F0_P5, MOE_CVT_ITEMS, (int)blockIdx.x - 144, 112); }
        else { if ((int)blockIdx.x >= 128) cvt_moe_range(F, args, 1, MOE_CVT_ITEMS - F1_P16, MOE_CVT_ITEMS, (int)blockIdx.x - 128, 128); }
    }
    SEAM(mb);
    if (IN(mb + 1)) REPEAT_IF(mb + 1) { REP_BAR(); moe_place(F, LAYER, ntok); }
    SEAM(mb + 1);
    if (IN(mb + 2)) REPEAT_IF(mb + 2) { REP_BAR();
        const int nj = moe_units_setup<2>(F, LAYER, ntok, F.vcu, true);
        SchedMoeGU S{(const char*)Hb, (const char*)(ws + WS_WGU + (size_t)LAYER * WGU_BYTES), (const LAS int*)(F.lds + AUX_TILEE), (const LAS int*)(F.lds + AUX_IDX), nj, F.G, F.vcu};
        EpiGateUp E{(bf16_t*)(ws + M_HID)};
        pg8::gemm_phase<EpiGateUp, SchedMoeGU, true>(F.lds, D, S, E);
        if (LAYER == 0) { const int ntr0 = ((const LAS int*)(F.lds + AUX_TST))[256]; int s9, s10; fill1_ranges(F, ntr0, s9, s10); const int nu = (ntr0 + NT / 256) * 2, hv = nu % F.G;
            if (hv && F.vcu >= hv) cvt_moe_range(F, args, 1, 0, s9, F.vcu - hv, F.G - hv); }
    }
    SEAM(mb + 2);
    if (IN(mb + 3)) REPEAT_IF(mb + 3) { REP_BAR();
        const int nj = moe_units_setup<4>(F, LAYER, ntok, F.vcu, false);
        SchedMoeDN S{(const char*)(ws + M_HID), (const char*)(ws + WS_WDN + (size_t)LAYER * WDN_BYTES), (const LAS int*)(F.lds + AUX_TILEE), nj, F.G, F.vcu};
        EpiF8 E{(unsigned char*)(ws + M_OUT)};
        pg8::gemm_phase<EpiF8, SchedMoeDN, true>(F.lds, DEXP, S, E);
        if (LAYER == 0) { const int ntr0 = ((const LAS int*)(F.lds + AUX_TST))[256]; int s9, s10; fill1_ranges(F, ntr0, s9, s10); const int nu = (ntr0 + NT / 256) * 4, hv = nu % F.G;
            if (hv && F.vcu >= hv) cvt_moe_range(F, args, 1, s9, s9 + s10, F.vcu - hv, F.G - hv); }
    }
    SEAM(mb + 3);
    if (IN(mb + 4)) REPEAT_IF(mb + 4) { REP_BAR();
        RowPhase P{}; P.xin_lat = xw; P.xin_ctx = xw + (size_t)NX * D; P.xout_lat = LAYER ? args.out : xw; P.xout_ctx = xw + (size_t)NX * D; P.nrows = ntok; P.ysrc = 2;
        P.mo8 = (const unsigned char*)(ws + M_OUT); P.tslot = (const int*)(ws + M_TS); P.tgate = (const float*)(ws + M_AG); P.sharedbase = (int)__hip_atomic_load(F.ctl + CW_TST + LAYER * 320 + 256, __ATOMIC_RELAXED, __HIP_MEMORY_SCOPE_AGENT) * 256;
        P.gpost = args.in[9] + LAYER * D; P.modx = lmodx; P.modc = lmodc; P.gate_chunk = 5;
        P.doH = LAYER == 0; P.H = Hb; P.gpre = args.in[6] + D; P.sc_chunk = 1; P.sh_chunk = 0; P.modxH = modx + (size_t)16 * ADA; P.modcH = modc + ADA;
        row_phase(F, P);
        if (LAYER == 0) {
            const int ntr0 = (int)__hip_atomic_load(F.ctl + CW_TST + 256, __ATOMIC_RELAXED, __HIP_MEMORY_SCOPE_AGENT); int s9, s10; fill1_ranges(F, ntr0, s9, s10);
            cvt_moe_range(F, args, 1, s9 + s10, F.G == 256 ? MOE_CVT_ITEMS - F1_P12 - F1_P16 : MOE_CVT_ITEMS, F.vcu, F.G);
        }
    }
    SEAM(mb + 4);
}

__global__ void __launch_bounds__(NTHREADS, 2) mk_fwd(Args args) {
    extern __shared__ __attribute__((aligned(16))) unsigned char lds_raw[];
    Frame F;
    F.lds = (LAS unsigned char*)lds_raw; F.MISC = (volatile LAS unsigned*)(F.lds + MISC_OFF);
    F.tid = threadIdx.x; F.lane = F.tid & 63; F.wave = __builtin_amdgcn_readfirstlane(F.tid >> 6);
    F.G = gridDim.x; { const int bx = blockIdx.x; F.vcu = (F.G % 8 == 0) ? (bx % 8) * (F.G / 8) + bx / 8 : bx; }
    F.ws = args.ws; F.ctl = (unsigned*)(args.ws + WS_CTL);
    for (int u = F.tid; u < (LDS_BYTES - MISC_OFF) / 4; u += NTHREADS) ((LAS unsigned*)(F.lds + MISC_OFF))[u] = 0u;
    __syncthreads();
    XcdBarrier bar; bar.bar = F.ctl + CW_BAR; bar.x = 0; bar.st = nullptr;
#if MK_ONE_LAUNCH
    bar = xcd_barrier_post(F.ctl + CW_BAR, F.MISC + 8);
#endif
    const int lo = args.ph_lo, hi = args.ph_hi;
    unsigned char* ws = args.ws;
    const float* modx = (const float*)(ws + WS_MODX); const float* modc = (const float*)(ws + WS_MODC);
    float* xw = (float*)(ws + WS_XW); bf16_t* Hb = (bf16_t*)(ws + WS_H);

    if (IN(0)) REPEAT_IF(0) { REP_BAR(); p0_ada(F, args); p0_convert(F, args); }
    SEAM(0);
    {
        if (IN(1)) REPEAT_IF(1) { REP_BAR();
            RowPhase P{}; P.xin_lat = args.in[0]; P.xin_ctx = args.in[2]; P.nrows = NT; P.ysrc = 0; P.modx = modx; P.modc = modc;
            P.doH = true; P.H = Hb; P.gpre = args.in[6]; P.sc_chunk = 1; P.sh_chunk = 0; P.modxH = modx; P.modcH = modc;
            row_phase(F, P);
        }
        SEAM(1);
        if (IN(2)) REPEAT_IF(2) { REP_BAR();
            SchedDense S{(const char*)Hb, (const char*)(ws + WS_WIN0), D, NT / 256, AB_INP / 256, 0, 1, 0, F.G, (int)blockIdx.x};
            EpiInproj E{(bf16_t*)(ws + T_QB), (bf16_t*)(ws + T_KB), (bf16_t*)(ws + T_VB), (bf16_t*)(ws + T_GB), (bf16_t*)(ws + T_UB), (float*)(ws + T_LR), (const f32x2*)(ws + WS_ROPE)};
            pg8::gemm_phase<EpiInproj, SchedDense, true>(F.lds, D, S, E);
            if (F.G == 256 && (int)blockIdx.x >= 48) cvt_moe_range(F, args, 0, F0_BULK, F0_BULK + F0_P2, (int)blockIdx.x - 48, 208);
        }
        SEAM(2);
        if (IN(3)) REPEAT_IF(3) { REP_BAR(); gla_prep_phase(F, args); }
        if (IN(3) && IN(22)) GRID_BAR();
        if (IN(22)) REPEAT_IF(22) { REP_BAR(); gla_seq_phase(F, args); }
        if (IN(22) && IN(4)) GRID_BAR();
        if (IN(4)) REPEAT_IF(4) { REP_BAR(); finish_conv_phase(F, args); }
        SEAM(4);

    }
    layer_tail<0>(F, args, lo, hi, bar);
    {
        if (IN(12)) REPEAT_IF(12) { REP_BAR();
            SchedDense S{(const char*)Hb, (const char*)(ws + WS_WQKV1), D, NX / 256, 12, NC / 256, 8, 4, F.G, (int)blockIdx.x};
            EpiBf16 E{(bf16_t*)(ws + T_QKV), D, D, (size_t)NT * D, 0.125f * 1.4426950408889634f};
            pg8::gemm_phase<EpiBf16, SchedDense, true>(F.lds, D, S, E);
            if (F.G == 256 && (int)blockIdx.x >= 128) cvt_moe_range(F, args, 1, MOE_CVT_ITEMS - F1_P16 - F1_P12, MOE_CVT_ITEMS - F1_P16, (int)blockIdx.x - 128, 128);
        }
        SEAM(12);
        if (IN(13)) REPEAT_IF(13) { REP_BAR(); na_phase(F, args); }
        SEAM(13);

    }
    layer_tail<1>(F, args, lo, hi, bar);

#undef IN
#undef SEAM
}

extern "C" void kernel_launch(void* const* d_in, const int* in_sizes, int n_in, void* d_out, int out_size, void* d_ws, size_t ws_size, hipStream_t stream) {
    static int grid = 0;
    if (grid == 0) {
        if (n_in != 32 || out_size != NX * D || ws_size < WS_END) { fprintf(stderr, "kernel_launch: unexpected problem (n_in %d, out %d, ws %zu < %zu)\n", n_in, out_size, ws_size, (size_t)WS_END); grid = -1; return; }
        int dev = 0, cus = 0, per_cu = 0;
        if (hipGetDevice(&dev) != hipSuccess || hipDeviceGetAttribute(&cus, hipDeviceAttributeMultiprocessorCount, dev) != hipSuccess) { grid = -1; return; }
        if (hipFuncSetAttribute((const void*)mk_fwd, hipFuncAttributeMaxDynamicSharedMemorySize, LDS_BYTES) != hipSuccess) { fprintf(stderr, "kernel_launch: hipFuncSetAttribute failed\n"); grid = -1; return; }
        if (hipOccupancyMaxActiveBlocksPerMultiprocessor(&per_cu, (const void*)mk_fwd, NTHREADS, LDS_BYTES) != hipSuccess || per_cu < 1) fprintf(stderr, "kernel_launch: occupancy query says %d\n", per_cu);
        (void)hipGetLastError();
        grid = cus;
    }
    if (grid < 0) return;
    (void)hipMemsetAsync((char*)d_ws + WS_CTL, 0, CTL_BYTES, stream);
    Args a{};
    for (int i = 0; i < 32; ++i) a.in[i] = (const float*)d_in[i];
    a.out = (float*)d_out; a.ws = (unsigned char*)d_ws;
#if MK_ONE_LAUNCH
    a.ph_lo = 0; a.ph_hi = 64;
    hipLaunchKernelGGL(mk_fwd, dim3(grid), dim3(NTHREADS), LDS_BYTES, stream, a);
#else
    for (int p = 0; p <= 20; ++p) { if (p > MK_LAST_PHASE) break; a.ph_lo = p; a.ph_hi = p + 1; hipLaunchKernelGGL(mk_fwd, dim3(grid), dim3(NTHREADS), LDS_BYTES, stream, a); }
#endif
}
```

```cpp
#include <hip/hip_runtime.h>
#include <cstdio>
#include <cstdint>

#ifndef MK_ONE_LAUNCH
#define MK_ONE_LAUNCH 1
#endif
#ifndef MK_LAST_PHASE
#define MK_LAST_PHASE 99
#endif

#ifndef MK_REP
#define MK_REP (-1)
#endif
#define REPEAT_IF(k) _Pragma("unroll") for (int _r = 0; _r < ((k) == MK_REP ? 2 : 1); ++_r)
#define REP_BAR() do { if (_r) GRID_BAR(); } while (0)

#define GAS __attribute__((address_space(1)))
#define LAS __attribute__((address_space(3)))
typedef unsigned short bf16_t;
typedef short bf16x8 __attribute__((ext_vector_type(8)));
typedef float f32x4 __attribute__((ext_vector_type(4)));
typedef float f32x2 __attribute__((ext_vector_type(2)));
typedef unsigned u32x4 __attribute__((ext_vector_type(4)));
typedef unsigned u32x2 __attribute__((ext_vector_type(2)));

constexpr int D = 1024, BATCH = 16, SEQ = 2048, CTXL = 256, GRIDW = 64;
constexpr int NX = BATCH * SEQ, NC = BATCH * CTXL, NT = NX + NC;
constexpr int ADA = 6 * D;
constexpr int GLA_H = 4, GLA_DK = 64, GLA_DV = 128, GLA_QK = 256, GLA_V = 512, CONV_CH = 512, CONV_W = 31;
constexpr int AB_IN = 2592, AB_INP = 2816;
constexpr int NA_H = 16, NA_DH = 64;
constexpr int NEXP = 256, TOPK = 8, DEXP = 256;
constexpr int NEXPS = NEXP + 1;
constexpr int PMAX = NT * TOPK + NEXP * 255 + NT;
static_assert(PMAX % 256 == 0, "PMAX");
constexpr float RMS_EPS = 1e-6f, LN_EPS = 1e-5f;
constexpr float F8_SCALE = 16.0f, F8_INV = 1.0f / 16.0f;

constexpr size_t MiB = 1u << 20;
constexpr size_t al(size_t x) { return (x + 4095) & ~(size_t)4095; }
constexpr size_t WS_CTL = 0, CTL_BYTES = 1 * MiB;
constexpr size_t WS_MODX = WS_CTL + CTL_BYTES;
constexpr size_t WS_MODC = WS_MODX + al((size_t)2 * 16 * ADA * 4);
constexpr size_t WS_ROPE = WS_MODC + al((size_t)2 * ADA * 4);
constexpr size_t WS_XW = WS_ROPE + al(64 * 16 * 8);
constexpr size_t WS_H = WS_XW + al((size_t)NT * D * 4);
constexpr size_t WS_WIN0 = WS_H + al((size_t)NT * D * 2);
constexpr size_t WS_WOUT0 = WS_WIN0 + al((size_t)AB_INP * D * 2);
constexpr size_t WS_WQKV1 = WS_WOUT0 + al((size_t)D * D * 2);
constexpr size_t WS_WOUT1 = WS_WQKV1 + al((size_t)3 * D * D * 2);
constexpr size_t WS_WR = WS_WOUT1 + al((size_t)D * D * 2);
constexpr size_t WGU_BYTES = al((size_t)NEXPS * 512 * D * 2), WDN_BYTES = al((size_t)NEXPS * D * 256 * 2);
constexpr size_t WS_WGU = WS_WR + al((size_t)2 * NEXP * D * 2);
constexpr size_t WS_WDN = WS_WGU + 2 * WGU_BYTES;
constexpr size_t WS_T = WS_WDN + 2 * WDN_BYTES;
constexpr size_t T_QB = WS_T;
constexpr size_t T_KB = T_QB + al((size_t)NT * 256 * 2);
constexpr size_t T_VB = T_KB + al((size_t)NT * 256 * 2);
constexpr size_t T_GB = T_VB + al((size_t)NT * 512 * 2);
constexpr size_t T_UB = T_GB + al((size_t)NT * 512 * 2);
constexpr size_t T_LR = T_UB + al((size_t)NT * 512 * 2);
constexpr size_t T_OF = T_LR + al((size_t)NT * 32 * 4);
constexpr size_t T_OB = T_OF + al((size_t)NT * 512 * 2);
constexpr size_t T_CAT = T_OB + al((size_t)NT * 512 * 2);
constexpr size_t T_Y = T_CAT + al((size_t)NT * D * 2);
constexpr size_t T_GLA = T_Y + al((size_t)NT * D * 2);
constexpr int GI_A = 0, GI_QIN = 8192, GI_KOT = 16384, GI_VT = 24576, GI_DEC = 40960, GI_BYTES = 41216;
constexpr size_t T_END0 = T_GLA + al((size_t)BATCH * GLA_H * 2 * 36 * GI_BYTES + 1024);
constexpr size_t T_QKV = WS_T;
static_assert(T_QKV + (size_t)3 * NT * D * 2 <= T_CAT, "qkv overlay");
constexpr size_t M_AE = WS_T;
constexpr size_t M_AR = M_AE + al((size_t)NT * 8 * 4);
constexpr size_t M_AG = M_AR + al((size_t)NT * 8 * 4);
constexpr size_t M_TS = M_AG + al((size_t)NT * 8 * 4);
constexpr size_t M_ST = M_TS + al((size_t)NT * 8 * 4);
constexpr size_t M_HID = M_ST + al((size_t)PMAX * 4);
constexpr size_t M_OUT = M_HID + al((size_t)PMAX * 256 * 2);
constexpr int MO_LD = 1024;
constexpr size_t M_END = M_OUT + al((size_t)PMAX * D);
constexpr size_t WS_END = (M_END > T_END0 ? M_END : T_END0);
static_assert(WS_END <= (size_t)2040 * MiB, "workspace map must fit 2 GiB");

constexpr int CW_BAR = 4096;
constexpr int CW_CNT = 16384;
constexpr int CW_CUR = 16384 + 512;

constexpr int RING_BYTES = 131072;
constexpr int AUX_OFF = RING_BYTES, AUX_BYTES = 31744;
constexpr int MISC_OFF = AUX_OFF + AUX_BYTES;
constexpr int LDS_BYTES = MISC_OFF + 1024;
constexpr int NWAVES = 8, NTHREADS = 512;

#define LDS_WAIT() asm volatile("s_waitcnt lgkmcnt(0)" ::: "memory")
#define VM_WAIT() asm volatile("s_waitcnt vmcnt(0)" ::: "memory")

__device__ __forceinline__ unsigned f2bf(float f) { unsigned u = __builtin_bit_cast(unsigned, f); return (u + 0x7fffu + ((u >> 16) & 1u)) >> 16; }
__device__ __forceinline__ unsigned pk2(float lo, float hi) { return f2bf(lo) | (f2bf(hi) << 16); }
__device__ __forceinline__ float bf2f(unsigned short b) { return __builtin_bit_cast(float, (unsigned)b << 16); }
__device__ __forceinline__ float bflo(unsigned w) { return __builtin_bit_cast(float, w << 16); }
__device__ __forceinline__ float bfhi(unsigned w) { return __builtin_bit_cast(float, w & 0xffff0000u); }
__device__ __forceinline__ float wave_sum(float v) {
#pragma unroll
    for (int o = 1; o < 64; o <<= 1) v += __shfl_xor(v, o);
    return v;
}
__device__ __forceinline__ float sigmoidf_(float x) { return 1.0f / (1.0f + __expf(-x)); }
__device__ __forceinline__ float siluf_(float x) { return x / (1.0f + __expf(-x)); }

__device__ __forceinline__ void lds_barrier() { asm volatile("s_waitcnt lgkmcnt(0)" ::: "memory"); __builtin_amdgcn_s_barrier(); asm volatile("" ::: "memory"); }
#define XB_TMO      128
#define XB_XCNT(j)  (256  + 64 * (j))
#define XB_XSUB(j)  (1280 + 64 * (j))
#define XB_XGEN(j)  (2304 + 64 * (j))
#define XB_TOP      3328
#define XB_TOPGEN   3392
#define XCD_BAR_WORDS 3456
#define XB_SPIN_CAP (1u << 18)

__device__ __forceinline__ unsigned xb_ld(unsigned* p)              { return __hip_atomic_load(p, __ATOMIC_RELAXED, __HIP_MEMORY_SCOPE_AGENT); }
__device__ __forceinline__ unsigned xb_add(unsigned* p, unsigned v) { return __hip_atomic_fetch_add(p, v, __ATOMIC_RELAXED, __HIP_MEMORY_SCOPE_AGENT); }
__device__ __forceinline__ unsigned xb_xcc_id() { return (unsigned)__builtin_amdgcn_s_getreg((3 << 11) | 20) & 0xFu; }
#define XB_SPIN(cond, bar) do { unsigned _sp = 0; while (cond) { __builtin_amdgcn_s_sleep(1); \
    if ((++_sp & 255u) == 0u) { if (xb_ld(&(bar)[XB_TMO])) break; if (_sp > XB_SPIN_CAP) { atomicAdd(&(bar)[XB_TMO], 1u); break; } } } } while (0)

struct XcdBarrier { unsigned* bar; unsigned x; volatile LAS unsigned* st; };

__device__ __forceinline__ XcdBarrier xcd_barrier_post(unsigned* bar, volatile LAS unsigned* st) {
    XcdBarrier b; b.bar = bar; b.x = xb_xcc_id(); b.st = st;
    if (threadIdx.x == 0) (void)xb_add(&bar[XB_XCNT(b.x)], 1u);
    return b;
}
__device__ __forceinline__ void xcd_barrier_complete(unsigned* bar, unsigned x, unsigned& nloc, unsigned& nx) {
    const unsigned G = gridDim.x * gridDim.y * gridDim.z;
    unsigned sum, cnt, mine, sp = 0u;
    for (;;) {
        sum = 0u; cnt = 0u; mine = 0u;
#pragma unroll
        for (unsigned j = 0; j < 16; ++j) { const unsigned c = xb_ld(&bar[XB_XCNT(j)]); sum += c; cnt += (c > 0u) ? 1u : 0u; mine = (j == x) ? c : mine; }
        if (sum == G) break;
        __builtin_amdgcn_s_sleep(1);
        if ((++sp & 255u) == 0u) { if (xb_ld(&bar[XB_TMO])) break; if (sp > XB_SPIN_CAP) { atomicAdd(&bar[XB_TMO], 1u); break; } }
    }
    nloc = mine > 0u ? mine : 1u; nx = cnt > 0u ? cnt : 1u;
}
__device__ __forceinline__ void xcd_barrier(const XcdBarrier& b) {
    asm volatile("s_waitcnt vmcnt(0)" ::: "memory");
    __syncthreads();
    if (threadIdx.x == 0) {
        unsigned* bar = b.bar;
        __builtin_amdgcn_s_waitcnt(0);
        unsigned nloc = b.st[0], nx = b.st[1];
        if (nloc == 0u) { xcd_barrier_complete(bar, b.x, nloc, nx); b.st[0] = nloc; b.st[1] = nx; }
        const unsigned old = xb_add(&bar[XB_XSUB(b.x)], 1u);
        const unsigned gen = old / nloc;
        if (old + 1u == (gen + 1u) * nloc) {
            __builtin_amdgcn_fence(__ATOMIC_RELEASE, "agent");
            asm volatile("s_waitcnt vmcnt(0)" ::: "memory");
            const unsigned og = xb_add(&bar[XB_TOP], 1u);
            const unsigned tg = og / nx;
            if (og + 1u == (tg + 1u) * nx) xb_add(&bar[XB_TOPGEN], 1u);
            else XB_SPIN(xb_ld(&bar[XB_TOPGEN]) == tg, bar);
            __builtin_amdgcn_fence(__ATOMIC_ACQUIRE, "agent");
            xb_add(&bar[XB_XGEN(b.x)], 1u);
            asm volatile("s_waitcnt vmcnt(0)" ::: "memory");
        } else {
            XB_SPIN(xb_ld(&bar[XB_XGEN(b.x)]) == gen, bar);
            __builtin_amdgcn_fence(__ATOMIC_ACQUIRE, "agent");
            asm volatile("s_waitcnt vmcnt(0)" ::: "memory");
        }
    }
    __syncthreads();
}

namespace pg8 {
constexpr int BM = 256, BK = 64, HALF = 128, HTB = HALF * BK * 2, STAGE_BYTES = 8 * HTB, NXCD = 8, WGM = 8;
__host__ __device__ __forceinline__ int lds_byte(int r, int c) { const int st = (r >> 4) * 2 + (c >> 5), rr = r & 15, cc = c & 31, ob = rr * 64 + cc * 2; return st * 1024 + (ob ^ (((ob >> 9) & 1) << 5)); }
__host__ __device__ __forceinline__ void stage_rc(int b, int& R, int& C) { const int st = b / 1024, sb = b % 1024, swz = sb ^ (((sb >> 9) & 1) << 5); R = (st >> 1) * 16 + swz / 64; C = (st & 1) * 32 + (swz % 64) / 2; }
__host__ __device__ __forceinline__ int perm32(int rho) { const int n = rho >> 4, i = rho & 15; return 8 * (i >> 2) + 4 * n + (i & 3); }

struct Unit { int a, b, orow, ocol, aux; };

__device__ __forceinline__ bool static_order(int L, int nM, int nN, int& pm, int& pn) {
    const int nwg = nM * nN; if (L >= nwg) return false;
    int wgid = L; { const int q = nwg / NXCD, r = nwg % NXCD, xcd = wgid % NXCD, off = wgid / NXCD; wgid = (xcd < r ? xcd * (q + 1) : r * (q + 1) + (xcd - r) * q) + off; }
    const int nig = WGM * nN, gid = wgid / nig, fm = gid * WGM, gsz = (nM - fm) < WGM ? (nM - fm) : WGM;
    pm = fm + ((wgid % nig) % gsz); pn = (wgid % nig) / gsz; return true;
}

template <class Epi, class Sched, bool ALIGN_EPI>
__device__ __forceinline__ void gemm_phase(LAS unsigned char* lds, const int K, const Sched& S, const Epi& E) {
    const int tid = threadIdx.x, wid = __builtin_amdgcn_readfirstlane(tid >> 6), lane = tid & 63, wr = wid >> 2, wc = wid & 3, fr = lane & 15, fq = lane >> 4;
    const int nt = K / BK;
    int Rr[2], Cc[2]; unsigned voffB[2];
#pragma unroll
    for (int i = 0; i < 2; ++i) { int R, C; stage_rc(tid * 16 + i * 8192, R, C); Rr[i] = R; Cc[i] = C; const int Rb = Epi::PERM ? ((R & ~31) + perm32(R & 31)) : R; voffB[i] = (unsigned)(Rb * K + C) * 2u; }
    const size_t kstep = (size_t)(BK * 2);
    const size_t hstepB = (size_t)HALF * K * 2;
    const unsigned ldsw = (unsigned)wid * 1024u;
    const int aoff = lds_byte(wr * 64 + fr, fq * 8), boff = lds_byte(wc * 32 + fr, fq * 8);
#define PG8_SA(b, h) (((b) * 2 + (h)) * HTB)
#define PG8_SB(b, h) ((4 + (b) * 2 + (h)) * HTB)
#define PG8_STAGE(bufoff, gbase, voff) do { _Pragma("unroll") for (int _i = 0; _i < 2; ++_i) \
        __builtin_amdgcn_global_load_lds((const unsigned*)((const char*)(gbase) + (voff)[_i]), (LAS unsigned*)(lds + (bufoff) + ldsw + _i * 8192), 16, 0, 0); } while (0)
#define PG8_LDA(dst, b, h) do { _Pragma("unroll") for (int m = 0; m < 4; ++m) _Pragma("unroll") for (int k = 0; k < 2; ++k) dst[m][k] = *(const LAS bf16x8*)(lds + PG8_SA(b, h) + aoff + m * 2048 + k * 1024); } while (0)
#define PG8_LDB(dst, b, h) do { _Pragma("unroll") for (int n = 0; n < 2; ++n) _Pragma("unroll") for (int k = 0; k < 2; ++k) dst[n][k] = *(const LAS bf16x8*)(lds + PG8_SB(b, h) + boff + n * 2048 + k * 1024); } while (0)
#define PG8_MMA(ai, bj, At, Bt) do { __builtin_amdgcn_s_setprio(1); _Pragma("unroll") for (int m = 0; m < 4; ++m) _Pragma("unroll") for (int n = 0; n < 2; ++n) _Pragma("unroll") for (int k = 0; k < 2; ++k) \
        acc[ai][bj][m][n] = __builtin_amdgcn_mfma_f32_16x16x32_bf16(Bt[n][k], At[m][k], acc[ai][bj][m][n], 0, 0, 0); __builtin_amdgcn_s_setprio(0); } while (0)
#define PG8_WAIT_V(n) asm volatile("s_waitcnt vmcnt(" #n ")" ::: "memory")
#define PG8_WAIT_L(n) asm volatile("s_waitcnt lgkmcnt(" #n ")" ::: "memory")
#define PG8_BAR __builtin_amdgcn_s_barrier()
#define PG8_SCHED __builtin_amdgcn_sched_barrier(0)
    Unit cur, nxt; int ui = 0;
    if (!S.next(0, cur)) return;
    f32x4 acc[2][2][4][2];
#pragma unroll
    for (int a = 0; a < 2; ++a)
#pragma unroll
        for (int b = 0; b < 2; ++b)
#pragma unroll
            for (int m = 0; m < 4; ++m)
#pragma unroll
                for (int n = 0; n < 2; ++n) acc[a][b][m][n] = (f32x4){0.f, 0.f, 0.f, 0.f};
    bf16x8 At[4][2], B0[2][2], B1[2][2];
    unsigned co0[2], co1[2], no0[2], no1[2];
    S.a_off(cur, Rr, Cc, co0, co1);
    const char* const Ab = S.a_base();
    const char* cB = S.b_ptr(cur);
    PG8_STAGE(PG8_SB(0, 0), cB, voffB); PG8_STAGE(PG8_SB(0, 1), cB + hstepB, voffB); PG8_STAGE(PG8_SA(0, 0), Ab, co0); PG8_STAGE(PG8_SA(0, 1), Ab, co1);
    if (wr == 1) PG8_BAR;
    PG8_WAIT_V(2); PG8_BAR;
    PG8_STAGE(PG8_SB(1, 0), cB + kstep, voffB); PG8_STAGE(PG8_SA(1, 0), Ab + kstep, co0); PG8_STAGE(PG8_SB(1, 1), cB + hstepB + kstep, voffB);
    PG8_WAIT_V(6); PG8_BAR;
    for (;;) {
        const bool has_next = S.next(ui + 1, nxt);
        const char* nB = has_next ? S.b_ptr(nxt) : cB;
#pragma nounroll
        for (int t = 0; t < nt; t += 2) {
            const bool last = (t == nt - 2);
            if (last) { if (has_next) S.a_off(nxt, Rr, Cc, no0, no1); else { no0[0] = co0[0]; no0[1] = co0[1]; no1[0] = co1[0]; no1[1] = co1[1]; } }
            const char* a1 = Ab + (size_t)(t + 1) * kstep;
            const char* a2 = last ? Ab : Ab + (size_t)(t + 2) * kstep; const char* b2 = last ? nB : cB + (size_t)(t + 2) * kstep;
            const char* a3 = a2 + kstep; const char* b3 = b2 + kstep;
            unsigned x0[2], x1[2];
            x0[0] = last ? no0[0] : co0[0]; x0[1] = last ? no0[1] : co0[1]; x1[0] = last ? no1[0] : co1[0]; x1[1] = last ? no1[1] : co1[1];
            PG8_LDB(B0, 0, 0); PG8_LDB(B1, 0, 1); PG8_SCHED; PG8_LDA(At, 0, 0); PG8_STAGE(PG8_SA(1, 1), a1, co1);
            PG8_WAIT_V(8); PG8_WAIT_L(0); PG8_BAR; PG8_MMA(0, 0, At, B0); PG8_MMA(0, 1, At, B1); PG8_BAR; PG8_SCHED;
            PG8_LDA(At, 0, 1); PG8_STAGE(PG8_SB(0, 0), b2, voffB); PG8_STAGE(PG8_SB(0, 1), b2 + hstepB, voffB); PG8_STAGE(PG8_SA(0, 0), a2, x0);
            PG8_WAIT_V(8); PG8_WAIT_L(0); PG8_BAR; PG8_MMA(1, 0, At, B0); PG8_MMA(1, 1, At, B1); PG8_BAR; PG8_SCHED;
            PG8_LDB(B0, 1, 0); PG8_LDB(B1, 1, 1); PG8_SCHED; PG8_LDA(At, 1, 0); PG8_STAGE(PG8_SA(0, 1), a2, x1);
            PG8_WAIT_V(8); PG8_WAIT_L(0); PG8_BAR; PG8_MMA(0, 0, At, B0); PG8_MMA(0, 1, At, B1); PG8_BAR; PG8_SCHED;
            PG8_LDA(At, 1, 1); PG8_STAGE(PG8_SB(1, 0), b3, voffB); PG8_STAGE(PG8_SB(1, 1), b3 + hstepB, voffB); PG8_STAGE(PG8_SA(1, 0), a3, x0);
            PG8_WAIT_V(8); PG8_WAIT_L(0); PG8_BAR; PG8_MMA(1, 0, At, B0); PG8_MMA(1, 1, At, B1); PG8_BAR; PG8_SCHED;
        }
        if constexpr (ALIGN_EPI) { if (wr == 0) PG8_BAR; }
        if constexpr (!Epi::AFTER_DRAIN) { E(acc, cur, wr, wc, fr, fq); }
        if (!has_next) break;
#pragma unroll
        for (int a = 0; a < 2; ++a)
#pragma unroll
            for (int b = 0; b < 2; ++b)
#pragma unroll
                for (int m = 0; m < 4; ++m)
#pragma unroll
                    for (int n = 0; n < 2; ++n) acc[a][b][m][n] = (f32x4){0.f, 0.f, 0.f, 0.f};
        cur = nxt; cB = nB; co0[0] = no0[0]; co0[1] = no0[1]; co1[0] = no1[0]; co1[1] = no1[1]; ++ui;
        if constexpr (ALIGN_EPI) { if (wr == 1) PG8_BAR; }
    }
    PG8_WAIT_V(0);
    if constexpr (!ALIGN_EPI) { if (wr == 0) PG8_BAR; }
    PG8_BAR;
    if constexpr (Epi::AFTER_DRAIN) { E.fused(acc, cur, wr, wc, fr, fq, lds, wid, lane); }
#undef PG8_SA
#undef PG8_SB
#undef PG8_STAGE
#undef PG8_LDA
#undef PG8_LDB
#undef PG8_MMA
#undef PG8_WAIT_V
#undef PG8_WAIT_L
#undef PG8_BAR
#undef PG8_SCHED
}
}
using pg8::Unit;

__device__ __forceinline__ unsigned cvt_pk_bf16(float lo, float hi) { unsigned r; asm volatile("v_cvt_pk_bf16_f32 %0, %1, %2" : "=v"(r) : "v"(lo), "v"(hi)); return r; }

struct SchedDense {
    const char* A; const char* Bt; int K; int nM0, nN0, nM1, nN1, pn1off; int G, c;
    __device__ __forceinline__ bool next(int i, Unit& u) const {
        const int L = i * G + c; int pm, pn;
        const int n0 = nM0 * nN0;
        if (L < n0) { pg8::static_order(L, nM0, nN0, pm, pn); }
        else { if (!pg8::static_order(L - n0, nM1, nN1, pm, pn)) return false; pm += nM0; pn += pn1off; }
        u.a = pm; u.b = pn * 256; u.orow = pm * 256; u.ocol = pn * 256; u.aux = pn; return true;
    }
    __device__ __forceinline__ const char* a_base() const { return A; }
    __device__ __forceinline__ const char* b_ptr(const Unit& u) const { return Bt + (size_t)u.b * K * 2; }
    __device__ __forceinline__ void a_off(const Unit& u, const int (&R)[2], const int (&C)[2], unsigned (&o0)[2], unsigned (&o1)[2]) const {
#pragma unroll
        for (int i = 0; i < 2; ++i) { o0[i] = (unsigned)((u.a * 256 + R[i]) * K + C[i]) * 2u; o1[i] = o0[i] + (unsigned)(128 * K * 2); }
    }
};

struct EpiBf16 {
    static constexpr bool PERM = true, AFTER_DRAIN = false;
    bf16_t* O; int ldc; int split_cols; size_t split_stride; float scale0 = 1.0f;
    __device__ __forceinline__ void operator()(const f32x4 (&acc)[2][2][4][2], const Unit& u, int wr, int wc, int fr, int fq) const {
        const int lane = fr + 16 * fq; const int srcb = ((lane >> 2) + 16 * (lane & 3)) << 2;
        const int row0 = u.orow + wr * 64 + (lane >> 2); int colt = u.ocol; bf16_t* base = O;
        float sc = 1.0f;
        if (split_cols) { const int t = colt / split_cols; base += (size_t)t * split_stride; colt -= t * split_cols; if (t == 0) sc = scale0; }
        const int col0 = colt + wc * 32 + 8 * (lane & 3);
#pragma unroll
        for (int ai = 0; ai < 2; ++ai)
#pragma unroll
            for (int m = 0; m < 4; ++m) { bf16_t* rowp = base + (size_t)(row0 + ai * 128 + m * 16) * ldc + col0;
#pragma unroll
                for (int bj = 0; bj < 2; ++bj) { const f32x4 v0 = acc[ai][bj][m][0] * sc, v1 = acc[ai][bj][m][1] * sc;
                    u32x4 w; w.x = cvt_pk_bf16(v0[0], v0[1]); w.y = cvt_pk_bf16(v0[2], v0[3]); w.z = cvt_pk_bf16(v1[0], v1[1]); w.w = cvt_pk_bf16(v1[2], v1[3]);
                    u32x4 t; t.x = (unsigned)__builtin_amdgcn_ds_bpermute(srcb, (int)w.x); t.y = (unsigned)__builtin_amdgcn_ds_bpermute(srcb, (int)w.y); t.z = (unsigned)__builtin_amdgcn_ds_bpermute(srcb, (int)w.z); t.w = (unsigned)__builtin_amdgcn_ds_bpermute(srcb, (int)w.w);
                    *(u32x4*)(rowp + bj * 128) = t; } }
    }
};
struct EpiF8 {
    static constexpr bool PERM = true, AFTER_DRAIN = false;
    unsigned char* O;
    __device__ __forceinline__ int nst(const Unit&, int) const { return 16; }
    __device__ __forceinline__ void operator()(const f32x4 (&acc)[2][2][4][2], const Unit& u, int wr, int wc, int fr, int fq) const {
        const int lane = fr + 16 * fq; const int srcb = ((lane >> 2) + 16 * (lane & 3)) << 2;
        const int row0 = u.orow + wr * 64 + (lane >> 2), col0 = u.ocol + wc * 32 + 8 * (lane & 3);
#pragma unroll
        for (int ai = 0; ai < 2; ++ai)
#pragma unroll
            for (int m = 0; m < 4; ++m) { unsigned char* rowp = O + (size_t)(row0 + ai * 128 + m * 16) * D + col0;
#pragma unroll
                for (int bj = 0; bj < 2; ++bj) { const f32x4 v0 = acc[ai][bj][m][0] * F8_SCALE, v1 = acc[ai][bj][m][1] * F8_SCALE;
                    int w0 = __builtin_amdgcn_cvt_pk_fp8_f32(v0[0], v0[1], 0, false); w0 = __builtin_amdgcn_cvt_pk_fp8_f32(v0[2], v0[3], w0, true);
                    int w1 = __builtin_amdgcn_cvt_pk_fp8_f32(v1[0], v1[1], 0, false); w1 = __builtin_amdgcn_cvt_pk_fp8_f32(v1[2], v1[3], w1, true);
                    u32x2 t; t.x = (unsigned)__builtin_amdgcn_ds_bpermute(srcb, w0); t.y = (unsigned)__builtin_amdgcn_ds_bpermute(srcb, w1);
                    *(u32x2*)(rowp + bj * 128) = t; } }
    }
};
template <int MODE> struct EpiBf16X {
    static constexpr bool PERM = true, AFTER_DRAIN = false;
    bf16_t* O; int ldc;
    __device__ __forceinline__ void operator()(const f32x4 (&acc)[2][2][4][2], const Unit& u, int wr, int wc, int fr, int fq) const {
        const int lane = fr + 16 * fq; const int srcb = ((lane >> 2) + 16 * (lane & 3)) << 2;
        const int row0 = u.orow + wr * 64 + (lane >> 2); const int col0 = u.ocol + wc * 32 + 8 * (lane & 3);
#pragma unroll
        for (int ai = 0; ai < 2; ++ai)
#pragma unroll
            for (int m = 0; m < 4; ++m) { bf16_t* rowp = O + (size_t)(row0 + ai * 128 + m * 16) * ldc + col0;
#pragma unroll
                for (int bj = 0; bj < 2; ++bj) { const f32x4 v0 = acc[ai][bj][m][0], v1 = acc[ai][bj][m][1];
                    u32x4 w; w.x = cvt_pk_bf16(v0[0], v0[1]); w.y = cvt_pk_bf16(v0[2], v0[3]); w.z = cvt_pk_bf16(v1[0], v1[1]); w.w = cvt_pk_bf16(v1[2], v1[3]);
                    u32x4 t; t.x = (unsigned)__builtin_amdgcn_ds_bpermute(srcb, (int)w.x); t.y = (unsigned)__builtin_amdgcn_ds_bpermute(srcb, (int)w.y); t.z = (unsigned)__builtin_amdgcn_ds_bpermute(srcb, (int)w.z); t.w = (unsigned)__builtin_amdgcn_ds_bpermute(srcb, (int)w.w);
                    if (MODE == 1) { if (bj == 0) *(u32x4*)(rowp + bj * 128) = t; else asm volatile("" :: "v"(t)); }
                    if (MODE == 2) { bf16_t* p = O + (wr * 128 + ai * 64 + m * 16 + bj * 8 + wc * 2) * 256 + 8 * lane; *(u32x4*)p = t; }
                } }
    }
};
struct EpiNull {
    static constexpr bool PERM = true, AFTER_DRAIN = false;
    __device__ __forceinline__ void operator()(const f32x4 (&acc)[2][2][4][2], const Unit& u, int wr, int wc, int fr, int fq) const {
#pragma unroll
        for (int ai = 0; ai < 2; ++ai)
#pragma unroll
            for (int bj = 0; bj < 2; ++bj)
#pragma unroll
                for (int m = 0; m < 4; ++m)
#pragma unroll
                    for (int n = 0; n < 2; ++n) asm volatile("" :: "v"(acc[ai][bj][m][n]));
    }
};
struct EpiBf16NS {
    static constexpr bool PERM = true, AFTER_DRAIN = false;
    __device__ __forceinline__ void operator()(const f32x4 (&acc)[2][2][4][2], const Unit& u, int wr, int wc, int fr, int fq) const {
#pragma unroll
        for (int ai = 0; ai < 2; ++ai)
#pragma unroll
            for (int m = 0; m < 4; ++m) {
#pragma unroll
                for (int bj = 0; bj < 2; ++bj) { const f32x4 v0 = acc[ai][bj][m][0], v1 = acc[ai][bj][m][1];
                    u32x4 w; w.x = cvt_pk_bf16(v0[0], v0[1]); w.y = cvt_pk_bf16(v0[2], v0[3]); w.z = cvt_pk_bf16(v1[0], v1[1]); w.w = cvt_pk_bf16(v1[2], v1[3]);
                    asm volatile("" :: "v"(w)); } }
    }
};
struct EpiInproj {
    static constexpr bool PERM = false, AFTER_DRAIN = false;
    bf16_t *qb, *kb, *vb, *gb, *ub; float* lr; const f32x2* rope;
    __device__ __forceinline__ void operator()(const f32x4 (&acc)[2][2][4][2], const Unit& u, int wr, int wc, int fr, int fq) const {
        const int pn = u.aux; const int row0 = u.orow + wr * 64 + fr;
        if (pn <= 1) {
            bf16_t* dst = pn == 0 ? qb : kb; const float sc = pn == 0 ? 0.125f : 1.0f;
#pragma unroll
            for (int ai = 0; ai < 2; ++ai)
#pragma unroll
                for (int m = 0; m < 4; ++m) {
                    const int row = row0 + ai * 128 + m * 16; const bool lat = row < NX;
                    const int s = row & (SEQ - 1); const int pos = (wc & 1) ? (s & 63) : (s >> 6);
                    f32x2 cs[4];
                    if (lat) {
#pragma unroll
                        for (int e = 0; e < 4; ++e) cs[e] = rope[pos * 16 + 4 * fq + e];
                    } else {
#pragma unroll
                        for (int e = 0; e < 4; ++e) cs[e] = (f32x2){1.f, 0.f};
                    }
#pragma unroll
                    for (int bj = 0; bj < 2; ++bj) {
                        const f32x4 u1 = acc[ai][bj][m][0], u2 = acc[ai][bj][m][1]; f32x4 o1, o2;
#pragma unroll
                        for (int e = 0; e < 4; ++e) { o1[e] = (u1[e] * cs[e].x - u2[e] * cs[e].y) * sc; o2[e] = (u1[e] * cs[e].y + u2[e] * cs[e].x) * sc; }
                        bf16_t* p = dst + (size_t)row * 256 + bj * 128 + wc * 32 + 4 * fq;
                        u32x2 w1, w2; w1.x = cvt_pk_bf16(o1[0], o1[1]); w1.y = cvt_pk_bf16(o1[2], o1[3]); w2.x = cvt_pk_bf16(o2[0], o2[1]); w2.y = cvt_pk_bf16(o2[2], o2[3]);
                        *(u32x2*)p = w1; *(u32x2*)(p + 16) = w2;
                    }
                }
        } else if (pn <= 5) {
            bf16_t* dst = pn <= 3 ? vb : gb; const int cb = (pn & 1) ? 256 : 0;
#pragma unroll
            for (int ai = 0; ai < 2; ++ai)
#pragma unroll
                for (int m = 0; m < 4; ++m) { const int row = row0 + ai * 128 + m * 16;
#pragma unroll
                    for (int bj = 0; bj < 2; ++bj)
#pragma unroll
                        for (int n = 0; n < 2; ++n) { const f32x4 v = acc[ai][bj][m][n]; u32x2 w; w.x = cvt_pk_bf16(v[0], v[1]); w.y = cvt_pk_bf16(v[2], v[3]);
                            *(u32x2*)(dst + (size_t)row * 512 + cb + bj * 128 + wc * 32 + n * 16 + 4 * fq) = w; } }
        } else if (pn <= 9) {
            const int cb = (pn - 6) * 128;
#pragma unroll
            for (int ai = 0; ai < 2; ++ai)
#pragma unroll
                for (int m = 0; m < 4; ++m) { const int row = row0 + ai * 128 + m * 16;
#pragma unroll
                    for (int n = 0; n < 2; ++n) { const f32x4 a = acc[ai][0][m][n], b = acc[ai][1][m][n]; f32x4 o;
#pragma unroll
                        for (int e = 0; e < 4; ++e) o[e] = a[e] * sigmoidf_(b[e]);
                        u32x2 w; w.x = cvt_pk_bf16(o[0], o[1]); w.y = cvt_pk_bf16(o[2], o[3]);
                        *(u32x2*)(ub + (size_t)row * 512 + cb + wc * 32 + n * 16 + 4 * fq) = w; } }
        } else {
            if (wc == 0) {
#pragma unroll
                for (int ai = 0; ai < 2; ++ai)
#pragma unroll
                    for (int m = 0; m < 4; ++m) { const int row = row0 + ai * 128 + m * 16;
#pragma unroll
                        for (int n = 0; n < 2; ++n) *(f32x4*)(lr + (size_t)row * 32 + n * 16 + 4 * fq) = acc[ai][0][m][n]; }
            }
        }
    }
};

struct Args { const float* in[32]; float* out; unsigned char* ws; int ph_lo, ph_hi; };

struct Frame {
    LAS unsigned char* lds; volatile LAS unsigned* MISC; unsigned* ctl; unsigned char* ws;
    int tid, lane, wave, G, vcu;
};

__device__ __forceinline__ void cvt_item(const float* __restrict__ src, int ld, int col0, int ncols, int k0, bf16_t* dst, int ldd, int drow0, LAS unsigned* T, int lane) {
    const bool okc = lane < ncols;
    const float* p = src + (size_t)k0 * ld + col0 + (okc ? lane : 0);
    float v[64];
#pragma unroll
    for (int k = 0; k < 64; ++k) v[k] = __builtin_nontemporal_load(p + (size_t)k * ld);
#pragma unroll
    for (int kp = 0; kp < 32; ++kp) T[lane * 33 + kp] = okc ? pk2(v[2 * kp], v[2 * kp + 1]) : 0u;
    LDS_WAIT(); asm volatile("" ::: "memory");
    const int c = lane & 7;
#pragma unroll
    for (int it = 0; it < 8; ++it) { const int n = (lane >> 3) + 8 * it;
        u32x4 o; o.x = T[n * 33 + 4 * c]; o.y = T[n * 33 + 4 * c + 1]; o.z = T[n * 33 + 4 * c + 2]; o.w = T[n * 33 + 4 * c + 3];
        if (n < ncols) __builtin_nontemporal_store(o, (u32x4*)(dst + (size_t)(drow0 + n) * ldd + k0 + 8 * c)); }
    LDS_WAIT(); asm volatile("" ::: "memory");
}
__device__ __forceinline__ void cvt_matrix_item(const float* src, int ld, int col0, int ncols, int K, bf16_t* dst, int drow0, int item, LAS unsigned* T, int lane) {
    const int ncg = (ncols + 63) >> 6; const int kt = item / ncg, cg = item - kt * ncg;
    const int nc = ncols - cg * 64 < 64 ? ncols - cg * 64 : 64;
    cvt_item(src, ld, col0 + cg * 64, nc, kt * 64, dst, K, drow0 + cg * 64, T, lane);
}

constexpr int MOE_CVT_ITEMS = NEXPS * 192;
__device__ __forceinline__ void cvt_moe_item(const Args& a, int layer, int item, unsigned char* ws, LAS unsigned* T, int lane) {
    const int e = item / 192, r = item - e * 192;
    bf16_t* wgu = (bf16_t*)(ws + WS_WGU + (size_t)layer * WGU_BYTES) + (size_t)e * 512 * D; bf16_t* wdn = (bf16_t*)(ws + WS_WDN + (size_t)layer * WDN_BYTES) + (size_t)e * D * 256;
    if (r < 128) {
        const int kt = r >> 3, gi = r & 7; const int up = gi >> 2, g4 = gi & 3;
        const float* src = e < NEXP ? (up ? a.in[27] : a.in[26]) + ((size_t)layer * NEXP + e) * D * DEXP : (up ? a.in[30] : a.in[29]) + (size_t)layer * D * DEXP;
        cvt_item(src, DEXP, 64 * g4, 64, kt * 64, wgu, D, 256 * (g4 >> 1) + 64 * (g4 & 1) + 128 * up, T, lane);
    } else {
        const int q = r - 128; const int kt = q >> 4, cg = q & 15;
        const float* src = e < NEXP ? a.in[28] + ((size_t)layer * NEXP + e) * DEXP * D : a.in[31] + (size_t)layer * DEXP * D;
        cvt_item(src, D, 64 * cg, 64, kt * 64, wdn, DEXP, 64 * cg, T, lane);
    }
}

__device__ __forceinline__ float row_rms_scale(const f32x4 (&v)[4]) {
    float s = 0.f;
#pragma unroll
    for (int j = 0; j < 4; ++j) s += (v[j].x * v[j].x + v[j].y * v[j].y) + (v[j].z * v[j].z + v[j].w * v[j].w);
    return rsqrtf(wave_sum(s) * (1.0f / D) + RMS_EPS);
}
__device__ __forceinline__ f32x4 ld4(const float* p) { return *(const f32x4*)p; }

struct RowPhase {
    const float* xin_lat; const float* xin_ctx;
    float* xout_lat; float* xout_ctx;
    int nrows;
    int ysrc; const bf16_t* y;
    const unsigned char* mo8; const int* tslot; const float* tgate; int sharedbase;
    const float* gpost; const float* modx; const float* modc; int gate_chunk;
    bool doH; bf16_t* H; const float* gpre; int sc_chunk, sh_chunk; const float* modxH; const float* modcH;
};
__device__ __forceinline__ void row_phase(const Frame& F, const RowPhase& P) {
    const int gw = F.vcu * NWAVES + F.wave, NGW = F.G * NWAVES, lane = F.lane;
    for (int row = gw; row < P.nrows; row += NGW) {
        const bool lat = row < NX; const int b = lat ? (row >> 11) : 0;
        const float* mod = lat ? P.modx + (size_t)b * ADA : P.modc;
        const float* xr = lat ? P.xin_lat + (size_t)row * D : P.xin_ctx + (size_t)(row - NX) * D;
        f32x4 x[4];
#pragma unroll
        for (int j = 0; j < 4; ++j) x[j] = ld4(xr + 4 * lane + 256 * j);
        if (P.ysrc) {
            f32x4 y[4];
            if (P.ysrc == 1) {
#pragma unroll
                for (int j = 0; j < 4; ++j) { const u32x2 w = __builtin_nontemporal_load((const u32x2*)(P.y + (size_t)row * D + 4 * lane + 256 * j)); y[j] = (f32x4){bflo(w.x), bfhi(w.x), bflo(w.y), bfhi(w.y)}; }
            } else {
#pragma unroll
                for (int j = 0; j < 4; ++j) { const int w = __builtin_nontemporal_load((const int*)(P.mo8 + (size_t)(P.sharedbase + row) * D + 4 * lane + 256 * j)); const f32x2 lo = __builtin_amdgcn_cvt_pk_f32_fp8(w, false), hi = __builtin_amdgcn_cvt_pk_f32_fp8(w, true); y[j] = (f32x4){lo.x, lo.y, hi.x, hi.y} * F8_INV; }
#pragma unroll
                for (int k = 0; k < TOPK; ++k) { const int sl = P.tslot[(size_t)row * 8 + k]; const float g = P.tgate[(size_t)row * 8 + k] * F8_INV;
#pragma unroll
                    for (int j = 0; j < 4; ++j) { const int w = __builtin_nontemporal_load((const int*)(P.mo8 + (size_t)sl * D + 4 * lane + 256 * j)); const f32x2 lo = __builtin_amdgcn_cvt_pk_f32_fp8(w, false), hi = __builtin_amdgcn_cvt_pk_f32_fp8(w, true);
                        y[j].x += g * lo.x; y[j].y += g * lo.y; y[j].z += g * hi.x; y[j].w += g * hi.y; } }
            }
            const float rs = row_rms_scale(y);
#pragma unroll
            for (int j = 0; j < 4; ++j) { const f32x4 gp = ld4(P.gpost + 4 * lane + 256 * j), gt = ld4(mod + P.gate_chunk * D + 4 * lane + 256 * j); x[j] = x[j] + gt * (y[j] * rs * gp); }
            float* xo = lat ? P.xout_lat + (size_t)row * D : P.xout_ctx + (size_t)(row - NX) * D;
#pragma unroll
            for (int j = 0; j < 4; ++j) *(f32x4*)(xo + 4 * lane + 256 * j) = x[j];
        }
        if (P.doH) {
            const float rs = row_rms_scale(x); const float* modh = lat ? P.modxH + (size_t)b * ADA : P.modcH;
#pragma unroll
            for (int j = 0; j < 4; ++j) { const f32x4 gp = ld4(P.gpre + 4 * lane + 256 * j), sc = ld4(modh + P.sc_chunk * D + 4 * lane + 256 * j), sh = ld4(modh + P.sh_chunk * D + 4 * lane + 256 * j);
                const f32x4 h = x[j] * rs * gp * (sc + 1.0f) + sh; u32x2 w; w.x = pk2(h.x, h.y); w.y = pk2(h.z, h.w);
                *(u32x2*)(P.H + (size_t)row * D + 4 * lane + 256 * j) = w; }
        }
    }
}


constexpr int FILL_PER_WAVE_S = 3;
constexpr int F0_P2 = 208 * 8 * FILL_PER_WAVE_S, F0_P5 = 192 * 8 * FILL_PER_WAVE_S, F0_P7 = MOE_CVT_ITEMS - F0_P2 - F0_P5;
constexpr int F0_BULK = MOE_CVT_ITEMS - F0_P2 - F0_P5 - F0_P7;
static_assert(F0_BULK >= 0, "fill plan");
constexpr int F1_P12 = 128 * 8 * FILL_PER_WAVE_S;
__device__ __forceinline__ void cvt_moe_range(const Frame& F, const Args& a, int layer, int lo, int hi, int rank, int nranks) {
    LAS unsigned* T = (LAS unsigned*)F.lds + F.wave * (64 * 33);
    for (int it = lo + rank * NWAVES + F.wave; it < hi; it += nranks * NWAVES) cvt_moe_item(a, layer, it, F.ws, T, F.lane);
}
__device__ __forceinline__ void fill1_ranges(const Frame& F, int ntr0, int& s9, int& s10) {
    const int nu9 = (ntr0 + NT / 256) * 2, nu10 = (ntr0 + NT / 256) * 4;
    const int l9 = (nu9 % F.G) ? F.G - nu9 % F.G : 0, l10 = (nu10 % F.G) ? F.G - nu10 % F.G : 0;
    s9 = l9 * NWAVES * FILL_PER_WAVE_S; s10 = l10 * NWAVES * (FILL_PER_WAVE_S / 3);
    if (F.G != 256) { s9 = 0; s10 = 0; }
}

#ifndef MK_STAG
#define MK_STAG 0
#endif
__device__ __forceinline__ void stagger_delay(const Frame& F, int step) {
    if (step <= 0) return;
    const unsigned long long t0 = __builtin_amdgcn_s_memrealtime(); const unsigned long long d = (unsigned long long)((F.vcu & 7) * step);
    while (__builtin_amdgcn_s_memrealtime() - t0 < d) __builtin_amdgcn_s_sleep(4);
}
__device__ __forceinline__ void p0_ada(const Frame& F, const Args& a) {
    LAS float* sc = (LAS float*)F.lds;
    if ((int)blockIdx.x >= 96) return;
    for (int i = F.tid; i < 17 * D; i += NTHREADS) { const int r = i >> 10, k = i & 1023; const float v = r < 16 ? a.in[1][r * D + k] : a.in[3][k]; sc[i] = siluf_(v); }
    __syncthreads();
    const int item = blockIdx.x; const int layer = item / 48, cg = item % 48;
    const int cq = F.tid & 31, kl = F.tid >> 5;
    const float* W = a.in[4] + (size_t)layer * D * ADA + cg * 128 + cq * 4;
    f32x4 acc[17];
#pragma unroll
    for (int r = 0; r < 17; ++r) acc[r] = (f32x4){0.f, 0.f, 0.f, 0.f};
    for (int k = kl; k < D; k += 16) {
        const f32x4 w = ld4(W + (size_t)k * ADA);
#pragma unroll
        for (int r = 0; r < 17; ++r) { const float s = sc[r * D + k]; acc[r] = acc[r] + w * s; }
    }
#pragma unroll
    for (int r = 0; r < 17; ++r) { acc[r].x += __shfl_xor(acc[r].x, 32); acc[r].y += __shfl_xor(acc[r].y, 32); acc[r].z += __shfl_xor(acc[r].z, 32); acc[r].w += __shfl_xor(acc[r].w, 32); }
    __syncthreads();
    LAS f32x4* red = (LAS f32x4*)F.lds;
    if (F.lane < 32) {
#pragma unroll
        for (int r = 0; r < 17; ++r) red[(F.wave * 17 + r) * 32 + cq] = acc[r];
    }
    __syncthreads();
    for (int i = F.tid; i < 17 * 32; i += NTHREADS) { const int r = i >> 5, q = i & 31; f32x4 s = red[r * 32 + q];
#pragma unroll
        for (int w = 1; w < 8; ++w) s = s + red[(w * 17 + r) * 32 + q];
        const int col = cg * 128 + q * 4; s = s + ld4(a.in[5] + (size_t)layer * ADA + col);
        float* dst = r < 16 ? (float*)(F.ws + WS_MODX) + ((size_t)layer * 16 + r) * ADA + col : (float*)(F.ws + WS_MODC) + (size_t)layer * ADA + col;
        *(f32x4*)dst = s; }
    __syncthreads();
}

__device__ __forceinline__ void p0_convert(const Frame& F, const Args& a) {
    LAS unsigned* T = (LAS unsigned*)(F.lds + 70 * 1024) + F.wave * (64 * 33);
    const int gw = F.vcu * NWAVES + F.wave, NGW = F.G * NWAVES, lane = F.lane;
    bf16_t* win0 = (bf16_t*)(F.ws + WS_WIN0); bf16_t* wout0 = (bf16_t*)(F.ws + WS_WOUT0); bf16_t* wqkv1 = (bf16_t*)(F.ws + WS_WQKV1); bf16_t* wout1 = (bf16_t*)(F.ws + WS_WOUT1); bf16_t* wr = (bf16_t*)(F.ws + WS_WR);
    constexpr int I_IN = 16 * (4 + 4 + 8 + 8 + 1 + 16);
    constexpr int I_SQ = 16 * 16, I_QKV = 16 * 48, I_R = 16 * 4;
    constexpr int NIT = I_IN + I_SQ + I_QKV + I_SQ + 2 * I_R;
    const int nbulk0 = F.G == 256 ? F0_BULK : MOE_CVT_ITEMS;
    for (int it = gw; it < NIT + nbulk0; it += NGW) {
        int r = it;
        if (r < I_IN) {
            const int kt = r & 15, g = r >> 4; int col0, nc = 64, drow;
            if (g < 24) { col0 = 64 * g; drow = 64 * g; }
            else if (g == 24) { col0 = 1536; nc = 32; drow = 2560; }
            else { const int s = g - 25; const int isb = s >> 3, q = s & 7;
                col0 = 1568 + 512 * isb + 64 * q; drow = 1536 + 256 * (q >> 1) + 128 * isb + 64 * (q & 1); }
            cvt_item(a.in[10], AB_IN, col0, nc, kt * 64, win0, D, drow, T, lane); continue; }
        r -= I_IN;
        if (r < I_SQ) { cvt_matrix_item(a.in[11], D, 0, D, D, wout0, 0, r, T, lane); continue; } r -= I_SQ;
        if (r < I_QKV) { cvt_matrix_item(a.in[21], 3 * D, 0, 3 * D, D, wqkv1, 0, r, T, lane); continue; } r -= I_QKV;
        if (r < I_SQ) { cvt_matrix_item(a.in[22], D, 0, D, D, wout1, 0, r, T, lane); continue; } r -= I_SQ;
        if (r < 2 * I_R) { const int l = r / I_R; cvt_matrix_item(a.in[24] + (size_t)l * D * NEXP, NEXP, 0, NEXP, D, wr + (size_t)l * NEXP * D, 0, r % I_R, T, lane); continue; } r -= 2 * I_R;
        cvt_moe_item(a, 0, r, F.ws, T, lane);
    }
    { u32x4 z = (u32x4){0u, 0u, 0u, 0u}; const size_t n16 = (size_t)(AB_INP - AB_IN) * D * 2 / 16; u32x4* p = (u32x4*)(win0 + (size_t)AB_IN * D);
      for (size_t i = (size_t)blockIdx.x * NTHREADS + F.tid; i < n16; i += (size_t)F.G * NTHREADS) p[i] = z; }
    if (blockIdx.x == 0) { f32x2* rt = (f32x2*)(F.ws + WS_ROPE);
        for (int i = F.tid; i < 64 * 16; i += NTHREADS) { const int pos = i >> 4, f = i & 15; const float inv = powf(10000.0f, -(float)f / 16.0f); const float ang = (float)pos * inv; rt[i] = (f32x2){cosf(ang), sinf(ang)}; } }
}


__device__ __forceinline__ int gsw(int row, int ch) { return row * 128 + ((ch ^ (row & 7)) << 4); }
__device__ __forceinline__ int gla_row(int n, int p, int b, int d) {
    const bool isctx = n < 4; const int j = isctx ? n : n - 4; int pos = j * 64 + p;
    if (d) pos = (isctx ? CTXL : SEQ) - 1 - pos;
    return isctx ? NX + b * CTXL + pos : b * SEQ + pos;
}
struct GlaRaw { u32x4 q, k, v0, v1; f32x4 lr[4]; };
__device__ __forceinline__ void gla_load(GlaRaw& R, int n, int lane, int w, int b, int h, int d, const bf16_t* qb, const bf16_t* kb, const bf16_t* vb, const float* lr) {
    const int row = gla_row(n, lane, b, d);
    R.q = *(const u32x4*)(qb + (size_t)row * 256 + h * 64 + 8 * w);
    R.k = *(const u32x4*)(kb + (size_t)row * 256 + h * 64 + 8 * w);
    R.v0 = *(const u32x4*)(vb + (size_t)row * 512 + h * 128 + 8 * w);
    R.v1 = *(const u32x4*)(vb + (size_t)row * 512 + h * 128 + 64 + 8 * w);
#pragma unroll
    for (int i = 0; i < 4; ++i) R.lr[i] = *(const f32x4*)(lr + (size_t)row * 32 + d * 16 + 4 * i);
}
__device__ __forceinline__ void unpack8(const u32x4& w, float (&f)[8]) { f[0] = bflo(w.x); f[1] = bfhi(w.x); f[2] = bflo(w.y); f[3] = bfhi(w.y); f[4] = bflo(w.z); f[5] = bfhi(w.z); f[6] = bflo(w.w); f[7] = bfhi(w.w); }
constexpr int GPL_QE = 0, GPL_KE = 8192, GPL_OUT = 16384, GPL_BUF = 16384 + GI_BYTES + 256, GPL_DW = 2 * GPL_BUF, GPL_DB = GPL_DW + 4096, GPL_END = GPL_DB + 256;
static_assert(GPL_END <= RING_BYTES && (GPL_BUF % 16) == 0, "gla prep lds");
__device__ __forceinline__ void gla_prep_phase(const Frame& F, const Args& a) {
    LAS unsigned char* L = F.lds; const int lane = F.lane, w = F.wave, r16 = lane & 15, g4 = lane >> 4;
    const bf16_t* qb = (const bf16_t*)(F.ws + T_QB); const bf16_t* kb = (const bf16_t*)(F.ws + T_KB); const bf16_t* vb = (const bf16_t*)(F.ws + T_VB); const float* lrb = (const float*)(F.ws + T_LR);
    for (int cc = blockIdx.x; cc < 256; cc += F.G) {
        const int sq = cc & 127, b = sq >> 3, h = (sq >> 1) & 3, d = sq & 1;
        const float* dw = d ? a.in[14] : a.in[12]; const float* db = d ? a.in[15] : a.in[13];
        __syncthreads();
        for (int i = F.tid; i < 16 * 64; i += NTHREADS) ((LAS float*)(L + GPL_DW))[i] = dw[(i >> 6) * GLA_QK + h * 64 + (i & 63)];
        if (F.tid < 64) ((LAS float*)(L + GPL_DB))[F.tid] = db[h * 64 + F.tid];
        GlaRaw R; gla_load(R, cc >> 7, lane, w, b, h, d, qb, kb, vb, lrb);
        __syncthreads();
        for (int k = 0; k < 18; ++k) {
            const int n = (cc >> 7) + 2 * k;
            LAS unsigned char* PB = L + (k & 1) * GPL_BUF; LAS unsigned char* OUT = PB + GPL_OUT;
            {
                float z[8], q[8], kk[8], v0[8], v1[8];
                unpack8(R.q, q); unpack8(R.k, kk); unpack8(R.v0, v0); unpack8(R.v1, v1);
                const LAS float* DW = (const LAS float*)(L + GPL_DW); const LAS float* DB = (const LAS float*)(L + GPL_DB);
#pragma unroll
                for (int j = 0; j < 8; ++j) z[j] = DB[8 * w + j];
#pragma unroll
                for (int r = 0; r < 16; ++r) { const float x = R.lr[r >> 2][r & 3]; const f32x4 w0 = *(const LAS f32x4*)(DW + r * 64 + 8 * w), w1 = *(const LAS f32x4*)(DW + r * 64 + 8 * w + 4);
                    z[0] += x * w0.x; z[1] += x * w0.y; z[2] += x * w0.z; z[3] += x * w0.w; z[4] += x * w1.x; z[5] += x * w1.y; z[6] += x * w1.z; z[7] += x * w1.w; }
                float qe[8], ke[8], qi[8]; unsigned short ko[8]; float ld[8];
#pragma unroll
                for (int j = 0; j < 8; ++j) ld[j] = (fminf(z[j], 0.f) - __logf(1.0f + __expf(-fabsf(z[j])))) * (1.0f / 16.0f);
#pragma unroll
                for (int o = 1; o < 64; o <<= 1) { float t[8];
#pragma unroll
                    for (int j = 0; j < 8; ++j) t[j] = __shfl_up(ld[j], o);
#pragma unroll
                    for (int j = 0; j < 8; ++j) ld[j] += (lane >= o) ? t[j] : 0.f; }
                float decv = 0.f;
#pragma unroll
                for (int j = 0; j < 8; ++j) {
                    const float bm = __builtin_bit_cast(float, __builtin_amdgcn_readlane(__builtin_bit_cast(int, ld[j]), 31)), bl = __builtin_bit_cast(float, __builtin_amdgcn_readlane(__builtin_bit_cast(int, ld[j]), 63));
                    const float e1 = __expf(ld[j] - bm), e2 = __expf(bm - ld[j]);
                    qe[j] = q[j] * e1; ke[j] = kk[j] * e2; qi[j] = q[j] * __expf(ld[j]); ko[j] = (unsigned short)f2bf(kk[j] * __expf(bl - ld[j]));
                    decv = (lane == j) ? __expf(bl) : decv;
                }
                if (lane < 8) ((LAS float*)(OUT + GI_DEC))[8 * w + lane] = decv;
                *(LAS u32x4*)(PB + GPL_QE + gsw(lane, w)) = (u32x4){pk2(qe[0], qe[1]), pk2(qe[2], qe[3]), pk2(qe[4], qe[5]), pk2(qe[6], qe[7])};
                *(LAS u32x4*)(PB + GPL_KE + gsw(lane, w)) = (u32x4){pk2(ke[0], ke[1]), pk2(ke[2], ke[3]), pk2(ke[4], ke[5]), pk2(ke[6], ke[7])};
                *(LAS u32x4*)(OUT + GI_QIN + gsw(lane, w)) = (u32x4){pk2(qi[0], qi[1]), pk2(qi[2], qi[3]), pk2(qi[4], qi[5]), pk2(qi[6], qi[7])};
#pragma unroll
                for (int j = 0; j < 8; ++j) { const int rw = 8 * w + j;
                    *(LAS unsigned short*)(OUT + GI_KOT + gsw(rw, lane >> 3) + (lane & 7) * 2) = ko[j];
                    *(LAS unsigned short*)(OUT + GI_VT + gsw(rw, lane >> 3) + (lane & 7) * 2) = (unsigned short)f2bf(v0[j]);
                    *(LAS unsigned short*)(OUT + GI_VT + gsw(64 + rw, lane >> 3) + (lane & 7) * 2) = (unsigned short)f2bf(v1[j]); }
            }
            if (k + 1 < 18) gla_load(R, n + 2, lane, w, b, h, d, qb, kb, vb, lrb);
            lds_barrier();
#pragma unroll
            for (int i = 0; i < 2; ++i) { const int tI = 2 * w + i, st = tI >> 2, pt = tI & 3;
                f32x4 c = (f32x4){0.f, 0.f, 0.f, 0.f};
                if (st <= pt) {
#pragma unroll
                    for (int ks = 0; ks < 2; ++ks) { const bf16x8 af = *(const LAS bf16x8*)(PB + GPL_KE + gsw(16 * st + r16, 4 * ks + g4)), bfr = *(const LAS bf16x8*)(PB + GPL_QE + gsw(16 * pt + r16, 4 * ks + g4));
                        c = __builtin_amdgcn_mfma_f32_16x16x32_bf16(af, bfr, c, 0, 0, 0); }
                    const int p = 16 * pt + r16, s0 = 16 * st + 4 * g4;
#pragma unroll
                    for (int e = 0; e < 4; ++e) if (s0 + e > p) c[e] = 0.f;
                }
                u32x2 o; o.x = pk2(c[0], c[1]); o.y = pk2(c[2], c[3]);
                *(LAS u32x2*)(OUT + GI_A + gsw(16 * pt + r16, 2 * st + (g4 >> 1)) + (g4 & 1) * 8) = o; }
            lds_barrier();
            { unsigned char* rec = F.ws + T_GLA + (size_t)(sq * 36 + n) * GI_BYTES;
              for (int i = F.tid; i < GI_BYTES / 16; i += NTHREADS) *(u32x4*)(rec + i * 16) = *(const LAS u32x4*)(OUT + i * 16); }
        }
    }
    __syncthreads();
}
constexpr int GSL_IN = 33792  , GSL_ST = 3 * GSL_IN, GSL_END = GSL_ST + 2 * 8192;
static_assert(GSL_END <= RING_BYTES, "gla seq lds");
__device__ __forceinline__ void gla_seq_phase(const Frame& F, const Args& a) {
    LAS unsigned char* L = F.lds; const int lane = F.lane, w = F.wave, r16 = lane & 15, g4 = lane >> 4, tid = F.tid;
    for (int it = blockIdx.x; it < 256; it += F.G) {
        const int sq = it >> 1, vh = it & 1, b = sq >> 3, h = (sq >> 1) & 3, d = sq & 1;
        bf16_t* ob = (bf16_t*)(F.ws + (d ? T_OB : T_OF));
        const unsigned char* rec0 = F.ws + T_GLA + (size_t)(sq * 36) * GI_BYTES;
        __syncthreads();
        for (int i = tid; i < 2 * 8192 / 4; i += NTHREADS) ((LAS unsigned*)(L + GSL_ST))[i] = 0u;
        f32x4 Sacc[2] = {(f32x4){0.f, 0.f, 0.f, 0.f}, (f32x4){0.f, 0.f, 0.f, 0.f}};
#define GLA_DMA(n_) do { const unsigned char* r_ = rec0 + (size_t)(n_) * GI_BYTES; LAS unsigned char* d_ = L + ((n_) % 3) * GSL_IN; \
            __builtin_amdgcn_global_load_lds((const unsigned*)(r_ + GI_A + tid * 16), (LAS unsigned*)(d_ + w * 1024), 16, 0, 0); \
            __builtin_amdgcn_global_load_lds((const unsigned*)(r_ + GI_QIN + tid * 16), (LAS unsigned*)(d_ + 8192 + w * 1024), 16, 0, 0); \
            __builtin_amdgcn_global_load_lds((const unsigned*)(r_ + GI_KOT + tid * 16), (LAS unsigned*)(d_ + 16384 + w * 1024), 16, 0, 0); \
            __builtin_amdgcn_global_load_lds((const unsigned*)(r_ + GI_VT + vh * 8192 + tid * 16), (LAS unsigned*)(d_ + 24576 + w * 1024), 16, 0, 0); \
            __builtin_amdgcn_global_load_lds((const unsigned*)(r_ + GI_DEC + lane * 16), (LAS unsigned*)(d_ + 32768), 16, 0, 0); } while (0)
        GLA_DMA(0); GLA_DMA(1);
        for (int n = 0; n < 36; ++n) {
            LAS unsigned char* IN = L + (n % 3) * GSL_IN; LAS unsigned char* STr = L + GSL_ST + (n & 1) * 8192; LAS unsigned char* STw = L + GSL_ST + ((n + 1) & 1) * 8192;
            if (n == 0) asm volatile("s_waitcnt vmcnt(5)" ::: "memory"); else if (n < 35) asm volatile("s_waitcnt vmcnt(7)" ::: "memory"); else asm volatile("s_waitcnt vmcnt(2)" ::: "memory");
            lds_barrier();
            if (n + 2 < 36) GLA_DMA(n + 2);
#pragma unroll
            for (int i = 0; i < 2; ++i) { const int tI = 2 * w + i, vt = tI >> 2, pt = tI & 3;
                f32x4 c = (f32x4){0.f, 0.f, 0.f, 0.f};
#pragma unroll
                for (int ks = 0; ks < 2; ++ks) {
                    const bf16x8 a1 = *(const LAS bf16x8*)(IN + 24576 + gsw(16 * vt + r16, 4 * ks + g4)), b1 = *(const LAS bf16x8*)(IN + gsw(16 * pt + r16, 4 * ks + g4));
                    c = __builtin_amdgcn_mfma_f32_16x16x32_bf16(a1, b1, c, 0, 0, 0);
                    const bf16x8 a2 = *(const LAS bf16x8*)(STr + gsw(16 * vt + r16, 4 * ks + g4)), b2 = *(const LAS bf16x8*)(IN + 8192 + gsw(16 * pt + r16, 4 * ks + g4));
                    c = __builtin_amdgcn_mfma_f32_16x16x32_bf16(a2, b2, c, 0, 0, 0); }
                const int row = gla_row(n, 16 * pt + r16, b, d);
                u32x2 o; o.x = pk2(c[0], c[1]); o.y = pk2(c[2], c[3]);
                *(u32x2*)(ob + (size_t)row * 512 + h * 128 + vh * 64 + 16 * vt + 4 * g4) = o; }
#pragma unroll
            for (int i = 0; i < 2; ++i) { const int tI = 2 * w + i, ct = tI >> 2, vt = tI & 3;
                const f32x4 dc = *(const LAS f32x4*)(IN + 32768 + (16 * ct + 4 * g4) * 4);
                f32x4 c = Sacc[i] * dc;
#pragma unroll
                for (int ks = 0; ks < 2; ++ks) { const bf16x8 af = *(const LAS bf16x8*)(IN + 16384 + gsw(16 * ct + r16, 4 * ks + g4)), bfr = *(const LAS bf16x8*)(IN + 24576 + gsw(16 * vt + r16, 4 * ks + g4));
                    c = __builtin_amdgcn_mfma_f32_16x16x32_bf16(af, bfr, c, 0, 0, 0); }
                Sacc[i] = c;
                u32x2 o; o.x = pk2(c[0], c[1]); o.y = pk2(c[2], c[3]);
                *(LAS u32x2*)(STw + gsw(16 * vt + r16, 2 * ct + (g4 >> 1)) + (g4 & 1) * 8) = o; }
        }
#undef GLA_DMA
        asm volatile("s_waitcnt vmcnt(0)" ::: "memory");
    }
    __syncthreads();
}

__device__ __forceinline__ void finish_conv_phase(const Frame& F, const Args& a) {
    const int lane = F.lane; bf16_t* cat = (bf16_t*)(F.ws + T_CAT);
    {
        const bf16_t* of = (const bf16_t*)(F.ws + T_OF); const bf16_t* obk = (const bf16_t*)(F.ws + T_OB); const bf16_t* gb = (const bf16_t*)(F.ws + T_GB);
        const int gw = F.vcu * NWAVES + F.wave, NGW = F.G * NWAVES;
        float gg[8];
#pragma unroll
        for (int j = 0; j < 8; ++j) gg[j] = a.in[16][8 * lane + j];
        for (int row = gw; row < NT; row += NGW) {
            float x[8], y[8], g[8];
            unpack8(*(const u32x4*)(of + (size_t)row * 512 + 8 * lane), x); unpack8(*(const u32x4*)(obk + (size_t)row * 512 + 8 * lane), y); unpack8(*(const u32x4*)(gb + (size_t)row * 512 + 8 * lane), g);
            float ss = 0.f;
#pragma unroll
            for (int j = 0; j < 8; ++j) { x[j] += y[j]; ss += x[j] * x[j]; }
            ss += __shfl_xor(ss, 1); ss += __shfl_xor(ss, 2); ss += __shfl_xor(ss, 4); ss += __shfl_xor(ss, 8);
            const float rs = rsqrtf(ss * (1.0f / 128.0f) + RMS_EPS);
#pragma unroll
            for (int j = 0; j < 8; ++j) x[j] = x[j] * rs * gg[j] * siluf_(g[j]);
            *(u32x4*)(cat + (size_t)row * D + 8 * lane) = (u32x4){pk2(x[0], x[1]), pk2(x[2], x[3]), pk2(x[4], x[5]), pk2(x[6], x[7])};
        }
    }
    {
        const bf16_t* ub = (const bf16_t*)(F.ws + T_UB); LAS float* tile = (LAS float*)F.lds;
        const int c = F.tid;
        float wv[CONV_W];
#pragma unroll
        for (int j = 0; j < CONV_W; ++j) wv[j] = a.in[17][j * CONV_CH + c];
        const float cb = a.in[18][c];
        float lg[8], lb[8];
#pragma unroll
        for (int i = 0; i < 8; ++i) { lg[i] = a.in[19][lane + 64 * i]; lb[i] = a.in[20][lane + 64 * i]; }
        for (int ti = blockIdx.x; ti < NT / 32; ti += F.G) {
            const int row0 = ti * 32; const bool lat = row0 < NX;
            const int t0 = lat ? (row0 & (SEQ - 1)) : ((row0 - NX) & (CTXL - 1)); const int len = lat ? SEQ : CTXL; const int sbase = row0 - t0;
            float in[62];
            unsigned short raw[62];
#pragma unroll
            for (int i = 0; i < 62; ++i) { int t = t0 - 15 + i; t = t < 0 ? 0 : (t >= len ? len - 1 : t); raw[i] = ub[(size_t)(sbase + t) * 512 + c]; }
#pragma unroll
            for (int i = 0; i < 62; ++i) { const int t = t0 - 15 + i; in[i] = (t >= 0 && t < len) ? bf2f(raw[i]) : 0.f; }
            __syncthreads();
#pragma unroll
            for (int t = 0; t < 32; ++t) { float s = cb;
#pragma unroll
                for (int j = 0; j < CONV_W; ++j) s += wv[j] * in[t + j];
                tile[t * 512 + c] = s; }
            __syncthreads();
#pragma unroll
            for (int q = 0; q < 4; ++q) { const int t = 4 * F.wave + q; float v[8]; float s = 0.f;
#pragma unroll
                for (int i = 0; i < 8; ++i) { v[i] = tile[t * 512 + lane + 64 * i]; s += v[i]; }
                const float mu = wave_sum(s) * (1.0f / 512.0f); float qq = 0.f;
#pragma unroll
                for (int i = 0; i < 8; ++i) { v[i] -= mu; qq += v[i] * v[i]; }
                const float rstd = rsqrtf(wave_sum(qq) * (1.0f / 512.0f) + LN_EPS);
#pragma unroll
                for (int i = 0; i < 8; ++i) { const float y = v[i] * rstd * lg[i] + lb[i]; cat[(size_t)(row0 + t) * D + 512 + lane + 64 * i] = (bf16_t)f2bf(siluf_(y)); } }
        }
        __syncthreads();
    }
}


constexpr int CW_TST = 20480;
constexpr int AUX_TST = AUX_OFF, AUX_TILEE = AUX_OFF + 1040, AUX_IDX = AUX_OFF + 1168;
constexpr int MOE_MAXU = 32, MOE_MAXIDX = 16;
static_assert(AUX_IDX + MOE_MAXIDX * 1024 <= MISC_OFF, "aux lds");

struct EpiRouter {
    static constexpr bool PERM = false, AFTER_DRAIN = true;
    const float* rbias; int* asg_e; int* asg_r; float* asg_g; unsigned* counts;
    __device__ __forceinline__ void operator()(const f32x4 (&)[2][2][4][2], const Unit&, int, int, int, int) const {}
    __device__ __forceinline__ void fused(const f32x4 (&acc)[2][2][4][2], const Unit& u, int wr, int wc, int fr, int fq, LAS unsigned char* lds, int wid, int lane) const {
        LAS float* SC = (LAS float*)lds;
        LAS unsigned* lcnt = (LAS unsigned*)(lds + 66560); LAS unsigned* lbase = lcnt + 256;
        LAS int* selE = (LAS int*)(lbase + 256); LAS int* selR = selE + 2048;
        const int tid = wid * 64 + lane;
        if (tid < 256) lcnt[tid] = 0u;
        const f32x4 rb = *(const f32x4*)(rbias + 4 * lane);
        const float NINF = -__builtin_inff();
#pragma unroll
        for (int ai = 0; ai < 2; ++ai)
#pragma unroll
            for (int mm = 0; mm < 2; ++mm) {
                LDS_WAIT(); __builtin_amdgcn_s_barrier(); asm volatile("" ::: "memory");
#pragma unroll
                for (int mi = 0; mi < 2; ++mi) { const int lr = 32 * wr + 16 * mi + fr;
#pragma unroll
                    for (int bj = 0; bj < 2; ++bj)
#pragma unroll
                        for (int n = 0; n < 2; ++n) *(LAS f32x4*)(SC + lr * 260 + 128 * bj + 32 * wc + 16 * n + 4 * fq) = acc[ai][bj][2 * mm + mi][n]; }
                LDS_WAIT(); __builtin_amdgcn_s_barrier(); asm volatile("" ::: "memory");
                for (int q = 0; q < 8; ++q) {
                    const int lr = 8 * wid + q; const int rit = 128 * ai + 64 * (lr >> 5) + 16 * (2 * mm + ((lr >> 4) & 1)) + (lr & 15);
                    const f32x4 lg = *(const LAS f32x4*)(SC + lr * 260 + 4 * lane);
                    float s[4], cd[4];
#pragma unroll
                    for (int j = 0; j < 4; ++j) { s[j] = 1.0f / (1.0f + __expf(-lg[j])); cd[j] = s[j] + rb[j]; }
                    float m1 = fmaxf(cd[0], cd[1]), m2 = fminf(cd[0], cd[1]);
                    { const float x = cd[2]; const float n1 = fmaxf(m1, x); m2 = fmaxf(fminf(m1, x), m2); m1 = n1; }
                    { const float x = cd[3]; const float n1 = fmaxf(m1, x); m2 = fmaxf(fminf(m1, x), m2); m1 = n1; }
#pragma unroll
                    for (int o = 1; o < 8; o <<= 1) { const float a1 = __shfl_xor(m1, o), a2 = __shfl_xor(m2, o); const float n1 = fmaxf(m1, a1); m2 = fmaxf(fminf(m1, a1), fmaxf(m2, a2)); m1 = n1; }
                    const float gs = m1 + m2; const int mygrp = lane >> 3; int rank = 0;
#pragma unroll
                    for (int g = 0; g < 8; ++g) { const float og = __shfl(gs, 8 * g); rank += (og > gs || (og == gs && g < mygrp)) ? 1 : 0; }
                    if (rank >= 4) { cd[0] = NINF; cd[1] = NINF; cd[2] = NINF; cd[3] = NINF; }
                    int myE = 0; float myG = 0.f; float gsum = 0.f;
#pragma unroll
                    for (int k = 0; k < TOPK; ++k) {
                        float bv = cd[0]; int bi = 0;
                        if (cd[1] > bv) { bv = cd[1]; bi = 1; } if (cd[2] > bv) { bv = cd[2]; bi = 2; } if (cd[3] > bv) { bv = cd[3]; bi = 3; }
                        float v = bv; int ix = 4 * lane + bi;
#pragma unroll
                        for (int o = 32; o >= 1; o >>= 1) { const float ov = __shfl_xor(v, o); const int oi = __shfl_xor(ix, o); if (ov > v || (ov == v && oi < ix)) { v = ov; ix = oi; } }
                        const int sl = ix & 3; const float mys = sl == 0 ? s[0] : (sl == 1 ? s[1] : (sl == 2 ? s[2] : s[3]));
                        const float gv = __shfl(mys, ix >> 2);
                        gsum += gv;
                        if (lane == k) { myE = ix; myG = gv; }
                        if (lane == (ix >> 2)) { if (sl == 0) cd[0] = NINF; else if (sl == 1) cd[1] = NINF; else if (sl == 2) cd[2] = NINF; else cd[3] = NINF; }
                    }
                    if (lane < TOPK) { const unsigned r = __hip_atomic_fetch_add(&lcnt[myE], 1u, __ATOMIC_RELAXED, __HIP_MEMORY_SCOPE_WORKGROUP); selE[rit * 8 + lane] = myE; selR[rit * 8 + lane] = (int)r; asg_g[(size_t)(u.orow + rit) * 8 + lane] = myG / gsum * 2.5f; }
                }
            }
        LDS_WAIT(); __builtin_amdgcn_s_barrier(); asm volatile("" ::: "memory");
        if (tid < 256) { const unsigned c = lcnt[tid]; lbase[tid] = c ? atomicAdd(&counts[tid], c) : 0u; }
        LDS_WAIT(); __builtin_amdgcn_s_barrier(); asm volatile("" ::: "memory");
        for (int i = tid; i < 2048; i += NTHREADS) { const int e = selE[i]; asg_e[(size_t)u.orow * 8 + i] = e; asg_r[(size_t)u.orow * 8 + i] = (int)lbase[e] + selR[i]; }
    }
};

__device__ __forceinline__ void moe_place(const Frame& F, int layer, int ntok) {
    LAS int* cnt = (LAS int*)F.lds; LAS int* tst = cnt + 256;
    const unsigned* counts = F.ctl + CW_CNT + layer * 256;
    const int* asg_e = (const int*)(F.ws + M_AE); const int* asg_r = (const int*)(F.ws + M_AR); int* tslot = (int*)(F.ws + M_TS); int* stok = (int*)(F.ws + M_ST);
    __syncthreads();
    if (F.tid < 256) cnt[F.tid] = (int)counts[F.tid];
    __syncthreads();
    if (F.tid == 0) { int acc = 0; for (int e = 0; e < 256; ++e) { tst[e] = acc; acc += (cnt[e] + 255) >> 8; } tst[256] = acc; }
    __syncthreads();
    const int ntr = tst[256];
    if (blockIdx.x == 0) for (int i = F.tid; i < 257; i += NTHREADS) F.ctl[CW_TST + layer * 320 + i] = (unsigned)tst[i];
    const int gt = blockIdx.x * NTHREADS + F.tid, gs = F.G * NTHREADS;
    for (int i = gt; i < ntok * 8; i += gs) { const int e = asg_e[i]; const int slot = tst[e] * 256 + asg_r[i]; stok[slot] = i >> 3; tslot[i] = slot; }
    for (int e = blockIdx.x; e < 256; e += F.G) { const int s0 = tst[e] * 256 + cnt[e], s1 = tst[e + 1] * 256; for (int s = s0 + F.tid; s < s1; s += NTHREADS) stok[s] = 0; }
    for (int i = gt; i < ntok; i += gs) stok[ntr * 256 + i] = i;
    __syncthreads();
}

template <int NCOL>
__device__ __forceinline__ int moe_units_setup(const Frame& F, int layer, int ntok, int c, bool want_idx) {
    LAS int* tst = (LAS int*)(F.lds + AUX_TST); LAS int* tileE = (LAS int*)(F.lds + AUX_TILEE); LAS int* idxl = (LAS int*)(F.lds + AUX_IDX);
    __syncthreads();
    for (int i = F.tid; i < 257; i += NTHREADS) tst[i] = (int)F.ctl[CW_TST + layer * 320 + i];
    __syncthreads();
    const int ntr = tst[256], nunits = (ntr + ntok / 256) * NCOL;
    int nu = c < nunits ? (nunits - c + F.G - 1) / F.G : 0; if (nu > MOE_MAXU) nu = MOE_MAXU; if (want_idx && nu > MOE_MAXIDX) nu = MOE_MAXIDX;
    if (F.tid < nu) { const int rt = (c + F.tid * F.G) / NCOL; int e;
        if (rt >= ntr) e = NEXP; else { int lo = 0, hi = 255; while (lo < hi) { const int mid = (lo + hi + 1) >> 1; if (tst[mid] <= rt) lo = mid; else hi = mid - 1; } e = lo; }
        tileE[F.tid] = e; }
    if (want_idx) { const int* stok = (const int*)(F.ws + M_ST); for (int i = F.tid; i < nu * 256; i += NTHREADS) idxl[i] = stok[(size_t)((c + (i >> 8) * F.G) / NCOL) * 256 + (i & 255)]; }
    __syncthreads();
    return nu;
}
struct SchedMoeGU {
    const char* A; const char* W; const LAS int* tileE; const LAS int* idxl; int nu, G, c;
    __device__ __forceinline__ bool next(int i, Unit& u) const {
        if (i >= nu) return false; const int un = c + i * G; const int rt = un >> 1, col = un & 1; const int e = tileE[i];
        u.a = i; u.b = e * 512 + col * 256; u.orow = rt * 256; u.ocol = col * 128; u.aux = e; return true; }
    __device__ __forceinline__ const char* a_base() const { return A; }
    __device__ __forceinline__ const char* b_ptr(const Unit& u) const { return W + (size_t)u.b * D * 2; }
    __device__ __forceinline__ void a_off(const Unit& u, const int (&R)[2], const int (&C)[2], unsigned (&o0)[2], unsigned (&o1)[2]) const {
#pragma unroll
        for (int i = 0; i < 2; ++i) { const int t0 = idxl[u.a * 256 + R[i]], t1 = idxl[u.a * 256 + 128 + R[i]]; o0[i] = (unsigned)t0 * (unsigned)(D * 2) + (unsigned)C[i] * 2u; o1[i] = (unsigned)t1 * (unsigned)(D * 2) + (unsigned)C[i] * 2u; }
    }
};
struct EpiGateUp {
    static constexpr bool PERM = true, AFTER_DRAIN = false;
    bf16_t* hid;
    __device__ __forceinline__ void operator()(const f32x4 (&acc)[2][2][4][2], const Unit& u, int wr, int wc, int fr, int fq) const {
        const int lane = fr + 16 * fq; const int srcb = ((lane >> 2) + 16 * (lane & 3)) << 2;
        const int row0 = u.orow + wr * 64 + (lane >> 2), col0 = u.ocol + wc * 32 + 8 * (lane & 3);
#pragma unroll
        for (int ai = 0; ai < 2; ++ai)
#pragma unroll
            for (int m = 0; m < 4; ++m) { float h[8];
#pragma unroll
                for (int n = 0; n < 2; ++n)
#pragma unroll
                    for (int e = 0; e < 4; ++e) { const float g = acc[ai][0][m][n][e], up = acc[ai][1][m][n][e]; h[4 * n + e] = g / (1.0f + __expf(-g)) * up; }
                u32x4 w; w.x = cvt_pk_bf16(h[0], h[1]); w.y = cvt_pk_bf16(h[2], h[3]); w.z = cvt_pk_bf16(h[4], h[5]); w.w = cvt_pk_bf16(h[6], h[7]);
                u32x4 t; t.x = (unsigned)__builtin_amdgcn_ds_bpermute(srcb, (int)w.x); t.y = (unsigned)__builtin_amdgcn_ds_bpermute(srcb, (int)w.y); t.z = (unsigned)__builtin_amdgcn_ds_bpermute(srcb, (int)w.z); t.w = (unsigned)__builtin_amdgcn_ds_bpermute(srcb, (int)w.w);
                *(u32x4*)(hid + (size_t)(row0 + ai * 128 + m * 16) * DEXP + col0) = t; }
    }
};
struct SchedMoeDN {
    const char* A; const char* W; const LAS int* tileE; int nu, G, c;
    __device__ __forceinline__ bool next(int i, Unit& u) const {
        if (i >= nu) return false; const int un = c + i * G; const int rt = un >> 2, col = un & 3; const int e = tileE[i];
        u.a = rt; u.b = e * 1024 + col * 256; u.orow = rt * 256; u.ocol = col * 256; u.aux = e; return true; }
    __device__ __forceinline__ const char* a_base() const { return A; }
    __device__ __forceinline__ const char* b_ptr(const Unit& u) const { return W + (size_t)u.b * DEXP * 2; }
    __device__ __forceinline__ void a_off(const Unit& u, const int (&R)[2], const int (&C)[2], unsigned (&o0)[2], unsigned (&o1)[2]) const {
#pragma unroll
        for (int i = 0; i < 2; ++i) { o0[i] = (unsigned)((u.a * 256 + R[i]) * DEXP + C[i]) * 2u; o1[i] = o0[i] + (unsigned)(128 * DEXP * 2); }
    }
};

constexpr int NA_RING = 11, NA_VR = 0, NA_VC = NA_RING * 64 * 128, NA_KC = NA_VC + 256 * 128, NA_RPB = NA_KC + 256 * 128, NA_END = NA_RPB + 15 * 128;
static_assert(NA_END <= MISC_OFF, "na lds");
typedef short s16x4 __attribute__((ext_vector_type(4)));
__device__ __forceinline__ int na_voff(int row, int ch) { return row * 128 + ((((ch >> 1) ^ ((row >> 1) & 3)) << 5) | ((ch & 1) << 4)); }
__device__ __forceinline__ int na_koff(int row, int ch) { return row * 128 + ((ch ^ (row & 7)) << 4); }
template <bool CTX, int TB>
__device__ __forceinline__ void na_seg(LAS unsigned char* L, bf16x8 (&kf)[8][2], const char* knext, unsigned loff, const bf16x8 (&qf)[2], int seg, int r16, int g4, int r0, int band, const int (&boff)[2][4], int rbase,
                                       const int (&voff)[4], f32x4 (&O)[4], float& m_run, float& sum) {
    const float NINF = -__builtin_inff();
    float S[8][4]; float mx = NINF;
#pragma unroll
    for (int t = 0; t < 8; ++t) {
        f32x4 c = (f32x4){0.f, 0.f, 0.f, 0.f};
        if (CTX) {
            const int key = 128 * seg + 16 * t + r16;
            const bf16x8 k0 = *(const LAS bf16x8*)(L + NA_KC + na_koff(key, g4)), k1 = *(const LAS bf16x8*)(L + NA_KC + na_koff(key, 4 + g4));
            c = __builtin_amdgcn_mfma_f32_16x16x32_bf16(k0, qf[0], c, 0, 0, 0); c = __builtin_amdgcn_mfma_f32_16x16x32_bf16(k1, qf[1], c, 0, 0, 0);
#pragma unroll
            for (int e = 0; e < 4; ++e) S[t][e] = c[e];
        } else {
            c = __builtin_amdgcn_mfma_f32_16x16x32_bf16(kf[t][0], qf[0], c, 0, 0, 0); c = __builtin_amdgcn_mfma_f32_16x16x32_bf16(kf[t][1], qf[1], c, 0, 0, 0);
#pragma unroll
            for (int e = 0; e < 4; ++e) S[t][e] = c[e] + *(const LAS float*)(L + rbase + ((TB + t) >> 1) * 128 + boff[t & 1][e]);
        }
        mx = fmaxf(mx, fmaxf(fmaxf(S[t][0], S[t][1]), fmaxf(S[t][2], S[t][3])));
    }
    if (!CTX && TB == 0) {
#pragma unroll
        for (int t = 0; t < 8; ++t) { const char* bt = knext + (size_t)((t >> 1) * 64 + 16 * (t & 1)) * D * 2; kf[t][0] = *(const bf16x8*)(bt + loff); kf[t][1] = *(const bf16x8*)(bt + loff + 64); }
    }
    mx = fmaxf(mx, __shfl_xor(mx, 16)); mx = fmaxf(mx, __shfl_xor(mx, 32));
    const float m_new = fmaxf(m_run, mx); const float alpha = __builtin_amdgcn_exp2f(m_run - m_new); m_run = m_new;
    float ps = 0.f;
#pragma unroll
    for (int t = 0; t < 8; ++t)
#pragma unroll
        for (int e = 0; e < 4; ++e) { const float p = __builtin_amdgcn_exp2f(S[t][e] - m_new); S[t][e] = p; ps += p; }
    ps += __shfl_xor(ps, 16); ps += __shfl_xor(ps, 32);
    sum = sum * alpha + ps;
#pragma unroll
    for (int mt = 0; mt < 4; ++mt) O[mt] = O[mt] * alpha;
#pragma unroll
    for (int j = 0; j < 4; ++j) {
        bf16x8 pb; { const u32x4 ww = (u32x4){cvt_pk_bf16(S[2 * j][0], S[2 * j][1]), cvt_pk_bf16(S[2 * j][2], S[2 * j][3]), cvt_pk_bf16(S[2 * j + 1][0], S[2 * j + 1][1]), cvt_pk_bf16(S[2 * j + 1][2], S[2 * j + 1][3])}; pb = __builtin_bit_cast(bf16x8, ww); }
        int ub;
        if (CTX) ub = NA_VC + (128 * seg + 32 * j) * 128; else ub = NA_VR + (((r0 + TB / 2 + j) % NA_RING) * 64 + band) * 128;
#pragma unroll
        for (int mt = 0; mt < 4; ++mt) {
            const s16x4 a0 = __builtin_amdgcn_ds_read_tr16_b64_v4i16((LAS s16x4*)(L + ub + voff[mt]));
            const s16x4 a1 = __builtin_amdgcn_ds_read_tr16_b64_v4i16((LAS s16x4*)(L + ub + voff[mt] + 16 * 128));
            const bf16x8 av = (bf16x8){a0[0], a0[1], a0[2], a0[3], a1[0], a1[1], a1[2], a1[3]};
            O[mt] = __builtin_amdgcn_mfma_f32_16x16x32_bf16(av, pb, O[mt], 0, 0, 0);
        }
    }
}
__device__ __forceinline__ void na_phase(const Frame& F, const Args& a) {
    LAS unsigned char* L = F.lds; const int lane = F.lane, w = F.wave, r16 = lane & 15, g4 = lane >> 4;
    const bf16_t* qbuf = (const bf16_t*)(F.ws + T_QKV); const bf16_t* kbuf = qbuf + (size_t)NT * D; const bf16_t* vbuf = kbuf + (size_t)NT * D; bf16_t* cat = (bf16_t*)(F.ws + T_CAT);
    const int rr = w >> 2, cb = w & 3; const int band = cb == 0 ? 0 : (cb == 1 ? 8 : (cb == 2 ? 24 : 32));
    const float NINF = -__builtin_inff();
    const int pkey = F.tid >> 3, pch = F.tid & 7;
    int boff[2][4], voff[4];
    { const int qc = 16 * cb + r16; int cs = qc - 8; cs = cs < 0 ? 0 : (cs > 48 ? 48 : cs);
#pragma unroll
      for (int hc = 0; hc < 2; ++hc)
#pragma unroll
          for (int e = 0; e < 4; ++e) { const int kc = band + 16 * hc + 4 * g4 + e; const bool ok = kc >= cs && kc < cs + 16; boff[hc][e] = (ok ? kc - qc + 15 : 31) * 4; }
      const int rl = 4 * g4 + (r16 >> 2), sw = (rl >> 1) & 3;
#pragma unroll
      for (int mt = 0; mt < 4; ++mt) voff[mt] = rl * 128 + ((mt ^ sw) << 5) + 8 * (r16 & 3); }
    for (int bh = blockIdx.x; bh < BATCH * NA_H; bh += F.G) {
        const int b = bh >> 4, h = bh & 15;
        __syncthreads();
        for (int i = F.tid; i < 15 * 32; i += NTHREADS) { const int ri = i >> 5, ci = i & 31; ((LAS float*)(L + NA_RPB))[i] = ci < 31 ? a.in[23][h * 465 + ri * 31 + ci] * 1.4426950408889634f : NINF; }
        for (int i = F.tid; i < 256 * 8; i += NTHREADS) { const int key = i >> 3, ch = i & 7; const size_t g = (size_t)(NX + b * CTXL + key) * D + h * 64 + ch * 8;
            *(LAS u32x4*)(L + NA_VC + na_voff(key, ch)) = *(const u32x4*)(vbuf + g); *(LAS u32x4*)(L + NA_KC + na_koff(key, ch)) = *(const u32x4*)(kbuf + g); }
        for (int gr = 0; gr < 9; ++gr) *(LAS u32x4*)(L + NA_VR + na_voff(gr * 64 + pkey, pch)) = *(const u32x4*)(vbuf + (size_t)(b * SEQ + gr * 64 + pkey) * D + h * 64 + pch * 8);
        for (int rp = 0; rp < 16; ++rp) {
            int R0 = 2 * rp - 4; R0 = R0 < 0 ? 0 : (R0 > 24 ? 24 : R0);
            int R0n = 2 * rp - 2; R0n = R0n < 0 ? 0 : (R0n > 24 ? 24 : R0n);
            const bool newrows = (rp < 15) && (R0n != R0);
            u32x4 nv0 = (u32x4){0u, 0u, 0u, 0u}, nv1 = nv0;
            if (newrows) { nv0 = *(const u32x4*)(vbuf + (size_t)(b * SEQ + (R0 + 9) * 64 + pkey) * D + h * 64 + pch * 8); if (R0 + 10 < 32) nv1 = *(const u32x4*)(vbuf + (size_t)(b * SEQ + (R0 + 10) * 64 + pkey) * D + h * 64 + pch * 8); }
            const int r = 2 * rp + rr; int r0 = r - 4; r0 = r0 < 0 ? 0 : (r0 > 24 ? 24 : r0);
            const int qrow = b * SEQ + r * 64 + 16 * cb + r16;
            bf16x8 qf[2];
#pragma unroll
            for (int ks = 0; ks < 2; ++ks) qf[ks] = *(const bf16x8*)(qbuf + (size_t)qrow * D + h * 64 + 32 * ks + 8 * g4);
            bf16x8 kf[8][2];
            const char* kb0 = (const char*)kbuf + ((size_t)(b * SEQ + r0 * 64 + band) * D + h * 64) * 2;
            const unsigned loff = (unsigned)(r16 * D + 8 * g4) * 2u;
#pragma unroll
            for (int t = 0; t < 8; ++t) { const char* bt = kb0 + (size_t)((t >> 1) * 64 + 16 * (t & 1)) * D * 2; kf[t][0] = *(const bf16x8*)(bt + loff); kf[t][1] = *(const bf16x8*)(bt + loff + 64); }
            const char* kb1 = kb0 + (size_t)(4 * 64) * D * 2;
            lds_barrier();
            const int rbase = NA_RPB + (r0 - r + 7) * 128;
            f32x4 O[4]; float m_run = NINF, sum = 0.f;
#pragma unroll
            for (int mt = 0; mt < 4; ++mt) O[mt] = (f32x4){0.f, 0.f, 0.f, 0.f};
#pragma nounroll
            for (int seg = 0; seg < 2; ++seg) na_seg<true, 0>(L, kf, kb1, loff, qf, seg, r16, g4, r0, band, boff, rbase, voff, O, m_run, sum);
            na_seg<false, 0>(L, kf, kb1, loff, qf, 0, r16, g4, r0, band, boff, rbase, voff, O, m_run, sum);
            na_seg<false, 8>(L, kf, kb1, loff, qf, 0, r16, g4, r0, band, boff, rbase, voff, O, m_run, sum);
            const float inv = 1.0f / sum;
#pragma unroll
            for (int mt = 0; mt < 4; ++mt) { u32x2 o; o.x = pk2(O[mt][0] * inv, O[mt][1] * inv); o.y = pk2(O[mt][2] * inv, O[mt][3] * inv);
                *(u32x2*)(cat + (size_t)qrow * D + h * 64 + 16 * mt + 4 * g4) = o; }
            if (newrows) { *(LAS u32x4*)(L + NA_VR + na_voff(((R0 + 9) % NA_RING) * 64 + pkey, pch)) = nv0; *(LAS u32x4*)(L + NA_VR + na_voff(((R0 + 10) % NA_RING) * 64 + pkey, pch)) = nv1; }
        }
    }
    __syncthreads();
}

#if MK_ONE_LAUNCH
#define GRID_BAR() xcd_barrier(bar)
#else
#define GRID_BAR() do { } while (0)
#endif
#define IN(k) (lo <= (k) && (k) < hi && (k) <= MK_LAST_PHASE)
#define SEAM(k) do { if (IN(k) && IN((k) + 1)) GRID_BAR(); } while (0)
template <int LAYER>
__device__ __forceinline__ void layer_tail(const Frame& F, const Args& args, const int lo, const int hi, const XcdBarrier& bar) {
    unsigned char* ws = args.ws;
    const float* modx = (const float*)(ws + WS_MODX); const float* modc = (const float*)(ws + WS_MODC);
    float* xw = (float*)(ws + WS_XW); bf16_t* Hb = (bf16_t*)(ws + WS_H);
    constexpr int mb = LAYER ? 16 : 7; constexpr int ntok = LAYER ? NX : NT;
    const float* lmodx = modx + (size_t)LAYER * 16 * ADA; const float* lmodc = modc + (size_t)LAYER * ADA;
    if (IN(LAYER ? 14 : 5)) REPEAT_IF(LAYER ? 14 : 5) { REP_BAR();
        SchedDense S{(const char*)(ws + T_CAT), (const char*)(ws + (LAYER ? WS_WOUT1 : WS_WOUT0)), D, ntok / 256, D / 256, 0, 1, 0, F.G, (int)blockIdx.x};
        EpiBf16 E{(bf16_t*)(ws + T_Y), D, 0, 0};
        pg8::gemm_phase<EpiBf16, SchedDense, true>(F.lds, D, S, E);
        if (LAYER == 0 && F.G == 256 && (int)blockIdx.x >= 64) cvt_moe_range(F, args, 0, F0_BULK + F0_P2, F0_BULK + F0_P2 + F0_P5, (int)blockIdx.x - 64, 192);
    }
    SEAM(LAYER ? 14 : 5);
    if (IN(LAYER ? 15 : 6)) REPEAT_IF(LAYER ? 15 : 6) { REP_BAR();
        RowPhase P{}; P.xin_lat = LAYER ? xw : args.in[0]; P.xin_ctx = LAYER ? xw + (size_t)NX * D : args.in[2]; P.xout_lat = xw; P.xout_ctx = xw + (size_t)NX * D; P.nrows = ntok; P.ysrc = 1; P.y = (const bf16_t*)(ws + T_Y);
        P.gpost = args.in[7] + LAYER * D; P.modx = lmodx; P.modc = lmodc; P.gate_chunk = 2;
        P.doH = true; P.H = Hb; P.gpre = args.in[8] + LAYER * D; P.sc_chunk = 4; P.sh_chunk = 3; P.modxH = lmodx; P.modcH = lmodc;
        row_phase(F, P);
    }
    SEAM(LAYER ? 15 : 6);
    if (IN(mb)) REPEAT_IF(mb) { REP_BAR();
        SchedDense S{(const char*)Hb, (const char*)(ws + WS_WR) + (size_t)LAYER * NEXP * D * 2, D, ntok / 256, 1, 0, 1, 0, F.G, (int)blockIdx.x};
        EpiRouter E{args.in[25] + LAYER * NEXP, (int*)(ws + M_AE), (int*)(ws + M_AR), (float*)(ws + M_AG), F.ctl + CW_CNT + LAYER * 256};
        pg8::gemm_phase<EpiRouter, SchedDense, false>(F.lds, D, S, E);
        if (F.G != 256) { } else if (LAYER == 0) { if ((int)blockIdx.x >= 144) cvt_moe_range(F, args, 0, F0_BULK + F0_P2 + F0_P5, MOE_CVT_ITEMS, (int)blockIdx.x - 144, 112); }
        else { if ((int)blockIdx.x >= 128) { const int ntr0 = (int)__hip_atomic_load(F.ctl + CW_TST + 256, __ATOMIC_RELAXED, __HIP_MEMORY_SCOPE_AGENT); int s9, s10; fill1_ranges(F, ntr0, s9, s10);
                cvt_moe_range(F, args, 1, s9 + s10, MOE_CVT_ITEMS - F1_P12, (int)blockIdx.x - 128, 128); } }
    }
    SEAM(mb);
    if (IN(mb + 1)) REPEAT_IF(mb + 1) { REP_BAR(); moe_place(F, LAYER, ntok); }
    SEAM(mb + 1);
    if (IN(mb + 2)) REPEAT_IF(mb + 2) { REP_BAR();
        const int nj = moe_units_setup<2>(F, LAYER, ntok, F.vcu, true);
        SchedMoeGU S{(const char*)Hb, (const char*)(ws + WS_WGU + (size_t)LAYER * WGU_BYTES), (const LAS int*)(F.lds + AUX_TILEE), (const LAS int*)(F.lds + AUX_IDX), nj, F.G, F.vcu};
        EpiGateUp E{(bf16_t*)(ws + M_HID)};
        pg8::gemm_phase<EpiGateUp, SchedMoeGU, true>(F.lds, D, S, E);
        if (LAYER == 0) { const int ntr0 = ((const LAS int*)(F.lds + AUX_TST))[256]; int s9, s10; fill1_ranges(F, ntr0, s9, s10); const int nu = (ntr0 + NT / 256) * 2, hv = nu % F.G;
            if (hv && F.vcu >= hv) cvt_moe_range(F, args, 1, 0, s9, F.vcu - hv, F.G - hv); }
    }
    SEAM(mb + 2);
    if (IN(mb + 3)) REPEAT_IF(mb + 3) { REP_BAR();
        const int nj = moe_units_setup<4>(F, LAYER, ntok, F.vcu, false);
        SchedMoeDN S{(const char*)(ws + M_HID), (const char*)(ws + WS_WDN + (size_t)LAYER * WDN_BYTES), (const LAS int*)(F.lds + AUX_TILEE), nj, F.G, F.vcu};
        EpiF8 E{(unsigned char*)(ws + M_OUT)};
        pg8::gemm_phase<EpiF8, SchedMoeDN, true>(F.lds, DEXP, S, E);
        if (LAYER == 0) { const int ntr0 = ((const LAS int*)(F.lds + AUX_TST))[256]; int s9, s10; fill1_ranges(F, ntr0, s9, s10); const int nu = (ntr0 + NT / 256) * 4, hv = nu % F.G;
            if (hv && F.vcu >= hv) cvt_moe_range(F, args, 1, s9, s9 + s10, F.vcu - hv, F.G - hv); }
    }
    SEAM(mb + 3);
    if (IN(mb + 4)) REPEAT_IF(mb + 4) { REP_BAR();
        RowPhase P{}; P.xin_lat = xw; P.xin_ctx = xw + (size_t)NX * D; P.xout_lat = LAYER ? args.out : xw; P.xout_ctx = xw + (size_t)NX * D; P.nrows = ntok; P.ysrc = 2;
        P.mo8 = (const unsigned char*)(ws + M_OUT); P.tslot = (const int*)(ws + M_TS); P.tgate = (const float*)(ws + M_AG); P.sharedbase = (int)__hip_atomic_load(F.ctl + CW_TST + LAYER * 320 + 256, __ATOMIC_RELAXED, __HIP_MEMORY_SCOPE_AGENT) * 256;
        P.gpost = args.in[9] + LAYER * D; P.modx = lmodx; P.modc = lmodc; P.gate_chunk = 5;
        P.doH = LAYER == 0; P.H = Hb; P.gpre = args.in[6] + D; P.sc_chunk = 1; P.sh_chunk = 0; P.modxH = modx + (size_t)16 * ADA; P.modcH = modc + ADA;
        row_phase(F, P);
        if (LAYER == 0) {
            const int ntr0 = (int)__hip_atomic_load(F.ctl + CW_TST + 256, __ATOMIC_RELAXED, __HIP_MEMORY_SCOPE_AGENT); int s9, s10; fill1_ranges(F, ntr0, s9, s10);
            if (F.G != 256) cvt_moe_range(F, args, 1, 0, MOE_CVT_ITEMS, F.vcu, F.G);
        }
    }
    SEAM(mb + 4);
}

__global__ void __launch_bounds__(NTHREADS, 2) mk_fwd(Args args) {
    extern __shared__ __attribute__((aligned(16))) unsigned char lds_raw[];
    Frame F;
    F.lds = (LAS unsigned char*)lds_raw; F.MISC = (volatile LAS unsigned*)(F.lds + MISC_OFF);
    F.tid = threadIdx.x; F.lane = F.tid & 63; F.wave = __builtin_amdgcn_readfirstlane(F.tid >> 6);
    F.G = gridDim.x; { const int bx = blockIdx.x; F.vcu = (F.G % 8 == 0) ? (bx % 8) * (F.G / 8) + bx / 8 : bx; }
    F.ws = args.ws; F.ctl = (unsigned*)(args.ws + WS_CTL);
    for (int u = F.tid; u < (LDS_BYTES - MISC_OFF) / 4; u += NTHREADS) ((LAS unsigned*)(F.lds + MISC_OFF))[u] = 0u;
    __syncthreads();
    XcdBarrier bar; bar.bar = F.ctl + CW_BAR; bar.x = 0; bar.st = nullptr;
#if MK_ONE_LAUNCH
    bar = xcd_barrier_post(F.ctl + CW_BAR, F.MISC + 8);
#endif
    const int lo = args.ph_lo, hi = args.ph_hi;
    unsigned char* ws = args.ws;
    const float* modx = (const float*)(ws + WS_MODX); const float* modc = (const float*)(ws + WS_MODC);
    float* xw = (float*)(ws + WS_XW); bf16_t* Hb = (bf16_t*)(ws + WS_H);

    if (IN(0)) REPEAT_IF(0) { REP_BAR(); p0_ada(F, args); p0_convert(F, args); }
    SEAM(0);
    {
        if (IN(1)) REPEAT_IF(1) { REP_BAR();
            RowPhase P{}; P.xin_lat = args.in[0]; P.xin_ctx = args.in[2]; P.nrows = NT; P.ysrc = 0; P.modx = modx; P.modc = modc;
            P.doH = true; P.H = Hb; P.gpre = args.in[6]; P.sc_chunk = 1; P.sh_chunk = 0; P.modxH = modx; P.modcH = modc;
            row_phase(F, P);
        }
        SEAM(1);
        if (IN(2)) REPEAT_IF(2) { REP_BAR();
            SchedDense S{(const char*)Hb, (const char*)(ws + WS_WIN0), D, NT / 256, AB_INP / 256, 0, 1, 0, F.G, (int)blockIdx.x};
            EpiInproj E{(bf16_t*)(ws + T_QB), (bf16_t*)(ws + T_KB), (bf16_t*)(ws + T_VB), (bf16_t*)(ws + T_GB), (bf16_t*)(ws + T_UB), (float*)(ws + T_LR), (const f32x2*)(ws + WS_ROPE)};
            pg8::gemm_phase<EpiInproj, SchedDense, true>(F.lds, D, S, E);
            if (F.G == 256 && (int)blockIdx.x >= 48) cvt_moe_range(F, args, 0, F0_BULK, F0_BULK + F0_P2, (int)blockIdx.x - 48, 208);
        }
        SEAM(2);
        if (IN(3)) REPEAT_IF(3) { REP_BAR(); gla_prep_phase(F, args); }
        if (IN(3) && IN(22)) GRID_BAR();
        if (IN(22)) REPEAT_IF(22) { REP_BAR(); gla_seq_phase(F, args); }
        if (IN(22) && IN(4)) GRID_BAR();
        if (IN(4)) REPEAT_IF(4) { REP_BAR(); finish_conv_phase(F, args); }
        SEAM(4);

    }
    layer_tail<0>(F, args, lo, hi, bar);
    {
        if (IN(12)) REPEAT_IF(12) { REP_BAR();
            SchedDense S{(const char*)Hb, (const char*)(ws + WS_WQKV1), D, NX / 256, 12, NC / 256, 8, 4, F.G, (int)blockIdx.x};
            EpiBf16 E{(bf16_t*)(ws + T_QKV), D, D, (size_t)NT * D, 0.125f * 1.4426950408889634f};
            pg8::gemm_phase<EpiBf16, SchedDense, true>(F.lds, D, S, E);
            if (F.G == 256 && (int)blockIdx.x >= 128) cvt_moe_range(F, args, 1, MOE_CVT_ITEMS - F1_P12, MOE_CVT_ITEMS, (int)blockIdx.x - 128, 128);
        }
        SEAM(12);
        if (IN(13)) REPEAT_IF(13) { REP_BAR(); na_phase(F, args); }
        SEAM(13);

    }
    layer_tail<1>(F, args, lo, hi, bar);

#undef IN
#undef SEAM
}

extern "C" void kernel_launch(void* const* d_in, const int* in_sizes, int n_in, void* d_out, int out_size, void* d_ws, size_t ws_size, hipStream_t stream) {
    static int grid = 0;
    if (grid == 0) {
        if (n_in != 32 || out_size != NX * D || ws_size < WS_END) { fprintf(stderr, "kernel_launch: unexpected problem (n_in %d, out %d, ws %zu < %zu)\n", n_in, out_size, ws_size, (size_t)WS_END); grid = -1; return; }
        int dev = 0, cus = 0, per_cu = 0;
        if (hipGetDevice(&dev) != hipSuccess || hipDeviceGetAttribute(&cus, hipDeviceAttributeMultiprocessorCount, dev) != hipSuccess) { grid = -1; return; }
        if (hipFuncSetAttribute((const void*)mk_fwd, hipFuncAttributeMaxDynamicSharedMemorySize, LDS_BYTES) != hipSuccess) { fprintf(stderr, "kernel_launch: hipFuncSetAttribute failed\n"); grid = -1; return; }
        if (hipOccupancyMaxActiveBlocksPerMultiprocessor(&per_cu, (const void*)mk_fwd, NTHREADS, LDS_BYTES) != hipSuccess || per_cu < 1) fprintf(stderr, "kernel_launch: occupancy query says %d\n", per_cu);
        (void)hipGetLastError();
        grid = cus;
    }
    if (grid < 0) return;
    (void)hipMemsetAsync((char*)d_ws + WS_CTL, 0, CTL_BYTES, stream);
    Args a{};
    for (int i = 0; i < 32; ++i) a.in[i] = (const float*)d_in[i];
    a.out = (float*)d_out; a.ws = (unsigned char*)d_ws;
#if MK_ONE_LAUNCH
    a.ph_lo = 0; a.ph_hi = 64;
    hipLaunchKernelGGL(mk_fwd, dim3(grid), dim3(NTHREADS), LDS_BYTES, stream, a);
#else
    for (int p = 0; p <= 20; ++p) { if (p > MK_LAST_PHASE) break; a.ph_lo = p; a.ph_hi = p + 1; hipLaunchKernelGGL(mk_fwd, dim3(grid), dim3(NTHREADS), LDS_BYTES, stream, a); }
#endif
}
```

```cpp
#include <hip/hip_runtime.h>
#include <cstdio>
#include <cstdint>

#ifndef MK_ONE_LAUNCH
#define MK_ONE_LAUNCH 1
#endif
#ifndef MK_LAST_PHASE
#define MK_LAST_PHASE 99
#endif

#ifndef MK_REP
#define MK_REP (-1)
#endif
#define REPEAT_IF(k) _Pragma("unroll") for (int _r = 0; _r < ((k) == MK_REP ? 2 : 1); ++_r)
#define REP_BAR() do { if (_r) GRID_BAR(); } while (0)

#define GAS __attribute__((address_space(1)))
#define LAS __attribute__((address_space(3)))
typedef unsigned short bf16_t;
typedef short bf16x8 __attribute__((ext_vector_type(8)));
typedef float f32x4 __attribute__((ext_vector_type(4)));
typedef float f32x2 __attribute__((ext_vector_type(2)));
typedef unsigned u32x4 __attribute__((ext_vector_type(4)));
typedef unsigned u32x2 __attribute__((ext_vector_type(2)));

constexpr int D = 1024, BATCH = 16, SEQ = 2048, CTXL = 256, GRIDW = 64;
constexpr int NX = BATCH * SEQ, NC = BATCH * CTXL, NT = NX + NC;
constexpr int ADA = 6 * D;
constexpr int GLA_H = 4, GLA_DK = 64, GLA_DV = 128, GLA_QK = 256, GLA_V = 512, CONV_CH = 512, CONV_W = 31;
constexpr int AB_IN = 2592, AB_INP = 2816;
constexpr int NA_H = 16, NA_DH = 64;
constexpr int NEXP = 256, TOPK = 8, DEXP = 256;
constexpr int NEXPS = NEXP + 1;
constexpr int PMAX = NT * TOPK + NEXP * 255 + NT;
static_assert(PMAX % 256 == 0, "PMAX");
constexpr float RMS_EPS = 1e-6f, LN_EPS = 1e-5f;
constexpr float F8_SCALE = 16.0f, F8_INV = 1.0f / 16.0f;

constexpr size_t MiB = 1u << 20;
constexpr size_t al(size_t x) { return (x + 4095) & ~(size_t)4095; }
constexpr size_t WS_CTL = 0, CTL_BYTES = 1 * MiB;
constexpr size_t WS_MODX = WS_CTL + CTL_BYTES;
constexpr size_t WS_MODC = WS_MODX + al((size_t)2 * 16 * ADA * 4);
constexpr size_t WS_ROPE = WS_MODC + al((size_t)2 * ADA * 4);
constexpr size_t WS_XW = WS_ROPE + al(64 * 16 * 8);
constexpr size_t WS_H = WS_XW + al((size_t)NT * D * 4);
constexpr size_t WS_WIN0 = WS_H + al((size_t)NT * D * 2);
constexpr size_t WS_WOUT0 = WS_WIN0 + al((size_t)AB_INP * D * 2);
constexpr size_t WS_WQKV1 = WS_WOUT0 + al((size_t)D * D * 2);
constexpr size_t WS_WOUT1 = WS_WQKV1 + al((size_t)3 * D * D * 2);
constexpr size_t WS_WR = WS_WOUT1 + al((size_t)D * D * 2);
constexpr size_t WGU_BYTES = al((size_t)NEXPS * 512 * D * 2), WDN_BYTES = al((size_t)NEXPS * D * 256 * 2);
constexpr size_t WS_WGU = WS_WR + al((size_t)2 * NEXP * D * 2);
constexpr size_t WS_WDN = WS_WGU + 2 * WGU_BYTES;
constexpr size_t WS_T = WS_WDN + 2 * WDN_BYTES;
constexpr size_t T_QB = WS_T;
constexpr size_t T_KB = T_QB + al((size_t)NT * 256 * 2);
constexpr size_t T_VB = T_KB + al((size_t)NT * 256 * 2);
constexpr size_t T_GB = T_VB + al((size_t)NT * 512 * 2);
constexpr size_t T_UB = T_GB + al((size_t)NT * 512 * 2);
constexpr size_t T_LR = T_UB + al((size_t)NT * 512 * 2);
constexpr size_t T_OF = T_LR + al((size_t)NT * 32 * 4);
constexpr size_t T_OB = T_OF + al((size_t)NT * 512 * 2);
constexpr size_t T_CAT = T_OB + al((size_t)NT * 512 * 2);
constexpr size_t T_Y = T_CAT + al((size_t)NT * D * 2);
constexpr size_t T_GLA = T_Y + al((size_t)NT * D * 2);
constexpr int GI_A = 0, GI_QIN = 8192, GI_KOT = 16384, GI_VT = 24576, GI_DEC = 40960, GI_BYTES = 41216;
constexpr size_t T_END0 = T_GLA + al((size_t)BATCH * GLA_H * 2 * 36 * GI_BYTES + 1024);
constexpr size_t T_QKV = WS_T;
static_assert(T_QKV + (size_t)3 * NT * D * 2 <= T_CAT, "qkv overlay");
constexpr size_t M_AE = WS_T;
constexpr size_t M_AR = M_AE + al((size_t)NT * 8 * 4);
constexpr size_t M_AG = M_AR + al((size_t)NT * 8 * 4);
constexpr size_t M_TS = M_AG + al((size_t)NT * 8 * 4);
constexpr size_t M_ST = M_TS + al((size_t)NT * 8 * 4);
constexpr size_t M_HID = M_ST + al((size_t)PMAX * 4);
constexpr size_t M_OUT = M_HID + al((size_t)PMAX * 256 * 2);
constexpr int MO_LD = 1024;
constexpr size_t M_END = M_OUT + al((size_t)PMAX * D);
constexpr size_t WS_END = (M_END > T_END0 ? M_END : T_END0);
static_assert(WS_END <= (size_t)2040 * MiB, "workspace map must fit 2 GiB");

constexpr int CW_BAR = 4096;
constexpr int CW_CNT = 16384;
constexpr int CW_CUR = 16384 + 512;

constexpr int RING_BYTES = 131072;
constexpr int AUX_OFF = RING_BYTES, AUX_BYTES = 31744;
constexpr int MISC_OFF = AUX_OFF + AUX_BYTES;
constexpr int LDS_BYTES = MISC_OFF + 1024;
constexpr int NWAVES = 8, NTHREADS = 512;

#define LDS_WAIT() asm volatile("s_waitcnt lgkmcnt(0)" ::: "memory")
#define VM_WAIT() asm volatile("s_waitcnt vmcnt(0)" ::: "memory")

__device__ __forceinline__ unsigned f2bf(float f) { unsigned u = __builtin_bit_cast(unsigned, f); return (u + 0x7fffu + ((u >> 16) & 1u)) >> 16; }
__device__ __forceinline__ unsigned pk2(float lo, float hi) { return f2bf(lo) | (f2bf(hi) << 16); }
__device__ __forceinline__ float bf2f(unsigned short b) { return __builtin_bit_cast(float, (unsigned)b << 16); }
__device__ __forceinline__ float bflo(unsigned w) { return __builtin_bit_cast(float, w << 16); }
__device__ __forceinline__ float bfhi(unsigned w) { return __builtin_bit_cast(float, w & 0xffff0000u); }
__device__ __forceinline__ float wave_sum(float v) {
#pragma unroll
    for (int o = 1; o < 64; o <<= 1) v += __shfl_xor(v, o);
    return v;
}
__device__ __forceinline__ float sigmoidf_(float x) { return 1.0f / (1.0f + __expf(-x)); }
__device__ __forceinline__ float siluf_(float x) { return x / (1.0f + __expf(-x)); }

__device__ __forceinline__ void lds_barrier() { asm volatile("s_waitcnt lgkmcnt(0)" ::: "memory"); __builtin_amdgcn_s_barrier(); asm volatile("" ::: "memory"); }
#define XB_TMO      128
#define XB_XCNT(j)  (256  + 64 * (j))
#define XB_XSUB(j)  (1280 + 64 * (j))
#define XB_XGEN(j)  (2304 + 64 * (j))
#define XB_TOP      3328
#define XB_TOPGEN   3392
#define XCD_BAR_WORDS 3456
#define XB_SPIN_CAP (1u << 18)

__device__ __forceinline__ unsigned xb_ld(unsigned* p)              { return __hip_atomic_load(p, __ATOMIC_RELAXED, __HIP_MEMORY_SCOPE_AGENT); }
__device__ __forceinline__ unsigned xb_add(unsigned* p, unsigned v) { return __hip_atomic_fetch_add(p, v, __ATOMIC_RELAXED, __HIP_MEMORY_SCOPE_AGENT); }
__device__ __forceinline__ unsigned xb_xcc_id() { return (unsigned)__builtin_amdgcn_s_getreg((3 << 11) | 20) & 0xFu; }
#define XB_SPIN(cond, bar) do { unsigned _sp = 0; while (cond) { __builtin_amdgcn_s_sleep(1); \
    if ((++_sp & 255u) == 0u) { if (xb_ld(&(bar)[XB_TMO])) break; if (_sp > XB_SPIN_CAP) { atomicAdd(&(bar)[XB_TMO], 1u); break; } } } } while (0)

struct XcdBarrier { unsigned* bar; unsigned x; volatile LAS unsigned* st; };

__device__ __forceinline__ XcdBarrier xcd_barrier_post(unsigned* bar, volatile LAS unsigned* st) {
    XcdBarrier b; b.bar = bar; b.x = xb_xcc_id(); b.st = st;
    if (threadIdx.x == 0) (void)xb_add(&bar[XB_XCNT(b.x)], 1u);
    return b;
}
__device__ __forceinline__ void xcd_barrier_complete(unsigned* bar, unsigned x, unsigned& nloc, unsigned& nx) {
    const unsigned G = gridDim.x * gridDim.y * gridDim.z;
    unsigned sum, cnt, mine, sp = 0u;
    for (;;) {
        sum = 0u; cnt = 0u; mine = 0u;
#pragma unroll
        for (unsigned j = 0; j < 16; ++j) { const unsigned c = xb_ld(&bar[XB_XCNT(j)]); sum += c; cnt += (c > 0u) ? 1u : 0u; mine = (j == x) ? c : mine; }
        if (sum == G) break;
        __builtin_amdgcn_s_sleep(1);
        if ((++sp & 255u) == 0u) { if (xb_ld(&bar[XB_TMO])) break; if (sp > XB_SPIN_CAP) { atomicAdd(&bar[XB_TMO], 1u); break; } }
    }
    nloc = mine > 0u ? mine : 1u; nx = cnt > 0u ? cnt : 1u;
}
__device__ __forceinline__ void xcd_barrier(const XcdBarrier& b) {
    asm volatile("s_waitcnt vmcnt(0)" ::: "memory");
    __syncthreads();
    if (threadIdx.x == 0) {
        unsigned* bar = b.bar;
        __builtin_amdgcn_s_waitcnt(0);
        unsigned nloc = b.st[0], nx = b.st[1];
        if (nloc == 0u) { xcd_barrier_complete(bar, b.x, nloc, nx); b.st[0] = nloc; b.st[1] = nx; }
        const unsigned old = xb_add(&bar[XB_XSUB(b.x)], 1u);
        const unsigned gen = old / nloc;
        if (old + 1u == (gen + 1u) * nloc) {
            __builtin_amdgcn_fence(__ATOMIC_RELEASE, "agent");
            asm volatile("s_waitcnt vmcnt(0)" ::: "memory");
            const unsigned og = xb_add(&bar[XB_TOP], 1u);
            const unsigned tg = og / nx;
            if (og + 1u == (tg + 1u) * nx) xb_add(&bar[XB_TOPGEN], 1u);
            else XB_SPIN(xb_ld(&bar[XB_TOPGEN]) == tg, bar);
            __builtin_amdgcn_fence(__ATOMIC_ACQUIRE, "agent");
            xb_add(&bar[XB_XGEN(b.x)], 1u);
            asm volatile("s_waitcnt vmcnt(0)" ::: "memory");
        } else {
            XB_SPIN(xb_ld(&bar[XB_XGEN(b.x)]) == gen, bar);
            __builtin_amdgcn_fence(__ATOMIC_ACQUIRE, "agent");
            asm volatile("s_waitcnt vmcnt(0)" ::: "memory");
        }
    }
    __syncthreads();
}

namespace pg8 {
constexpr int BM = 256, BK = 64, HALF = 128, HTB = HALF * BK * 2, STAGE_BYTES = 8 * HTB, NXCD = 8, WGM = 8;
__host__ __device__ __forceinline__ int lds_byte(int r, int c) { const int st = (r >> 4) * 2 + (c >> 5), rr = r & 15, cc = c & 31, ob = rr * 64 + cc * 2; return st * 1024 + (ob ^ (((ob >> 9) & 1) << 5)); }
__host__ __device__ __forceinline__ void stage_rc(int b, int& R, int& C) { const int st = b / 1024, sb = b % 1024, swz = sb ^ (((sb >> 9) & 1) << 5); R = (st >> 1) * 16 + swz / 64; C = (st & 1) * 32 + (swz % 64) / 2; }
__host__ __device__ __forceinline__ int perm32(int rho) { const int n = rho >> 4, i = rho & 15; return 8 * (i >> 2) + 4 * n + (i & 3); }

struct Unit { int a, b, orow, ocol, aux; };

__device__ __forceinline__ bool static_order(int L, int nM, int nN, int& pm, int& pn) {
    const int nwg = nM * nN; if (L >= nwg) return false;
    int wgid = L; { const int q = nwg / NXCD, r = nwg % NXCD, xcd = wgid % NXCD, off = wgid / NXCD; wgid = (xcd < r ? xcd * (q + 1) : r * (q + 1) + (xcd - r) * q) + off; }
    const int nig = WGM * nN, gid = wgid / nig, fm = gid * WGM, gsz = (nM - fm) < WGM ? (nM - fm) : WGM;
    pm = fm + ((wgid % nig) % gsz); pn = (wgid % nig) / gsz; return true;
}

template <class Epi, class Sched, bool ALIGN_EPI>
__device__ __forceinline__ void gemm_phase(LAS unsigned char* lds, const int K, const Sched& S, const Epi& E) {
    const int tid = threadIdx.x, wid = __builtin_amdgcn_readfirstlane(tid >> 6), lane = tid & 63, wr = wid >> 2, wc = wid & 3, fr = lane & 15, fq = lane >> 4;
    const int nt = K / BK;
    int Rr[2], Cc[2]; unsigned voffB[2];
#pragma unroll
    for (int i = 0; i < 2; ++i) { int R, C; stage_rc(tid * 16 + i * 8192, R, C); Rr[i] = R; Cc[i] = C; const int Rb = Epi::PERM ? ((R & ~31) + perm32(R & 31)) : R; voffB[i] = (unsigned)(Rb * K + C) * 2u; }
    const size_t kstep = (size_t)(BK * 2);
    const size_t hstepB = (size_t)HALF * K * 2;
    const unsigned ldsw = (unsigned)wid * 1024u;
    const int aoff = lds_byte(wr * 64 + fr, fq * 8), boff = lds_byte(wc * 32 + fr, fq * 8);
#define PG8_SA(b, h) (((b) * 2 + (h)) * HTB)
#define PG8_SB(b, h) ((4 + (b) * 2 + (h)) * HTB)
#define PG8_STAGE(bufoff, gbase, voff) do { _Pragma("unroll") for (int _i = 0; _i < 2; ++_i) \
        __builtin_amdgcn_global_load_lds((const unsigned*)((const char*)(gbase) + (voff)[_i]), (LAS unsigned*)(lds + (bufoff) + ldsw + _i * 8192), 16, 0, 0); } while (0)
#define PG8_LDA(dst, b, h) do { _Pragma("unroll") for (int m = 0; m < 4; ++m) _Pragma("unroll") for (int k = 0; k < 2; ++k) dst[m][k] = *(const LAS bf16x8*)(lds + PG8_SA(b, h) + aoff + m * 2048 + k * 1024); } while (0)
#define PG8_LDB(dst, b, h) do { _Pragma("unroll") for (int n = 0; n < 2; ++n) _Pragma("unroll") for (int k = 0; k < 2; ++k) dst[n][k] = *(const LAS bf16x8*)(lds + PG8_SB(b, h) + boff + n * 2048 + k * 1024); } while (0)
#define PG8_MMA(ai, bj, At, Bt) do { __builtin_amdgcn_s_setprio(1); _Pragma("unroll") for (int m = 0; m < 4; ++m) _Pragma("unroll") for (int n = 0; n < 2; ++n) _Pragma("unroll") for (int k = 0; k < 2; ++k) \
        acc[ai][bj][m][n] = __builtin_amdgcn_mfma_f32_16x16x32_bf16(Bt[n][k], At[m][k], acc[ai][bj][m][n], 0, 0, 0); __builtin_amdgcn_s_setprio(0); } while (0)
#define PG8_WAIT_V(n) asm volatile("s_waitcnt vmcnt(" #n ")" ::: "memory")
#define PG8_WAIT_L(n) asm volatile("s_waitcnt lgkmcnt(" #n ")" ::: "memory")
#define PG8_BAR __builtin_amdgcn_s_barrier()
#define PG8_SCHED __builtin_amdgcn_sched_barrier(0)
    Unit cur, nxt; int ui = 0;
    if (!S.next(0, cur)) return;
    f32x4 acc[2][2][4][2];
#pragma unroll
    for (int a = 0; a < 2; ++a)
#pragma unroll
        for (int b = 0; b < 2; ++b)
#pragma unroll
            for (int m = 0; m < 4; ++m)
#pragma unroll
                for (int n = 0; n < 2; ++n) acc[a][b][m][n] = (f32x4){0.f, 0.f, 0.f, 0.f};
    bf16x8 At[4][2], B0[2][2], B1[2][2];
    unsigned co0[2], co1[2], no0[2], no1[2];
    S.a_off(cur, Rr, Cc, co0, co1);
    const char* const Ab = S.a_base();
    const char* cB = S.b_ptr(cur);
    PG8_STAGE(PG8_SB(0, 0), cB, voffB); PG8_STAGE(PG8_SB(0, 1), cB + hstepB, voffB); PG8_STAGE(PG8_SA(0, 0), Ab, co0); PG8_STAGE(PG8_SA(0, 1), Ab, co1);
    if (wr == 1) PG8_BAR;
    PG8_WAIT_V(2); PG8_BAR;
    PG8_STAGE(PG8_SB(1, 0), cB + kstep, voffB); PG8_STAGE(PG8_SA(1, 0), Ab + kstep, co0); PG8_STAGE(PG8_SB(1, 1), cB + hstepB + kstep, voffB);
    PG8_WAIT_V(6); PG8_BAR;
    for (;;) {
        const bool has_next = S.next(ui + 1, nxt);
        const char* nB = has_next ? S.b_ptr(nxt) : cB;
#pragma nounroll
        for (int t = 0; t < nt; t += 2) {
            const bool last = (t == nt - 2);
            if (last) { if (has_next) S.a_off(nxt, Rr, Cc, no0, no1); else { no0[0] = co0[0]; no0[1] = co0[1]; no1[0] = co1[0]; no1[1] = co1[1]; } }
            const char* a1 = Ab + (size_t)(t + 1) * kstep;
            const char* a2 = last ? Ab : Ab + (size_t)(t + 2) * kstep; const char* b2 = last ? nB : cB + (size_t)(t + 2) * kstep;
            const char* a3 = a2 + kstep; const char* b3 = b2 + kstep;
            unsigned x0[2], x1[2];
            x0[0] = last ? no0[0] : co0[0]; x0[1] = last ? no0[1] : co0[1]; x1[0] = last ? no1[0] : co1[0]; x1[1] = last ? no1[1] : co1[1];
            PG8_LDB(B0, 0, 0); PG8_LDB(B1, 0, 1); PG8_SCHED; PG8_LDA(At, 0, 0); PG8_STAGE(PG8_SA(1, 1), a1, co1);
            PG8_WAIT_V(8); PG8_WAIT_L(0); PG8_BAR; PG8_MMA(0, 0, At, B0); PG8_MMA(0, 1, At, B1); PG8_BAR; PG8_SCHED;
            PG8_LDA(At, 0, 1); PG8_STAGE(PG8_SB(0, 0), b2, voffB); PG8_STAGE(PG8_SB(0, 1), b2 + hstepB, voffB); PG8_STAGE(PG8_SA(0, 0), a2, x0);
            PG8_WAIT_V(8); PG8_WAIT_L(0); PG8_BAR; PG8_MMA(1, 0, At, B0); PG8_MMA(1, 1, At, B1); PG8_BAR; PG8_SCHED;
            PG8_LDB(B0, 1, 0); PG8_LDB(B1, 1, 1); PG8_SCHED; PG8_LDA(At, 1, 0); PG8_STAGE(PG8_SA(0, 1), a2, x1);
            PG8_WAIT_V(8); PG8_WAIT_L(0); PG8_BAR; PG8_MMA(0, 0, At, B0); PG8_MMA(0, 1, At, B1); PG8_BAR; PG8_SCHED;
            PG8_LDA(At, 1, 1); PG8_STAGE(PG8_SB(1, 0), b3, voffB); PG8_STAGE(PG8_SB(1, 1), b3 + hstepB, voffB); PG8_STAGE(PG8_SA(1, 0), a3, x0);
            PG8_WAIT_V(8); PG8_WAIT_L(0); PG8_BAR; PG8_MMA(1, 0, At, B0); PG8_MMA(1, 1, At, B1); PG8_BAR; PG8_SCHED;
        }
        if constexpr (ALIGN_EPI) { if (wr == 0) PG8_BAR; }
        if constexpr (!Epi::AFTER_DRAIN) { E(acc, cur, wr, wc, fr, fq); }
        if (!has_next) break;
#pragma unroll
        for (int a = 0; a < 2; ++a)
#pragma unroll
            for (int b = 0; b < 2; ++b)
#pragma unroll
                for (int m = 0; m < 4; ++m)
#pragma unroll
                    for (int n = 0; n < 2; ++n) acc[a][b][m][n] = (f32x4){0.f, 0.f, 0.f, 0.f};
        cur = nxt; cB = nB; co0[0] = no0[0]; co0[1] = no0[1]; co1[0] = no1[0]; co1[1] = no1[1]; ++ui;
        if constexpr (ALIGN_EPI) { if (wr == 1) PG8_BAR; }
    }
    PG8_WAIT_V(0);
    if constexpr (!ALIGN_EPI) { if (wr == 0) PG8_BAR; }
    PG8_BAR;
    if constexpr (Epi::AFTER_DRAIN) { E.fused(acc, cur, wr, wc, fr, fq, lds, wid, lane); }
#undef PG8_SA
#undef PG8_SB
#undef PG8_STAGE
#undef PG8_LDA
#undef PG8_LDB
#undef PG8_MMA
#undef PG8_WAIT_V
#undef PG8_WAIT_L
#undef PG8_BAR
#undef PG8_SCHED
}
}
using pg8::Unit;

__device__ __forceinline__ unsigned cvt_pk_bf16(float lo, float hi) { unsigned r; asm volatile("v_cvt_pk_bf16_f32 %0, %1, %2" : "=v"(r) : "v"(lo), "v"(hi)); return r; }

struct SchedDense {
    const char* A; const char* Bt; int K; int nM0, nN0, nM1, nN1, pn1off; int G, c;
    __device__ __forceinline__ bool next(int i, Unit& u) const {
        const int L = i * G + c; int pm, pn;
        const int n0 = nM0 * nN0;
        if (L < n0) { pg8::static_order(L, nM0, nN0, pm, pn); }
        else { if (!pg8::static_order(L - n0, nM1, nN1, pm, pn)) return false; pm += nM0; pn += pn1off; }
        u.a = pm; u.b = pn * 256; u.orow = pm * 256; u.ocol = pn * 256; u.aux = pn; return true;
    }
    __device__ __forceinline__ const char* a_base() const { return A; }
    __device__ __forceinline__ const char* b_ptr(const Unit& u) const { return Bt + (size_t)u.b * K * 2; }
    __device__ __forceinline__ void a_off(const Unit& u, const int (&R)[2], const int (&C)[2], unsigned (&o0)[2], unsigned (&o1)[2]) const {
#pragma unroll
        for (int i = 0; i < 2; ++i) { o0[i] = (unsigned)((u.a * 256 + R[i]) * K + C[i]) * 2u; o1[i] = o0[i] + (unsigned)(128 * K * 2); }
    }
};

struct EpiBf16 {
    static constexpr bool PERM = true, AFTER_DRAIN = false;
    bf16_t* O; int ldc; int split_cols; size_t split_stride; float scale0 = 1.0f;
    __device__ __forceinline__ void operator()(const f32x4 (&acc)[2][2][4][2], const Unit& u, int wr, int wc, int fr, int fq) const {
        const int lane = fr + 16 * fq; const int srcb = ((lane >> 2) + 16 * (lane & 3)) << 2;
        const int row0 = u.orow + wr * 64 + (lane >> 2); int colt = u.ocol; bf16_t* base = O;
        float sc = 1.0f;
        if (split_cols) { const int t = colt / split_cols; base += (size_t)t * split_stride; colt -= t * split_cols; if (t == 0) sc = scale0; }
        const int col0 = colt + wc * 32 + 8 * (lane & 3);
#pragma unroll
        for (int ai = 0; ai < 2; ++ai)
#pragma unroll
            for (int m = 0; m < 4; ++m) { bf16_t* rowp = base + (size_t)(row0 + ai * 128 + m * 16) * ldc + col0;
#pragma unroll
                for (int bj = 0; bj < 2; ++bj) { const f32x4 v0 = acc[ai][bj][m][0] * sc, v1 = acc[ai][bj][m][1] * sc;
                    u32x4 w; w.x = cvt_pk_bf16(v0[0], v0[1]); w.y = cvt_pk_bf16(v0[2], v0[3]); w.z = cvt_pk_bf16(v1[0], v1[1]); w.w = cvt_pk_bf16(v1[2], v1[3]);
                    u32x4 t; t.x = (unsigned)__builtin_amdgcn_ds_bpermute(srcb, (int)w.x); t.y = (unsigned)__builtin_amdgcn_ds_bpermute(srcb, (int)w.y); t.z = (unsigned)__builtin_amdgcn_ds_bpermute(srcb, (int)w.z); t.w = (unsigned)__builtin_amdgcn_ds_bpermute(srcb, (int)w.w);
                    *(u32x4*)(rowp + bj * 128) = t; } }
    }
};
struct EpiF8 {
    static constexpr bool PERM = true, AFTER_DRAIN = false;
    unsigned char* O;
    __device__ __forceinline__ int nst(const Unit&, int) const { return 16; }
    __device__ __forceinline__ void operator()(const f32x4 (&acc)[2][2][4][2], const Unit& u, int wr, int wc, int fr, int fq) const {
        const int lane = fr + 16 * fq; const int srcb = ((lane >> 2) + 16 * (lane & 3)) << 2;
        const int row0 = u.orow + wr * 64 + (lane >> 2), col0 = u.ocol + wc * 32 + 8 * (lane & 3);
#pragma unroll
        for (int ai = 0; ai < 2; ++ai)
#pragma unroll
            for (int m = 0; m < 4; ++m) { unsigned char* rowp = O + (size_t)(row0 + ai * 128 + m * 16) * D + col0;
#pragma unroll
                for (int bj = 0; bj < 2; ++bj) { const f32x4 v0 = acc[ai][bj][m][0] * F8_SCALE, v1 = acc[ai][bj][m][1] * F8_SCALE;
                    int w0 = __builtin_amdgcn_cvt_pk_fp8_f32(v0[0], v0[1], 0, false); w0 = __builtin_amdgcn_cvt_pk_fp8_f32(v0[2], v0[3], w0, true);
                    int w1 = __builtin_amdgcn_cvt_pk_fp8_f32(v1[0], v1[1], 0, false); w1 = __builtin_amdgcn_cvt_pk_fp8_f32(v1[2], v1[3], w1, true);
                    u32x2 t; t.x = (unsigned)__builtin_amdgcn_ds_bpermute(srcb, w0); t.y = (unsigned)__builtin_amdgcn_ds_bpermute(srcb, w1);
                    *(u32x2*)(rowp + bj * 128) = t; } }
    }
};
struct EpiInproj {
    static constexpr bool PERM = false, AFTER_DRAIN = false;
    bf16_t *qb, *kb, *vb, *gb, *ub; float* lr; const f32x2* rope;
    __device__ __forceinline__ void operator()(const f32x4 (&acc)[2][2][4][2], const Unit& u, int wr, int wc, int fr, int fq) const {
        const int pn = u.aux; const int row0 = u.orow + wr * 64 + fr;
        if (pn <= 1) {
            bf16_t* dst = pn == 0 ? qb : kb; const float sc = pn == 0 ? 0.125f : 1.0f;
#pragma unroll
            for (int ai = 0; ai < 2; ++ai)
#pragma unroll
                for (int m = 0; m < 4; ++m) {
                    const int row = row0 + ai * 128 + m * 16; const bool lat = row < NX;
                    const int s = row & (SEQ - 1); const int pos = (wc & 1) ? (s & 63) : (s >> 6);
                    f32x2 cs[4];
                    if (lat) {
#pragma unroll
                        for (int e = 0; e < 4; ++e) cs[e] = rope[pos * 16 + 4 * fq + e];
                    } else {
#pragma unroll
                        for (int e = 0; e < 4; ++e) cs[e] = (f32x2){1.f, 0.f};
                    }
#pragma unroll
                    for (int bj = 0; bj < 2; ++bj) {
                        const f32x4 u1 = acc[ai][bj][m][0], u2 = acc[ai][bj][m][1]; f32x4 o1, o2;
#pragma unroll
                        for (int e = 0; e < 4; ++e) { o1[e] = (u1[e] * cs[e].x - u2[e] * cs[e].y) * sc; o2[e] = (u1[e] * cs[e].y + u2[e] * cs[e].x) * sc; }
                        bf16_t* p = dst + (size_t)row * 256 + bj * 128 + wc * 32 + 4 * fq;
                        u32x2 w1, w2; w1.x = cvt_pk_bf16(o1[0], o1[1]); w1.y = cvt_pk_bf16(o1[2], o1[3]); w2.x = cvt_pk_bf16(o2[0], o2[1]); w2.y = cvt_pk_bf16(o2[2], o2[3]);
                        *(u32x2*)p = w1; *(u32x2*)(p + 16) = w2;
                    }
                }
        } else if (pn <= 5) {
            bf16_t* dst = pn <= 3 ? vb : gb; const int cb = (pn & 1) ? 256 : 0;
#pragma unroll
            for (int ai = 0; ai < 2; ++ai)
#pragma unroll
                for (int m = 0; m < 4; ++m) { const int row = row0 + ai * 128 + m * 16;
#pragma unroll
                    for (int bj = 0; bj < 2; ++bj)
#pragma unroll
                        for (int n = 0; n < 2; ++n) { const f32x4 v = acc[ai][bj][m][n]; u32x2 w; w.x = cvt_pk_bf16(v[0], v[1]); w.y = cvt_pk_bf16(v[2], v[3]);
                            *(u32x2*)(dst + (size_t)row * 512 + cb + bj * 128 + wc * 32 + n * 16 + 4 * fq) = w; } }
        } else if (pn <= 9) {
            const int cb = (pn - 6) * 128;
#pragma unroll
            for (int ai = 0; ai < 2; ++ai)
#pragma unroll
                for (int m = 0; m < 4; ++m) { const int row = row0 + ai * 128 + m * 16;
#pragma unroll
                    for (int n = 0; n < 2; ++n) { const f32x4 a = acc[ai][0][m][n], b = acc[ai][1][m][n]; f32x4 o;
#pragma unroll
                        for (int e = 0; e < 4; ++e) o[e] = a[e] * sigmoidf_(b[e]);
                        u32x2 w; w.x = cvt_pk_bf16(o[0], o[1]); w.y = cvt_pk_bf16(o[2], o[3]);
                        *(u32x2*)(ub + (size_t)row * 512 + cb + wc * 32 + n * 16 + 4 * fq) = w; } }
        } else {
            if (wc == 0) {
#pragma unroll
                for (int ai = 0; ai < 2; ++ai)
#pragma unroll
                    for (int m = 0; m < 4; ++m) { const int row = row0 + ai * 128 + m * 16;
#pragma unroll
                        for (int n = 0; n < 2; ++n) *(f32x4*)(lr + (size_t)row * 32 + n * 16 + 4 * fq) = acc[ai][0][m][n]; }
            }
        }
    }
};

struct Args { const float* in[32]; float* out; unsigned char* ws; int ph_lo, ph_hi; };

struct Frame {
    LAS unsigned char* lds; volatile LAS unsigned* MISC; unsigned* ctl; unsigned char* ws;
    int tid, lane, wave, G, vcu;
};

__device__ __forceinline__ void cvt_item(const float* __restrict__ src, int ld, int col0, int ncols, int k0, bf16_t* dst, int ldd, int drow0, LAS unsigned* T, int lane) {
    const bool okc = lane < ncols;
    const float* p = src + (size_t)k0 * ld + col0 + (okc ? lane : 0);
    float v[64];
#pragma unroll
    for (int k = 0; k < 64; ++k) v[k] = __builtin_nontemporal_load(p + (size_t)k * ld);
#pragma unroll
    for (int kp = 0; kp < 32; ++kp) T[lane * 33 + kp] = okc ? pk2(v[2 * kp], v[2 * kp + 1]) : 0u;
    LDS_WAIT(); asm volatile("" ::: "memory");
    const int c = lane & 7;
#pragma unroll
    for (int it = 0; it < 8; ++it) { const int n = (lane >> 3) + 8 * it;
        u32x4 o; o.x = T[n * 33 + 4 * c]; o.y = T[n * 33 + 4 * c + 1]; o.z = T[n * 33 + 4 * c + 2]; o.w = T[n * 33 + 4 * c + 3];
        if (n < ncols) __builtin_nontemporal_store(o, (u32x4*)(dst + (size_t)(drow0 + n) * ldd + k0 + 8 * c)); }
    LDS_WAIT(); asm volatile("" ::: "memory");
}
__device__ __forceinline__ void cvt_matrix_item(const float* src, int ld, int col0, int ncols, int K, bf16_t* dst, int drow0, int item, LAS unsigned* T, int lane) {
    const int ncg = (ncols + 63) >> 6; const int kt = item / ncg, cg = item - kt * ncg;
    const int nc = ncols - cg * 64 < 64 ? ncols - cg * 64 : 64;
    cvt_item(src, ld, col0 + cg * 64, nc, kt * 64, dst, K, drow0 + cg * 64, T, lane);
}

constexpr int MOE_CVT_ITEMS = NEXPS * 192;
__device__ __forceinline__ void cvt_moe_item(const Args& a, int layer, int item, unsigned char* ws, LAS unsigned* T, int lane) {
    const int e = item / 192, r = item - e * 192;
    bf16_t* wgu = (bf16_t*)(ws + WS_WGU + (size_t)layer * WGU_BYTES) + (size_t)e * 512 * D; bf16_t* wdn = (bf16_t*)(ws + WS_WDN + (size_t)layer * WDN_BYTES) + (size_t)e * D * 256;
    if (r < 128) {
        const int kt = r >> 3, gi = r & 7; const int up = gi >> 2, g4 = gi & 3;
        const float* src = e < NEXP ? (up ? a.in[27] : a.in[26]) + ((size_t)layer * NEXP + e) * D * DEXP : (up ? a.in[30] : a.in[29]) + (size_t)layer * D * DEXP;
        cvt_item(src, DEXP, 64 * g4, 64, kt * 64, wgu, D, 256 * (g4 >> 1) + 64 * (g4 & 1) + 128 * up, T, lane);
    } else {
        const int q = r - 128; const int kt = q >> 4, cg = q & 15;
        const float* src = e < NEXP ? a.in[28] + ((size_t)layer * NEXP + e) * DEXP * D : a.in[31] + (size_t)layer * DEXP * D;
        cvt_item(src, D, 64 * cg, 64, kt * 64, wdn, DEXP, 64 * cg, T, lane);
    }
}

__device__ __forceinline__ float row_rms_scale(const f32x4 (&v)[4]) {
    float s = 0.f;
#pragma unroll
    for (int j = 0; j < 4; ++j) s += (v[j].x * v[j].x + v[j].y * v[j].y) + (v[j].z * v[j].z + v[j].w * v[j].w);
    return rsqrtf(wave_sum(s) * (1.0f / D) + RMS_EPS);
}
__device__ __forceinline__ f32x4 ld4(const float* p) { return *(const f32x4*)p; }

struct RowPhase {
    const float* xin_lat; const float* xin_ctx;
    float* xout_lat; float* xout_ctx;
    int nrows;
    int ysrc; const bf16_t* y;
    const unsigned char* mo8; const int* tslot; const float* tgate; int sharedbase;
    const float* gpost; const float* modx; const float* modc; int gate_chunk;
    bool doH; bf16_t* H; const float* gpre; int sc_chunk, sh_chunk; const float* modxH; const float* modcH;
};
__device__ __forceinline__ void row_phase(const Frame& F, const RowPhase& P) {
    const int gw = F.vcu * NWAVES + F.wave, NGW = F.G * NWAVES, lane = F.lane;
    for (int row = gw; row < P.nrows; row += NGW) {
        const bool lat = row < NX; const int b = lat ? (row >> 11) : 0;
        const float* mod = lat ? P.modx + (size_t)b * ADA : P.modc;
        const float* xr = lat ? P.xin_lat + (size_t)row * D : P.xin_ctx + (size_t)(row - NX) * D;
        f32x4 x[4];
#pragma unroll
        for (int j = 0; j < 4; ++j) x[j] = ld4(xr + 4 * lane + 256 * j);
        if (P.ysrc) {
            f32x4 y[4];
            if (P.ysrc == 1) {
#pragma unroll
                for (int j = 0; j < 4; ++j) { const u32x2 w = __builtin_nontemporal_load((const u32x2*)(P.y + (size_t)row * D + 4 * lane + 256 * j)); y[j] = (f32x4){bflo(w.x), bfhi(w.x), bflo(w.y), bfhi(w.y)}; }
            } else {
#pragma unroll
                for (int j = 0; j < 4; ++j) { const int w = __builtin_nontemporal_load((const int*)(P.mo8 + (size_t)(P.sharedbase + row) * D + 4 * lane + 256 * j)); const f32x2 lo = __builtin_amdgcn_cvt_pk_f32_fp8(w, false), hi = __builtin_amdgcn_cvt_pk_f32_fp8(w, true); y[j] = (f32x4){lo.x, lo.y, hi.x, hi.y} * F8_INV; }
#pragma unroll
                for (int k = 0; k < TOPK; ++k) { const int sl = P.tslot[(size_t)row * 8 + k]; const float g = P.tgate[(size_t)row * 8 + k] * F8_INV;
#pragma unroll
                    for (int j = 0; j < 4; ++j) { const int w = __builtin_nontemporal_load((const int*)(P.mo8 + (size_t)sl * D + 4 * lane + 256 * j)); const f32x2 lo = __builtin_amdgcn_cvt_pk_f32_fp8(w, false), hi = __builtin_amdgcn_cvt_pk_f32_fp8(w, true);
                        y[j].x += g * lo.x; y[j].y += g * lo.y; y[j].z += g * hi.x; y[j].w += g * hi.y; } }
            }
            const float rs = row_rms_scale(y);
#pragma unroll
            for (int j = 0; j < 4; ++j) { const f32x4 gp = ld4(P.gpost + 4 * lane + 256 * j), gt = ld4(mod + P.gate_chunk * D + 4 * lane + 256 * j); x[j] = x[j] + gt * (y[j] * rs * gp); }
            float* xo = lat ? P.xout_lat + (size_t)row * D : P.xout_ctx + (size_t)(row - NX) * D;
#pragma unroll
            for (int j = 0; j < 4; ++j) *(f32x4*)(xo + 4 * lane + 256 * j) = x[j];
        }
        if (P.doH) {
            const float rs = row_rms_scale(x); const float* modh = lat ? P.modxH + (size_t)b * ADA : P.modcH;
#pragma unroll
            for (int j = 0; j < 4; ++j) { const f32x4 gp = ld4(P.gpre + 4 * lane + 256 * j), sc = ld4(modh + P.sc_chunk * D + 4 * lane + 256 * j), sh = ld4(modh + P.sh_chunk * D + 4 * lane + 256 * j);
                const f32x4 h = x[j] * rs * gp * (sc + 1.0f) + sh; u32x2 w; w.x = pk2(h.x, h.y); w.y = pk2(h.z, h.w);
                *(u32x2*)(P.H + (size_t)row * D + 4 * lane + 256 * j) = w; }
        }
    }
}


constexpr int FILL_PER_WAVE_S = 3;
constexpr int F0_P2 = 208 * 8 * FILL_PER_WAVE_S, F0_P5 = 192 * 8 * FILL_PER_WAVE_S, F0_P7 = MOE_CVT_ITEMS - F0_P2 - F0_P5;
constexpr int F0_BULK = MOE_CVT_ITEMS - F0_P2 - F0_P5 - F0_P7;
static_assert(F0_BULK >= 0, "fill plan");
constexpr int F1_P12 = 128 * 8 * FILL_PER_WAVE_S;
__device__ __forceinline__ void cvt_moe_range(const Frame& F, const Args& a, int layer, int lo, int hi, int rank, int nranks) {
    LAS unsigned* T = (LAS unsigned*)F.lds + F.wave * (64 * 33);
    for (int it = lo + rank * NWAVES + F.wave; it < hi; it += nranks * NWAVES) cvt_moe_item(a, layer, it, F.ws, T, F.lane);
}
__device__ __forceinline__ void fill1_ranges(const Frame& F, int ntr0, int& s9, int& s10) {
    const int nu9 = (ntr0 + NT / 256) * 2, nu10 = (ntr0 + NT / 256) * 4;
    const int l9 = (nu9 % F.G) ? F.G - nu9 % F.G : 0, l10 = (nu10 % F.G) ? F.G - nu10 % F.G : 0;
    s9 = l9 * NWAVES * FILL_PER_WAVE_S; s10 = l10 * NWAVES * (FILL_PER_WAVE_S / 3);
    if (F.G != 256) { s9 = 0; s10 = 0; }
}

__device__ __forceinline__ void p0_ada(const Frame& F, const Args& a) {
    LAS float* sc = (LAS float*)F.lds;
    if ((int)blockIdx.x >= 96) return;
    for (int i = F.tid; i < 17 * D; i += NTHREADS) { const int r = i >> 10, k = i & 1023; const float v = r < 16 ? a.in[1][r * D + k] : a.in[3][k]; sc[i] = siluf_(v); }
    __syncthreads();
    const int item = blockIdx.x; const int layer = item / 48, cg = item % 48;
    const int cq = F.tid & 31, kl = F.tid >> 5;
    const float* W = a.in[4] + (size_t)layer * D * ADA + cg * 128 + cq * 4;
    f32x4 acc[17];
#pragma unroll
    for (int r = 0; r < 17; ++r) acc[r] = (f32x4){0.f, 0.f, 0.f, 0.f};
    for (int k = kl; k < D; k += 16) {
        const f32x4 w = ld4(W + (size_t)k * ADA);
#pragma unroll
        for (int r = 0; r < 17; ++r) { const float s = sc[r * D + k]; acc[r] = acc[r] + w * s; }
    }
#pragma unroll
    for (int r = 0; r < 17; ++r) { acc[r].x += __shfl_xor(acc[r].x, 32); acc[r].y += __shfl_xor(acc[r].y, 32); acc[r].z += __shfl_xor(acc[r].z, 32); acc[r].w += __shfl_xor(acc[r].w, 32); }
    __syncthreads();
    LAS f32x4* red = (LAS f32x4*)F.lds;
    if (F.lane < 32) {
#pragma unroll
        for (int r = 0; r < 17; ++r) red[(F.wave * 17 + r) * 32 + cq] = acc[r];
    }
    __syncthreads();
    for (int i = F.tid; i < 17 * 32; i += NTHREADS) { const int r = i >> 5, q = i & 31; f32x4 s = red[r * 32 + q];
#pragma unroll
        for (int w = 1; w < 8; ++w) s = s + red[(w * 17 + r) * 32 + q];
        const int col = cg * 128 + q * 4; s = s + ld4(a.in[5] + (size_t)layer * ADA + col);
        float* dst = r < 16 ? (float*)(F.ws + WS_MODX) + ((size_t)layer * 16 + r) * ADA + col : (float*)(F.ws + WS_MODC) + (size_t)layer * ADA + col;
        *(f32x4*)dst = s; }
    __syncthreads();
}

__device__ __forceinline__ void p0_convert(const Frame& F, const Args& a) {
    LAS unsigned* T = (LAS unsigned*)(F.lds + 70 * 1024) + F.wave * (64 * 33);
    const int gw = F.vcu * NWAVES + F.wave, NGW = F.G * NWAVES, lane = F.lane;
    bf16_t* win0 = (bf16_t*)(F.ws + WS_WIN0); bf16_t* wout0 = (bf16_t*)(F.ws + WS_WOUT0); bf16_t* wqkv1 = (bf16_t*)(F.ws + WS_WQKV1); bf16_t* wout1 = (bf16_t*)(F.ws + WS_WOUT1); bf16_t* wr = (bf16_t*)(F.ws + WS_WR);
    constexpr int I_IN = 16 * (4 + 4 + 8 + 8 + 1 + 16);
    constexpr int I_SQ = 16 * 16, I_QKV = 16 * 48, I_R = 16 * 4;
    constexpr int NIT = I_IN + I_SQ + I_QKV + I_SQ + 2 * I_R;
    const int nbulk0 = F.G == 256 ? F0_BULK : MOE_CVT_ITEMS;
    for (int it = gw; it < NIT + nbulk0; it += NGW) {
        int r = it;
        if (r < I_IN) {
            const int kt = r & 15, g = r >> 4; int col0, nc = 64, drow;
            if (g < 24) { col0 = 64 * g; drow = 64 * g; }
            else if (g == 24) { col0 = 1536; nc = 32; drow = 2560; }
            else { const int s = g - 25; const int isb = s >> 3, q = s & 7;
                col0 = 1568 + 512 * isb + 64 * q; drow = 1536 + 256 * (q >> 1) + 128 * isb + 64 * (q & 1); }
            cvt_item(a.in[10], AB_IN, col0, nc, kt * 64, win0, D, drow, T, lane); continue; }
        r -= I_IN;
        if (r < I_SQ) { cvt_matrix_item(a.in[11], D, 0, D, D, wout0, 0, r, T, lane); continue; } r -= I_SQ;
        if (r < I_QKV) { cvt_matrix_item(a.in[21], 3 * D, 0, 3 * D, D, wqkv1, 0, r, T, lane); continue; } r -= I_QKV;
        if (r < I_SQ) { cvt_matrix_item(a.in[22], D, 0, D, D, wout1, 0, r, T, lane); continue; } r -= I_SQ;
        if (r < 2 * I_R) { const int l = r / I_R; cvt_matrix_item(a.in[24] + (size_t)l * D * NEXP, NEXP, 0, NEXP, D, wr + (size_t)l * NEXP * D, 0, r % I_R, T, lane); continue; } r -= 2 * I_R;
        cvt_moe_item(a, 0, r, F.ws, T, lane);
    }
    { u32x4 z = (u32x4){0u, 0u, 0u, 0u}; const size_t n16 = (size_t)(AB_INP - AB_IN) * D * 2 / 16; u32x4* p = (u32x4*)(win0 + (size_t)AB_IN * D);
      for (size_t i = (size_t)blockIdx.x * NTHREADS + F.tid; i < n16; i += (size_t)F.G * NTHREADS) p[i] = z; }
    if (blockIdx.x == 0) { f32x2* rt = (f32x2*)(F.ws + WS_ROPE);
        for (int i = F.tid; i < 64 * 16; i += NTHREADS) { const int pos = i >> 4, f = i & 15; const float inv = powf(10000.0f, -(float)f / 16.0f); const float ang = (float)pos * inv; rt[i] = (f32x2){cosf(ang), sinf(ang)}; } }
}


__device__ __forceinline__ int gsw(int row, int ch) { return row * 128 + ((ch ^ (row & 7)) << 4); }
__device__ __forceinline__ int gla_row(int n, int p, int b, int d) {
    const bool isctx = n < 4; const int j = isctx ? n : n - 4; int pos = j * 64 + p;
    if (d) pos = (isctx ? CTXL : SEQ) - 1 - pos;
    return isctx ? NX + b * CTXL + pos : b * SEQ + pos;
}
struct GlaRaw { u32x4 q, k, v0, v1; f32x4 lr[4]; };
__device__ __forceinline__ void gla_load(GlaRaw& R, int n, int lane, int w, int b, int h, int d, const bf16_t* qb, const bf16_t* kb, const bf16_t* vb, const float* lr) {
    const int row = gla_row(n, lane, b, d);
    R.q = *(const u32x4*)(qb + (size_t)row * 256 + h * 64 + 8 * w);
    R.k = *(const u32x4*)(kb + (size_t)row * 256 + h * 64 + 8 * w);
    R.v0 = *(const u32x4*)(vb + (size_t)row * 512 + h * 128 + 8 * w);
    R.v1 = *(const u32x4*)(vb + (size_t)row * 512 + h * 128 + 64 + 8 * w);
#pragma unroll
    for (int i = 0; i < 4; ++i) R.lr[i] = *(const f32x4*)(lr + (size_t)row * 32 + d * 16 + 4 * i);
}
__device__ __forceinline__ void unpack8(const u32x4& w, float (&f)[8]) { f[0] = bflo(w.x); f[1] = bfhi(w.x); f[2] = bflo(w.y); f[3] = bfhi(w.y); f[4] = bflo(w.z); f[5] = bfhi(w.z); f[6] = bflo(w.w); f[7] = bfhi(w.w); }
constexpr int GPL_QE = 0, GPL_KE = 8192, GPL_OUT = 16384, GPL_BUF = 16384 + GI_BYTES + 256, GPL_DW = 2 * GPL_BUF, GPL_DB = GPL_DW + 4096, GPL_END = GPL_DB + 256;
static_assert(GPL_END <= RING_BYTES && (GPL_BUF % 16) == 0, "gla prep lds");
__device__ __forceinline__ void gla_prep_phase(const Frame& F, const Args& a) {
    LAS unsigned char* L = F.lds; const int lane = F.lane, w = F.wave, r16 = lane & 15, g4 = lane >> 4;
    const bf16_t* qb = (const bf16_t*)(F.ws + T_QB); const bf16_t* kb = (const bf16_t*)(F.ws + T_KB); const bf16_t* vb = (const bf16_t*)(F.ws + T_VB); const float* lrb = (const float*)(F.ws + T_LR);
    for (int cc = blockIdx.x; cc < 256; cc += F.G) {
        const int sq = cc & 127, b = sq >> 3, h = (sq >> 1) & 3, d = sq & 1;
        const float* dw = d ? a.in[14] : a.in[12]; const float* db = d ? a.in[15] : a.in[13];
        __syncthreads();
        for (int i = F.tid; i < 16 * 64; i += NTHREADS) ((LAS float*)(L + GPL_DW))[i] = dw[(i >> 6) * GLA_QK + h * 64 + (i & 63)];
        if (F.tid < 64) ((LAS float*)(L + GPL_DB))[F.tid] = db[h * 64 + F.tid];
        GlaRaw R; gla_load(R, cc >> 7, lane, w, b, h, d, qb, kb, vb, lrb);
        __syncthreads();
        for (int k = 0; k < 18; ++k) {
            const int n = (cc >> 7) + 2 * k;
            LAS unsigned char* PB = L + (k & 1) * GPL_BUF; LAS unsigned char* OUT = PB + GPL_OUT;
            {
                float z[8], q[8], kk[8], v0[8], v1[8];
                unpack8(R.q, q); unpack8(R.k, kk); unpack8(R.v0, v0); unpack8(R.v1, v1);
                const LAS float* DW = (const LAS float*)(L + GPL_DW); const LAS float* DB = (const LAS float*)(L + GPL_DB);
#pragma unroll
                for (int j = 0; j < 8; ++j) z[j] = DB[8 * w + j];
#pragma unroll
                for (int r = 0; r < 16; ++r) { const float x = R.lr[r >> 2][r & 3]; const f32x4 w0 = *(const LAS f32x4*)(DW + r * 64 + 8 * w), w1 = *(const LAS f32x4*)(DW + r * 64 + 8 * w + 4);
                    z[0] += x * w0.x; z[1] += x * w0.y; z[2] += x * w0.z; z[3] += x * w0.w; z[4] += x * w1.x; z[5] += x * w1.y; z[6] += x * w1.z; z[7] += x * w1.w; }
                float qe[8], ke[8], qi[8]; unsigned short ko[8]; float ld[8];
#pragma unroll
                for (int j = 0; j < 8; ++j) ld[j] = (fminf(z[j], 0.f) - __logf(1.0f + __expf(-fabsf(z[j])))) * (1.0f / 16.0f);
#pragma unroll
                for (int o = 1; o < 64; o <<= 1) { float t[8];
#pragma unroll
                    for (int j = 0; j < 8; ++j) t[j] = __shfl_up(ld[j], o);
#pragma unroll
                    for (int j = 0; j < 8; ++j) ld[j] += (lane >= o) ? t[j] : 0.f; }
                float decv = 0.f;
#pragma unroll
                for (int j = 0; j < 8; ++j) {
                    const float bm = __builtin_bit_cast(float, __builtin_amdgcn_readlane(__builtin_bit_cast(int, ld[j]), 31)), bl = __builtin_bit_cast(float, __builtin_amdgcn_readlane(__builtin_bit_cast(int, ld[j]), 63));
                    const float e1 = __expf(ld[j] - bm), e2 = __expf(bm - ld[j]);
                    qe[j] = q[j] * e1; ke[j] = kk[j] * e2; qi[j] = q[j] * __expf(ld[j]); ko[j] = (unsigned short)f2bf(kk[j] * __expf(bl - ld[j]));
                    decv = (lane == j) ? __expf(bl) : decv;
                }
                if (lane < 8) ((LAS float*)(OUT + GI_DEC))[8 * w + lane] = decv;
                *(LAS u32x4*)(PB + GPL_QE + gsw(lane, w)) = (u32x4){pk2(qe[0], qe[1]), pk2(qe[2], qe[3]), pk2(qe[4], qe[5]), pk2(qe[6], qe[7])};
                *(LAS u32x4*)(PB + GPL_KE + gsw(lane, w)) = (u32x4){pk2(ke[0], ke[1]), pk2(ke[2], ke[3]), pk2(ke[4], ke[5]), pk2(ke[6], ke[7])};
                *(LAS u32x4*)(OUT + GI_QIN + gsw(lane, w)) = (u32x4){pk2(qi[0], qi[1]), pk2(qi[2], qi[3]), pk2(qi[4], qi[5]), pk2(qi[6], qi[7])};
#pragma unroll
                for (int j = 0; j < 8; ++j) { const int rw = 8 * w + j;
                    *(LAS unsigned short*)(OUT + GI_KOT + gsw(rw, lane >> 3) + (lane & 7) * 2) = ko[j];
                    *(LAS unsigned short*)(OUT + GI_VT + gsw(rw, lane >> 3) + (lane & 7) * 2) = (unsigned short)f2bf(v0[j]);
                    *(LAS unsigned short*)(OUT + GI_VT + gsw(64 + rw, lane >> 3) + (lane & 7) * 2) = (unsigned short)f2bf(v1[j]); }
            }
            if (k + 1 < 18) gla_load(R, n + 2, lane, w, b, h, d, qb, kb, vb, lrb);
            lds_barrier();
#pragma unroll
            for (int i = 0; i < 2; ++i) { const int tI = 2 * w + i, st = tI >> 2, pt = tI & 3;
                f32x4 c = (f32x4){0.f, 0.f, 0.f, 0.f};
                if (st <= pt) {
#pragma unroll
                    for (int ks = 0; ks < 2; ++ks) { const bf16x8 af = *(const LAS bf16x8*)(PB + GPL_KE + gsw(16 * st + r16, 4 * ks + g4)), bfr = *(const LAS bf16x8*)(PB + GPL_QE + gsw(16 * pt + r16, 4 * ks + g4));
                        c = __builtin_amdgcn_mfma_f32_16x16x32_bf16(af, bfr, c, 0, 0, 0); }
                    const int p = 16 * pt + r16, s0 = 16 * st + 4 * g4;
#pragma unroll
                    for (int e = 0; e < 4; ++e) if (s0 + e > p) c[e] = 0.f;
                }
                u32x2 o; o.x = pk2(c[0], c[1]); o.y = pk2(c[2], c[3]);
                *(LAS u32x2*)(OUT + GI_A + gsw(16 * pt + r16, 2 * st + (g4 >> 1)) + (g4 & 1) * 8) = o; }
            lds_barrier();
            { unsigned char* rec = F.ws + T_GLA + (size_t)(sq * 36 + n) * GI_BYTES;
              for (int i = F.tid; i < GI_BYTES / 16; i += NTHREADS) *(u32x4*)(rec + i * 16) = *(const LAS u32x4*)(OUT + i * 16); }
        }
    }
    __syncthreads();
}
constexpr int GSL_IN = 33792  , GSL_ST = 3 * GSL_IN, GSL_END = GSL_ST + 2 * 8192;
static_assert(GSL_END <= RING_BYTES, "gla seq lds");
__device__ __forceinline__ void gla_seq_phase(const Frame& F, const Args& a) {
    LAS unsigned char* L = F.lds; const int lane = F.lane, w = F.wave, r16 = lane & 15, g4 = lane >> 4, tid = F.tid;
    for (int it = blockIdx.x; it < 256; it += F.G) {
        const int sq = it >> 1, vh = it & 1, b = sq >> 3, h = (sq >> 1) & 3, d = sq & 1;
        bf16_t* ob = (bf16_t*)(F.ws + (d ? T_OB : T_OF));
        const unsigned char* rec0 = F.ws + T_GLA + (size_t)(sq * 36) * GI_BYTES;
        __syncthreads();
        for (int i = tid; i < 2 * 8192 / 4; i += NTHREADS) ((LAS unsigned*)(L + GSL_ST))[i] = 0u;
        f32x4 Sacc[2] = {(f32x4){0.f, 0.f, 0.f, 0.f}, (f32x4){0.f, 0.f, 0.f, 0.f}};
#define GLA_DMA(n_) do { const unsigned char* r_ = rec0 + (size_t)(n_) * GI_BYTES; LAS unsigned char* d_ = L + ((n_) % 3) * GSL_IN; \
            __builtin_amdgcn_global_load_lds((const unsigned*)(r_ + GI_A + tid * 16), (LAS unsigned*)(d_ + w * 1024), 16, 0, 0); \
            __builtin_amdgcn_global_load_lds((const unsigned*)(r_ + GI_QIN + tid * 16), (LAS unsigned*)(d_ + 8192 + w * 1024), 16, 0, 0); \
            __builtin_amdgcn_global_load_lds((const unsigned*)(r_ + GI_KOT + tid * 16), (LAS unsigned*)(d_ + 16384 + w * 1024), 16, 0, 0); \
            __builtin_amdgcn_global_load_lds((const unsigned*)(r_ + GI_VT + vh * 8192 + tid * 16), (LAS unsigned*)(d_ + 24576 + w * 1024), 16, 0, 0); \
            __builtin_amdgcn_global_load_lds((const unsigned*)(r_ + GI_DEC + lane * 16), (LAS unsigned*)(d_ + 32768), 16, 0, 0); } while (0)
        GLA_DMA(0); GLA_DMA(1);
        for (int n = 0; n < 36; ++n) {
            LAS unsigned char* IN = L + (n % 3) * GSL_IN; LAS unsigned char* STr = L + GSL_ST + (n & 1) * 8192; LAS unsigned char* STw = L + GSL_ST + ((n + 1) & 1) * 8192;
            if (n == 0) asm volatile("s_waitcnt vmcnt(5)" ::: "memory"); else if (n < 35) asm volatile("s_waitcnt vmcnt(7)" ::: "memory"); else asm volatile("s_waitcnt vmcnt(2)" ::: "memory");
            lds_barrier();
            if (n + 2 < 36) GLA_DMA(n + 2);
#pragma unroll
            for (int i = 0; i < 2; ++i) { const int tI = 2 * w + i, vt = tI >> 2, pt = tI & 3;
                f32x4 c = (f32x4){0.f, 0.f, 0.f, 0.f};
#pragma unroll
                for (int ks = 0; ks < 2; ++ks) {
                    const bf16x8 a1 = *(const LAS bf16x8*)(IN + 24576 + gsw(16 * vt + r16, 4 * ks + g4)), b1 = *(const LAS bf16x8*)(IN + gsw(16 * pt + r16, 4 * ks + g4));
                    c = __builtin_amdgcn_mfma_f32_16x16x32_bf16(a1, b1, c, 0, 0, 0);
                    const bf16x8 a2 = *(const LAS bf16x8*)(STr + gsw(16 * vt + r16, 4 * ks + g4)), b2 = *(const LAS bf16x8*)(IN + 8192 + gsw(16 * pt + r16, 4 * ks + g4));
                    c = __builtin_amdgcn_mfma_f32_16x16x32_bf16(a2, b2, c, 0, 0, 0); }
                const int row = gla_row(n, 16 * pt + r16, b, d);
                u32x2 o; o.x = pk2(c[0], c[1]); o.y = pk2(c[2], c[3]);
                *(u32x2*)(ob + (size_t)row * 512 + h * 128 + vh * 64 + 16 * vt + 4 * g4) = o; }
#pragma unroll
            for (int i = 0; i < 2; ++i) { const int tI = 2 * w + i, ct = tI >> 2, vt = tI & 3;
                const f32x4 dc = *(const LAS f32x4*)(IN + 32768 + (16 * ct + 4 * g4) * 4);
                f32x4 c = Sacc[i] * dc;
#pragma unroll
                for (int ks = 0; ks < 2; ++ks) { const bf16x8 af = *(const LAS bf16x8*)(IN + 16384 + gsw(16 * ct + r16, 4 * ks + g4)), bfr = *(const LAS bf16x8*)(IN + 24576 + gsw(16 * vt + r16, 4 * ks + g4));
                    c = __builtin_amdgcn_mfma_f32_16x16x32_bf16(af, bfr, c, 0, 0, 0); }
                Sacc[i] = c;
                u32x2 o; o.x = pk2(c[0], c[1]); o.y = pk2(c[2], c[3]);
                *(LAS u32x2*)(STw + gsw(16 * vt + r16, 2 * ct + (g4 >> 1)) + (g4 & 1) * 8) = o; }
        }
#undef GLA_DMA
        asm volatile("s_waitcnt vmcnt(0)" ::: "memory");
    }
    __syncthreads();
}

__device__ __forceinline__ void finish_conv_phase(const Frame& F, const Args& a) {
    const int lane = F.lane; bf16_t* cat = (bf16_t*)(F.ws + T_CAT);
    {
        const bf16_t* of = (const bf16_t*)(F.ws + T_OF); const bf16_t* obk = (const bf16_t*)(F.ws + T_OB); const bf16_t* gb = (const bf16_t*)(F.ws + T_GB);
        const int gw = F.vcu * NWAVES + F.wave, NGW = F.G * NWAVES;
        float gg[8];
#pragma unroll
        for (int j = 0; j < 8; ++j) gg[j] = a.in[16][8 * lane + j];
        for (int row = gw; row < NT; row += NGW) {
            float x[8], y[8], g[8];
            unpack8(*(const u32x4*)(of + (size_t)row * 512 + 8 * lane), x); unpack8(*(const u32x4*)(obk + (size_t)row * 512 + 8 * lane), y); unpack8(*(const u32x4*)(gb + (size_t)row * 512 + 8 * lane), g);
            float ss = 0.f;
#pragma unroll
            for (int j = 0; j < 8; ++j) { x[j] += y[j]; ss += x[j] * x[j]; }
            ss += __shfl_xor(ss, 1); ss += __shfl_xor(ss, 2); ss += __shfl_xor(ss, 4); ss += __shfl_xor(ss, 8);
            const float rs = rsqrtf(ss * (1.0f / 128.0f) + RMS_EPS);
#pragma unroll
            for (int j = 0; j < 8; ++j) x[j] = x[j] * rs * gg[j] * siluf_(g[j]);
            *(u32x4*)(cat + (size_t)row * D + 8 * lane) = (u32x4){pk2(x[0], x[1]), pk2(x[2], x[3]), pk2(x[4], x[5]), pk2(x[6], x[7])};
        }
    }
    {
        const bf16_t* ub = (const bf16_t*)(F.ws + T_UB); LAS float* tile = (LAS float*)F.lds;
        const int c = F.tid;
        float wv[CONV_W];
#pragma unroll
        for (int j = 0; j < CONV_W; ++j) wv[j] = a.in[17][j * CONV_CH + c];
        const float cb = a.in[18][c];
        float lg[8], lb[8];
#pragma unroll
        for (int i = 0; i < 8; ++i) { lg[i] = a.in[19][lane + 64 * i]; lb[i] = a.in[20][lane + 64 * i]; }
        for (int ti = blockIdx.x; ti < NT / 32; ti += F.G) {
            const int row0 = ti * 32; const bool lat = row0 < NX;
            const int t0 = lat ? (row0 & (SEQ - 1)) : ((row0 - NX) & (CTXL - 1)); const int len = lat ? SEQ : CTXL; const int sbase = row0 - t0;
            float in[62];
            unsigned short raw[62];
#pragma unroll
            for (int i = 0; i < 62; ++i) { int t = t0 - 15 + i; t = t < 0 ? 0 : (t >= len ? len - 1 : t); raw[i] = ub[(size_t)(sbase + t) * 512 + c]; }
#pragma unroll
            for (int i = 0; i < 62; ++i) { const int t = t0 - 15 + i; in[i] = (t >= 0 && t < len) ? bf2f(raw[i]) : 0.f; }
            __syncthreads();
#pragma unroll
            for (int t = 0; t < 32; ++t) { float s = cb;
#pragma unroll
                for (int j = 0; j < CONV_W; ++j) s += wv[j] * in[t + j];
                tile[t * 512 + c] = s; }
            __syncthreads();
#pragma unroll
            for (int q = 0; q < 4; ++q) { const int t = 4 * F.wave + q; float v[8]; float s = 0.f;
#pragma unroll
                for (int i = 0; i < 8; ++i) { v[i] = tile[t * 512 + lane + 64 * i]; s += v[i]; }
                const float mu = wave_sum(s) * (1.0f / 512.0f); float qq = 0.f;
#pragma unroll
                for (int i = 0; i < 8; ++i) { v[i] -= mu; qq += v[i] * v[i]; }
                const float rstd = rsqrtf(wave_sum(qq) * (1.0f / 512.0f) + LN_EPS);
#pragma unroll
                for (int i = 0; i < 8; ++i) { const float y = v[i] * rstd * lg[i] + lb[i]; cat[(size_t)(row0 + t) * D + 512 + lane + 64 * i] = (bf16_t)f2bf(siluf_(y)); } }
        }
        __syncthreads();
    }
}


constexpr int CW_TST = 20480;
constexpr int AUX_TST = AUX_OFF, AUX_TILEE = AUX_OFF + 1040, AUX_IDX = AUX_OFF + 1168;
constexpr int MOE_MAXU = 32, MOE_MAXIDX = 16;
static_assert(AUX_IDX + MOE_MAXIDX * 1024 <= MISC_OFF, "aux lds");

struct EpiRouter {
    static constexpr bool PERM = false, AFTER_DRAIN = true;
    const float* rbias; int* asg_e; int* asg_r; float* asg_g; unsigned* counts;
    __device__ __forceinline__ void operator()(const f32x4 (&)[2][2][4][2], const Unit&, int, int, int, int) const {}
    __device__ __forceinline__ void fused(const f32x4 (&acc)[2][2][4][2], const Unit& u, int wr, int wc, int fr, int fq, LAS unsigned char* lds, int wid, int lane) const {
        LAS float* SC = (LAS float*)lds;
        LAS unsigned* lcnt = (LAS unsigned*)(lds + 66560); LAS unsigned* lbase = lcnt + 256;
        LAS int* selE = (LAS int*)(lbase + 256); LAS int* selR = selE + 2048;
        const int tid = wid * 64 + lane;
        if (tid < 256) lcnt[tid] = 0u;
        const f32x4 rb = *(const f32x4*)(rbias + 4 * lane);
        const float NINF = -__builtin_inff();
#pragma unroll
        for (int ai = 0; ai < 2; ++ai)
#pragma unroll
            for (int mm = 0; mm < 2; ++mm) {
                LDS_WAIT(); __builtin_amdgcn_s_barrier(); asm volatile("" ::: "memory");
#pragma unroll
                for (int mi = 0; mi < 2; ++mi) { const int lr = 32 * wr + 16 * mi + fr;
#pragma unroll
                    for (int bj = 0; bj < 2; ++bj)
#pragma unroll
                        for (int n = 0; n < 2; ++n) *(LAS f32x4*)(SC + lr * 260 + 128 * bj + 32 * wc + 16 * n + 4 * fq) = acc[ai][bj][2 * mm + mi][n]; }
                LDS_WAIT(); __builtin_amdgcn_s_barrier(); asm volatile("" ::: "memory");
                for (int q = 0; q < 8; ++q) {
                    const int lr = 8 * wid + q; const int rit = 128 * ai + 64 * (lr >> 5) + 16 * (2 * mm + ((lr >> 4) & 1)) + (lr & 15);
                    const f32x4 lg = *(const LAS f32x4*)(SC + lr * 260 + 4 * lane);
                    float s[4], cd[4];
#pragma unroll
                    for (int j = 0; j < 4; ++j) { s[j] = 1.0f / (1.0f + __expf(-lg[j])); cd[j] = s[j] + rb[j]; }
                    float m1 = fmaxf(cd[0], cd[1]), m2 = fminf(cd[0], cd[1]);
                    { const float x = cd[2]; const float n1 = fmaxf(m1, x); m2 = fmaxf(fminf(m1, x), m2); m1 = n1; }
                    { const float x = cd[3]; const float n1 = fmaxf(m1, x); m2 = fmaxf(fminf(m1, x), m2); m1 = n1; }
#pragma unroll
                    for (int o = 1; o < 8; o <<= 1) { const float a1 = __shfl_xor(m1, o), a2 = __shfl_xor(m2, o); const float n1 = fmaxf(m1, a1); m2 = fmaxf(fminf(m1, a1), fmaxf(m2, a2)); m1 = n1; }
                    const float gs = m1 + m2; const int mygrp = lane >> 3; int rank = 0;
#pragma unroll
                    for (int g = 0; g < 8; ++g) { const float og = __shfl(gs, 8 * g); rank += (og > gs || (og == gs && g < mygrp)) ? 1 : 0; }
                    if (rank >= 4) { cd[0] = NINF; cd[1] = NINF; cd[2] = NINF; cd[3] = NINF; }
                    int myE = 0; float myG = 0.f; float gsum = 0.f;
#pragma unroll
                    for (int k = 0; k < TOPK; ++k) {
                        float bv = cd[0]; int bi = 0;
                        if (cd[1] > bv) { bv = cd[1]; bi = 1; } if (cd[2] > bv) { bv = cd[2]; bi = 2; } if (cd[3] > bv) { bv = cd[3]; bi = 3; }
                        float v = bv; int ix = 4 * lane + bi;
#pragma unroll
                        for (int o = 32; o >= 1; o >>= 1) { const float ov = __shfl_xor(v, o); const int oi = __shfl_xor(ix, o); if (ov > v || (ov == v && oi < ix)) { v = ov; ix = oi; } }
                        const int sl = ix & 3; const float mys = sl == 0 ? s[0] : (sl == 1 ? s[1] : (sl == 2 ? s[2] : s[3]));
                        const float gv = __shfl(mys, ix >> 2);
                        gsum += gv;
                        if (lane == k) { myE = ix; myG = gv; }
                        if (lane == (ix >> 2)) { if (sl == 0) cd[0] = NINF; else if (sl == 1) cd[1] = NINF; else if (sl == 2) cd[2] = NINF; else cd[3] = NINF; }
                    }
                    if (lane < TOPK) { const unsigned r = __hip_atomic_fetch_add(&lcnt[myE], 1u, __ATOMIC_RELAXED, __HIP_MEMORY_SCOPE_WORKGROUP); selE[rit * 8 + lane] = myE; selR[rit * 8 + lane] = (int)r; asg_g[(size_t)(u.orow + rit) * 8 + lane] = myG / gsum * 2.5f; }
                }
            }
        LDS_WAIT(); __builtin_amdgcn_s_barrier(); asm volatile("" ::: "memory");
        if (tid < 256) { const unsigned c = lcnt[tid]; lbase[tid] = c ? atomicAdd(&counts[tid], c) : 0u; }
        LDS_WAIT(); __builtin_amdgcn_s_barrier(); asm volatile("" ::: "memory");
        for (int i = tid; i < 2048; i += NTHREADS) { const int e = selE[i]; asg_e[(size_t)u.orow * 8 + i] = e; asg_r[(size_t)u.orow * 8 + i] = (int)lbase[e] + selR[i]; }
    }
};

__device__ __forceinline__ void moe_place(const Frame& F, int layer, int ntok) {
    LAS int* cnt = (LAS int*)F.lds; LAS int* tst = cnt + 256;
    const unsigned* counts = F.ctl + CW_CNT + layer * 256;
    const int* asg_e = (const int*)(F.ws + M_AE); const int* asg_r = (const int*)(F.ws + M_AR); int* tslot = (int*)(F.ws + M_TS); int* stok = (int*)(F.ws + M_ST);
    __syncthreads();
    if (F.tid < 256) cnt[F.tid] = (int)counts[F.tid];
    __syncthreads();
    if (F.tid == 0) { int acc = 0; for (int e = 0; e < 256; ++e) { tst[e] = acc; acc += (cnt[e] + 255) >> 8; } tst[256] = acc; }
    __syncthreads();
    const int ntr = tst[256];
    if (blockIdx.x == 0) for (int i = F.tid; i < 257; i += NTHREADS) F.ctl[CW_TST + layer * 320 + i] = (unsigned)tst[i];
    const int gt = blockIdx.x * NTHREADS + F.tid, gs = F.G * NTHREADS;
    for (int i = gt; i < ntok * 8; i += gs) { const int e = asg_e[i]; const int slot = tst[e] * 256 + asg_r[i]; stok[slot] = i >> 3; tslot[i] = slot; }
    for (int e = blockIdx.x; e < 256; e += F.G) { const int s0 = tst[e] * 256 + cnt[e], s1 = tst[e + 1] * 256; for (int s = s0 + F.tid; s < s1; s += NTHREADS) stok[s] = 0; }
    for (int i = gt; i < ntok; i += gs) stok[ntr * 256 + i] = i;
    __syncthreads();
}

template <int NCOL>
__device__ __forceinline__ int moe_units_setup(const Frame& F, int layer, int ntok, int c, bool want_idx) {
    LAS int* tst = (LAS int*)(F.lds + AUX_TST); LAS int* tileE = (LAS int*)(F.lds + AUX_TILEE); LAS int* idxl = (LAS int*)(F.lds + AUX_IDX);
    __syncthreads();
    for (int i = F.tid; i < 257; i += NTHREADS) tst[i] = (int)F.ctl[CW_TST + layer * 320 + i];
    __syncthreads();
    const int ntr = tst[256], nunits = (ntr + ntok / 256) * NCOL;
    int nu = c < nunits ? (nunits - c + F.G - 1) / F.G : 0; if (nu > MOE_MAXU) nu = MOE_MAXU; if (want_idx && nu > MOE_MAXIDX) nu = MOE_MAXIDX;
    if (F.tid < nu) { const int rt = (c + F.tid * F.G) / NCOL; int e;
        if (rt >= ntr) e = NEXP; else { int lo = 0, hi = 255; while (lo < hi) { const int mid = (lo + hi + 1) >> 1; if (tst[mid] <= rt) lo = mid; else hi = mid - 1; } e = lo; }
        tileE[F.tid] = e; }
    if (want_idx) { const int* stok = (const int*)(F.ws + M_ST); for (int i = F.tid; i < nu * 256; i += NTHREADS) idxl[i] = stok[(size_t)((c + (i >> 8) * F.G) / NCOL) * 256 + (i & 255)]; }
    __syncthreads();
    return nu;
}
struct SchedMoeGU {
    const char* A; const char* W; const LAS int* tileE; const LAS int* idxl; int nu, G, c;
    __device__ __forceinline__ bool next(int i, Unit& u) const {
        if (i >= nu) return false; const int un = c + i * G; const int rt = un >> 1, col = un & 1; const int e = tileE[i];
        u.a = i; u.b = e * 512 + col * 256; u.orow = rt * 256; u.ocol = col * 128; u.aux = e; return true; }
    __device__ __forceinline__ const char* a_base() const { return A; }
    __device__ __forceinline__ const char* b_ptr(const Unit& u) const { return W + (size_t)u.b * D * 2; }
    __device__ __forceinline__ void a_off(const Unit& u, const int (&R)[2], const int (&C)[2], unsigned (&o0)[2], unsigned (&o1)[2]) const {
#pragma unroll
        for (int i = 0; i < 2; ++i) { const int t0 = idxl[u.a * 256 + R[i]], t1 = idxl[u.a * 256 + 128 + R[i]]; o0[i] = (unsigned)t0 * (unsigned)(D * 2) + (unsigned)C[i] * 2u; o1[i] = (unsigned)t1 * (unsigned)(D * 2) + (unsigned)C[i] * 2u; }
    }
};
struct EpiGateUp {
    static constexpr bool PERM = true, AFTER_DRAIN = false;
    bf16_t* hid;
    __device__ __forceinline__ void operator()(const f32x4 (&acc)[2][2][4][2], const Unit& u, int wr, int wc, int fr, int fq) const {
        const int lane = fr + 16 * fq; const int srcb = ((lane >> 2) + 16 * (lane & 3)) << 2;
        const int row0 = u.orow + wr * 64 + (lane >> 2), col0 = u.ocol + wc * 32 + 8 * (lane & 3);
#pragma unroll
        for (int ai = 0; ai < 2; ++ai)
#pragma unroll
            for (int m = 0; m < 4; ++m) { float h[8];
#pragma unroll
                for (int n = 0; n < 2; ++n)
#pragma unroll
                    for (int e = 0; e < 4; ++e) { const float g = acc[ai][0][m][n][e], up = acc[ai][1][m][n][e]; h[4 * n + e] = g / (1.0f + __expf(-g)) * up; }
                u32x4 w; w.x = cvt_pk_bf16(h[0], h[1]); w.y = cvt_pk_bf16(h[2], h[3]); w.z = cvt_pk_bf16(h[4], h[5]); w.w = cvt_pk_bf16(h[6], h[7]);
                u32x4 t; t.x = (unsigned)__builtin_amdgcn_ds_bpermute(srcb, (int)w.x); t.y = (unsigned)__builtin_amdgcn_ds_bpermute(srcb, (int)w.y); t.z = (unsigned)__builtin_amdgcn_ds_bpermute(srcb, (int)w.z); t.w = (unsigned)__builtin_amdgcn_ds_bpermute(srcb, (int)w.w);
                *(u32x4*)(hid + (size_t)(row0 + ai * 128 + m * 16) * DEXP + col0) = t; }
    }
};
struct SchedMoeDN {
    const char* A; const char* W; const LAS int* tileE; int nu, G, c;
    __device__ __forceinline__ bool next(int i, Unit& u) const {
        if (i >= nu) return false; const int un = c + i * G; const int rt = un >> 2, col = un & 3; const int e = tileE[i];
        u.a = rt; u.b = e * 1024 + col * 256; u.orow = rt * 256; u.ocol = col * 256; u.aux = e; return true; }
    __device__ __forceinline__ const char* a_base() const { return A; }
    __device__ __forceinline__ const char* b_ptr(const Unit& u) const { return W + (size_t)u.b * DEXP * 2; }
    __device__ __forceinline__ void a_off(const Unit& u, const int (&R)[2], const int (&C)[2], unsigned (&o0)[2], unsigned (&o1)[2]) const {
#pragma unroll
        for (int i = 0; i < 2; ++i) { o0[i] = (unsigned)((u.a * 256 + R[i]) * DEXP + C[i]) * 2u; o1[i] = o0[i] + (unsigned)(128 * DEXP * 2); }
    }
};

constexpr int NA_RING = 11, NA_VR = 0, NA_VC = NA_RING * 64 * 128, NA_KC = NA_VC + 256 * 128, NA_RPB = NA_KC + 256 * 128, NA_END = NA_RPB + 15 * 128;
static_assert(NA_END <= MISC_OFF, "na lds");
typedef short s16x4 __attribute__((ext_vector_type(4)));
__device__ __forceinline__ int na_voff(int row, int ch) { return row * 128 + ((((ch >> 1) ^ ((row >> 1) & 3)) << 5) | ((ch & 1) << 4)); }
__device__ __forceinline__ int na_koff(int row, int ch) { return row * 128 + ((ch ^ (row & 7)) << 4); }
template <bool CTX, int TB>
__device__ __forceinline__ void na_seg(LAS unsigned char* L, bf16x8 (&kf)[8][2], const char* knext, unsigned loff, const bf16x8 (&qf)[2], int seg, int r16, int g4, int r0, int band, const int (&boff)[2][4], int rbase,
                                       const int (&voff)[4], f32x4 (&O)[4], float& m_run, float& sum) {
    const float NINF = -__builtin_inff();
    float S[8][4]; float mx = NINF;
#pragma unroll
    for (int t = 0; t < 8; ++t) {
        f32x4 c = (f32x4){0.f, 0.f, 0.f, 0.f};
        if (CTX) {
            const int key = 128 * seg + 16 * t + r16;
            const bf16x8 k0 = *(const LAS bf16x8*)(L + NA_KC + na_koff(key, g4)), k1 = *(const LAS bf16x8*)(L + NA_KC + na_koff(key, 4 + g4));
            c = __builtin_amdgcn_mfma_f32_16x16x32_bf16(k0, qf[0], c, 0, 0, 0); c = __builtin_amdgcn_mfma_f32_16x16x32_bf16(k1, qf[1], c, 0, 0, 0);
#pragma unroll
            for (int e = 0; e < 4; ++e) S[t][e] = c[e];
        } else {
            c = __builtin_amdgcn_mfma_f32_16x16x32_bf16(kf[t][0], qf[0], c, 0, 0, 0); c = __builtin_amdgcn_mfma_f32_16x16x32_bf16(kf[t][1], qf[1], c, 0, 0, 0);
#pragma unroll
            for (int e = 0; e < 4; ++e) S[t][e] = c[e] + *(const LAS float*)(L + rbase + ((TB + t) >> 1) * 128 + boff[t & 1][e]);
        }
        mx = fmaxf(mx, fmaxf(fmaxf(S[t][0], S[t][1]), fmaxf(S[t][2], S[t][3])));
    }
    if (!CTX && TB == 0) {
#pragma unroll
        for (int t = 0; t < 8; ++t) { const char* bt = knext + (size_t)((t >> 1) * 64 + 16 * (t & 1)) * D * 2; kf[t][0] = *(const bf16x8*)(bt + loff); kf[t][1] = *(const bf16x8*)(bt + loff + 64); }
    }
    mx = fmaxf(mx, __shfl_xor(mx, 16)); mx = fmaxf(mx, __shfl_xor(mx, 32));
    const float m_new = fmaxf(m_run, mx); const float alpha = __builtin_amdgcn_exp2f(m_run - m_new); m_run = m_new;
    float ps = 0.f;
#pragma unroll
    for (int t = 0; t < 8; ++t)
#pragma unroll
        for (int e = 0; e < 4; ++e) { const float p = __builtin_amdgcn_exp2f(S[t][e] - m_new); S[t][e] = p; ps += p; }
    ps += __shfl_xor(ps, 16); ps += __shfl_xor(ps, 32);
    sum = sum * alpha + ps;
#pragma unroll
    for (int mt = 0; mt < 4; ++mt) O[mt] = O[mt] * alpha;
#pragma unroll
    for (int j = 0; j < 4; ++j) {
        bf16x8 pb; { const u32x4 ww = (u32x4){cvt_pk_bf16(S[2 * j][0], S[2 * j][1]), cvt_pk_bf16(S[2 * j][2], S[2 * j][3]), cvt_pk_bf16(S[2 * j + 1][0], S[2 * j + 1][1]), cvt_pk_bf16(S[2 * j + 1][2], S[2 * j + 1][3])}; pb = __builtin_bit_cast(bf16x8, ww); }
        int ub;
        if (CTX) ub = NA_VC + (128 * seg + 32 * j) * 128; else ub = NA_VR + (((r0 + TB / 2 + j) % NA_RING) * 64 + band) * 128;
#pragma unroll
        for (int mt = 0; mt < 4; ++mt) {
            const s16x4 a0 = __builtin_amdgcn_ds_read_tr16_b64_v4i16((LAS s16x4*)(L + ub + voff[mt]));
            const s16x4 a1 = __builtin_amdgcn_ds_read_tr16_b64_v4i16((LAS s16x4*)(L + ub + voff[mt] + 16 * 128));
            const bf16x8 av = (bf16x8){a0[0], a0[1], a0[2], a0[3], a1[0], a1[1], a1[2], a1[3]};
            O[mt] = __builtin_amdgcn_mfma_f32_16x16x32_bf16(av, pb, O[mt], 0, 0, 0);
        }
    }
}
__device__ __forceinline__ void na_phase(const Frame& F, const Args& a) {
    LAS unsigned char* L = F.lds; const int lane = F.lane, w = F.wave, r16 = lane & 15, g4 = lane >> 4;
    const bf16_t* qbuf = (const bf16_t*)(F.ws + T_QKV); const bf16_t* kbuf = qbuf + (size_t)NT * D; const bf16_t* vbuf = kbuf + (size_t)NT * D; bf16_t* cat = (bf16_t*)(F.ws + T_CAT);
    const int rr = w >> 2, cb = w & 3; const int band = cb == 0 ? 0 : (cb == 1 ? 8 : (cb == 2 ? 24 : 32));
    const float NINF = -__builtin_inff();
    const int pkey = F.tid >> 3, pch = F.tid & 7;
    int boff[2][4], voff[4];
    { const int qc = 16 * cb + r16; int cs = qc - 8; cs = cs < 0 ? 0 : (cs > 48 ? 48 : cs);
#pragma unroll
      for (int hc = 0; hc < 2; ++hc)
#pragma unroll
          for (int e = 0; e < 4; ++e) { const int kc = band + 16 * hc + 4 * g4 + e; const bool ok = kc >= cs && kc < cs + 16; boff[hc][e] = (ok ? kc - qc + 15 : 31) * 4; }
      const int rl = 4 * g4 + (r16 >> 2), sw = (rl >> 1) & 3;
#pragma unroll
      for (int mt = 0; mt < 4; ++mt) voff[mt] = rl * 128 + ((mt ^ sw) << 5) + 8 * (r16 & 3); }
    for (int bh = blockIdx.x; bh < BATCH * NA_H; bh += F.G) {
        const int b = bh >> 4, h = bh & 15;
        __syncthreads();
        for (int i = F.tid; i < 15 * 32; i += NTHREADS) { const int ri = i >> 5, ci = i & 31; ((LAS float*)(L + NA_RPB))[i] = ci < 31 ? a.in[23][h * 465 + ri * 31 + ci] * 1.4426950408889634f : NINF; }
        for (int i = F.tid; i < 256 * 8; i += NTHREADS) { const int key = i >> 3, ch = i & 7; const size_t g = (size_t)(NX + b * CTXL + key) * D + h * 64 + ch * 8;
            *(LAS u32x4*)(L + NA_VC + na_voff(key, ch)) = *(const u32x4*)(vbuf + g); *(LAS u32x4*)(L + NA_KC + na_koff(key, ch)) = *(const u32x4*)(kbuf + g); }
        for (int gr = 0; gr < 9; ++gr) *(LAS u32x4*)(L + NA_VR + na_voff(gr * 64 + pkey, pch)) = *(const u32x4*)(vbuf + (size_t)(b * SEQ + gr * 64 + pkey) * D + h * 64 + pch * 8);
        for (int rp = 0; rp < 16; ++rp) {
            int R0 = 2 * rp - 4; R0 = R0 < 0 ? 0 : (R0 > 24 ? 24 : R0);
            int R0n = 2 * rp - 2; R0n = R0n < 0 ? 0 : (R0n > 24 ? 24 : R0n);
            const bool newrows = (rp < 15) && (R0n != R0);
            u32x4 nv0 = (u32x4){0u, 0u, 0u, 0u}, nv1 = nv0;
            if (newrows) { nv0 = *(const u32x4*)(vbuf + (size_t)(b * SEQ + (R0 + 9) * 64 + pkey) * D + h * 64 + pch * 8); if (R0 + 10 < 32) nv1 = *(const u32x4*)(vbuf + (size_t)(b * SEQ + (R0 + 10) * 64 + pkey) * D + h * 64 + pch * 8); }
            const int r = 2 * rp + rr; int r0 = r - 4; r0 = r0 < 0 ? 0 : (r0 > 24 ? 24 : r0);
            const int qrow = b * SEQ + r * 64 + 16 * cb + r16;
            bf16x8 qf[2];
#pragma unroll
            for (int ks = 0; ks < 2; ++ks) qf[ks] = *(const bf16x8*)(qbuf + (size_t)qrow * D + h * 64 + 32 * ks + 8 * g4);
            bf16x8 kf[8][2];
            const char* kb0 = (const char*)kbuf + ((size_t)(b * SEQ + r0 * 64 + band) * D + h * 64) * 2;
            const unsigned loff = (unsigned)(r16 * D + 8 * g4) * 2u;
#pragma unroll
            for (int t = 0; t < 8; ++t) { const char* bt = kb0 + (size_t)((t >> 1) * 64 + 16 * (t & 1)) * D * 2; kf[t][0] = *(const bf16x8*)(bt + loff); kf[t][1] = *(const bf16x8*)(bt + loff + 64); }
            const char* kb1 = kb0 + (size_t)(4 * 64) * D * 2;
            lds_barrier();
            const int rbase = NA_RPB + (r0 - r + 7) * 128;
            f32x4 O[4]; float m_run = NINF, sum = 0.f;
#pragma unroll
            for (int mt = 0; mt < 4; ++mt) O[mt] = (f32x4){0.f, 0.f, 0.f, 0.f};
#pragma nounroll
            for (int seg = 0; seg < 2; ++seg) na_seg<true, 0>(L, kf, kb1, loff, qf, seg, r16, g4, r0, band, boff, rbase, voff, O, m_run, sum);
            na_seg<false, 0>(L, kf, kb1, loff, qf, 0, r16, g4, r0, band, boff, rbase, voff, O, m_run, sum);
            na_seg<false, 8>(L, kf, kb1, loff, qf, 0, r16, g4, r0, band, boff, rbase, voff, O, m_run, sum);
            const float inv = 1.0f / sum;
#pragma unroll
            for (int mt = 0; mt < 4; ++mt) { u32x2 o; o.x = pk2(O[mt][0] * inv, O[mt][1] * inv); o.y = pk2(O[mt][2] * inv, O[mt][3] * inv);
                *(u32x2*)(cat + (size_t)qrow * D + h * 64 + 16 * mt + 4 * g4) = o; }
            if (newrows) { *(LAS u32x4*)(L + NA_VR + na_voff(((R0 + 9) % NA_RING) * 64 + pkey, pch)) = nv0; *(LAS u32x4*)(L + NA_VR + na_voff(((R0 + 10) % NA_RING) * 64 + pkey, pch)) = nv1; }
        }
    }
    __syncthreads();
}

#if MK_ONE_LAUNCH
#define GRID_BAR() xcd_barrier(bar)
#else
#define GRID_BAR() do { } while (0)
#endif
#define IN(k) (lo <= (k) && (k) < hi && (k) <= MK_LAST_PHASE)
#define SEAM(k) do { if (IN(k) && IN((k) + 1)) GRID_BAR(); } while (0)
template <int LAYER>
__device__ __forceinline__ void layer_tail(const Frame& F, const Args& args, const int lo, const int hi, const XcdBarrier& bar) {
    unsigned char* ws = args.ws;
    const float* modx = (const float*)(ws + WS_MODX); const float* modc = (const float*)(ws + WS_MODC);
    float* xw = (float*)(ws + WS_XW); bf16_t* Hb = (bf16_t*)(ws + WS_H);
    constexpr int mb = LAYER ? 16 : 7; constexpr int ntok = LAYER ? NX : NT;
    const float* lmodx = modx + (size_t)LAYER * 16 * ADA; const float* lmodc = modc + (size_t)LAYER * ADA;
    if (IN(LAYER ? 14 : 5)) REPEAT_IF(LAYER ? 14 : 5) { REP_BAR();
        SchedDense S{(const char*)(ws + T_CAT), (const char*)(ws + (LAYER ? WS_WOUT1 : WS_WOUT0)), D, ntok / 256, D / 256, 0, 1, 0, F.G, (int)blockIdx.x};
        EpiBf16 E{(bf16_t*)(ws + T_Y), D, 0, 0};
        pg8::gemm_phase<EpiBf16, SchedDense, true>(F.lds, D, S, E);
        if (LAYER == 0 && F.G == 256 && (int)blockIdx.x >= 64) cvt_moe_range(F, args, 0, F0_BULK + F0_P2, F0_BULK + F0_P2 + F0_P5, (int)blockIdx.x - 64, 192);
    }
    SEAM(LAYER ? 14 : 5);
    if (IN(LAYER ? 15 : 6)) REPEAT_IF(LAYER ? 15 : 6) { REP_BAR();
        RowPhase P{}; P.xin_lat = LAYER ? xw : args.in[0]; P.xin_ctx = LAYER ? xw + (size_t)NX * D : args.in[2]; P.xout_lat = xw; P.xout_ctx = xw + (size_t)NX * D; P.nrows = ntok; P.ysrc = 1; P.y = (const bf16_t*)(ws + T_Y);
        P.gpost = args.in[7] + LAYER * D; P.modx = lmodx; P.modc = lmodc; P.gate_chunk = 2;
        P.doH = true; P.H = Hb; P.gpre = args.in[8] + LAYER * D; P.sc_chunk = 4; P.sh_chunk = 3; P.modxH = lmodx; P.modcH = lmodc;
        row_phase(F, P);
    }
    SEAM(LAYER ? 15 : 6);
    if (IN(mb)) REPEAT_IF(mb) { REP_BAR();
        SchedDense S{(const char*)Hb, (const char*)(ws + WS_WR) + (size_t)LAYER * NEXP * D * 2, D, ntok / 256, 1, 0, 1, 0, F.G, (int)blockIdx.x};
        EpiRouter E{args.in[25] + LAYER * NEXP, (int*)(ws + M_AE), (int*)(ws + M_AR), (float*)(ws + M_AG), F.ctl + CW_CNT + LAYER * 256};
        pg8::gemm_phase<EpiRouter, SchedDense, false>(F.lds, D, S, E);
        if (F.G != 256) { } else if (LAYER == 0) { if ((int)blockIdx.x >= 144) cvt_moe_range(F, args, 0, F0_BULK + F0_P2 + F0_P5, MOE_CVT_ITEMS, (int)blockIdx.x - 144, 112); }
        else { if ((int)blockIdx.x >= 128) { const int ntr0 = (int)__hip_atomic_load(F.ctl + CW_TST + 256, __ATOMIC_RELAXED, __HIP_MEMORY_SCOPE_AGENT); int s9, s10; fill1_ranges(F, ntr0, s9, s10);
                cvt_moe_range(F, args, 1, s9 + s10, MOE_CVT_ITEMS - F1_P12, (int)blockIdx.x - 128, 128); } }
    }
    SEAM(mb);
    if (IN(mb + 1)) REPEAT_IF(mb + 1) { REP_BAR(); moe_place(F, LAYER, ntok); }
    SEAM(mb + 1);
    if (IN(mb + 2)) REPEAT_IF(mb + 2) { REP_BAR();
        const int nj = moe_units_setup<2>(F, LAYER, ntok, F.vcu, true);
        SchedMoeGU S{(const char*)Hb, (const char*)(ws + WS_WGU + (size_t)LAYER * WGU_BYTES), (const LAS int*)(F.lds + AUX_TILEE), (const LAS int*)(F.lds + AUX_IDX), nj, F.G, F.vcu};
        EpiGateUp E{(bf16_t*)(ws + M_HID)};
        pg8::gemm_phase<EpiGateUp, SchedMoeGU, true>(F.lds, D, S, E);
        if (LAYER == 0) { const int ntr0 = ((const LAS int*)(F.lds + AUX_TST))[256]; int s9, s10; fill1_ranges(F, ntr0, s9, s10); const int nu = (ntr0 + NT / 256) * 2, hv = nu % F.G;
            if (hv && F.vcu >= hv) cvt_moe_range(F, args, 1, 0, s9, F.vcu - hv, F.G - hv); }
    }
    SEAM(mb + 2);
    if (IN(mb + 3)) REPEAT_IF(mb + 3) { REP_BAR();
        const int nj = moe_units_setup<4>(F, LAYER, ntok, F.vcu, false);
        SchedMoeDN S{(const char*)(ws + M_HID), (const char*)(ws + WS_WDN + (size_t)LAYER * WDN_BYTES), (const LAS int*)(F.lds + AUX_TILEE), nj, F.G, F.vcu};
        EpiF8 E{(unsigned char*)(ws + M_OUT)};
        pg8::gemm_phase<EpiF8, SchedMoeDN, true>(F.lds, DEXP, S, E);
        if (LAYER == 0) { const int ntr0 = ((const LAS int*)(F.lds + AUX_TST))[256]; int s9, s10; fill1_ranges(F, ntr0, s9, s10); const int nu = (ntr0 + NT / 256) * 4, hv = nu % F.G;
            if (hv && F.vcu >= hv) cvt_moe_range(F, args, 1, s9, s9 + s10, F.vcu - hv, F.G - hv); }
    }
    SEAM(mb + 3);
    if (IN(mb + 4)) REPEAT_IF(mb + 4) { REP_BAR();
        RowPhase P{}; P.xin_lat = xw; P.xin_ctx = xw + (size_t)NX * D; P.xout_lat = LAYER ? args.out : xw; P.xout_ctx = xw + (size_t)NX * D; P.nrows = ntok; P.ysrc = 2;
        P.mo8 = (const unsigned char*)(ws + M_OUT); P.tslot = (const int*)(ws + M_TS); P.tgate = (const float*)(ws + M_AG); P.sharedbase = (int)__hip_atomic_load(F.ctl + CW_TST + LAYER * 320 + 256, __ATOMIC_RELAXED, __HIP_MEMORY_SCOPE_AGENT) * 256;
        P.gpost = args.in[9] + LAYER * D; P.modx = lmodx; P.modc = lmodc; P.gate_chunk = 5;
        P.doH = LAYER == 0; P.H = Hb; P.gpre = args.in[6] + D; P.sc_chunk = 1; P.sh_chunk = 0; P.modxH = modx + (size_t)16 * ADA; P.modcH = modc + ADA;
        row_phase(F, P);
        if (LAYER == 0) {
            const int ntr0 = (int)__hip_atomic_load(F.ctl + CW_TST + 256, __ATOMIC_RELAXED, __HIP_MEMORY_SCOPE_AGENT); int s9, s10; fill1_ranges(F, ntr0, s9, s10);
            if (F.G != 256) cvt_moe_range(F, args, 1, 0, MOE_CVT_ITEMS, F.vcu, F.G);
        }
    }
    SEAM(mb + 4);
}

__global__ void __launch_bounds__(NTHREADS, 2) mk_fwd(Args args) {
    extern __shared__ __attribute__((aligned(16))) unsigned char lds_raw[];
    Frame F;
    F.lds = (LAS unsigned char*)lds_raw; F.MISC = (volatile LAS unsigned*)(F.lds + MISC_OFF);
    F.tid = threadIdx.x; F.lane = F.tid & 63; F.wave = __builtin_amdgcn_readfirstlane(F.tid >> 6);
    F.G = gridDim.x; { const int bx = blockIdx.x; F.vcu = (F.G % 8 == 0) ? (bx % 8) * (F.G / 8) + bx / 8 : bx; }
    F.ws = args.ws; F.ctl = (unsigned*)(args.ws + WS_CTL);
    for (int u = F.tid; u < (LDS_BYTES - MISC_OFF) / 4; u += NTHREADS) ((LAS unsigned*)(F.lds + MISC_OFF))[u] = 0u;
    __syncthreads();
    XcdBarrier bar; bar.bar = F.ctl + CW_BAR; bar.x = 0; bar.st = nullptr;
#if MK_ONE_LAUNCH
    bar = xcd_barrier_post(F.ctl + CW_BAR, F.MISC + 8);
#endif
    const int lo = args.ph_lo, hi = args.ph_hi;
    unsigned char* ws = args.ws;
    const float* modx = (const float*)(ws + WS_MODX); const float* modc = (const float*)(ws + WS_MODC);
    float* xw = (float*)(ws + WS_XW); bf16_t* Hb = (bf16_t*)(ws + WS_H);

    if (IN(0)) REPEAT_IF(0) { REP_BAR(); p0_ada(F, args); p0_convert(F, args); }
    SEAM(0);
    {
        if (IN(1)) REPEAT_IF(1) { REP_BAR();
            RowPhase P{}; P.xin_lat = args.in[0]; P.xin_ctx = args.in[2]; P.nrows = NT; P.ysrc = 0; P.modx = modx; P.modc = modc;
            P.doH = true; P.H = Hb; P.gpre = args.in[6]; P.sc_chunk = 1; P.sh_chunk = 0; P.modxH = modx; P.modcH = modc;
            row_phase(F, P);
        }
        SEAM(1);
        if (IN(2)) REPEAT_IF(2) { REP_BAR();
            SchedDense S{(const char*)Hb, (const char*)(ws + WS_WIN0), D, NT / 256, AB_INP / 256, 0, 1, 0, F.G, (int)blockIdx.x};
            EpiInproj E{(bf16_t*)(ws + T_QB), (bf16_t*)(ws + T_KB), (bf16_t*)(ws + T_VB), (bf16_t*)(ws + T_GB), (bf16_t*)(ws + T_UB), (float*)(ws + T_LR), (const f32x2*)(ws + WS_ROPE)};
            pg8::gemm_phase<EpiInproj, SchedDense, true>(F.lds, D, S, E);
            if (F.G == 256 && (int)blockIdx.x >= 48) cvt_moe_range(F, args, 0, F0_BULK, F0_BULK + F0_P2, (int)blockIdx.x - 48, 208);
        }
        SEAM(2);
        if (IN(3)) REPEAT_IF(3) { REP_BAR(); gla_prep_phase(F, args); }
        if (IN(3) && IN(22)) GRID_BAR();
        if (IN(22)) REPEAT_IF(22) { REP_BAR(); gla_seq_phase(F, args); }
        if (IN(22) && IN(4)) GRID_BAR();
        if (IN(4)) REPEAT_IF(4) { REP_BAR(); finish_conv_phase(F, args); }
        SEAM(4);

    }
    layer_tail<0>(F, args, lo, hi, bar);
    {
        if (IN(12)) REPEAT_IF(12) { REP_BAR();
            SchedDense S{(const char*)Hb, (const char*)(ws + WS_WQKV1), D, NX / 256, 12, NC / 256, 8, 4, F.G, (int)blockIdx.x};
            EpiBf16 E{(bf16_t*)(ws + T_QKV), D, D, (size_t)NT * D, 0.125f * 1.4426950408889634f};
            pg8::gemm_phase<EpiBf16, SchedDense, true>(F.lds, D, S, E);
            if (F.G == 256 && (int)blockIdx.x >= 128) cvt_moe_range(F, args, 1, MOE_CVT_ITEMS - F1_P12, MOE_CVT_ITEMS, (int)blockIdx.x - 128, 128);
        }
        SEAM(12);
        if (IN(13)) REPEAT_IF(13) { REP_BAR(); na_phase(F, args); }
        SEAM(13);

    }
    layer_tail<1>(F, args, lo, hi, bar);

#undef IN
#undef SEAM
}

extern "C" void kernel_launch(void* const* d_in, const int* in_sizes, int n_in, void* d_out, int out_size, void* d_ws, size_t ws_size, hipStream_t stream) {
    static int grid = 0;
    if (grid == 0) {
        if (n_in != 32 || out_size != NX * D || ws_size < WS_END) { fprintf(stderr, "kernel_launch: unexpected problem (n_in %d, out %d, ws %zu < %zu)\n", n_in, out_size, ws_size, (size_t)WS_END); grid = -1; return; }
        int dev = 0, cus = 0, per_cu = 0;
        if (hipGetDevice(&dev) != hipSuccess || hipDeviceGetAttribute(&cus, hipDeviceAttributeMultiprocessorCount, dev) != hipSuccess) { grid = -1; return; }
        if (hipFuncSetAttribute((const void*)mk_fwd, hipFuncAttributeMaxDynamicSharedMemorySize, LDS_BYTES) != hipSuccess) { fprintf(stderr, "kernel_launch: hipFuncSetAttribute failed\n"); grid = -1; return; }
        if (hipOccupancyMaxActiveBlocksPerMultiprocessor(&per_cu, (const void*)mk_fwd, NTHREADS, LDS_BYTES) != hipSuccess || per_cu < 1) fprintf(stderr, "kernel_launch: occupancy query says %d\n", per_cu);
        (void)hipGetLastError();
        grid = cus;
    }
    if (grid < 0) return;
    (void)hipMemsetAsync((char*)d_ws + WS_CTL, 0, CTL_BYTES, stream);
    Args a{};
    for (int i = 0; i < 32; ++i) a.in[i] = (const float*)d_in[i];
    a.out = (float*)d_out; a.ws = (unsigned char*)d_ws;
#if MK_ONE_LAUNCH
    a.ph_lo = 0; a.ph_hi = 64;
    hipLaunchKernelGGL(mk_fwd, dim3(grid), dim3(NTHREADS), LDS_BYTES, stream, a);
#else
    for (int p = 0; p <= 20; ++p) { if (p > MK_LAST_PHASE) break; a.ph_lo = p; a.ph_hi = p + 1; hipLaunchKernelGGL(mk_fwd, dim3(grid), dim3(NTHREADS), LDS_BYTES, stream, a); }
#endif
}
```

```cpp
#include <hip/hip_runtime.h>
#include <cstdio>
#include <cstdint>

#ifndef MK_ONE_LAUNCH
#define MK_ONE_LAUNCH 1
#endif
#ifndef MK_LAST_PHASE
#define MK_LAST_PHASE 99
#endif

#ifndef MK_REP
#define MK_REP (-1)
#endif
#define REPEAT_IF(k) _Pragma("unroll") for (int _r = 0; _r < ((k) == MK_REP ? 2 : 1); ++_r)
#define REP_BAR() do { if (_r) GRID_BAR(); } while (0)

#define GAS __attribute__((address_space(1)))
#define LAS __attribute__((address_space(3)))
typedef unsigned short bf16_t;
typedef short bf16x8 __attribute__((ext_vector_type(8)));
typedef float f32x4 __attribute__((ext_vector_type(4)));
typedef float f32x2 __attribute__((ext_vector_type(2)));
typedef unsigned u32x4 __attribute__((ext_vector_type(4)));
typedef unsigned u32x2 __attribute__((ext_vector_type(2)));

constexpr int D = 1024, BATCH = 16, SEQ = 2048, CTXL = 256, GRIDW = 64;
constexpr int NX = BATCH * SEQ, NC = BATCH * CTXL, NT = NX + NC;
constexpr int ADA = 6 * D;
constexpr int GLA_H = 4, GLA_DK = 64, GLA_DV = 128, GLA_QK = 256, GLA_V = 512, CONV_CH = 512, CONV_W = 31;
constexpr int AB_IN = 2592, AB_INP = 2816;
constexpr int NA_H = 16, NA_DH = 64;
constexpr int NEXP = 256, TOPK = 8, DEXP = 256;
constexpr int NEXPS = NEXP + 1;
constexpr int PMAX = NT * TOPK + NEXP * 255 + NT;
static_assert(PMAX % 256 == 0, "PMAX");
constexpr float RMS_EPS = 1e-6f, LN_EPS = 1e-5f;
constexpr float F8_SCALE = 16.0f, F8_INV = 1.0f / 16.0f;

constexpr size_t MiB = 1u << 20;
constexpr size_t al(size_t x) { return (x + 4095) & ~(size_t)4095; }
constexpr size_t WS_CTL = 0, CTL_BYTES = 1 * MiB;
constexpr size_t WS_MODX = WS_CTL + CTL_BYTES;
constexpr size_t WS_MODC = WS_MODX + al((size_t)2 * 16 * ADA * 4);
constexpr size_t WS_ROPE = WS_MODC + al((size_t)2 * ADA * 4);
constexpr size_t WS_XW = WS_ROPE + al(64 * 16 * 8);
constexpr size_t WS_H = WS_XW + al((size_t)NT * D * 4);
constexpr size_t WS_WIN0 = WS_H + al((size_t)NT * D * 2);
constexpr size_t WS_WOUT0 = WS_WIN0 + al((size_t)AB_INP * D * 2);
constexpr size_t WS_WQKV1 = WS_WOUT0 + al((size_t)D * D * 2);
constexpr size_t WS_WOUT1 = WS_WQKV1 + al((size_t)3 * D * D * 2);
constexpr size_t WS_WR = WS_WOUT1 + al((size_t)D * D * 2);
constexpr size_t WGU_BYTES = al((size_t)NEXPS * 512 * D * 2), WDN_BYTES = al((size_t)NEXPS * D * 256 * 2);
constexpr size_t WS_WGU = WS_WR + al((size_t)2 * NEXP * D * 2);
constexpr size_t WS_WDN = WS_WGU + 2 * WGU_BYTES;
constexpr size_t WS_T = WS_WDN + 2 * WDN_BYTES;
constexpr size_t T_QB = WS_T;
constexpr size_t T_KB = T_QB + al((size_t)NT * 256 * 2);
constexpr size_t T_VB = T_KB + al((size_t)NT * 256 * 2);
constexpr size_t T_GB = T_VB + al((size_t)NT * 512 * 2);
constexpr size_t T_UB = T_GB + al((size_t)NT * 512 * 2);
constexpr size_t T_LR = T_UB + al((size_t)NT * 512 * 2);
constexpr size_t T_OF = T_LR + al((size_t)NT * 32 * 4);
constexpr size_t T_OB = T_OF + al((size_t)NT * 512 * 2);
constexpr size_t T_CAT = T_OB + al((size_t)NT * 512 * 2);
constexpr size_t T_Y = T_CAT + al((size_t)NT * D * 2);
constexpr size_t T_GLA = T_Y + al((size_t)NT * D * 2);
constexpr int GI_A = 0, GI_QIN = 8192, GI_KOT = 16384, GI_VT = 24576, GI_DEC = 40960, GI_BYTES = 41216;
constexpr size_t T_END0 = T_GLA + al((size_t)BATCH * GLA_H * 2 * 36 * GI_BYTES + 1024);
constexpr size_t T_QKV = WS_T;
static_assert(T_QKV + (size_t)3 * NT * D * 2 <= T_CAT, "qkv overlay");
constexpr size_t M_AE = WS_T;
constexpr size_t M_AR = M_AE + al((size_t)NT * 8 * 4);
constexpr size_t M_AG = M_AR + al((size_t)NT * 8 * 4);
constexpr size_t M_TS = M_AG + al((size_t)NT * 8 * 4);
constexpr size_t M_ST = M_TS + al((size_t)NT * 8 * 4);
constexpr size_t M_HID = M_ST + al((size_t)PMAX * 4);
constexpr size_t M_OUT = M_HID + al((size_t)PMAX * 256 * 2);
constexpr int MO_LD = 1024;
constexpr size_t M_END = M_OUT + al((size_t)PMAX * D);
constexpr size_t WS_END = (M_END > T_END0 ? M_END : T_END0);
static_assert(WS_END <= (size_t)2040 * MiB, "workspace map must fit 2 GiB");

constexpr int CW_BAR = 4096;
constexpr int CW_CNT = 16384;
constexpr int CW_CUR = 16384 + 512;

constexpr int RING_BYTES = 131072;
constexpr int AUX_OFF = RING_BYTES, AUX_BYTES = 31744;
constexpr int MISC_OFF = AUX_OFF + AUX_BYTES;
constexpr int LDS_BYTES = MISC_OFF + 1024;
constexpr int NWAVES = 8, NTHREADS = 512;

#define LDS_WAIT() asm volatile("s_waitcnt lgkmcnt(0)" ::: "memory")
#define VM_WAIT() asm volatile("s_waitcnt vmcnt(0)" ::: "memory")

__device__ __forceinline__ unsigned f2bf(float f) { unsigned u = __builtin_bit_cast(unsigned, f); return (u + 0x7fffu + ((u >> 16) & 1u)) >> 16; }
__device__ __forceinline__ unsigned pk2(float lo, float hi) { return f2bf(lo) | (f2bf(hi) << 16); }
__device__ __forceinline__ float bf2f(unsigned short b) { return __builtin_bit_cast(float, (unsigned)b << 16); }
__device__ __forceinline__ float bflo(unsigned w) { return __builtin_bit_cast(float, w << 16); }
__device__ __forceinline__ float bfhi(unsigned w) { return __builtin_bit_cast(float, w & 0xffff0000u); }
__device__ __forceinline__ float wave_sum(float v) {
#pragma unroll
    for (int o = 1; o < 64; o <<= 1) v += __shfl_xor(v, o);
    return v;
}
__device__ __forceinline__ float sigmoidf_(float x) { return 1.0f / (1.0f + __expf(-x)); }
__device__ __forceinline__ float siluf_(float x) { return x / (1.0f + __expf(-x)); }

__device__ __forceinline__ void lds_barrier() { asm volatile("s_waitcnt lgkmcnt(0)" ::: "memory"); __builtin_amdgcn_s_barrier(); asm volatile("" ::: "memory"); }
#define XB_TMO      128
#define XB_XCNT(j)  (256  + 64 * (j))
#define XB_XSUB(j)  (1280 + 64 * (j))
#define XB_XGEN(j)  (2304 + 64 * (j))
#define XB_TOP      3328
#define XB_TOPGEN   3392
#define XCD_BAR_WORDS 3456
#define XB_SPIN_CAP (1u << 18)

__device__ __forceinline__ unsigned xb_ld(unsigned* p)              { return __hip_atomic_load(p, __ATOMIC_RELAXED, __HIP_MEMORY_SCOPE_AGENT); }
__device__ __forceinline__ unsigned xb_add(unsigned* p, unsigned v) { return __hip_atomic_fetch_add(p, v, __ATOMIC_RELAXED, __HIP_MEMORY_SCOPE_AGENT); }
__device__ __forceinline__ unsigned xb_xcc_id() { return (unsigned)__builtin_amdgcn_s_getreg((3 << 11) | 20) & 0xFu; }
#define XB_SPIN(cond, bar) do { unsigned _sp = 0; while (cond) { __builtin_amdgcn_s_sleep(1); \
    if ((++_sp & 255u) == 0u) { if (xb_ld(&(bar)[XB_TMO])) break; if (_sp > XB_SPIN_CAP) { atomicAdd(&(bar)[XB_TMO], 1u); break; } } } } while (0)

struct XcdBarrier { unsigned* bar; unsigned x; volatile LAS unsigned* st; };

__device__ __forceinline__ XcdBarrier xcd_barrier_post(unsigned* bar, volatile LAS unsigned* st) {
    XcdBarrier b; b.bar = bar; b.x = xb_xcc_id(); b.st = st;
    if (threadIdx.x == 0) (void)xb_add(&bar[XB_XCNT(b.x)], 1u);
    return b;
}
__device__ __forceinline__ void xcd_barrier_complete(unsigned* bar, unsigned x, unsigned& nloc, unsigned& nx) {
    const unsigned G = gridDim.x * gridDim.y * gridDim.z;
    unsigned sum, cnt, mine, sp = 0u;
    for (;;) {
        sum = 0u; cnt = 0u; mine = 0u;
#pragma unroll
        for (unsigned j = 0; j < 16; ++j) { const unsigned c = xb_ld(&bar[XB_XCNT(j)]); sum += c; cnt += (c > 0u) ? 1u : 0u; mine = (j == x) ? c : mine; }
        if (sum == G) break;
        __builtin_amdgcn_s_sleep(1);
        if ((++sp & 255u) == 0u) { if (xb_ld(&bar[XB_TMO])) break; if (sp > XB_SPIN_CAP) { atomicAdd(&bar[XB_TMO], 1u); break; } }
    }
    nloc = mine > 0u ? mine : 1u; nx = cnt > 0u ? cnt : 1u;
}
__device__ __forceinline__ void xcd_barrier(const XcdBarrier& b) {
    asm volatile("s_waitcnt vmcnt(0)" ::: "memory");
    __syncthreads();
    if (threadIdx.x == 0) {
        unsigned* bar = b.bar;
        __builtin_amdgcn_s_waitcnt(0);
        unsigned nloc = b.st[0], nx = b.st[1];
        if (nloc == 0u) { xcd_barrier_complete(bar, b.x, nloc, nx); b.st[0] = nloc; b.st[1] = nx; }
        const unsigned old = xb_add(&bar[XB_XSUB(b.x)], 1u);
        const unsigned gen = old / nloc;
        if (old + 1u == (gen + 1u) * nloc) {
            __builtin_amdgcn_fence(__ATOMIC_RELEASE, "agent");
            asm volatile("s_waitcnt vmcnt(0)" ::: "memory");
            const unsigned og = xb_add(&bar[XB_TOP], 1u);
            const unsigned tg = og / nx;
            if (og + 1u == (tg + 1u) * nx) xb_add(&bar[XB_TOPGEN], 1u);
            else XB_SPIN(xb_ld(&bar[XB_TOPGEN]) == tg, bar);
            __builtin_amdgcn_fence(__ATOMIC_ACQUIRE, "agent");
            xb_add(&bar[XB_XGEN(b.x)], 1u);
            asm volatile("s_waitcnt vmcnt(0)" ::: "memory");
        } else {
            XB_SPIN(xb_ld(&bar[XB_XGEN(b.x)]) == gen, bar);
            __builtin_amdgcn_fence(__ATOMIC_ACQUIRE, "agent");
            asm volatile("s_waitcnt vmcnt(0)" ::: "memory");
        }
    }
    __syncthreads();
}

namespace pg8 {
constexpr int BM = 256, BK = 64, HALF = 128, HTB = HALF * BK * 2, STAGE_BYTES = 8 * HTB, NXCD = 8, WGM = 8;
__host__ __device__ __forceinline__ int lds_byte(int r, int c) { const int st = (r >> 4) * 2 + (c >> 5), rr = r & 15, cc = c & 31, ob = rr * 64 + cc * 2; return st * 1024 + (ob ^ (((ob >> 9) & 1) << 5)); }
__host__ __device__ __forceinline__ void stage_rc(int b, int& R, int& C) { const int st = b / 1024, sb = b % 1024, swz = sb ^ (((sb >> 9) & 1) << 5); R = (st >> 1) * 16 + swz / 64; C = (st & 1) * 32 + (swz % 64) / 2; }
__host__ __device__ __forceinline__ int perm32(int rho) { const int n = rho >> 4, i = rho & 15; return 8 * (i >> 2) + 4 * n + (i & 3); }

struct Unit { int a, b, orow, ocol, aux; };

__device__ __forceinline__ bool static_order(int L, int nM, int nN, int& pm, int& pn) {
    const int nwg = nM * nN; if (L >= nwg) return false;
    int wgid = L; { const int q = nwg / NXCD, r = nwg % NXCD, xcd = wgid % NXCD, off = wgid / NXCD; wgid = (xcd < r ? xcd * (q + 1) : r * (q + 1) + (xcd - r) * q) + off; }
    const int nig = WGM * nN, gid = wgid / nig, fm = gid * WGM, gsz = (nM - fm) < WGM ? (nM - fm) : WGM;
    pm = fm + ((wgid % nig) % gsz); pn = (wgid % nig) / gsz; return true;
}

template <class Epi, class Sched, bool ALIGN_EPI>
__device__ __forceinline__ void gemm_phase(LAS unsigned char* lds, const int K, const Sched& S, const Epi& E) {
    const int tid = threadIdx.x, wid = __builtin_amdgcn_readfirstlane(tid >> 6), lane = tid & 63, wr = wid >> 2, wc = wid & 3, fr = lane & 15, fq = lane >> 4;
    const int nt = K / BK;
    int Rr[2], Cc[2]; unsigned voffB[2];
#pragma unroll
    for (int i = 0; i < 2; ++i) { int R, C; stage_rc(tid * 16 + i * 8192, R, C); Rr[i] = R; Cc[i] = C; const int Rb = Epi::PERM ? ((R & ~31) + perm32(R & 31)) : R; voffB[i] = (unsigned)(Rb * K + C) * 2u; }
    const size_t kstep = (size_t)(BK * 2);
    const size_t hstepB = (size_t)HALF * K * 2;
    const unsigned ldsw = (unsigned)wid * 1024u;
    const int aoff = lds_byte(wr * 64 + fr, fq * 8), boff = lds_byte(wc * 32 + fr, fq * 8);
#define PG8_SA(b, h) (((b) * 2 + (h)) * HTB)
#define PG8_SB(b, h) ((4 + (b) * 2 + (h)) * HTB)
#define PG8_STAGE(bufoff, gbase, voff) do { _Pragma("unroll") for (int _i = 0; _i < 2; ++_i) \
        __builtin_amdgcn_global_load_lds((const unsigned*)((const char*)(gbase) + (voff)[_i]), (LAS unsigned*)(lds + (bufoff) + ldsw + _i * 8192), 16, 0, 0); } while (0)
#define PG8_LDA(dst, b, h) do { _Pragma("unroll") for (int m = 0; m < 4; ++m) _Pragma("unroll") for (int k = 0; k < 2; ++k) dst[m][k] = *(const LAS bf16x8*)(lds + PG8_SA(b, h) + aoff + m * 2048 + k * 1024); } while (0)
#define PG8_LDB(dst, b, h) do { _Pragma("unroll") for (int n = 0; n < 2; ++n) _Pragma("unroll") for (int k = 0; k < 2; ++k) dst[n][k] = *(const LAS bf16x8*)(lds + PG8_SB(b, h) + boff + n * 2048 + k * 1024); } while (0)
#define PG8_MMA(ai, bj, At, Bt) do { __builtin_amdgcn_s_setprio(1); _Pragma("unroll") for (int m = 0; m < 4; ++m) _Pragma("unroll") for (int n = 0; n < 2; ++n) _Pragma("unroll") for (int k = 0; k < 2; ++k) \
        acc[ai][bj][m][n] = __builtin_amdgcn_mfma_f32_16x16x32_bf16(Bt[n][k], At[m][k], acc[ai][bj][m][n], 0, 0, 0); __builtin_amdgcn_s_setprio(0); } while (0)
#define PG8_WAIT_V(n) asm volatile("s_waitcnt vmcnt(" #n ")" ::: "memory")
#define PG8_WAIT_L(n) asm volatile("s_waitcnt lgkmcnt(" #n ")" ::: "memory")
#define PG8_BAR __builtin_amdgcn_s_barrier()
#define PG8_SCHED __builtin_amdgcn_sched_barrier(0)
    Unit cur, nxt; int ui = 0;
    if (!S.next(0, cur)) return;
    f32x4 acc[2][2][4][2];
#pragma unroll
    for (int a = 0; a < 2; ++a)
#pragma unroll
        for (int b = 0; b < 2; ++b)
#pragma unroll
            for (int m = 0; m < 4; ++m)
#pragma unroll
                for (int n = 0; n < 2; ++n) acc[a][b][m][n] = (f32x4){0.f, 0.f, 0.f, 0.f};
    bf16x8 At[4][2], B0[2][2], B1[2][2];
    unsigned co0[2], co1[2], no0[2], no1[2];
    S.a_off(cur, Rr, Cc, co0, co1);
    const char* const Ab = S.a_base();
    const char* cB = S.b_ptr(cur);
    PG8_STAGE(PG8_SB(0, 0), cB, voffB); PG8_STAGE(PG8_SB(0, 1), cB + hstepB, voffB); PG8_STAGE(PG8_SA(0, 0), Ab, co0); PG8_STAGE(PG8_SA(0, 1), Ab, co1);
    if (wr == 1) PG8_BAR;
    PG8_WAIT_V(2); PG8_BAR;
    PG8_STAGE(PG8_SB(1, 0), cB + kstep, voffB); PG8_STAGE(PG8_SA(1, 0), Ab + kstep, co0); PG8_STAGE(PG8_SB(1, 1), cB + hstepB + kstep, voffB);
    PG8_WAIT_V(6); PG8_BAR;
    for (;;) {
        const bool has_next = S.next(ui + 1, nxt);
        const char* nB = has_next ? S.b_ptr(nxt) : cB;
#pragma nounroll
        for (int t = 0; t < nt; t += 2) {
            const bool last = (t == nt - 2);
            if (last) { if (has_next) S.a_off(nxt, Rr, Cc, no0, no1); else { no0[0] = co0[0]; no0[1] = co0[1]; no1[0] = co1[0]; no1[1] = co1[1]; } }
            const char* a1 = Ab + (size_t)(t + 1) * kstep;
            const char* a2 = last ? Ab : Ab + (size_t)(t + 2) * kstep; const char* b2 = last ? nB : cB + (size_t)(t + 2) * kstep;
            const char* a3 = a2 + kstep; const char* b3 = b2 + kstep;
            unsigned x0[2], x1[2];
            x0[0] = last ? no0[0] : co0[0]; x0[1] = last ? no0[1] : co0[1]; x1[0] = last ? no1[0] : co1[0]; x1[1] = last ? no1[1] : co1[1];
            PG8_LDB(B0, 0, 0); PG8_LDB(B1, 0, 1); PG8_SCHED; PG8_LDA(At, 0, 0); PG8_STAGE(PG8_SA(1, 1), a1, co1);
            PG8_WAIT_V(8); PG8_WAIT_L(0); PG8_BAR; PG8_MMA(0, 0, At, B0); PG8_MMA(0, 1, At, B1); PG8_BAR; PG8_SCHED;
            PG8_LDA(At, 0, 1); PG8_STAGE(PG8_SB(0, 0), b2, voffB); PG8_STAGE(PG8_SB(0, 1), b2 + hstepB, voffB); PG8_STAGE(PG8_SA(0, 0), a2, x0);
            PG8_WAIT_V(8); PG8_WAIT_L(0); PG8_BAR; PG8_MMA(1, 0, At, B0); PG8_MMA(1, 1, At, B1); PG8_BAR; PG8_SCHED;
            PG8_LDB(B0, 1, 0); PG8_LDB(B1, 1, 1); PG8_SCHED; PG8_LDA(At, 1, 0); PG8_STAGE(PG8_SA(0, 1), a2, x1);
            PG8_WAIT_V(8); PG8_WAIT_L(0); PG8_BAR; PG8_MMA(0, 0, At, B0); PG8_MMA(0, 1, At, B1); PG8_BAR; PG8_SCHED;
            PG8_LDA(At, 1, 1); PG8_STAGE(PG8_SB(1, 0), b3, voffB); PG8_STAGE(PG8_SB(1, 1), b3 + hstepB, voffB); PG8_STAGE(PG8_SA(1, 0), a3, x0);
            PG8_WAIT_V(8); PG8_WAIT_L(0); PG8_BAR; PG8_MMA(1, 0, At, B0); PG8_MMA(1, 1, At, B1); PG8_BAR; PG8_SCHED;
        }
        if constexpr (ALIGN_EPI) { if (wr == 0) PG8_BAR; }
        if constexpr (!Epi::AFTER_DRAIN) { E(acc, cur, wr, wc, fr, fq); }
        if (!has_next) break;
#pragma unroll
        for (int a = 0; a < 2; ++a)
#pragma unroll
            for (int b = 0; b < 2; ++b)
#pragma unroll
                for (int m = 0; m < 4; ++m)
#pragma unroll
                    for (int n = 0; n < 2; ++n) acc[a][b][m][n] = (f32x4){0.f, 0.f, 0.f, 0.f};
        cur = nxt; cB = nB; co0[0] = no0[0]; co0[1] = no0[1]; co1[0] = no1[0]; co1[1] = no1[1]; ++ui;
        if constexpr (ALIGN_EPI) { if (wr == 1) PG8_BAR; }
    }
    PG8_WAIT_V(0);
    if constexpr (!ALIGN_EPI) { if (wr == 0) PG8_BAR; }
    PG8_BAR;
    if constexpr (Epi::AFTER_DRAIN) { E.fused(acc, cur, wr, wc, fr, fq, lds, wid, lane); }
#undef PG8_SA
#undef PG8_SB
#undef PG8_STAGE
#undef PG8_LDA
#undef PG8_LDB
#undef PG8_MMA
#undef PG8_WAIT_V
#undef PG8_WAIT_L
#undef PG8_BAR
#undef PG8_SCHED
}
}
using pg8::Unit;

__device__ __forceinline__ unsigned cvt_pk_bf16(float lo, float hi) { unsigned r; asm volatile("v_cvt_pk_bf16_f32 %0, %1, %2" : "=v"(r) : "v"(lo), "v"(hi)); return r; }

struct SchedDense {
    const char* A; const char* Bt; int K; int nM0, nN0, nM1, nN1, pn1off; int G, c;
    __device__ __forceinline__ bool next(int i, Unit& u) const {
        const int L = i * G + c; int pm, pn;
        const int n0 = nM0 * nN0;
        if (L < n0) { pg8::static_order(L, nM0, nN0, pm, pn); }
        else { if (!pg8::static_order(L - n0, nM1, nN1, pm, pn)) return false; pm += nM0; pn += pn1off; }
        u.a = pm; u.b = pn * 256; u.orow = pm * 256; u.ocol = pn * 256; u.aux = pn; return true;
    }
    __device__ __forceinline__ const char* a_base() const { return A; }
    __device__ __forceinline__ const char* b_ptr(const Unit& u) const { return Bt + (size_t)u.b * K * 2; }
    __device__ __forceinline__ void a_off(const Unit& u, const int (&R)[2], const int (&C)[2], unsigned (&o0)[2], unsigned (&o1)[2]) const {
#pragma unroll
        for (int i = 0; i < 2; ++i) { o0[i] = (unsigned)((u.a * 256 + R[i]) * K + C[i]) * 2u; o1[i] = o0[i] + (unsigned)(128 * K * 2); }
    }
};

struct EpiBf16 {
    static constexpr bool PERM = true, AFTER_DRAIN = false;
    bf16_t* O; int ldc; int split_cols; size_t split_stride; float scale0 = 1.0f;
    __device__ __forceinline__ void operator()(const f32x4 (&acc)[2][2][4][2], const Unit& u, int wr, int wc, int fr, int fq) const {
        const int lane = fr + 16 * fq; const int srcb = ((lane >> 2) + 16 * (lane & 3)) << 2;
        const int row0 = u.orow + wr * 64 + (lane >> 2); int colt = u.ocol; bf16_t* base = O;
        float sc = 1.0f;
        if (split_cols) { const int t = colt / split_cols; base += (size_t)t * split_stride; colt -= t * split_cols; if (t == 0) sc = scale0; }
        const int col0 = colt + wc * 32 + 8 * (lane & 3);
#pragma unroll
        for (int ai = 0; ai < 2; ++ai)
#pragma unroll
            for (int m = 0; m < 4; ++m) { bf16_t* rowp = base + (size_t)(row0 + ai * 128 + m * 16) * ldc + col0;
#pragma unroll
                for (int bj = 0; bj < 2; ++bj) { const f32x4 v0 = acc[ai][bj][m][0] * sc, v1 = acc[ai][bj][m][1] * sc;
                    u32x4 w; w.x = cvt_pk_bf16(v0[0], v0[1]); w.y = cvt_pk_bf16(v0[2], v0[3]); w.z = cvt_pk_bf16(v1[0], v1[1]); w.w = cvt_pk_bf16(v1[2], v1[3]);
                    u32x4 t; t.x = (unsigned)__builtin_amdgcn_ds_bpermute(srcb, (int)w.x); t.y = (unsigned)__builtin_amdgcn_ds_bpermute(srcb, (int)w.y); t.z = (unsigned)__builtin_amdgcn_ds_bpermute(srcb, (int)w.z); t.w = (unsigned)__builtin_amdgcn_ds_bpermute(srcb, (int)w.w);
                    *(u32x4*)(rowp + bj * 128) = t; } }
    }
};
struct EpiF8 {
    static constexpr bool PERM = true, AFTER_DRAIN = false;
    unsigned char* O;
    __device__ __forceinline__ int nst(const Unit&, int) const { return 16; }
    __device__ __forceinline__ void operator()(const f32x4 (&acc)[2][2][4][2], const Unit& u, int wr, int wc, int fr, int fq) const {
        const int lane = fr + 16 * fq; const int srcb = ((lane >> 2) + 16 * (lane & 3)) << 2;
        const int row0 = u.orow + wr * 64 + (lane >> 2), col0 = u.ocol + wc * 32 + 8 * (lane & 3);
#pragma unroll
        for (int ai = 0; ai < 2; ++ai)
#pragma unroll
            for (int m = 0; m < 4; ++m) { unsigned char* rowp = O + (size_t)(row0 + ai * 128 + m * 16) * D + col0;
#pragma unroll
                for (int bj = 0; bj < 2; ++bj) { const f32x4 v0 = acc[ai][bj][m][0] * F8_SCALE, v1 = acc[ai][bj][m][1] * F8_SCALE;
                    int w0 = __builtin_amdgcn_cvt_pk_fp8_f32(v0[0], v0[1], 0, false); w0 = __builtin_amdgcn_cvt_pk_fp8_f32(v0[2], v0[3], w0, true);
                    int w1 = __builtin_amdgcn_cvt_pk_fp8_f32(v1[0], v1[1], 0, false); w1 = __builtin_amdgcn_cvt_pk_fp8_f32(v1[2], v1[3], w1, true);
                    u32x2 t; t.x = (unsigned)__builtin_amdgcn_ds_bpermute(srcb, w0); t.y = (unsigned)__builtin_amdgcn_ds_bpermute(srcb, w1);
                    *(u32x2*)(rowp + bj * 128) = t; } }
    }
};
struct EpiInproj {
    static constexpr bool PERM = false, AFTER_DRAIN = false;
    bf16_t *qb, *kb, *vb, *gb, *ub; float* lr; const f32x2* rope;
    __device__ __forceinline__ void operator()(const f32x4 (&acc)[2][2][4][2], const Unit& u, int wr, int wc, int fr, int fq) const {
        const int pn = u.aux; const int row0 = u.orow + wr * 64 + fr;
        if (pn <= 1) {
            bf16_t* dst = pn == 0 ? qb : kb; const float sc = pn == 0 ? 0.125f : 1.0f;
#pragma unroll
            for (int ai = 0; ai < 2; ++ai)
#pragma unroll
                for (int m = 0; m < 4; ++m) {
                    const int row = row0 + ai * 128 + m * 16; const bool lat = row < NX;
                    const int s = row & (SEQ - 1); const int pos = (wc & 1) ? (s & 63) : (s >> 6);
                    f32x2 cs[4];
                    if (lat) {
#pragma unroll
                        for (int e = 0; e < 4; ++e) cs[e] = rope[pos * 16 + 4 * fq + e];
                    } else {
#pragma unroll
                        for (int e = 0; e < 4; ++e) cs[e] = (f32x2){1.f, 0.f};
                    }
#pragma unroll
                    for (int bj = 0; bj < 2; ++bj) {
                        const f32x4 u1 = acc[ai][bj][m][0], u2 = acc[ai][bj][m][1]; f32x4 o1, o2;
#pragma unroll
                        for (int e = 0; e < 4; ++e) { o1[e] = (u1[e] * cs[e].x - u2[e] * cs[e].y) * sc; o2[e] = (u1[e] * cs[e].y + u2[e] * cs[e].x) * sc; }
                        bf16_t* p = dst + (size_t)row * 256 + bj * 128 + wc * 32 + 4 * fq;
                        u32x2 w1, w2; w1.x = cvt_pk_bf16(o1[0], o1[1]); w1.y = cvt_pk_bf16(o1[2], o1[3]); w2.x = cvt_pk_bf16(o2[0], o2[1]); w2.y = cvt_pk_bf16(o2[2], o2[3]);
                        *(u32x2*)p = w1; *(u32x2*)(p + 16) = w2;
                    }
                }
        } else if (pn <= 5) {
            bf16_t* dst = pn <= 3 ? vb : gb; const int cb = (pn & 1) ? 256 : 0;
#pragma unroll
            for (int ai = 0; ai < 2; ++ai)
#pragma unroll
                for (int m = 0; m < 4; ++m) { const int row = row0 + ai * 128 + m * 16;
#pragma unroll
                    for (int bj = 0; bj < 2; ++bj)
#pragma unroll
                        for (int n = 0; n < 2; ++n) { const f32x4 v = acc[ai][bj][m][n]; u32x2 w; w.x = cvt_pk_bf16(v[0], v[1]); w.y = cvt_pk_bf16(v[2], v[3]);
                            *(u32x2*)(dst + (size_t)row * 512 + cb + bj * 128 + wc * 32 + n * 16 + 4 * fq) = w; } }
        } else if (pn <= 9) {
            const int cb = (pn - 6) * 128;
#pragma unroll
            for (int ai = 0; ai < 2; ++ai)
#pragma unroll
                for (int m = 0; m < 4; ++m) { const int row = row0 + ai * 128 + m * 16;
#pragma unroll
                    for (int n = 0; n < 2; ++n) { const f32x4 a = acc[ai][0][m][n], b = acc[ai][1][m][n]; f32x4 o;
#pragma unroll
                        for (int e = 0; e < 4; ++e) o[e] = a[e] * sigmoidf_(b[e]);
                        u32x2 w; w.x = cvt_pk_bf16(o[0], o[1]); w.y = cvt_pk_bf16(o[2], o[3]);
                        *(u32x2*)(ub + (size_t)row * 512 + cb + wc * 32 + n * 16 + 4 * fq) = w; } }
        } else {
            if (wc == 0) {
#pragma unroll
                for (int ai = 0; ai < 2; ++ai)
#pragma unroll
                    for (int m = 0; m < 4; ++m) { const int row = row0 + ai * 128 + m * 16;
#pragma unroll
                        for (int n = 0; n < 2; ++n) *(f32x4*)(lr + (size_t)row * 32 + n * 16 + 4 * fq) = acc[ai][0][m][n]; }
            }
        }
    }
};

struct Args { const float* in[32]; float* out; unsigned char* ws; int ph_lo, ph_hi; };

struct Frame {
    LAS unsigned char* lds; volatile LAS unsigned* MISC; unsigned* ctl; unsigned char* ws;
    int tid, lane, wave, G, vcu;
};

__device__ __forceinline__ void cvt_item(const float* __restrict__ src, int ld, int col0, int ncols, int k0, bf16_t* dst, int ldd, int drow0, LAS unsigned* T, int lane) {
    const bool okc = lane < ncols;
    const float* p = src + (size_t)k0 * ld + col0 + (okc ? lane : 0);
    float v[64];
#pragma unroll
    for (int k = 0; k < 64; ++k) v[k] = __builtin_nontemporal_load(p + (size_t)k * ld);
#pragma unroll
    for (int kp = 0; kp < 32; ++kp) T[lane * 33 + kp] = okc ? pk2(v[2 * kp], v[2 * kp + 1]) : 0u;
    LDS_WAIT(); asm volatile("" ::: "memory");
    const int c = lane & 7;
#pragma unroll
    for (int it = 0; it < 8; ++it) { const int n = (lane >> 3) + 8 * it;
        u32x4 o; o.x = T[n * 33 + 4 * c]; o.y = T[n * 33 + 4 * c + 1]; o.z = T[n * 33 + 4 * c + 2]; o.w = T[n * 33 + 4 * c + 3];
        if (n < ncols) __builtin_nontemporal_store(o, (u32x4*)(dst + (size_t)(drow0 + n) * ldd + k0 + 8 * c)); }
    LDS_WAIT(); asm volatile("" ::: "memory");
}
__device__ __forceinline__ void cvt_matrix_item(const float* src, int ld, int col0, int ncols, int K, bf16_t* dst, int drow0, int item, LAS unsigned* T, int lane) {
    const int ncg = (ncols + 63) >> 6; const int kt = item / ncg, cg = item - kt * ncg;
    const int nc = ncols - cg * 64 < 64 ? ncols - cg * 64 : 64;
    cvt_item(src, ld, col0 + cg * 64, nc, kt * 64, dst, K, drow0 + cg * 64, T, lane);
}

constexpr int MOE_CVT_ITEMS = NEXPS * 192;
__device__ __forceinline__ void cvt_moe_item(const Args& a, int layer, int item, unsigned char* ws, LAS unsigned* T, int lane) {
    const int e = item / 192, r = item - e * 192;
    bf16_t* wgu = (bf16_t*)(ws + WS_WGU + (size_t)layer * WGU_BYTES) + (size_t)e * 512 * D; bf16_t* wdn = (bf16_t*)(ws + WS_WDN + (size_t)layer * WDN_BYTES) + (size_t)e * D * 256;
    if (r < 128) {
        const int kt = r >> 3, gi = r & 7; const int up = gi >> 2, g4 = gi & 3;
        const float* src = e < NEXP ? (up ? a.in[27] : a.in[26]) + ((size_t)layer * NEXP + e) * D * DEXP : (up ? a.in[30] : a.in[29]) + (size_t)layer * D * DEXP;
        cvt_item(src, DEXP, 64 * g4, 64, kt * 64, wgu, D, 256 * (g4 >> 1) + 64 * (g4 & 1) + 128 * up, T, lane);
    } else {
        const int q = r - 128; const int kt = q >> 4, cg = q & 15;
        const float* src = e < NEXP ? a.in[28] + ((size_t)layer * NEXP + e) * DEXP * D : a.in[31] + (size_t)layer * DEXP * D;
        cvt_item(src, D, 64 * cg, 64, kt * 64, wdn, DEXP, 64 * cg, T, lane);
    }
}

__device__ __forceinline__ float row_rms_scale(const f32x4 (&v)[4]) {
    float s = 0.f;
#pragma unroll
    for (int j = 0; j < 4; ++j) s += (v[j].x * v[j].x + v[j].y * v[j].y) + (v[j].z * v[j].z + v[j].w * v[j].w);
    return rsqrtf(wave_sum(s) * (1.0f / D) + RMS_EPS);
}
__device__ __forceinline__ f32x4 ld4(const float* p) { return *(const f32x4*)p; }

struct RowPhase {
    const float* xin_lat; const float* xin_ctx;
    float* xout_lat; float* xout_ctx;
    int nrows;
    int ysrc; const bf16_t* y;
    const unsigned char* mo8; const int* tslot; const float* tgate; int sharedbase;
    const float* gpost; const float* modx; const float* modc; int gate_chunk;
    bool doH; bf16_t* H; const float* gpre; int sc_chunk, sh_chunk; const float* modxH; const float* modcH;
};
__device__ __forceinline__ void row_phase(const Frame& F, const RowPhase& P) {
    const int gw = F.vcu * NWAVES + F.wave, NGW = F.G * NWAVES, lane = F.lane;
    for (int row = gw; row < P.nrows; row += NGW) {
        const bool lat = row < NX; const int b = lat ? (row >> 11) : 0;
        const float* mod = lat ? P.modx + (size_t)b * ADA : P.modc;
        const float* xr = lat ? P.xin_lat + (size_t)row * D : P.xin_ctx + (size_t)(row - NX) * D;
        f32x4 x[4];
#pragma unroll
        for (int j = 0; j < 4; ++j) x[j] = ld4(xr + 4 * lane + 256 * j);
        if (P.ysrc) {
            f32x4 y[4];
            if (P.ysrc == 1) {
#pragma unroll
                for (int j = 0; j < 4; ++j) { const u32x2 w = __builtin_nontemporal_load((const u32x2*)(P.y + (size_t)row * D + 4 * lane + 256 * j)); y[j] = (f32x4){bflo(w.x), bfhi(w.x), bflo(w.y), bfhi(w.y)}; }
            } else {
#pragma unroll
                for (int j = 0; j < 4; ++j) { const int w = __builtin_nontemporal_load((const int*)(P.mo8 + (size_t)(P.sharedbase + row) * D + 4 * lane + 256 * j)); const f32x2 lo = __builtin_amdgcn_cvt_pk_f32_fp8(w, false), hi = __builtin_amdgcn_cvt_pk_f32_fp8(w, true); y[j] = (f32x4){lo.x, lo.y, hi.x, hi.y} * F8_INV; }
#pragma unroll
                for (int k = 0; k < TOPK; ++k) { const int sl = P.tslot[(size_t)row * 8 + k]; const float g = P.tgate[(size_t)row * 8 + k] * F8_INV;
#pragma unroll
                    for (int j = 0; j < 4; ++j) { const int w = __builtin_nontemporal_load((const int*)(P.mo8 + (size_t)sl * D + 4 * lane + 256 * j)); const f32x2 lo = __builtin_amdgcn_cvt_pk_f32_fp8(w, false), hi = __builtin_amdgcn_cvt_pk_f32_fp8(w, true);
                        y[j].x += g * lo.x; y[j].y += g * lo.y; y[j].z += g * hi.x; y[j].w += g * hi.y; } }
            }
            const float rs = row_rms_scale(y);
#pragma unroll
            for (int j = 0; j < 4; ++j) { const f32x4 gp = ld4(P.gpost + 4 * lane + 256 * j), gt = ld4(mod + P.gate_chunk * D + 4 * lane + 256 * j); x[j] = x[j] + gt * (y[j] * rs * gp); }
            float* xo = lat ? P.xout_lat + (size_t)row * D : P.xout_ctx + (size_t)(row - NX) * D;
#pragma unroll
            for (int j = 0; j < 4; ++j) *(f32x4*)(xo + 4 * lane + 256 * j) = x[j];
        }
        if (P.doH) {
            const float rs = row_rms_scale(x); const float* modh = lat ? P.modxH + (size_t)b * ADA : P.modcH;
#pragma unroll
            for (int j = 0; j < 4; ++j) { const f32x4 gp = ld4(P.gpre + 4 * lane + 256 * j), sc = ld4(modh + P.sc_chunk * D + 4 * lane + 256 * j), sh = ld4(modh + P.sh_chunk * D + 4 * lane + 256 * j);
                const f32x4 h = x[j] * rs * gp * (sc + 1.0f) + sh; u32x2 w; w.x = pk2(h.x, h.y); w.y = pk2(h.z, h.w);
                *(u32x2*)(P.H + (size_t)row * D + 4 * lane + 256 * j) = w; }
        }
    }
}


constexpr int FILL_PER_WAVE_S = 3;
constexpr int F0_P2 = 208 * 8 * FILL_PER_WAVE_S, F0_P5 = 192 * 8 * FILL_PER_WAVE_S, F0_P7 = MOE_CVT_ITEMS - F0_P2 - F0_P5;
constexpr int F0_BULK = MOE_CVT_ITEMS - F0_P2 - F0_P5 - F0_P7;
static_assert(F0_BULK >= 0, "fill plan");
constexpr int F1_P12 = 128 * 8 * FILL_PER_WAVE_S;
__device__ __forceinline__ void cvt_moe_range(const Frame& F, const Args& a, int layer, int lo, int hi, int rank, int nranks) {
    LAS unsigned* T = (LAS unsigned*)F.lds + F.wave * (64 * 33);
    for (int it = lo + rank * NWAVES + F.wave; it < hi; it += nranks * NWAVES) cvt_moe_item(a, layer, it, F.ws, T, F.lane);
}
__device__ __forceinline__ void fill1_ranges(const Frame& F, int ntr0, int& s9, int& s10) {
    const int nu9 = (ntr0 + NT / 256) * 2, nu10 = (ntr0 + NT / 256) * 4;
    const int l9 = (nu9 % F.G) ? F.G - nu9 % F.G : 0, l10 = (nu10 % F.G) ? F.G - nu10 % F.G : 0;
    s9 = l9 * NWAVES * FILL_PER_WAVE_S; s10 = l10 * NWAVES * (FILL_PER_WAVE_S / 3);
    if (F.G != 256) { s9 = 0; s10 = 0; }
}

__device__ __forceinline__ void p0_ada(const Frame& F, const Args& a) {
    LAS float* sc = (LAS float*)F.lds;
    if ((int)blockIdx.x >= 96) return;
    for (int i = F.tid; i < 17 * D; i += NTHREADS) { const int r = i >> 10, k = i & 1023; const float v = r < 16 ? a.in[1][r * D + k] : a.in[3][k]; sc[i] = siluf_(v); }
    __syncthreads();
    const int item = blockIdx.x; const int layer = item / 48, cg = item % 48;
    const int cq = F.tid & 31, kl = F.tid >> 5;
    const float* W = a.in[4] + (size_t)layer * D * ADA + cg * 128 + cq * 4;
    f32x4 acc[17];
#pragma unroll
    for (int r = 0; r < 17; ++r) acc[r] = (f32x4){0.f, 0.f, 0.f, 0.f};
    for (int k = kl; k < D; k += 16) {
        const f32x4 w = ld4(W + (size_t)k * ADA);
#pragma unroll
        for (int r = 0; r < 17; ++r) { const float s = sc[r * D + k]; acc[r] = acc[r] + w * s; }
    }
#pragma unroll
    for (int r = 0; r < 17; ++r) { acc[r].x += __shfl_xor(acc[r].x, 32); acc[r].y += __shfl_xor(acc[r].y, 32); acc[r].z += __shfl_xor(acc[r].z, 32); acc[r].w += __shfl_xor(acc[r].w, 32); }
    __syncthreads();
    LAS f32x4* red = (LAS f32x4*)F.lds;
    if (F.lane < 32) {
#pragma unroll
        for (int r = 0; r < 17; ++r) red[(F.wave * 17 + r) * 32 + cq] = acc[r];
    }
    __syncthreads();
    for (int i = F.tid; i < 17 * 32; i += NTHREADS) { const int r = i >> 5, q = i & 31; f32x4 s = red[r * 32 + q];
#pragma unroll
        for (int w = 1; w < 8; ++w) s = s + red[(w * 17 + r) * 32 + q];
        const int col = cg * 128 + q * 4; s = s + ld4(a.in[5] + (size_t)layer * ADA + col);
        float* dst = r < 16 ? (float*)(F.ws + WS_MODX) + ((size_t)layer * 16 + r) * ADA + col : (float*)(F.ws + WS_MODC) + (size_t)layer * ADA + col;
        *(f32x4*)dst = s; }
    __syncthreads();
}

__device__ __forceinline__ void p0_convert(const Frame& F, const Args& a) {
    LAS unsigned* T = (LAS unsigned*)(F.lds + 70 * 1024) + F.wave * (64 * 33);
    const int gw = F.vcu * NWAVES + F.wave, NGW = F.G * NWAVES, lane = F.lane;
    bf16_t* win0 = (bf16_t*)(F.ws + WS_WIN0); bf16_t* wout0 = (bf16_t*)(F.ws + WS_WOUT0); bf16_t* wqkv1 = (bf16_t*)(F.ws + WS_WQKV1); bf16_t* wout1 = (bf16_t*)(F.ws + WS_WOUT1); bf16_t* wr = (bf16_t*)(F.ws + WS_WR);
    constexpr int I_IN = 16 * (4 + 4 + 8 + 8 + 1 + 16);
    constexpr int I_SQ = 16 * 16, I_QKV = 16 * 48, I_R = 16 * 4;
    constexpr int NIT = I_IN + I_SQ + I_QKV + I_SQ + 2 * I_R;
    const int nbulk0 = F.G == 256 ? F0_BULK : MOE_CVT_ITEMS;
    for (int it = gw; it < NIT + nbulk0; it += NGW) {
        int r = it;
        if (r < I_IN) {
            const int kt = r & 15, g = r >> 4; int col0, nc = 64, drow;
            if (g < 24) { col0 = 64 * g; drow = 64 * g; }
            else if (g == 24) { col0 = 1536; nc = 32; drow = 2560; }
            else { const int s = g - 25; const int isb = s >> 3, q = s & 7;
                col0 = 1568 + 512 * isb + 64 * q; drow = 1536 + 256 * (q >> 1) + 128 * isb + 64 * (q & 1); }
            cvt_item(a.in[10], AB_IN, col0, nc, kt * 64, win0, D, drow, T, lane); continue; }
        r -= I_IN;
        if (r < I_SQ) { cvt_matrix_item(a.in[11], D, 0, D, D, wout0, 0, r, T, lane); continue; } r -= I_SQ;
        if (r < I_QKV) { cvt_matrix_item(a.in[21], 3 * D, 0, 3 * D, D, wqkv1, 0, r, T, lane); continue; } r -= I_QKV;
        if (r < I_SQ) { cvt_matrix_item(a.in[22], D, 0, D, D, wout1, 0, r, T, lane); continue; } r -= I_SQ;
        if (r < 2 * I_R) { const int l = r / I_R; cvt_matrix_item(a.in[24] + (size_t)l * D * NEXP, NEXP, 0, NEXP, D, wr + (size_t)l * NEXP * D, 0, r % I_R, T, lane); continue; } r -= 2 * I_R;
        cvt_moe_item(a, 0, r, F.ws, T, lane);
    }
    { u32x4 z = (u32x4){0u, 0u, 0u, 0u}; const size_t n16 = (size_t)(AB_INP - AB_IN) * D * 2 / 16; u32x4* p = (u32x4*)(win0 + (size_t)AB_IN * D);
      for (size_t i = (size_t)blockIdx.x * NTHREADS + F.tid; i < n16; i += (size_t)F.G * NTHREADS) p[i] = z; }
    if (blockIdx.x == 0) { f32x2* rt = (f32x2*)(F.ws + WS_ROPE);
        for (int i = F.tid; i < 64 * 16; i += NTHREADS) { const int pos = i >> 4, f = i & 15; const float inv = powf(10000.0f, -(float)f / 16.0f); const float ang = (float)pos * inv; rt[i] = (f32x2){cosf(ang), sinf(ang)}; } }
}


__device__ __forceinline__ int gsw(int row, int ch) { return row * 128 + ((ch ^ (row & 7)) << 4); }
__device__ __forceinline__ int gla_row(int n, int p, int b, int d) {
    const bool isctx = n < 4; const int j = isctx ? n : n - 4; int pos = j * 64 + p;
    if (d) pos = (isctx ? CTXL : SEQ) - 1 - pos;
    return isctx ? NX + b * CTXL + pos : b * SEQ + pos;
}
struct GlaRaw { u32x4 q, k, v0, v1; f32x4 lr[4]; };
__device__ __forceinline__ void gla_load(GlaRaw& R, int n, int lane, int w, int b, int h, int d, const bf16_t* qb, const bf16_t* kb, const bf16_t* vb, const float* lr) {
    const int row = gla_row(n, lane, b, d);
    R.q = *(const u32x4*)(qb + (size_t)row * 256 + h * 64 + 8 * w);
    R.k = *(const u32x4*)(kb + (size_t)row * 256 + h * 64 + 8 * w);
    R.v0 = *(const u32x4*)(vb + (size_t)row * 512 + h * 128 + 8 * w);
    R.v1 = *(const u32x4*)(vb + (size_t)row * 512 + h * 128 + 64 + 8 * w);
#pragma unroll
    for (int i = 0; i < 4; ++i) R.lr[i] = *(const f32x4*)(lr + (size_t)row * 32 + d * 16 + 4 * i);
}
__device__ __forceinline__ void unpack8(const u32x4& w, float (&f)[8]) { f[0] = bflo(w.x); f[1] = bfhi(w.x); f[2] = bflo(w.y); f[3] = bfhi(w.y); f[4] = bflo(w.z); f[5] = bfhi(w.z); f[6] = bflo(w.w); f[7] = bfhi(w.w); }
constexpr int GPL_QE = 0, GPL_KE = 8192, GPL_OUT = 16384, GPL_BUF = 16384 + GI_BYTES + 256, GPL_DW = 2 * GPL_BUF, GPL_DB = GPL_DW + 4096, GPL_END = GPL_DB + 256;
static_assert(GPL_END <= RING_BYTES && (GPL_BUF % 16) == 0, "gla prep lds");
__device__ __forceinline__ void gla_prep_phase(const Frame& F, const Args& a) {
    LAS unsigned char* L = F.lds; const int lane = F.lane, w = F.wave, r16 = lane & 15, g4 = lane >> 4;
    const bf16_t* qb = (const bf16_t*)(F.ws + T_QB); const bf16_t* kb = (const bf16_t*)(F.ws + T_KB); const bf16_t* vb = (const bf16_t*)(F.ws + T_VB); const float* lrb = (const float*)(F.ws + T_LR);
    for (int cc = blockIdx.x; cc < 256; cc += F.G) {
        const int sq = cc & 127, b = sq >> 3, h = (sq >> 1) & 3, d = sq & 1;
        const float* dw = d ? a.in[14] : a.in[12]; const float* db = d ? a.in[15] : a.in[13];
        __syncthreads();
        for (int i = F.tid; i < 16 * 64; i += NTHREADS) ((LAS float*)(L + GPL_DW))[i] = dw[(i >> 6) * GLA_QK + h * 64 + (i & 63)];
        if (F.tid < 64) ((LAS float*)(L + GPL_DB))[F.tid] = db[h * 64 + F.tid];
        GlaRaw R; gla_load(R, cc >> 7, lane, w, b, h, d, qb, kb, vb, lrb);
        __syncthreads();
        for (int k = 0; k < 18; ++k) {
            const int n = (cc >> 7) + 2 * k;
            LAS unsigned char* PB = L + (k & 1) * GPL_BUF; LAS unsigned char* OUT = PB + GPL_OUT;
            {
                float z[8], q[8], kk[8], v0[8], v1[8];
                unpack8(R.q, q); unpack8(R.k, kk); unpack8(R.v0, v0); unpack8(R.v1, v1);
                const LAS float* DW = (const LAS float*)(L + GPL_DW); const LAS float* DB = (const LAS float*)(L + GPL_DB);
#pragma unroll
                for (int j = 0; j < 8; ++j) z[j] = DB[8 * w + j];
#pragma unroll
                for (int r = 0; r < 16; ++r) { const float x = R.lr[r >> 2][r & 3]; const f32x4 w0 = *(const LAS f32x4*)(DW + r * 64 + 8 * w), w1 = *(const LAS f32x4*)(DW + r * 64 + 8 * w + 4);
                    z[0] += x * w0.x; z[1] += x * w0.y; z[2] += x * w0.z; z[3] += x * w0.w; z[4] += x * w1.x; z[5] += x * w1.y; z[6] += x * w1.z; z[7] += x * w1.w; }
                float qe[8], ke[8], qi[8]; unsigned short ko[8]; float ld[8];
#pragma unroll
                for (int j = 0; j < 8; ++j) ld[j] = (fminf(z[j], 0.f) - __logf(1.0f + __expf(-fabsf(z[j])))) * (1.0f / 16.0f);
#pragma unroll
                for (int o = 1; o < 64; o <<= 1) { float t[8];
#pragma unroll
                    for (int j = 0; j < 8; ++j) t[j] = __shfl_up(ld[j], o);
#pragma unroll
                    for (int j = 0; j < 8; ++j) ld[j] += (lane >= o) ? t[j] : 0.f; }
                float decv = 0.f;
#pragma unroll
                for (int j = 0; j < 8; ++j) {
                    const float bm = __builtin_bit_cast(float, __builtin_amdgcn_readlane(__builtin_bit_cast(int, ld[j]), 31)), bl = __builtin_bit_cast(float, __builtin_amdgcn_readlane(__builtin_bit_cast(int, ld[j]), 63));
                    const float e1 = __expf(ld[j] - bm), e2 = __expf(bm - ld[j]);
                    qe[j] = q[j] * e1; ke[j] = kk[j] * e2; qi[j] = q[j] * __expf(ld[j]); ko[j] = (unsigned short)f2bf(kk[j] * __expf(bl - ld[j]));
                    decv = (lane == j) ? __expf(bl) : decv;
                }
                if (lane < 8) ((LAS float*)(OUT + GI_DEC))[8 * w + lane] = decv;
                *(LAS u32x4*)(PB + GPL_QE + gsw(lane, w)) = (u32x4){pk2(qe[0], qe[1]), pk2(qe[2], qe[3]), pk2(qe[4], qe[5]), pk2(qe[6], qe[7])};
                *(LAS u32x4*)(PB + GPL_KE + gsw(lane, w)) = (u32x4){pk2(ke[0], ke[1]), pk2(ke[2], ke[3]), pk2(ke[4], ke[5]), pk2(ke[6], ke[7])};
                *(LAS u32x4*)(OUT + GI_QIN + gsw(lane, w)) = (u32x4){pk2(qi[0], qi[1]), pk2(qi[2], qi[3]), pk2(qi[4], qi[5]), pk2(qi[6], qi[7])};
#pragma unroll
                for (int j = 0; j < 8; ++j) { const int rw = 8 * w + j;
                    *(LAS unsigned short*)(OUT + GI_KOT + gsw(rw, lane >> 3) + (lane & 7) * 2) = ko[j];
                    *(LAS unsigned short*)(OUT + GI_VT + gsw(rw, lane >> 3) + (lane & 7) * 2) = (unsigned short)f2bf(v0[j]);
                    *(LAS unsigned short*)(OUT + GI_VT + gsw(64 + rw, lane >> 3) + (lane & 7) * 2) = (unsigned short)f2bf(v1[j]); }
            }
            if (k + 1 < 18) gla_load(R, n + 2, lane, w, b, h, d, qb, kb, vb, lrb);
            lds_barrier();
#pragma unroll
            for (int i = 0; i < 2; ++i) { const int tI = 2 * w + i, st = tI >> 2, pt = tI & 3;
                f32x4 c = (f32x4){0.f, 0.f, 0.f, 0.f};
                if (st <= pt) {
#pragma unroll
                    for (int ks = 0; ks < 2; ++ks) { const bf16x8 af = *(const LAS bf16x8*)(PB + GPL_KE + gsw(16 * st + r16, 4 * ks + g4)), bfr = *(const LAS bf16x8*)(PB + GPL_QE + gsw(16 * pt + r16, 4 * ks + g4));
                        c = __builtin_amdgcn_mfma_f32_16x16x32_bf16(af, bfr, c, 0, 0, 0); }
                    const int p = 16 * pt + r16, s0 = 16 * st + 4 * g4;
#pragma unroll
                    for (int e = 0; e < 4; ++e) if (s0 + e > p) c[e] = 0.f;
                }
                u32x2 o; o.x = pk2(c[0], c[1]); o.y = pk2(c[2], c[3]);
                *(LAS u32x2*)(OUT + GI_A + gsw(16 * pt + r16, 2 * st + (g4 >> 1)) + (g4 & 1) * 8) = o; }
            lds_barrier();
            { unsigned char* rec = F.ws + T_GLA + (size_t)(sq * 36 + n) * GI_BYTES;
              for (int i = F.tid; i < GI_BYTES / 16; i += NTHREADS) *(u32x4*)(rec + i * 16) = *(const LAS u32x4*)(OUT + i * 16); }
        }
    }
    __syncthreads();
}
constexpr int GSL_IN = 33792  , GSL_ST = 3 * GSL_IN, GSL_END = GSL_ST + 2 * 8192;
static_assert(GSL_END <= RING_BYTES, "gla seq lds");
__device__ __forceinline__ void gla_seq_phase(const Frame& F, const Args& a) {
    LAS unsigned char* L = F.lds; const int lane = F.lane, w = F.wave, r16 = lane & 15, g4 = lane >> 4, tid = F.tid;
    for (int it = blockIdx.x; it < 256; it += F.G) {
        const int sq = it >> 1, vh = it & 1, b = sq >> 3, h = (sq >> 1) & 3, d = sq & 1;
        bf16_t* ob = (bf16_t*)(F.ws + (d ? T_OB : T_OF));
        const unsigned char* rec0 = F.ws + T_GLA + (size_t)(sq * 36) * GI_BYTES;
        __syncthreads();
        for (int i = tid; i < 2 * 8192 / 4; i += NTHREADS) ((LAS unsigned*)(L + GSL_ST))[i] = 0u;
        f32x4 Sacc[2] = {(f32x4){0.f, 0.f, 0.f, 0.f}, (f32x4){0.f, 0.f, 0.f, 0.f}};
#define GLA_DMA(n_) do { const unsigned char* r_ = rec0 + (size_t)(n_) * GI_BYTES; LAS unsigned char* d_ = L + ((n_) % 3) * GSL_IN; \
            __builtin_amdgcn_global_load_lds((const unsigned*)(r_ + GI_A + tid * 16), (LAS unsigned*)(d_ + w * 1024), 16, 0, 0); \
            __builtin_amdgcn_global_load_lds((const unsigned*)(r_ + GI_QIN + tid * 16), (LAS unsigned*)(d_ + 8192 + w * 1024), 16, 0, 0); \
            __builtin_amdgcn_global_load_lds((const unsigned*)(r_ + GI_KOT + tid * 16), (LAS unsigned*)(d_ + 16384 + w * 1024), 16, 0, 0); \
            __builtin_amdgcn_global_load_lds((const unsigned*)(r_ + GI_VT + vh * 8192 + tid * 16), (LAS unsigned*)(d_ + 24576 + w * 1024), 16, 0, 0); \
            __builtin_amdgcn_global_load_lds((const unsigned*)(r_ + GI_DEC + lane * 16), (LAS unsigned*)(d_ + 32768), 16, 0, 0); } while (0)
        GLA_DMA(0); GLA_DMA(1);
        for (int n = 0; n < 36; ++n) {
            LAS unsigned char* IN = L + (n % 3) * GSL_IN; LAS unsigned char* STr = L + GSL_ST + (n & 1) * 8192; LAS unsigned char* STw = L + GSL_ST + ((n + 1) & 1) * 8192;
            if (n == 0) asm volatile("s_waitcnt vmcnt(5)" ::: "memory"); else if (n < 35) asm volatile("s_waitcnt vmcnt(7)" ::: "memory"); else asm volatile("s_waitcnt vmcnt(2)" ::: "memory");
            lds_barrier();
            if (n + 2 < 36) GLA_DMA(n + 2);
#pragma unroll
            for (int i = 0; i < 2; ++i) { const int tI = 2 * w + i, vt = tI >> 2, pt = tI & 3;
                f32x4 c = (f32x4){0.f, 0.f, 0.f, 0.f};
#pragma unroll
                for (int ks = 0; ks < 2; ++ks) {
                    const bf16x8 a1 = *(const LAS bf16x8*)(IN + 24576 + gsw(16 * vt + r16, 4 * ks + g4)), b1 = *(const LAS bf16x8*)(IN + gsw(16 * pt + r16, 4 * ks + g4));
                    c = __builtin_amdgcn_mfma_f32_16x16x32_bf16(a1, b1, c, 0, 0, 0);
                    const bf16x8 a2 = *(const LAS bf16x8*)(STr + gsw(16 * vt + r16, 4 * ks + g4)), b2 = *(const LAS bf16x8*)(IN + 8192 + gsw(16 * pt + r16, 4 * ks + g4));
                    c = __builtin_amdgcn_mfma_f32_16x16x32_bf16(a2, b2, c, 0, 0, 0); }
                const int row = gla_row(n, 16 * pt + r16, b, d);
                u32x2 o; o.x = pk2(c[0], c[1]); o.y = pk2(c[2], c[3]);
                *(u32x2*)(ob + (size_t)row * 512 + h * 128 + vh * 64 + 16 * vt + 4 * g4) = o; }
#pragma unroll
            for (int i = 0; i < 2; ++i) { const int tI = 2 * w + i, ct = tI >> 2, vt = tI & 3;
                const f32x4 dc = *(const LAS f32x4*)(IN + 32768 + (16 * ct + 4 * g4) * 4);
                f32x4 c = Sacc[i] * dc;
#pragma unroll
                for (int ks = 0; ks < 2; ++ks) { const bf16x8 af = *(const LAS bf16x8*)(IN + 16384 + gsw(16 * ct + r16, 4 * ks + g4)), bfr = *(const LAS bf16x8*)(IN + 24576 + gsw(16 * vt + r16, 4 * ks + g4));
                    c = __builtin_amdgcn_mfma_f32_16x16x32_bf16(af, bfr, c, 0, 0, 0); }
                Sacc[i] = c;
                u32x2 o; o.x = pk2(c[0], c[1]); o.y = pk2(c[2], c[3]);
                *(LAS u32x2*)(STw + gsw(16 * vt + r16, 2 * ct + (g4 >> 1)) + (g4 & 1) * 8) = o; }
        }
#undef GLA_DMA
        asm volatile("s_waitcnt vmcnt(0)" ::: "memory");
    }
    __syncthreads();
}

__device__ __forceinline__ void finish_conv_phase(const Frame& F, const Args& a) {
    const int lane = F.lane; bf16_t* cat = (bf16_t*)(F.ws + T_CAT);
    {
        const bf16_t* of = (const bf16_t*)(F.ws + T_OF); const bf16_t* obk = (const bf16_t*)(F.ws + T_OB); const bf16_t* gb = (const bf16_t*)(F.ws + T_GB);
        const int gw = F.vcu * NWAVES + F.wave, NGW = F.G * NWAVES;
        float gg[8];
#pragma unroll
        for (int j = 0; j < 8; ++j) gg[j] = a.in[16][8 * lane + j];
        for (int row = gw; row < NT; row += NGW) {
            float x[8], y[8], g[8];
            unpack8(*(const u32x4*)(of + (size_t)row * 512 + 8 * lane), x); unpack8(*(const u32x4*)(obk + (size_t)row * 512 + 8 * lane), y); unpack8(*(const u32x4*)(gb + (size_t)row * 512 + 8 * lane), g);
            float ss = 0.f;
#pragma unroll
            for (int j = 0; j < 8; ++j) { x[j] += y[j]; ss += x[j] * x[j]; }
            ss += __shfl_xor(ss, 1); ss += __shfl_xor(ss, 2); ss += __shfl_xor(ss, 4); ss += __shfl_xor(ss, 8);
            const float rs = rsqrtf(ss * (1.0f / 128.0f) + RMS_EPS);
#pragma unroll
            for (int j = 0; j < 8; ++j) x[j] = x[j] * rs * gg[j] * siluf_(g[j]);
            *(u32x4*)(cat + (size_t)row * D + 8 * lane) = (u32x4){pk2(x[0], x[1]), pk2(x[2], x[3]), pk2(x[4], x[5]), pk2(x[6], x[7])};
        }
    }
    {
        const bf16_t* ub = (const bf16_t*)(F.ws + T_UB); LAS float* tile = (LAS float*)F.lds;
        const int c = F.tid;
        float wv[CONV_W];
#pragma unroll
        for (int j = 0; j < CONV_W; ++j) wv[j] = a.in[17][j * CONV_CH + c];
        const float cb = a.in[18][c];
        float lg[8], lb[8];
#pragma unroll
        for (int i = 0; i < 8; ++i) { lg[i] = a.in[19][lane + 64 * i]; lb[i] = a.in[20][lane + 64 * i]; }
        for (int ti = blockIdx.x; ti < NT / 32; ti += F.G) {
            const int row0 = ti * 32; const bool lat = row0 < NX;
            const int t0 = lat ? (row0 & (SEQ - 1)) : ((row0 - NX) & (CTXL - 1)); const int len = lat ? SEQ : CTXL; const int sbase = row0 - t0;
            float in[62];
            unsigned short raw[62];
#pragma unroll
            for (int i = 0; i < 62; ++i) { int t = t0 - 15 + i; t = t < 0 ? 0 : (t >= len ? len - 1 : t); raw[i] = ub[(size_t)(sbase + t) * 512 + c]; }
#pragma unroll
            for (int i = 0; i < 62; ++i) { const int t = t0 - 15 + i; in[i] = (t >= 0 && t < len) ? bf2f(raw[i]) : 0.f; }
            __syncthreads();
#pragma unroll
            for (int t = 0; t < 32; ++t) { float s = cb;
#pragma unroll
                for (int j = 0; j < CONV_W; ++j) s += wv[j] * in[t + j];
                tile[t * 512 + c] = s; }
            __syncthreads();
#pragma unroll
            for (int q = 0; q < 4; ++q) { const int t = 4 * F.wave + q; float v[8]; float s = 0.f;
#pragma unroll
                for (int i = 0; i < 8; ++i) { v[i] = tile[t * 512 + lane + 64 * i]; s += v[i]; }
                const float mu = wave_sum(s) * (1.0f / 512.0f); float qq = 0.f;
#pragma unroll
                for (int i = 0; i < 8; ++i) { v[i] -= mu; qq += v[i] * v[i]; }
                const float rstd = rsqrtf(wave_sum(qq) * (1.0f / 512.0f) + LN_EPS);
#pragma unroll
                for (int i = 0; i < 8; ++i) { const float y = v[i] * rstd * lg[i] + lb[i]; cat[(size_t)(row0 + t) * D + 512 + lane + 64 * i] = (bf16_t)f2bf(siluf_(y)); } }
        }
        __syncthreads();
    }
}


constexpr int CW_TST = 20480;
constexpr int AUX_TST = AUX_OFF, AUX_TILEE = AUX_OFF + 1040, AUX_IDX = AUX_OFF + 1168;
constexpr int MOE_MAXU = 32, MOE_MAXIDX = 16;
static_assert(AUX_IDX + MOE_MAXIDX * 1024 <= MISC_OFF, "aux lds");

struct EpiRouter {
    static constexpr bool PERM = false, AFTER_DRAIN = true;
    const float* rbias; int* asg_e; int* asg_r; float* asg_g; unsigned* counts;
    __device__ __forceinline__ void operator()(const f32x4 (&)[2][2][4][2], const Unit&, int, int, int, int) const {}
    __device__ __forceinline__ void fused(const f32x4 (&acc)[2][2][4][2], const Unit& u, int wr, int wc, int fr, int fq, LAS unsigned char* lds, int wid, int lane) const {
        LAS float* SC = (LAS float*)lds;
        LAS unsigned* lcnt = (LAS unsigned*)(lds + 66560); LAS unsigned* lbase = lcnt + 256;
        LAS int* selE = (LAS int*)(lbase + 256); LAS int* selR = selE + 2048;
        const int tid = wid * 64 + lane;
        if (tid < 256) lcnt[tid] = 0u;
        const f32x4 rb = *(const f32x4*)(rbias + 4 * lane);
        const float NINF = -__builtin_inff();
#pragma unroll
        for (int ai = 0; ai < 2; ++ai)
#pragma unroll
            for (int mm = 0; mm < 2; ++mm) {
                LDS_WAIT(); __builtin_amdgcn_s_barrier(); asm volatile("" ::: "memory");
#pragma unroll
                for (int mi = 0; mi < 2; ++mi) { const int lr = 32 * wr + 16 * mi + fr;
#pragma unroll
                    for (int bj = 0; bj < 2; ++bj)
#pragma unroll
                        for (int n = 0; n < 2; ++n) *(LAS f32x4*)(SC + lr * 260 + 128 * bj + 32 * wc + 16 * n + 4 * fq) = acc[ai][bj][2 * mm + mi][n]; }
                LDS_WAIT(); __builtin_amdgcn_s_barrier(); asm volatile("" ::: "memory");
                for (int q = 0; q < 8; ++q) {
                    const int lr = 8 * wid + q; const int rit = 128 * ai + 64 * (lr >> 5) + 16 * (2 * mm + ((lr >> 4) & 1)) + (lr & 15);
                    const f32x4 lg = *(const LAS f32x4*)(SC + lr * 260 + 4 * lane);
                    float s[4], cd[4];
#pragma unroll
                    for (int j = 0; j < 4; ++j) { s[j] = 1.0f / (1.0f + __expf(-lg[j])); cd[j] = s[j] + rb[j]; }
                    float m1 = fmaxf(cd[0], cd[1]), m2 = fminf(cd[0], cd[1]);
                    { const float x = cd[2]; const float n1 = fmaxf(m1, x); m2 = fmaxf(fminf(m1, x), m2); m1 = n1; }
                    { const float x = cd[3]; const float n1 = fmaxf(m1, x); m2 = fmaxf(fminf(m1, x), m2); m1 = n1; }
#pragma unroll
                    for (int o = 1; o < 8; o <<= 1) { const float a1 = __shfl_xor(m1, o), a2 = __shfl_xor(m2, o); const float n1 = fmaxf(m1, a1); m2 = fmaxf(fminf(m1, a1), fmaxf(m2, a2)); m1 = n1; }
                    const float gs = m1 + m2; const int mygrp = lane >> 3; int rank = 0;
#pragma unroll
                    for (int g = 0; g < 8; ++g) { const float og = __shfl(gs, 8 * g); rank += (og > gs || (og == gs && g < mygrp)) ? 1 : 0; }
                    if (rank >= 4) { cd[0] = NINF; cd[1] = NINF; cd[2] = NINF; cd[3] = NINF; }
                    int myE = 0; float myG = 0.f; float gsum = 0.f;
#pragma unroll
                    for (int k = 0; k < TOPK; ++k) {
                        float bv = cd[0]; int bi = 0;
                        if (cd[1] > bv) { bv = cd[1]; bi = 1; } if (cd[2] > bv) { bv = cd[2]; bi = 2; } if (cd[3] > bv) { bv = cd[3]; bi = 3; }
                        float v = bv; int ix = 4 * lane + bi;
#pragma unroll
                        for (int o = 32; o >= 1; o >>= 1) { const float ov = __shfl_xor(v, o); const int oi = __shfl_xor(ix, o); if (ov > v || (ov == v && oi < ix)) { v = ov; ix = oi; } }
                        const int sl = ix & 3; const float mys = sl == 0 ? s[0] : (sl == 1 ? s[1] : (sl == 2 ? s[2] : s[3]));
                        const float gv = __shfl(mys, ix >> 2);
                        gsum += gv;
                        if (lane == k) { myE = ix; myG = gv; }
                        if (lane == (ix >> 2)) { if (sl == 0) cd[0] = NINF; else if (sl == 1) cd[1] = NINF; else if (sl == 2) cd[2] = NINF; else cd[3] = NINF; }
                    }
                    if (lane < TOPK) { const unsigned r = __hip_atomic_fetch_add(&lcnt[myE], 1u, __ATOMIC_RELAXED, __HIP_MEMORY_SCOPE_WORKGROUP); selE[rit * 8 + lane] = myE; selR[rit * 8 + lane] = (int)r; asg_g[(size_t)(u.orow + rit) * 8 + lane] = myG / gsum * 2.5f; }
                }
            }
        LDS_WAIT(); __builtin_amdgcn_s_barrier(); asm volatile("" ::: "memory");
        if (tid < 256) { const unsigned c = lcnt[tid]; lbase[tid] = c ? atomicAdd(&counts[tid], c) : 0u; }
        LDS_WAIT(); __builtin_amdgcn_s_barrier(); asm volatile("" ::: "memory");
        for (int i = tid; i < 2048; i += NTHREADS) { const int e = selE[i]; asg_e[(size_t)u.orow * 8 + i] = e; asg_r[(size_t)u.orow * 8 + i] = (int)lbase[e] + selR[i]; }
    }
};

__device__ __forceinline__ void moe_place(const Frame& F, int layer, int ntok) {
    LAS int* cnt = (LAS int*)F.lds; LAS int* tst = cnt + 256;
    const unsigned* counts = F.ctl + CW_CNT + layer * 256;
    const int* asg_e = (const int*)(F.ws + M_AE); const int* asg_r = (const int*)(F.ws + M_AR); int* tslot = (int*)(F.ws + M_TS); int* stok = (int*)(F.ws + M_ST);
    __syncthreads();
    if (F.tid < 256) cnt[F.tid] = (int)counts[F.tid];
    __syncthreads();
    if (F.tid == 0) { int acc = 0; for (int e = 0; e < 256; ++e) { tst[e] = acc; acc += (cnt[e] + 255) >> 8; } tst[256] = acc; }
    __syncthreads();
    const int ntr = tst[256];
    if (blockIdx.x == 0) for (int i = F.tid; i < 257; i += NTHREADS) F.ctl[CW_TST + layer * 320 + i] = (unsigned)tst[i];
    const int gt = blockIdx.x * NTHREADS + F.tid, gs = F.G * NTHREADS;
    for (int i = gt; i < ntok * 8; i += gs) { const int e = asg_e[i]; const int slot = tst[e] * 256 + asg_r[i]; stok[slot] = i >> 3; tslot[i] = slot; }
    for (int e = blockIdx.x; e < 256; e += F.G) { const int s0 = tst[e] * 256 + cnt[e], s1 = tst[e + 1] * 256; for (int s = s0 + F.tid; s < s1; s += NTHREADS) stok[s] = 0; }
    for (int i = gt; i < ntok; i += gs) stok[ntr * 256 + i] = i;
    __syncthreads();
}

template <int NCOL>
__device__ __forceinline__ int moe_units_setup(const Frame& F, int layer, int ntok, int c, bool want_idx) {
    LAS int* tst = (LAS int*)(F.lds + AUX_TST); LAS int* tileE = (LAS int*)(F.lds + AUX_TILEE); LAS int* idxl = (LAS int*)(F.lds + AUX_IDX);
    __syncthreads();
    for (int i = F.tid; i < 257; i += NTHREADS) tst[i] = (int)F.ctl[CW_TST + layer * 320 + i];
    __syncthreads();
    const int ntr = tst[256], nunits = (ntr + ntok / 256) * NCOL;
    int nu = c < nunits ? (nunits - c + F.G - 1) / F.G : 0; if (nu > MOE_MAXU) nu = MOE_MAXU; if (want_idx && nu > MOE_MAXIDX) nu = MOE_MAXIDX;
    if (F.tid < nu) { const int rt = (c + F.tid * F.G) / NCOL; int e;
        if (rt >= ntr) e = NEXP; else { int lo = 0, hi = 255; while (lo < hi) { const int mid = (lo + hi + 1) >> 1; if (tst[mid] <= rt) lo = mid; else hi = mid - 1; } e = lo; }
        tileE[F.tid] = e; }
    if (want_idx) { const int* stok = (const int*)(F.ws + M_ST); for (int i = F.tid; i < nu * 256; i += NTHREADS) idxl[i] = stok[(size_t)((c + (i >> 8) * F.G) / NCOL) * 256 + (i & 255)]; }
    __syncthreads();
    return nu;
}
struct SchedMoeGU {
    const char* A; const char* W; const LAS int* tileE; const LAS int* idxl; int nu, G, c;
    __device__ __forceinline__ bool next(int i, Unit& u) const {
        if (i >= nu) return false; const int un = c + i * G; const int rt = un >> 1, col = un & 1; const int e = tileE[i];
        u.a = i; u.b = e * 512 + col * 256; u.orow = rt * 256; u.ocol = col * 128; u.aux = e; return true; }
    __device__ __forceinline__ const char* a_base() const { return A; }
    __device__ __forceinline__ const char* b_ptr(const Unit& u) const { return W + (size_t)u.b * D * 2; }
    __device__ __forceinline__ void a_off(const Unit& u, const int (&R)[2], const int (&C)[2], unsigned (&o0)[2], unsigned (&o1)[2]) const {
#pragma unroll
        for (int i = 0; i < 2; ++i) { const int t0 = idxl[u.a * 256 + R[i]], t1 = idxl[u.a * 256 + 128 + R[i]]; o0[i] = (unsigned)t0 * (unsigned)(D * 2) + (unsigned)C[i] * 2u; o1[i] = (unsigned)t1 * (unsigned)(D * 2) + (unsigned)C[i] * 2u; }
    }
};
struct EpiGateUp {
    static constexpr bool PERM = true, AFTER_DRAIN = false;
    bf16_t* hid;
    __device__ __forceinline__ void operator()(const f32x4 (&acc)[2][2][4][2], const Unit& u, int wr, int wc, int fr, int fq) const {
        const int lane = fr + 16 * fq; const int srcb = ((lane >> 2) + 16 * (lane & 3)) << 2;
        const int row0 = u.orow + wr * 64 + (lane >> 2), col0 = u.ocol + wc * 32 + 8 * (lane & 3);
#pragma unroll
        for (int ai = 0; ai < 2; ++ai)
#pragma unroll
            for (int m = 0; m < 4; ++m) { float h[8];
#pragma unroll
                for (int n = 0; n < 2; ++n)
#pragma unroll
                    for (int e = 0; e < 4; ++e) { const float g = acc[ai][0][m][n][e], up = acc[ai][1][m][n][e]; h[4 * n + e] = g / (1.0f + __expf(-g)) * up; }
                u32x4 w; w.x = cvt_pk_bf16(h[0], h[1]); w.y = cvt_pk_bf16(h[2], h[3]); w.z = cvt_pk_bf16(h[4], h[5]); w.w = cvt_pk_bf16(h[6], h[7]);
                u32x4 t; t.x = (unsigned)__builtin_amdgcn_ds_bpermute(srcb, (int)w.x); t.y = (unsigned)__builtin_amdgcn_ds_bpermute(srcb, (int)w.y); t.z = (unsigned)__builtin_amdgcn_ds_bpermute(srcb, (int)w.z); t.w = (unsigned)__builtin_amdgcn_ds_bpermute(srcb, (int)w.w);
                *(u32x4*)(hid + (size_t)(row0 + ai * 128 + m * 16) * DEXP + col0) = t; }
    }
};
struct SchedMoeDN {
    const char* A; const char* W; const LAS int* tileE; int nu, G, c;
    __device__ __forceinline__ bool next(int i, Unit& u) const {
        if (i >= nu) return false; const int un = c + i * G; const int rt = un >> 2, col = un & 3; const int e = tileE[i];
        u.a = rt; u.b = e * 1024 + col * 256; u.orow = rt * 256; u.ocol = col * 256; u.aux = e; return true; }
    __device__ __forceinline__ const char* a_base() const { return A; }
    __device__ __forceinline__ const char* b_ptr(const Unit& u) const { return W + (size_t)u.b * DEXP * 2; }
    __device__ __forceinline__ void a_off(const Unit& u, const int (&R)[2], const int (&C)[2], unsigned (&o0)[2], unsigned (&o1)[2]) const {
#pragma unroll
        for (int i = 0; i < 2; ++i) { o0[i] = (unsigned)((u.a * 256 + R[i]) * DEXP + C[i]) * 2u; o1[i] = o0[i] + (unsigned)(128 * DEXP * 2); }
    }
};

constexpr int NA_RING = 9, NA_KR = 0, NA_VR = NA_RING * 64 * 128, NA_RPB = 2 * NA_RING * 64 * 128, NA_END = NA_RPB + 15 * 128;
constexpr int NA_KC = 0, NA_VC = 256 * 128;
static_assert(NA_END <= MISC_OFF, "na lds");
typedef short s16x4 __attribute__((ext_vector_type(4)));
__device__ __forceinline__ int na_voff(int row, int ch) { return row * 128 + ((((ch >> 1) ^ ((row >> 1) & 3)) << 5) | ((ch & 1) << 4)); }
__device__ __forceinline__ int na_koff(int row, int ch) { return row * 128 + ((ch ^ (row & 7)) << 4); }
template <bool CTX>
__device__ __forceinline__ void na_seg2(LAS unsigned char* L, const bf16x8 (&qf)[2], int r16, int g4, int r0, int band, const int (&boff)[2][4], int rbase,
                                        const int (&voff)[4], f32x4 (&O)[4], float& m_run, float& sum) {
    const float NINF = -__builtin_inff();
    float S[2][8][4]; float mx[2] = {NINF, NINF};
#pragma unroll
    for (int t = 0; t < 8; ++t) {
#pragma unroll
        for (int q = 0; q < 2; ++q) {
            f32x4 c = (f32x4){0.f, 0.f, 0.f, 0.f};
            int key, kbase;
            if (CTX) { key = 128 * q + 16 * t + r16; kbase = NA_KC; } else { key = ((r0 + ((8 * q + t) >> 1)) % NA_RING) * 64 + band + 16 * (t & 1) + r16; kbase = NA_KR; }
            const bf16x8 k0 = *(const LAS bf16x8*)(L + kbase + na_koff(key, g4)), k1 = *(const LAS bf16x8*)(L + kbase + na_koff(key, 4 + g4));
            c = __builtin_amdgcn_mfma_f32_16x16x32_bf16(k0, qf[0], c, 0, 0, 0); c = __builtin_amdgcn_mfma_f32_16x16x32_bf16(k1, qf[1], c, 0, 0, 0);
            if (CTX) {
#pragma unroll
                for (int e = 0; e < 4; ++e) S[q][t][e] = c[e];
            } else {
#pragma unroll
                for (int e = 0; e < 4; ++e) S[q][t][e] = c[e] + *(const LAS float*)(L + rbase + ((8 * q + t) >> 1) * 128 + boff[t & 1][e]);
            }
            mx[q] = fmaxf(mx[q], fmaxf(fmaxf(S[q][t][0], S[q][t][1]), fmaxf(S[q][t][2], S[q][t][3])));
        }
    }
    float ps[2]; f32x4 Oq[2][4];
#pragma unroll
    for (int q = 0; q < 2; ++q) { mx[q] = fmaxf(mx[q], __shfl_xor(mx[q], 16)); mx[q] = fmaxf(mx[q], __shfl_xor(mx[q], 32)); }
#pragma unroll
    for (int q = 0; q < 2; ++q) { float s = 0.f;
#pragma unroll
        for (int t = 0; t < 8; ++t)
#pragma unroll
            for (int e = 0; e < 4; ++e) { const float p = __builtin_amdgcn_exp2f(S[q][t][e] - mx[q]); S[q][t][e] = p; s += p; }
        ps[q] = s;
#pragma unroll
        for (int mt = 0; mt < 4; ++mt) Oq[q][mt] = (f32x4){0.f, 0.f, 0.f, 0.f}; }
#pragma unroll
    for (int q = 0; q < 2; ++q) { ps[q] += __shfl_xor(ps[q], 16); ps[q] += __shfl_xor(ps[q], 32); }
#pragma unroll
    for (int j = 0; j < 4; ++j) {
#pragma unroll
        for (int q = 0; q < 2; ++q) {
            bf16x8 pb; { const u32x4 ww = (u32x4){cvt_pk_bf16(S[q][2 * j][0], S[q][2 * j][1]), cvt_pk_bf16(S[q][2 * j][2], S[q][2 * j][3]), cvt_pk_bf16(S[q][2 * j + 1][0], S[q][2 * j + 1][1]), cvt_pk_bf16(S[q][2 * j + 1][2], S[q][2 * j + 1][3])}; pb = __builtin_bit_cast(bf16x8, ww); }
            int ub;
            if (CTX) ub = NA_VC + (128 * q + 32 * j) * 128; else ub = NA_VR + (((r0 + 4 * q + j) % NA_RING) * 64 + band) * 128;
#pragma unroll
            for (int mt = 0; mt < 4; ++mt) {
                const s16x4 a0 = __builtin_amdgcn_ds_read_tr16_b64_v4i16((LAS s16x4*)(L + ub + voff[mt]));
                const s16x4 a1 = __builtin_amdgcn_ds_read_tr16_b64_v4i16((LAS s16x4*)(L + ub + voff[mt] + 16 * 128));
                const bf16x8 av = (bf16x8){a0[0], a0[1], a0[2], a0[3], a1[0], a1[1], a1[2], a1[3]};
                Oq[q][mt] = __builtin_amdgcn_mfma_f32_16x16x32_bf16(av, pb, Oq[q][mt], 0, 0, 0);
            }
        }
    }
    const float m_new = fmaxf(m_run, fmaxf(mx[0], mx[1]));
    const float a_run = __builtin_amdgcn_exp2f(m_run - m_new), a0 = __builtin_amdgcn_exp2f(mx[0] - m_new), a1 = __builtin_amdgcn_exp2f(mx[1] - m_new);
    m_run = m_new; sum = sum * a_run + ps[0] * a0 + ps[1] * a1;
#pragma unroll
    for (int mt = 0; mt < 4; ++mt) O[mt] = O[mt] * a_run + Oq[0][mt] * a0 + Oq[1][mt] * a1;
}
__device__ __forceinline__ void na_phase(const Frame& F, const Args& a) {
    LAS unsigned char* L = F.lds; const int lane = F.lane, w = F.wave, r16 = lane & 15, g4 = lane >> 4;
    const bf16_t* qbuf = (const bf16_t*)(F.ws + T_QKV); const bf16_t* kbuf = qbuf + (size_t)NT * D; const bf16_t* vbuf = kbuf + (size_t)NT * D; bf16_t* cat = (bf16_t*)(F.ws + T_CAT);
    f32x2* mlbuf = (f32x2*)(F.ws + T_Y);
    const int rr = w >> 2, cb = w & 3; const int band = cb == 0 ? 0 : (cb == 1 ? 8 : (cb == 2 ? 24 : 32));
    const float NINF = -__builtin_inff();
    const int pkey = F.tid >> 3, pch = F.tid & 7;
    int boff[2][4], voff[4];
    { const int qc = 16 * cb + r16; int cs = qc - 8; cs = cs < 0 ? 0 : (cs > 48 ? 48 : cs);
#pragma unroll
      for (int hc = 0; hc < 2; ++hc)
#pragma unroll
          for (int e = 0; e < 4; ++e) { const int kc = band + 16 * hc + 4 * g4 + e; const bool ok = kc >= cs && kc < cs + 16; boff[hc][e] = (ok ? kc - qc + 15 : 31) * 4; }
      const int rl = 4 * g4 + (r16 >> 2), sw = (rl >> 1) & 3;
#pragma unroll
      for (int mt = 0; mt < 4; ++mt) voff[mt] = rl * 128 + ((mt ^ sw) << 5) + 8 * (r16 & 3); }
    for (int bh = blockIdx.x; bh < BATCH * NA_H; bh += F.G) {
        const int b = bh >> 4, h = bh & 15;
        __syncthreads();
        for (int i = F.tid; i < 256 * 8; i += NTHREADS) { const int key = i >> 3, ch = i & 7; const size_t g = (size_t)(NX + b * CTXL + key) * D + h * 64 + ch * 8;
            *(LAS u32x4*)(L + NA_VC + na_voff(key, ch)) = *(const u32x4*)(vbuf + g); *(LAS u32x4*)(L + NA_KC + na_koff(key, ch)) = *(const u32x4*)(kbuf + g); }
        __syncthreads();
        {
            bf16x8 qn[2];
            { const bf16_t* q0 = qbuf + (size_t)(b * SEQ + rr * 64 + 16 * cb + r16) * D + h * 64 + 8 * g4; qn[0] = *(const bf16x8*)q0; qn[1] = *(const bf16x8*)(q0 + 32); }
            for (int rp = 0; rp < 16; ++rp) {
                const int r = 2 * rp + rr; const int qrow = b * SEQ + r * 64 + 16 * cb + r16;
                bf16x8 qf[2]; qf[0] = qn[0]; qf[1] = qn[1];
                if (rp < 15) { const bf16_t* q1 = qbuf + (size_t)(qrow + 128) * D + h * 64 + 8 * g4; qn[0] = *(const bf16x8*)q1; qn[1] = *(const bf16x8*)(q1 + 32); }
                f32x4 O[4]; float m_run = NINF, sum = 0.f;
#pragma unroll
                for (int mt = 0; mt < 4; ++mt) O[mt] = (f32x4){0.f, 0.f, 0.f, 0.f};
                na_seg2<true>(L, qf, r16, g4, 0, band, boff, 0, voff, O, m_run, sum);
#pragma unroll
                for (int mt = 0; mt < 4; ++mt) { u32x2 o; o.x = pk2(O[mt][0], O[mt][1]); o.y = pk2(O[mt][2], O[mt][3]); *(u32x2*)(cat + (size_t)qrow * D + h * 64 + 16 * mt + 4 * g4) = o; }
                if (g4 == 0) mlbuf[(size_t)qrow * 16 + h] = (f32x2){m_run, sum};
            }
        }
        __syncthreads();
        asm volatile("s_waitcnt vmcnt(0)" ::: "memory");
        for (int i = F.tid; i < 15 * 32; i += NTHREADS) { const int ri = i >> 5, ci = i & 31; ((LAS float*)(L + NA_RPB))[i] = ci < 31 ? a.in[23][h * 465 + ri * 31 + ci] * 1.4426950408889634f : NINF; }
        for (int gr = 0; gr < 9; ++gr) { const size_t g = (size_t)(b * SEQ + gr * 64 + pkey) * D + h * 64 + pch * 8;
            *(LAS u32x4*)(L + NA_VR + na_voff(gr * 64 + pkey, pch)) = *(const u32x4*)(vbuf + g); *(LAS u32x4*)(L + NA_KR + na_koff(gr * 64 + pkey, pch)) = *(const u32x4*)(kbuf + g); }
        for (int rp = 0; rp < 16; ++rp) {
            int R0 = 2 * rp - 4; R0 = R0 < 0 ? 0 : (R0 > 24 ? 24 : R0);
            int R0n = 2 * rp - 2; R0n = R0n < 0 ? 0 : (R0n > 24 ? 24 : R0n);
            const bool newrows = (rp < 15) && (R0n != R0);
            u32x4 nv0 = (u32x4){0u, 0u, 0u, 0u}, nv1 = nv0, nk0 = nv0, nk1 = nv0;
            if (newrows) { const size_t g0 = (size_t)(b * SEQ + (R0 + 9) * 64 + pkey) * D + h * 64 + pch * 8; nv0 = *(const u32x4*)(vbuf + g0); nk0 = *(const u32x4*)(kbuf + g0);
                if (R0 + 10 < 32) { const size_t g1 = g0 + (size_t)64 * D; nv1 = *(const u32x4*)(vbuf + g1); nk1 = *(const u32x4*)(kbuf + g1); } }
            const int r = 2 * rp + rr; int r0 = r - 4; r0 = r0 < 0 ? 0 : (r0 > 24 ? 24 : r0);
            const int qrow = b * SEQ + r * 64 + 16 * cb + r16;
            bf16x8 qf[2];
#pragma unroll
            for (int ks = 0; ks < 2; ++ks) qf[ks] = *(const bf16x8*)(qbuf + (size_t)qrow * D + h * 64 + 32 * ks + 8 * g4);
            f32x4 O[4]; float m_run, sum;
#pragma unroll
            for (int mt = 0; mt < 4; ++mt) { const u32x2 o = *(const u32x2*)(cat + (size_t)qrow * D + h * 64 + 16 * mt + 4 * g4); O[mt] = (f32x4){bflo(o.x), bfhi(o.x), bflo(o.y), bfhi(o.y)}; }
            { const f32x2 ml = mlbuf[(size_t)qrow * 16 + h]; m_run = ml.x; sum = ml.y; }
            lds_barrier();
            const int rbase = NA_RPB + (r0 - r + 7) * 128;
            na_seg2<false>(L, qf, r16, g4, r0, band, boff, rbase, voff, O, m_run, sum);
            const float inv = 1.0f / sum;
#pragma unroll
            for (int mt = 0; mt < 4; ++mt) { u32x2 o; o.x = pk2(O[mt][0] * inv, O[mt][1] * inv); o.y = pk2(O[mt][2] * inv, O[mt][3] * inv);
                *(u32x2*)(cat + (size_t)qrow * D + h * 64 + 16 * mt + 4 * g4) = o; }
            if (newrows) {
                lds_barrier();
                *(LAS u32x4*)(L + NA_VR + na_voff(((R0 + 9) % NA_RING) * 64 + pkey, pch)) = nv0; *(LAS u32x4*)(L + NA_KR + na_koff(((R0 + 9) % NA_RING) * 64 + pkey, pch)) = nk0;
                *(LAS u32x4*)(L + NA_VR + na_voff(((R0 + 10) % NA_RING) * 64 + pkey, pch)) = nv1; *(LAS u32x4*)(L + NA_KR + na_koff(((R0 + 10) % NA_RING) * 64 + pkey, pch)) = nk1; }
        }
    }
    __syncthreads();
}

#if MK_ONE_LAUNCH
#define GRID_BAR() xcd_barrier(bar)
#else
#define GRID_BAR() do { } while (0)
#endif
#define IN(k) (lo <= (k) && (k) < hi && (k) <= MK_LAST_PHASE)
#define SEAM(k) do { if (IN(k) && IN((k) + 1)) GRID_BAR(); } while (0)
template <int LAYER>
__device__ __forceinline__ void layer_tail(const Frame& F, const Args& args, const int lo, const int hi, const XcdBarrier& bar) {
    unsigned char* ws = args.ws;
    const float* modx = (const float*)(ws + WS_MODX); const float* modc = (const float*)(ws + WS_MODC);
    float* xw = (float*)(ws + WS_XW); bf16_t* Hb = (bf16_t*)(ws + WS_H);
    constexpr int mb = LAYER ? 16 : 7; constexpr int ntok = LAYER ? NX : NT;
    const float* lmodx = modx + (size_t)LAYER * 16 * ADA; const float* lmodc = modc + (size_t)LAYER * ADA;
    if (IN(LAYER ? 14 : 5)) REPEAT_IF(LAYER ? 14 : 5) { REP_BAR();
        SchedDense S{(const char*)(ws + T_CAT), (const char*)(ws + (LAYER ? WS_WOUT1 : WS_WOUT0)), D, ntok / 256, D / 256, 0, 1, 0, F.G, (int)blockIdx.x};
        EpiBf16 E{(bf16_t*)(ws + T_Y), D, 0, 0};
        pg8::gemm_phase<EpiBf16, SchedDense, true>(F.lds, D, S, E);
        if (LAYER == 0 && F.G == 256 && (int)blockIdx.x >= 64) cvt_moe_range(F, args, 0, F0_BULK + F0_P2, F0_BULK + F0_P2 + F0_P5, (int)blockIdx.x - 64, 192);
    }
    SEAM(LAYER ? 14 : 5);
    if (IN(LAYER ? 15 : 6)) REPEAT_IF(LAYER ? 15 : 6) { REP_BAR();
        RowPhase P{}; P.xin_lat = LAYER ? xw : args.in[0]; P.xin_ctx = LAYER ? xw + (size_t)NX * D : args.in[2]; P.xout_lat = xw; P.xout_ctx = xw + (size_t)NX * D; P.nrows = ntok; P.ysrc = 1; P.y = (const bf16_t*)(ws + T_Y);
        P.gpost = args.in[7] + LAYER * D; P.modx = lmodx; P.modc = lmodc; P.gate_chunk = 2;
        P.doH = true; P.H = Hb; P.gpre = args.in[8] + LAYER * D; P.sc_chunk = 4; P.sh_chunk = 3; P.modxH = lmodx; P.modcH = lmodc;
        row_phase(F, P);
    }
    SEAM(LAYER ? 15 : 6);
    if (IN(mb)) REPEAT_IF(mb) { REP_BAR();
        SchedDense S{(const char*)Hb, (const char*)(ws + WS_WR) + (size_t)LAYER * NEXP * D * 2, D, ntok / 256, 1, 0, 1, 0, F.G, (int)blockIdx.x};
        EpiRouter E{args.in[25] + LAYER * NEXP, (int*)(ws + M_AE), (int*)(ws + M_AR), (float*)(ws + M_AG), F.ctl + CW_CNT + LAYER * 256};
        pg8::gemm_phase<EpiRouter, SchedDense, false>(F.lds, D, S, E);
        if (F.G != 256) { } else if (LAYER == 0) { if ((int)blockIdx.x >= 144) cvt_moe_range(F, args, 0, F0_BULK + F0_P2 + F0_P5, MOE_CVT_ITEMS, (int)blockIdx.x - 144, 112); }
        else { if ((int)blockIdx.x >= 128) { const int ntr0 = (int)__hip_atomic_load(F.ctl + CW_TST + 256, __ATOMIC_RELAXED, __HIP_MEMORY_SCOPE_AGENT); int s9, s10; fill1_ranges(F, ntr0, s9, s10);
                cvt_moe_range(F, args, 1, s9 + s10, MOE_CVT_ITEMS - F1_P12, (int)blockIdx.x - 128, 128); } }
    }
    SEAM(mb);
    if (IN(mb + 1)) REPEAT_IF(mb + 1) { REP_BAR(); moe_place(F, LAYER, ntok); }
    SEAM(mb + 1);
    if (IN(mb + 2)) REPEAT_IF(mb + 2) { REP_BAR();
        const int nj = moe_units_setup<2>(F, LAYER, ntok, F.vcu, true);
        SchedMoeGU S{(const char*)Hb, (const char*)(ws + WS_WGU + (size_t)LAYER * WGU_BYTES), (const LAS int*)(F.lds + AUX_TILEE), (const LAS int*)(F.lds + AUX_IDX), nj, F.G, F.vcu};
        EpiGateUp E{(bf16_t*)(ws + M_HID)};
        pg8::gemm_phase<EpiGateUp, SchedMoeGU, true>(F.lds, D, S, E);
        if (LAYER == 0) { const int ntr0 = ((const LAS int*)(F.lds + AUX_TST))[256]; int s9, s10; fill1_ranges(F, ntr0, s9, s10); const int nu = (ntr0 + NT / 256) * 2, hv = nu % F.G;
            if (hv && F.vcu >= hv) cvt_moe_range(F, args, 1, 0, s9, F.vcu - hv, F.G - hv); }
    }
    SEAM(mb + 2);
    if (IN(mb + 3)) REPEAT_IF(mb + 3) { REP_BAR();
        const int nj = moe_units_setup<4>(F, LAYER, ntok, F.vcu, false);
        SchedMoeDN S{(const char*)(ws + M_HID), (const char*)(ws + WS_WDN + (size_t)LAYER * WDN_BYTES), (const LAS int*)(F.lds + AUX_TILEE), nj, F.G, F.vcu};
        EpiF8 E{(unsigned char*)(ws + M_OUT)};
        pg8::gemm_phase<EpiF8, SchedMoeDN, true>(F.lds, DEXP, S, E);
        if (LAYER == 0) { const int ntr0 = ((const LAS int*)(F.lds + AUX_TST))[256]; int s9, s10; fill1_ranges(F, ntr0, s9, s10); const int nu = (ntr0 + NT / 256) * 4, hv = nu % F.G;
            if (hv && F.vcu >= hv) cvt_moe_range(F, args, 1, s9, s9 + s10, F.vcu - hv, F.G - hv); }
    }
    SEAM(mb + 3);
    if (IN(mb + 4)) REPEAT_IF(mb + 4) { REP_BAR();
        RowPhase P{}; P.xin_lat = xw; P.xin_ctx = xw + (size_t)NX * D; P.xout_lat = LAYER ? args.out : xw; P.xout_ctx = xw + (size_t)NX * D; P.nrows = ntok; P.ysrc = 2;
        P.mo8 = (const unsigned char*)(ws + M_OUT); P.tslot = (const int*)(ws + M_TS); P.tgate = (const float*)(ws + M_AG); P.sharedbase = (int)__hip_atomic_load(F.ctl + CW_TST + LAYER * 320 + 256, __ATOMIC_RELAXED, __HIP_MEMORY_SCOPE_AGENT) * 256;
        P.gpost = args.in[9] + LAYER * D; P.modx = lmodx; P.modc = lmodc; P.gate_chunk = 5;
        P.doH = LAYER == 0; P.H = Hb; P.gpre = args.in[6] + D; P.sc_chunk = 1; P.sh_chunk = 0; P.modxH = modx + (size_t)16 * ADA; P.modcH = modc + ADA;
        row_phase(F, P);
        if (LAYER == 0) {
            const int ntr0 = (int)__hip_atomic_load(F.ctl + CW_TST + 256, __ATOMIC_RELAXED, __HIP_MEMORY_SCOPE_AGENT); int s9, s10; fill1_ranges(F, ntr0, s9, s10);
            if (F.G != 256) cvt_moe_range(F, args, 1, 0, MOE_CVT_ITEMS, F.vcu, F.G);
        }
    }
    SEAM(mb + 4);
}

__global__ void __launch_bounds__(NTHREADS, 2) mk_fwd(Args args) {
    extern __shared__ __attribute__((aligned(16))) unsigned char lds_raw[];
    Frame F;
    F.lds = (LAS unsigned char*)lds_raw; F.MISC = (volatile LAS unsigned*)(F.lds + MISC_OFF);
    F.tid = threadIdx.x; F.lane = F.tid & 63; F.wave = __builtin_amdgcn_readfirstlane(F.tid >> 6);
    F.G = gridDim.x; { const int bx = blockIdx.x; F.vcu = (F.G % 8 == 0) ? (bx % 8) * (F.G / 8) + bx / 8 : bx; }
    F.ws = args.ws; F.ctl = (unsigned*)(args.ws + WS_CTL);
    for (int u = F.tid; u < (LDS_BYTES - MISC_OFF) / 4; u += NTHREADS) ((LAS unsigned*)(F.lds + MISC_OFF))[u] = 0u;
    __syncthreads();
    XcdBarrier bar; bar.bar = F.ctl + CW_BAR; bar.x = 0; bar.st = nullptr;
#if MK_ONE_LAUNCH
    bar = xcd_barrier_post(F.ctl + CW_BAR, F.MISC + 8);
#endif
    const int lo = args.ph_lo, hi = args.ph_hi;
    unsigned char* ws = args.ws;
    const float* modx = (const float*)(ws + WS_MODX); const float* modc = (const float*)(ws + WS_MODC);
    float* xw = (float*)(ws + WS_XW); bf16_t* Hb = (bf16_t*)(ws + WS_H);

    if (IN(0)) REPEAT_IF(0) { REP_BAR(); p0_ada(F, args); p0_convert(F, args); }
    SEAM(0);
    {
        if (IN(1)) REPEAT_IF(1) { REP_BAR();
            RowPhase P{}; P.xin_lat = args.in[0]; P.xin_ctx = args.in[2]; P.nrows = NT; P.ysrc = 0; P.modx = modx; P.modc = modc;
            P.doH = true; P.H = Hb; P.gpre = args.in[6]; P.sc_chunk = 1; P.sh_chunk = 0; P.modxH = modx; P.modcH = modc;
            row_phase(F, P);
        }
        SEAM(1);
        if (IN(2)) REPEAT_IF(2) { REP_BAR();
            SchedDense S{(const char*)Hb, (const char*)(ws + WS_WIN0), D, NT / 256, AB_INP / 256, 0, 1, 0, F.G, (int)blockIdx.x};
            EpiInproj E{(bf16_t*)(ws + T_QB), (bf16_t*)(ws + T_KB), (bf16_t*)(ws + T_VB), (bf16_t*)(ws + T_GB), (bf16_t*)(ws + T_UB), (float*)(ws + T_LR), (const f32x2*)(ws + WS_ROPE)};
            pg8::gemm_phase<EpiInproj, SchedDense, true>(F.lds, D, S, E);
            if (F.G == 256 && (int)blockIdx.x >= 48) cvt_moe_range(F, args, 0, F0_BULK, F0_BULK + F0_P2, (int)blockIdx.x - 48, 208);
        }
        SEAM(2);
        if (IN(3)) REPEAT_IF(3) { REP_BAR(); gla_prep_phase(F, args); }
        if (IN(3) && IN(22)) GRID_BAR();
        if (IN(22)) REPEAT_IF(22) { REP_BAR(); gla_seq_phase(F, args); }
        if (IN(22) && IN(4)) GRID_BAR();
        if (IN(4)) REPEAT_IF(4) { REP_BAR(); finish_conv_phase(F, args); }
        SEAM(4);

    }
    layer_tail<0>(F, args, lo, hi, bar);
    {
        if (IN(12)) REPEAT_IF(12) { REP_BAR();
            SchedDense S{(const char*)Hb, (const char*)(ws + WS_WQKV1), D, NX / 256, 12, NC / 256, 8, 4, F.G, (int)blockIdx.x};
            EpiBf16 E{(bf16_t*)(ws + T_QKV), D, D, (size_t)NT * D, 0.125f * 1.4426950408889634f};
            pg8::gemm_phase<EpiBf16, SchedDense, true>(F.lds, D, S, E);
            if (F.G == 256 && (int)blockIdx.x >= 128) cvt_moe_range(F, args, 1, MOE_CVT_ITEMS - F1_P12, MOE_CVT_ITEMS, (int)blockIdx.x - 128, 128);
        }
        SEAM(12);
        if (IN(13)) REPEAT_IF(13) { REP_BAR(); na_phase(F, args); }
        SEAM(13);

    }
    layer_tail<1>(F, args, lo, hi, bar);

#undef IN
#undef SEAM
}

extern "C" void kernel_launch(void* const* d_in, const int* in_sizes, int n_in, void* d_out, int out_size, void* d_ws, size_t ws_size, hipStream_t stream) {
    static int grid = 0;
    if (grid == 0) {
        if (n_in != 32 || out_size != NX * D || ws_size < WS_END) { fprintf(stderr, "kernel_launch: unexpected problem (n_in %d, out %d, ws %zu < %zu)\n", n_in, out_size, ws_size, (size_t)WS_END); grid = -1; return; }
        int dev = 0, cus = 0, per_cu = 0;
        if (hipGetDevice(&dev) != hipSuccess || hipDeviceGetAttribute(&cus, hipDeviceAttributeMultiprocessorCount, dev) != hipSuccess) { grid = -1; return; }
        if (hipFuncSetAttribute((const void*)mk_fwd, hipFuncAttributeMaxDynamicSharedMemorySize, LDS_BYTES) != hipSuccess) { fprintf(stderr, "kernel_launch: hipFuncSetAttribute failed\n"); grid = -1; return; }
        if (hipOccupancyMaxActiveBlocksPerMultiprocessor(&per_cu, (const void*)mk_fwd, NTHREADS, LDS_BYTES) != hipSuccess || per_cu < 1) fprintf(stderr, "kernel_launch: occupancy query says %d\n", per_cu);
        (void)hipGetLastError();
        grid = cus;
    }
    if (grid < 0) return;
    (void)hipMemsetAsync((char*)d_ws + WS_CTL, 0, CTL_BYTES, stream);
    Args a{};
    for (int i = 0; i < 32; ++i) a.in[i] = (const float*)d_in[i];
    a.out = (float*)d_out; a.ws = (unsigned char*)d_ws;
#if MK_ONE_LAUNCH
    a.ph_lo = 0; a.ph_hi = 64;
    hipLaunchKernelGGL(mk_fwd, dim3(grid), dim3(NTHREADS), LDS_BYTES, stream, a);
#else
    for (int p = 0; p <= 20; ++p) { if (p > MK_LAST_PHASE) break; a.ph_lo = p; a.ph_hi = p + 1; hipLaunchKernelGGL(mk_fwd, dim3(grid), dim3(NTHREADS), LDS_BYTES, stream, a); }
#endif
}
```

```cpp
#include <hip/hip_runtime.h>
#include <cstdio>
#include <cstdint>

#ifndef MK_ONE_LAUNCH
#define MK_ONE_LAUNCH 1
#endif
#ifndef MK_LAST_PHASE
#define MK_LAST_PHASE 99
#endif

#ifndef MK_REP
#define MK_REP (-1)
#endif
#define REPEAT_IF(k) _Pragma("unroll") for (int _r = 0; _r < ((k) == MK_REP ? 2 : 1); ++_r)
#define REP_BAR() do { if (_r) GRID_BAR(); } while (0)

#define GAS __attribute__((address_space(1)))
#define LAS __attribute__((address_space(3)))
typedef unsigned short bf16_t;
typedef short bf16x8 __attribute__((ext_vector_type(8)));
typedef float f32x4 __attribute__((ext_vector_type(4)));
typedef float f32x2 __attribute__((ext_vector_type(2)));
typedef unsigned u32x4 __attribute__((ext_vector_type(4)));
typedef unsigned u32x2 __attribute__((ext_vector_type(2)));

constexpr int D = 1024, BATCH = 16, SEQ = 2048, CTXL = 256, GRIDW = 64;
constexpr int NX = BATCH * SEQ, NC = BATCH * CTXL, NT = NX + NC;
constexpr int ADA = 6 * D;
constexpr int GLA_H = 4, GLA_DK = 64, GLA_DV = 128, GLA_QK = 256, GLA_V = 512, CONV_CH = 512, CONV_W = 31;
constexpr int AB_IN = 2592, AB_INP = 2816;
constexpr int NA_H = 16, NA_DH = 64;
constexpr int NEXP = 256, TOPK = 8, DEXP = 256;
constexpr int NEXPS = NEXP + 1;
constexpr int PMAX = NT * TOPK + NEXP * 255 + NT;
static_assert(PMAX % 256 == 0, "PMAX");
constexpr float RMS_EPS = 1e-6f, LN_EPS = 1e-5f;
constexpr float F8_SCALE = 16.0f, F8_INV = 1.0f / 16.0f;

constexpr size_t MiB = 1u << 20;
constexpr size_t al(size_t x) { return (x + 4095) & ~(size_t)4095; }
constexpr size_t WS_CTL = 0, CTL_BYTES = 1 * MiB;
constexpr size_t WS_MODX = WS_CTL + CTL_BYTES;
constexpr size_t WS_MODC = WS_MODX + al((size_t)2 * 16 * ADA * 4);
constexpr size_t WS_ROPE = WS_MODC + al((size_t)2 * ADA * 4);
constexpr size_t WS_XW = WS_ROPE + al(64 * 16 * 8);
constexpr size_t WS_H = WS_XW + al((size_t)NT * D * 4);
constexpr size_t WS_WIN0 = WS_H + al((size_t)NT * D * 2);
constexpr size_t WS_WOUT0 = WS_WIN0 + al((size_t)AB_INP * D * 2);
constexpr size_t WS_WQKV1 = WS_WOUT0 + al((size_t)D * D * 2);
constexpr size_t WS_WOUT1 = WS_WQKV1 + al((size_t)3 * D * D * 2);
constexpr size_t WS_WR = WS_WOUT1 + al((size_t)D * D * 2);
constexpr size_t WGU_BYTES = al((size_t)NEXPS * 512 * D * 2), WDN_BYTES = al((size_t)NEXPS * D * 256 * 2);
constexpr size_t WS_WGU = WS_WR + al((size_t)2 * NEXP * D * 2);
constexpr size_t WS_WDN = WS_WGU + 2 * WGU_BYTES;
constexpr size_t WS_T = WS_WDN + 2 * WDN_BYTES;
constexpr size_t T_QB = WS_T;
constexpr size_t T_KB = T_QB + al((size_t)NT * 256 * 2);
constexpr size_t T_VB = T_KB + al((size_t)NT * 256 * 2);
constexpr size_t T_GB = T_VB + al((size_t)NT * 512 * 2);
constexpr size_t T_UB = T_GB + al((size_t)NT * 512 * 2);
constexpr size_t T_LR = T_UB + al((size_t)NT * 512 * 2);
constexpr size_t T_OF = T_LR + al((size_t)NT * 32 * 4);
constexpr size_t T_OB = T_OF + al((size_t)NT * 512 * 2);
constexpr size_t T_CAT = T_OB + al((size_t)NT * 512 * 2);
constexpr size_t T_Y = T_CAT + al((size_t)NT * D * 2);
constexpr size_t T_GLA = T_Y + al((size_t)NT * D * 2);
constexpr int GI_A = 0, GI_QIN = 8192, GI_KOT = 16384, GI_VT = 24576, GI_DEC = 40960, GI_BYTES = 41216;
constexpr size_t T_END0 = T_GLA + al((size_t)BATCH * GLA_H * 2 * 36 * GI_BYTES + 1024);
constexpr size_t T_QKV = WS_T;
static_assert(T_QKV + (size_t)3 * NT * D * 2 <= T_CAT, "qkv overlay");
constexpr size_t M_AE = WS_T;
constexpr size_t M_AR = M_AE + al((size_t)NT * 8 * 4);
constexpr size_t M_AG = M_AR + al((size_t)NT * 8 * 4);
constexpr size_t M_TS = M_AG + al((size_t)NT * 8 * 4);
constexpr size_t M_ST = M_TS + al((size_t)NT * 8 * 4);
constexpr size_t M_HID = M_ST + al((size_t)PMAX * 4);
constexpr size_t M_OUT = M_HID + al((size_t)PMAX * 256 * 2);
constexpr int MO_LD = 1024;
constexpr size_t M_END = M_OUT + al((size_t)PMAX * D);
constexpr size_t WS_END = (M_END > T_END0 ? M_END : T_END0);
static_assert(WS_END <= (size_t)2040 * MiB, "workspace map must fit 2 GiB");

constexpr int CW_BAR = 4096;
constexpr int CW_CNT = 16384;
constexpr int CW_CUR = 16384 + 512;

constexpr int RING_BYTES = 131072;
constexpr int AUX_OFF = RING_BYTES, AUX_BYTES = 31744;
constexpr int MISC_OFF = AUX_OFF + AUX_BYTES;
constexpr int LDS_BYTES = MISC_OFF + 1024;
constexpr int NWAVES = 8, NTHREADS = 512;

#define LDS_WAIT() asm volatile("s_waitcnt lgkmcnt(0)" ::: "memory")
#define VM_WAIT() asm volatile("s_waitcnt vmcnt(0)" ::: "memory")

__device__ __forceinline__ unsigned f2bf(float f) { unsigned u = __builtin_bit_cast(unsigned, f); return (u + 0x7fffu + ((u >> 16) & 1u)) >> 16; }
__device__ __forceinline__ unsigned pk2(float lo, float hi) { return f2bf(lo) | (f2bf(hi) << 16); }
__device__ __forceinline__ float bf2f(unsigned short b) { return __builtin_bit_cast(float, (unsigned)b << 16); }
__device__ __forceinline__ float bflo(unsigned w) { return __builtin_bit_cast(float, w << 16); }
__device__ __forceinline__ float bfhi(unsigned w) { return __builtin_bit_cast(float, w & 0xffff0000u); }
__device__ __forceinline__ float wave_sum(float v) {
#pragma unroll
    for (int o = 1; o < 64; o <<= 1) v += __shfl_xor(v, o);
    return v;
}
__device__ __forceinline__ float sigmoidf_(float x) { return 1.0f / (1.0f + __expf(-x)); }
__device__ __forceinline__ float siluf_(float x) { return x / (1.0f + __expf(-x)); }

__device__ __forceinline__ void lds_barrier() { asm volatile("s_waitcnt lgkmcnt(0)" ::: "memory"); __builtin_amdgcn_s_barrier(); asm volatile("" ::: "memory"); }
#define XB_TMO      128
#define XB_XCNT(j)  (256  + 64 * (j))
#define XB_XSUB(j)  (1280 + 64 * (j))
#define XB_XGEN(j)  (2304 + 64 * (j))
#define XB_TOP      3328
#define XB_TOPGEN   3392
#define XCD_BAR_WORDS 3456
#define XB_SPIN_CAP (1u << 18)

__device__ __forceinline__ unsigned xb_ld(unsigned* p)              { return __hip_atomic_load(p, __ATOMIC_RELAXED, __HIP_MEMORY_SCOPE_AGENT); }
__device__ __forceinline__ unsigned xb_add(unsigned* p, unsigned v) { return __hip_atomic_fetch_add(p, v, __ATOMIC_RELAXED, __HIP_MEMORY_SCOPE_AGENT); }
__device__ __forceinline__ unsigned xb_xcc_id() { return (unsigned)__builtin_amdgcn_s_getreg((3 << 11) | 20) & 0xFu; }
#define XB_SPIN(cond, bar) do { unsigned _sp = 0; while (cond) { __builtin_amdgcn_s_sleep(1); \
    if ((++_sp & 255u) == 0u) { if (xb_ld(&(bar)[XB_TMO])) break; if (_sp > XB_SPIN_CAP) { atomicAdd(&(bar)[XB_TMO], 1u); break; } } } } while (0)

struct XcdBarrier { unsigned* bar; unsigned x; volatile LAS unsigned* st; };

__device__ __forceinline__ XcdBarrier xcd_barrier_post(unsigned* bar, volatile LAS unsigned* st) {
    XcdBarrier b; b.bar = bar; b.x = xb_xcc_id(); b.st = st;
    if (threadIdx.x == 0) (void)xb_add(&bar[XB_XCNT(b.x)], 1u);
    return b;
}
__device__ __forceinline__ void xcd_barrier_complete(unsigned* bar, unsigned x, unsigned& nloc, unsigned& nx) {
    const unsigned G = gridDim.x * gridDim.y * gridDim.z;
    unsigned sum, cnt, mine, sp = 0u;
    for (;;) {
        sum = 0u; cnt = 0u; mine = 0u;
#pragma unroll
        for (unsigned j = 0; j < 16; ++j) { const unsigned c = xb_ld(&bar[XB_XCNT(j)]); sum += c; cnt += (c > 0u) ? 1u : 0u; mine = (j == x) ? c : mine; }
        if (sum == G) break;
        __builtin_amdgcn_s_sleep(1);
        if ((++sp & 255u) == 0u) { if (xb_ld(&bar[XB_TMO])) break; if (sp > XB_SPIN_CAP) { atomicAdd(&bar[XB_TMO], 1u); break; } }
    }
    nloc = mine > 0u ? mine : 1u; nx = cnt > 0u ? cnt : 1u;
}
__device__ __forceinline__ void xcd_barrier(const XcdBarrier& b) {
    asm volatile("s_waitcnt vmcnt(0)" ::: "memory");
    __syncthreads();
    if (threadIdx.x == 0) {
        unsigned* bar = b.bar;
        __builtin_amdgcn_s_waitcnt(0);
        unsigned nloc = b.st[0], nx = b.st[1];
        if (nloc == 0u) { xcd_barrier_complete(bar, b.x, nloc, nx); b.st[0] = nloc; b.st[1] = nx; }
        const unsigned old = xb_add(&bar[XB_XSUB(b.x)], 1u);
        const unsigned gen = old / nloc;
        if (old + 1u == (gen + 1u) * nloc) {
            __builtin_amdgcn_fence(__ATOMIC_RELEASE, "agent");
            asm volatile("s_waitcnt vmcnt(0)" ::: "memory");
            const unsigned og = xb_add(&bar[XB_TOP], 1u);
            const unsigned tg = og / nx;
            if (og + 1u == (tg + 1u) * nx) xb_add(&bar[XB_TOPGEN], 1u);
            else XB_SPIN(xb_ld(&bar[XB_TOPGEN]) == tg, bar);
            __builtin_amdgcn_fence(__ATOMIC_ACQUIRE, "agent");
            xb_add(&bar[XB_XGEN(b.x)], 1u);
            asm volatile("s_waitcnt vmcnt(0)" ::: "memory");
        } else {
            XB_SPIN(xb_ld(&bar[XB_XGEN(b.x)]) == gen, bar);
            __builtin_amdgcn_fence(__ATOMIC_ACQUIRE, "agent");
            asm volatile("s_waitcnt vmcnt(0)" ::: "memory");
        }
    }
    __syncthreads();
}

namespace pg8 {
constexpr int BM = 256, BK = 64, HALF = 128, HTB = HALF * BK * 2, STAGE_BYTES = 8 * HTB, NXCD = 8, WGM = 8;
__host__ __device__ __forceinline__ int lds_byte(int r, int c) { const int st = (r >> 4) * 2 + (c >> 5), rr = r & 15, cc = c & 31, ob = rr * 64 + cc * 2; return st * 1024 + (ob ^ (((ob >> 9) & 1) << 5)); }
__host__ __device__ __forceinline__ void stage_rc(int b, int& R, int& C) { const int st = b / 1024, sb = b % 1024, swz = sb ^ (((sb >> 9) & 1) << 5); R = (st >> 1) * 16 + swz / 64; C = (st & 1) * 32 + (swz % 64) / 2; }
__host__ __device__ __forceinline__ int perm32(int rho) { const int n = rho >> 4, i = rho & 15; return 8 * (i >> 2) + 4 * n + (i & 3); }

struct Unit { int a, b, orow, ocol, aux; };

__device__ __forceinline__ bool static_order(int L, int nM, int nN, int& pm, int& pn) {
    const int nwg = nM * nN; if (L >= nwg) return false;
    int wgid = L; { const int q = nwg / NXCD, r = nwg % NXCD, xcd = wgid % NXCD, off = wgid / NXCD; wgid = (xcd < r ? xcd * (q + 1) : r * (q + 1) + (xcd - r) * q) + off; }
    const int nig = WGM * nN, gid = wgid / nig, fm = gid * WGM, gsz = (nM - fm) < WGM ? (nM - fm) : WGM;
    pm = fm + ((wgid % nig) % gsz); pn = (wgid % nig) / gsz; return true;
}

template <class Epi, class Sched, bool ALIGN_EPI>
__device__ __forceinline__ void gemm_phase(LAS unsigned char* lds, const int K, const Sched& S, const Epi& E) {
    const int tid = threadIdx.x, wid = __builtin_amdgcn_readfirstlane(tid >> 6), lane = tid & 63, wr = wid >> 2, wc = wid & 3, fr = lane & 15, fq = lane >> 4;
    const int nt = K / BK;
    int Rr[2], Cc[2]; unsigned voffB[2];
#pragma unroll
    for (int i = 0; i < 2; ++i) { int R, C; stage_rc(tid * 16 + i * 8192, R, C); Rr[i] = R; Cc[i] = C; const int Rb = Epi::PERM ? ((R & ~31) + perm32(R & 31)) : R; voffB[i] = (unsigned)(Rb * K + C) * 2u; }
    const size_t kstep = (size_t)(BK * 2);
    const size_t hstepB = (size_t)HALF * K * 2;
    const unsigned ldsw = (unsigned)wid * 1024u;
    const int aoff = lds_byte(wr * 64 + fr, fq * 8), boff = lds_byte(wc * 32 + fr, fq * 8);
#define PG8_SA(b, h) (((b) * 2 + (h)) * HTB)
#define PG8_SB(b, h) ((4 + (b) * 2 + (h)) * HTB)
#define PG8_STAGE(bufoff, gbase, voff) do { _Pragma("unroll") for (int _i = 0; _i < 2; ++_i) \
        __builtin_amdgcn_global_load_lds((const unsigned*)((const char*)(gbase) + (voff)[_i]), (LAS unsigned*)(lds + (bufoff) + ldsw + _i * 8192), 16, 0, 0); } while (0)
#define PG8_LDA(dst, b, h) do { _Pragma("unroll") for (int m = 0; m < 4; ++m) _Pragma("unroll") for (int k = 0; k < 2; ++k) dst[m][k] = *(const LAS bf16x8*)(lds + PG8_SA(b, h) + aoff + m * 2048 + k * 1024); } while (0)
#define PG8_LDB(dst, b, h) do { _Pragma("unroll") for (int n = 0; n < 2; ++n) _Pragma("unroll") for (int k = 0; k < 2; ++k) dst[n][k] = *(const LAS bf16x8*)(lds + PG8_SB(b, h) + boff + n * 2048 + k * 1024); } while (0)
#define PG8_MMA(ai, bj, At, Bt) do { __builtin_amdgcn_s_setprio(1); _Pragma("unroll") for (int m = 0; m < 4; ++m) _Pragma("unroll") for (int n = 0; n < 2; ++n) _Pragma("unroll") for (int k = 0; k < 2; ++k) \
        acc[ai][bj][m][n] = __builtin_amdgcn_mfma_f32_16x16x32_bf16(Bt[n][k], At[m][k], acc[ai][bj][m][n], 0, 0, 0); __builtin_amdgcn_s_setprio(0); } while (0)
#define PG8_WAIT_V(n) asm volatile("s_waitcnt vmcnt(" #n ")" ::: "memory")
#define PG8_WAIT_L(n) asm volatile("s_waitcnt lgkmcnt(" #n ")" ::: "memory")
#define PG8_BAR __builtin_amdgcn_s_barrier()
#define PG8_SCHED __builtin_amdgcn_sched_barrier(0)
    Unit cur, nxt; int ui = 0;
    if (!S.next(0, cur)) return;
    f32x4 acc[2][2][4][2];
#pragma unroll
    for (int a = 0; a < 2; ++a)
#pragma unroll
        for (int b = 0; b < 2; ++b)
#pragma unroll
            for (int m = 0; m < 4; ++m)
#pragma unroll
                for (int n = 0; n < 2; ++n) acc[a][b][m][n] = (f32x4){0.f, 0.f, 0.f, 0.f};
    bf16x8 At[4][2], B0[2][2], B1[2][2];
    unsigned co0[2], co1[2], no0[2], no1[2];
    S.a_off(cur, Rr, Cc, co0, co1);
    const char* const Ab = S.a_base();
    const char* cB = S.b_ptr(cur);
    PG8_STAGE(PG8_SB(0, 0), cB, voffB); PG8_STAGE(PG8_SB(0, 1), cB + hstepB, voffB); PG8_STAGE(PG8_SA(0, 0), Ab, co0); PG8_STAGE(PG8_SA(0, 1), Ab, co1);
    if (wr == 1) PG8_BAR;
    PG8_WAIT_V(2); PG8_BAR;
    PG8_STAGE(PG8_SB(1, 0), cB + kstep, voffB); PG8_STAGE(PG8_SA(1, 0), Ab + kstep, co0); PG8_STAGE(PG8_SB(1, 1), cB + hstepB + kstep, voffB);
    PG8_WAIT_V(6); PG8_BAR;
    for (;;) {
        const bool has_next = S.next(ui + 1, nxt);
        const char* nB = has_next ? S.b_ptr(nxt) : cB;
#pragma nounroll
        for (int t = 0; t < nt; t += 2) {
            const bool last = (t == nt - 2);
            if (last) { if (has_next) S.a_off(nxt, Rr, Cc, no0, no1); else { no0[0] = co0[0]; no0[1] = co0[1]; no1[0] = co1[0]; no1[1] = co1[1]; } }
            const char* a1 = Ab + (size_t)(t + 1) * kstep;
            const char* a2 = last ? Ab : Ab + (size_t)(t + 2) * kstep; const char* b2 = last ? nB : cB + (size_t)(t + 2) * kstep;
            const char* a3 = a2 + kstep; const char* b3 = b2 + kstep;
            unsigned x0[2], x1[2];
            x0[0] = last ? no0[0] : co0[0]; x0[1] = last ? no0[1] : co0[1]; x1[0] = last ? no1[0] : co1[0]; x1[1] = last ? no1[1] : co1[1];
            PG8_LDB(B0, 0, 0); PG8_LDB(B1, 0, 1); PG8_SCHED; PG8_LDA(At, 0, 0); PG8_STAGE(PG8_SA(1, 1), a1, co1);
            PG8_WAIT_V(8); PG8_WAIT_L(0); PG8_BAR; PG8_MMA(0, 0, At, B0); PG8_MMA(0, 1, At, B1); PG8_BAR; PG8_SCHED;
            PG8_LDA(At, 0, 1); PG8_STAGE(PG8_SB(0, 0), b2, voffB); PG8_STAGE(PG8_SB(0, 1), b2 + hstepB, voffB); PG8_STAGE(PG8_SA(0, 0), a2, x0);
            PG8_WAIT_V(8); PG8_WAIT_L(0); PG8_BAR; PG8_MMA(1, 0, At, B0); PG8_MMA(1, 1, At, B1); PG8_BAR; PG8_SCHED;
            PG8_LDB(B0, 1, 0); PG8_LDB(B1, 1, 1); PG8_SCHED; PG8_LDA(At, 1, 0); PG8_STAGE(PG8_SA(0, 1), a2, x1);
            PG8_WAIT_V(8); PG8_WAIT_L(0); PG8_BAR; PG8_MMA(0, 0, At, B0); PG8_MMA(0, 1, At, B1); PG8_BAR; PG8_SCHED;
            PG8_LDA(At, 1, 1); PG8_STAGE(PG8_SB(1, 0), b3, voffB); PG8_STAGE(PG8_SB(1, 1), b3 + hstepB, voffB); PG8_STAGE(PG8_SA(1, 0), a3, x0);
            PG8_WAIT_V(8); PG8_WAIT_L(0); PG8_BAR; PG8_MMA(1, 0, At, B0); PG8_MMA(1, 1, At, B1); PG8_BAR; PG8_SCHED;
        }
        if constexpr (ALIGN_EPI) { if (wr == 0) PG8_BAR; }
        if constexpr (!Epi::AFTER_DRAIN) { E(acc, cur, wr, wc, fr, fq); }
        if (!has_next) break;
#pragma unroll
        for (int a = 0; a < 2; ++a)
#pragma unroll
            for (int b = 0; b < 2; ++b)
#pragma unroll
                for (int m = 0; m < 4; ++m)
#pragma unroll
                    for (int n = 0; n < 2; ++n) acc[a][b][m][n] = (f32x4){0.f, 0.f, 0.f, 0.f};
        cur = nxt; cB = nB; co0[0] = no0[0]; co0[1] = no0[1]; co1[0] = no1[0]; co1[1] = no1[1]; ++ui;
        if constexpr (ALIGN_EPI) { if (wr == 1) PG8_BAR; }
    }
    PG8_WAIT_V(0);
    if constexpr (!ALIGN_EPI) { if (wr == 0) PG8_BAR; }
    PG8_BAR;
    if constexpr (Epi::AFTER_DRAIN) { E.fused(acc, cur, wr, wc, fr, fq, lds, wid, lane); }
#undef PG8_SA
#undef PG8_SB
#undef PG8_STAGE
#undef PG8_LDA
#undef PG8_LDB
#undef PG8_MMA
#undef PG8_WAIT_V
#undef PG8_WAIT_L
#undef PG8_BAR
#undef PG8_SCHED
}
}
using pg8::Unit;

__device__ __forceinline__ unsigned cvt_pk_bf16(float lo, float hi) { unsigned r; asm volatile("v_cvt_pk_bf16_f32 %0, %1, %2" : "=v"(r) : "v"(lo), "v"(hi)); return r; }

struct SchedDense {
    const char* A; const char* Bt; int K; int nM0, nN0, nM1, nN1, pn1off; int G, c;
    __device__ __forceinline__ bool next(int i, Unit& u) const {
        const int L = i * G + c; int pm, pn;
        const int n0 = nM0 * nN0;
        if (L < n0) { pg8::static_order(L, nM0, nN0, pm, pn); }
        else { if (!pg8::static_order(L - n0, nM1, nN1, pm, pn)) return false; pm += nM0; pn += pn1off; }
        u.a = pm; u.b = pn * 256; u.orow = pm * 256; u.ocol = pn * 256; u.aux = pn; return true;
    }
    __device__ __forceinline__ const char* a_base() const { return A; }
    __device__ __forceinline__ const char* b_ptr(const Unit& u) const { return Bt + (size_t)u.b * K * 2; }
    __device__ __forceinline__ void a_off(const Unit& u, const int (&R)[2], const int (&C)[2], unsigned (&o0)[2], unsigned (&o1)[2]) const {
#pragma unroll
        for (int i = 0; i < 2; ++i) { o0[i] = (unsigned)((u.a * 256 + R[i]) * K + C[i]) * 2u; o1[i] = o0[i] + (unsigned)(128 * K * 2); }
    }
};

struct EpiBf16 {
    static constexpr bool PERM = true, AFTER_DRAIN = false;
    bf16_t* O; int ldc; int split_cols; size_t split_stride; float scale0 = 1.0f;
    __device__ __forceinline__ void operator()(const f32x4 (&acc)[2][2][4][2], const Unit& u, int wr, int wc, int fr, int fq) const {
        const int lane = fr + 16 * fq; const int srcb = ((lane >> 2) + 16 * (lane & 3)) << 2;
        const int row0 = u.orow + wr * 64 + (lane >> 2); int colt = u.ocol; bf16_t* base = O;
        float sc = 1.0f;
        if (split_cols) { const int t = colt / split_cols; base += (size_t)t * split_stride; colt -= t * split_cols; if (t == 0) sc = scale0; }
        const int col0 = colt + wc * 32 + 8 * (lane & 3);
#pragma unroll
        for (int ai = 0; ai < 2; ++ai)
#pragma unroll
            for (int m = 0; m < 4; ++m) { bf16_t* rowp = base + (size_t)(row0 + ai * 128 + m * 16) * ldc + col0;
#pragma unroll
                for (int bj = 0; bj < 2; ++bj) { const f32x4 v0 = acc[ai][bj][m][0] * sc, v1 = acc[ai][bj][m][1] * sc;
                    u32x4 w; w.x = cvt_pk_bf16(v0[0], v0[1]); w.y = cvt_pk_bf16(v0[2], v0[3]); w.z = cvt_pk_bf16(v1[0], v1[1]); w.w = cvt_pk_bf16(v1[2], v1[3]);
                    u32x4 t; t.x = (unsigned)__builtin_amdgcn_ds_bpermute(srcb, (int)w.x); t.y = (unsigned)__builtin_amdgcn_ds_bpermute(srcb, (int)w.y); t.z = (unsigned)__builtin_amdgcn_ds_bpermute(srcb, (int)w.z); t.w = (unsigned)__builtin_amdgcn_ds_bpermute(srcb, (int)w.w);
                    *(u32x4*)(rowp + bj * 128) = t; } }
    }
};
struct EpiF8 {
    static constexpr bool PERM = true, AFTER_DRAIN = false;
    unsigned char* O;
    __device__ __forceinline__ int nst(const Unit&, int) const { return 16; }
    __device__ __forceinline__ void operator()(const f32x4 (&acc)[2][2][4][2], const Unit& u, int wr, int wc, int fr, int fq) const {
        const int lane = fr + 16 * fq; const int srcb = ((lane >> 2) + 16 * (lane & 3)) << 2;
        const int row0 = u.orow + wr * 64 + (lane >> 2), col0 = u.ocol + wc * 32 + 8 * (lane & 3);
#pragma unroll
        for (int ai = 0; ai < 2; ++ai)
#pragma unroll
            for (int m = 0; m < 4; ++m) { unsigned char* rowp = O + (size_t)(row0 + ai * 128 + m * 16) * D + col0;
#pragma unroll
                for (int bj = 0; bj < 2; ++bj) { const f32x4 v0 = acc[ai][bj][m][0] * F8_SCALE, v1 = acc[ai][bj][m][1] * F8_SCALE;
                    int w0 = __builtin_amdgcn_cvt_pk_fp8_f32(v0[0], v0[1], 0, false); w0 = __builtin_amdgcn_cvt_pk_fp8_f32(v0[2], v0[3], w0, true);
                    int w1 = __builtin_amdgcn_cvt_pk_fp8_f32(v1[0], v1[1], 0, false); w1 = __builtin_amdgcn_cvt_pk_fp8_f32(v1[2], v1[3], w1, true);
                    u32x2 t; t.x = (unsigned)__builtin_amdgcn_ds_bpermute(srcb, w0); t.y = (unsigned)__builtin_amdgcn_ds_bpermute(srcb, w1);
                    *(u32x2*)(rowp + bj * 128) = t; } }
    }
};
struct EpiInproj {
    static constexpr bool PERM = false, AFTER_DRAIN = false;
    bf16_t *qb, *kb, *vb, *gb, *ub; float* lr; const f32x2* rope;
    __device__ __forceinline__ void operator()(const f32x4 (&acc)[2][2][4][2], const Unit& u, int wr, int wc, int fr, int fq) const {
        const int pn = u.aux; const int row0 = u.orow + wr * 64 + fr;
        if (pn <= 1) {
            bf16_t* dst = pn == 0 ? qb : kb; const float sc = pn == 0 ? 0.125f : 1.0f;
#pragma unroll
            for (int ai = 0; ai < 2; ++ai)
#pragma unroll
                for (int m = 0; m < 4; ++m) {
                    const int row = row0 + ai * 128 + m * 16; const bool lat = row < NX;
                    const int s = row & (SEQ - 1); const int pos = (wc & 1) ? (s & 63) : (s >> 6);
                    f32x2 cs[4];
                    if (lat) {
#pragma unroll
                        for (int e = 0; e < 4; ++e) cs[e] = rope[pos * 16 + 4 * fq + e];
                    } else {
#pragma unroll
                        for (int e = 0; e < 4; ++e) cs[e] = (f32x2){1.f, 0.f};
                    }
#pragma unroll
                    for (int bj = 0; bj < 2; ++bj) {
                        const f32x4 u1 = acc[ai][bj][m][0], u2 = acc[ai][bj][m][1]; f32x4 o1, o2;
#pragma unroll
                        for (int e = 0; e < 4; ++e) { o1[e] = (u1[e] * cs[e].x - u2[e] * cs[e].y) * sc; o2[e] = (u1[e] * cs[e].y + u2[e] * cs[e].x) * sc; }
                        bf16_t* p = dst + (size_t)row * 256 + bj * 128 + wc * 32 + 4 * fq;
                        u32x2 w1, w2; w1.x = cvt_pk_bf16(o1[0], o1[1]); w1.y = cvt_pk_bf16(o1[2], o1[3]); w2.x = cvt_pk_bf16(o2[0], o2[1]); w2.y = cvt_pk_bf16(o2[2], o2[3]);
                        *(u32x2*)p = w1; *(u32x2*)(p + 16) = w2;
                    }
                }
        } else if (pn <= 5) {
            bf16_t* dst = pn <= 3 ? vb : gb; const int cb = (pn & 1) ? 256 : 0;
#pragma unroll
            for (int ai = 0; ai < 2; ++ai)
#pragma unroll
                for (int m = 0; m < 4; ++m) { const int row = row0 + ai * 128 + m * 16;
#pragma unroll
                    for (int bj = 0; bj < 2; ++bj)
#pragma unroll
                        for (int n = 0; n < 2; ++n) { const f32x4 v = acc[ai][bj][m][n]; u32x2 w; w.x = cvt_pk_bf16(v[0], v[1]); w.y = cvt_pk_bf16(v[2], v[3]);
                            *(u32x2*)(dst + (size_t)row * 512 + cb + bj * 128 + wc * 32 + n * 16 + 4 * fq) = w; } }
        } else if (pn <= 9) {
            const int cb = (pn - 6) * 128;
#pragma unroll
            for (int ai = 0; ai < 2; ++ai)
#pragma unroll
                for (int m = 0; m < 4; ++m) { const int row = row0 + ai * 128 + m * 16;
#pragma unroll
                    for (int n = 0; n < 2; ++n) { const f32x4 a = acc[ai][0][m][n], b = acc[ai][1][m][n]; f32x4 o;
#pragma unroll
                        for (int e = 0; e < 4; ++e) o[e] = a[e] * sigmoidf_(b[e]);
                        u32x2 w; w.x = cvt_pk_bf16(o[0], o[1]); w.y = cvt_pk_bf16(o[2], o[3]);
                        *(u32x2*)(ub + (size_t)row * 512 + cb + wc * 32 + n * 16 + 4 * fq) = w; } }
        } else {
            if (wc == 0) {
#pragma unroll
                for (int ai = 0; ai < 2; ++ai)
#pragma unroll
                    for (int m = 0; m < 4; ++m) { const int row = row0 + ai * 128 + m * 16;
#pragma unroll
                        for (int n = 0; n < 2; ++n) *(f32x4*)(lr + (size_t)row * 32 + n * 16 + 4 * fq) = acc[ai][0][m][n]; }
            }
        }
    }
};

struct Args { const float* in[32]; float* out; unsigned char* ws; int ph_lo, ph_hi; };

struct Frame {
    LAS unsigned char* lds; volatile LAS unsigned* MISC; unsigned* ctl; unsigned char* ws;
    int tid, lane, wave, G, vcu;
};

__device__ __forceinline__ void cvt_item(const float* __restrict__ src, int ld, int col0, int ncols, int k0, bf16_t* dst, int ldd, int drow0, LAS unsigned* T, int lane) {
    const bool okc = lane < ncols;
    const float* p = src + (size_t)k0 * ld + col0 + (okc ? lane : 0);
    float v[64];
#pragma unroll
    for (int k = 0; k < 64; ++k) v[k] = __builtin_nontemporal_load(p + (size_t)k * ld);
#pragma unroll
    for (int kp = 0; kp < 32; ++kp) T[lane * 33 + kp] = okc ? pk2(v[2 * kp], v[2 * kp + 1]) : 0u;
    LDS_WAIT(); asm volatile("" ::: "memory");
    const int c = lane & 7;
#pragma unroll
    for (int it = 0; it < 8; ++it) { const int n = (lane >> 3) + 8 * it;
        u32x4 o; o.x = T[n * 33 + 4 * c]; o.y = T[n * 33 + 4 * c + 1]; o.z = T[n * 33 + 4 * c + 2]; o.w = T[n * 33 + 4 * c + 3];
        if (n < ncols) __builtin_nontemporal_store(o, (u32x4*)(dst + (size_t)(drow0 + n) * ldd + k0 + 8 * c)); }
    LDS_WAIT(); asm volatile("" ::: "memory");
}
__device__ __forceinline__ void cvt_matrix_item(const float* src, int ld, int col0, int ncols, int K, bf16_t* dst, int drow0, int item, LAS unsigned* T, int lane) {
    const int ncg = (ncols + 63) >> 6; const int kt = item / ncg, cg = item - kt * ncg;
    const int nc = ncols - cg * 64 < 64 ? ncols - cg * 64 : 64;
    cvt_item(src, ld, col0 + cg * 64, nc, kt * 64, dst, K, drow0 + cg * 64, T, lane);
}

constexpr int MOE_CVT_ITEMS = NEXPS * 192;
__device__ __forceinline__ void cvt_moe_item(const Args& a, int layer, int item, unsigned char* ws, LAS unsigned* T, int lane) {
    const int e = item / 192, r = item - e * 192;
    bf16_t* wgu = (bf16_t*)(ws + WS_WGU + (size_t)layer * WGU_BYTES) + (size_t)e * 512 * D; bf16_t* wdn = (bf16_t*)(ws + WS_WDN + (size_t)layer * WDN_BYTES) + (size_t)e * D * 256;
    if (r < 128) {
        const int kt = r >> 3, gi = r & 7; const int up = gi >> 2, g4 = gi & 3;
        const float* src = e < NEXP ? (up ? a.in[27] : a.in[26]) + ((size_t)layer * NEXP + e) * D * DEXP : (up ? a.in[30] : a.in[29]) + (size_t)layer * D * DEXP;
        cvt_item(src, DEXP, 64 * g4, 64, kt * 64, wgu, D, 256 * (g4 >> 1) + 64 * (g4 & 1) + 128 * up, T, lane);
    } else {
        const int q = r - 128; const int kt = q >> 4, cg = q & 15;
        const float* src = e < NEXP ? a.in[28] + ((size_t)layer * NEXP + e) * DEXP * D : a.in[31] + (size_t)layer * DEXP * D;
        cvt_item(src, D, 64 * cg, 64, kt * 64, wdn, DEXP, 64 * cg, T, lane);
    }
}

__device__ __forceinline__ float row_rms_scale(const f32x4 (&v)[4]) {
    float s = 0.f;
#pragma unroll
    for (int j = 0; j < 4; ++j) s += (v[j].x * v[j].x + v[j].y * v[j].y) + (v[j].z * v[j].z + v[j].w * v[j].w);
    return rsqrtf(wave_sum(s) * (1.0f / D) + RMS_EPS);
}
__device__ __forceinline__ f32x4 ld4(const float* p) { return *(const f32x4*)p; }

struct RowPhase {
    const float* xin_lat; const float* xin_ctx;
    float* xout_lat; float* xout_ctx;
    bool xin16, xout16;
    int nrows;
    int ysrc; const bf16_t* y;
    const unsigned char* mo8; const int* tslot; const float* tgate; int sharedbase;
    const float* gpost; const float* modx; const float* modc; int gate_chunk;
    bool doH; bf16_t* H; const float* gpre; int sc_chunk, sh_chunk; const float* modxH; const float* modcH;
};
__device__ __forceinline__ void row_phase(const Frame& F, const RowPhase& P) {
    const int gw = F.vcu * NWAVES + F.wave, NGW = F.G * NWAVES, lane = F.lane;
    for (int row = gw; row < P.nrows; row += NGW) {
        const bool lat = row < NX; const int b = lat ? (row >> 11) : 0;
        const float* mod = lat ? P.modx + (size_t)b * ADA : P.modc;
        const float* xr = lat ? P.xin_lat + (size_t)row * D : P.xin_ctx + (size_t)(row - NX) * D;
        f32x4 x[4];
        if (P.xin16) { const bf16_t* xr16 = (lat ? (const bf16_t*)P.xin_lat + (size_t)row * D : (const bf16_t*)P.xin_ctx + (size_t)(row - NX) * D);
#pragma unroll
            for (int j = 0; j < 4; ++j) { const u32x2 w = *(const u32x2*)(xr16 + 4 * lane + 256 * j); x[j] = (f32x4){bflo(w.x), bfhi(w.x), bflo(w.y), bfhi(w.y)}; }
        } else {
#pragma unroll
            for (int j = 0; j < 4; ++j) x[j] = ld4(xr + 4 * lane + 256 * j);
        }
        if (P.ysrc) {
            f32x4 y[4];
            if (P.ysrc == 1) {
#pragma unroll
                for (int j = 0; j < 4; ++j) { const u32x2 w = __builtin_nontemporal_load((const u32x2*)(P.y + (size_t)row * D + 4 * lane + 256 * j)); y[j] = (f32x4){bflo(w.x), bfhi(w.x), bflo(w.y), bfhi(w.y)}; }
            } else {
#pragma unroll
                for (int j = 0; j < 4; ++j) { const int w = __builtin_nontemporal_load((const int*)(P.mo8 + (size_t)(P.sharedbase + row) * D + 4 * lane + 256 * j)); const f32x2 lo = __builtin_amdgcn_cvt_pk_f32_fp8(w, false), hi = __builtin_amdgcn_cvt_pk_f32_fp8(w, true); y[j] = (f32x4){lo.x, lo.y, hi.x, hi.y} * F8_INV; }
#pragma unroll
                for (int k = 0; k < TOPK; ++k) { const int sl = P.tslot[(size_t)row * 8 + k]; const float g = P.tgate[(size_t)row * 8 + k] * F8_INV;
#pragma unroll
                    for (int j = 0; j < 4; ++j) { const int w = __builtin_nontemporal_load((const int*)(P.mo8 + (size_t)sl * D + 4 * lane + 256 * j)); const f32x2 lo = __builtin_amdgcn_cvt_pk_f32_fp8(w, false), hi = __builtin_amdgcn_cvt_pk_f32_fp8(w, true);
                        y[j].x += g * lo.x; y[j].y += g * lo.y; y[j].z += g * hi.x; y[j].w += g * hi.y; } }
            }
            const float rs = row_rms_scale(y);
#pragma unroll
            for (int j = 0; j < 4; ++j) { const f32x4 gp = ld4(P.gpost + 4 * lane + 256 * j), gt = ld4(mod + P.gate_chunk * D + 4 * lane + 256 * j); x[j] = x[j] + gt * (y[j] * rs * gp); }
            if (P.xout16) { bf16_t* xo16 = lat ? (bf16_t*)P.xout_lat + (size_t)row * D : (bf16_t*)P.xout_ctx + (size_t)(row - NX) * D;
#pragma unroll
                for (int j = 0; j < 4; ++j) { u32x2 w; w.x = pk2(x[j].x, x[j].y); w.y = pk2(x[j].z, x[j].w); *(u32x2*)(xo16 + 4 * lane + 256 * j) = w; }
            } else { float* xo = lat ? P.xout_lat + (size_t)row * D : P.xout_ctx + (size_t)(row - NX) * D;
#pragma unroll
                for (int j = 0; j < 4; ++j) *(f32x4*)(xo + 4 * lane + 256 * j) = x[j]; }
        }
        if (P.doH) {
            const float rs = row_rms_scale(x); const float* modh = lat ? P.modxH + (size_t)b * ADA : P.modcH;
#pragma unroll
            for (int j = 0; j < 4; ++j) { const f32x4 gp = ld4(P.gpre + 4 * lane + 256 * j), sc = ld4(modh + P.sc_chunk * D + 4 * lane + 256 * j), sh = ld4(modh + P.sh_chunk * D + 4 * lane + 256 * j);
                const f32x4 h = x[j] * rs * gp * (sc + 1.0f) + sh; u32x2 w; w.x = pk2(h.x, h.y); w.y = pk2(h.z, h.w);
                *(u32x2*)(P.H + (size_t)row * D + 4 * lane + 256 * j) = w; }
        }
    }
}


constexpr int FILL_PER_WAVE_S = 3;
constexpr int F0_P2 = 208 * 8 * FILL_PER_WAVE_S, F0_P5 = 192 * 8 * FILL_PER_WAVE_S, F0_P7 = MOE_CVT_ITEMS - F0_P2 - F0_P5;
constexpr int F0_BULK = MOE_CVT_ITEMS - F0_P2 - F0_P5 - F0_P7;
static_assert(F0_BULK >= 0, "fill plan");
constexpr int F1_P12 = 128 * 8 * FILL_PER_WAVE_S;
__device__ __forceinline__ void cvt_moe_range(const Frame& F, const Args& a, int layer, int lo, int hi, int rank, int nranks) {
    LAS unsigned* T = (LAS unsigned*)F.lds + F.wave * (64 * 33);
    for (int it = lo + rank * NWAVES + F.wave; it < hi; it += nranks * NWAVES) cvt_moe_item(a, layer, it, F.ws, T, F.lane);
}
__device__ __forceinline__ void fill1_ranges(const Frame& F, int ntr0, int& s9, int& s10) {
    const int nu9 = (ntr0 + NT / 256) * 2, nu10 = (ntr0 + NT / 256) * 4;
    const int l9 = (nu9 % F.G) ? F.G - nu9 % F.G : 0, l10 = (nu10 % F.G) ? F.G - nu10 % F.G : 0;
    s9 = l9 * NWAVES * FILL_PER_WAVE_S; s10 = l10 * NWAVES * (FILL_PER_WAVE_S / 3);
    if (F.G != 256) { s9 = 0; s10 = 0; }
}

__device__ __forceinline__ void p0_ada(const Frame& F, const Args& a) {
    LAS float* sc = (LAS float*)F.lds;
    if ((int)blockIdx.x >= 96) return;
    for (int i = F.tid; i < 17 * D; i += NTHREADS) { const int r = i >> 10, k = i & 1023; const float v = r < 16 ? a.in[1][r * D + k] : a.in[3][k]; sc[i] = siluf_(v); }
    __syncthreads();
    const int item = blockIdx.x; const int layer = item / 48, cg = item % 48;
    const int cq = F.tid & 31, kl = F.tid >> 5;
    const float* W = a.in[4] + (size_t)layer * D * ADA + cg * 128 + cq * 4;
    f32x4 acc[17];
#pragma unroll
    for (int r = 0; r < 17; ++r) acc[r] = (f32x4){0.f, 0.f, 0.f, 0.f};
    for (int k = kl; k < D; k += 16) {
        const f32x4 w = ld4(W + (size_t)k * ADA);
#pragma unroll
        for (int r = 0; r < 17; ++r) { const float s = sc[r * D + k]; acc[r] = acc[r] + w * s; }
    }
#pragma unroll
    for (int r = 0; r < 17; ++r) { acc[r].x += __shfl_xor(acc[r].x, 32); acc[r].y += __shfl_xor(acc[r].y, 32); acc[r].z += __shfl_xor(acc[r].z, 32); acc[r].w += __shfl_xor(acc[r].w, 32); }
    __syncthreads();
    LAS f32x4* red = (LAS f32x4*)F.lds;
    if (F.lane < 32) {
#pragma unroll
        for (int r = 0; r < 17; ++r) red[(F.wave * 17 + r) * 32 + cq] = acc[r];
    }
    __syncthreads();
    for (int i = F.tid; i < 17 * 32; i += NTHREADS) { const int r = i >> 5, q = i & 31; f32x4 s = red[r * 32 + q];
#pragma unroll
        for (int w = 1; w < 8; ++w) s = s + red[(w * 17 + r) * 32 + q];
        const int col = cg * 128 + q * 4; s = s + ld4(a.in[5] + (size_t)layer * ADA + col);
        float* dst = r < 16 ? (float*)(F.ws + WS_MODX) + ((size_t)layer * 16 + r) * ADA + col : (float*)(F.ws + WS_MODC) + (size_t)layer * ADA + col;
        *(f32x4*)dst = s; }
    __syncthreads();
}

__device__ __forceinline__ void p0_convert(const Frame& F, const Args& a) {
    LAS unsigned* T = (LAS unsigned*)(F.lds + 70 * 1024) + F.wave * (64 * 33);
    const int gw = F.vcu * NWAVES + F.wave, NGW = F.G * NWAVES, lane = F.lane;
    bf16_t* win0 = (bf16_t*)(F.ws + WS_WIN0); bf16_t* wout0 = (bf16_t*)(F.ws + WS_WOUT0); bf16_t* wqkv1 = (bf16_t*)(F.ws + WS_WQKV1); bf16_t* wout1 = (bf16_t*)(F.ws + WS_WOUT1); bf16_t* wr = (bf16_t*)(F.ws + WS_WR);
    constexpr int I_IN = 16 * (4 + 4 + 8 + 8 + 1 + 16);
    constexpr int I_SQ = 16 * 16, I_QKV = 16 * 48, I_R = 16 * 4;
    constexpr int NIT = I_IN + I_SQ + I_QKV + I_SQ + 2 * I_R;
    const int nbulk0 = F.G == 256 ? F0_BULK : MOE_CVT_ITEMS;
    for (int it = gw; it < NIT + nbulk0; it += NGW) {
        int r = it;
        if (r < I_IN) {
            const int kt = r & 15, g = r >> 4; int col0, nc = 64, drow;
            if (g < 24) { col0 = 64 * g; drow = 64 * g; }
            else if (g == 24) { col0 = 1536; nc = 32; drow = 2560; }
            else { const int s = g - 25; const int isb = s >> 3, q = s & 7;
                col0 = 1568 + 512 * isb + 64 * q; drow = 1536 + 256 * (q >> 1) + 128 * isb + 64 * (q & 1); }
            cvt_item(a.in[10], AB_IN, col0, nc, kt * 64, win0, D, drow, T, lane); continue; }
        r -= I_IN;
        if (r < I_SQ) { cvt_matrix_item(a.in[11], D, 0, D, D, wout0, 0, r, T, lane); continue; } r -= I_SQ;
        if (r < I_QKV) { cvt_matrix_item(a.in[21], 3 * D, 0, 3 * D, D, wqkv1, 0, r, T, lane); continue; } r -= I_QKV;
        if (r < I_SQ) { cvt_matrix_item(a.in[22], D, 0, D, D, wout1, 0, r, T, lane); continue; } r -= I_SQ;
        if (r < 2 * I_R) { const int l = r / I_R; cvt_matrix_item(a.in[24] + (size_t)l * D * NEXP, NEXP, 0, NEXP, D, wr + (size_t)l * NEXP * D, 0, r % I_R, T, lane); continue; } r -= 2 * I_R;
        cvt_moe_item(a, 0, r, F.ws, T, lane);
    }
    { u32x4 z = (u32x4){0u, 0u, 0u, 0u}; const size_t n16 = (size_t)(AB_INP - AB_IN) * D * 2 / 16; u32x4* p = (u32x4*)(win0 + (size_t)AB_IN * D);
      for (size_t i = (size_t)blockIdx.x * NTHREADS + F.tid; i < n16; i += (size_t)F.G * NTHREADS) p[i] = z; }
    if (blockIdx.x == 0) { f32x2* rt = (f32x2*)(F.ws + WS_ROPE);
        for (int i = F.tid; i < 64 * 16; i += NTHREADS) { const int pos = i >> 4, f = i & 15; const float inv = powf(10000.0f, -(float)f / 16.0f); const float ang = (float)pos * inv; rt[i] = (f32x2){cosf(ang), sinf(ang)}; } }
}


__device__ __forceinline__ int gsw(int row, int ch) { return row * 128 + ((ch ^ (row & 7)) << 4); }
__device__ __forceinline__ int gla_row(int n, int p, int b, int d) {
    const bool isctx = n < 4; const int j = isctx ? n : n - 4; int pos = j * 64 + p;
    if (d) pos = (isctx ? CTXL : SEQ) - 1 - pos;
    return isctx ? NX + b * CTXL + pos : b * SEQ + pos;
}
struct GlaRaw { u32x4 q, k, v0, v1; f32x4 lr[4]; };
__device__ __forceinline__ void gla_load(GlaRaw& R, int n, int lane, int w, int b, int h, int d, const bf16_t* qb, const bf16_t* kb, const bf16_t* vb, const float* lr) {
    const int row = gla_row(n, lane, b, d);
    R.q = *(const u32x4*)(qb + (size_t)row * 256 + h * 64 + 8 * w);
    R.k = *(const u32x4*)(kb + (size_t)row * 256 + h * 64 + 8 * w);
    R.v0 = *(const u32x4*)(vb + (size_t)row * 512 + h * 128 + 8 * w);
    R.v1 = *(const u32x4*)(vb + (size_t)row * 512 + h * 128 + 64 + 8 * w);
#pragma unroll
    for (int i = 0; i < 4; ++i) R.lr[i] = *(const f32x4*)(lr + (size_t)row * 32 + d * 16 + 4 * i);
}
__device__ __forceinline__ void unpack8(const u32x4& w, float (&f)[8]) { f[0] = bflo(w.x); f[1] = bfhi(w.x); f[2] = bflo(w.y); f[3] = bfhi(w.y); f[4] = bflo(w.z); f[5] = bfhi(w.z); f[6] = bflo(w.w); f[7] = bfhi(w.w); }
constexpr int GPL_QE = 0, GPL_KE = 8192, GPL_OUT = 16384, GPL_BUF = 16384 + GI_BYTES + 256, GPL_DW = 2 * GPL_BUF, GPL_DB = GPL_DW + 4096, GPL_END = GPL_DB + 256;
static_assert(GPL_END <= RING_BYTES && (GPL_BUF % 16) == 0, "gla prep lds");
__device__ __forceinline__ void gla_prep_phase(const Frame& F, const Args& a) {
    LAS unsigned char* L = F.lds; const int lane = F.lane, w = F.wave, r16 = lane & 15, g4 = lane >> 4;
    const bf16_t* qb = (const bf16_t*)(F.ws + T_QB); const bf16_t* kb = (const bf16_t*)(F.ws + T_KB); const bf16_t* vb = (const bf16_t*)(F.ws + T_VB); const float* lrb = (const float*)(F.ws + T_LR);
    for (int cc = blockIdx.x; cc < 256; cc += F.G) {
        const int sq = cc & 127, b = sq >> 3, h = (sq >> 1) & 3, d = sq & 1;
        const float* dw = d ? a.in[14] : a.in[12]; const float* db = d ? a.in[15] : a.in[13];
        __syncthreads();
        for (int i = F.tid; i < 16 * 64; i += NTHREADS) ((LAS float*)(L + GPL_DW))[i] = dw[(i >> 6) * GLA_QK + h * 64 + (i & 63)];
        if (F.tid < 64) ((LAS float*)(L + GPL_DB))[F.tid] = db[h * 64 + F.tid];
        GlaRaw R; gla_load(R, cc >> 7, lane, w, b, h, d, qb, kb, vb, lrb);
        __syncthreads();
        for (int k = 0; k < 18; ++k) {
            const int n = (cc >> 7) + 2 * k;
            LAS unsigned char* PB = L + (k & 1) * GPL_BUF; LAS unsigned char* OUT = PB + GPL_OUT;
            {
                float z[8], q[8], kk[8], v0[8], v1[8];
                unpack8(R.q, q); unpack8(R.k, kk); unpack8(R.v0, v0); unpack8(R.v1, v1);
                const LAS float* DW = (const LAS float*)(L + GPL_DW); const LAS float* DB = (const LAS float*)(L + GPL_DB);
#pragma unroll
                for (int j = 0; j < 8; ++j) z[j] = DB[8 * w + j];
#pragma unroll
                for (int r = 0; r < 16; ++r) { const float x = R.lr[r >> 2][r & 3]; const f32x4 w0 = *(const LAS f32x4*)(DW + r * 64 + 8 * w), w1 = *(const LAS f32x4*)(DW + r * 64 + 8 * w + 4);
                    z[0] += x * w0.x; z[1] += x * w0.y; z[2] += x * w0.z; z[3] += x * w0.w; z[4] += x * w1.x; z[5] += x * w1.y; z[6] += x * w1.z; z[7] += x * w1.w; }
                float qe[8], ke[8], qi[8]; unsigned short ko[8]; float ld[8];
#pragma unroll
                for (int j = 0; j < 8; ++j) ld[j] = (fminf(z[j], 0.f) - __logf(1.0f + __expf(-fabsf(z[j])))) * (1.0f / 16.0f);
#pragma unroll
                for (int o = 1; o < 64; o <<= 1) { float t[8];
#pragma unroll
                    for (int j = 0; j < 8; ++j) t[j] = __shfl_up(ld[j], o);
#pragma unroll
                    for (int j = 0; j < 8; ++j) ld[j] += (lane >= o) ? t[j] : 0.f; }
                float decv = 0.f;
#pragma unroll
                for (int j = 0; j < 8; ++j) {
                    const float bm = __builtin_bit_cast(float, __builtin_amdgcn_readlane(__builtin_bit_cast(int, ld[j]), 31)), bl = __builtin_bit_cast(float, __builtin_amdgcn_readlane(__builtin_bit_cast(int, ld[j]), 63));
                    const float e1 = __expf(ld[j] - bm), e2 = __expf(bm - ld[j]);
                    qe[j] = q[j] * e1; ke[j] = kk[j] * e2; qi[j] = q[j] * __expf(ld[j]); ko[j] = (unsigned short)f2bf(kk[j] * __expf(bl - ld[j]));
                    decv = (lane == j) ? __expf(bl) : decv;
                }
                if (lane < 8) ((LAS float*)(OUT + GI_DEC))[8 * w + lane] = decv;
                *(LAS u32x4*)(PB + GPL_QE + gsw(lane, w)) = (u32x4){pk2(qe[0], qe[1]), pk2(qe[2], qe[3]), pk2(qe[4], qe[5]), pk2(qe[6], qe[7])};
                *(LAS u32x4*)(PB + GPL_KE + gsw(lane, w)) = (u32x4){pk2(ke[0], ke[1]), pk2(ke[2], ke[3]), pk2(ke[4], ke[5]), pk2(ke[6], ke[7])};
                *(LAS u32x4*)(OUT + GI_QIN + gsw(lane, w)) = (u32x4){pk2(qi[0], qi[1]), pk2(qi[2], qi[3]), pk2(qi[4], qi[5]), pk2(qi[6], qi[7])};
#pragma unroll
                for (int j = 0; j < 8; ++j) { const int rw = 8 * w + j;
                    *(LAS unsigned short*)(OUT + GI_KOT + gsw(rw, lane >> 3) + (lane & 7) * 2) = ko[j];
                    *(LAS unsigned short*)(OUT + GI_VT + gsw(rw, lane >> 3) + (lane & 7) * 2) = (unsigned short)f2bf(v0[j]);
                    *(LAS unsigned short*)(OUT + GI_VT + gsw(64 + rw, lane >> 3) + (lane & 7) * 2) = (unsigned short)f2bf(v1[j]); }
            }
            if (k + 1 < 18) gla_load(R, n + 2, lane, w, b, h, d, qb, kb, vb, lrb);
            lds_barrier();
#pragma unroll
            for (int i = 0; i < 2; ++i) { const int tI = 2 * w + i, st = tI >> 2, pt = tI & 3;
                f32x4 c = (f32x4){0.f, 0.f, 0.f, 0.f};
                if (st <= pt) {
#pragma unroll
                    for (int ks = 0; ks < 2; ++ks) { const bf16x8 af = *(const LAS bf16x8*)(PB + GPL_KE + gsw(16 * st + r16, 4 * ks + g4)), bfr = *(const LAS bf16x8*)(PB + GPL_QE + gsw(16 * pt + r16, 4 * ks + g4));
                        c = __builtin_amdgcn_mfma_f32_16x16x32_bf16(af, bfr, c, 0, 0, 0); }
                    const int p = 16 * pt + r16, s0 = 16 * st + 4 * g4;
#pragma unroll
                    for (int e = 0; e < 4; ++e) if (s0 + e > p) c[e] = 0.f;
                }
                u32x2 o; o.x = pk2(c[0], c[1]); o.y = pk2(c[2], c[3]);
                *(LAS u32x2*)(OUT + GI_A + gsw(16 * pt + r16, 2 * st + (g4 >> 1)) + (g4 & 1) * 8) = o; }
            lds_barrier();
            { unsigned char* rec = F.ws + T_GLA + (size_t)(sq * 36 + n) * GI_BYTES;
              for (int i = F.tid; i < GI_BYTES / 16; i += NTHREADS) *(u32x4*)(rec + i * 16) = *(const LAS u32x4*)(OUT + i * 16); }
        }
    }
    __syncthreads();
}
constexpr int GSL_IN = 33792  , GSL_ST = 3 * GSL_IN, GSL_END = GSL_ST + 2 * 8192;
static_assert(GSL_END <= RING_BYTES, "gla seq lds");
__device__ __forceinline__ void gla_seq_phase(const Frame& F, const Args& a) {
    LAS unsigned char* L = F.lds; const int lane = F.lane, w = F.wave, r16 = lane & 15, g4 = lane >> 4, tid = F.tid;
    for (int it = blockIdx.x; it < 256; it += F.G) {
        const int sq = it >> 1, vh = it & 1, b = sq >> 3, h = (sq >> 1) & 3, d = sq & 1;
        bf16_t* ob = (bf16_t*)(F.ws + (d ? T_OB : T_OF));
        const unsigned char* rec0 = F.ws + T_GLA + (size_t)(sq * 36) * GI_BYTES;
        __syncthreads();
        for (int i = tid; i < 2 * 8192 / 4; i += NTHREADS) ((LAS unsigned*)(L + GSL_ST))[i] = 0u;
        f32x4 Sacc[2] = {(f32x4){0.f, 0.f, 0.f, 0.f}, (f32x4){0.f, 0.f, 0.f, 0.f}};
#define GLA_DMA(n_) do { const unsigned char* r_ = rec0 + (size_t)(n_) * GI_BYTES; LAS unsigned char* d_ = L + ((n_) % 3) * GSL_IN; \
            __builtin_amdgcn_global_load_lds((const unsigned*)(r_ + GI_A + tid * 16), (LAS unsigned*)(d_ + w * 1024), 16, 0, 0); \
            __builtin_amdgcn_global_load_lds((const unsigned*)(r_ + GI_QIN + tid * 16), (LAS unsigned*)(d_ + 8192 + w * 1024), 16, 0, 0); \
            __builtin_amdgcn_global_load_lds((const unsigned*)(r_ + GI_KOT + tid * 16), (LAS unsigned*)(d_ + 16384 + w * 1024), 16, 0, 0); \
            __builtin_amdgcn_global_load_lds((const unsigned*)(r_ + GI_VT + vh * 8192 + tid * 16), (LAS unsigned*)(d_ + 24576 + w * 1024), 16, 0, 0); \
            __builtin_amdgcn_global_load_lds((const unsigned*)(r_ + GI_DEC + lane * 16), (LAS unsigned*)(d_ + 32768), 16, 0, 0); } while (0)
        GLA_DMA(0); GLA_DMA(1);
        for (int n = 0; n < 36; ++n) {
            LAS unsigned char* IN = L + (n % 3) * GSL_IN; LAS unsigned char* STr = L + GSL_ST + (n & 1) * 8192; LAS unsigned char* STw = L + GSL_ST + ((n + 1) & 1) * 8192;
            if (n == 0) asm volatile("s_waitcnt vmcnt(5)" ::: "memory"); else if (n < 35) asm volatile("s_waitcnt vmcnt(7)" ::: "memory"); else asm volatile("s_waitcnt vmcnt(2)" ::: "memory");
            lds_barrier();
            if (n + 2 < 36) GLA_DMA(n + 2);
#pragma unroll
            for (int i = 0; i < 2; ++i) { const int tI = 2 * w + i, vt = tI >> 2, pt = tI & 3;
                f32x4 c = (f32x4){0.f, 0.f, 0.f, 0.f};
#pragma unroll
                for (int ks = 0; ks < 2; ++ks) {
                    const bf16x8 a1 = *(const LAS bf16x8*)(IN + 24576 + gsw(16 * vt + r16, 4 * ks + g4)), b1 = *(const LAS bf16x8*)(IN + gsw(16 * pt + r16, 4 * ks + g4));
                    c = __builtin_amdgcn_mfma_f32_16x16x32_bf16(a1, b1, c, 0, 0, 0);
                    const bf16x8 a2 = *(const LAS bf16x8*)(STr + gsw(16 * vt + r16, 4 * ks + g4)), b2 = *(const LAS bf16x8*)(IN + 8192 + gsw(16 * pt + r16, 4 * ks + g4));
                    c = __builtin_amdgcn_mfma_f32_16x16x32_bf16(a2, b2, c, 0, 0, 0); }
                const int row = gla_row(n, 16 * pt + r16, b, d);
                u32x2 o; o.x = pk2(c[0], c[1]); o.y = pk2(c[2], c[3]);
                *(u32x2*)(ob + (size_t)row * 512 + h * 128 + vh * 64 + 16 * vt + 4 * g4) = o; }
#pragma unroll
            for (int i = 0; i < 2; ++i) { const int tI = 2 * w + i, ct = tI >> 2, vt = tI & 3;
                const f32x4 dc = *(const LAS f32x4*)(IN + 32768 + (16 * ct + 4 * g4) * 4);
                f32x4 c = Sacc[i] * dc;
#pragma unroll
                for (int ks = 0; ks < 2; ++ks) { const bf16x8 af = *(const LAS bf16x8*)(IN + 16384 + gsw(16 * ct + r16, 4 * ks + g4)), bfr = *(const LAS bf16x8*)(IN + 24576 + gsw(16 * vt + r16, 4 * ks + g4));
                    c = __builtin_amdgcn_mfma_f32_16x16x32_bf16(af, bfr, c, 0, 0, 0); }
                Sacc[i] = c;
                u32x2 o; o.x = pk2(c[0], c[1]); o.y = pk2(c[2], c[3]);
                *(LAS u32x2*)(STw + gsw(16 * vt + r16, 2 * ct + (g4 >> 1)) + (g4 & 1) * 8) = o; }
        }
#undef GLA_DMA
        asm volatile("s_waitcnt vmcnt(0)" ::: "memory");
    }
    __syncthreads();
}

__device__ __forceinline__ void finish_conv_phase(const Frame& F, const Args& a) {
    const int lane = F.lane; bf16_t* cat = (bf16_t*)(F.ws + T_CAT);
    {
        const bf16_t* of = (const bf16_t*)(F.ws + T_OF); const bf16_t* obk = (const bf16_t*)(F.ws + T_OB); const bf16_t* gb = (const bf16_t*)(F.ws + T_GB);
        const int gw = F.vcu * NWAVES + F.wave, NGW = F.G * NWAVES;
        float gg[8];
#pragma unroll
        for (int j = 0; j < 8; ++j) gg[j] = a.in[16][8 * lane + j];
        for (int row = gw; row < NT; row += NGW) {
            float x[8], y[8], g[8];
            unpack8(*(const u32x4*)(of + (size_t)row * 512 + 8 * lane), x); unpack8(*(const u32x4*)(obk + (size_t)row * 512 + 8 * lane), y); unpack8(*(const u32x4*)(gb + (size_t)row * 512 + 8 * lane), g);
            float ss = 0.f;
#pragma unroll
            for (int j = 0; j < 8; ++j) { x[j] += y[j]; ss += x[j] * x[j]; }
            ss += __shfl_xor(ss, 1); ss += __shfl_xor(ss, 2); ss += __shfl_xor(ss, 4); ss += __shfl_xor(ss, 8);
            const float rs = rsqrtf(ss * (1.0f / 128.0f) + RMS_EPS);
#pragma unroll
            for (int j = 0; j < 8; ++j) x[j] = x[j] * rs * gg[j] * siluf_(g[j]);
            *(u32x4*)(cat + (size_t)row * D + 8 * lane) = (u32x4){pk2(x[0], x[1]), pk2(x[2], x[3]), pk2(x[4], x[5]), pk2(x[6], x[7])};
        }
    }
    {
        const bf16_t* ub = (const bf16_t*)(F.ws + T_UB); LAS float* tile = (LAS float*)F.lds;
        const int c = F.tid;
        float wv[CONV_W];
#pragma unroll
        for (int j = 0; j < CONV_W; ++j) wv[j] = a.in[17][j * CONV_CH + c];
        const float cb = a.in[18][c];
        float lg[8], lb[8];
#pragma unroll
        for (int i = 0; i < 8; ++i) { lg[i] = a.in[19][lane + 64 * i]; lb[i] = a.in[20][lane + 64 * i]; }
        for (int ti = blockIdx.x; ti < NT / 32; ti += F.G) {
            const int row0 = ti * 32; const bool lat = row0 < NX;
            const int t0 = lat ? (row0 & (SEQ - 1)) : ((row0 - NX) & (CTXL - 1)); const int len = lat ? SEQ : CTXL; const int sbase = row0 - t0;
            float in[62];
            unsigned short raw[62];
#pragma unroll
            for (int i = 0; i < 62; ++i) { int t = t0 - 15 + i; t = t < 0 ? 0 : (t >= len ? len - 1 : t); raw[i] = ub[(size_t)(sbase + t) * 512 + c]; }
#pragma unroll
            for (int i = 0; i < 62; ++i) { const int t = t0 - 15 + i; in[i] = (t >= 0 && t < len) ? bf2f(raw[i]) : 0.f; }
            __syncthreads();
#pragma unroll
            for (int t = 0; t < 32; ++t) { float s = cb;
#pragma unroll
                for (int j = 0; j < CONV_W; ++j) s += wv[j] * in[t + j];
                tile[t * 512 + c] = s; }
            __syncthreads();
#pragma unroll
            for (int q = 0; q < 4; ++q) { const int t = 4 * F.wave + q; float v[8]; float s = 0.f;
#pragma unroll
                for (int i = 0; i < 8; ++i) { v[i] = tile[t * 512 + lane + 64 * i]; s += v[i]; }
                const float mu = wave_sum(s) * (1.0f / 512.0f); float qq = 0.f;
#pragma unroll
                for (int i = 0; i < 8; ++i) { v[i] -= mu; qq += v[i] * v[i]; }
                const float rstd = rsqrtf(wave_sum(qq) * (1.0f / 512.0f) + LN_EPS);
#pragma unroll
                for (int i = 0; i < 8; ++i) { const float y = v[i] * rstd * lg[i] + lb[i]; cat[(size_t)(row0 + t) * D + 512 + lane + 64 * i] = (bf16_t)f2bf(siluf_(y)); } }
        }
        __syncthreads();
    }
}


constexpr int CW_TST = 20480;
constexpr int AUX_TST = AUX_OFF, AUX_TILEE = AUX_OFF + 1040, AUX_IDX = AUX_OFF + 1168;
constexpr int MOE_MAXU = 32, MOE_MAXIDX = 16;
static_assert(AUX_IDX + MOE_MAXIDX * 1024 <= MISC_OFF, "aux lds");

struct EpiRouter {
    static constexpr bool PERM = false, AFTER_DRAIN = true;
    const float* rbias; int* asg_e; int* asg_r; float* asg_g; unsigned* counts;
    __device__ __forceinline__ void operator()(const f32x4 (&)[2][2][4][2], const Unit&, int, int, int, int) const {}
    __device__ __forceinline__ void fused(const f32x4 (&acc)[2][2][4][2], const Unit& u, int wr, int wc, int fr, int fq, LAS unsigned char* lds, int wid, int lane) const {
        LAS float* SC = (LAS float*)lds;
        LAS unsigned* lcnt = (LAS unsigned*)(lds + 66560); LAS unsigned* lbase = lcnt + 256;
        LAS int* selE = (LAS int*)(lbase + 256); LAS int* selR = selE + 2048;
        const int tid = wid * 64 + lane;
        if (tid < 256) lcnt[tid] = 0u;
        const f32x4 rb = *(const f32x4*)(rbias + 4 * lane);
        const float NINF = -__builtin_inff();
#pragma unroll
        for (int ai = 0; ai < 2; ++ai)
#pragma unroll
            for (int mm = 0; mm < 2; ++mm) {
                LDS_WAIT(); __builtin_amdgcn_s_barrier(); asm volatile("" ::: "memory");
#pragma unroll
                for (int mi = 0; mi < 2; ++mi) { const int lr = 32 * wr + 16 * mi + fr;
#pragma unroll
                    for (int bj = 0; bj < 2; ++bj)
#pragma unroll
                        for (int n = 0; n < 2; ++n) *(LAS f32x4*)(SC + lr * 260 + 128 * bj + 32 * wc + 16 * n + 4 * fq) = acc[ai][bj][2 * mm + mi][n]; }
                LDS_WAIT(); __builtin_amdgcn_s_barrier(); asm volatile("" ::: "memory");
                for (int q = 0; q < 8; ++q) {
                    const int lr = 8 * wid + q; const int rit = 128 * ai + 64 * (lr >> 5) + 16 * (2 * mm + ((lr >> 4) & 1)) + (lr & 15);
                    const f32x4 lg = *(const LAS f32x4*)(SC + lr * 260 + 4 * lane);
                    float s[4], cd[4];
#pragma unroll
                    for (int j = 0; j < 4; ++j) { s[j] = 1.0f / (1.0f + __expf(-lg[j])); cd[j] = s[j] + rb[j]; }
                    float m1 = fmaxf(cd[0], cd[1]), m2 = fminf(cd[0], cd[1]);
                    { const float x = cd[2]; const float n1 = fmaxf(m1, x); m2 = fmaxf(fminf(m1, x), m2); m1 = n1; }
                    { const float x = cd[3]; const float n1 = fmaxf(m1, x); m2 = fmaxf(fminf(m1, x), m2); m1 = n1; }
#pragma unroll
                    for (int o = 1; o < 8; o <<= 1) { const float a1 = __shfl_xor(m1, o), a2 = __shfl_xor(m2, o); const float n1 = fmaxf(m1, a1); m2 = fmaxf(fminf(m1, a1), fmaxf(m2, a2)); m1 = n1; }
                    const float gs = m1 + m2; const int mygrp = lane >> 3; int rank = 0;
#pragma unroll
                    for (int g = 0; g < 8; ++g) { const float og = __shfl(gs, 8 * g); rank += (og > gs || (og == gs && g < mygrp)) ? 1 : 0; }
                    if (rank >= 4) { cd[0] = NINF; cd[1] = NINF; cd[2] = NINF; cd[3] = NINF; }
                    int myE = 0; float myG = 0.f; float gsum = 0.f;
#pragma unroll
                    for (int k = 0; k < TOPK; ++k) {
                        float bv = cd[0]; int bi = 0;
                        if (cd[1] > bv) { bv = cd[1]; bi = 1; } if (cd[2] > bv) { bv = cd[2]; bi = 2; } if (cd[3] > bv) { bv = cd[3]; bi = 3; }
                        float v = bv; int ix = 4 * lane + bi;
#pragma unroll
                        for (int o = 32; o >= 1; o >>= 1) { const float ov = __shfl_xor(v, o); const int oi = __shfl_xor(ix, o); if (ov > v || (ov == v && oi < ix)) { v = ov; ix = oi; } }
                        const int sl = ix & 3; const float mys = sl == 0 ? s[0] : (sl == 1 ? s[1] : (sl == 2 ? s[2] : s[3]));
                        const float gv = __shfl(mys, ix >> 2);
                        gsum += gv;
                        if (lane == k) { myE = ix; myG = gv; }
                        if (lane == (ix >> 2)) { if (sl == 0) cd[0] = NINF; else if (sl == 1) cd[1] = NINF; else if (sl == 2) cd[2] = NINF; else cd[3] = NINF; }
                    }
                    if (lane < TOPK) { const unsigned r = __hip_atomic_fetch_add(&lcnt[myE], 1u, __ATOMIC_RELAXED, __HIP_MEMORY_SCOPE_WORKGROUP); selE[rit * 8 + lane] = myE; selR[rit * 8 + lane] = (int)r; asg_g[(size_t)(u.orow + rit) * 8 + lane] = myG / gsum * 2.5f; }
                }
            }
        LDS_WAIT(); __builtin_amdgcn_s_barrier(); asm volatile("" ::: "memory");
        if (tid < 256) { const unsigned c = lcnt[tid]; lbase[tid] = c ? atomicAdd(&counts[tid], c) : 0u; }
        LDS_WAIT(); __builtin_amdgcn_s_barrier(); asm volatile("" ::: "memory");
        for (int i = tid; i < 2048; i += NTHREADS) { const int e = selE[i]; asg_e[(size_t)u.orow * 8 + i] = e; asg_r[(size_t)u.orow * 8 + i] = (int)lbase[e] + selR[i]; }
    }
};

__device__ __forceinline__ void moe_place(const Frame& F, int layer, int ntok) {
    LAS int* cnt = (LAS int*)F.lds; LAS int* tst = cnt + 256;
    const unsigned* counts = F.ctl + CW_CNT + layer * 256;
    const int* asg_e = (const int*)(F.ws + M_AE); const int* asg_r = (const int*)(F.ws + M_AR); int* tslot = (int*)(F.ws + M_TS); int* stok = (int*)(F.ws + M_ST);
    __syncthreads();
    if (F.tid < 256) cnt[F.tid] = (int)counts[F.tid];
    __syncthreads();
    if (F.tid == 0) { int acc = 0; for (int e = 0; e < 256; ++e) { tst[e] = acc; acc += (cnt[e] + 255) >> 8; } tst[256] = acc; }
    __syncthreads();
    const int ntr = tst[256];
    if (blockIdx.x == 0) for (int i = F.tid; i < 257; i += NTHREADS) F.ctl[CW_TST + layer * 320 + i] = (unsigned)tst[i];
    const int gt = blockIdx.x * NTHREADS + F.tid, gs = F.G * NTHREADS;
    for (int i = gt; i < ntok * 8; i += gs) { const int e = asg_e[i]; const int slot = tst[e] * 256 + asg_r[i]; stok[slot] = i >> 3; tslot[i] = slot; }
    for (int e = blockIdx.x; e < 256; e += F.G) { const int s0 = tst[e] * 256 + cnt[e], s1 = tst[e + 1] * 256; for (int s = s0 + F.tid; s < s1; s += NTHREADS) stok[s] = 0; }
    for (int i = gt; i < ntok; i += gs) stok[ntr * 256 + i] = i;
    __syncthreads();
}

template <int NCOL>
__device__ __forceinline__ int moe_units_setup(const Frame& F, int layer, int ntok, int c, bool want_idx) {
    LAS int* tst = (LAS int*)(F.lds + AUX_TST); LAS int* tileE = (LAS int*)(F.lds + AUX_TILEE); LAS int* idxl = (LAS int*)(F.lds + AUX_IDX);
    __syncthreads();
    for (int i = F.tid; i < 257; i += NTHREADS) tst[i] = (int)F.ctl[CW_TST + layer * 320 + i];
    __syncthreads();
    const int ntr = tst[256], nunits = (ntr + ntok / 256) * NCOL;
    int nu = c < nunits ? (nunits - c + F.G - 1) / F.G : 0; if (nu > MOE_MAXU) nu = MOE_MAXU; if (want_idx && nu > MOE_MAXIDX) nu = MOE_MAXIDX;
    if (F.tid < nu) { const int rt = (c + F.tid * F.G) / NCOL; int e;
        if (rt >= ntr) e = NEXP; else { int lo = 0, hi = 255; while (lo < hi) { const int mid = (lo + hi + 1) >> 1; if (tst[mid] <= rt) lo = mid; else hi = mid - 1; } e = lo; }
        tileE[F.tid] = e; }
    if (want_idx) { const int* stok = (const int*)(F.ws + M_ST); for (int i = F.tid; i < nu * 256; i += NTHREADS) idxl[i] = stok[(size_t)((c + (i >> 8) * F.G) / NCOL) * 256 + (i & 255)]; }
    __syncthreads();
    return nu;
}
struct SchedMoeGU {
    const char* A; const char* W; const LAS int* tileE; const LAS int* idxl; int nu, G, c;
    __device__ __forceinline__ bool next(int i, Unit& u) const {
        if (i >= nu) return false; const int un = c + i * G; const int rt = un >> 1, col = un & 1; const int e = tileE[i];
        u.a = i; u.b = e * 512 + col * 256; u.orow = rt * 256; u.ocol = col * 128; u.aux = e; return true; }
    __device__ __forceinline__ const char* a_base() const { return A; }
    __device__ __forceinline__ const char* b_ptr(const Unit& u) const { return W + (size_t)u.b * D * 2; }
    __device__ __forceinline__ void a_off(const Unit& u, const int (&R)[2], const int (&C)[2], unsigned (&o0)[2], unsigned (&o1)[2]) const {
#pragma unroll
        for (int i = 0; i < 2; ++i) { const int t0 = idxl[u.a * 256 + R[i]], t1 = idxl[u.a * 256 + 128 + R[i]]; o0[i] = (unsigned)t0 * (unsigned)(D * 2) + (unsigned)C[i] * 2u; o1[i] = (unsigned)t1 * (unsigned)(D * 2) + (unsigned)C[i] * 2u; }
    }
};
struct EpiGateUp {
    static constexpr bool PERM = true, AFTER_DRAIN = false;
    bf16_t* hid;
    __device__ __forceinline__ void operator()(const f32x4 (&acc)[2][2][4][2], const Unit& u, int wr, int wc, int fr, int fq) const {
        const int lane = fr + 16 * fq; const int srcb = ((lane >> 2) + 16 * (lane & 3)) << 2;
        const int row0 = u.orow + wr * 64 + (lane >> 2), col0 = u.ocol + wc * 32 + 8 * (lane & 3);
#pragma unroll
        for (int ai = 0; ai < 2; ++ai)
#pragma unroll
            for (int m = 0; m < 4; ++m) { float h[8];
#pragma unroll
                for (int n = 0; n < 2; ++n)
#pragma unroll
                    for (int e = 0; e < 4; ++e) { const float g = acc[ai][0][m][n][e], up = acc[ai][1][m][n][e]; h[4 * n + e] = g / (1.0f + __expf(-g)) * up; }
                u32x4 w; w.x = cvt_pk_bf16(h[0], h[1]); w.y = cvt_pk_bf16(h[2], h[3]); w.z = cvt_pk_bf16(h[4], h[5]); w.w = cvt_pk_bf16(h[6], h[7]);
                u32x4 t; t.x = (unsigned)__builtin_amdgcn_ds_bpermute(srcb, (int)w.x); t.y = (unsigned)__builtin_amdgcn_ds_bpermute(srcb, (int)w.y); t.z = (unsigned)__builtin_amdgcn_ds_bpermute(srcb, (int)w.z); t.w = (unsigned)__builtin_amdgcn_ds_bpermute(srcb, (int)w.w);
                *(u32x4*)(hid + (size_t)(row0 + ai * 128 + m * 16) * DEXP + col0) = t; }
    }
};
struct SchedMoeDN {
    const char* A; const char* W; const LAS int* tileE; int nu, G, c;
    __device__ __forceinline__ bool next(int i, Unit& u) const {
        if (i >= nu) return false; const int un = c + i * G; const int rt = un >> 2, col = un & 3; const int e = tileE[i];
        u.a = rt; u.b = e * 1024 + col * 256; u.orow = rt * 256; u.ocol = col * 256; u.aux = e; return true; }
    __device__ __forceinline__ const char* a_base() const { return A; }
    __device__ __forceinline__ const char* b_ptr(const Unit& u) const { return W + (size_t)u.b * DEXP * 2; }
    __device__ __forceinline__ void a_off(const Unit& u, const int (&R)[2], const int (&C)[2], unsigned (&o0)[2], unsigned (&o1)[2]) const {
#pragma unroll
        for (int i = 0; i < 2; ++i) { o0[i] = (unsigned)((u.a * 256 + R[i]) * DEXP + C[i]) * 2u; o1[i] = o0[i] + (unsigned)(128 * DEXP * 2); }
    }
};

constexpr int NA_RING = 9, NA_KR = 0, NA_VR = NA_RING * 64 * 128, NA_RPB = 2 * NA_RING * 64 * 128, NA_END = NA_RPB + 15 * 128;
constexpr int NA_KC = 0, NA_VC = 256 * 128;
static_assert(NA_END <= MISC_OFF, "na lds");
typedef short s16x4 __attribute__((ext_vector_type(4)));
__device__ __forceinline__ int na_voff(int row, int ch) { return row * 128 + ((((ch >> 1) ^ ((row >> 1) & 3)) << 5) | ((ch & 1) << 4)); }
__device__ __forceinline__ int na_koff(int row, int ch) { return row * 128 + ((ch ^ (row & 7)) << 4); }
template <bool CTX>
__device__ __forceinline__ void na_seg2(LAS unsigned char* L, const bf16x8 (&qf)[2], int r16, int g4, int r0, int band, const int (&boff)[2][4], int rbase,
                                        const int (&voff)[4], f32x4 (&O)[4], float& m_run, float& sum) {
    const float NINF = -__builtin_inff();
    float S[2][8][4]; float mx[2] = {NINF, NINF};
#pragma unroll
    for (int t = 0; t < 8; ++t) {
#pragma unroll
        for (int q = 0; q < 2; ++q) {
            f32x4 c = (f32x4){0.f, 0.f, 0.f, 0.f};
            int key, kbase;
            if (CTX) { key = 128 * q + 16 * t + r16; kbase = NA_KC; } else { key = ((r0 + ((8 * q + t) >> 1)) % NA_RING) * 64 + band + 16 * (t & 1) + r16; kbase = NA_KR; }
            const bf16x8 k0 = *(const LAS bf16x8*)(L + kbase + na_koff(key, g4)), k1 = *(const LAS bf16x8*)(L + kbase + na_koff(key, 4 + g4));
            c = __builtin_amdgcn_mfma_f32_16x16x32_bf16(k0, qf[0], c, 0, 0, 0); c = __builtin_amdgcn_mfma_f32_16x16x32_bf16(k1, qf[1], c, 0, 0, 0);
            if (CTX) {
#pragma unroll
                for (int e = 0; e < 4; ++e) S[q][t][e] = c[e];
            } else {
#pragma unroll
                for (int e = 0; e < 4; ++e) S[q][t][e] = c[e] + *(const LAS float*)(L + rbase + ((8 * q + t) >> 1) * 128 + boff[t & 1][e]);
            }
            mx[q] = fmaxf(mx[q], fmaxf(fmaxf(S[q][t][0], S[q][t][1]), fmaxf(S[q][t][2], S[q][t][3])));
        }
    }
    float ps[2]; f32x4 Oq[2][4];
#pragma unroll
    for (int q = 0; q < 2; ++q) { mx[q] = fmaxf(mx[q], __shfl_xor(mx[q], 16)); mx[q] = fmaxf(mx[q], __shfl_xor(mx[q], 32)); }
#pragma unroll
    for (int q = 0; q < 2; ++q) { float s = 0.f;
#pragma unroll
        for (int t = 0; t < 8; ++t)
#pragma unroll
            for (int e = 0; e < 4; ++e) { const float p = __builtin_amdgcn_exp2f(S[q][t][e] - mx[q]); S[q][t][e] = p; s += p; }
        ps[q] = s;
#pragma unroll
        for (int mt = 0; mt < 4; ++mt) Oq[q][mt] = (f32x4){0.f, 0.f, 0.f, 0.f}; }
#pragma unroll
    for (int q = 0; q < 2; ++q) { ps[q] += __shfl_xor(ps[q], 16); ps[q] += __shfl_xor(ps[q], 32); }
#pragma unroll
    for (int j = 0; j < 4; ++j) {
#pragma unroll
        for (int q = 0; q < 2; ++q) {
            bf16x8 pb; { const u32x4 ww = (u32x4){cvt_pk_bf16(S[q][2 * j][0], S[q][2 * j][1]), cvt_pk_bf16(S[q][2 * j][2], S[q][2 * j][3]), cvt_pk_bf16(S[q][2 * j + 1][0], S[q][2 * j + 1][1]), cvt_pk_bf16(S[q][2 * j + 1][2], S[q][2 * j + 1][3])}; pb = __builtin_bit_cast(bf16x8, ww); }
            int ub;
            if (CTX) ub = NA_VC + (128 * q + 32 * j) * 128; else ub = NA_VR + (((r0 + 4 * q + j) % NA_RING) * 64 + band) * 128;
#pragma unroll
            for (int mt = 0; mt < 4; ++mt) {
                const s16x4 a0 = __builtin_amdgcn_ds_read_tr16_b64_v4i16((LAS s16x4*)(L + ub + voff[mt]));
                const s16x4 a1 = __builtin_amdgcn_ds_read_tr16_b64_v4i16((LAS s16x4*)(L + ub + voff[mt] + 16 * 128));
                const bf16x8 av = (bf16x8){a0[0], a0[1], a0[2], a0[3], a1[0], a1[1], a1[2], a1[3]};
                Oq[q][mt] = __builtin_amdgcn_mfma_f32_16x16x32_bf16(av, pb, Oq[q][mt], 0, 0, 0);
            }
        }
    }
    const float m_new = fmaxf(m_run, fmaxf(mx[0], mx[1]));
    const float a_run = __builtin_amdgcn_exp2f(m_run - m_new), a0 = __builtin_amdgcn_exp2f(mx[0] - m_new), a1 = __builtin_amdgcn_exp2f(mx[1] - m_new);
    m_run = m_new; sum = sum * a_run + ps[0] * a0 + ps[1] * a1;
#pragma unroll
    for (int mt = 0; mt < 4; ++mt) O[mt] = O[mt] * a_run + Oq[0][mt] * a0 + Oq[1][mt] * a1;
}
__device__ __forceinline__ void na_phase(const Frame& F, const Args& a) {
    LAS unsigned char* L = F.lds; const int lane = F.lane, w = F.wave, r16 = lane & 15, g4 = lane >> 4;
    const bf16_t* qbuf = (const bf16_t*)(F.ws + T_QKV); const bf16_t* kbuf = qbuf + (size_t)NT * D; const bf16_t* vbuf = kbuf + (size_t)NT * D; bf16_t* cat = (bf16_t*)(F.ws + T_CAT);
    f32x2* mlbuf = (f32x2*)(F.ws + T_Y);
    const int rr = w >> 2, cb = w & 3; const int band = cb == 0 ? 0 : (cb == 1 ? 8 : (cb == 2 ? 24 : 32));
    const float NINF = -__builtin_inff();
    const int pkey = F.tid >> 3, pch = F.tid & 7;
    int boff[2][4], voff[4];
    { const int qc = 16 * cb + r16; int cs = qc - 8; cs = cs < 0 ? 0 : (cs > 48 ? 48 : cs);
#pragma unroll
      for (int hc = 0; hc < 2; ++hc)
#pragma unroll
          for (int e = 0; e < 4; ++e) { const int kc = band + 16 * hc + 4 * g4 + e; const bool ok = kc >= cs && kc < cs + 16; boff[hc][e] = (ok ? kc - qc + 15 : 31) * 4; }
      const int rl = 4 * g4 + (r16 >> 2), sw = (rl >> 1) & 3;
#pragma unroll
      for (int mt = 0; mt < 4; ++mt) voff[mt] = rl * 128 + ((mt ^ sw) << 5) + 8 * (r16 & 3); }
    for (int bh = blockIdx.x; bh < BATCH * NA_H; bh += F.G) {
        const int b = bh >> 4, h = bh & 15;
        __syncthreads();
        for (int i = F.tid; i < 256 * 8; i += NTHREADS) { const int key = i >> 3, ch = i & 7; const size_t g = (size_t)(NX + b * CTXL + key) * D + h * 64 + ch * 8;
            *(LAS u32x4*)(L + NA_VC + na_voff(key, ch)) = *(const u32x4*)(vbuf + g); *(LAS u32x4*)(L + NA_KC + na_koff(key, ch)) = *(const u32x4*)(kbuf + g); }
        __syncthreads();
        {
            bf16x8 qn[2];
            { const bf16_t* q0 = qbuf + (size_t)(b * SEQ + rr * 64 + 16 * cb + r16) * D + h * 64 + 8 * g4; qn[0] = *(const bf16x8*)q0; qn[1] = *(const bf16x8*)(q0 + 32); }
            for (int rp = 0; rp < 16; ++rp) {
                const int r = 2 * rp + rr; const int qrow = b * SEQ + r * 64 + 16 * cb + r16;
                bf16x8 qf[2]; qf[0] = qn[0]; qf[1] = qn[1];
                if (rp < 15) { const bf16_t* q1 = qbuf + (size_t)(qrow + 128) * D + h * 64 + 8 * g4; qn[0] = *(const bf16x8*)q1; qn[1] = *(const bf16x8*)(q1 + 32); }
                f32x4 O[4]; float m_run = NINF, sum = 0.f;
#pragma unroll
                for (int mt = 0; mt < 4; ++mt) O[mt] = (f32x4){0.f, 0.f, 0.f, 0.f};
                na_seg2<true>(L, qf, r16, g4, 0, band, boff, 0, voff, O, m_run, sum);
#pragma unroll
                for (int mt = 0; mt < 4; ++mt) { u32x2 o; o.x = pk2(O[mt][0], O[mt][1]); o.y = pk2(O[mt][2], O[mt][3]); *(u32x2*)(cat + (size_t)qrow * D + h * 64 + 16 * mt + 4 * g4) = o; }
                if (g4 == 0) mlbuf[(size_t)qrow * 16 + h] = (f32x2){m_run, sum};
            }
        }
        __syncthreads();
        asm volatile("s_waitcnt vmcnt(0)" ::: "memory");
        for (int i = F.tid; i < 15 * 32; i += NTHREADS) { const int ri = i >> 5, ci = i & 31; ((LAS float*)(L + NA_RPB))[i] = ci < 31 ? a.in[23][h * 465 + ri * 31 + ci] * 1.4426950408889634f : NINF; }
        for (int gr = 0; gr < 9; ++gr) { const size_t g = (size_t)(b * SEQ + gr * 64 + pkey) * D + h * 64 + pch * 8;
            *(LAS u32x4*)(L + NA_VR + na_voff(gr * 64 + pkey, pch)) = *(const u32x4*)(vbuf + g); *(LAS u32x4*)(L + NA_KR + na_koff(gr * 64 + pkey, pch)) = *(const u32x4*)(kbuf + g); }
        for (int rp = 0; rp < 16; ++rp) {
            int R0 = 2 * rp - 4; R0 = R0 < 0 ? 0 : (R0 > 24 ? 24 : R0);
            int R0n = 2 * rp - 2; R0n = R0n < 0 ? 0 : (R0n > 24 ? 24 : R0n);
            const bool newrows = (rp < 15) && (R0n != R0);
            u32x4 nv0 = (u32x4){0u, 0u, 0u, 0u}, nv1 = nv0, nk0 = nv0, nk1 = nv0;
            if (newrows) { const size_t g0 = (size_t)(b * SEQ + (R0 + 9) * 64 + pkey) * D + h * 64 + pch * 8; nv0 = *(const u32x4*)(vbuf + g0); nk0 = *(const u32x4*)(kbuf + g0);
                if (R0 + 10 < 32) { const size_t g1 = g0 + (size_t)64 * D; nv1 = *(const u32x4*)(vbuf + g1); nk1 = *(const u32x4*)(kbuf + g1); } }
            const int r = 2 * rp + rr; int r0 = r - 4; r0 = r0 < 0 ? 0 : (r0 > 24 ? 24 : r0);
            const int qrow = b * SEQ + r * 64 + 16 * cb + r16;
            bf16x8 qf[2];
#pragma unroll
            for (int ks = 0; ks < 2; ++ks) qf[ks] = *(const bf16x8*)(qbuf + (size_t)qrow * D + h * 64 + 32 * ks + 8 * g4);
            f32x4 O[4]; float m_run, sum;
#pragma unroll
            for (int mt = 0; mt < 4; ++mt) { const u32x2 o = *(const u32x2*)(cat + (size_t)qrow * D + h * 64 + 16 * mt + 4 * g4); O[mt] = (f32x4){bflo(o.x), bfhi(o.x), bflo(o.y), bfhi(o.y)}; }
            { const f32x2 ml = mlbuf[(size_t)qrow * 16 + h]; m_run = ml.x; sum = ml.y; }
            lds_barrier();
            const int rbase = NA_RPB + (r0 - r + 7) * 128;
            na_seg2<false>(L, qf, r16, g4, r0, band, boff, rbase, voff, O, m_run, sum);
            const float inv = 1.0f / sum;
#pragma unroll
            for (int mt = 0; mt < 4; ++mt) { u32x2 o; o.x = pk2(O[mt][0] * inv, O[mt][1] * inv); o.y = pk2(O[mt][2] * inv, O[mt][3] * inv);
                *(u32x2*)(cat + (size_t)qrow * D + h * 64 + 16 * mt + 4 * g4) = o; }
            if (newrows) {
                lds_barrier();
                *(LAS u32x4*)(L + NA_VR + na_voff(((R0 + 9) % NA_RING) * 64 + pkey, pch)) = nv0; *(LAS u32x4*)(L + NA_KR + na_koff(((R0 + 9) % NA_RING) * 64 + pkey, pch)) = nk0;
                *(LAS u32x4*)(L + NA_VR + na_voff(((R0 + 10) % NA_RING) * 64 + pkey, pch)) = nv1; *(LAS u32x4*)(L + NA_KR + na_koff(((R0 + 10) % NA_RING) * 64 + pkey, pch)) = nk1; }
        }
    }
    __syncthreads();
}

#if MK_ONE_LAUNCH
#define GRID_BAR() xcd_barrier(bar)
#else
#define GRID_BAR() do { } while (0)
#endif
#define IN(k) (lo <= (k) && (k) < hi && (k) <= MK_LAST_PHASE)
#define SEAM(k) do { if (IN(k) && IN((k) + 1)) GRID_BAR(); } while (0)
template <int LAYER>
__device__ __forceinline__ void layer_tail(const Frame& F, const Args& args, const int lo, const int hi, const XcdBarrier& bar) {
    unsigned char* ws = args.ws;
    const float* modx = (const float*)(ws + WS_MODX); const float* modc = (const float*)(ws + WS_MODC);
    float* xw = (float*)(ws + WS_XW); float* xwc = (float*)(ws + WS_XW + (size_t)NX * D * 2); bf16_t* Hb = (bf16_t*)(ws + WS_H);
    constexpr int mb = LAYER ? 16 : 7; constexpr int ntok = LAYER ? NX : NT;
    const float* lmodx = modx + (size_t)LAYER * 16 * ADA; const float* lmodc = modc + (size_t)LAYER * ADA;
    if (IN(LAYER ? 14 : 5)) REPEAT_IF(LAYER ? 14 : 5) { REP_BAR();
        SchedDense S{(const char*)(ws + T_CAT), (const char*)(ws + (LAYER ? WS_WOUT1 : WS_WOUT0)), D, ntok / 256, D / 256, 0, 1, 0, F.G, (int)blockIdx.x};
        EpiBf16 E{(bf16_t*)(ws + T_Y), D, 0, 0};
        pg8::gemm_phase<EpiBf16, SchedDense, true>(F.lds, D, S, E);
        if (LAYER == 0 && F.G == 256 && (int)blockIdx.x >= 64) cvt_moe_range(F, args, 0, F0_BULK + F0_P2, F0_BULK + F0_P2 + F0_P5, (int)blockIdx.x - 64, 192);
    }
    SEAM(LAYER ? 14 : 5);
    if (IN(LAYER ? 15 : 6)) REPEAT_IF(LAYER ? 15 : 6) { REP_BAR();
        RowPhase P{}; P.xin_lat = LAYER ? xw : args.in[0]; P.xin_ctx = LAYER ? xwc : args.in[2]; P.xin16 = LAYER != 0; P.xout_lat = xw; P.xout_ctx = xwc; P.xout16 = true; P.nrows = ntok; P.ysrc = 1; P.y = (const bf16_t*)(ws + T_Y);
        P.gpost = args.in[7] + LAYER * D; P.modx = lmodx; P.modc = lmodc; P.gate_chunk = 2;
        P.doH = true; P.H = Hb; P.gpre = args.in[8] + LAYER * D; P.sc_chunk = 4; P.sh_chunk = 3; P.modxH = lmodx; P.modcH = lmodc;
        row_phase(F, P);
    }
    SEAM(LAYER ? 15 : 6);
    if (IN(mb)) REPEAT_IF(mb) { REP_BAR();
        SchedDense S{(const char*)Hb, (const char*)(ws + WS_WR) + (size_t)LAYER * NEXP * D * 2, D, ntok / 256, 1, 0, 1, 0, F.G, (int)blockIdx.x};
        EpiRouter E{args.in[25] + LAYER * NEXP, (int*)(ws + M_AE), (int*)(ws + M_AR), (float*)(ws + M_AG), F.ctl + CW_CNT + LAYER * 256};
        pg8::gemm_phase<EpiRouter, SchedDense, false>(F.lds, D, S, E);
        if (F.G != 256) { } else if (LAYER == 0) { if ((int)blockIdx.x >= 144) cvt_moe_range(F, args, 0, F0_BULK + F0_P2 + F0_P5, MOE_CVT_ITEMS, (int)blockIdx.x - 144, 112); }
        else { if ((int)blockIdx.x >= 128) { const int ntr0 = (int)__hip_atomic_load(F.ctl + CW_TST + 256, __ATOMIC_RELAXED, __HIP_MEMORY_SCOPE_AGENT); int s9, s10; fill1_ranges(F, ntr0, s9, s10);
                cvt_moe_range(F, args, 1, s9 + s10, MOE_CVT_ITEMS - F1_P12, (int)blockIdx.x - 128, 128); } }
    }
    SEAM(mb);
    if (IN(mb + 1)) REPEAT_IF(mb + 1) { REP_BAR(); moe_place(F, LAYER, ntok); }
    SEAM(mb + 1);
    if (IN(mb + 2)) REPEAT_IF(mb + 2) { REP_BAR();
        const int nj = moe_units_setup<2>(F, LAYER, ntok, F.vcu, true);
        SchedMoeGU S{(const char*)Hb, (const char*)(ws + WS_WGU + (size_t)LAYER * WGU_BYTES), (const LAS int*)(F.lds + AUX_TILEE), (const LAS int*)(F.lds + AUX_IDX), nj, F.G, F.vcu};
        EpiGateUp E{(bf16_t*)(ws + M_HID)};
        pg8::gemm_phase<EpiGateUp, SchedMoeGU, true>(F.lds, D, S, E);
        if (LAYER == 0) { const int ntr0 = ((const LAS int*)(F.lds + AUX_TST))[256]; int s9, s10; fill1_ranges(F, ntr0, s9, s10); const int nu = (ntr0 + NT / 256) * 2, hv = nu % F.G;
            if (hv && F.vcu >= hv) cvt_moe_range(F, args, 1, 0, s9, F.vcu - hv, F.G - hv); }
    }
    SEAM(mb + 2);
    if (IN(mb + 3)) REPEAT_IF(mb + 3) { REP_BAR();
        const int nj = moe_units_setup<4>(F, LAYER, ntok, F.vcu, false);
        SchedMoeDN S{(const char*)(ws + M_HID), (const char*)(ws + WS_WDN + (size_t)LAYER * WDN_BYTES), (const LAS int*)(F.lds + AUX_TILEE), nj, F.G, F.vcu};
        EpiF8 E{(unsigned char*)(ws + M_OUT)};
        pg8::gemm_phase<EpiF8, SchedMoeDN, true>(F.lds, DEXP, S, E);
        if (LAYER == 0) { const int ntr0 = ((const LAS int*)(F.lds + AUX_TST))[256]; int s9, s10; fill1_ranges(F, ntr0, s9, s10); const int nu = (ntr0 + NT / 256) * 4, hv = nu % F.G;
            if (hv && F.vcu >= hv) cvt_moe_range(F, args, 1, s9, s9 + s10, F.vcu - hv, F.G - hv); }
    }
    SEAM(mb + 3);
    if (IN(mb + 4)) REPEAT_IF(mb + 4) { REP_BAR();
        RowPhase P{}; P.xin_lat = xw; P.xin_ctx = xwc; P.xin16 = true; P.xout_lat = LAYER ? args.out : xw; P.xout_ctx = xwc; P.xout16 = LAYER == 0; P.nrows = ntok; P.ysrc = 2;
        P.mo8 = (const unsigned char*)(ws + M_OUT); P.tslot = (const int*)(ws + M_TS); P.tgate = (const float*)(ws + M_AG); P.sharedbase = (int)__hip_atomic_load(F.ctl + CW_TST + LAYER * 320 + 256, __ATOMIC_RELAXED, __HIP_MEMORY_SCOPE_AGENT) * 256;
        P.gpost = args.in[9] + LAYER * D; P.modx = lmodx; P.modc = lmodc; P.gate_chunk = 5;
        P.doH = LAYER == 0; P.H = Hb; P.gpre = args.in[6] + D; P.sc_chunk = 1; P.sh_chunk = 0; P.modxH = modx + (size_t)16 * ADA; P.modcH = modc + ADA;
        row_phase(F, P);
        if (LAYER == 0) {
            const int ntr0 = (int)__hip_atomic_load(F.ctl + CW_TST + 256, __ATOMIC_RELAXED, __HIP_MEMORY_SCOPE_AGENT); int s9, s10; fill1_ranges(F, ntr0, s9, s10);
            if (F.G != 256) cvt_moe_range(F, args, 1, 0, MOE_CVT_ITEMS, F.vcu, F.G);
        }
    }
    SEAM(mb + 4);
}

__global__ void __launch_bounds__(NTHREADS, 2) mk_fwd(Args args) {
    extern __shared__ __attribute__((aligned(16))) unsigned char lds_raw[];
    Frame F;
    F.lds = (LAS unsigned char*)lds_raw; F.MISC = (volatile LAS unsigned*)(F.lds + MISC_OFF);
    F.tid = threadIdx.x; F.lane = F.tid & 63; F.wave = __builtin_amdgcn_readfirstlane(F.tid >> 6);
    F.G = gridDim.x; { const int bx = blockIdx.x; F.vcu = (F.G % 8 == 0) ? (bx % 8) * (F.G / 8) + bx / 8 : bx; }
    F.ws = args.ws; F.ctl = (unsigned*)(args.ws + WS_CTL);
    for (int u = F.tid; u < (LDS_BYTES - MISC_OFF) / 4; u += NTHREADS) ((LAS unsigned*)(F.lds + MISC_OFF))[u] = 0u;
    __syncthreads();
    XcdBarrier bar; bar.bar = F.ctl + CW_BAR; bar.x = 0; bar.st = nullptr;
#if MK_ONE_LAUNCH
    bar = xcd_barrier_post(F.ctl + CW_BAR, F.MISC + 8);
#endif
    const int lo = args.ph_lo, hi = args.ph_hi;
    unsigned char* ws = args.ws;
    const float* modx = (const float*)(ws + WS_MODX); const float* modc = (const float*)(ws + WS_MODC);
    float* xw = (float*)(ws + WS_XW); bf16_t* Hb = (bf16_t*)(ws + WS_H);

    if (IN(0)) REPEAT_IF(0) { REP_BAR(); p0_ada(F, args); p0_convert(F, args); }
    SEAM(0);
    {
        if (IN(1)) REPEAT_IF(1) { REP_BAR();
            RowPhase P{}; P.xin_lat = args.in[0]; P.xin_ctx = args.in[2]; P.nrows = NT; P.ysrc = 0; P.modx = modx; P.modc = modc;
            P.doH = true; P.H = Hb; P.gpre = args.in[6]; P.sc_chunk = 1; P.sh_chunk = 0; P.modxH = modx; P.modcH = modc;
            row_phase(F, P);
        }
        SEAM(1);
        if (IN(2)) REPEAT_IF(2) { REP_BAR();
            SchedDense S{(const char*)Hb, (const char*)(ws + WS_WIN0), D, NT / 256, AB_INP / 256, 0, 1, 0, F.G, (int)blockIdx.x};
            EpiInproj E{(bf16_t*)(ws + T_QB), (bf16_t*)(ws + T_KB), (bf16_t*)(ws + T_VB), (bf16_t*)(ws + T_GB), (bf16_t*)(ws + T_UB), (float*)(ws + T_LR), (const f32x2*)(ws + WS_ROPE)};
            pg8::gemm_phase<EpiInproj, SchedDense, true>(F.lds, D, S, E);
            if (F.G == 256 && (int)blockIdx.x >= 48) cvt_moe_range(F, args, 0, F0_BULK, F0_BULK + F0_P2, (int)blockIdx.x - 48, 208);
        }
        SEAM(2);
        if (IN(3)) REPEAT_IF(3) { REP_BAR(); gla_prep_phase(F, args); }
        if (IN(3) && IN(22)) GRID_BAR();
        if (IN(22)) REPEAT_IF(22) { REP_BAR(); gla_seq_phase(F, args); }
        if (IN(22) && IN(4)) GRID_BAR();
        if (IN(4)) REPEAT_IF(4) { REP_BAR(); finish_conv_phase(F, args); }
        SEAM(4);

    }
    layer_tail<0>(F, args, lo, hi, bar);
    {
        if (IN(12)) REPEAT_IF(12) { REP_BAR();
            SchedDense S{(const char*)Hb, (const char*)(ws + WS_WQKV1), D, NX / 256, 12, NC / 256, 8, 4, F.G, (int)blockIdx.x};
            EpiBf16 E{(bf16_t*)(ws + T_QKV), D, D, (size_t)NT * D, 0.125f * 1.4426950408889634f};
            pg8::gemm_phase<EpiBf16, SchedDense, true>(F.lds, D, S, E);
            if (F.G == 256 && (int)blockIdx.x >= 128) cvt_moe_range(F, args, 1, MOE_CVT_ITEMS - F1_P12, MOE_CVT_ITEMS, (int)blockIdx.x - 128, 128);
        }
        SEAM(12);
        if (IN(13)) REPEAT_IF(13) { REP_BAR(); na_phase(F, args); }
        SEAM(13);

    }
    layer_tail<1>(F, args, lo, hi, bar);

#undef IN
#undef SEAM
}

extern "C" void kernel_launch(void* const* d_in, const int* in_sizes, int n_in, void* d_out, int out_size, void* d_ws, size_t ws_size, hipStream_t stream) {
    static int grid = 0;
    if (grid == 0) {
        if (n_in != 32 || out_size != NX * D || ws_size < WS_END) { fprintf(stderr, "kernel_launch: unexpected problem (n_in %d, out %d, ws %zu < %zu)\n", n_in, out_size, ws_size, (size_t)WS_END); grid = -1; return; }
        int dev = 0, cus = 0, per_cu = 0;
        if (hipGetDevice(&dev) != hipSuccess || hipDeviceGetAttribute(&cus, hipDeviceAttributeMultiprocessorCount, dev) != hipSuccess) { grid = -1; return; }
        if (hipFuncSetAttribute((const void*)mk_fwd, hipFuncAttributeMaxDynamicSharedMemorySize, LDS_BYTES) != hipSuccess) { fprintf(stderr, "kernel_launch: hipFuncSetAttribute failed\n"); grid = -1; return; }
        if (hipOccupancyMaxActiveBlocksPerMultiprocessor(&per_cu, (const void*)mk_fwd, NTHREADS, LDS_BYTES) != hipSuccess || per_cu < 1) fprintf(stderr, "kernel_launch: occupancy query says %d\n", per_cu);
        (void)hipGetLastError();
        grid = cus;
    }
    if (grid < 0) return;
    (void)hipMemsetAsync((char*)d_ws + WS_CTL, 0, CTL_BYTES, stream);
    Args a{};
    for (int i = 0; i < 32; ++i) a.in[i] = (const float*)d_in[i];
    a.out = (float*)d_out; a.ws = (unsigned char*)d_ws;
#if MK_ONE_LAUNCH
    a.ph_lo = 0; a.ph_hi = 64;
    hipLaunchKernelGGL(mk_fwd, dim3(grid), dim3(NTHREADS), LDS_BYTES, stream, a);
#else
    for (int p = 0; p <= 20; ++p) { if (p > MK_LAST_PHASE) break; a.ph_lo = p; a.ph_hi = p + 1; hipLaunchKernelGGL(mk_fwd, dim3(grid), dim3(NTHREADS), LDS_BYTES, stream, a); }
#endif
}
```

```cpp
#include <hip/hip_runtime.h>
#include <cstdio>
#include <cstdint>

#ifndef MK_ONE_LAUNCH
#define MK_ONE_LAUNCH 1
#endif
#ifndef MK_LAST_PHASE
#define MK_LAST_PHASE 99
#endif

#ifndef MK_REP
#define MK_REP (-1)
#endif
#define REPEAT_IF(k) _Pragma("unroll") for (int _r = 0; _r < ((k) == MK_REP ? 2 : 1); ++_r)
#define REP_BAR() do { if (_r) GRID_BAR(); } while (0)

#define GAS __attribute__((address_space(1)))
#define LAS __attribute__((address_space(3)))
typedef unsigned short bf16_t;
typedef short bf16x8 __attribute__((ext_vector_type(8)));
typedef float f32x4 __attribute__((ext_vector_type(4)));
typedef float f32x2 __attribute__((ext_vector_type(2)));
typedef unsigned u32x4 __attribute__((ext_vector_type(4)));
typedef unsigned u32x2 __attribute__((ext_vector_type(2)));

constexpr int D = 1024, BATCH = 16, SEQ = 2048, CTXL = 256, GRIDW = 64;
constexpr int NX = BATCH * SEQ, NC = BATCH * CTXL, NT = NX + NC;
constexpr int ADA = 6 * D;
constexpr int GLA_H = 4, GLA_DK = 64, GLA_DV = 128, GLA_QK = 256, GLA_V = 512, CONV_CH = 512, CONV_W = 31;
constexpr int AB_IN = 2592, AB_INP = 2816;
constexpr int NA_H = 16, NA_DH = 64;
constexpr int NEXP = 256, TOPK = 8, DEXP = 256;
constexpr int NEXPS = NEXP + 1;
constexpr int PMAX = NT * TOPK + NEXP * 255 + NT;
static_assert(PMAX % 256 == 0, "PMAX");
constexpr float RMS_EPS = 1e-6f, LN_EPS = 1e-5f;
constexpr float F8_SCALE = 16.0f, F8_INV = 1.0f / 16.0f;

constexpr size_t MiB = 1u << 20;
constexpr size_t al(size_t x) { return (x + 4095) & ~(size_t)4095; }
constexpr size_t WS_CTL = 0, CTL_BYTES = 1 * MiB;
constexpr size_t WS_MODX = WS_CTL + CTL_BYTES;
constexpr size_t WS_MODC = WS_MODX + al((size_t)2 * 16 * ADA * 4);
constexpr size_t WS_ROPE = WS_MODC + al((size_t)2 * ADA * 4);
constexpr size_t WS_XW = WS_ROPE + al(64 * 16 * 8);
constexpr size_t M_LST = WS_XW + al((size_t)NT * D * 2);
constexpr int LCAP = NT;
static_assert(M_LST + (size_t)NEXP * LCAP * 4 <= WS_XW + al((size_t)NT * D * 4), "token lists");
constexpr size_t WS_H = WS_XW + al((size_t)NT * D * 4);
constexpr size_t WS_WIN0 = WS_H + al((size_t)NT * D * 2);
constexpr size_t WS_WOUT0 = WS_WIN0 + al((size_t)AB_INP * D * 2);
constexpr size_t WS_WQKV1 = WS_WOUT0 + al((size_t)D * D * 2);
constexpr size_t WS_WOUT1 = WS_WQKV1 + al((size_t)3 * D * D * 2);
constexpr size_t WS_WR = WS_WOUT1 + al((size_t)D * D * 2);
constexpr size_t WGU_BYTES = al((size_t)NEXPS * 512 * D * 2), WDN_BYTES = al((size_t)NEXPS * D * 256 * 2);
constexpr size_t WS_WGU = WS_WR + al((size_t)2 * NEXP * D * 2);
constexpr size_t WS_WDN = WS_WGU + 2 * WGU_BYTES;
constexpr size_t WS_T = WS_WDN + 2 * WDN_BYTES;
constexpr size_t T_QB = WS_T;
constexpr size_t T_KB = T_QB + al((size_t)NT * 256 * 2);
constexpr size_t T_VB = T_KB + al((size_t)NT * 256 * 2);
constexpr size_t T_GB = T_VB + al((size_t)NT * 512 * 2);
constexpr size_t T_UB = T_GB + al((size_t)NT * 512 * 2);
constexpr size_t T_LR = T_UB + al((size_t)NT * 512 * 2);
constexpr size_t T_OF = T_LR + al((size_t)NT * 32 * 4);
constexpr size_t T_OB = T_OF + al((size_t)NT * 512 * 2);
constexpr size_t T_CAT = T_OB + al((size_t)NT * 512 * 2);
constexpr size_t T_Y = T_CAT + al((size_t)NT * D * 2);
constexpr size_t T_GLA = T_Y + al((size_t)NT * D * 2);
constexpr int GI_A = 0, GI_QIN = 8192, GI_KOT = 16384, GI_VT = 24576, GI_DEC = 40960, GI_BYTES = 41216;
constexpr size_t T_END0 = T_GLA + al((size_t)BATCH * GLA_H * 2 * 36 * GI_BYTES + 1024);
constexpr size_t T_QKV = WS_T;
static_assert(T_QKV + (size_t)3 * NT * D * 2 <= T_CAT, "qkv overlay");
constexpr size_t M_AE = WS_T;
constexpr size_t M_AR = M_AE + al((size_t)NT * 8 * 4);
constexpr size_t M_AG = M_AR + al((size_t)NT * 8 * 4);
constexpr size_t M_TS = M_AG + al((size_t)NT * 8 * 4);
constexpr size_t M_ST = M_TS + al((size_t)NT * 8 * 4);
constexpr size_t M_HID = M_ST + al((size_t)PMAX * 4);
constexpr size_t M_OUT = M_HID + al((size_t)PMAX * 256 * 2);
constexpr int MO_LD = 1024;
constexpr size_t M_END = M_OUT + al((size_t)PMAX * D);
constexpr size_t WS_END = (M_END > T_END0 ? M_END : T_END0);
static_assert(WS_END <= (size_t)2040 * MiB, "workspace map must fit 2 GiB");

constexpr int CW_BAR = 4096;
constexpr int CW_CNT = 16384;
constexpr int CW_CUR = 16384 + 512;

constexpr int RING_BYTES = 131072;
constexpr int AUX_OFF = RING_BYTES, AUX_BYTES = 31744;
constexpr int MISC_OFF = AUX_OFF + AUX_BYTES;
constexpr int LDS_BYTES = MISC_OFF + 1024;
constexpr int NWAVES = 8, NTHREADS = 512;

#define LDS_WAIT() asm volatile("s_waitcnt lgkmcnt(0)" ::: "memory")
#define VM_WAIT() asm volatile("s_waitcnt vmcnt(0)" ::: "memory")

__device__ __forceinline__ unsigned f2bf(float f) { unsigned u = __builtin_bit_cast(unsigned, f); return (u + 0x7fffu + ((u >> 16) & 1u)) >> 16; }
__device__ __forceinline__ unsigned pk2(float lo, float hi) { return f2bf(lo) | (f2bf(hi) << 16); }
__device__ __forceinline__ float bf2f(unsigned short b) { return __builtin_bit_cast(float, (unsigned)b << 16); }
__device__ __forceinline__ float bflo(unsigned w) { return __builtin_bit_cast(float, w << 16); }
__device__ __forceinline__ float bfhi(unsigned w) { return __builtin_bit_cast(float, w & 0xffff0000u); }
__device__ __forceinline__ float wave_sum(float v) {
#pragma unroll
    for (int o = 1; o < 64; o <<= 1) v += __shfl_xor(v, o);
    return v;
}
__device__ __forceinline__ float sigmoidf_(float x) { return 1.0f / (1.0f + __expf(-x)); }
__device__ __forceinline__ float siluf_(float x) { return x / (1.0f + __expf(-x)); }

__device__ __forceinline__ void lds_barrier() { asm volatile("s_waitcnt lgkmcnt(0)" ::: "memory"); __builtin_amdgcn_s_barrier(); asm volatile("" ::: "memory"); }
#define XB_TMO      128
#define XB_XCNT(j)  (256  + 64 * (j))
#define XB_XSUB(j)  (1280 + 64 * (j))
#define XB_XGEN(j)  (2304 + 64 * (j))
#define XB_TOP      3328
#define XB_TOPGEN   3392
#define XCD_BAR_WORDS 3456
#define XB_SPIN_CAP (1u << 18)

__device__ __forceinline__ unsigned xb_ld(unsigned* p)              { return __hip_atomic_load(p, __ATOMIC_RELAXED, __HIP_MEMORY_SCOPE_AGENT); }
__device__ __forceinline__ unsigned xb_add(unsigned* p, unsigned v) { return __hip_atomic_fetch_add(p, v, __ATOMIC_RELAXED, __HIP_MEMORY_SCOPE_AGENT); }
__device__ __forceinline__ unsigned xb_xcc_id() { return (unsigned)__builtin_amdgcn_s_getreg((3 << 11) | 20) & 0xFu; }
#define XB_SPIN(cond, bar) do { unsigned _sp = 0; while (cond) { __builtin_amdgcn_s_sleep(1); \
    if ((++_sp & 255u) == 0u) { if (xb_ld(&(bar)[XB_TMO])) break; if (_sp > XB_SPIN_CAP) { atomicAdd(&(bar)[XB_TMO], 1u); break; } } } } while (0)

struct XcdBarrier { unsigned* bar; unsigned x; volatile LAS unsigned* st; };

__device__ __forceinline__ XcdBarrier xcd_barrier_post(unsigned* bar, volatile LAS unsigned* st) {
    XcdBarrier b; b.bar = bar; b.x = xb_xcc_id(); b.st = st;
    if (threadIdx.x == 0) (void)xb_add(&bar[XB_XCNT(b.x)], 1u);
    return b;
}
__device__ __forceinline__ void xcd_barrier_complete(unsigned* bar, unsigned x, unsigned& nloc, unsigned& nx) {
    const unsigned G = gridDim.x * gridDim.y * gridDim.z;
    unsigned sum, cnt, mine, sp = 0u;
    for (;;) {
        sum = 0u; cnt = 0u; mine = 0u;
#pragma unroll
        for (unsigned j = 0; j < 16; ++j) { const unsigned c = xb_ld(&bar[XB_XCNT(j)]); sum += c; cnt += (c > 0u) ? 1u : 0u; mine = (j == x) ? c : mine; }
        if (sum == G) break;
        __builtin_amdgcn_s_sleep(1);
        if ((++sp & 255u) == 0u) { if (xb_ld(&bar[XB_TMO])) break; if (sp > XB_SPIN_CAP) { atomicAdd(&bar[XB_TMO], 1u); break; } }
    }
    nloc = mine > 0u ? mine : 1u; nx = cnt > 0u ? cnt : 1u;
}
__device__ __forceinline__ void xcd_barrier(const XcdBarrier& b) {
    asm volatile("s_waitcnt vmcnt(0)" ::: "memory");
    __syncthreads();
    if (threadIdx.x == 0) {
        unsigned* bar = b.bar;
        __builtin_amdgcn_s_waitcnt(0);
        unsigned nloc = b.st[0], nx = b.st[1];
        if (nloc == 0u) { xcd_barrier_complete(bar, b.x, nloc, nx); b.st[0] = nloc; b.st[1] = nx; }
        const unsigned old = xb_add(&bar[XB_XSUB(b.x)], 1u);
        const unsigned gen = old / nloc;
        if (old + 1u == (gen + 1u) * nloc) {
            __builtin_amdgcn_fence(__ATOMIC_RELEASE, "agent");
            asm volatile("s_waitcnt vmcnt(0)" ::: "memory");
            const unsigned og = xb_add(&bar[XB_TOP], 1u);
            const unsigned tg = og / nx;
            if (og + 1u == (tg + 1u) * nx) xb_add(&bar[XB_TOPGEN], 1u);
            else XB_SPIN(xb_ld(&bar[XB_TOPGEN]) == tg, bar);
            __builtin_amdgcn_fence(__ATOMIC_ACQUIRE, "agent");
            xb_add(&bar[XB_XGEN(b.x)], 1u);
            asm volatile("s_waitcnt vmcnt(0)" ::: "memory");
        } else {
            XB_SPIN(xb_ld(&bar[XB_XGEN(b.x)]) == gen, bar);
            __builtin_amdgcn_fence(__ATOMIC_ACQUIRE, "agent");
            asm volatile("s_waitcnt vmcnt(0)" ::: "memory");
        }
    }
    __syncthreads();
}

namespace pg8 {
constexpr int BM = 256, BK = 64, HALF = 128, HTB = HALF * BK * 2, STAGE_BYTES = 8 * HTB, NXCD = 8, WGM = 8;
__host__ __device__ __forceinline__ int lds_byte(int r, int c) { const int st = (r >> 4) * 2 + (c >> 5), rr = r & 15, cc = c & 31, ob = rr * 64 + cc * 2; return st * 1024 + (ob ^ (((ob >> 9) & 1) << 5)); }
__host__ __device__ __forceinline__ void stage_rc(int b, int& R, int& C) { const int st = b / 1024, sb = b % 1024, swz = sb ^ (((sb >> 9) & 1) << 5); R = (st >> 1) * 16 + swz / 64; C = (st & 1) * 32 + (swz % 64) / 2; }
__host__ __device__ __forceinline__ int perm32(int rho) { const int n = rho >> 4, i = rho & 15; return 8 * (i >> 2) + 4 * n + (i & 3); }

struct Unit { int a, b, orow, ocol, aux; };

__device__ __forceinline__ bool static_order(int L, int nM, int nN, int& pm, int& pn) {
    const int nwg = nM * nN; if (L >= nwg) return false;
    int wgid = L; { const int q = nwg / NXCD, r = nwg % NXCD, xcd = wgid % NXCD, off = wgid / NXCD; wgid = (xcd < r ? xcd * (q + 1) : r * (q + 1) + (xcd - r) * q) + off; }
    const int nig = WGM * nN, gid = wgid / nig, fm = gid * WGM, gsz = (nM - fm) < WGM ? (nM - fm) : WGM;
    pm = fm + ((wgid % nig) % gsz); pn = (wgid % nig) / gsz; return true;
}

template <class Epi, class Sched, bool ALIGN_EPI>
__device__ __forceinline__ void gemm_phase(LAS unsigned char* lds, const int K, const Sched& S, const Epi& E) {
    const int tid = threadIdx.x, wid = __builtin_amdgcn_readfirstlane(tid >> 6), lane = tid & 63, wr = wid >> 2, wc = wid & 3, fr = lane & 15, fq = lane >> 4;
    const int nt = K / BK;
    int Rr[2], Cc[2]; unsigned voffB[2];
#pragma unroll
    for (int i = 0; i < 2; ++i) { int R, C; stage_rc(tid * 16 + i * 8192, R, C); Rr[i] = R; Cc[i] = C; const int Rb = Epi::PERM ? ((R & ~31) + perm32(R & 31)) : R; voffB[i] = (unsigned)(Rb * K + C) * 2u; }
    const size_t kstep = (size_t)(BK * 2);
    const size_t hstepB = (size_t)HALF * K * 2;
    const unsigned ldsw = (unsigned)wid * 1024u;
    const int aoff = lds_byte(wr * 64 + fr, fq * 8), boff = lds_byte(wc * 32 + fr, fq * 8);
#define PG8_SA(b, h) (((b) * 2 + (h)) * HTB)
#define PG8_SB(b, h) ((4 + (b) * 2 + (h)) * HTB)
#define PG8_STAGE(bufoff, gbase, voff) do { _Pragma("unroll") for (int _i = 0; _i < 2; ++_i) \
        __builtin_amdgcn_global_load_lds((const unsigned*)((const char*)(gbase) + (voff)[_i]), (LAS unsigned*)(lds + (bufoff) + ldsw + _i * 8192), 16, 0, 0); } while (0)
#define PG8_LDA(dst, b, h) do { _Pragma("unroll") for (int m = 0; m < 4; ++m) _Pragma("unroll") for (int k = 0; k < 2; ++k) dst[m][k] = *(const LAS bf16x8*)(lds + PG8_SA(b, h) + aoff + m * 2048 + k * 1024); } while (0)
#define PG8_LDB(dst, b, h) do { _Pragma("unroll") for (int n = 0; n < 2; ++n) _Pragma("unroll") for (int k = 0; k < 2; ++k) dst[n][k] = *(const LAS bf16x8*)(lds + PG8_SB(b, h) + boff + n * 2048 + k * 1024); } while (0)
#define PG8_MMA(ai, bj, At, Bt) do { __builtin_amdgcn_s_setprio(1); _Pragma("unroll") for (int m = 0; m < 4; ++m) _Pragma("unroll") for (int n = 0; n < 2; ++n) _Pragma("unroll") for (int k = 0; k < 2; ++k) \
        acc[ai][bj][m][n] = __builtin_amdgcn_mfma_f32_16x16x32_bf16(Bt[n][k], At[m][k], acc[ai][bj][m][n], 0, 0, 0); __builtin_amdgcn_s_setprio(0); } while (0)
#define PG8_WAIT_V(n) asm volatile("s_waitcnt vmcnt(" #n ")" ::: "memory")
#define PG8_WAIT_L(n) asm volatile("s_waitcnt lgkmcnt(" #n ")" ::: "memory")
#define PG8_BAR __builtin_amdgcn_s_barrier()
#define PG8_SCHED __builtin_amdgcn_sched_barrier(0)
    Unit cur, nxt; int ui = 0;
    if (!S.next(0, cur)) return;
    f32x4 acc[2][2][4][2];
#pragma unroll
    for (int a = 0; a < 2; ++a)
#pragma unroll
        for (int b = 0; b < 2; ++b)
#pragma unroll
            for (int m = 0; m < 4; ++m)
#pragma unroll
                for (int n = 0; n < 2; ++n) acc[a][b][m][n] = (f32x4){0.f, 0.f, 0.f, 0.f};
    bf16x8 At[4][2], B0[2][2], B1[2][2];
    unsigned co0[2], co1[2], no0[2], no1[2];
    S.a_off(cur, Rr, Cc, co0, co1);
    const char* const Ab = S.a_base();
    const char* cB = S.b_ptr(cur);
    PG8_STAGE(PG8_SB(0, 0), cB, voffB); PG8_STAGE(PG8_SB(0, 1), cB + hstepB, voffB); PG8_STAGE(PG8_SA(0, 0), Ab, co0); PG8_STAGE(PG8_SA(0, 1), Ab, co1);
    if (wr == 1) PG8_BAR;
    PG8_WAIT_V(2); PG8_BAR;
    PG8_STAGE(PG8_SB(1, 0), cB + kstep, voffB); PG8_STAGE(PG8_SA(1, 0), Ab + kstep, co0); PG8_STAGE(PG8_SB(1, 1), cB + hstepB + kstep, voffB);
    PG8_WAIT_V(6); PG8_BAR;
    for (;;) {
        const bool has_next = S.next(ui + 1, nxt);
        const char* nB = has_next ? S.b_ptr(nxt) : cB;
#pragma nounroll
        for (int t = 0; t < nt; t += 2) {
            const bool last = (t == nt - 2);
            if (last) { if (has_next) S.a_off(nxt, Rr, Cc, no0, no1); else { no0[0] = co0[0]; no0[1] = co0[1]; no1[0] = co1[0]; no1[1] = co1[1]; } }
            const char* a1 = Ab + (size_t)(t + 1) * kstep;
            const char* a2 = last ? Ab : Ab + (size_t)(t + 2) * kstep; const char* b2 = last ? nB : cB + (size_t)(t + 2) * kstep;
            const char* a3 = a2 + kstep; const char* b3 = b2 + kstep;
            unsigned x0[2], x1[2];
            x0[0] = last ? no0[0] : co0[0]; x0[1] = last ? no0[1] : co0[1]; x1[0] = last ? no1[0] : co1[0]; x1[1] = last ? no1[1] : co1[1];
            PG8_LDB(B0, 0, 0); PG8_LDB(B1, 0, 1); PG8_SCHED; PG8_LDA(At, 0, 0); PG8_STAGE(PG8_SA(1, 1), a1, co1);
            PG8_WAIT_V(8); PG8_WAIT_L(0); PG8_BAR; PG8_MMA(0, 0, At, B0); PG8_MMA(0, 1, At, B1); PG8_BAR; PG8_SCHED;
            PG8_LDA(At, 0, 1); PG8_STAGE(PG8_SB(0, 0), b2, voffB); PG8_STAGE(PG8_SB(0, 1), b2 + hstepB, voffB); PG8_STAGE(PG8_SA(0, 0), a2, x0);
            PG8_WAIT_V(8); PG8_WAIT_L(0); PG8_BAR; PG8_MMA(1, 0, At, B0); PG8_MMA(1, 1, At, B1); PG8_BAR; PG8_SCHED;
            PG8_LDB(B0, 1, 0); PG8_LDB(B1, 1, 1); PG8_SCHED; PG8_LDA(At, 1, 0); PG8_STAGE(PG8_SA(0, 1), a2, x1);
            PG8_WAIT_V(8); PG8_WAIT_L(0); PG8_BAR; PG8_MMA(0, 0, At, B0); PG8_MMA(0, 1, At, B1); PG8_BAR; PG8_SCHED;
            PG8_LDA(At, 1, 1); PG8_STAGE(PG8_SB(1, 0), b3, voffB); PG8_STAGE(PG8_SB(1, 1), b3 + hstepB, voffB); PG8_STAGE(PG8_SA(1, 0), a3, x0);
            PG8_WAIT_V(8); PG8_WAIT_L(0); PG8_BAR; PG8_MMA(1, 0, At, B0); PG8_MMA(1, 1, At, B1); PG8_BAR; PG8_SCHED;
        }
        if constexpr (ALIGN_EPI) { if (wr == 0) PG8_BAR; }
        if constexpr (!Epi::AFTER_DRAIN) { E(acc, cur, wr, wc, fr, fq); }
        if (!has_next) break;
#pragma unroll
        for (int a = 0; a < 2; ++a)
#pragma unroll
            for (int b = 0; b < 2; ++b)
#pragma unroll
                for (int m = 0; m < 4; ++m)
#pragma unroll
                    for (int n = 0; n < 2; ++n) acc[a][b][m][n] = (f32x4){0.f, 0.f, 0.f, 0.f};
        cur = nxt; cB = nB; co0[0] = no0[0]; co0[1] = no0[1]; co1[0] = no1[0]; co1[1] = no1[1]; ++ui;
        if constexpr (ALIGN_EPI) { if (wr == 1) PG8_BAR; }
    }
    PG8_WAIT_V(0);
    if constexpr (!ALIGN_EPI) { if (wr == 0) PG8_BAR; }
    PG8_BAR;
    if constexpr (Epi::AFTER_DRAIN) { E.fused(acc, cur, wr, wc, fr, fq, lds, wid, lane); }
#undef PG8_SA
#undef PG8_SB
#undef PG8_STAGE
#undef PG8_LDA
#undef PG8_LDB
#undef PG8_MMA
#undef PG8_WAIT_V
#undef PG8_WAIT_L
#undef PG8_BAR
#undef PG8_SCHED
}
}
using pg8::Unit;

__device__ __forceinline__ unsigned cvt_pk_bf16(float lo, float hi) { unsigned r; asm volatile("v_cvt_pk_bf16_f32 %0, %1, %2" : "=v"(r) : "v"(lo), "v"(hi)); return r; }

struct SchedDense {
    const char* A; const char* Bt; int K; int nM0, nN0, nM1, nN1, pn1off; int G, c;
    __device__ __forceinline__ bool next(int i, Unit& u) const {
        const int L = i * G + c; int pm, pn;
        const int n0 = nM0 * nN0;
        if (L < n0) { pg8::static_order(L, nM0, nN0, pm, pn); }
        else { if (!pg8::static_order(L - n0, nM1, nN1, pm, pn)) return false; pm += nM0; pn += pn1off; }
        u.a = pm; u.b = pn * 256; u.orow = pm * 256; u.ocol = pn * 256; u.aux = pn; return true;
    }
    __device__ __forceinline__ const char* a_base() const { return A; }
    __device__ __forceinline__ const char* b_ptr(const Unit& u) const { return Bt + (size_t)u.b * K * 2; }
    __device__ __forceinline__ void a_off(const Unit& u, const int (&R)[2], const int (&C)[2], unsigned (&o0)[2], unsigned (&o1)[2]) const {
#pragma unroll
        for (int i = 0; i < 2; ++i) { o0[i] = (unsigned)((u.a * 256 + R[i]) * K + C[i]) * 2u; o1[i] = o0[i] + (unsigned)(128 * K * 2); }
    }
};

struct EpiBf16 {
    static constexpr bool PERM = true, AFTER_DRAIN = false;
    bf16_t* O; int ldc; int split_cols; size_t split_stride; float scale0 = 1.0f;
    __device__ __forceinline__ void operator()(const f32x4 (&acc)[2][2][4][2], const Unit& u, int wr, int wc, int fr, int fq) const {
        const int lane = fr + 16 * fq; const int srcb = ((lane >> 2) + 16 * (lane & 3)) << 2;
        const int row0 = u.orow + wr * 64 + (lane >> 2); int colt = u.ocol; bf16_t* base = O;
        float sc = 1.0f;
        if (split_cols) { const int t = colt / split_cols; base += (size_t)t * split_stride; colt -= t * split_cols; if (t == 0) sc = scale0; }
        const int col0 = colt + wc * 32 + 8 * (lane & 3);
#pragma unroll
        for (int ai = 0; ai < 2; ++ai)
#pragma unroll
            for (int m = 0; m < 4; ++m) { bf16_t* rowp = base + (size_t)(row0 + ai * 128 + m * 16) * ldc + col0;
#pragma unroll
                for (int bj = 0; bj < 2; ++bj) { const f32x4 v0 = acc[ai][bj][m][0] * sc, v1 = acc[ai][bj][m][1] * sc;
                    u32x4 w; w.x = cvt_pk_bf16(v0[0], v0[1]); w.y = cvt_pk_bf16(v0[2], v0[3]); w.z = cvt_pk_bf16(v1[0], v1[1]); w.w = cvt_pk_bf16(v1[2], v1[3]);
                    u32x4 t; t.x = (unsigned)__builtin_amdgcn_ds_bpermute(srcb, (int)w.x); t.y = (unsigned)__builtin_amdgcn_ds_bpermute(srcb, (int)w.y); t.z = (unsigned)__builtin_amdgcn_ds_bpermute(srcb, (int)w.z); t.w = (unsigned)__builtin_amdgcn_ds_bpermute(srcb, (int)w.w);
                    *(u32x4*)(rowp + bj * 128) = t; } }
    }
};
struct EpiF8 {
    static constexpr bool PERM = true, AFTER_DRAIN = false;
    unsigned char* O;
    __device__ __forceinline__ int nst(const Unit&, int) const { return 16; }
    __device__ __forceinline__ void operator()(const f32x4 (&acc)[2][2][4][2], const Unit& u, int wr, int wc, int fr, int fq) const {
        const int lane = fr + 16 * fq; const int srcb = ((lane >> 2) + 16 * (lane & 3)) << 2;
        const int row0 = u.orow + wr * 64 + (lane >> 2), col0 = u.ocol + wc * 32 + 8 * (lane & 3);
#pragma unroll
        for (int ai = 0; ai < 2; ++ai)
#pragma unroll
            for (int m = 0; m < 4; ++m) { unsigned char* rowp = O + (size_t)(row0 + ai * 128 + m * 16) * D + col0;
#pragma unroll
                for (int bj = 0; bj < 2; ++bj) { const f32x4 v0 = acc[ai][bj][m][0] * F8_SCALE, v1 = acc[ai][bj][m][1] * F8_SCALE;
                    int w0 = __builtin_amdgcn_cvt_pk_fp8_f32(v0[0], v0[1], 0, false); w0 = __builtin_amdgcn_cvt_pk_fp8_f32(v0[2], v0[3], w0, true);
                    int w1 = __builtin_amdgcn_cvt_pk_fp8_f32(v1[0], v1[1], 0, false); w1 = __builtin_amdgcn_cvt_pk_fp8_f32(v1[2], v1[3], w1, true);
                    u32x2 t; t.x = (unsigned)__builtin_amdgcn_ds_bpermute(srcb, w0); t.y = (unsigned)__builtin_amdgcn_ds_bpermute(srcb, w1);
                    *(u32x2*)(rowp + bj * 128) = t; } }
    }
};
struct EpiInproj {
    static constexpr bool PERM = false, AFTER_DRAIN = false;
    bf16_t *qb, *kb, *vb, *gb, *ub; float* lr; const f32x2* rope;
    __device__ __forceinline__ void operator()(const f32x4 (&acc)[2][2][4][2], const Unit& u, int wr, int wc, int fr, int fq) const {
        const int pn = u.aux; const int row0 = u.orow + wr * 64 + fr;
        if (pn <= 1) {
            bf16_t* dst = pn == 0 ? qb : kb; const float sc = pn == 0 ? 0.125f : 1.0f;
#pragma unroll
            for (int ai = 0; ai < 2; ++ai)
#pragma unroll
                for (int m = 0; m < 4; ++m) {
                    const int row = row0 + ai * 128 + m * 16; const bool lat = row < NX;
                    const int s = row & (SEQ - 1); const int pos = (wc & 1) ? (s & 63) : (s >> 6);
                    f32x2 cs[4];
                    if (lat) {
#pragma unroll
                        for (int e = 0; e < 4; ++e) cs[e] = rope[pos * 16 + 4 * fq + e];
                    } else {
#pragma unroll
                        for (int e = 0; e < 4; ++e) cs[e] = (f32x2){1.f, 0.f};
                    }
#pragma unroll
                    for (int bj = 0; bj < 2; ++bj) {
                        const f32x4 u1 = acc[ai][bj][m][0], u2 = acc[ai][bj][m][1]; f32x4 o1, o2;
#pragma unroll
                        for (int e = 0; e < 4; ++e) { o1[e] = (u1[e] * cs[e].x - u2[e] * cs[e].y) * sc; o2[e] = (u1[e] * cs[e].y + u2[e] * cs[e].x) * sc; }
                        bf16_t* p = dst + (size_t)row * 256 + bj * 128 + wc * 32 + 4 * fq;
                        u32x2 w1, w2; w1.x = cvt_pk_bf16(o1[0], o1[1]); w1.y = cvt_pk_bf16(o1[2], o1[3]); w2.x = cvt_pk_bf16(o2[0], o2[1]); w2.y = cvt_pk_bf16(o2[2], o2[3]);
                        *(u32x2*)p = w1; *(u32x2*)(p + 16) = w2;
                    }
                }
        } else if (pn <= 5) {
            bf16_t* dst = pn <= 3 ? vb : gb; const int cb = (pn & 1) ? 256 : 0;
#pragma unroll
            for (int ai = 0; ai < 2; ++ai)
#pragma unroll
                for (int m = 0; m < 4; ++m) { const int row = row0 + ai * 128 + m * 16;
#pragma unroll
                    for (int bj = 0; bj < 2; ++bj)
#pragma unroll
                        for (int n = 0; n < 2; ++n) { const f32x4 v = acc[ai][bj][m][n]; u32x2 w; w.x = cvt_pk_bf16(v[0], v[1]); w.y = cvt_pk_bf16(v[2], v[3]);
                            *(u32x2*)(dst + (size_t)row * 512 + cb + bj * 128 + wc * 32 + n * 16 + 4 * fq) = w; } }
        } else if (pn <= 9) {
            const int cb = (pn - 6) * 128;
#pragma unroll
            for (int ai = 0; ai < 2; ++ai)
#pragma unroll
                for (int m = 0; m < 4; ++m) { const int row = row0 + ai * 128 + m * 16;
#pragma unroll
                    for (int n = 0; n < 2; ++n) { const f32x4 a = acc[ai][0][m][n], b = acc[ai][1][m][n]; f32x4 o;
#pragma unroll
                        for (int e = 0; e < 4; ++e) o[e] = a[e] * sigmoidf_(b[e]);
                        u32x2 w; w.x = cvt_pk_bf16(o[0], o[1]); w.y = cvt_pk_bf16(o[2], o[3]);
                        *(u32x2*)(ub + (size_t)row * 512 + cb + wc * 32 + n * 16 + 4 * fq) = w; } }
        } else {
            if (wc == 0) {
#pragma unroll
                for (int ai = 0; ai < 2; ++ai)
#pragma unroll
                    for (int m = 0; m < 4; ++m) { const int row = row0 + ai * 128 + m * 16;
#pragma unroll
                        for (int n = 0; n < 2; ++n) *(f32x4*)(lr + (size_t)row * 32 + n * 16 + 4 * fq) = acc[ai][0][m][n]; }
            }
        }
    }
};

struct Args { const float* in[32]; float* out; unsigned char* ws; int ph_lo, ph_hi; };

struct Frame {
    LAS unsigned char* lds; volatile LAS unsigned* MISC; unsigned* ctl; unsigned char* ws;
    int tid, lane, wave, G, vcu;
};

__device__ __forceinline__ void cvt_item(const float* __restrict__ src, int ld, int col0, int ncols, int k0, bf16_t* dst, int ldd, int drow0, LAS unsigned* T, int lane) {
    const bool okc = lane < ncols;
    const float* p = src + (size_t)k0 * ld + col0 + (okc ? lane : 0);
    float v[64];
#pragma unroll
    for (int k = 0; k < 64; ++k) v[k] = __builtin_nontemporal_load(p + (size_t)k * ld);
#pragma unroll
    for (int kp = 0; kp < 32; ++kp) T[lane * 33 + kp] = okc ? pk2(v[2 * kp], v[2 * kp + 1]) : 0u;
    LDS_WAIT(); asm volatile("" ::: "memory");
    const int c = lane & 7;
#pragma unroll
    for (int it = 0; it < 8; ++it) { const int n = (lane >> 3) + 8 * it;
        u32x4 o; o.x = T[n * 33 + 4 * c]; o.y = T[n * 33 + 4 * c + 1]; o.z = T[n * 33 + 4 * c + 2]; o.w = T[n * 33 + 4 * c + 3];
        if (n < ncols) __builtin_nontemporal_store(o, (u32x4*)(dst + (size_t)(drow0 + n) * ldd + k0 + 8 * c)); }
    LDS_WAIT(); asm volatile("" ::: "memory");
}
__device__ __forceinline__ void cvt_matrix_item(const float* src, int ld, int col0, int ncols, int K, bf16_t* dst, int drow0, int item, LAS unsigned* T, int lane) {
    const int ncg = (ncols + 63) >> 6; const int kt = item / ncg, cg = item - kt * ncg;
    const int nc = ncols - cg * 64 < 64 ? ncols - cg * 64 : 64;
    cvt_item(src, ld, col0 + cg * 64, nc, kt * 64, dst, K, drow0 + cg * 64, T, lane);
}

constexpr int MOE_CVT_ITEMS = NEXPS * 192;
__device__ __forceinline__ void cvt_moe_item(const Args& a, int layer, int item, unsigned char* ws, LAS unsigned* T, int lane) {
    const int e = item / 192, r = item - e * 192;
    bf16_t* wgu = (bf16_t*)(ws + WS_WGU + (size_t)layer * WGU_BYTES) + (size_t)e * 512 * D; bf16_t* wdn = (bf16_t*)(ws + WS_WDN + (size_t)layer * WDN_BYTES) + (size_t)e * D * 256;
    if (r < 128) {
        const int kt = r >> 3, gi = r & 7; const int up = gi >> 2, g4 = gi & 3;
        const float* src = e < NEXP ? (up ? a.in[27] : a.in[26]) + ((size_t)layer * NEXP + e) * D * DEXP : (up ? a.in[30] : a.in[29]) + (size_t)layer * D * DEXP;
        cvt_item(src, DEXP, 64 * g4, 64, kt * 64, wgu, D, 256 * (g4 >> 1) + 64 * (g4 & 1) + 128 * up, T, lane);
    } else {
        const int q = r - 128; const int kt = q >> 4, cg = q & 15;
        const float* src = e < NEXP ? a.in[28] + ((size_t)layer * NEXP + e) * DEXP * D : a.in[31] + (size_t)layer * DEXP * D;
        cvt_item(src, D, 64 * cg, 64, kt * 64, wdn, DEXP, 64 * cg, T, lane);
    }
}

__device__ __forceinline__ float row_rms_scale(const f32x4 (&v)[4]) {
    float s = 0.f;
#pragma unroll
    for (int j = 0; j < 4; ++j) s += (v[j].x * v[j].x + v[j].y * v[j].y) + (v[j].z * v[j].z + v[j].w * v[j].w);
    return rsqrtf(wave_sum(s) * (1.0f / D) + RMS_EPS);
}
__device__ __forceinline__ f32x4 ld4(const float* p) { return *(const f32x4*)p; }

struct RowPhase {
    const float* xin_lat; const float* xin_ctx;
    float* xout_lat; float* xout_ctx;
    bool xin16, xout16;
    int nrows;
    int ysrc; const bf16_t* y;
    const unsigned char* mo8; const int* tslot; const float* tgate; int sharedbase;
    const float* gpost; const float* modx; const float* modc; int gate_chunk;
    bool doH; bf16_t* H; const float* gpre; int sc_chunk, sh_chunk; const float* modxH; const float* modcH;
};
__device__ __forceinline__ void row_phase(const Frame& F, const RowPhase& P) {
    const int gw = F.vcu * NWAVES + F.wave, NGW = F.G * NWAVES, lane = F.lane;
    for (int row = gw; row < P.nrows; row += NGW) {
        const bool lat = row < NX; const int b = lat ? (row >> 11) : 0;
        const float* mod = lat ? P.modx + (size_t)b * ADA : P.modc;
        const float* xr = lat ? P.xin_lat + (size_t)row * D : P.xin_ctx + (size_t)(row - NX) * D;
        f32x4 x[4];
        if (P.xin16) { const bf16_t* xr16 = (lat ? (const bf16_t*)P.xin_lat + (size_t)row * D : (const bf16_t*)P.xin_ctx + (size_t)(row - NX) * D);
#pragma unroll
            for (int j = 0; j < 4; ++j) { const u32x2 w = *(const u32x2*)(xr16 + 4 * lane + 256 * j); x[j] = (f32x4){bflo(w.x), bfhi(w.x), bflo(w.y), bfhi(w.y)}; }
        } else {
#pragma unroll
            for (int j = 0; j < 4; ++j) x[j] = ld4(xr + 4 * lane + 256 * j);
        }
        if (P.ysrc) {
            f32x4 y[4];
            if (P.ysrc == 1) {
#pragma unroll
                for (int j = 0; j < 4; ++j) { const u32x2 w = __builtin_nontemporal_load((const u32x2*)(P.y + (size_t)row * D + 4 * lane + 256 * j)); y[j] = (f32x4){bflo(w.x), bfhi(w.x), bflo(w.y), bfhi(w.y)}; }
            } else {
#pragma unroll
                for (int j = 0; j < 4; ++j) { const int w = __builtin_nontemporal_load((const int*)(P.mo8 + (size_t)(P.sharedbase + row) * D + 4 * lane + 256 * j)); const f32x2 lo = __builtin_amdgcn_cvt_pk_f32_fp8(w, false), hi = __builtin_amdgcn_cvt_pk_f32_fp8(w, true); y[j] = (f32x4){lo.x, lo.y, hi.x, hi.y} * F8_INV; }
#pragma unroll
                for (int k = 0; k < TOPK; ++k) { const int sl = P.tslot[(size_t)row * 8 + k]; const float g = P.tgate[(size_t)row * 8 + k] * F8_INV;
#pragma unroll
                    for (int j = 0; j < 4; ++j) { const int w = __builtin_nontemporal_load((const int*)(P.mo8 + (size_t)sl * D + 4 * lane + 256 * j)); const f32x2 lo = __builtin_amdgcn_cvt_pk_f32_fp8(w, false), hi = __builtin_amdgcn_cvt_pk_f32_fp8(w, true);
                        y[j].x += g * lo.x; y[j].y += g * lo.y; y[j].z += g * hi.x; y[j].w += g * hi.y; } }
            }
            const float rs = row_rms_scale(y);
#pragma unroll
            for (int j = 0; j < 4; ++j) { const f32x4 gp = ld4(P.gpost + 4 * lane + 256 * j), gt = ld4(mod + P.gate_chunk * D + 4 * lane + 256 * j); x[j] = x[j] + gt * (y[j] * rs * gp); }
            if (P.xout16) { bf16_t* xo16 = lat ? (bf16_t*)P.xout_lat + (size_t)row * D : (bf16_t*)P.xout_ctx + (size_t)(row - NX) * D;
#pragma unroll
                for (int j = 0; j < 4; ++j) { u32x2 w; w.x = pk2(x[j].x, x[j].y); w.y = pk2(x[j].z, x[j].w); *(u32x2*)(xo16 + 4 * lane + 256 * j) = w; }
            } else { float* xo = lat ? P.xout_lat + (size_t)row * D : P.xout_ctx + (size_t)(row - NX) * D;
#pragma unroll
                for (int j = 0; j < 4; ++j) *(f32x4*)(xo + 4 * lane + 256 * j) = x[j]; }
        }
        if (P.doH) {
            const float rs = row_rms_scale(x); const float* modh = lat ? P.modxH + (size_t)b * ADA : P.modcH;
#pragma unroll
            for (int j = 0; j < 4; ++j) { const f32x4 gp = ld4(P.gpre + 4 * lane + 256 * j), sc = ld4(modh + P.sc_chunk * D + 4 * lane + 256 * j), sh = ld4(modh + P.sh_chunk * D + 4 * lane + 256 * j);
                const f32x4 h = x[j] * rs * gp * (sc + 1.0f) + sh; u32x2 w; w.x = pk2(h.x, h.y); w.y = pk2(h.z, h.w);
                *(u32x2*)(P.H + (size_t)row * D + 4 * lane + 256 * j) = w; }
        }
    }
}


constexpr int FILL_PER_WAVE_S = 3;
constexpr int F0_P2 = 208 * 8 * FILL_PER_WAVE_S, F0_P5 = 192 * 8 * FILL_PER_WAVE_S, F0_P7 = MOE_CVT_ITEMS - F0_P2 - F0_P5;
constexpr int F0_BULK = MOE_CVT_ITEMS - F0_P2 - F0_P5 - F0_P7;
static_assert(F0_BULK >= 0, "fill plan");
constexpr int F1_P12 = 128 * 8 * FILL_PER_WAVE_S;
__device__ __forceinline__ void cvt_moe_range(const Frame& F, const Args& a, int layer, int lo, int hi, int rank, int nranks) {
    LAS unsigned* T = (LAS unsigned*)F.lds + F.wave * (64 * 33);
    for (int it = lo + rank * NWAVES + F.wave; it < hi; it += nranks * NWAVES) cvt_moe_item(a, layer, it, F.ws, T, F.lane);
}
__device__ __forceinline__ void fill1_ranges(const Frame& F, int ntr0, int& s9, int& s10) {
    const int nu9 = (ntr0 + NT / 256) * 2, nu10 = (ntr0 + NT / 256) * 4;
    const int l9 = (nu9 % F.G) ? F.G - nu9 % F.G : 0, l10 = (nu10 % F.G) ? F.G - nu10 % F.G : 0;
    s9 = l9 * NWAVES * FILL_PER_WAVE_S; s10 = l10 * NWAVES * (FILL_PER_WAVE_S / 3);
    if (F.G != 256) { s9 = 0; s10 = 0; }
}

__device__ __forceinline__ void p0_ada(const Frame& F, const Args& a) {
    LAS float* sc = (LAS float*)F.lds;
    if ((int)blockIdx.x >= 96) return;
    for (int i = F.tid; i < 17 * D; i += NTHREADS) { const int r = i >> 10, k = i & 1023; const float v = r < 16 ? a.in[1][r * D + k] : a.in[3][k]; sc[i] = siluf_(v); }
    __syncthreads();
    const int item = blockIdx.x; const int layer = item / 48, cg = item % 48;
    const int cq = F.tid & 31, kl = F.tid >> 5;
    const float* W = a.in[4] + (size_t)layer * D * ADA + cg * 128 + cq * 4;
    f32x4 acc[17];
#pragma unroll
    for (int r = 0; r < 17; ++r) acc[r] = (f32x4){0.f, 0.f, 0.f, 0.f};
    for (int k = kl; k < D; k += 16) {
        const f32x4 w = ld4(W + (size_t)k * ADA);
#pragma unroll
        for (int r = 0; r < 17; ++r) { const float s = sc[r * D + k]; acc[r] = acc[r] + w * s; }
    }
#pragma unroll
    for (int r = 0; r < 17; ++r) { acc[r].x += __shfl_xor(acc[r].x, 32); acc[r].y += __shfl_xor(acc[r].y, 32); acc[r].z += __shfl_xor(acc[r].z, 32); acc[r].w += __shfl_xor(acc[r].w, 32); }
    __syncthreads();
    LAS f32x4* red = (LAS f32x4*)F.lds;
    if (F.lane < 32) {
#pragma unroll
        for (int r = 0; r < 17; ++r) red[(F.wave * 17 + r) * 32 + cq] = acc[r];
    }
    __syncthreads();
    for (int i = F.tid; i < 17 * 32; i += NTHREADS) { const int r = i >> 5, q = i & 31; f32x4 s = red[r * 32 + q];
#pragma unroll
        for (int w = 1; w < 8; ++w) s = s + red[(w * 17 + r) * 32 + q];
        const int col = cg * 128 + q * 4; s = s + ld4(a.in[5] + (size_t)layer * ADA + col);
        float* dst = r < 16 ? (float*)(F.ws + WS_MODX) + ((size_t)layer * 16 + r) * ADA + col : (float*)(F.ws + WS_MODC) + (size_t)layer * ADA + col;
        *(f32x4*)dst = s; }
    __syncthreads();
}

__device__ __forceinline__ void p0_convert(const Frame& F, const Args& a) {
    LAS unsigned* T = (LAS unsigned*)(F.lds + 70 * 1024) + F.wave * (64 * 33);
    const int gw = F.vcu * NWAVES + F.wave, NGW = F.G * NWAVES, lane = F.lane;
    bf16_t* win0 = (bf16_t*)(F.ws + WS_WIN0); bf16_t* wout0 = (bf16_t*)(F.ws + WS_WOUT0); bf16_t* wqkv1 = (bf16_t*)(F.ws + WS_WQKV1); bf16_t* wout1 = (bf16_t*)(F.ws + WS_WOUT1); bf16_t* wr = (bf16_t*)(F.ws + WS_WR);
    constexpr int I_IN = 16 * (4 + 4 + 8 + 8 + 1 + 16);
    constexpr int I_SQ = 16 * 16, I_QKV = 16 * 48, I_R = 16 * 4;
    constexpr int NIT = I_IN + I_SQ + I_QKV + I_SQ + 2 * I_R;
    const int nbulk0 = F.G == 256 ? F0_BULK : MOE_CVT_ITEMS;
    for (int it = gw; it < NIT + nbulk0; it += NGW) {
        int r = it;
        if (r < I_IN) {
            const int kt = r & 15, g = r >> 4; int col0, nc = 64, drow;
            if (g < 24) { col0 = 64 * g; drow = 64 * g; }
            else if (g == 24) { col0 = 1536; nc = 32; drow = 2560; }
            else { const int s = g - 25; const int isb = s >> 3, q = s & 7;
                col0 = 1568 + 512 * isb + 64 * q; drow = 1536 + 256 * (q >> 1) + 128 * isb + 64 * (q & 1); }
            cvt_item(a.in[10], AB_IN, col0, nc, kt * 64, win0, D, drow, T, lane); continue; }
        r -= I_IN;
        if (r < I_SQ) { cvt_matrix_item(a.in[11], D, 0, D, D, wout0, 0, r, T, lane); continue; } r -= I_SQ;
        if (r < I_QKV) { cvt_matrix_item(a.in[21], 3 * D, 0, 3 * D, D, wqkv1, 0, r, T, lane); continue; } r -= I_QKV;
        if (r < I_SQ) { cvt_matrix_item(a.in[22], D, 0, D, D, wout1, 0, r, T, lane); continue; } r -= I_SQ;
        if (r < 2 * I_R) { const int l = r / I_R; cvt_matrix_item(a.in[24] + (size_t)l * D * NEXP, NEXP, 0, NEXP, D, wr + (size_t)l * NEXP * D, 0, r % I_R, T, lane); continue; } r -= 2 * I_R;
        cvt_moe_item(a, 0, r, F.ws, T, lane);
    }
    { u32x4 z = (u32x4){0u, 0u, 0u, 0u}; const size_t n16 = (size_t)(AB_INP - AB_IN) * D * 2 / 16; u32x4* p = (u32x4*)(win0 + (size_t)AB_IN * D);
      for (size_t i = (size_t)blockIdx.x * NTHREADS + F.tid; i < n16; i += (size_t)F.G * NTHREADS) p[i] = z; }
    if (blockIdx.x == 0) { f32x2* rt = (f32x2*)(F.ws + WS_ROPE);
        for (int i = F.tid; i < 64 * 16; i += NTHREADS) { const int pos = i >> 4, f = i & 15; const float inv = powf(10000.0f, -(float)f / 16.0f); const float ang = (float)pos * inv; rt[i] = (f32x2){cosf(ang), sinf(ang)}; } }
}


__device__ __forceinline__ int gsw(int row, int ch) { return row * 128 + ((ch ^ (row & 7)) << 4); }
__device__ __forceinline__ int gla_row(int n, int p, int b, int d) {
    const bool isctx = n < 4; const int j = isctx ? n : n - 4; int pos = j * 64 + p;
    if (d) pos = (isctx ? CTXL : SEQ) - 1 - pos;
    return isctx ? NX + b * CTXL + pos : b * SEQ + pos;
}
struct GlaRaw { u32x4 q, k, v0, v1; f32x4 lr[4]; };
__device__ __forceinline__ void gla_load(GlaRaw& R, int n, int lane, int w, int b, int h, int d, const bf16_t* qb, const bf16_t* kb, const bf16_t* vb, const float* lr) {
    const int row = gla_row(n, lane, b, d);
    R.q = *(const u32x4*)(qb + (size_t)row * 256 + h * 64 + 8 * w);
    R.k = *(const u32x4*)(kb + (size_t)row * 256 + h * 64 + 8 * w);
    R.v0 = *(const u32x4*)(vb + (size_t)row * 512 + h * 128 + 8 * w);
    R.v1 = *(const u32x4*)(vb + (size_t)row * 512 + h * 128 + 64 + 8 * w);
#pragma unroll
    for (int i = 0; i < 4; ++i) R.lr[i] = *(const f32x4*)(lr + (size_t)row * 32 + d * 16 + 4 * i);
}
__device__ __forceinline__ void unpack8(const u32x4& w, float (&f)[8]) { f[0] = bflo(w.x); f[1] = bfhi(w.x); f[2] = bflo(w.y); f[3] = bfhi(w.y); f[4] = bflo(w.z); f[5] = bfhi(w.z); f[6] = bflo(w.w); f[7] = bfhi(w.w); }
constexpr int GPL_QE = 0, GPL_KE = 8192, GPL_OUT = 16384, GPL_BUF = 16384 + GI_BYTES + 256, GPL_DW = 2 * GPL_BUF, GPL_DB = GPL_DW + 4096, GPL_END = GPL_DB + 256;
static_assert(GPL_END <= RING_BYTES && (GPL_BUF % 16) == 0, "gla prep lds");
__device__ __forceinline__ void gla_prep_phase(const Frame& F, const Args& a) {
    LAS unsigned char* L = F.lds; const int lane = F.lane, w = F.wave, r16 = lane & 15, g4 = lane >> 4;
    const bf16_t* qb = (const bf16_t*)(F.ws + T_QB); const bf16_t* kb = (const bf16_t*)(F.ws + T_KB); const bf16_t* vb = (const bf16_t*)(F.ws + T_VB); const float* lrb = (const float*)(F.ws + T_LR);
    for (int cc = blockIdx.x; cc < 256; cc += F.G) {
        const int sq = cc & 127, b = sq >> 3, h = (sq >> 1) & 3, d = sq & 1;
        const float* dw = d ? a.in[14] : a.in[12]; const float* db = d ? a.in[15] : a.in[13];
        __syncthreads();
        for (int i = F.tid; i < 16 * 64; i += NTHREADS) ((LAS float*)(L + GPL_DW))[i] = dw[(i >> 6) * GLA_QK + h * 64 + (i & 63)];
        if (F.tid < 64) ((LAS float*)(L + GPL_DB))[F.tid] = db[h * 64 + F.tid];
        GlaRaw R; gla_load(R, cc >> 7, lane, w, b, h, d, qb, kb, vb, lrb);
        __syncthreads();
        for (int k = 0; k < 18; ++k) {
            const int n = (cc >> 7) + 2 * k;
            LAS unsigned char* PB = L + (k & 1) * GPL_BUF; LAS unsigned char* OUT = PB + GPL_OUT;
            {
                float z[8], q[8], kk[8], v0[8], v1[8];
                unpack8(R.q, q); unpack8(R.k, kk); unpack8(R.v0, v0); unpack8(R.v1, v1);
                const LAS float* DW = (const LAS float*)(L + GPL_DW); const LAS float* DB = (const LAS float*)(L + GPL_DB);
#pragma unroll
                for (int j = 0; j < 8; ++j) z[j] = DB[8 * w + j];
#pragma unroll
                for (int r = 0; r < 16; ++r) { const float x = R.lr[r >> 2][r & 3]; const f32x4 w0 = *(const LAS f32x4*)(DW + r * 64 + 8 * w), w1 = *(const LAS f32x4*)(DW + r * 64 + 8 * w + 4);
                    z[0] += x * w0.x; z[1] += x * w0.y; z[2] += x * w0.z; z[3] += x * w0.w; z[4] += x * w1.x; z[5] += x * w1.y; z[6] += x * w1.z; z[7] += x * w1.w; }
                float qe[8], ke[8], qi[8]; unsigned short ko[8]; float ld[8];
#pragma unroll
                for (int j = 0; j < 8; ++j) ld[j] = (fminf(z[j], 0.f) - __logf(1.0f + __expf(-fabsf(z[j])))) * (1.0f / 16.0f);
#pragma unroll
                for (int o = 1; o < 64; o <<= 1) { float t[8];
#pragma unroll
                    for (int j = 0; j < 8; ++j) t[j] = __shfl_up(ld[j], o);
#pragma unroll
                    for (int j = 0; j < 8; ++j) ld[j] += (lane >= o) ? t[j] : 0.f; }
                float decv = 0.f;
#pragma unroll
                for (int j = 0; j < 8; ++j) {
                    const float bm = __builtin_bit_cast(float, __builtin_amdgcn_readlane(__builtin_bit_cast(int, ld[j]), 31)), bl = __builtin_bit_cast(float, __builtin_amdgcn_readlane(__builtin_bit_cast(int, ld[j]), 63));
                    const float e1 = __expf(ld[j] - bm), e2 = __expf(bm - ld[j]);
                    qe[j] = q[j] * e1; ke[j] = kk[j] * e2; qi[j] = q[j] * __expf(ld[j]); ko[j] = (unsigned short)f2bf(kk[j] * __expf(bl - ld[j]));
                    decv = (lane == j) ? __expf(bl) : decv;
                }
                if (lane < 8) ((LAS float*)(OUT + GI_DEC))[8 * w + lane] = decv;
                *(LAS u32x4*)(PB + GPL_QE + gsw(lane, w)) = (u32x4){pk2(qe[0], qe[1]), pk2(qe[2], qe[3]), pk2(qe[4], qe[5]), pk2(qe[6], qe[7])};
                *(LAS u32x4*)(PB + GPL_KE + gsw(lane, w)) = (u32x4){pk2(ke[0], ke[1]), pk2(ke[2], ke[3]), pk2(ke[4], ke[5]), pk2(ke[6], ke[7])};
                *(LAS u32x4*)(OUT + GI_QIN + gsw(lane, w)) = (u32x4){pk2(qi[0], qi[1]), pk2(qi[2], qi[3]), pk2(qi[4], qi[5]), pk2(qi[6], qi[7])};
#pragma unroll
                for (int j = 0; j < 8; ++j) { const int rw = 8 * w + j;
                    *(LAS unsigned short*)(OUT + GI_KOT + gsw(rw, lane >> 3) + (lane & 7) * 2) = ko[j];
                    *(LAS unsigned short*)(OUT + GI_VT + gsw(rw, lane >> 3) + (lane & 7) * 2) = (unsigned short)f2bf(v0[j]);
                    *(LAS unsigned short*)(OUT + GI_VT + gsw(64 + rw, lane >> 3) + (lane & 7) * 2) = (unsigned short)f2bf(v1[j]); }
            }
            if (k + 1 < 18) gla_load(R, n + 2, lane, w, b, h, d, qb, kb, vb, lrb);
            lds_barrier();
#pragma unroll
            for (int i = 0; i < 2; ++i) { const int tI = 2 * w + i, st = tI >> 2, pt = tI & 3;
                f32x4 c = (f32x4){0.f, 0.f, 0.f, 0.f};
                if (st <= pt) {
#pragma unroll
                    for (int ks = 0; ks < 2; ++ks) { const bf16x8 af = *(const LAS bf16x8*)(PB + GPL_KE + gsw(16 * st + r16, 4 * ks + g4)), bfr = *(const LAS bf16x8*)(PB + GPL_QE + gsw(16 * pt + r16, 4 * ks + g4));
                        c = __builtin_amdgcn_mfma_f32_16x16x32_bf16(af, bfr, c, 0, 0, 0); }
                    const int p = 16 * pt + r16, s0 = 16 * st + 4 * g4;
#pragma unroll
                    for (int e = 0; e < 4; ++e) if (s0 + e > p) c[e] = 0.f;
                }
                u32x2 o; o.x = pk2(c[0], c[1]); o.y = pk2(c[2], c[3]);
                *(LAS u32x2*)(OUT + GI_A + gsw(16 * pt + r16, 2 * st + (g4 >> 1)) + (g4 & 1) * 8) = o; }
            lds_barrier();
            { unsigned char* rec = F.ws + T_GLA + (size_t)(sq * 36 + n) * GI_BYTES;
              for (int i = F.tid; i < GI_BYTES / 16; i += NTHREADS) *(u32x4*)(rec + i * 16) = *(const LAS u32x4*)(OUT + i * 16); }
        }
    }
    __syncthreads();
}
constexpr int GSL_IN = 33792  , GSL_ST = 3 * GSL_IN, GSL_END = GSL_ST + 2 * 8192;
static_assert(GSL_END <= RING_BYTES, "gla seq lds");
__device__ __forceinline__ void gla_seq_phase(const Frame& F, const Args& a) {
    LAS unsigned char* L = F.lds; const int lane = F.lane, w = F.wave, r16 = lane & 15, g4 = lane >> 4, tid = F.tid;
    for (int it = blockIdx.x; it < 256; it += F.G) {
        const int sq = it >> 1, vh = it & 1, b = sq >> 3, h = (sq >> 1) & 3, d = sq & 1;
        bf16_t* ob = (bf16_t*)(F.ws + (d ? T_OB : T_OF));
        const unsigned char* rec0 = F.ws + T_GLA + (size_t)(sq * 36) * GI_BYTES;
        __syncthreads();
        for (int i = tid; i < 2 * 8192 / 4; i += NTHREADS) ((LAS unsigned*)(L + GSL_ST))[i] = 0u;
        f32x4 Sacc[2] = {(f32x4){0.f, 0.f, 0.f, 0.f}, (f32x4){0.f, 0.f, 0.f, 0.f}};
#define GLA_DMA(n_) do { const unsigned char* r_ = rec0 + (size_t)(n_) * GI_BYTES; LAS unsigned char* d_ = L + ((n_) % 3) * GSL_IN; \
            __builtin_amdgcn_global_load_lds((const unsigned*)(r_ + GI_A + tid * 16), (LAS unsigned*)(d_ + w * 1024), 16, 0, 0); \
            __builtin_amdgcn_global_load_lds((const unsigned*)(r_ + GI_QIN + tid * 16), (LAS unsigned*)(d_ + 8192 + w * 1024), 16, 0, 0); \
            __builtin_amdgcn_global_load_lds((const unsigned*)(r_ + GI_KOT + tid * 16), (LAS unsigned*)(d_ + 16384 + w * 1024), 16, 0, 0); \
            __builtin_amdgcn_global_load_lds((const unsigned*)(r_ + GI_VT + vh * 8192 + tid * 16), (LAS unsigned*)(d_ + 24576 + w * 1024), 16, 0, 0); \
            __builtin_amdgcn_global_load_lds((const unsigned*)(r_ + GI_DEC + lane * 16), (LAS unsigned*)(d_ + 32768), 16, 0, 0); } while (0)
        GLA_DMA(0); GLA_DMA(1);
        for (int n = 0; n < 36; ++n) {
            LAS unsigned char* IN = L + (n % 3) * GSL_IN; LAS unsigned char* STr = L + GSL_ST + (n & 1) * 8192; LAS unsigned char* STw = L + GSL_ST + ((n + 1) & 1) * 8192;
            if (n == 0) asm volatile("s_waitcnt vmcnt(5)" ::: "memory"); else if (n < 35) asm volatile("s_waitcnt vmcnt(7)" ::: "memory"); else asm volatile("s_waitcnt vmcnt(2)" ::: "memory");
            lds_barrier();
            if (n + 2 < 36) GLA_DMA(n + 2);
#pragma unroll
            for (int i = 0; i < 2; ++i) { const int tI = 2 * w + i, vt = tI >> 2, pt = tI & 3;
                f32x4 c = (f32x4){0.f, 0.f, 0.f, 0.f};
#pragma unroll
                for (int ks = 0; ks < 2; ++ks) {
                    const bf16x8 a1 = *(const LAS bf16x8*)(IN + 24576 + gsw(16 * vt + r16, 4 * ks + g4)), b1 = *(const LAS bf16x8*)(IN + gsw(16 * pt + r16, 4 * ks + g4));
                    c = __builtin_amdgcn_mfma_f32_16x16x32_bf16(a1, b1, c, 0, 0, 0);
                    const bf16x8 a2 = *(const LAS bf16x8*)(STr + gsw(16 * vt + r16, 4 * ks + g4)), b2 = *(const LAS bf16x8*)(IN + 8192 + gsw(16 * pt + r16, 4 * ks + g4));
                    c = __builtin_amdgcn_mfma_f32_16x16x32_bf16(a2, b2, c, 0, 0, 0); }
                const int row = gla_row(n, 16 * pt + r16, b, d);
                u32x2 o; o.x = pk2(c[0], c[1]); o.y = pk2(c[2], c[3]);
                *(u32x2*)(ob + (size_t)row * 512 + h * 128 + vh * 64 + 16 * vt + 4 * g4) = o; }
#pragma unroll
            for (int i = 0; i < 2; ++i) { const int tI = 2 * w + i, ct = tI >> 2, vt = tI & 3;
                const f32x4 dc = *(const LAS f32x4*)(IN + 32768 + (16 * ct + 4 * g4) * 4);
                f32x4 c = Sacc[i] * dc;
#pragma unroll
                for (int ks = 0; ks < 2; ++ks) { const bf16x8 af = *(const LAS bf16x8*)(IN + 16384 + gsw(16 * ct + r16, 4 * ks + g4)), bfr = *(const LAS bf16x8*)(IN + 24576 + gsw(16 * vt + r16, 4 * ks + g4));
                    c = __builtin_amdgcn_mfma_f32_16x16x32_bf16(af, bfr, c, 0, 0, 0); }
                Sacc[i] = c;
                u32x2 o; o.x = pk2(c[0], c[1]); o.y = pk2(c[2], c[3]);
                *(LAS u32x2*)(STw + gsw(16 * vt + r16, 2 * ct + (g4 >> 1)) + (g4 & 1) * 8) = o; }
        }
#undef GLA_DMA
        asm volatile("s_waitcnt vmcnt(0)" ::: "memory");
    }
    __syncthreads();
}

__device__ __forceinline__ void finish_conv_phase(const Frame& F, const Args& a) {
    const int lane = F.lane; bf16_t* cat = (bf16_t*)(F.ws + T_CAT);
    {
        const bf16_t* of = (const bf16_t*)(F.ws + T_OF); const bf16_t* obk = (const bf16_t*)(F.ws + T_OB); const bf16_t* gb = (const bf16_t*)(F.ws + T_GB);
        const int gw = F.vcu * NWAVES + F.wave, NGW = F.G * NWAVES;
        float gg[8];
#pragma unroll
        for (int j = 0; j < 8; ++j) gg[j] = a.in[16][8 * lane + j];
        for (int row = gw; row < NT; row += NGW) {
            float x[8], y[8], g[8];
            unpack8(*(const u32x4*)(of + (size_t)row * 512 + 8 * lane), x); unpack8(*(const u32x4*)(obk + (size_t)row * 512 + 8 * lane), y); unpack8(*(const u32x4*)(gb + (size_t)row * 512 + 8 * lane), g);
            float ss = 0.f;
#pragma unroll
            for (int j = 0; j < 8; ++j) { x[j] += y[j]; ss += x[j] * x[j]; }
            ss += __shfl_xor(ss, 1); ss += __shfl_xor(ss, 2); ss += __shfl_xor(ss, 4); ss += __shfl_xor(ss, 8);
            const float rs = rsqrtf(ss * (1.0f / 128.0f) + RMS_EPS);
#pragma unroll
            for (int j = 0; j < 8; ++j) x[j] = x[j] * rs * gg[j] * siluf_(g[j]);
            *(u32x4*)(cat + (size_t)row * D + 8 * lane) = (u32x4){pk2(x[0], x[1]), pk2(x[2], x[3]), pk2(x[4], x[5]), pk2(x[6], x[7])};
        }
    }
    {
        const bf16_t* ub = (const bf16_t*)(F.ws + T_UB); LAS float* tile = (LAS float*)F.lds;
        const int c = F.tid;
        float wv[CONV_W];
#pragma unroll
        for (int j = 0; j < CONV_W; ++j) wv[j] = a.in[17][j * CONV_CH + c];
        const float cb = a.in[18][c];
        float lg[8], lb[8];
#pragma unroll
        for (int i = 0; i < 8; ++i) { lg[i] = a.in[19][lane + 64 * i]; lb[i] = a.in[20][lane + 64 * i]; }
        for (int ti = blockIdx.x; ti < NT / 32; ti += F.G) {
            const int row0 = ti * 32; const bool lat = row0 < NX;
            const int t0 = lat ? (row0 & (SEQ - 1)) : ((row0 - NX) & (CTXL - 1)); const int len = lat ? SEQ : CTXL; const int sbase = row0 - t0;
            float in[62];
            unsigned short raw[62];
#pragma unroll
            for (int i = 0; i < 62; ++i) { int t = t0 - 15 + i; t = t < 0 ? 0 : (t >= len ? len - 1 : t); raw[i] = ub[(size_t)(sbase + t) * 512 + c]; }
#pragma unroll
            for (int i = 0; i < 62; ++i) { const int t = t0 - 15 + i; in[i] = (t >= 0 && t < len) ? bf2f(raw[i]) : 0.f; }
            __syncthreads();
#pragma unroll
            for (int t = 0; t < 32; ++t) { float s = cb;
#pragma unroll
                for (int j = 0; j < CONV_W; ++j) s += wv[j] * in[t + j];
                tile[t * 512 + c] = s; }
            __syncthreads();
#pragma unroll
            for (int q = 0; q < 4; ++q) { const int t = 4 * F.wave + q; float v[8]; float s = 0.f;
#pragma unroll
                for (int i = 0; i < 8; ++i) { v[i] = tile[t * 512 + lane + 64 * i]; s += v[i]; }
                const float mu = wave_sum(s) * (1.0f / 512.0f); float qq = 0.f;
#pragma unroll
                for (int i = 0; i < 8; ++i) { v[i] -= mu; qq += v[i] * v[i]; }
                const float rstd = rsqrtf(wave_sum(qq) * (1.0f / 512.0f) + LN_EPS);
#pragma unroll
                for (int i = 0; i < 8; ++i) { const float y = v[i] * rstd * lg[i] + lb[i]; cat[(size_t)(row0 + t) * D + 512 + lane + 64 * i] = (bf16_t)f2bf(siluf_(y)); } }
        }
        __syncthreads();
    }
}


constexpr int CW_TST = 20480;
constexpr int AUX_TST = AUX_OFF, AUX_TILEE = AUX_OFF + 1040, AUX_IDX = AUX_OFF + 1168;
constexpr int MOE_MAXU = 32, MOE_MAXIDX = 16;
static_assert(AUX_IDX + MOE_MAXIDX * 1024 <= MISC_OFF, "aux lds");

struct EpiRouter {
    static constexpr bool PERM = false, AFTER_DRAIN = true;
    const float* rbias; int* asg_e; int* asg_r; float* asg_g; unsigned* counts; int* lst;
    __device__ __forceinline__ void operator()(const f32x4 (&)[2][2][4][2], const Unit&, int, int, int, int) const {}
    __device__ __forceinline__ void fused(const f32x4 (&acc)[2][2][4][2], const Unit& u, int wr, int wc, int fr, int fq, LAS unsigned char* lds, int wid, int lane) const {
        LAS float* SC = (LAS float*)lds;
        LAS unsigned* lcnt = (LAS unsigned*)(lds + 66560); LAS unsigned* lbase = lcnt + 256;
        LAS int* selE = (LAS int*)(lbase + 256); LAS int* selR = selE + 2048;
        const int tid = wid * 64 + lane;
        if (tid < 256) lcnt[tid] = 0u;
        const f32x4 rb = *(const f32x4*)(rbias + 4 * lane);
        const float NINF = -__builtin_inff();
#pragma unroll
        for (int ai = 0; ai < 2; ++ai)
#pragma unroll
            for (int mm = 0; mm < 2; ++mm) {
                LDS_WAIT(); __builtin_amdgcn_s_barrier(); asm volatile("" ::: "memory");
#pragma unroll
                for (int mi = 0; mi < 2; ++mi) { const int lr = 32 * wr + 16 * mi + fr;
#pragma unroll
                    for (int bj = 0; bj < 2; ++bj)
#pragma unroll
                        for (int n = 0; n < 2; ++n) *(LAS f32x4*)(SC + lr * 260 + 128 * bj + 32 * wc + 16 * n + 4 * fq) = acc[ai][bj][2 * mm + mi][n]; }
                LDS_WAIT(); __builtin_amdgcn_s_barrier(); asm volatile("" ::: "memory");
                for (int q = 0; q < 8; ++q) {
                    const int lr = 8 * wid + q; const int rit = 128 * ai + 64 * (lr >> 5) + 16 * (2 * mm + ((lr >> 4) & 1)) + (lr & 15);
                    const f32x4 lg = *(const LAS f32x4*)(SC + lr * 260 + 4 * lane);
                    float s[4], cd[4];
#pragma unroll
                    for (int j = 0; j < 4; ++j) { s[j] = 1.0f / (1.0f + __expf(-lg[j])); cd[j] = s[j] + rb[j]; }
                    float m1 = fmaxf(cd[0], cd[1]), m2 = fminf(cd[0], cd[1]);
                    { const float x = cd[2]; const float n1 = fmaxf(m1, x); m2 = fmaxf(fminf(m1, x), m2); m1 = n1; }
                    { const float x = cd[3]; const float n1 = fmaxf(m1, x); m2 = fmaxf(fminf(m1, x), m2); m1 = n1; }
#pragma unroll
                    for (int o = 1; o < 8; o <<= 1) { const float a1 = __shfl_xor(m1, o), a2 = __shfl_xor(m2, o); const float n1 = fmaxf(m1, a1); m2 = fmaxf(fminf(m1, a1), fmaxf(m2, a2)); m1 = n1; }
                    const float gs = m1 + m2; const int mygrp = lane >> 3; int rank = 0;
#pragma unroll
                    for (int g = 0; g < 8; ++g) { const float og = __shfl(gs, 8 * g); rank += (og > gs || (og == gs && g < mygrp)) ? 1 : 0; }
                    if (rank >= 4) { cd[0] = NINF; cd[1] = NINF; cd[2] = NINF; cd[3] = NINF; }
                    int myE = 0; float myG = 0.f; float gsum = 0.f;
#pragma unroll
                    for (int k = 0; k < TOPK; ++k) {
                        float bv = cd[0]; int bi = 0;
                        if (cd[1] > bv) { bv = cd[1]; bi = 1; } if (cd[2] > bv) { bv = cd[2]; bi = 2; } if (cd[3] > bv) { bv = cd[3]; bi = 3; }
                        float v = bv; int ix = 4 * lane + bi;
#pragma unroll
                        for (int o = 32; o >= 1; o >>= 1) { const float ov = __shfl_xor(v, o); const int oi = __shfl_xor(ix, o); if (ov > v || (ov == v && oi < ix)) { v = ov; ix = oi; } }
                        const int sl = ix & 3; const float mys = sl == 0 ? s[0] : (sl == 1 ? s[1] : (sl == 2 ? s[2] : s[3]));
                        const float gv = __shfl(mys, ix >> 2);
                        gsum += gv;
                        if (lane == k) { myE = ix; myG = gv; }
                        if (lane == (ix >> 2)) { if (sl == 0) cd[0] = NINF; else if (sl == 1) cd[1] = NINF; else if (sl == 2) cd[2] = NINF; else cd[3] = NINF; }
                    }
                    if (lane < TOPK) { const unsigned r = __hip_atomic_fetch_add(&lcnt[myE], 1u, __ATOMIC_RELAXED, __HIP_MEMORY_SCOPE_WORKGROUP); selE[rit * 8 + lane] = myE; selR[rit * 8 + lane] = (int)r; asg_g[(size_t)(u.orow + rit) * 8 + lane] = myG / gsum * 2.5f; }
                }
            }
        LDS_WAIT(); __builtin_amdgcn_s_barrier(); asm volatile("" ::: "memory");
        if (tid < 256) { const unsigned c = lcnt[tid]; lbase[tid] = c ? atomicAdd(&counts[tid], c) : 0u; }
        LDS_WAIT(); __builtin_amdgcn_s_barrier(); asm volatile("" ::: "memory");
        for (int i = tid; i < 2048; i += NTHREADS) { const int e = selE[i]; const int r = (int)lbase[e] + selR[i]; asg_e[(size_t)u.orow * 8 + i] = e; asg_r[(size_t)u.orow * 8 + i] = r; lst[(size_t)e * LCAP + r] = u.orow + (i >> 3); }
    }
};

template <int NCOL>
__device__ __forceinline__ int moe_units_setup(const Frame& F, int layer, int ntok, int c, bool want_idx) {
    LAS int* tst = (LAS int*)(F.lds + AUX_TST); LAS int* tileE = (LAS int*)(F.lds + AUX_TILEE); LAS int* idxl = (LAS int*)(F.lds + AUX_IDX);
    const unsigned* counts = F.ctl + CW_CNT + layer * 256;
    __syncthreads();
    if (want_idx) {
        if (F.wave == 0) { int t4[4], s = 0;
#pragma unroll
            for (int j = 0; j < 4; ++j) { t4[j] = ((int)counts[4 * F.lane + j] + 255) >> 8; s += t4[j]; }
            int incl = s;
#pragma unroll
            for (int o = 1; o < 64; o <<= 1) { const int v = __shfl_up(incl, o); if (F.lane >= o) incl += v; }
            int base = incl - s;
#pragma unroll
            for (int j = 0; j < 4; ++j) { tst[4 * F.lane + j] = base; base += t4[j]; }
            if (F.lane == 63) tst[256] = incl; }
    } else for (int i = F.tid; i < 257; i += NTHREADS) tst[i] = (int)F.ctl[CW_TST + layer * 320 + i];
    __syncthreads();
    const int ntr = tst[256], nunits = (ntr + ntok / 256) * NCOL;
    int nu = c < nunits ? (nunits - c + F.G - 1) / F.G : 0; if (nu > MOE_MAXU) nu = MOE_MAXU; if (want_idx && nu > MOE_MAXIDX) nu = MOE_MAXIDX;
    if (F.tid < nu) { const int rt = (c + F.tid * F.G) / NCOL; int e;
        if (rt >= ntr) e = NEXP; else { int lo = 0, hi = 255; while (lo < hi) { const int mid = (lo + hi + 1) >> 1; if (tst[mid] <= rt) lo = mid; else hi = mid - 1; } e = lo; }
        tileE[F.tid] = e; }
    if (want_idx) {
        if (blockIdx.x == 0) for (int i = F.tid; i < 257; i += NTHREADS) F.ctl[CW_TST + layer * 320 + i] = (unsigned)tst[i];
        {
            const int* asg_e = (const int*)(F.ws + M_AE); const int* asg_r = (const int*)(F.ws + M_AR); int* tslot = (int*)(F.ws + M_TS);
            const int gt = blockIdx.x * NTHREADS + F.tid, gs = F.G * NTHREADS;
            for (int i = gt; i < ntok * 8; i += gs) tslot[i] = tst[asg_e[i]] * 256 + asg_r[i]; }
        __syncthreads();
        const int* lst = (const int*)(F.ws + M_LST);
        for (int i = F.tid; i < nu * 256; i += NTHREADS) { const int j = i >> 8, r = i & 255; const int rt = (c + j * F.G) / NCOL; const int e = tileE[j]; int tok;
            if (e >= NEXP) tok = (rt - ntr) * 256 + r;
            else { const int pos = (rt - tst[e]) * 256 + r; tok = pos < (int)counts[e] ? lst[(size_t)e * LCAP + pos] : 0; }
            idxl[i] = tok; }
    }
    __syncthreads();
    return nu;
}
struct SchedMoeGU {
    const char* A; const char* W; const LAS int* tileE; const LAS int* idxl; int nu, G, c;
    __device__ __forceinline__ bool next(int i, Unit& u) const {
        if (i >= nu) return false; const int un = c + i * G; const int rt = un >> 1, col = un & 1; const int e = tileE[i];
        u.a = i; u.b = e * 512 + col * 256; u.orow = rt * 256; u.ocol = col * 128; u.aux = e; return true; }
    __device__ __forceinline__ const char* a_base() const { return A; }
    __device__ __forceinline__ const char* b_ptr(const Unit& u) const { return W + (size_t)u.b * D * 2; }
    __device__ __forceinline__ void a_off(const Unit& u, const int (&R)[2], const int (&C)[2], unsigned (&o0)[2], unsigned (&o1)[2]) const {
#pragma unroll
        for (int i = 0; i < 2; ++i) { const int t0 = idxl[u.a * 256 + R[i]], t1 = idxl[u.a * 256 + 128 + R[i]]; o0[i] = (unsigned)t0 * (unsigned)(D * 2) + (unsigned)C[i] * 2u; o1[i] = (unsigned)t1 * (unsigned)(D * 2) + (unsigned)C[i] * 2u; }
    }
};
struct EpiGateUp {
    static constexpr bool PERM = true, AFTER_DRAIN = false;
    bf16_t* hid;
    __device__ __forceinline__ void operator()(const f32x4 (&acc)[2][2][4][2], const Unit& u, int wr, int wc, int fr, int fq) const {
        const int lane = fr + 16 * fq; const int srcb = ((lane >> 2) + 16 * (lane & 3)) << 2;
        const int row0 = u.orow + wr * 64 + (lane >> 2), col0 = u.ocol + wc * 32 + 8 * (lane & 3);
#pragma unroll
        for (int ai = 0; ai < 2; ++ai)
#pragma unroll
            for (int m = 0; m < 4; ++m) { float h[8];
#pragma unroll
                for (int n = 0; n < 2; ++n)
#pragma unroll
                    for (int e = 0; e < 4; ++e) { const float g = acc[ai][0][m][n][e], up = acc[ai][1][m][n][e]; h[4 * n + e] = g / (1.0f + __expf(-g)) * up; }
                u32x4 w; w.x = cvt_pk_bf16(h[0], h[1]); w.y = cvt_pk_bf16(h[2], h[3]); w.z = cvt_pk_bf16(h[4], h[5]); w.w = cvt_pk_bf16(h[6], h[7]);
                u32x4 t; t.x = (unsigned)__builtin_amdgcn_ds_bpermute(srcb, (int)w.x); t.y = (unsigned)__builtin_amdgcn_ds_bpermute(srcb, (int)w.y); t.z = (unsigned)__builtin_amdgcn_ds_bpermute(srcb, (int)w.z); t.w = (unsigned)__builtin_amdgcn_ds_bpermute(srcb, (int)w.w);
                *(u32x4*)(hid + (size_t)(row0 + ai * 128 + m * 16) * DEXP + col0) = t; }
    }
};
struct SchedMoeDN {
    const char* A; const char* W; const LAS int* tileE; int nu, G, c;
    __device__ __forceinline__ bool next(int i, Unit& u) const {
        if (i >= nu) return false; const int un = c + i * G; const int rt = un >> 2, col = un & 3; const int e = tileE[i];
        u.a = rt; u.b = e * 1024 + col * 256; u.orow = rt * 256; u.ocol = col * 256; u.aux = e; return true; }
    __device__ __forceinline__ const char* a_base() const { return A; }
    __device__ __forceinline__ const char* b_ptr(const Unit& u) const { return W + (size_t)u.b * DEXP * 2; }
    __device__ __forceinline__ void a_off(const Unit& u, const int (&R)[2], const int (&C)[2], unsigned (&o0)[2], unsigned (&o1)[2]) const {
#pragma unroll
        for (int i = 0; i < 2; ++i) { o0[i] = (unsigned)((u.a * 256 + R[i]) * DEXP + C[i]) * 2u; o1[i] = o0[i] + (unsigned)(128 * DEXP * 2); }
    }
};

constexpr int NA_RING = 9, NA_KR = 0, NA_VR = NA_RING * 64 * 128, NA_RPB = 2 * NA_RING * 64 * 128, NA_END = NA_RPB + 15 * 128;
constexpr int NA_KC = 0, NA_VC = 256 * 128;
static_assert(NA_END <= MISC_OFF, "na lds");
typedef short s16x4 __attribute__((ext_vector_type(4)));
__device__ __forceinline__ int na_voff(int row, int ch) { return row * 128 + ((((ch >> 1) ^ ((row >> 1) & 3)) << 5) | ((ch & 1) << 4)); }
__device__ __forceinline__ int na_koff(int row, int ch) { return row * 128 + ((ch ^ (row & 7)) << 4); }
template <bool CTX>
__device__ __forceinline__ void na_seg2(LAS unsigned char* L, const bf16x8 (&qf)[2], int r16, int g4, int r0, int band, const int (&boff)[2][4], int rbase,
                                        const int (&voff)[4], f32x4 (&O)[4], float& m_run, float& sum) {
    const float NINF = -__builtin_inff();
    float S[2][8][4]; float mx[2] = {NINF, NINF};
#pragma unroll
    for (int t = 0; t < 8; ++t) {
#pragma unroll
        for (int q = 0; q < 2; ++q) {
            f32x4 c = (f32x4){0.f, 0.f, 0.f, 0.f};
            int key, kbase;
            if (CTX) { key = 128 * q + 16 * t + r16; kbase = NA_KC; } else { key = ((r0 + ((8 * q + t) >> 1)) % NA_RING) * 64 + band + 16 * (t & 1) + r16; kbase = NA_KR; }
            const bf16x8 k0 = *(const LAS bf16x8*)(L + kbase + na_koff(key, g4)), k1 = *(const LAS bf16x8*)(L + kbase + na_koff(key, 4 + g4));
            c = __builtin_amdgcn_mfma_f32_16x16x32_bf16(k0, qf[0], c, 0, 0, 0); c = __builtin_amdgcn_mfma_f32_16x16x32_bf16(k1, qf[1], c, 0, 0, 0);
            if (CTX) {
#pragma unroll
                for (int e = 0; e < 4; ++e) S[q][t][e] = c[e];
            } else {
#pragma unroll
                for (int e = 0; e < 4; ++e) S[q][t][e] = c[e] + *(const LAS float*)(L + rbase + ((8 * q + t) >> 1) * 128 + boff[t & 1][e]);
            }
            mx[q] = fmaxf(mx[q], fmaxf(fmaxf(S[q][t][0], S[q][t][1]), fmaxf(S[q][t][2], S[q][t][3])));
        }
    }
    float ps[2]; f32x4 Oq[2][4];
#pragma unroll
    for (int q = 0; q < 2; ++q) { mx[q] = fmaxf(mx[q], __shfl_xor(mx[q], 16)); mx[q] = fmaxf(mx[q], __shfl_xor(mx[q], 32)); }
#pragma unroll
    for (int q = 0; q < 2; ++q) { float s = 0.f;
#pragma unroll
        for (int t = 0; t < 8; ++t)
#pragma unroll
            for (int e = 0; e < 4; ++e) { const float p = __builtin_amdgcn_exp2f(S[q][t][e] - mx[q]); S[q][t][e] = p; s += p; }
        ps[q] = s;
#pragma unroll
        for (int mt = 0; mt < 4; ++mt) Oq[q][mt] = (f32x4){0.f, 0.f, 0.f, 0.f}; }
#pragma unroll
    for (int q = 0; q < 2; ++q) { ps[q] += __shfl_xor(ps[q], 16); ps[q] += __shfl_xor(ps[q], 32); }
#pragma unroll
    for (int j = 0; j < 4; ++j) {
#pragma unroll
        for (int q = 0; q < 2; ++q) {
            bf16x8 pb; { const u32x4 ww = (u32x4){cvt_pk_bf16(S[q][2 * j][0], S[q][2 * j][1]), cvt_pk_bf16(S[q][2 * j][2], S[q][2 * j][3]), cvt_pk_bf16(S[q][2 * j + 1][0], S[q][2 * j + 1][1]), cvt_pk_bf16(S[q][2 * j + 1][2], S[q][2 * j + 1][3])}; pb = __builtin_bit_cast(bf16x8, ww); }
            int ub;
            if (CTX) ub = NA_VC + (128 * q + 32 * j) * 128; else ub = NA_VR + (((r0 + 4 * q + j) % NA_RING) * 64 + band) * 128;
#pragma unroll
            for (int mt = 0; mt < 4; ++mt) {
                const s16x4 a0 = __builtin_amdgcn_ds_read_tr16_b64_v4i16((LAS s16x4*)(L + ub + voff[mt]));
                const s16x4 a1 = __builtin_amdgcn_ds_read_tr16_b64_v4i16((LAS s16x4*)(L + ub + voff[mt] + 16 * 128));
                const bf16x8 av = (bf16x8){a0[0], a0[1], a0[2], a0[3], a1[0], a1[1], a1[2], a1[3]};
                Oq[q][mt] = __builtin_amdgcn_mfma_f32_16x16x32_bf16(av, pb, Oq[q][mt], 0, 0, 0);
            }
        }
    }
    const float m_new = fmaxf(m_run, fmaxf(mx[0], mx[1]));
    const float a_run = __builtin_amdgcn_exp2f(m_run - m_new), a0 = __builtin_amdgcn_exp2f(mx[0] - m_new), a1 = __builtin_amdgcn_exp2f(mx[1] - m_new);
    m_run = m_new; sum = sum * a_run + ps[0] * a0 + ps[1] * a1;
#pragma unroll
    for (int mt = 0; mt < 4; ++mt) O[mt] = O[mt] * a_run + Oq[0][mt] * a0 + Oq[1][mt] * a1;
}
__device__ __forceinline__ void na_phase(const Frame& F, const Args& a) {
    LAS unsigned char* L = F.lds; const int lane = F.lane, w = F.wave, r16 = lane & 15, g4 = lane >> 4;
    const bf16_t* qbuf = (const bf16_t*)(F.ws + T_QKV); const bf16_t* kbuf = qbuf + (size_t)NT * D; const bf16_t* vbuf = kbuf + (size_t)NT * D; bf16_t* cat = (bf16_t*)(F.ws + T_CAT);
    f32x2* mlbuf = (f32x2*)(F.ws + T_Y);
    const int rr = w >> 2, cb = w & 3; const int band = cb == 0 ? 0 : (cb == 1 ? 8 : (cb == 2 ? 24 : 32));
    const float NINF = -__builtin_inff();
    const int pkey = F.tid >> 3, pch = F.tid & 7;
    int boff[2][4], voff[4];
    { const int qc = 16 * cb + r16; int cs = qc - 8; cs = cs < 0 ? 0 : (cs > 48 ? 48 : cs);
#pragma unroll
      for (int hc = 0; hc < 2; ++hc)
#pragma unroll
          for (int e = 0; e < 4; ++e) { const int kc = band + 16 * hc + 4 * g4 + e; const bool ok = kc >= cs && kc < cs + 16; boff[hc][e] = (ok ? kc - qc + 15 : 31) * 4; }
      const int rl = 4 * g4 + (r16 >> 2), sw = (rl >> 1) & 3;
#pragma unroll
      for (int mt = 0; mt < 4; ++mt) voff[mt] = rl * 128 + ((mt ^ sw) << 5) + 8 * (r16 & 3); }
    for (int bh = blockIdx.x; bh < BATCH * NA_H; bh += F.G) {
        const int b = bh >> 4, h = bh & 15;
        __syncthreads();
        for (int i = F.tid; i < 256 * 8; i += NTHREADS) { const int key = i >> 3, ch = i & 7; const size_t g = (size_t)(NX + b * CTXL + key) * D + h * 64 + ch * 8;
            *(LAS u32x4*)(L + NA_VC + na_voff(key, ch)) = *(const u32x4*)(vbuf + g); *(LAS u32x4*)(L + NA_KC + na_koff(key, ch)) = *(const u32x4*)(kbuf + g); }
        __syncthreads();
        {
            bf16x8 qn[2];
            { const bf16_t* q0 = qbuf + (size_t)(b * SEQ + rr * 64 + 16 * cb + r16) * D + h * 64 + 8 * g4; qn[0] = *(const bf16x8*)q0; qn[1] = *(const bf16x8*)(q0 + 32); }
            for (int rp = 0; rp < 16; ++rp) {
                const int r = 2 * rp + rr; const int qrow = b * SEQ + r * 64 + 16 * cb + r16;
                bf16x8 qf[2]; qf[0] = qn[0]; qf[1] = qn[1];
                if (rp < 15) { const bf16_t* q1 = qbuf + (size_t)(qrow + 128) * D + h * 64 + 8 * g4; qn[0] = *(const bf16x8*)q1; qn[1] = *(const bf16x8*)(q1 + 32); }
                f32x4 O[4]; float m_run = NINF, sum = 0.f;
#pragma unroll
                for (int mt = 0; mt < 4; ++mt) O[mt] = (f32x4){0.f, 0.f, 0.f, 0.f};
                na_seg2<true>(L, qf, r16, g4, 0, band, boff, 0, voff, O, m_run, sum);
#pragma unroll
                for (int mt = 0; mt < 4; ++mt) { u32x2 o; o.x = pk2(O[mt][0], O[mt][1]); o.y = pk2(O[mt][2], O[mt][3]); *(u32x2*)(cat + (size_t)qrow * D + h * 64 + 16 * mt + 4 * g4) = o; }
                if (g4 == 0) mlbuf[(size_t)qrow * 16 + h] = (f32x2){m_run, sum};
            }
        }
        __syncthreads();
        asm volatile("s_waitcnt vmcnt(0)" ::: "memory");
        for (int i = F.tid; i < 15 * 32; i += NTHREADS) { const int ri = i >> 5, ci = i & 31; ((LAS float*)(L + NA_RPB))[i] = ci < 31 ? a.in[23][h * 465 + ri * 31 + ci] * 1.4426950408889634f : NINF; }
        for (int gr = 0; gr < 9; ++gr) { const size_t g = (size_t)(b * SEQ + gr * 64 + pkey) * D + h * 64 + pch * 8;
            *(LAS u32x4*)(L + NA_VR + na_voff(gr * 64 + pkey, pch)) = *(const u32x4*)(vbuf + g); *(LAS u32x4*)(L + NA_KR + na_koff(gr * 64 + pkey, pch)) = *(const u32x4*)(kbuf + g); }
        for (int rp = 0; rp < 16; ++rp) {
            int R0 = 2 * rp - 4; R0 = R0 < 0 ? 0 : (R0 > 24 ? 24 : R0);
            int R0n = 2 * rp - 2; R0n = R0n < 0 ? 0 : (R0n > 24 ? 24 : R0n);
            const bool newrows = (rp < 15) && (R0n != R0);
            u32x4 nv0 = (u32x4){0u, 0u, 0u, 0u}, nv1 = nv0, nk0 = nv0, nk1 = nv0;
            if (newrows) { const size_t g0 = (size_t)(b * SEQ + (R0 + 9) * 64 + pkey) * D + h * 64 + pch * 8; nv0 = *(const u32x4*)(vbuf + g0); nk0 = *(const u32x4*)(kbuf + g0);
                if (R0 + 10 < 32) { const size_t g1 = g0 + (size_t)64 * D; nv1 = *(const u32x4*)(vbuf + g1); nk1 = *(const u32x4*)(kbuf + g1); } }
            const int r = 2 * rp + rr; int r0 = r - 4; r0 = r0 < 0 ? 0 : (r0 > 24 ? 24 : r0);
            const int qrow = b * SEQ + r * 64 + 16 * cb + r16;
            bf16x8 qf[2];
#pragma unroll
            for (int ks = 0; ks < 2; ++ks) qf[ks] = *(const bf16x8*)(qbuf + (size_t)qrow * D + h * 64 + 32 * ks + 8 * g4);
            f32x4 O[4]; float m_run, sum;
#pragma unroll
            for (int mt = 0; mt < 4; ++mt) { const u32x2 o = *(const u32x2*)(cat + (size_t)qrow * D + h * 64 + 16 * mt + 4 * g4); O[mt] = (f32x4){bflo(o.x), bfhi(o.x), bflo(o.y), bfhi(o.y)}; }
            { const f32x2 ml = mlbuf[(size_t)qrow * 16 + h]; m_run = ml.x; sum = ml.y; }
            lds_barrier();
            const int rbase = NA_RPB + (r0 - r + 7) * 128;
            na_seg2<false>(L, qf, r16, g4, r0, band, boff, rbase, voff, O, m_run, sum);
            const float inv = 1.0f / sum;
#pragma unroll
            for (int mt = 0; mt < 4; ++mt) { u32x2 o; o.x = pk2(O[mt][0] * inv, O[mt][1] * inv); o.y = pk2(O[mt][2] * inv, O[mt][3] * inv);
                *(u32x2*)(cat + (size_t)qrow * D + h * 64 + 16 * mt + 4 * g4) = o; }
            if (newrows) {
                lds_barrier();
                *(LAS u32x4*)(L + NA_VR + na_voff(((R0 + 9) % NA_RING) * 64 + pkey, pch)) = nv0; *(LAS u32x4*)(L + NA_KR + na_koff(((R0 + 9) % NA_RING) * 64 + pkey, pch)) = nk0;
                *(LAS u32x4*)(L + NA_VR + na_voff(((R0 + 10) % NA_RING) * 64 + pkey, pch)) = nv1; *(LAS u32x4*)(L + NA_KR + na_koff(((R0 + 10) % NA_RING) * 64 + pkey, pch)) = nk1; }
        }
    }
    __syncthreads();
}

#if MK_ONE_LAUNCH
#define GRID_BAR() xcd_barrier(bar)
#else
#define GRID_BAR() do { } while (0)
#endif
#define IN(k) (lo <= (k) && (k) < hi && (k) <= MK_LAST_PHASE)
#define SEAM(k) do { if (IN(k) && IN((k) + 1)) GRID_BAR(); } while (0)
template <int LAYER>
__device__ __forceinline__ void layer_tail(const Frame& F, const Args& args, const int lo, const int hi, const XcdBarrier& bar) {
    unsigned char* ws = args.ws;
    const float* modx = (const float*)(ws + WS_MODX); const float* modc = (const float*)(ws + WS_MODC);
    float* xw = (float*)(ws + WS_XW); float* xwc = (float*)(ws + WS_XW + (size_t)NX * D * 2); bf16_t* Hb = (bf16_t*)(ws + WS_H);
    constexpr int mb = LAYER ? 16 : 7; constexpr int ntok = LAYER ? NX : NT;
    const float* lmodx = modx + (size_t)LAYER * 16 * ADA; const float* lmodc = modc + (size_t)LAYER * ADA;
    if (IN(LAYER ? 14 : 5)) REPEAT_IF(LAYER ? 14 : 5) { REP_BAR();
        SchedDense S{(const char*)(ws + T_CAT), (const char*)(ws + (LAYER ? WS_WOUT1 : WS_WOUT0)), D, ntok / 256, D / 256, 0, 1, 0, F.G, (int)blockIdx.x};
        EpiBf16 E{(bf16_t*)(ws + T_Y), D, 0, 0};
        pg8::gemm_phase<EpiBf16, SchedDense, true>(F.lds, D, S, E);
        if (LAYER == 0 && F.G == 256 && (int)blockIdx.x >= 64) cvt_moe_range(F, args, 0, F0_BULK + F0_P2, F0_BULK + F0_P2 + F0_P5, (int)blockIdx.x - 64, 192);
    }
    SEAM(LAYER ? 14 : 5);
    if (IN(LAYER ? 15 : 6)) REPEAT_IF(LAYER ? 15 : 6) { REP_BAR();
        RowPhase P{}; P.xin_lat = LAYER ? xw : args.in[0]; P.xin_ctx = LAYER ? xwc : args.in[2]; P.xin16 = LAYER != 0; P.xout_lat = xw; P.xout_ctx = xwc; P.xout16 = true; P.nrows = ntok; P.ysrc = 1; P.y = (const bf16_t*)(ws + T_Y);
        P.gpost = args.in[7] + LAYER * D; P.modx = lmodx; P.modc = lmodc; P.gate_chunk = 2;
        P.doH = true; P.H = Hb; P.gpre = args.in[8] + LAYER * D; P.sc_chunk = 4; P.sh_chunk = 3; P.modxH = lmodx; P.modcH = lmodc;
        row_phase(F, P);
    }
    SEAM(LAYER ? 15 : 6);
    if (IN(mb)) REPEAT_IF(mb) { REP_BAR();
        SchedDense S{(const char*)Hb, (const char*)(ws + WS_WR) + (size_t)LAYER * NEXP * D * 2, D, ntok / 256, 1, 0, 1, 0, F.G, (int)blockIdx.x};
        EpiRouter E{args.in[25] + LAYER * NEXP, (int*)(ws + M_AE), (int*)(ws + M_AR), (float*)(ws + M_AG), F.ctl + CW_CNT + LAYER * 256, (int*)(ws + M_LST)};
        pg8::gemm_phase<EpiRouter, SchedDense, false>(F.lds, D, S, E);
        if (F.G != 256) { } else if (LAYER == 0) { if ((int)blockIdx.x >= 144) cvt_moe_range(F, args, 0, F0_BULK + F0_P2 + F0_P5, MOE_CVT_ITEMS, (int)blockIdx.x - 144, 112); }
        else { if ((int)blockIdx.x >= 128) { const int ntr0 = (int)__hip_atomic_load(F.ctl + CW_TST + 256, __ATOMIC_RELAXED, __HIP_MEMORY_SCOPE_AGENT); int s9, s10; fill1_ranges(F, ntr0, s9, s10);
                cvt_moe_range(F, args, 1, s9 + s10, MOE_CVT_ITEMS - F1_P12, (int)blockIdx.x - 128, 128); } }
    }
    if (IN(mb) && IN(mb + 2)) GRID_BAR();
    if (IN(mb + 2)) REPEAT_IF(mb + 2) { REP_BAR();
        const int nj = moe_units_setup<2>(F, LAYER, ntok, F.vcu, true);
        SchedMoeGU S{(const char*)Hb, (const char*)(ws + WS_WGU + (size_t)LAYER * WGU_BYTES), (const LAS int*)(F.lds + AUX_TILEE), (const LAS int*)(F.lds + AUX_IDX), nj, F.G, F.vcu};
        EpiGateUp E{(bf16_t*)(ws + M_HID)};
        pg8::gemm_phase<EpiGateUp, SchedMoeGU, true>(F.lds, D, S, E);
        if (LAYER == 0) { const int ntr0 = ((const LAS int*)(F.lds + AUX_TST))[256]; int s9, s10; fill1_ranges(F, ntr0, s9, s10); const int nu = (ntr0 + NT / 256) * 2, hv = nu % F.G;
            if (hv && F.vcu >= hv) cvt_moe_range(F, args, 1, 0, s9, F.vcu - hv, F.G - hv); }
    }
    SEAM(mb + 2);
    if (IN(mb + 3)) REPEAT_IF(mb + 3) { REP_BAR();
        const int nj = moe_units_setup<4>(F, LAYER, ntok, F.vcu, false);
        SchedMoeDN S{(const char*)(ws + M_HID), (const char*)(ws + WS_WDN + (size_t)LAYER * WDN_BYTES), (const LAS int*)(F.lds + AUX_TILEE), nj, F.G, F.vcu};
        EpiF8 E{(unsigned char*)(ws + M_OUT)};
        pg8::gemm_phase<EpiF8, SchedMoeDN, true>(F.lds, DEXP, S, E);
        if (LAYER == 0) { const int ntr0 = ((const LAS int*)(F.lds + AUX_TST))[256]; int s9, s10; fill1_ranges(F, ntr0, s9, s10); const int nu = (ntr0 + NT / 256) * 4, hv = nu % F.G;
            if (hv && F.vcu >= hv) cvt_moe_range(F, args, 1, s9, s9 + s10, F.vcu - hv, F.G - hv); }
    }
    SEAM(mb + 3);
    if (IN(mb + 4)) REPEAT_IF(mb + 4) { REP_BAR();
        RowPhase P{}; P.xin_lat = xw; P.xin_ctx = xwc; P.xin16 = true; P.xout_lat = LAYER ? args.out : xw; P.xout_ctx = xwc; P.xout16 = LAYER == 0; P.nrows = ntok; P.ysrc = 2;
        P.mo8 = (const unsigned char*)(ws + M_OUT); P.tslot = (const int*)(ws + M_TS); P.tgate = (const float*)(ws + M_AG); P.sharedbase = (int)__hip_atomic_load(F.ctl + CW_TST + LAYER * 320 + 256, __ATOMIC_RELAXED, __HIP_MEMORY_SCOPE_AGENT) * 256;
        P.gpost = args.in[9] + LAYER * D; P.modx = lmodx; P.modc = lmodc; P.gate_chunk = 5;
        P.doH = LAYER == 0; P.H = Hb; P.gpre = args.in[6] + D; P.sc_chunk = 1; P.sh_chunk = 0; P.modxH = modx + (size_t)16 * ADA; P.modcH = modc + ADA;
        row_phase(F, P);
        if (LAYER == 0) {
            const int ntr0 = (int)__hip_atomic_load(F.ctl + CW_TST + 256, __ATOMIC_RELAXED, __HIP_MEMORY_SCOPE_AGENT); int s9, s10; fill1_ranges(F, ntr0, s9, s10);
            if (F.G != 256) cvt_moe_range(F, args, 1, 0, MOE_CVT_ITEMS, F.vcu, F.G);
        }
    }
    SEAM(mb + 4);
}

__global__ void __launch_bounds__(NTHREADS, 2) mk_fwd(Args args) {
    extern __shared__ __attribute__((aligned(16))) unsigned char lds_raw[];
    Frame F;
    F.lds = (LAS unsigned char*)lds_raw; F.MISC = (volatile LAS unsigned*)(F.lds + MISC_OFF);
    F.tid = threadIdx.x; F.lane = F.tid & 63; F.wave = __builtin_amdgcn_readfirstlane(F.tid >> 6);
    F.G = gridDim.x; { const int bx = blockIdx.x; F.vcu = (F.G % 8 == 0) ? (bx % 8) * (F.G / 8) + bx / 8 : bx; }
    F.ws = args.ws; F.ctl = (unsigned*)(args.ws + WS_CTL);
    for (int u = F.tid; u < (LDS_BYTES - MISC_OFF) / 4; u += NTHREADS) ((LAS unsigned*)(F.lds + MISC_OFF))[u] = 0u;
    __syncthreads();
    XcdBarrier bar; bar.bar = F.ctl + CW_BAR; bar.x = 0; bar.st = nullptr;
#if MK_ONE_LAUNCH
    bar = xcd_barrier_post(F.ctl + CW_BAR, F.MISC + 8);
#endif
    const int lo = args.ph_lo, hi = args.ph_hi;
    unsigned char* ws = args.ws;
    const float* modx = (const float*)(ws + WS_MODX); const float* modc = (const float*)(ws + WS_MODC);
    float* xw = (float*)(ws + WS_XW); bf16_t* Hb = (bf16_t*)(ws + WS_H);

    if (IN(0)) REPEAT_IF(0) { REP_BAR(); p0_ada(F, args); p0_convert(F, args); }
    SEAM(0);
    {
        if (IN(1)) REPEAT_IF(1) { REP_BAR();
            RowPhase P{}; P.xin_lat = args.in[0]; P.xin_ctx = args.in[2]; P.nrows = NT; P.ysrc = 0; P.modx = modx; P.modc = modc;
            P.doH = true; P.H = Hb; P.gpre = args.in[6]; P.sc_chunk = 1; P.sh_chunk = 0; P.modxH = modx; P.modcH = modc;
            row_phase(F, P);
        }
        SEAM(1);
        if (IN(2)) REPEAT_IF(2) { REP_BAR();
            SchedDense S{(const char*)Hb, (const char*)(ws + WS_WIN0), D, NT / 256, AB_INP / 256, 0, 1, 0, F.G, (int)blockIdx.x};
            EpiInproj E{(bf16_t*)(ws + T_QB), (bf16_t*)(ws + T_KB), (bf16_t*)(ws + T_VB), (bf16_t*)(ws + T_GB), (bf16_t*)(ws + T_UB), (float*)(ws + T_LR), (const f32x2*)(ws + WS_ROPE)};
            pg8::gemm_phase<EpiInproj, SchedDense, true>(F.lds, D, S, E);
            if (F.G == 256 && (int)blockIdx.x >= 48) cvt_moe_range(F, args, 0, F0_BULK, F0_BULK + F0_P2, (int)blockIdx.x - 48, 208);
        }
        SEAM(2);
        if (IN(3)) REPEAT_IF(3) { REP_BAR(); gla_prep_phase(F, args); }
        if (IN(3) && IN(22)) GRID_BAR();
        if (IN(22)) REPEAT_IF(22) { REP_BAR(); gla_seq_phase(F, args); }
        if (IN(22) && IN(4)) GRID_BAR();
        if (IN(4)) REPEAT_IF(4) { REP_BAR(); finish_conv_phase(F, args); }
        SEAM(4);

    }
    layer_tail<0>(F, args, lo, hi, bar);
    {
        if (IN(12)) REPEAT_IF(12) { REP_BAR();
            SchedDense S{(const char*)Hb, (const char*)(ws + WS_WQKV1), D, NX / 256, 12, NC / 256, 8, 4, F.G, (int)blockIdx.x};
            EpiBf16 E{(bf16_t*)(ws + T_QKV), D, D, (size_t)NT * D, 0.125f * 1.4426950408889634f};
            pg8::gemm_phase<EpiBf16, SchedDense, true>(F.lds, D, S, E);
            if (F.G == 256 && (int)blockIdx.x >= 128) cvt_moe_range(F, args, 1, MOE_CVT_ITEMS - F1_P12, MOE_CVT_ITEMS, (int)blockIdx.x - 128, 128);
        }
        SEAM(12);
        if (IN(13)) REPEAT_IF(13) { REP_BAR(); na_phase(F, args); }
        SEAM(13);

    }
    layer_tail<1>(F, args, lo, hi, bar);

#undef IN
#undef SEAM
}

extern "C" void kernel_launch(void* const* d_in, const int* in_sizes, int n_in, void* d_out, int out_size, void* d_ws, size_t ws_size, hipStream_t stream) {
    static int grid = 0;
    if (grid == 0) {
        if (n_in != 32 || out_size != NX * D || ws_size < WS_END) { fprintf(stderr, "kernel_launch: unexpected problem (n_in %d, out %d, ws %zu < %zu)\n", n_in, out_size, ws_size, (size_t)WS_END); grid = -1; return; }
        int dev = 0, cus = 0, per_cu = 0;
        if (hipGetDevice(&dev) != hipSuccess || hipDeviceGetAttribute(&cus, hipDeviceAttributeMultiprocessorCount, dev) != hipSuccess) { grid = -1; return; }
        if (hipFuncSetAttribute((const void*)mk_fwd, hipFuncAttributeMaxDynamicSharedMemorySize, LDS_BYTES) != hipSuccess) { fprintf(stderr, "kernel_launch: hipFuncSetAttribute failed\n"); grid = -1; return; }
        if (hipOccupancyMaxActiveBlocksPerMultiprocessor(&per_cu, (const void*)mk_fwd, NTHREADS, LDS_BYTES) != hipSuccess || per_cu < 1) fprintf(stderr, "kernel_launch: occupancy query says %d\n", per_cu);
        (void)hipGetLastError();
        grid = cus;
    }
    if (grid < 0) return;
    (void)hipMemsetAsync((char*)d_ws + WS_CTL, 0, CTL_BYTES, stream);
    Args a{};
    for (int i = 0; i < 32; ++i) a.in[i] = (const float*)d_in[i];
    a.out = (float*)d_out; a.ws = (unsigned char*)d_ws;
#if MK_ONE_LAUNCH
    a.ph_lo = 0; a.ph_hi = 64;
    hipLaunchKernelGGL(mk_fwd, dim3(grid), dim3(NTHREADS), LDS_BYTES, stream, a);
#else
    for (int p = 0; p <= 20; ++p) { if (p > MK_LAST_PHASE) break; a.ph_lo = p; a.ph_hi = p + 1; hipLaunchKernelGGL(mk_fwd, dim3(grid), dim3(NTHREADS), LDS_BYTES, stream, a); }
#endif
}
```

```cpp
#include <hip/hip_runtime.h>
#include <cstdio>
#include <cstdint>

#ifndef MK_ONE_LAUNCH
#define MK_ONE_LAUNCH 1
#endif
#ifndef MK_LAST_PHASE
#define MK_LAST_PHASE 99
#endif

#ifndef MK_REP
#define MK_REP (-1)
#endif
#define REPEAT_IF(k) _Pragma("unroll") for (int _r = 0; _r < ((k) == MK_REP ? 2 : 1); ++_r)
#define REP_BAR() do { if (_r) GRID_BAR(); } while (0)

#define GAS __attribute__((address_space(1)))
#define LAS __attribute__((address_space(3)))
typedef unsigned short bf16_t;
typedef short bf16x8 __attribute__((ext_vector_type(8)));
typedef float f32x4 __attribute__((ext_vector_type(4)));
typedef float f32x2 __attribute__((ext_vector_type(2)));
typedef unsigned u32x4 __attribute__((ext_vector_type(4)));
typedef unsigned u32x2 __attribute__((ext_vector_type(2)));

constexpr int D = 1024, BATCH = 16, SEQ = 2048, CTXL = 256, GRIDW = 64;
constexpr int NX = BATCH * SEQ, NC = BATCH * CTXL, NT = NX + NC;
constexpr int ADA = 6 * D;
constexpr int GLA_H = 4, GLA_DK = 64, GLA_DV = 128, GLA_QK = 256, GLA_V = 512, CONV_CH = 512, CONV_W = 31;
constexpr int AB_IN = 2592, AB_INP = 2816;
constexpr int NA_H = 16, NA_DH = 64;
constexpr int NEXP = 256, TOPK = 8, DEXP = 256;
constexpr int NEXPS = NEXP + 1;
constexpr int PMAX = NT * TOPK + NEXP * 255 + NT;
static_assert(PMAX % 256 == 0, "PMAX");
constexpr float RMS_EPS = 1e-6f, LN_EPS = 1e-5f;
constexpr float F8_SCALE = 16.0f, F8_INV = 1.0f / 16.0f;

constexpr size_t MiB = 1u << 20;
constexpr size_t al(size_t x) { return (x + 4095) & ~(size_t)4095; }
constexpr size_t WS_CTL = 0, CTL_BYTES = 1 * MiB;
constexpr size_t WS_MODX = WS_CTL + CTL_BYTES;
constexpr size_t WS_MODC = WS_MODX + al((size_t)2 * 16 * ADA * 4);
constexpr size_t WS_ROPE = WS_MODC + al((size_t)2 * ADA * 4);
constexpr size_t WS_XW = WS_ROPE + al(64 * 16 * 8);
constexpr size_t M_LST = WS_XW + al((size_t)NT * D * 2);
constexpr int LCAP = NT;
static_assert(M_LST + (size_t)NEXP * LCAP * 4 <= WS_XW + al((size_t)NT * D * 4), "token lists");
constexpr size_t WS_H = WS_XW + al((size_t)NT * D * 4);
constexpr size_t WS_WIN0 = WS_H + al((size_t)NT * D * 2);
constexpr size_t WS_WOUT0 = WS_WIN0 + al((size_t)AB_INP * D * 2);
constexpr size_t WS_WQKV1 = WS_WOUT0 + al((size_t)D * D * 2);
constexpr size_t WS_WOUT1 = WS_WQKV1 + al((size_t)3 * D * D * 2);
constexpr size_t WS_WR = WS_WOUT1 + al((size_t)D * D * 2);
constexpr size_t WGU_BYTES = al((size_t)NEXPS * 512 * D * 2), WDN_BYTES = al((size_t)NEXPS * D * 256 * 2);
constexpr size_t WS_WGU = WS_WR + al((size_t)2 * NEXP * D * 2);
constexpr size_t WS_WDN = WS_WGU + 2 * WGU_BYTES;
constexpr size_t WS_T = WS_WDN + 2 * WDN_BYTES;
constexpr size_t T_QB = WS_T;
constexpr size_t T_KB = T_QB + al((size_t)NT * 256 * 2);
constexpr size_t T_VB = T_KB + al((size_t)NT * 256 * 2);
constexpr size_t T_GB = T_VB + al((size_t)NT * 512 * 2);
constexpr size_t T_UB = T_GB + al((size_t)NT * 512 * 2);
constexpr size_t T_LR = T_UB + al((size_t)NT * 512 * 2);
constexpr size_t T_OF = T_LR + al((size_t)NT * 32 * 4);
constexpr size_t T_OB = T_OF + al((size_t)NT * 512 * 2);
constexpr size_t T_CAT = T_OB + al((size_t)NT * 512 * 2);
constexpr size_t T_Y = T_CAT + al((size_t)NT * D * 2);
constexpr size_t T_GLA = T_Y + al((size_t)NT * D * 2);
constexpr int GI_A = 0, GI_QIN = 8192, GI_KOT = 16384, GI_VT = 24576, GI_DEC = 40960, GI_BYTES = 41216;
constexpr size_t T_END0 = T_GLA + al((size_t)BATCH * GLA_H * 2 * 36 * GI_BYTES + 1024);
constexpr size_t T_QKV = WS_T;
static_assert(T_QKV + (size_t)3 * NT * D * 2 <= T_CAT, "qkv overlay");
constexpr size_t M_AE = WS_T;
constexpr size_t M_AR = M_AE + al((size_t)NT * 8 * 4);
constexpr size_t M_AG = M_AR + al((size_t)NT * 8 * 4);
constexpr size_t M_TS = M_AG + al((size_t)NT * 8 * 4);
constexpr size_t M_ST = M_TS + al((size_t)NT * 8 * 4);
constexpr size_t M_HID = M_ST + al((size_t)PMAX * 4);
constexpr size_t M_OUT = M_HID + al((size_t)PMAX * 256 * 2);
constexpr int MO_LD = 1024;
constexpr size_t M_END = M_OUT + al((size_t)PMAX * D);
constexpr size_t WS_END = (M_END > T_END0 ? M_END : T_END0);
static_assert(WS_END <= (size_t)2040 * MiB, "workspace map must fit 2 GiB");

constexpr int CW_BAR = 4096;
constexpr int CW_CNT = 16384;
constexpr int CW_CUR = 16384 + 512;

constexpr int RING_BYTES = 131072;
constexpr int AUX_OFF = RING_BYTES, AUX_BYTES = 31744;
constexpr int MISC_OFF = AUX_OFF + AUX_BYTES;
constexpr int LDS_BYTES = MISC_OFF + 1024;
constexpr int NWAVES = 8, NTHREADS = 512;

#define LDS_WAIT() asm volatile("s_waitcnt lgkmcnt(0)" ::: "memory")
#define VM_WAIT() asm volatile("s_waitcnt vmcnt(0)" ::: "memory")

__device__ __forceinline__ unsigned f2bf(float f) { unsigned u = __builtin_bit_cast(unsigned, f); return (u + 0x7fffu + ((u >> 16) & 1u)) >> 16; }
__device__ __forceinline__ unsigned pk2(float lo, float hi) { return f2bf(lo) | (f2bf(hi) << 16); }
__device__ __forceinline__ float bf2f(unsigned short b) { return __builtin_bit_cast(float, (unsigned)b << 16); }
__device__ __forceinline__ float bflo(unsigned w) { return __builtin_bit_cast(float, w << 16); }
__device__ __forceinline__ float bfhi(unsigned w) { return __builtin_bit_cast(float, w & 0xffff0000u); }
__device__ __forceinline__ float wave_sum(float v) {
#pragma unroll
    for (int o = 1; o < 64; o <<= 1) v += __shfl_xor(v, o);
    return v;
}
__device__ __forceinline__ float sigmoidf_(float x) { return 1.0f / (1.0f + __expf(-x)); }
__device__ __forceinline__ float siluf_(float x) { return x / (1.0f + __expf(-x)); }

__device__ __forceinline__ void lds_barrier() { asm volatile("s_waitcnt lgkmcnt(0)" ::: "memory"); __builtin_amdgcn_s_barrier(); asm volatile("" ::: "memory"); }
#define XB_TMO      128
#define XB_XCNT(j)  (256  + 64 * (j))
#define XB_XSUB(j)  (1280 + 64 * (j))
#define XB_XGEN(j)  (2304 + 64 * (j))
#define XB_TOP      3328
#define XB_TOPGEN   3392
#define XCD_BAR_WORDS 3456
#define XB_SPIN_CAP (1u << 18)

__device__ __forceinline__ unsigned xb_ld(unsigned* p)              { return __hip_atomic_load(p, __ATOMIC_RELAXED, __HIP_MEMORY_SCOPE_AGENT); }
__device__ __forceinline__ unsigned xb_add(unsigned* p, unsigned v) { return __hip_atomic_fetch_add(p, v, __ATOMIC_RELAXED, __HIP_MEMORY_SCOPE_AGENT); }
__device__ __forceinline__ unsigned xb_xcc_id() { return (unsigned)__builtin_amdgcn_s_getreg((3 << 11) | 20) & 0xFu; }
#define XB_SPIN(cond, bar) do { unsigned _sp = 0; while (cond) { __builtin_amdgcn_s_sleep(1); \
    if ((++_sp & 255u) == 0u) { if (xb_ld(&(bar)[XB_TMO])) break; if (_sp > XB_SPIN_CAP) { atomicAdd(&(bar)[XB_TMO], 1u); break; } } } } while (0)

struct XcdBarrier { unsigned* bar; unsigned x; volatile LAS unsigned* st; };

__device__ __forceinline__ XcdBarrier xcd_barrier_post(unsigned* bar, volatile LAS unsigned* st) {
    XcdBarrier b; b.bar = bar; b.x = xb_xcc_id(); b.st = st;
    if (threadIdx.x == 0) (void)xb_add(&bar[XB_XCNT(b.x)], 1u);
    return b;
}
__device__ __forceinline__ void xcd_barrier_complete(unsigned* bar, unsigned x, unsigned& nloc, unsigned& nx) {
    const unsigned G = gridDim.x * gridDim.y * gridDim.z;
    unsigned sum, cnt, mine, sp = 0u;
    for (;;) {
        sum = 0u; cnt = 0u; mine = 0u;
#pragma unroll
        for (unsigned j = 0; j < 16; ++j) { const unsigned c = xb_ld(&bar[XB_XCNT(j)]); sum += c; cnt += (c > 0u) ? 1u : 0u; mine = (j == x) ? c : mine; }
        if (sum == G) break;
        __builtin_amdgcn_s_sleep(1);
        if ((++sp & 255u) == 0u) { if (xb_ld(&bar[XB_TMO])) break; if (sp > XB_SPIN_CAP) { atomicAdd(&bar[XB_TMO], 1u); break; } }
    }
    nloc = mine > 0u ? mine : 1u; nx = cnt > 0u ? cnt : 1u;
}
__device__ __forceinline__ void xcd_barrier(const XcdBarrier& b) {
    asm volatile("s_waitcnt vmcnt(0)" ::: "memory");
    __syncthreads();
    if (threadIdx.x == 0) {
        unsigned* bar = b.bar;
        __builtin_amdgcn_s_waitcnt(0);
        unsigned nloc = b.st[0], nx = b.st[1];
        if (nloc == 0u) { xcd_barrier_complete(bar, b.x, nloc, nx); b.st[0] = nloc; b.st[1] = nx; }
        const unsigned old = xb_add(&bar[XB_XSUB(b.x)], 1u);
        const unsigned gen = old / nloc;
        if (old + 1u == (gen + 1u) * nloc) {
            __builtin_amdgcn_fence(__ATOMIC_RELEASE, "agent");
            asm volatile("s_waitcnt vmcnt(0)" ::: "memory");
            const unsigned og = xb_add(&bar[XB_TOP], 1u);
            const unsigned tg = og / nx;
            if (og + 1u == (tg + 1u) * nx) xb_add(&bar[XB_TOPGEN], 1u);
            else XB_SPIN(xb_ld(&bar[XB_TOPGEN]) == tg, bar);
            __builtin_amdgcn_fence(__ATOMIC_ACQUIRE, "agent");
            xb_add(&bar[XB_XGEN(b.x)], 1u);
            asm volatile("s_waitcnt vmcnt(0)" ::: "memory");
        } else {
            XB_SPIN(xb_ld(&bar[XB_XGEN(b.x)]) == gen, bar);
            __builtin_amdgcn_fence(__ATOMIC_ACQUIRE, "agent");
            asm volatile("s_waitcnt vmcnt(0)" ::: "memory");
        }
    }
    __syncthreads();
}

namespace pg8 {
constexpr int BM = 256, BK = 64, HALF = 128, HTB = HALF * BK * 2, STAGE_BYTES = 8 * HTB, NXCD = 8, WGM = 8;
__host__ __device__ __forceinline__ int lds_byte(int r, int c) { const int st = (r >> 4) * 2 + (c >> 5), rr = r & 15, cc = c & 31, ob = rr * 64 + cc * 2; return st * 1024 + (ob ^ (((ob >> 9) & 1) << 5)); }
__host__ __device__ __forceinline__ void stage_rc(int b, int& R, int& C) { const int st = b / 1024, sb = b % 1024, swz = sb ^ (((sb >> 9) & 1) << 5); R = (st >> 1) * 16 + swz / 64; C = (st & 1) * 32 + (swz % 64) / 2; }
__host__ __device__ __forceinline__ int perm32(int rho) { const int n = rho >> 4, i = rho & 15; return 8 * (i >> 2) + 4 * n + (i & 3); }

struct Unit { int a, b, orow, ocol, aux; };

__device__ __forceinline__ bool static_order(int L, int nM, int nN, int& pm, int& pn) {
    const int nwg = nM * nN; if (L >= nwg) return false;
    int wgid = L; { const int q = nwg / NXCD, r = nwg % NXCD, xcd = wgid % NXCD, off = wgid / NXCD; wgid = (xcd < r ? xcd * (q + 1) : r * (q + 1) + (xcd - r) * q) + off; }
    const int nig = WGM * nN, gid = wgid / nig, fm = gid * WGM, gsz = (nM - fm) < WGM ? (nM - fm) : WGM;
    pm = fm + ((wgid % nig) % gsz); pn = (wgid % nig) / gsz; return true;
}

template <class Epi, class Sched, bool ALIGN_EPI>
__device__ __forceinline__ void gemm_phase(LAS unsigned char* lds, const int K, const Sched& S, const Epi& E) {
    const int tid = threadIdx.x, wid = __builtin_amdgcn_readfirstlane(tid >> 6), lane = tid & 63, wr = wid >> 2, wc = wid & 3, fr = lane & 15, fq = lane >> 4;
    const int nt = K / BK;
    int Rr[2], Cc[2]; unsigned voffB[2];
#pragma unroll
    for (int i = 0; i < 2; ++i) { int R, C; stage_rc(tid * 16 + i * 8192, R, C); Rr[i] = R; Cc[i] = C; const int Rb = Epi::PERM ? ((R & ~31) + perm32(R & 31)) : R; voffB[i] = (unsigned)(Rb * K + C) * 2u; }
    const size_t kstep = (size_t)(BK * 2);
    const size_t hstepB = (size_t)HALF * K * 2;
    const unsigned ldsw = (unsigned)wid * 1024u;
    const int aoff = lds_byte(wr * 64 + fr, fq * 8), boff = lds_byte(wc * 32 + fr, fq * 8);
#define PG8_SA(b, h) (((b) * 2 + (h)) * HTB)
#define PG8_SB(b, h) ((4 + (b) * 2 + (h)) * HTB)
#define PG8_STAGE(bufoff, gbase, voff) do { _Pragma("unroll") for (int _i = 0; _i < 2; ++_i) \
        __builtin_amdgcn_global_load_lds((const unsigned*)((const char*)(gbase) + (voff)[_i]), (LAS unsigned*)(lds + (bufoff) + ldsw + _i * 8192), 16, 0, 0); } while (0)
#define PG8_LDA(dst, b, h) do { _Pragma("unroll") for (int m = 0; m < 4; ++m) _Pragma("unroll") for (int k = 0; k < 2; ++k) dst[m][k] = *(const LAS bf16x8*)(lds + PG8_SA(b, h) + aoff + m * 2048 + k * 1024); } while (0)
#define PG8_LDB(dst, b, h) do { _Pragma("unroll") for (int n = 0; n < 2; ++n) _Pragma("unroll") for (int k = 0; k < 2; ++k) dst[n][k] = *(const LAS bf16x8*)(lds + PG8_SB(b, h) + boff + n * 2048 + k * 1024); } while (0)
#define PG8_MMA(ai, bj, At, Bt) do { __builtin_amdgcn_s_setprio(1); _Pragma("unroll") for (int m = 0; m < 4; ++m) _Pragma("unroll") for (int n = 0; n < 2; ++n) _Pragma("unroll") for (int k = 0; k < 2; ++k) \
        acc[ai][bj][m][n] = __builtin_amdgcn_mfma_f32_16x16x32_bf16(Bt[n][k], At[m][k], acc[ai][bj][m][n], 0, 0, 0); __builtin_amdgcn_s_setprio(0); } while (0)
#define PG8_WAIT_V(n) asm volatile("s_waitcnt vmcnt(" #n ")" ::: "memory")
#define PG8_WAIT_L(n) asm volatile("s_waitcnt lgkmcnt(" #n ")" ::: "memory")
#define PG8_BAR __builtin_amdgcn_s_barrier()
#define PG8_SCHED __builtin_amdgcn_sched_barrier(0)
    Unit cur, nxt; int ui = 0;
    if (!S.next(0, cur)) return;
    f32x4 acc[2][2][4][2];
#pragma unroll
    for (int a = 0; a < 2; ++a)
#pragma unroll
        for (int b = 0; b < 2; ++b)
#pragma unroll
            for (int m = 0; m < 4; ++m)
#pragma unroll
                for (int n = 0; n < 2; ++n) acc[a][b][m][n] = (f32x4){0.f, 0.f, 0.f, 0.f};
    bf16x8 At[4][2], B0[2][2], B1[2][2];
    unsigned co0[2], co1[2], no0[2], no1[2];
    S.a_off(cur, Rr, Cc, co0, co1);
    const char* const Ab = S.a_base();
    const char* cB = S.b_ptr(cur);
    PG8_STAGE(PG8_SB(0, 0), cB, voffB); PG8_STAGE(PG8_SB(0, 1), cB + hstepB, voffB); PG8_STAGE(PG8_SA(0, 0), Ab, co0); PG8_STAGE(PG8_SA(0, 1), Ab, co1);
    if (wr == 1) PG8_BAR;
    PG8_WAIT_V(2); PG8_BAR;
    PG8_STAGE(PG8_SB(1, 0), cB + kstep, voffB); PG8_STAGE(PG8_SA(1, 0), Ab + kstep, co0); PG8_STAGE(PG8_SB(1, 1), cB + hstepB + kstep, voffB);
    PG8_WAIT_V(6); PG8_BAR;
    for (;;) {
        const bool has_next = S.next(ui + 1, nxt);
        const char* nB = has_next ? S.b_ptr(nxt) : cB;
#pragma nounroll
        for (int t = 0; t < nt; t += 2) {
            const bool last = (t == nt - 2);
            if (last) { if (has_next) S.a_off(nxt, Rr, Cc, no0, no1); else { no0[0] = co0[0]; no0[1] = co0[1]; no1[0] = co1[0]; no1[1] = co1[1]; } }
            const char* a1 = Ab + (size_t)(t + 1) * kstep;
            const char* a2 = last ? Ab : Ab + (size_t)(t + 2) * kstep; const char* b2 = last ? nB : cB + (size_t)(t + 2) * kstep;
            const char* a3 = a2 + kstep; const char* b3 = b2 + kstep;
            unsigned x0[2], x1[2];
            x0[0] = last ? no0[0] : co0[0]; x0[1] = last ? no0[1] : co0[1]; x1[0] = last ? no1[0] : co1[0]; x1[1] = last ? no1[1] : co1[1];
            PG8_LDB(B0, 0, 0); PG8_LDB(B1, 0, 1); PG8_SCHED; PG8_LDA(At, 0, 0); PG8_STAGE(PG8_SA(1, 1), a1, co1);
            PG8_WAIT_V(8); PG8_WAIT_L(0); PG8_BAR; PG8_MMA(0, 0, At, B0); PG8_MMA(0, 1, At, B1); PG8_BAR; PG8_SCHED;
            PG8_LDA(At, 0, 1); PG8_STAGE(PG8_SB(0, 0), b2, voffB); PG8_STAGE(PG8_SB(0, 1), b2 + hstepB, voffB); PG8_STAGE(PG8_SA(0, 0), a2, x0);
            PG8_WAIT_V(8); PG8_WAIT_L(0); PG8_BAR; PG8_MMA(1, 0, At, B0); PG8_MMA(1, 1, At, B1); PG8_BAR; PG8_SCHED;
            PG8_LDB(B0, 1, 0); PG8_LDB(B1, 1, 1); PG8_SCHED; PG8_LDA(At, 1, 0); PG8_STAGE(PG8_SA(0, 1), a2, x1);
            PG8_WAIT_V(8); PG8_WAIT_L(0); PG8_BAR; PG8_MMA(0, 0, At, B0); PG8_MMA(0, 1, At, B1); PG8_BAR; PG8_SCHED;
            PG8_LDA(At, 1, 1); PG8_STAGE(PG8_SB(1, 0), b3, voffB); PG8_STAGE(PG8_SB(1, 1), b3 + hstepB, voffB); PG8_STAGE(PG8_SA(1, 0), a3, x0);
            PG8_WAIT_V(8); PG8_WAIT_L(0); PG8_BAR; PG8_MMA(1, 0, At, B0); PG8_MMA(1, 1, At, B1); PG8_BAR; PG8_SCHED;
        }
        if constexpr (ALIGN_EPI) { if (wr == 0) PG8_BAR; }
        if constexpr (!Epi::AFTER_DRAIN) { E(acc, cur, wr, wc, fr, fq); }
        if (!has_next) break;
#pragma unroll
        for (int a = 0; a < 2; ++a)
#pragma unroll
            for (int b = 0; b < 2; ++b)
#pragma unroll
                for (int m = 0; m < 4; ++m)
#pragma unroll
                    for (int n = 0; n < 2; ++n) acc[a][b][m][n] = (f32x4){0.f, 0.f, 0.f, 0.f};
        cur = nxt; cB = nB; co0[0] = no0[0]; co0[1] = no0[1]; co1[0] = no1[0]; co1[1] = no1[1]; ++ui;
        if constexpr (ALIGN_EPI) { if (wr == 1) PG8_BAR; }
    }
    PG8_WAIT_V(0);
    if constexpr (!ALIGN_EPI) { if (wr == 0) PG8_BAR; }
    PG8_BAR;
    if constexpr (Epi::AFTER_DRAIN) { E.fused(acc, cur, wr, wc, fr, fq, lds, wid, lane); }
#undef PG8_SA
#undef PG8_SB
#undef PG8_STAGE
#undef PG8_LDA
#undef PG8_LDB
#undef PG8_MMA
#undef PG8_WAIT_V
#undef PG8_WAIT_L
#undef PG8_BAR
#undef PG8_SCHED
}
}
using pg8::Unit;

__device__ __forceinline__ unsigned cvt_pk_bf16(float lo, float hi) { unsigned r; asm volatile("v_cvt_pk_bf16_f32 %0, %1, %2" : "=v"(r) : "v"(lo), "v"(hi)); return r; }

struct SchedDense {
    const char* A; const char* Bt; int K; int nM0, nN0, nM1, nN1, pn1off; int G, c;
    __device__ __forceinline__ bool next(int i, Unit& u) const {
        const int L = i * G + c; int pm, pn;
        const int n0 = nM0 * nN0;
        if (L < n0) { pg8::static_order(L, nM0, nN0, pm, pn); }
        else { if (!pg8::static_order(L - n0, nM1, nN1, pm, pn)) return false; pm += nM0; pn += pn1off; }
        u.a = pm; u.b = pn * 256; u.orow = pm * 256; u.ocol = pn * 256; u.aux = pn; return true;
    }
    __device__ __forceinline__ const char* a_base() const { return A; }
    __device__ __forceinline__ const char* b_ptr(const Unit& u) const { return Bt + (size_t)u.b * K * 2; }
    __device__ __forceinline__ void a_off(const Unit& u, const int (&R)[2], const int (&C)[2], unsigned (&o0)[2], unsigned (&o1)[2]) const {
#pragma unroll
        for (int i = 0; i < 2; ++i) { o0[i] = (unsigned)((u.a * 256 + R[i]) * K + C[i]) * 2u; o1[i] = o0[i] + (unsigned)(128 * K * 2); }
    }
};

struct EpiBf16 {
    static constexpr bool PERM = true, AFTER_DRAIN = false;
    bf16_t* O; int ldc; int split_cols; size_t split_stride; float scale0 = 1.0f;
    __device__ __forceinline__ void operator()(const f32x4 (&acc)[2][2][4][2], const Unit& u, int wr, int wc, int fr, int fq) const {
        const int lane = fr + 16 * fq; const int srcb = ((lane >> 2) + 16 * (lane & 3)) << 2;
        const int row0 = u.orow + wr * 64 + (lane >> 2); int colt = u.ocol; bf16_t* base = O;
        float sc = 1.0f;
        if (split_cols) { const int t = colt / split_cols; base += (size_t)t * split_stride; colt -= t * split_cols; if (t == 0) sc = scale0; }
        const int col0 = colt + wc * 32 + 8 * (lane & 3);
#pragma unroll
        for (int ai = 0; ai < 2; ++ai)
#pragma unroll
            for (int m = 0; m < 4; ++m) { bf16_t* rowp = base + (size_t)(row0 + ai * 128 + m * 16) * ldc + col0;
#pragma unroll
                for (int bj = 0; bj < 2; ++bj) { const f32x4 v0 = acc[ai][bj][m][0] * sc, v1 = acc[ai][bj][m][1] * sc;
                    u32x4 w; w.x = cvt_pk_bf16(v0[0], v0[1]); w.y = cvt_pk_bf16(v0[2], v0[3]); w.z = cvt_pk_bf16(v1[0], v1[1]); w.w = cvt_pk_bf16(v1[2], v1[3]);
                    u32x4 t; t.x = (unsigned)__builtin_amdgcn_ds_bpermute(srcb, (int)w.x); t.y = (unsigned)__builtin_amdgcn_ds_bpermute(srcb, (int)w.y); t.z = (unsigned)__builtin_amdgcn_ds_bpermute(srcb, (int)w.z); t.w = (unsigned)__builtin_amdgcn_ds_bpermute(srcb, (int)w.w);
                    *(u32x4*)(rowp + bj * 128) = t; } }
    }
};
struct EpiF8 {
    static constexpr bool PERM = true, AFTER_DRAIN = false;
    unsigned char* O;
    __device__ __forceinline__ int nst(const Unit&, int) const { return 16; }
    __device__ __forceinline__ void operator()(const f32x4 (&acc)[2][2][4][2], const Unit& u, int wr, int wc, int fr, int fq) const {
        const int lane = fr + 16 * fq; const int srcb = ((lane >> 2) + 16 * (lane & 3)) << 2;
        const int row0 = u.orow + wr * 64 + (lane >> 2), col0 = u.ocol + wc * 32 + 8 * (lane & 3);
#pragma unroll
        for (int ai = 0; ai < 2; ++ai)
#pragma unroll
            for (int m = 0; m < 4; ++m) { unsigned char* rowp = O + (size_t)(row0 + ai * 128 + m * 16) * D + col0;
#pragma unroll
                for (int bj = 0; bj < 2; ++bj) { const f32x4 v0 = acc[ai][bj][m][0] * F8_SCALE, v1 = acc[ai][bj][m][1] * F8_SCALE;
                    int w0 = __builtin_amdgcn_cvt_pk_fp8_f32(v0[0], v0[1], 0, false); w0 = __builtin_amdgcn_cvt_pk_fp8_f32(v0[2], v0[3], w0, true);
                    int w1 = __builtin_amdgcn_cvt_pk_fp8_f32(v1[0], v1[1], 0, false); w1 = __builtin_amdgcn_cvt_pk_fp8_f32(v1[2], v1[3], w1, true);
                    u32x2 t; t.x = (unsigned)__builtin_amdgcn_ds_bpermute(srcb, w0); t.y = (unsigned)__builtin_amdgcn_ds_bpermute(srcb, w1);
                    *(u32x2*)(rowp + bj * 128) = t; } }
    }
};
struct EpiInproj {
    static constexpr bool PERM = false, AFTER_DRAIN = false;
    bf16_t *qb, *kb, *vb, *gb, *ub; float* lr; const f32x2* rope;
    __device__ __forceinline__ void operator()(const f32x4 (&acc)[2][2][4][2], const Unit& u, int wr, int wc, int fr, int fq) const {
        const int pn = u.aux; const int row0 = u.orow + wr * 64 + fr;
        if (pn <= 1) {
            bf16_t* dst = pn == 0 ? qb : kb; const float sc = pn == 0 ? 0.125f : 1.0f;
#pragma unroll
            for (int ai = 0; ai < 2; ++ai)
#pragma unroll
                for (int m = 0; m < 4; ++m) {
                    const int row = row0 + ai * 128 + m * 16; const bool lat = row < NX;
                    const int s = row & (SEQ - 1); const int pos = (wc & 1) ? (s & 63) : (s >> 6);
                    f32x2 cs[4];
                    if (lat) {
#pragma unroll
                        for (int e = 0; e < 4; ++e) cs[e] = rope[pos * 16 + 4 * fq + e];
                    } else {
#pragma unroll
                        for (int e = 0; e < 4; ++e) cs[e] = (f32x2){1.f, 0.f};
                    }
#pragma unroll
                    for (int bj = 0; bj < 2; ++bj) {
                        const f32x4 u1 = acc[ai][bj][m][0], u2 = acc[ai][bj][m][1]; f32x4 o1, o2;
#pragma unroll
                        for (int e = 0; e < 4; ++e) { o1[e] = (u1[e] * cs[e].x - u2[e] * cs[e].y) * sc; o2[e] = (u1[e] * cs[e].y + u2[e] * cs[e].x) * sc; }
                        bf16_t* p = dst + (size_t)row * 256 + bj * 128 + wc * 32 + 4 * fq;
                        u32x2 w1, w2; w1.x = cvt_pk_bf16(o1[0], o1[1]); w1.y = cvt_pk_bf16(o1[2], o1[3]); w2.x = cvt_pk_bf16(o2[0], o2[1]); w2.y = cvt_pk_bf16(o2[2], o2[3]);
                        *(u32x2*)p = w1; *(u32x2*)(p + 16) = w2;
                    }
                }
        } else if (pn <= 5) {
            bf16_t* dst = pn <= 3 ? vb : gb; const int cb = (pn & 1) ? 256 : 0;
#pragma unroll
            for (int ai = 0; ai < 2; ++ai)
#pragma unroll
                for (int m = 0; m < 4; ++m) { const int row = row0 + ai * 128 + m * 16;
#pragma unroll
                    for (int bj = 0; bj < 2; ++bj)
#pragma unroll
                        for (int n = 0; n < 2; ++n) { const f32x4 v = acc[ai][bj][m][n]; u32x2 w; w.x = cvt_pk_bf16(v[0], v[1]); w.y = cvt_pk_bf16(v[2], v[3]);
                            *(u32x2*)(dst + (size_t)row * 512 + cb + bj * 128 + wc * 32 + n * 16 + 4 * fq) = w; } }
        } else if (pn <= 9) {
            const int cb = (pn - 6) * 128;
#pragma unroll
            for (int ai = 0; ai < 2; ++ai)
#pragma unroll
                for (int m = 0; m < 4; ++m) { const int row = row0 + ai * 128 + m * 16;
#pragma unroll
                    for (int n = 0; n < 2; ++n) { const f32x4 a = acc[ai][0][m][n], b = acc[ai][1][m][n]; f32x4 o;
#pragma unroll
                        for (int e = 0; e < 4; ++e) o[e] = a[e] * sigmoidf_(b[e]);
                        u32x2 w; w.x = cvt_pk_bf16(o[0], o[1]); w.y = cvt_pk_bf16(o[2], o[3]);
                        *(u32x2*)(ub + (size_t)row * 512 + cb + wc * 32 + n * 16 + 4 * fq) = w; } }
        } else {
            if (wc == 0) {
#pragma unroll
                for (int ai = 0; ai < 2; ++ai)
#pragma unroll
                    for (int m = 0; m < 4; ++m) { const int row = row0 + ai * 128 + m * 16;
#pragma unroll
                        for (int n = 0; n < 2; ++n) *(f32x4*)(lr + (size_t)row * 32 + n * 16 + 4 * fq) = acc[ai][0][m][n]; }
            }
        }
    }
};

struct Args { const float* in[32]; float* out; unsigned char* ws; int ph_lo, ph_hi; };

struct Frame {
    LAS unsigned char* lds; volatile LAS unsigned* MISC; unsigned* ctl; unsigned char* ws;
    int tid, lane, wave, G, vcu;
};

__device__ __forceinline__ void cvt_item(const float* __restrict__ src, int ld, int col0, int ncols, int k0, bf16_t* dst, int ldd, int drow0, LAS unsigned* T, int lane) {
    const bool okc = lane < ncols;
    const float* p = src + (size_t)k0 * ld + col0 + (okc ? lane : 0);
    float v[64];
#pragma unroll
    for (int k = 0; k < 64; ++k) v[k] = __builtin_nontemporal_load(p + (size_t)k * ld);
#pragma unroll
    for (int kp = 0; kp < 32; ++kp) T[lane * 33 + kp] = okc ? pk2(v[2 * kp], v[2 * kp + 1]) : 0u;
    LDS_WAIT(); asm volatile("" ::: "memory");
    const int c = lane & 7;
#pragma unroll
    for (int it = 0; it < 8; ++it) { const int n = (lane >> 3) + 8 * it;
        u32x4 o; o.x = T[n * 33 + 4 * c]; o.y = T[n * 33 + 4 * c + 1]; o.z = T[n * 33 + 4 * c + 2]; o.w = T[n * 33 + 4 * c + 3];
        if (n < ncols) __builtin_nontemporal_store(o, (u32x4*)(dst + (size_t)(drow0 + n) * ldd + k0 + 8 * c)); }
    LDS_WAIT(); asm volatile("" ::: "memory");
}
__device__ __forceinline__ void cvt_matrix_item(const float* src, int ld, int col0, int ncols, int K, bf16_t* dst, int drow0, int item, LAS unsigned* T, int lane) {
    const int ncg = (ncols + 63) >> 6; const int kt = item / ncg, cg = item - kt * ncg;
    const int nc = ncols - cg * 64 < 64 ? ncols - cg * 64 : 64;
    cvt_item(src, ld, col0 + cg * 64, nc, kt * 64, dst, K, drow0 + cg * 64, T, lane);
}

constexpr int MOE_CVT_ITEMS = NEXPS * 192;
__device__ __forceinline__ void cvt_moe_item(const Args& a, int layer, int item, unsigned char* ws, LAS unsigned* T, int lane) {
    const int e = item / 192, r = item - e * 192;
    bf16_t* wgu = (bf16_t*)(ws + WS_WGU + (size_t)layer * WGU_BYTES) + (size_t)e * 512 * D; bf16_t* wdn = (bf16_t*)(ws + WS_WDN + (size_t)layer * WDN_BYTES) + (size_t)e * D * 256;
    if (r < 128) {
        const int kt = r >> 3, gi = r & 7; const int up = gi >> 2, g4 = gi & 3;
        const float* src = e < NEXP ? (up ? a.in[27] : a.in[26]) + ((size_t)layer * NEXP + e) * D * DEXP : (up ? a.in[30] : a.in[29]) + (size_t)layer * D * DEXP;
        cvt_item(src, DEXP, 64 * g4, 64, kt * 64, wgu, D, 256 * (g4 >> 1) + 64 * (g4 & 1) + 128 * up, T, lane);
    } else {
        const int q = r - 128; const int kt = q >> 4, cg = q & 15;
        const float* src = e < NEXP ? a.in[28] + ((size_t)layer * NEXP + e) * DEXP * D : a.in[31] + (size_t)layer * DEXP * D;
        cvt_item(src, D, 64 * cg, 64, kt * 64, wdn, DEXP, 64 * cg, T, lane);
    }
}

__device__ __forceinline__ float row_rms_scale(const f32x4 (&v)[4]) {
    float s = 0.f;
#pragma unroll
    for (int j = 0; j < 4; ++j) s += (v[j].x * v[j].x + v[j].y * v[j].y) + (v[j].z * v[j].z + v[j].w * v[j].w);
    return rsqrtf(wave_sum(s) * (1.0f / D) + RMS_EPS);
}
__device__ __forceinline__ f32x4 ld4(const float* p) { return *(const f32x4*)p; }

struct RowPhase {
    const float* xin_lat; const float* xin_ctx;
    float* xout_lat; float* xout_ctx;
    bool xin16, xout16;
    int nrows;
    int ysrc; const bf16_t* y;
    const unsigned char* mo8; const int* tslot; const float* tgate; int sharedbase;
    const float* gpost; const float* modx; const float* modc; int gate_chunk;
    bool doH; bf16_t* H; const float* gpre; int sc_chunk, sh_chunk; const float* modxH; const float* modcH;
};
__device__ __forceinline__ void row_phase(const Frame& F, const RowPhase& P) {
    const int gw = F.vcu * NWAVES + F.wave, NGW = F.G * NWAVES, lane = F.lane;
    for (int row = gw; row < P.nrows; row += NGW) {
        const bool lat = row < NX; const int b = lat ? (row >> 11) : 0;
        const float* mod = lat ? P.modx + (size_t)b * ADA : P.modc;
        const float* xr = lat ? P.xin_lat + (size_t)row * D : P.xin_ctx + (size_t)(row - NX) * D;
        f32x4 x[4];
        if (P.xin16) { const bf16_t* xr16 = (lat ? (const bf16_t*)P.xin_lat + (size_t)row * D : (const bf16_t*)P.xin_ctx + (size_t)(row - NX) * D);
#pragma unroll
            for (int j = 0; j < 4; ++j) { const u32x2 w = *(const u32x2*)(xr16 + 4 * lane + 256 * j); x[j] = (f32x4){bflo(w.x), bfhi(w.x), bflo(w.y), bfhi(w.y)}; }
        } else {
#pragma unroll
            for (int j = 0; j < 4; ++j) x[j] = ld4(xr + 4 * lane + 256 * j);
        }
        if (P.ysrc) {
            f32x4 y[4];
            if (P.ysrc == 1) {
#pragma unroll
                for (int j = 0; j < 4; ++j) { const u32x2 w = __builtin_nontemporal_load((const u32x2*)(P.y + (size_t)row * D + 4 * lane + 256 * j)); y[j] = (f32x4){bflo(w.x), bfhi(w.x), bflo(w.y), bfhi(w.y)}; }
            } else {
#pragma unroll
                for (int j = 0; j < 4; ++j) { const int w = __builtin_nontemporal_load((const int*)(P.mo8 + (size_t)(P.sharedbase + row) * D + 4 * lane + 256 * j)); const f32x2 lo = __builtin_amdgcn_cvt_pk_f32_fp8(w, false), hi = __builtin_amdgcn_cvt_pk_f32_fp8(w, true); y[j] = (f32x4){lo.x, lo.y, hi.x, hi.y} * F8_INV; }
#pragma unroll
                for (int k = 0; k < TOPK; ++k) { const int sl = P.tslot[(size_t)row * 8 + k]; const float g = P.tgate[(size_t)row * 8 + k] * F8_INV;
#pragma unroll
                    for (int j = 0; j < 4; ++j) { const int w = __builtin_nontemporal_load((const int*)(P.mo8 + (size_t)sl * D + 4 * lane + 256 * j)); const f32x2 lo = __builtin_amdgcn_cvt_pk_f32_fp8(w, false), hi = __builtin_amdgcn_cvt_pk_f32_fp8(w, true);
                        y[j].x += g * lo.x; y[j].y += g * lo.y; y[j].z += g * hi.x; y[j].w += g * hi.y; } }
            }
            const float rs = row_rms_scale(y);
#pragma unroll
            for (int j = 0; j < 4; ++j) { const f32x4 gp = ld4(P.gpost + 4 * lane + 256 * j), gt = ld4(mod + P.gate_chunk * D + 4 * lane + 256 * j); x[j] = x[j] + gt * (y[j] * rs * gp); }
            if (P.xout16) { bf16_t* xo16 = lat ? (bf16_t*)P.xout_lat + (size_t)row * D : (bf16_t*)P.xout_ctx + (size_t)(row - NX) * D;
#pragma unroll
                for (int j = 0; j < 4; ++j) { u32x2 w; w.x = pk2(x[j].x, x[j].y); w.y = pk2(x[j].z, x[j].w); *(u32x2*)(xo16 + 4 * lane + 256 * j) = w; }
            } else { float* xo = lat ? P.xout_lat + (size_t)row * D : P.xout_ctx + (size_t)(row - NX) * D;
#pragma unroll
                for (int j = 0; j < 4; ++j) *(f32x4*)(xo + 4 * lane + 256 * j) = x[j]; }
        }
        if (P.doH) {
            const float rs = row_rms_scale(x); const float* modh = lat ? P.modxH + (size_t)b * ADA : P.modcH;
#pragma unroll
            for (int j = 0; j < 4; ++j) { const f32x4 gp = ld4(P.gpre + 4 * lane + 256 * j), sc = ld4(modh + P.sc_chunk * D + 4 * lane + 256 * j), sh = ld4(modh + P.sh_chunk * D + 4 * lane + 256 * j);
                const f32x4 h = x[j] * rs * gp * (sc + 1.0f) + sh; u32x2 w; w.x = pk2(h.x, h.y); w.y = pk2(h.z, h.w);
                *(u32x2*)(P.H + (size_t)row * D + 4 * lane + 256 * j) = w; }
        }
    }
}


constexpr int FILL_PER_WAVE_S = 3;
constexpr int F0_P2 = 208 * 8 * FILL_PER_WAVE_S, F0_P5 = 192 * 8 * FILL_PER_WAVE_S, F0_P7 = MOE_CVT_ITEMS - F0_P2 - F0_P5;
constexpr int F0_BULK = MOE_CVT_ITEMS - F0_P2 - F0_P5 - F0_P7;
static_assert(F0_BULK >= 0, "fill plan");
constexpr int F1_P12 = 128 * 8 * FILL_PER_WAVE_S;
__device__ __forceinline__ void cvt_moe_range(const Frame& F, const Args& a, int layer, int lo, int hi, int rank, int nranks) {
    LAS unsigned* T = (LAS unsigned*)F.lds + F.wave * (64 * 33);
    for (int it = lo + rank * NWAVES + F.wave; it < hi; it += nranks * NWAVES) cvt_moe_item(a, layer, it, F.ws, T, F.lane);
}
__device__ __forceinline__ void fill1_ranges(const Frame& F, int ntr0, int& s9, int& s10) {
    const int nu9 = (ntr0 + NT / 256) * 2, nu10 = (ntr0 + NT / 256) * 4;
    const int l9 = (nu9 % F.G) ? F.G - nu9 % F.G : 0, l10 = (nu10 % F.G) ? F.G - nu10 % F.G : 0;
    s9 = l9 * NWAVES * FILL_PER_WAVE_S; s10 = l10 * NWAVES * (FILL_PER_WAVE_S / 3);
    if (F.G != 256) { s9 = 0; s10 = 0; }
}

__device__ __forceinline__ void p0_ada(const Frame& F, const Args& a) {
    LAS float* sc = (LAS float*)F.lds;
    if ((int)blockIdx.x >= 192) return;
    for (int i = F.tid; i < 17 * D; i += NTHREADS) { const int r = i >> 10, k = i & 1023; const float v = r < 16 ? a.in[1][r * D + k] : a.in[3][k]; sc[i] = siluf_(v); }
    __syncthreads();
    const int item = blockIdx.x; const int layer = item / 96, cg = item % 96;
    const int cq = F.tid & 15, kl = F.tid >> 4;
    const float* W = a.in[4] + (size_t)layer * D * ADA + cg * 64 + cq * 4;
    f32x4 acc[17];
#pragma unroll
    for (int r = 0; r < 17; ++r) acc[r] = (f32x4){0.f, 0.f, 0.f, 0.f};
    for (int k0 = kl; k0 < D; k0 += 32 * 8) {
        f32x4 w[8];
#pragma unroll
        for (int j = 0; j < 8; ++j) w[j] = ld4(W + (size_t)(k0 + 32 * j) * ADA);
#pragma unroll
        for (int j = 0; j < 8; ++j) {
#pragma unroll
            for (int r = 0; r < 17; ++r) { const float s = sc[r * D + k0 + 32 * j]; acc[r] = acc[r] + w[j] * s; } }
    }
#pragma unroll
    for (int r = 0; r < 17; ++r) {
#pragma unroll
        for (int o = 16; o <= 32; o <<= 1) { acc[r].x += __shfl_xor(acc[r].x, o); acc[r].y += __shfl_xor(acc[r].y, o); acc[r].z += __shfl_xor(acc[r].z, o); acc[r].w += __shfl_xor(acc[r].w, o); } }
    __syncthreads();
    LAS f32x4* red = (LAS f32x4*)F.lds;
    if (F.lane < 16) {
#pragma unroll
        for (int r = 0; r < 17; ++r) red[(F.wave * 17 + r) * 16 + cq] = acc[r];
    }
    __syncthreads();
    for (int i = F.tid; i < 17 * 16; i += NTHREADS) { const int r = i >> 4, q = i & 15; f32x4 s = red[r * 16 + q];
#pragma unroll
        for (int w = 1; w < 8; ++w) s = s + red[(w * 17 + r) * 16 + q];
        const int col = cg * 64 + q * 4; s = s + ld4(a.in[5] + (size_t)layer * ADA + col);
        float* dst = r < 16 ? (float*)(F.ws + WS_MODX) + ((size_t)layer * 16 + r) * ADA + col : (float*)(F.ws + WS_MODC) + (size_t)layer * ADA + col;
        *(f32x4*)dst = s; }
    __syncthreads();
}

__device__ __forceinline__ void p0_convert(const Frame& F, const Args& a) {
    LAS unsigned* T = (LAS unsigned*)(F.lds + 70 * 1024) + F.wave * (64 * 33);
    const int gw = F.vcu * NWAVES + F.wave, NGW = F.G * NWAVES, lane = F.lane;
    bf16_t* win0 = (bf16_t*)(F.ws + WS_WIN0); bf16_t* wout0 = (bf16_t*)(F.ws + WS_WOUT0); bf16_t* wqkv1 = (bf16_t*)(F.ws + WS_WQKV1); bf16_t* wout1 = (bf16_t*)(F.ws + WS_WOUT1); bf16_t* wr = (bf16_t*)(F.ws + WS_WR);
    constexpr int I_IN = 16 * (4 + 4 + 8 + 8 + 1 + 16);
    constexpr int I_SQ = 16 * 16, I_QKV = 16 * 48, I_R = 16 * 4;
    constexpr int NIT = I_IN + I_SQ + I_QKV + I_SQ + 2 * I_R;
    const int nbulk0 = F.G == 256 ? F0_BULK : MOE_CVT_ITEMS;
    for (int it = gw; it < NIT + nbulk0; it += NGW) {
        int r = it;
        if (r < I_IN) {
            const int kt = r & 15, g = r >> 4; int col0, nc = 64, drow;
            if (g < 24) { col0 = 64 * g; drow = 64 * g; }
            else if (g == 24) { col0 = 1536; nc = 32; drow = 2560; }
            else { const int s = g - 25; const int isb = s >> 3, q = s & 7;
                col0 = 1568 + 512 * isb + 64 * q; drow = 1536 + 256 * (q >> 1) + 128 * isb + 64 * (q & 1); }
            cvt_item(a.in[10], AB_IN, col0, nc, kt * 64, win0, D, drow, T, lane); continue; }
        r -= I_IN;
        if (r < I_SQ) { cvt_matrix_item(a.in[11], D, 0, D, D, wout0, 0, r, T, lane); continue; } r -= I_SQ;
        if (r < I_QKV) { cvt_matrix_item(a.in[21], 3 * D, 0, 3 * D, D, wqkv1, 0, r, T, lane); continue; } r -= I_QKV;
        if (r < I_SQ) { cvt_matrix_item(a.in[22], D, 0, D, D, wout1, 0, r, T, lane); continue; } r -= I_SQ;
        if (r < 2 * I_R) { const int l = r / I_R; cvt_matrix_item(a.in[24] + (size_t)l * D * NEXP, NEXP, 0, NEXP, D, wr + (size_t)l * NEXP * D, 0, r % I_R, T, lane); continue; } r -= 2 * I_R;
        cvt_moe_item(a, 0, r, F.ws, T, lane);
    }
    { u32x4 z = (u32x4){0u, 0u, 0u, 0u}; const size_t n16 = (size_t)(AB_INP - AB_IN) * D * 2 / 16; u32x4* p = (u32x4*)(win0 + (size_t)AB_IN * D);
      for (size_t i = (size_t)blockIdx.x * NTHREADS + F.tid; i < n16; i += (size_t)F.G * NTHREADS) p[i] = z; }
    if (blockIdx.x == 0) { f32x2* rt = (f32x2*)(F.ws + WS_ROPE);
        for (int i = F.tid; i < 64 * 16; i += NTHREADS) { const int pos = i >> 4, f = i & 15; const float inv = powf(10000.0f, -(float)f / 16.0f); const float ang = (float)pos * inv; rt[i] = (f32x2){cosf(ang), sinf(ang)}; } }
}


__device__ __forceinline__ int gsw(int row, int ch) { return row * 128 + ((ch ^ (row & 7)) << 4); }
__device__ __forceinline__ int gla_row(int n, int p, int b, int d) {
    const bool isctx = n < 4; const int j = isctx ? n : n - 4; int pos = j * 64 + p;
    if (d) pos = (isctx ? CTXL : SEQ) - 1 - pos;
    return isctx ? NX + b * CTXL + pos : b * SEQ + pos;
}
struct GlaRaw { u32x4 q, k, v0, v1; f32x4 lr[4]; };
__device__ __forceinline__ void gla_load(GlaRaw& R, int n, int lane, int w, int b, int h, int d, const bf16_t* qb, const bf16_t* kb, const bf16_t* vb, const float* lr) {
    const int row = gla_row(n, lane, b, d);
    R.q = *(const u32x4*)(qb + (size_t)row * 256 + h * 64 + 8 * w);
    R.k = *(const u32x4*)(kb + (size_t)row * 256 + h * 64 + 8 * w);
    R.v0 = *(const u32x4*)(vb + (size_t)row * 512 + h * 128 + 8 * w);
    R.v1 = *(const u32x4*)(vb + (size_t)row * 512 + h * 128 + 64 + 8 * w);
#pragma unroll
    for (int i = 0; i < 4; ++i) R.lr[i] = *(const f32x4*)(lr + (size_t)row * 32 + d * 16 + 4 * i);
}
__device__ __forceinline__ void unpack8(const u32x4& w, float (&f)[8]) { f[0] = bflo(w.x); f[1] = bfhi(w.x); f[2] = bflo(w.y); f[3] = bfhi(w.y); f[4] = bflo(w.z); f[5] = bfhi(w.z); f[6] = bflo(w.w); f[7] = bfhi(w.w); }
constexpr int GPL_QE = 0, GPL_KE = 8192, GPL_OUT = 16384, GPL_BUF = 16384 + GI_BYTES + 256, GPL_DW = 2 * GPL_BUF, GPL_DB = GPL_DW + 4096, GPL_END = GPL_DB + 256;
static_assert(GPL_END <= RING_BYTES && (GPL_BUF % 16) == 0, "gla prep lds");
__device__ __forceinline__ void gla_prep_phase(const Frame& F, const Args& a) {
    LAS unsigned char* L = F.lds; const int lane = F.lane, w = F.wave, r16 = lane & 15, g4 = lane >> 4;
    const bf16_t* qb = (const bf16_t*)(F.ws + T_QB); const bf16_t* kb = (const bf16_t*)(F.ws + T_KB); const bf16_t* vb = (const bf16_t*)(F.ws + T_VB); const float* lrb = (const float*)(F.ws + T_LR);
    for (int cc = blockIdx.x; cc < 256; cc += F.G) {
        const int sq = cc & 127, b = sq >> 3, h = (sq >> 1) & 3, d = sq & 1;
        const float* dw = d ? a.in[14] : a.in[12]; const float* db = d ? a.in[15] : a.in[13];
        __syncthreads();
        for (int i = F.tid; i < 16 * 64; i += NTHREADS) ((LAS float*)(L + GPL_DW))[i] = dw[(i >> 6) * GLA_QK + h * 64 + (i & 63)];
        if (F.tid < 64) ((LAS float*)(L + GPL_DB))[F.tid] = db[h * 64 + F.tid];
        GlaRaw R; gla_load(R, cc >> 7, lane, w, b, h, d, qb, kb, vb, lrb);
        __syncthreads();
        for (int k = 0; k < 18; ++k) {
            const int n = (cc >> 7) + 2 * k;
            LAS unsigned char* PB = L + (k & 1) * GPL_BUF; LAS unsigned char* OUT = PB + GPL_OUT;
            {
                float z[8], q[8], kk[8], v0[8], v1[8];
                unpack8(R.q, q); unpack8(R.k, kk); unpack8(R.v0, v0); unpack8(R.v1, v1);
                const LAS float* DW = (const LAS float*)(L + GPL_DW); const LAS float* DB = (const LAS float*)(L + GPL_DB);
#pragma unroll
                for (int j = 0; j < 8; ++j) z[j] = DB[8 * w + j];
#pragma unroll
                for (int r = 0; r < 16; ++r) { const float x = R.lr[r >> 2][r & 3]; const f32x4 w0 = *(const LAS f32x4*)(DW + r * 64 + 8 * w), w1 = *(const LAS f32x4*)(DW + r * 64 + 8 * w + 4);
                    z[0] += x * w0.x; z[1] += x * w0.y; z[2] += x * w0.z; z[3] += x * w0.w; z[4] += x * w1.x; z[5] += x * w1.y; z[6] += x * w1.z; z[7] += x * w1.w; }
                float qe[8], ke[8], qi[8]; unsigned short ko[8]; float ld[8];
#pragma unroll
                for (int j = 0; j < 8; ++j) ld[j] = (fminf(z[j], 0.f) - __logf(1.0f + __expf(-fabsf(z[j])))) * (1.0f / 16.0f);
#pragma unroll
                for (int o = 1; o < 64; o <<= 1) { float t[8];
#pragma unroll
                    for (int j = 0; j < 8; ++j) t[j] = __shfl_up(ld[j], o);
#pragma unroll
                    for (int j = 0; j < 8; ++j) ld[j] += (lane >= o) ? t[j] : 0.f; }
                float decv = 0.f;
#pragma unroll
                for (int j = 0; j < 8; ++j) {
                    const float bm = __builtin_bit_cast(float, __builtin_amdgcn_readlane(__builtin_bit_cast(int, ld[j]), 31)), bl = __builtin_bit_cast(float, __builtin_amdgcn_readlane(__builtin_bit_cast(int, ld[j]), 63));
                    const float e1 = __expf(ld[j] - bm), e2 = __expf(bm - ld[j]);
                    qe[j] = q[j] * e1; ke[j] = kk[j] * e2; qi[j] = q[j] * __expf(ld[j]); ko[j] = (unsigned short)f2bf(kk[j] * __expf(bl - ld[j]));
                    decv = (lane == j) ? __expf(bl) : decv;
                }
                if (lane < 8) ((LAS float*)(OUT + GI_DEC))[8 * w + lane] = decv;
                *(LAS u32x4*)(PB + GPL_QE + gsw(lane, w)) = (u32x4){pk2(qe[0], qe[1]), pk2(qe[2], qe[3]), pk2(qe[4], qe[5]), pk2(qe[6], qe[7])};
                *(LAS u32x4*)(PB + GPL_KE + gsw(lane, w)) = (u32x4){pk2(ke[0], ke[1]), pk2(ke[2], ke[3]), pk2(ke[4], ke[5]), pk2(ke[6], ke[7])};
                *(LAS u32x4*)(OUT + GI_QIN + gsw(lane, w)) = (u32x4){pk2(qi[0], qi[1]), pk2(qi[2], qi[3]), pk2(qi[4], qi[5]), pk2(qi[6], qi[7])};
#pragma unroll
                for (int j = 0; j < 8; ++j) { const int rw = 8 * w + j;
                    *(LAS unsigned short*)(OUT + GI_KOT + gsw(rw, lane >> 3) + (lane & 7) * 2) = ko[j];
                    *(LAS unsigned short*)(OUT + GI_VT + gsw(rw, lane >> 3) + (lane & 7) * 2) = (unsigned short)f2bf(v0[j]);
                    *(LAS unsigned short*)(OUT + GI_VT + gsw(64 + rw, lane >> 3) + (lane & 7) * 2) = (unsigned short)f2bf(v1[j]); }
            }
            if (k + 1 < 18) gla_load(R, n + 2, lane, w, b, h, d, qb, kb, vb, lrb);
            lds_barrier();
#pragma unroll
            for (int i = 0; i < 2; ++i) { const int tI = 2 * w + i, st = tI >> 2, pt = tI & 3;
                f32x4 c = (f32x4){0.f, 0.f, 0.f, 0.f};
                if (st <= pt) {
#pragma unroll
                    for (int ks = 0; ks < 2; ++ks) { const bf16x8 af = *(const LAS bf16x8*)(PB + GPL_KE + gsw(16 * st + r16, 4 * ks + g4)), bfr = *(const LAS bf16x8*)(PB + GPL_QE + gsw(16 * pt + r16, 4 * ks + g4));
                        c = __builtin_amdgcn_mfma_f32_16x16x32_bf16(af, bfr, c, 0, 0, 0); }
                    const int p = 16 * pt + r16, s0 = 16 * st + 4 * g4;
#pragma unroll
                    for (int e = 0; e < 4; ++e) if (s0 + e > p) c[e] = 0.f;
                }
                u32x2 o; o.x = pk2(c[0], c[1]); o.y = pk2(c[2], c[3]);
                *(LAS u32x2*)(OUT + GI_A + gsw(16 * pt + r16, 2 * st + (g4 >> 1)) + (g4 & 1) * 8) = o; }
            lds_barrier();
            { unsigned char* rec = F.ws + T_GLA + (size_t)(sq * 36 + n) * GI_BYTES;
              for (int i = F.tid; i < GI_BYTES / 16; i += NTHREADS) *(u32x4*)(rec + i * 16) = *(const LAS u32x4*)(OUT + i * 16); }
        }
    }
    __syncthreads();
}
constexpr int GSL_IN = 33792  , GSL_ST = 3 * GSL_IN, GSL_END = GSL_ST + 2 * 8192;
static_assert(GSL_END <= RING_BYTES, "gla seq lds");
__device__ __forceinline__ void gla_seq_phase(const Frame& F, const Args& a) {
    LAS unsigned char* L = F.lds; const int lane = F.lane, w = F.wave, r16 = lane & 15, g4 = lane >> 4, tid = F.tid;
    for (int it = blockIdx.x; it < 256; it += F.G) {
        const int sq = it >> 1, vh = it & 1, b = sq >> 3, h = (sq >> 1) & 3, d = sq & 1;
        bf16_t* ob = (bf16_t*)(F.ws + (d ? T_OB : T_OF));
        const unsigned char* rec0 = F.ws + T_GLA + (size_t)(sq * 36) * GI_BYTES;
        __syncthreads();
        for (int i = tid; i < 2 * 8192 / 4; i += NTHREADS) ((LAS unsigned*)(L + GSL_ST))[i] = 0u;
        f32x4 Sacc[2] = {(f32x4){0.f, 0.f, 0.f, 0.f}, (f32x4){0.f, 0.f, 0.f, 0.f}};
#define GLA_DMA(n_) do { const unsigned char* r_ = rec0 + (size_t)(n_) * GI_BYTES; LAS unsigned char* d_ = L + ((n_) % 3) * GSL_IN; \
            __builtin_amdgcn_global_load_lds((const unsigned*)(r_ + GI_A + tid * 16), (LAS unsigned*)(d_ + w * 1024), 16, 0, 0); \
            __builtin_amdgcn_global_load_lds((const unsigned*)(r_ + GI_QIN + tid * 16), (LAS unsigned*)(d_ + 8192 + w * 1024), 16, 0, 0); \
            __builtin_amdgcn_global_load_lds((const unsigned*)(r_ + GI_KOT + tid * 16), (LAS unsigned*)(d_ + 16384 + w * 1024), 16, 0, 0); \
            __builtin_amdgcn_global_load_lds((const unsigned*)(r_ + GI_VT + vh * 8192 + tid * 16), (LAS unsigned*)(d_ + 24576 + w * 1024), 16, 0, 0); \
            __builtin_amdgcn_global_load_lds((const unsigned*)(r_ + GI_DEC + lane * 16), (LAS unsigned*)(d_ + 32768), 16, 0, 0); } while (0)
        GLA_DMA(0); GLA_DMA(1);
        for (int n = 0; n < 36; ++n) {
            LAS unsigned char* IN = L + (n % 3) * GSL_IN; LAS unsigned char* STr = L + GSL_ST + (n & 1) * 8192; LAS unsigned char* STw = L + GSL_ST + ((n + 1) & 1) * 8192;
            if (n == 0) asm volatile("s_waitcnt vmcnt(5)" ::: "memory"); else if (n < 35) asm volatile("s_waitcnt vmcnt(7)" ::: "memory"); else asm volatile("s_waitcnt vmcnt(2)" ::: "memory");
            lds_barrier();
            if (n + 2 < 36) GLA_DMA(n + 2);
#pragma unroll
            for (int i = 0; i < 2; ++i) { const int tI = 2 * w + i, vt = tI >> 2, pt = tI & 3;
                f32x4 c = (f32x4){0.f, 0.f, 0.f, 0.f};
#pragma unroll
                for (int ks = 0; ks < 2; ++ks) {
                    const bf16x8 a1 = *(const LAS bf16x8*)(IN + 24576 + gsw(16 * vt + r16, 4 * ks + g4)), b1 = *(const LAS bf16x8*)(IN + gsw(16 * pt + r16, 4 * ks + g4));
                    c = __builtin_amdgcn_mfma_f32_16x16x32_bf16(a1, b1, c, 0, 0, 0);
                    const bf16x8 a2 = *(const LAS bf16x8*)(STr + gsw(16 * vt + r16, 4 * ks + g4)), b2 = *(const LAS bf16x8*)(IN + 8192 + gsw(16 * pt + r16, 4 * ks + g4));
                    c = __builtin_amdgcn_mfma_f32_16x16x32_bf16(a2, b2, c, 0, 0, 0); }
                const int row = gla_row(n, 16 * pt + r16, b, d);
                u32x2 o; o.x = pk2(c[0], c[1]); o.y = pk2(c[2], c[3]);
                *(u32x2*)(ob + (size_t)row * 512 + h * 128 + vh * 64 + 16 * vt + 4 * g4) = o; }
#pragma unroll
            for (int i = 0; i < 2; ++i) { const int tI = 2 * w + i, ct = tI >> 2, vt = tI & 3;
                const f32x4 dc = *(const LAS f32x4*)(IN + 32768 + (16 * ct + 4 * g4) * 4);
                f32x4 c = Sacc[i] * dc;
#pragma unroll
                for (int ks = 0; ks < 2; ++ks) { const bf16x8 af = *(const LAS bf16x8*)(IN + 16384 + gsw(16 * ct + r16, 4 * ks + g4)), bfr = *(const LAS bf16x8*)(IN + 24576 + gsw(16 * vt + r16, 4 * ks + g4));
                    c = __builtin_amdgcn_mfma_f32_16x16x32_bf16(af, bfr, c, 0, 0, 0); }
                Sacc[i] = c;
                u32x2 o; o.x = pk2(c[0], c[1]); o.y = pk2(c[2], c[3]);
                *(LAS u32x2*)(STw + gsw(16 * vt + r16, 2 * ct + (g4 >> 1)) + (g4 & 1) * 8) = o; }
        }
#undef GLA_DMA
        asm volatile("s_waitcnt vmcnt(0)" ::: "memory");
    }
    __syncthreads();
}

__device__ __forceinline__ void finish_conv_phase(const Frame& F, const Args& a) {
    const int lane = F.lane; bf16_t* cat = (bf16_t*)(F.ws + T_CAT);
    {
        const bf16_t* of = (const bf16_t*)(F.ws + T_OF); const bf16_t* obk = (const bf16_t*)(F.ws + T_OB); const bf16_t* gb = (const bf16_t*)(F.ws + T_GB);
        const int gw = F.vcu * NWAVES + F.wave, NGW = F.G * NWAVES;
        float gg[8];
#pragma unroll
        for (int j = 0; j < 8; ++j) gg[j] = a.in[16][8 * lane + j];
        for (int row = gw; row < NT; row += NGW) {
            float x[8], y[8], g[8];
            unpack8(*(const u32x4*)(of + (size_t)row * 512 + 8 * lane), x); unpack8(*(const u32x4*)(obk + (size_t)row * 512 + 8 * lane), y); unpack8(*(const u32x4*)(gb + (size_t)row * 512 + 8 * lane), g);
            float ss = 0.f;
#pragma unroll
            for (int j = 0; j < 8; ++j) { x[j] += y[j]; ss += x[j] * x[j]; }
            ss += __shfl_xor(ss, 1); ss += __shfl_xor(ss, 2); ss += __shfl_xor(ss, 4); ss += __shfl_xor(ss, 8);
            const float rs = rsqrtf(ss * (1.0f / 128.0f) + RMS_EPS);
#pragma unroll
            for (int j = 0; j < 8; ++j) x[j] = x[j] * rs * gg[j] * siluf_(g[j]);
            *(u32x4*)(cat + (size_t)row * D + 8 * lane) = (u32x4){pk2(x[0], x[1]), pk2(x[2], x[3]), pk2(x[4], x[5]), pk2(x[6], x[7])};
        }
    }
    {
        const bf16_t* ub = (const bf16_t*)(F.ws + T_UB); LAS float* tile = (LAS float*)F.lds;
        const int c = F.tid;
        float wv[CONV_W];
#pragma unroll
        for (int j = 0; j < CONV_W; ++j) wv[j] = a.in[17][j * CONV_CH + c];
        const float cb = a.in[18][c];
        float lg[8], lb[8];
#pragma unroll
        for (int i = 0; i < 8; ++i) { lg[i] = a.in[19][lane + 64 * i]; lb[i] = a.in[20][lane + 64 * i]; }
        for (int ti = blockIdx.x; ti < NT / 32; ti += F.G) {
            const int row0 = ti * 32; const bool lat = row0 < NX;
            const int t0 = lat ? (row0 & (SEQ - 1)) : ((row0 - NX) & (CTXL - 1)); const int len = lat ? SEQ : CTXL; const int sbase = row0 - t0;
            float in[62];
            unsigned short raw[62];
#pragma unroll
            for (int i = 0; i < 62; ++i) { int t = t0 - 15 + i; t = t < 0 ? 0 : (t >= len ? len - 1 : t); raw[i] = ub[(size_t)(sbase + t) * 512 + c]; }
#pragma unroll
            for (int i = 0; i < 62; ++i) { const int t = t0 - 15 + i; in[i] = (t >= 0 && t < len) ? bf2f(raw[i]) : 0.f; }
            __syncthreads();
#pragma unroll
            for (int t = 0; t < 32; ++t) { float s = cb;
#pragma unroll
                for (int j = 0; j < CONV_W; ++j) s += wv[j] * in[t + j];
                tile[t * 512 + c] = s; }
            __syncthreads();
#pragma unroll
            for (int q = 0; q < 4; ++q) { const int t = 4 * F.wave + q; float v[8]; float s = 0.f;
#pragma unroll
                for (int i = 0; i < 8; ++i) { v[i] = tile[t * 512 + lane + 64 * i]; s += v[i]; }
                const float mu = wave_sum(s) * (1.0f / 512.0f); float qq = 0.f;
#pragma unroll
                for (int i = 0; i < 8; ++i) { v[i] -= mu; qq += v[i] * v[i]; }
                const float rstd = rsqrtf(wave_sum(qq) * (1.0f / 512.0f) + LN_EPS);
#pragma unroll
                for (int i = 0; i < 8; ++i) { const float y = v[i] * rstd * lg[i] + lb[i]; cat[(size_t)(row0 + t) * D + 512 + lane + 64 * i] = (bf16_t)f2bf(siluf_(y)); } }
        }
        __syncthreads();
    }
}


constexpr int CW_TST = 20480;
constexpr int AUX_TST = AUX_OFF, AUX_TILEE = AUX_OFF + 1040, AUX_IDX = AUX_OFF + 1168;
constexpr int MOE_MAXU = 32, MOE_MAXIDX = 16;
static_assert(AUX_IDX + MOE_MAXIDX * 1024 <= MISC_OFF, "aux lds");

struct EpiRouter {
    static constexpr bool PERM = false, AFTER_DRAIN = true;
    const float* rbias; int* asg_e; int* asg_r; float* asg_g; unsigned* counts; int* lst;
    __device__ __forceinline__ void operator()(const f32x4 (&)[2][2][4][2], const Unit&, int, int, int, int) const {}
    __device__ __forceinline__ void fused(const f32x4 (&acc)[2][2][4][2], const Unit& u, int wr, int wc, int fr, int fq, LAS unsigned char* lds, int wid, int lane) const {
        LAS float* SC = (LAS float*)lds;
        LAS unsigned* lcnt = (LAS unsigned*)(lds + 66560); LAS unsigned* lbase = lcnt + 256;
        LAS int* selE = (LAS int*)(lbase + 256); LAS int* selR = selE + 2048;
        const int tid = wid * 64 + lane;
        if (tid < 256) lcnt[tid] = 0u;
        const f32x4 rb = *(const f32x4*)(rbias + 4 * lane);
        const float NINF = -__builtin_inff();
#pragma unroll
        for (int ai = 0; ai < 2; ++ai)
#pragma unroll
            for (int mm = 0; mm < 2; ++mm) {
                LDS_WAIT(); __builtin_amdgcn_s_barrier(); asm volatile("" ::: "memory");
#pragma unroll
                for (int mi = 0; mi < 2; ++mi) { const int lr = 32 * wr + 16 * mi + fr;
#pragma unroll
                    for (int bj = 0; bj < 2; ++bj)
#pragma unroll
                        for (int n = 0; n < 2; ++n) *(LAS f32x4*)(SC + lr * 260 + 128 * bj + 32 * wc + 16 * n + 4 * fq) = acc[ai][bj][2 * mm + mi][n]; }
                LDS_WAIT(); __builtin_amdgcn_s_barrier(); asm volatile("" ::: "memory");
                for (int q = 0; q < 8; ++q) {
                    const int lr = 8 * wid + q; const int rit = 128 * ai + 64 * (lr >> 5) + 16 * (2 * mm + ((lr >> 4) & 1)) + (lr & 15);
                    const f32x4 lg = *(const LAS f32x4*)(SC + lr * 260 + 4 * lane);
                    float s[4], cd[4];
#pragma unroll
                    for (int j = 0; j < 4; ++j) { s[j] = 1.0f / (1.0f + __expf(-lg[j])); cd[j] = s[j] + rb[j]; }
                    float m1 = fmaxf(cd[0], cd[1]), m2 = fminf(cd[0], cd[1]);
                    { const float x = cd[2]; const float n1 = fmaxf(m1, x); m2 = fmaxf(fminf(m1, x), m2); m1 = n1; }
                    { const float x = cd[3]; const float n1 = fmaxf(m1, x); m2 = fmaxf(fminf(m1, x), m2); m1 = n1; }
#pragma unroll
                    for (int o = 1; o < 8; o <<= 1) { const float a1 = __shfl_xor(m1, o), a2 = __shfl_xor(m2, o); const float n1 = fmaxf(m1, a1); m2 = fmaxf(fminf(m1, a1), fmaxf(m2, a2)); m1 = n1; }
                    const float gs = m1 + m2; const int mygrp = lane >> 3; int rank = 0;
#pragma unroll
                    for (int g = 0; g < 8; ++g) { const float og = __shfl(gs, 8 * g); rank += (og > gs || (og == gs && g < mygrp)) ? 1 : 0; }
                    if (rank >= 4) { cd[0] = NINF; cd[1] = NINF; cd[2] = NINF; cd[3] = NINF; }
                    int myE = 0; float myG = 0.f; float gsum = 0.f;
#pragma unroll
                    for (int k = 0; k < TOPK; ++k) {
                        float bv = cd[0]; int bi = 0;
                        if (cd[1] > bv) { bv = cd[1]; bi = 1; } if (cd[2] > bv) { bv = cd[2]; bi = 2; } if (cd[3] > bv) { bv = cd[3]; bi = 3; }
                        float v = bv; int ix = 4 * lane + bi;
#pragma unroll
                        for (int o = 32; o >= 1; o >>= 1) { const float ov = __shfl_xor(v, o); const int oi = __shfl_xor(ix, o); if (ov > v || (ov == v && oi < ix)) { v = ov; ix = oi; } }
                        const int sl = ix & 3; const float mys = sl == 0 ? s[0] : (sl == 1 ? s[1] : (sl == 2 ? s[2] : s[3]));
                        const float gv = __shfl(mys, ix >> 2);
                        gsum += gv;
                        if (lane == k) { myE = ix; myG = gv; }
                        if (lane == (ix >> 2)) { if (sl == 0) cd[0] = NINF; else if (sl == 1) cd[1] = NINF; else if (sl == 2) cd[2] = NINF; else cd[3] = NINF; }
                    }
                    if (lane < TOPK) { const unsigned r = __hip_atomic_fetch_add(&lcnt[myE], 1u, __ATOMIC_RELAXED, __HIP_MEMORY_SCOPE_WORKGROUP); selE[rit * 8 + lane] = myE; selR[rit * 8 + lane] = (int)r; asg_g[(size_t)(u.orow + rit) * 8 + lane] = myG / gsum * 2.5f; }
                }
            }
        LDS_WAIT(); __builtin_amdgcn_s_barrier(); asm volatile("" ::: "memory");
        if (tid < 256) { const unsigned c = lcnt[tid]; lbase[tid] = c ? atomicAdd(&counts[tid], c) : 0u; }
        LDS_WAIT(); __builtin_amdgcn_s_barrier(); asm volatile("" ::: "memory");
        for (int i = tid; i < 2048; i += NTHREADS) { const int e = selE[i]; const int r = (int)lbase[e] + selR[i]; asg_e[(size_t)u.orow * 8 + i] = e; asg_r[(size_t)u.orow * 8 + i] = r; lst[(size_t)e * LCAP + r] = u.orow + (i >> 3); }
    }
};

template <int NCOL>
__device__ __forceinline__ int moe_units_setup(const Frame& F, int layer, int ntok, int c, bool want_idx) {
    LAS int* tst = (LAS int*)(F.lds + AUX_TST); LAS int* tileE = (LAS int*)(F.lds + AUX_TILEE); LAS int* idxl = (LAS int*)(F.lds + AUX_IDX);
    const unsigned* counts = F.ctl + CW_CNT + layer * 256;
    __syncthreads();
    if (want_idx) {
        if (F.wave == 0) { int t4[4], s = 0;
#pragma unroll
            for (int j = 0; j < 4; ++j) { t4[j] = ((int)counts[4 * F.lane + j] + 255) >> 8; s += t4[j]; }
            int incl = s;
#pragma unroll
            for (int o = 1; o < 64; o <<= 1) { const int v = __shfl_up(incl, o); if (F.lane >= o) incl += v; }
            int base = incl - s;
#pragma unroll
            for (int j = 0; j < 4; ++j) { tst[4 * F.lane + j] = base; base += t4[j]; }
            if (F.lane == 63) tst[256] = incl; }
    } else for (int i = F.tid; i < 257; i += NTHREADS) tst[i] = (int)F.ctl[CW_TST + layer * 320 + i];
    __syncthreads();
    const int ntr = tst[256], nunits = (ntr + ntok / 256) * NCOL;
    int nu = c < nunits ? (nunits - c + F.G - 1) / F.G : 0; if (nu > MOE_MAXU) nu = MOE_MAXU; if (want_idx && nu > MOE_MAXIDX) nu = MOE_MAXIDX;
    if (F.tid < nu) { const int rt = (c + F.tid * F.G) / NCOL; int e;
        if (rt >= ntr) e = NEXP; else { int lo = 0, hi = 255; while (lo < hi) { const int mid = (lo + hi + 1) >> 1; if (tst[mid] <= rt) lo = mid; else hi = mid - 1; } e = lo; }
        tileE[F.tid] = e; }
    if (want_idx) {
        if (blockIdx.x == 0) for (int i = F.tid; i < 257; i += NTHREADS) F.ctl[CW_TST + layer * 320 + i] = (unsigned)tst[i];
        {
            const int* asg_e = (const int*)(F.ws + M_AE); const int* asg_r = (const int*)(F.ws + M_AR); int* tslot = (int*)(F.ws + M_TS);
            const int gt = blockIdx.x * NTHREADS + F.tid, gs = F.G * NTHREADS;
            for (int i = gt; i < ntok * 8; i += gs) tslot[i] = tst[asg_e[i]] * 256 + asg_r[i]; }
        __syncthreads();
        const int* lst = (const int*)(F.ws + M_LST);
        for (int i = F.tid; i < nu * 256; i += NTHREADS) { const int j = i >> 8, r = i & 255; const int rt = (c + j * F.G) / NCOL; const int e = tileE[j]; int tok;
            if (e >= NEXP) tok = (rt - ntr) * 256 + r;
            else { const int pos = (rt - tst[e]) * 256 + r; tok = pos < (int)counts[e] ? lst[(size_t)e * LCAP + pos] : 0; }
            idxl[i] = tok; }
    }
    __syncthreads();
    return nu;
}
struct SchedMoeGU {
    const char* A; const char* W; const LAS int* tileE; const LAS int* idxl; int nu, G, c;
    __device__ __forceinline__ bool next(int i, Unit& u) const {
        if (i >= nu) return false; const int un = c + i * G; const int rt = un >> 1, col = un & 1; const int e = tileE[i];
        u.a = i; u.b = e * 512 + col * 256; u.orow = rt * 256; u.ocol = col * 128; u.aux = e; return true; }
    __device__ __forceinline__ const char* a_base() const { return A; }
    __device__ __forceinline__ const char* b_ptr(const Unit& u) const { return W + (size_t)u.b * D * 2; }
    __device__ __forceinline__ void a_off(const Unit& u, const int (&R)[2], const int (&C)[2], unsigned (&o0)[2], unsigned (&o1)[2]) const {
#pragma unroll
        for (int i = 0; i < 2; ++i) { const int t0 = idxl[u.a * 256 + R[i]], t1 = idxl[u.a * 256 + 128 + R[i]]; o0[i] = (unsigned)t0 * (unsigned)(D * 2) + (unsigned)C[i] * 2u; o1[i] = (unsigned)t1 * (unsigned)(D * 2) + (unsigned)C[i] * 2u; }
    }
};
struct EpiGateUp {
    static constexpr bool PERM = true, AFTER_DRAIN = false;
    bf16_t* hid;
    __device__ __forceinline__ void operator()(const f32x4 (&acc)[2][2][4][2], const Unit& u, int wr, int wc, int fr, int fq) const {
        const int lane = fr + 16 * fq; const int srcb = ((lane >> 2) + 16 * (lane & 3)) << 2;
        const int row0 = u.orow + wr * 64 + (lane >> 2), col0 = u.ocol + wc * 32 + 8 * (lane & 3);
#pragma unroll
        for (int ai = 0; ai < 2; ++ai)
#pragma unroll
            for (int m = 0; m < 4; ++m) { float h[8];
#pragma unroll
                for (int n = 0; n < 2; ++n)
#pragma unroll
                    for (int e = 0; e < 4; ++e) { const float g = acc[ai][0][m][n][e], up = acc[ai][1][m][n][e]; h[4 * n + e] = g / (1.0f + __expf(-g)) * up; }
                u32x4 w; w.x = cvt_pk_bf16(h[0], h[1]); w.y = cvt_pk_bf16(h[2], h[3]); w.z = cvt_pk_bf16(h[4], h[5]); w.w = cvt_pk_bf16(h[6], h[7]);
                u32x4 t; t.x = (unsigned)__builtin_amdgcn_ds_bpermute(srcb, (int)w.x); t.y = (unsigned)__builtin_amdgcn_ds_bpermute(srcb, (int)w.y); t.z = (unsigned)__builtin_amdgcn_ds_bpermute(srcb, (int)w.z); t.w = (unsigned)__builtin_amdgcn_ds_bpermute(srcb, (int)w.w);
                *(u32x4*)(hid + (size_t)(row0 + ai * 128 + m * 16) * DEXP + col0) = t; }
    }
};
struct SchedMoeDN {
    const char* A; const char* W; const LAS int* tileE; int nu, G, c;
    __device__ __forceinline__ bool next(int i, Unit& u) const {
        if (i >= nu) return false; const int un = c + i * G; const int rt = un >> 2, col = un & 3; const int e = tileE[i];
        u.a = rt; u.b = e * 1024 + col * 256; u.orow = rt * 256; u.ocol = col * 256; u.aux = e; return true; }
    __device__ __forceinline__ const char* a_base() const { return A; }
    __device__ __forceinline__ const char* b_ptr(const Unit& u) const { return W + (size_t)u.b * DEXP * 2; }
    __device__ __forceinline__ void a_off(const Unit& u, const int (&R)[2], const int (&C)[2], unsigned (&o0)[2], unsigned (&o1)[2]) const {
#pragma unroll
        for (int i = 0; i < 2; ++i) { o0[i] = (unsigned)((u.a * 256 + R[i]) * DEXP + C[i]) * 2u; o1[i] = o0[i] + (unsigned)(128 * DEXP * 2); }
    }
};

constexpr int NA_RING = 9, NA_KR = 0, NA_VR = NA_RING * 64 * 128, NA_RPB = 2 * NA_RING * 64 * 128, NA_END = NA_RPB + 15 * 128;
constexpr int NA_KC = 0, NA_VC = 256 * 128;
static_assert(NA_END <= MISC_OFF, "na lds");
typedef short s16x4 __attribute__((ext_vector_type(4)));
__device__ __forceinline__ int na_voff(int row, int ch) { return row * 128 + ((((ch >> 1) ^ ((row >> 1) & 3)) << 5) | ((ch & 1) << 4)); }
__device__ __forceinline__ int na_koff(int row, int ch) { return row * 128 + ((ch ^ (row & 7)) << 4); }
template <bool CTX>
__device__ __forceinline__ void na_seg2(LAS unsigned char* L, const bf16x8 (&qf)[2], int r16, int g4, int r0, int band, const int (&boff)[2][4], int rbase,
                                        const int (&voff)[4], f32x4 (&O)[4], float& m_run, float& sum) {
    const float NINF = -__builtin_inff();
    float S[2][8][4]; float mx[2] = {NINF, NINF};
#pragma unroll
    for (int t = 0; t < 8; ++t) {
#pragma unroll
        for (int q = 0; q < 2; ++q) {
            f32x4 c = (f32x4){0.f, 0.f, 0.f, 0.f};
            int key, kbase;
            if (CTX) { key = 128 * q + 16 * t + r16; kbase = NA_KC; } else { key = ((r0 + ((8 * q + t) >> 1)) % NA_RING) * 64 + band + 16 * (t & 1) + r16; kbase = NA_KR; }
            const bf16x8 k0 = *(const LAS bf16x8*)(L + kbase + na_koff(key, g4)), k1 = *(const LAS bf16x8*)(L + kbase + na_koff(key, 4 + g4));
            c = __builtin_amdgcn_mfma_f32_16x16x32_bf16(k0, qf[0], c, 0, 0, 0); c = __builtin_amdgcn_mfma_f32_16x16x32_bf16(k1, qf[1], c, 0, 0, 0);
            if (CTX) {
#pragma unroll
                for (int e = 0; e < 4; ++e) S[q][t][e] = c[e];
            } else {
#pragma unroll
                for (int e = 0; e < 4; ++e) S[q][t][e] = c[e] + *(const LAS float*)(L + rbase + ((8 * q + t) >> 1) * 128 + boff[t & 1][e]);
            }
            mx[q] = fmaxf(mx[q], fmaxf(fmaxf(S[q][t][0], S[q][t][1]), fmaxf(S[q][t][2], S[q][t][3])));
        }
    }
    float ps[2]; f32x4 Oq[2][4];
#pragma unroll
    for (int q = 0; q < 2; ++q) { mx[q] = fmaxf(mx[q], __shfl_xor(mx[q], 16)); mx[q] = fmaxf(mx[q], __shfl_xor(mx[q], 32)); }
#pragma unroll
    for (int q = 0; q < 2; ++q) { float s = 0.f;
#pragma unroll
        for (int t = 0; t < 8; ++t)
#pragma unroll
            for (int e = 0; e < 4; ++e) { const float p = __builtin_amdgcn_exp2f(S[q][t][e] - mx[q]); S[q][t][e] = p; s += p; }
        ps[q] = s;
#pragma unroll
        for (int mt = 0; mt < 4; ++mt) Oq[q][mt] = (f32x4){0.f, 0.f, 0.f, 0.f}; }
#pragma unroll
    for (int q = 0; q < 2; ++q) { ps[q] += __shfl_xor(ps[q], 16); ps[q] += __shfl_xor(ps[q], 32); }
#pragma unroll
    for (int j = 0; j < 4; ++j) {
#pragma unroll
        for (int q = 0; q < 2; ++q) {
            bf16x8 pb; { const u32x4 ww = (u32x4){cvt_pk_bf16(S[q][2 * j][0], S[q][2 * j][1]), cvt_pk_bf16(S[q][2 * j][2], S[q][2 * j][3]), cvt_pk_bf16(S[q][2 * j + 1][0], S[q][2 * j + 1][1]), cvt_pk_bf16(S[q][2 * j + 1][2], S[q][2 * j + 1][3])}; pb = __builtin_bit_cast(bf16x8, ww); }
            int ub;
            if (CTX) ub = NA_VC + (128 * q + 32 * j) * 128; else ub = NA_VR + (((r0 + 4 * q + j) % NA_RING) * 64 + band) * 128;
#pragma unroll
            for (int mt = 0; mt < 4; ++mt) {
                const s16x4 a0 = __builtin_amdgcn_ds_read_tr16_b64_v4i16((LAS s16x4*)(L + ub + voff[mt]));
                const s16x4 a1 = __builtin_amdgcn_ds_read_tr16_b64_v4i16((LAS s16x4*)(L + ub + voff[mt] + 16 * 128));
                const bf16x8 av = (bf16x8){a0[0], a0[1], a0[2], a0[3], a1[0], a1[1], a1[2], a1[3]};
                Oq[q][mt] = __builtin_amdgcn_mfma_f32_16x16x32_bf16(av, pb, Oq[q][mt], 0, 0, 0);
            }
        }
    }
    const float m_new = fmaxf(m_run, fmaxf(mx[0], mx[1]));
    const float a_run = __builtin_amdgcn_exp2f(m_run - m_new), a0 = __builtin_amdgcn_exp2f(mx[0] - m_new), a1 = __builtin_amdgcn_exp2f(mx[1] - m_new);
    m_run = m_new; sum = sum * a_run + ps[0] * a0 + ps[1] * a1;
#pragma unroll
    for (int mt = 0; mt < 4; ++mt) O[mt] = O[mt] * a_run + Oq[0][mt] * a0 + Oq[1][mt] * a1;
}
__device__ __forceinline__ void na_phase(const Frame& F, const Args& a) {
    LAS unsigned char* L = F.lds; const int lane = F.lane, w = F.wave, r16 = lane & 15, g4 = lane >> 4;
    const bf16_t* qbuf = (const bf16_t*)(F.ws + T_QKV); const bf16_t* kbuf = qbuf + (size_t)NT * D; const bf16_t* vbuf = kbuf + (size_t)NT * D; bf16_t* cat = (bf16_t*)(F.ws + T_CAT);
    f32x2* mlbuf = (f32x2*)(F.ws + T_Y);
    const int rr = w >> 2, cb = w & 3; const int band = cb == 0 ? 0 : (cb == 1 ? 8 : (cb == 2 ? 24 : 32));
    const float NINF = -__builtin_inff();
    const int pkey = F.tid >> 3, pch = F.tid & 7;
    int boff[2][4], voff[4];
    { const int qc = 16 * cb + r16; int cs = qc - 8; cs = cs < 0 ? 0 : (cs > 48 ? 48 : cs);
#pragma unroll
      for (int hc = 0; hc < 2; ++hc)
#pragma unroll
          for (int e = 0; e < 4; ++e) { const int kc = band + 16 * hc + 4 * g4 + e; const bool ok = kc >= cs && kc < cs + 16; boff[hc][e] = (ok ? kc - qc + 15 : 31) * 4; }
      const int rl = 4 * g4 + (r16 >> 2), sw = (rl >> 1) & 3;
#pragma unroll
      for (int mt = 0; mt < 4; ++mt) voff[mt] = rl * 128 + ((mt ^ sw) << 5) + 8 * (r16 & 3); }
    for (int bh = blockIdx.x; bh < BATCH * NA_H; bh += F.G) {
        const int b = bh >> 4, h = bh & 15;
        __syncthreads();
        for (int i = F.tid; i < 256 * 8; i += NTHREADS) { const int key = i >> 3, ch = i & 7; const size_t g = (size_t)(NX + b * CTXL + key) * D + h * 64 + ch * 8;
            *(LAS u32x4*)(L + NA_VC + na_voff(key, ch)) = *(const u32x4*)(vbuf + g); *(LAS u32x4*)(L + NA_KC + na_koff(key, ch)) = *(const u32x4*)(kbuf + g); }
        __syncthreads();
        {
            bf16x8 qn[2];
            { const bf16_t* q0 = qbuf + (size_t)(b * SEQ + rr * 64 + 16 * cb + r16) * D + h * 64 + 8 * g4; qn[0] = *(const bf16x8*)q0; qn[1] = *(const bf16x8*)(q0 + 32); }
            for (int rp = 0; rp < 16; ++rp) {
                const int r = 2 * rp + rr; const int qrow = b * SEQ + r * 64 + 16 * cb + r16;
                bf16x8 qf[2]; qf[0] = qn[0]; qf[1] = qn[1];
                if (rp < 15) { const bf16_t* q1 = qbuf + (size_t)(qrow + 128) * D + h * 64 + 8 * g4; qn[0] = *(const bf16x8*)q1; qn[1] = *(const bf16x8*)(q1 + 32); }
                f32x4 O[4]; float m_run = NINF, sum = 0.f;
#pragma unroll
                for (int mt = 0; mt < 4; ++mt) O[mt] = (f32x4){0.f, 0.f, 0.f, 0.f};
                na_seg2<true>(L, qf, r16, g4, 0, band, boff, 0, voff, O, m_run, sum);
#pragma unroll
                for (int mt = 0; mt < 4; ++mt) { u32x2 o; o.x = pk2(O[mt][0], O[mt][1]); o.y = pk2(O[mt][2], O[mt][3]); *(u32x2*)(cat + (size_t)qrow * D + h * 64 + 16 * mt + 4 * g4) = o; }
                if (g4 == 0) mlbuf[(size_t)qrow * 16 + h] = (f32x2){m_run, sum};
            }
        }
        __syncthreads();
        asm volatile("s_waitcnt vmcnt(0)" ::: "memory");
        for (int i = F.tid; i < 15 * 32; i += NTHREADS) { const int ri = i >> 5, ci = i & 31; ((LAS float*)(L + NA_RPB))[i] = ci < 31 ? a.in[23][h * 465 + ri * 31 + ci] * 1.4426950408889634f : NINF; }
        for (int gr = 0; gr < 9; ++gr) { const size_t g = (size_t)(b * SEQ + gr * 64 + pkey) * D + h * 64 + pch * 8;
            *(LAS u32x4*)(L + NA_VR + na_voff(gr * 64 + pkey, pch)) = *(const u32x4*)(vbuf + g); *(LAS u32x4*)(L + NA_KR + na_koff(gr * 64 + pkey, pch)) = *(const u32x4*)(kbuf + g); }
        for (int rp = 0; rp < 16; ++rp) {
            int R0 = 2 * rp - 4; R0 = R0 < 0 ? 0 : (R0 > 24 ? 24 : R0);
            int R0n = 2 * rp - 2; R0n = R0n < 0 ? 0 : (R0n > 24 ? 24 : R0n);
            const bool newrows = (rp < 15) && (R0n != R0);
            u32x4 nv0 = (u32x4){0u, 0u, 0u, 0u}, nv1 = nv0, nk0 = nv0, nk1 = nv0;
            if (newrows) { const size_t g0 = (size_t)(b * SEQ + (R0 + 9) * 64 + pkey) * D + h * 64 + pch * 8; nv0 = *(const u32x4*)(vbuf + g0); nk0 = *(const u32x4*)(kbuf + g0);
                if (R0 + 10 < 32) { const size_t g1 = g0 + (size_t)64 * D; nv1 = *(const u32x4*)(vbuf + g1); nk1 = *(const u32x4*)(kbuf + g1); } }
            const int r = 2 * rp + rr; int r0 = r - 4; r0 = r0 < 0 ? 0 : (r0 > 24 ? 24 : r0);
            const int qrow = b * SEQ + r * 64 + 16 * cb + r16;
            bf16x8 qf[2];
#pragma unroll
            for (int ks = 0; ks < 2; ++ks) qf[ks] = *(const bf16x8*)(qbuf + (size_t)qrow * D + h * 64 + 32 * ks + 8 * g4);
            f32x4 O[4]; float m_run, sum;
#pragma unroll
            for (int mt = 0; mt < 4; ++mt) { const u32x2 o = *(const u32x2*)(cat + (size_t)qrow * D + h * 64 + 16 * mt + 4 * g4); O[mt] = (f32x4){bflo(o.x), bfhi(o.x), bflo(o.y), bfhi(o.y)}; }
            { const f32x2 ml = mlbuf[(size_t)qrow * 16 + h]; m_run = ml.x; sum = ml.y; }
            lds_barrier();
            const int rbase = NA_RPB + (r0 - r + 7) * 128;
            na_seg2<false>(L, qf, r16, g4, r0, band, boff, rbase, voff, O, m_run, sum);
            const float inv = 1.0f / sum;
#pragma unroll
            for (int mt = 0; mt < 4; ++mt) { u32x2 o; o.x = pk2(O[mt][0] * inv, O[mt][1] * inv); o.y = pk2(O[mt][2] * inv, O[mt][3] * inv);
                *(u32x2*)(cat + (size_t)qrow * D + h * 64 + 16 * mt + 4 * g4) = o; }
            if (newrows) {
                lds_barrier();
                *(LAS u32x4*)(L + NA_VR + na_voff(((R0 + 9) % NA_RING) * 64 + pkey, pch)) = nv0; *(LAS u32x4*)(L + NA_KR + na_koff(((R0 + 9) % NA_RING) * 64 + pkey, pch)) = nk0;
                *(LAS u32x4*)(L + NA_VR + na_voff(((R0 + 10) % NA_RING) * 64 + pkey, pch)) = nv1; *(LAS u32x4*)(L + NA_KR + na_koff(((R0 + 10) % NA_RING) * 64 + pkey, pch)) = nk1; }
        }
    }
    __syncthreads();
}

#if MK_ONE_LAUNCH
#define GRID_BAR() xcd_barrier(bar)
#else
#define GRID_BAR() do { } while (0)
#endif
#define IN(k) (lo <= (k) && (k) < hi && (k) <= MK_LAST_PHASE)
#define SEAM(k) do { if (IN(k) && IN((k) + 1)) GRID_BAR(); } while (0)
template <int LAYER>
__device__ __forceinline__ void layer_tail(const Frame& F, const Args& args, const int lo, const int hi, const XcdBarrier& bar) {
    unsigned char* ws = args.ws;
    const float* modx = (const float*)(ws + WS_MODX); const float* modc = (const float*)(ws + WS_MODC);
    float* xw = (float*)(ws + WS_XW); float* xwc = (float*)(ws + WS_XW + (size_t)NX * D * 2); bf16_t* Hb = (bf16_t*)(ws + WS_H);
    constexpr int mb = LAYER ? 16 : 7; constexpr int ntok = LAYER ? NX : NT;
    const float* lmodx = modx + (size_t)LAYER * 16 * ADA; const float* lmodc = modc + (size_t)LAYER * ADA;
    if (IN(LAYER ? 14 : 5)) REPEAT_IF(LAYER ? 14 : 5) { REP_BAR();
        SchedDense S{(const char*)(ws + T_CAT), (const char*)(ws + (LAYER ? WS_WOUT1 : WS_WOUT0)), D, ntok / 256, D / 256, 0, 1, 0, F.G, (int)blockIdx.x};
        EpiBf16 E{(bf16_t*)(ws + T_Y), D, 0, 0};
        pg8::gemm_phase<EpiBf16, SchedDense, true>(F.lds, D, S, E);
        if (LAYER == 0 && F.G == 256 && (int)blockIdx.x >= 64) cvt_moe_range(F, args, 0, F0_BULK + F0_P2, F0_BULK + F0_P2 + F0_P5, (int)blockIdx.x - 64, 192);
    }
    SEAM(LAYER ? 14 : 5);
    if (IN(LAYER ? 15 : 6)) REPEAT_IF(LAYER ? 15 : 6) { REP_BAR();
        RowPhase P{}; P.xin_lat = LAYER ? xw : args.in[0]; P.xin_ctx = LAYER ? xwc : args.in[2]; P.xin16 = LAYER != 0; P.xout_lat = xw; P.xout_ctx = xwc; P.xout16 = true; P.nrows = ntok; P.ysrc = 1; P.y = (const bf16_t*)(ws + T_Y);
        P.gpost = args.in[7] + LAYER * D; P.modx = lmodx; P.modc = lmodc; P.gate_chunk = 2;
        P.doH = true; P.H = Hb; P.gpre = args.in[8] + LAYER * D; P.sc_chunk = 4; P.sh_chunk = 3; P.modxH = lmodx; P.modcH = lmodc;
        row_phase(F, P);
    }
    SEAM(LAYER ? 15 : 6);
    if (IN(mb)) REPEAT_IF(mb) { REP_BAR();
        SchedDense S{(const char*)Hb, (const char*)(ws + WS_WR) + (size_t)LAYER * NEXP * D * 2, D, ntok / 256, 1, 0, 1, 0, F.G, (int)blockIdx.x};
        EpiRouter E{args.in[25] + LAYER * NEXP, (int*)(ws + M_AE), (int*)(ws + M_AR), (float*)(ws + M_AG), F.ctl + CW_CNT + LAYER * 256, (int*)(ws + M_LST)};
        pg8::gemm_phase<EpiRouter, SchedDense, false>(F.lds, D, S, E);
        if (F.G != 256) { } else if (LAYER == 0) { if ((int)blockIdx.x >= 144) cvt_moe_range(F, args, 0, F0_BULK + F0_P2 + F0_P5, MOE_CVT_ITEMS, (int)blockIdx.x - 144, 112); }
        else { if ((int)blockIdx.x >= 128) { const int ntr0 = (int)__hip_atomic_load(F.ctl + CW_TST + 256, __ATOMIC_RELAXED, __HIP_MEMORY_SCOPE_AGENT); int s9, s10; fill1_ranges(F, ntr0, s9, s10);
                cvt_moe_range(F, args, 1, s9 + s10, MOE_CVT_ITEMS - F1_P12, (int)blockIdx.x - 128, 128); } }
    }
    if (IN(mb) && IN(mb + 2)) GRID_BAR();
    if (IN(mb + 2)) REPEAT_IF(mb + 2) { REP_BAR();
        const int nj = moe_units_setup<2>(F, LAYER, ntok, F.vcu, true);
        SchedMoeGU S{(const char*)Hb, (const char*)(ws + WS_WGU + (size_t)LAYER * WGU_BYTES), (const LAS int*)(F.lds + AUX_TILEE), (const LAS int*)(F.lds + AUX_IDX), nj, F.G, F.vcu};
        EpiGateUp E{(bf16_t*)(ws + M_HID)};
        pg8::gemm_phase<EpiGateUp, SchedMoeGU, true>(F.lds, D, S, E);
        if (LAYER == 0) { const int ntr0 = ((const LAS int*)(F.lds + AUX_TST))[256]; int s9, s10; fill1_ranges(F, ntr0, s9, s10); const int nu = (ntr0 + NT / 256) * 2, hv = nu % F.G;
            if (hv && F.vcu >= hv) cvt_moe_range(F, args, 1, 0, s9, F.vcu - hv, F.G - hv); }
    }
    SEAM(mb + 2);
    if (IN(mb + 3)) REPEAT_IF(mb + 3) { REP_BAR();
        const int nj = moe_units_setup<4>(F, LAYER, ntok, F.vcu, false);
        SchedMoeDN S{(const char*)(ws + M_HID), (const char*)(ws + WS_WDN + (size_t)LAYER * WDN_BYTES), (const LAS int*)(F.lds + AUX_TILEE), nj, F.G, F.vcu};
        EpiF8 E{(unsigned char*)(ws + M_OUT)};
        pg8::gemm_phase<EpiF8, SchedMoeDN, true>(F.lds, DEXP, S, E);
        if (LAYER == 0) { const int ntr0 = ((const LAS int*)(F.lds + AUX_TST))[256]; int s9, s10; fill1_ranges(F, ntr0, s9, s10); const int nu = (ntr0 + NT / 256) * 4, hv = nu % F.G;
            if (hv && F.vcu >= hv) cvt_moe_range(F, args, 1, s9, s9 + s10, F.vcu - hv, F.G - hv); }
    }
    SEAM(mb + 3);
    if (IN(mb + 4)) REPEAT_IF(mb + 4) { REP_BAR();
        RowPhase P{}; P.xin_lat = xw; P.xin_ctx = xwc; P.xin16 = true; P.xout_lat = LAYER ? args.out : xw; P.xout_ctx = xwc; P.xout16 = LAYER == 0; P.nrows = ntok; P.ysrc = 2;
        P.mo8 = (const unsigned char*)(ws + M_OUT); P.tslot = (const int*)(ws + M_TS); P.tgate = (const float*)(ws + M_AG); P.sharedbase = (int)__hip_atomic_load(F.ctl + CW_TST + LAYER * 320 + 256, __ATOMIC_RELAXED, __HIP_MEMORY_SCOPE_AGENT) * 256;
        P.gpost = args.in[9] + LAYER * D; P.modx = lmodx; P.modc = lmodc; P.gate_chunk = 5;
        P.doH = LAYER == 0; P.H = Hb; P.gpre = args.in[6] + D; P.sc_chunk = 1; P.sh_chunk = 0; P.modxH = modx + (size_t)16 * ADA; P.modcH = modc + ADA;
        row_phase(F, P);
        if (LAYER == 0) {
            const int ntr0 = (int)__hip_atomic_load(F.ctl + CW_TST + 256, __ATOMIC_RELAXED, __HIP_MEMORY_SCOPE_AGENT); int s9, s10; fill1_ranges(F, ntr0, s9, s10);
            if (F.G != 256) cvt_moe_range(F, args, 1, 0, MOE_CVT_ITEMS, F.vcu, F.G);
        }
    }
    SEAM(mb + 4);
}

__global__ void __launch_bounds__(NTHREADS, 2) mk_fwd(Args args) {
    extern __shared__ __attribute__((aligned(16))) unsigned char lds_raw[];
    Frame F;
    F.lds = (LAS unsigned char*)lds_raw; F.MISC = (volatile LAS unsigned*)(F.lds + MISC_OFF);
    F.tid = threadIdx.x; F.lane = F.tid & 63; F.wave = __builtin_amdgcn_readfirstlane(F.tid >> 6);
    F.G = gridDim.x; { const int bx = blockIdx.x; F.vcu = (F.G % 8 == 0) ? (bx % 8) * (F.G / 8) + bx / 8 : bx; }
    F.ws = args.ws; F.ctl = (unsigned*)(args.ws + WS_CTL);
    for (int u = F.tid; u < (LDS_BYTES - MISC_OFF) / 4; u += NTHREADS) ((LAS unsigned*)(F.lds + MISC_OFF))[u] = 0u;
    __syncthreads();
    XcdBarrier bar; bar.bar = F.ctl + CW_BAR; bar.x = 0; bar.st = nullptr;
#if MK_ONE_LAUNCH
    bar = xcd_barrier_post(F.ctl + CW_BAR, F.MISC + 8);
#endif
    const int lo = args.ph_lo, hi = args.ph_hi;
    unsigned char* ws = args.ws;
    const float* modx = (const float*)(ws + WS_MODX); const float* modc = (const float*)(ws + WS_MODC);
    float* xw = (float*)(ws + WS_XW); bf16_t* Hb = (bf16_t*)(ws + WS_H);

    if (IN(0)) REPEAT_IF(0) { REP_BAR(); p0_ada(F, args); p0_convert(F, args); }
    SEAM(0);
    {
        if (IN(1)) REPEAT_IF(1) { REP_BAR();
            RowPhase P{}; P.xin_lat = args.in[0]; P.xin_ctx = args.in[2]; P.nrows = NT; P.ysrc = 0; P.modx = modx; P.modc = modc;
            P.doH = true; P.H = Hb; P.gpre = args.in[6]; P.sc_chunk = 1; P.sh_chunk = 0; P.modxH = modx; P.modcH = modc;
            row_phase(F, P);
        }
        SEAM(1);
        if (IN(2)) REPEAT_IF(2) { REP_BAR();
            SchedDense S{(const char*)Hb, (const char*)(ws + WS_WIN0), D, NT / 256, AB_INP / 256, 0, 1, 0, F.G, (int)blockIdx.x};
            EpiInproj E{(bf16_t*)(ws + T_QB), (bf16_t*)(ws + T_KB), (bf16_t*)(ws + T_VB), (bf16_t*)(ws + T_GB), (bf16_t*)(ws + T_UB), (float*)(ws + T_LR), (const f32x2*)(ws + WS_ROPE)};
            pg8::gemm_phase<EpiInproj, SchedDense, true>(F.lds, D, S, E);
            if (F.G == 256 && (int)blockIdx.x >= 48) cvt_moe_range(F, args, 0, F0_BULK, F0_BULK + F0_P2, (int)blockIdx.x - 48, 208);
        }
        SEAM(2);
        if (IN(3)) REPEAT_IF(3) { REP_BAR(); gla_prep_phase(F, args); }
        if (IN(3) && IN(22)) GRID_BAR();
        if (IN(22)) REPEAT_IF(22) { REP_BAR(); gla_seq_phase(F, args); }
        if (IN(22) && IN(4)) GRID_BAR();
        if (IN(4)) REPEAT_IF(4) { REP_BAR(); finish_conv_phase(F, args); }
        SEAM(4);

    }
    layer_tail<0>(F, args, lo, hi, bar);
    {
        if (IN(12)) REPEAT_IF(12) { REP_BAR();
            SchedDense S{(const char*)Hb, (const char*)(ws + WS_WQKV1), D, NX / 256, 12, NC / 256, 8, 4, F.G, (int)blockIdx.x};
            EpiBf16 E{(bf16_t*)(ws + T_QKV), D, D, (size_t)NT * D, 0.125f * 1.4426950408889634f};
            pg8::gemm_phase<EpiBf16, SchedDense, true>(F.lds, D, S, E);
            if (F.G == 256 && (int)blockIdx.x >= 128) cvt_moe_range(F, args, 1, MOE_CVT_ITEMS - F1_P12, MOE_CVT_ITEMS, (int)blockIdx.x - 128, 128);
        }
        SEAM(12);
        if (IN(13)) REPEAT_IF(13) { REP_BAR(); na_phase(F, args); }
        SEAM(13);

    }
    layer_tail<1>(F, args, lo, hi, bar);

#undef IN
#undef SEAM
}

extern "C" void kernel_launch(void* const* d_in, const int* in_sizes, int n_in, void* d_out, int out_size, void* d_ws, size_t ws_size, hipStream_t stream) {
    static int grid = 0;
    if (grid == 0) {
        if (n_in != 32 || out_size != NX * D || ws_size < WS_END) { fprintf(stderr, "kernel_launch: unexpected problem (n_in %d, out %d, ws %zu < %zu)\n", n_in, out_size, ws_size, (size_t)WS_END); grid = -1; return; }
        int dev = 0, cus = 0, per_cu = 0;
        if (hipGetDevice(&dev) != hipSuccess || hipDeviceGetAttribute(&cus, hipDeviceAttributeMultiprocessorCount, dev) != hipSuccess) { grid = -1; return; }
        if (hipFuncSetAttribute((const void*)mk_fwd, hipFuncAttributeMaxDynamicSharedMemorySize, LDS_BYTES) != hipSuccess) { fprintf(stderr, "kernel_launch: hipFuncSetAttribute failed\n"); grid = -1; return; }
        if (hipOccupancyMaxActiveBlocksPerMultiprocessor(&per_cu, (const void*)mk_fwd, NTHREADS, LDS_BYTES) != hipSuccess || per_cu < 1) fprintf(stderr, "kernel_launch: occupancy query says %d\n", per_cu);
        (void)hipGetLastError();
        grid = cus;
    }
    if (grid < 0) return;
    (void)hipMemsetAsync((char*)d_ws + WS_CTL, 0, CTL_BYTES, stream);
    Args a{};
    for (int i = 0; i < 32; ++i) a.in[i] = (const float*)d_in[i];
    a.out = (float*)d_out; a.ws = (unsigned char*)d_ws;
#if MK_ONE_LAUNCH
    a.ph_lo = 0; a.ph_hi = 64;
    hipLaunchKernelGGL(mk_fwd, dim3(grid), dim3(NTHREADS), LDS_BYTES, stream, a);
#else
    for (int p = 0; p <= 20; ++p) { if (p > MK_LAST_PHASE) break; a.ph_lo = p; a.ph_hi = p + 1; hipLaunchKernelGGL(mk_fwd, dim3(grid), dim3(NTHREADS), LDS_BYTES, stream, a); }
#endif
}
```

```cpp
#include <hip/hip_runtime.h>
#include <cstdio>
#include <cstdint>

#ifndef MK_ONE_LAUNCH
#define MK_ONE_LAUNCH 1
#endif
#ifndef MK_LAST_PHASE
#define MK_LAST_PHASE 99
#endif

#ifndef MK_REP
#define MK_REP (-1)
#endif
#define REPEAT_IF(k) _Pragma("unroll") for (int _r = 0; _r < ((k) == MK_REP ? 2 : 1); ++_r)
#define REP_BAR() do { if (_r) GRID_BAR(); } while (0)

#define GAS __attribute__((address_space(1)))
#define LAS __attribute__((address_space(3)))
typedef unsigned short bf16_t;
typedef short bf16x8 __attribute__((ext_vector_type(8)));
typedef float f32x4 __attribute__((ext_vector_type(4)));
typedef float f32x2 __attribute__((ext_vector_type(2)));
typedef unsigned u32x4 __attribute__((ext_vector_type(4)));
typedef unsigned u32x2 __attribute__((ext_vector_type(2)));

constexpr int D = 1024, BATCH = 16, SEQ = 2048, CTXL = 256, GRIDW = 64;
constexpr int NX = BATCH * SEQ, NC = BATCH * CTXL, NT = NX + NC;
constexpr int ADA = 6 * D;
constexpr int GLA_H = 4, GLA_DK = 64, GLA_DV = 128, GLA_QK = 256, GLA_V = 512, CONV_CH = 512, CONV_W = 31;
constexpr int AB_IN = 2592, AB_INP = 2816;
constexpr int NA_H = 16, NA_DH = 64;
constexpr int NEXP = 256, TOPK = 8, DEXP = 256;
constexpr int NEXPS = NEXP + 1;
constexpr int PMAX = NT * TOPK + NEXP * 255 + NT;
static_assert(PMAX % 256 == 0, "PMAX");
constexpr float RMS_EPS = 1e-6f, LN_EPS = 1e-5f;
constexpr float F8_SCALE = 16.0f, F8_INV = 1.0f / 16.0f;

constexpr size_t MiB = 1u << 20;
constexpr size_t al(size_t x) { return (x + 4095) & ~(size_t)4095; }
constexpr size_t WS_CTL = 0, CTL_BYTES = 1 * MiB;
constexpr size_t WS_MODX = WS_CTL + CTL_BYTES;
constexpr size_t WS_MODC = WS_MODX + al((size_t)2 * 16 * ADA * 4);
constexpr size_t WS_ROPE = WS_MODC + al((size_t)2 * ADA * 4);
constexpr size_t WS_XW = WS_ROPE + al(64 * 16 * 8);
constexpr size_t M_LST = WS_XW + al((size_t)NT * D * 2);
constexpr int LCAP = NT;
static_assert(M_LST + (size_t)NEXP * LCAP * 4 <= WS_XW + al((size_t)NT * D * 4), "token lists");
constexpr size_t WS_H = WS_XW + al((size_t)NT * D * 4);
constexpr size_t WS_WIN0 = WS_H + al((size_t)NT * D * 2);
constexpr size_t WS_WOUT0 = WS_WIN0 + al((size_t)AB_INP * D * 2);
constexpr size_t WS_WQKV1 = WS_WOUT0 + al((size_t)D * D * 2);
constexpr size_t WS_WOUT1 = WS_WQKV1 + al((size_t)3 * D * D * 2);
constexpr size_t WS_WR = WS_WOUT1 + al((size_t)D * D * 2);
constexpr size_t WGU_BYTES = al((size_t)NEXPS * 512 * D * 2), WDN_BYTES = al((size_t)NEXPS * D * 256 * 2);
constexpr size_t WS_WGU = WS_WR + al((size_t)2 * NEXP * D * 2);
constexpr size_t WS_WDN = WS_WGU + 2 * WGU_BYTES;
constexpr size_t WS_T = WS_WDN + 2 * WDN_BYTES;
constexpr size_t T_QB = WS_T;
constexpr size_t T_KB = T_QB + al((size_t)NT * 256 * 2);
constexpr size_t T_VB = T_KB + al((size_t)NT * 256 * 2);
constexpr size_t T_GB = T_VB + al((size_t)NT * 512 * 2);
constexpr size_t T_UB = T_GB + al((size_t)NT * 512 * 2);
constexpr size_t T_LR = T_UB + al((size_t)NT * 512 * 2);
constexpr size_t T_OF = T_LR + al((size_t)NT * 32 * 4);
constexpr size_t T_OB = T_OF + al((size_t)NT * 512 * 2);
constexpr size_t T_CAT = T_OB + al((size_t)NT * 512 * 2);
constexpr size_t T_Y = T_CAT + al((size_t)NT * D * 2);
constexpr size_t T_GLA = T_Y + al((size_t)NT * D * 2);
constexpr int GI_A = 0, GI_QIN = 8192, GI_KOT = 16384, GI_VT = 24576, GI_DEC = 40960, GI_BYTES = 41216;
constexpr size_t T_END0 = T_GLA + al((size_t)BATCH * GLA_H * 2 * 36 * GI_BYTES + 1024);
constexpr size_t T_QKV = WS_T;
static_assert(T_QKV + (size_t)3 * NT * D * 2 <= T_CAT, "qkv overlay");
constexpr size_t M_AE = WS_T;
constexpr size_t M_AR = M_AE + al((size_t)NT * 8 * 4);
constexpr size_t M_AG = M_AR + al((size_t)NT * 8 * 4);
constexpr size_t M_TS = M_AG + al((size_t)NT * 8 * 4);
constexpr size_t M_ST = M_TS + al((size_t)NT * 8 * 4);
constexpr size_t M_HID = M_ST + al((size_t)PMAX * 4);
constexpr size_t M_OUT = M_HID + al((size_t)PMAX * 256 * 2);
constexpr int MO_LD = 1024;
constexpr size_t M_END = M_OUT + al((size_t)PMAX * D);
constexpr size_t WS_END = (M_END > T_END0 ? M_END : T_END0);
static_assert(WS_END <= (size_t)2040 * MiB, "workspace map must fit 2 GiB");

constexpr int CW_BAR = 4096;
constexpr int CW_CNT = 16384;
constexpr int CW_CUR = 16384 + 512;

constexpr int RING_BYTES = 131072;
constexpr int AUX_OFF = RING_BYTES, AUX_BYTES = 31744;
constexpr int MISC_OFF = AUX_OFF + AUX_BYTES;
constexpr int LDS_BYTES = MISC_OFF + 1024;
constexpr int NWAVES = 8, NTHREADS = 512;

#define LDS_WAIT() asm volatile("s_waitcnt lgkmcnt(0)" ::: "memory")
#define VM_WAIT() asm volatile("s_waitcnt vmcnt(0)" ::: "memory")

__device__ __forceinline__ unsigned f2bf(float f) { unsigned u = __builtin_bit_cast(unsigned, f); return (u + 0x7fffu + ((u >> 16) & 1u)) >> 16; }
__device__ __forceinline__ unsigned pk2(float lo, float hi) { return f2bf(lo) | (f2bf(hi) << 16); }
__device__ __forceinline__ float bf2f(unsigned short b) { return __builtin_bit_cast(float, (unsigned)b << 16); }
__device__ __forceinline__ float bflo(unsigned w) { return __builtin_bit_cast(float, w << 16); }
__device__ __forceinline__ float bfhi(unsigned w) { return __builtin_bit_cast(float, w & 0xffff0000u); }
__device__ __forceinline__ float wave_sum(float v) {
#pragma unroll
    for (int o = 1; o < 64; o <<= 1) v += __shfl_xor(v, o);
    return v;
}
__device__ __forceinline__ float sigmoidf_(float x) { return 1.0f / (1.0f + __expf(-x)); }
__device__ __forceinline__ float siluf_(float x) { return x / (1.0f + __expf(-x)); }

__device__ __forceinline__ void lds_barrier() { asm volatile("s_waitcnt lgkmcnt(0)" ::: "memory"); __builtin_amdgcn_s_barrier(); asm volatile("" ::: "memory"); }
#define XB_TMO      128
#define XB_XCNT(j)  (256  + 64 * (j))
#define XB_XSUB(j)  (1280 + 64 * (j))
#define XB_XGEN(j)  (2304 + 64 * (j))
#define XB_TOP      3328
#define XB_TOPGEN   3392
#define XCD_BAR_WORDS 3456
#define XB_SPIN_CAP (1u << 18)

__device__ __forceinline__ unsigned xb_ld(unsigned* p)              { return __hip_atomic_load(p, __ATOMIC_RELAXED, __HIP_MEMORY_SCOPE_AGENT); }
__device__ __forceinline__ unsigned xb_add(unsigned* p, unsigned v) { return __hip_atomic_fetch_add(p, v, __ATOMIC_RELAXED, __HIP_MEMORY_SCOPE_AGENT); }
__device__ __forceinline__ unsigned xb_xcc_id() { return (unsigned)__builtin_amdgcn_s_getreg((3 << 11) | 20) & 0xFu; }
#define XB_SPIN(cond, bar) do { unsigned _sp = 0; while (cond) { __builtin_amdgcn_s_sleep(1); \
    if ((++_sp & 255u) == 0u) { if (xb_ld(&(bar)[XB_TMO])) break; if (_sp > XB_SPIN_CAP) { atomicAdd(&(bar)[XB_TMO], 1u); break; } } } } while (0)

struct XcdBarrier { unsigned* bar; unsigned x; volatile LAS unsigned* st; };

__device__ __forceinline__ XcdBarrier xcd_barrier_post(unsigned* bar, volatile LAS unsigned* st) {
    XcdBarrier b; b.bar = bar; b.x = xb_xcc_id(); b.st = st;
    if (threadIdx.x == 0) (void)xb_add(&bar[XB_XCNT(b.x)], 1u);
    return b;
}
__device__ __forceinline__ void xcd_barrier_complete(unsigned* bar, unsigned x, unsigned& nloc, unsigned& nx) {
    const unsigned G = gridDim.x * gridDim.y * gridDim.z;
    unsigned sum, cnt, mine, sp = 0u;
    for (;;) {
        sum = 0u; cnt = 0u; mine = 0u;
#pragma unroll
        for (unsigned j = 0; j < 16; ++j) { const unsigned c = xb_ld(&bar[XB_XCNT(j)]); sum += c; cnt += (c > 0u) ? 1u : 0u; mine = (j == x) ? c : mine; }
        if (sum == G) break;
        __builtin_amdgcn_s_sleep(1);
        if ((++sp & 255u) == 0u) { if (xb_ld(&bar[XB_TMO])) break; if (sp > XB_SPIN_CAP) { atomicAdd(&bar[XB_TMO], 1u); break; } }
    }
    nloc = mine > 0u ? mine : 1u; nx = cnt > 0u ? cnt : 1u;
}
__device__ __forceinline__ void xcd_barrier(const XcdBarrier& b) {
    asm volatile("s_waitcnt vmcnt(0)" ::: "memory");
    __syncthreads();
    if (threadIdx.x == 0) {
        unsigned* bar = b.bar;
        __builtin_amdgcn_s_waitcnt(0);
        unsigned nloc = b.st[0], nx = b.st[1];
        if (nloc == 0u) { xcd_barrier_complete(bar, b.x, nloc, nx); b.st[0] = nloc; b.st[1] = nx; }
        const unsigned old = xb_add(&bar[XB_XSUB(b.x)], 1u);
        const unsigned gen = old / nloc;
        if (old + 1u == (gen + 1u) * nloc) {
            __builtin_amdgcn_fence(__ATOMIC_RELEASE, "agent");
            asm volatile("s_waitcnt vmcnt(0)" ::: "memory");
            const unsigned og = xb_add(&bar[XB_TOP], 1u);
            const unsigned tg = og / nx;
            if (og + 1u == (tg + 1u) * nx) xb_add(&bar[XB_TOPGEN], 1u);
            else XB_SPIN(xb_ld(&bar[XB_TOPGEN]) == tg, bar);
            __builtin_amdgcn_fence(__ATOMIC_ACQUIRE, "agent");
            xb_add(&bar[XB_XGEN(b.x)], 1u);
            asm volatile("s_waitcnt vmcnt(0)" ::: "memory");
        } else {
            XB_SPIN(xb_ld(&bar[XB_XGEN(b.x)]) == gen, bar);
            __builtin_amdgcn_fence(__ATOMIC_ACQUIRE, "agent");
            asm volatile("s_waitcnt vmcnt(0)" ::: "memory");
        }
    }
    __syncthreads();
}

namespace pg8 {
constexpr int BM = 256, BK = 64, HALF = 128, HTB = HALF * BK * 2, STAGE_BYTES = 8 * HTB, NXCD = 8, WGM = 8;
__host__ __device__ __forceinline__ int lds_byte(int r, int c) { const int st = (r >> 4) * 2 + (c >> 5), rr = r & 15, cc = c & 31, ob = rr * 64 + cc * 2; return st * 1024 + (ob ^ (((ob >> 9) & 1) << 5)); }
__host__ __device__ __forceinline__ void stage_rc(int b, int& R, int& C) { const int st = b / 1024, sb = b % 1024, swz = sb ^ (((sb >> 9) & 1) << 5); R = (st >> 1) * 16 + swz / 64; C = (st & 1) * 32 + (swz % 64) / 2; }
__host__ __device__ __forceinline__ int perm32(int rho) { const int n = rho >> 4, i = rho & 15; return 8 * (i >> 2) + 4 * n + (i & 3); }

struct Unit { int a, b, orow, ocol, aux; };

__device__ __forceinline__ bool static_order(int L, int nM, int nN, int& pm, int& pn) {
    const int nwg = nM * nN; if (L >= nwg) return false;
    int wgid = L; { const int q = nwg / NXCD, r = nwg % NXCD, xcd = wgid % NXCD, off = wgid / NXCD; wgid = (xcd < r ? xcd * (q + 1) : r * (q + 1) + (xcd - r) * q) + off; }
    const int nig = WGM * nN, gid = wgid / nig, fm = gid * WGM, gsz = (nM - fm) < WGM ? (nM - fm) : WGM;
    pm = fm + ((wgid % nig) % gsz); pn = (wgid % nig) / gsz; return true;
}

template <class Epi, class Sched, bool ALIGN_EPI>
__device__ __forceinline__ void gemm_phase(LAS unsigned char* lds, const int K, const Sched& S, const Epi& E) {
    const int tid = threadIdx.x, wid = __builtin_amdgcn_readfirstlane(tid >> 6), lane = tid & 63, wr = wid >> 2, wc = wid & 3, fr = lane & 15, fq = lane >> 4;
    const int nt = K / BK;
    int Rr[2], Cc[2]; unsigned voffB[2];
#pragma unroll
    for (int i = 0; i < 2; ++i) { int R, C; stage_rc(tid * 16 + i * 8192, R, C); Rr[i] = R; Cc[i] = C; const int Rb = Epi::PERM ? ((R & ~31) + perm32(R & 31)) : R; voffB[i] = (unsigned)(Rb * K + C) * 2u; }
    const size_t kstep = (size_t)(BK * 2);
    const size_t hstepB = (size_t)HALF * K * 2;
    const unsigned ldsw = (unsigned)wid * 1024u;
    const int aoff = lds_byte(wr * 64 + fr, fq * 8), boff = lds_byte(wc * 32 + fr, fq * 8);
#define PG8_SA(b, h) (((b) * 2 + (h)) * HTB)
#define PG8_SB(b, h) ((4 + (b) * 2 + (h)) * HTB)
#define PG8_STAGE(bufoff, gbase, voff) do { _Pragma("unroll") for (int _i = 0; _i < 2; ++_i) \
        __builtin_amdgcn_global_load_lds((const unsigned*)((const char*)(gbase) + (voff)[_i]), (LAS unsigned*)(lds + (bufoff) + ldsw + _i * 8192), 16, 0, 0); } while (0)
#define PG8_LDA(dst, b, h) do { _Pragma("unroll") for (int m = 0; m < 4; ++m) _Pragma("unroll") for (int k = 0; k < 2; ++k) dst[m][k] = *(const LAS bf16x8*)(lds + PG8_SA(b, h) + aoff + m * 2048 + k * 1024); } while (0)
#define PG8_LDB(dst, b, h) do { _Pragma("unroll") for (int n = 0; n < 2; ++n) _Pragma("unroll") for (int k = 0; k < 2; ++k) dst[n][k] = *(const LAS bf16x8*)(lds + PG8_SB(b, h) + boff + n * 2048 + k * 1024); } while (0)
#define PG8_MMA(ai, bj, At, Bt) do { __builtin_amdgcn_s_setprio(1); _Pragma("unroll") for (int m = 0; m < 4; ++m) _Pragma("unroll") for (int n = 0; n < 2; ++n) _Pragma("unroll") for (int k = 0; k < 2; ++k) \
        acc[ai][bj][m][n] = __builtin_amdgcn_mfma_f32_16x16x32_bf16(Bt[n][k], At[m][k], acc[ai][bj][m][n], 0, 0, 0); __builtin_amdgcn_s_setprio(0); } while (0)
#define PG8_WAIT_V(n) asm volatile("s_waitcnt vmcnt(" #n ")" ::: "memory")
#define PG8_WAIT_L(n) asm volatile("s_waitcnt lgkmcnt(" #n ")" ::: "memory")
#define PG8_BAR __builtin_amdgcn_s_barrier()
#define PG8_SCHED __builtin_amdgcn_sched_barrier(0)
    Unit cur, nxt; int ui = 0;
    if (!S.next(0, cur)) return;
    f32x4 acc[2][2][4][2];
#pragma unroll
    for (int a = 0; a < 2; ++a)
#pragma unroll
        for (int b = 0; b < 2; ++b)
#pragma unroll
            for (int m = 0; m < 4; ++m)
#pragma unroll
                for (int n = 0; n < 2; ++n) acc[a][b][m][n] = (f32x4){0.f, 0.f, 0.f, 0.f};
    bf16x8 At[4][2], B0[2][2], B1[2][2];
    unsigned co0[2], co1[2], no0[2], no1[2];
    S.a_off(cur, Rr, Cc, co0, co1);
    const char* const Ab = S.a_base();
    const char* cB = S.b_ptr(cur);
    PG8_STAGE(PG8_SB(0, 0), cB, voffB); PG8_STAGE(PG8_SB(0, 1), cB + hstepB, voffB); PG8_STAGE(PG8_SA(0, 0), Ab, co0); PG8_STAGE(PG8_SA(0, 1), Ab, co1);
    if (wr == 1) PG8_BAR;
    PG8_WAIT_V(2); PG8_BAR;
    PG8_STAGE(PG8_SB(1, 0), cB + kstep, voffB); PG8_STAGE(PG8_SA(1, 0), Ab + kstep, co0); PG8_STAGE(PG8_SB(1, 1), cB + hstepB + kstep, voffB);
    PG8_WAIT_V(6); PG8_BAR;
    for (;;) {
        const bool has_next = S.next(ui + 1, nxt);
        const char* nB = has_next ? S.b_ptr(nxt) : cB;
#pragma nounroll
        for (int t = 0; t < nt; t += 2) {
            const bool last = (t == nt - 2);
            if (last) { if (has_next) S.a_off(nxt, Rr, Cc, no0, no1); else { no0[0] = co0[0]; no0[1] = co0[1]; no1[0] = co1[0]; no1[1] = co1[1]; } }
            const char* a1 = Ab + (size_t)(t + 1) * kstep;
            const char* a2 = last ? Ab : Ab + (size_t)(t + 2) * kstep; const char* b2 = last ? nB : cB + (size_t)(t + 2) * kstep;
            const char* a3 = a2 + kstep; const char* b3 = b2 + kstep;
            unsigned x0[2], x1[2];
            x0[0] = last ? no0[0] : co0[0]; x0[1] = last ? no0[1] : co0[1]; x1[0] = last ? no1[0] : co1[0]; x1[1] = last ? no1[1] : co1[1];
            PG8_LDB(B0, 0, 0); PG8_LDB(B1, 0, 1); PG8_SCHED; PG8_LDA(At, 0, 0); PG8_STAGE(PG8_SA(1, 1), a1, co1);
            PG8_WAIT_V(8); PG8_WAIT_L(0); PG8_BAR; PG8_MMA(0, 0, At, B0); PG8_MMA(0, 1, At, B1); PG8_BAR; PG8_SCHED;
            PG8_LDA(At, 0, 1); PG8_STAGE(PG8_SB(0, 0), b2, voffB); PG8_STAGE(PG8_SB(0, 1), b2 + hstepB, voffB); PG8_STAGE(PG8_SA(0, 0), a2, x0);
            PG8_WAIT_V(8); PG8_WAIT_L(0); PG8_BAR; PG8_MMA(1, 0, At, B0); PG8_MMA(1, 1, At, B1); PG8_BAR; PG8_SCHED;
            PG8_LDB(B0, 1, 0); PG8_LDB(B1, 1, 1); PG8_SCHED; PG8_LDA(At, 1, 0); PG8_STAGE(PG8_SA(0, 1), a2, x1);
            PG8_WAIT_V(8); PG8_WAIT_L(0); PG8_BAR; PG8_MMA(0, 0, At, B0); PG8_MMA(0, 1, At, B1); PG8_BAR; PG8_SCHED;
            PG8_LDA(At, 1, 1); PG8_STAGE(PG8_SB(1, 0), b3, voffB); PG8_STAGE(PG8_SB(1, 1), b3 + hstepB, voffB); PG8_STAGE(PG8_SA(1, 0), a3, x0);
            PG8_WAIT_V(8); PG8_WAIT_L(0); PG8_BAR; PG8_MMA(1, 0, At, B0); PG8_MMA(1, 1, At, B1); PG8_BAR; PG8_SCHED;
        }
        if constexpr (ALIGN_EPI) { if (wr == 0) PG8_BAR; }
        if constexpr (!Epi::AFTER_DRAIN) { E(acc, cur, wr, wc, fr, fq); }
        if (!has_next) break;
#pragma unroll
        for (int a = 0; a < 2; ++a)
#pragma unroll
            for (int b = 0; b < 2; ++b)
#pragma unroll
                for (int m = 0; m < 4; ++m)
#pragma unroll
                    for (int n = 0; n < 2; ++n) acc[a][b][m][n] = (f32x4){0.f, 0.f, 0.f, 0.f};
        cur = nxt; cB = nB; co0[0] = no0[0]; co0[1] = no0[1]; co1[0] = no1[0]; co1[1] = no1[1]; ++ui;
        if constexpr (ALIGN_EPI) { if (wr == 1) PG8_BAR; }
    }
    PG8_WAIT_V(0);
    if constexpr (!ALIGN_EPI) { if (wr == 0) PG8_BAR; }
    PG8_BAR;
    if constexpr (Epi::AFTER_DRAIN) { E.fused(acc, cur, wr, wc, fr, fq, lds, wid, lane); }
#undef PG8_SA
#undef PG8_SB
#undef PG8_STAGE
#undef PG8_LDA
#undef PG8_LDB
#undef PG8_MMA
#undef PG8_WAIT_V
#undef PG8_WAIT_L
#undef PG8_BAR
#undef PG8_SCHED
}
}
using pg8::Unit;

__device__ __forceinline__ unsigned cvt_pk_bf16(float lo, float hi) { unsigned r; asm volatile("v_cvt_pk_bf16_f32 %0, %1, %2" : "=v"(r) : "v"(lo), "v"(hi)); return r; }

struct SchedDense {
    const char* A; const char* Bt; int K; int nM0, nN0, nM1, nN1, pn1off; int G, c;
    __device__ __forceinline__ bool next(int i, Unit& u) const {
        const int L = i * G + c; int pm, pn;
        const int n0 = nM0 * nN0;
        if (L < n0) { pg8::static_order(L, nM0, nN0, pm, pn); }
        else { if (!pg8::static_order(L - n0, nM1, nN1, pm, pn)) return false; pm += nM0; pn += pn1off; }
        u.a = pm; u.b = pn * 256; u.orow = pm * 256; u.ocol = pn * 256; u.aux = pn; return true;
    }
    __device__ __forceinline__ const char* a_base() const { return A; }
    __device__ __forceinline__ const char* b_ptr(const Unit& u) const { return Bt + (size_t)u.b * K * 2; }
    __device__ __forceinline__ void a_off(const Unit& u, const int (&R)[2], const int (&C)[2], unsigned (&o0)[2], unsigned (&o1)[2]) const {
#pragma unroll
        for (int i = 0; i < 2; ++i) { o0[i] = (unsigned)((u.a * 256 + R[i]) * K + C[i]) * 2u; o1[i] = o0[i] + (unsigned)(128 * K * 2); }
    }
};

struct EpiBf16 {
    static constexpr bool PERM = true, AFTER_DRAIN = false;
    bf16_t* O; int ldc; int split_cols; size_t split_stride; float scale0 = 1.0f;
    __device__ __forceinline__ void operator()(const f32x4 (&acc)[2][2][4][2], const Unit& u, int wr, int wc, int fr, int fq) const {
        const int lane = fr + 16 * fq; const int srcb = ((lane >> 2) + 16 * (lane & 3)) << 2;
        const int row0 = u.orow + wr * 64 + (lane >> 2); int colt = u.ocol; bf16_t* base = O;
        float sc = 1.0f;
        if (split_cols) { const int t = colt / split_cols; base += (size_t)t * split_stride; colt -= t * split_cols; if (t == 0) sc = scale0; }
        const int col0 = colt + wc * 32 + 8 * (lane & 3);
#pragma unroll
        for (int ai = 0; ai < 2; ++ai)
#pragma unroll
            for (int m = 0; m < 4; ++m) { bf16_t* rowp = base + (size_t)(row0 + ai * 128 + m * 16) * ldc + col0;
#pragma unroll
                for (int bj = 0; bj < 2; ++bj) { const f32x4 v0 = acc[ai][bj][m][0] * sc, v1 = acc[ai][bj][m][1] * sc;
                    u32x4 w; w.x = cvt_pk_bf16(v0[0], v0[1]); w.y = cvt_pk_bf16(v0[2], v0[3]); w.z = cvt_pk_bf16(v1[0], v1[1]); w.w = cvt_pk_bf16(v1[2], v1[3]);
                    u32x4 t; t.x = (unsigned)__builtin_amdgcn_ds_bpermute(srcb, (int)w.x); t.y = (unsigned)__builtin_amdgcn_ds_bpermute(srcb, (int)w.y); t.z = (unsigned)__builtin_amdgcn_ds_bpermute(srcb, (int)w.z); t.w = (unsigned)__builtin_amdgcn_ds_bpermute(srcb, (int)w.w);
                    *(u32x4*)(rowp + bj * 128) = t; } }
    }
};
struct EpiF8 {
    static constexpr bool PERM = true, AFTER_DRAIN = false;
    unsigned char* O;
    __device__ __forceinline__ int nst(const Unit&, int) const { return 16; }
    __device__ __forceinline__ void operator()(const f32x4 (&acc)[2][2][4][2], const Unit& u, int wr, int wc, int fr, int fq) const {
        const int lane = fr + 16 * fq; const int srcb = ((lane >> 2) + 16 * (lane & 3)) << 2;
        const int row0 = u.orow + wr * 64 + (lane >> 2), col0 = u.ocol + wc * 32 + 8 * (lane & 3);
#pragma unroll
        for (int ai = 0; ai < 2; ++ai)
#pragma unroll
            for (int m = 0; m < 4; ++m) { unsigned char* rowp = O + (size_t)(row0 + ai * 128 + m * 16) * D + col0;
#pragma unroll
                for (int bj = 0; bj < 2; ++bj) { const f32x4 v0 = acc[ai][bj][m][0] * F8_SCALE, v1 = acc[ai][bj][m][1] * F8_SCALE;
                    int w0 = __builtin_amdgcn_cvt_pk_fp8_f32(v0[0], v0[1], 0, false); w0 = __builtin_amdgcn_cvt_pk_fp8_f32(v0[2], v0[3], w0, true);
                    int w1 = __builtin_amdgcn_cvt_pk_fp8_f32(v1[0], v1[1], 0, false); w1 = __builtin_amdgcn_cvt_pk_fp8_f32(v1[2], v1[3], w1, true);
                    u32x2 t; t.x = (unsigned)__builtin_amdgcn_ds_bpermute(srcb, w0); t.y = (unsigned)__builtin_amdgcn_ds_bpermute(srcb, w1);
                    *(u32x2*)(rowp + bj * 128) = t; } }
    }
};
struct EpiInproj {
    static constexpr bool PERM = false, AFTER_DRAIN = false;
    bf16_t *qb, *kb, *vb, *gb, *ub; float* lr; const f32x2* rope;
    __device__ __forceinline__ void operator()(const f32x4 (&acc)[2][2][4][2], const Unit& u, int wr, int wc, int fr, int fq) const {
        const int pn = u.aux; const int row0 = u.orow + wr * 64 + fr;
        if (pn <= 1) {
            bf16_t* dst = pn == 0 ? qb : kb; const float sc = pn == 0 ? 0.125f : 1.0f;
#pragma unroll
            for (int ai = 0; ai < 2; ++ai)
#pragma unroll
                for (int m = 0; m < 4; ++m) {
                    const int row = row0 + ai * 128 + m * 16; const bool lat = row < NX;
                    const int s = row & (SEQ - 1); const int pos = (wc & 1) ? (s & 63) : (s >> 6);
                    f32x2 cs[4];
                    if (lat) {
#pragma unroll
                        for (int e = 0; e < 4; ++e) cs[e] = rope[pos * 16 + 4 * fq + e];
                    } else {
#pragma unroll
                        for (int e = 0; e < 4; ++e) cs[e] = (f32x2){1.f, 0.f};
                    }
#pragma unroll
                    for (int bj = 0; bj < 2; ++bj) {
                        const f32x4 u1 = acc[ai][bj][m][0], u2 = acc[ai][bj][m][1]; f32x4 o1, o2;
#pragma unroll
                        for (int e = 0; e < 4; ++e) { o1[e] = (u1[e] * cs[e].x - u2[e] * cs[e].y) * sc; o2[e] = (u1[e] * cs[e].y + u2[e] * cs[e].x) * sc; }
                        bf16_t* p = dst + (size_t)row * 256 + bj * 128 + wc * 32 + 4 * fq;
                        u32x2 w1, w2; w1.x = cvt_pk_bf16(o1[0], o1[1]); w1.y = cvt_pk_bf16(o1[2], o1[3]); w2.x = cvt_pk_bf16(o2[0], o2[1]); w2.y = cvt_pk_bf16(o2[2], o2[3]);
                        *(u32x2*)p = w1; *(u32x2*)(p + 16) = w2;
                    }
                }
        } else if (pn <= 5) {
            bf16_t* dst = pn <= 3 ? vb : gb; const int cb = (pn & 1) ? 256 : 0;
#pragma unroll
            for (int ai = 0; ai < 2; ++ai)
#pragma unroll
                for (int m = 0; m < 4; ++m) { const int row = row0 + ai * 128 + m * 16;
#pragma unroll
                    for (int bj = 0; bj < 2; ++bj)
#pragma unroll
                        for (int n = 0; n < 2; ++n) { const f32x4 v = acc[ai][bj][m][n]; u32x2 w; w.x = cvt_pk_bf16(v[0], v[1]); w.y = cvt_pk_bf16(v[2], v[3]);
                            *(u32x2*)(dst + (size_t)row * 512 + cb + bj * 128 + wc * 32 + n * 16 + 4 * fq) = w; } }
        } else if (pn <= 9) {
            const int cb = (pn - 6) * 128;
#pragma unroll
            for (int ai = 0; ai < 2; ++ai)
#pragma unroll
                for (int m = 0; m < 4; ++m) { const int row = row0 + ai * 128 + m * 16;
#pragma unroll
                    for (int n = 0; n < 2; ++n) { const f32x4 a = acc[ai][0][m][n], b = acc[ai][1][m][n]; f32x4 o;
#pragma unroll
                        for (int e = 0; e < 4; ++e) o[e] = a[e] * sigmoidf_(b[e]);
                        u32x2 w; w.x = cvt_pk_bf16(o[0], o[1]); w.y = cvt_pk_bf16(o[2], o[3]);
                        *(u32x2*)(ub + (size_t)row * 512 + cb + wc * 32 + n * 16 + 4 * fq) = w; } }
        } else {
            if (wc == 0) {
#pragma unroll
                for (int ai = 0; ai < 2; ++ai)
#pragma unroll
                    for (int m = 0; m < 4; ++m) { const int row = row0 + ai * 128 + m * 16;
#pragma unroll
                        for (int n = 0; n < 2; ++n) *(f32x4*)(lr + (size_t)row * 32 + n * 16 + 4 * fq) = acc[ai][0][m][n]; }
            }
        }
    }
};

struct Args { const float* in[32]; float* out; unsigned char* ws; int ph_lo, ph_hi; };

struct Frame {
    LAS unsigned char* lds; volatile LAS unsigned* MISC; unsigned* ctl; unsigned char* ws;
    int tid, lane, wave, G, vcu;
};

__device__ __forceinline__ void cvt_item(const float* __restrict__ src, int ld, int col0, int ncols, int k0, bf16_t* dst, int ldd, int drow0, LAS unsigned* T, int lane) {
    const bool okc = lane < ncols;
    const float* p = src + (size_t)k0 * ld + col0 + (okc ? lane : 0);
    float v[64];
#pragma unroll
    for (int k = 0; k < 64; ++k) v[k] = __builtin_nontemporal_load(p + (size_t)k * ld);
#pragma unroll
    for (int kp = 0; kp < 32; ++kp) T[lane * 33 + kp] = okc ? pk2(v[2 * kp], v[2 * kp + 1]) : 0u;
    LDS_WAIT(); asm volatile("" ::: "memory");
    const int c = lane & 7;
#pragma unroll
    for (int it = 0; it < 8; ++it) { const int n = (lane >> 3) + 8 * it;
        u32x4 o; o.x = T[n * 33 + 4 * c]; o.y = T[n * 33 + 4 * c + 1]; o.z = T[n * 33 + 4 * c + 2]; o.w = T[n * 33 + 4 * c + 3];
        if (n < ncols) __builtin_nontemporal_store(o, (u32x4*)(dst + (size_t)(drow0 + n) * ldd + k0 + 8 * c)); }
    LDS_WAIT(); asm volatile("" ::: "memory");
}
__device__ __forceinline__ void cvt_matrix_item(const float* src, int ld, int col0, int ncols, int K, bf16_t* dst, int drow0, int item, LAS unsigned* T, int lane) {
    const int ncg = (ncols + 63) >> 6; const int kt = item / ncg, cg = item - kt * ncg;
    const int nc = ncols - cg * 64 < 64 ? ncols - cg * 64 : 64;
    cvt_item(src, ld, col0 + cg * 64, nc, kt * 64, dst, K, drow0 + cg * 64, T, lane);
}

constexpr int MOE_CVT_ITEMS = NEXPS * 192;
__device__ __forceinline__ void cvt_moe_item(const Args& a, int layer, int item, unsigned char* ws, LAS unsigned* T, int lane) {
    const int e = item / 192, r = item - e * 192;
    bf16_t* wgu = (bf16_t*)(ws + WS_WGU + (size_t)layer * WGU_BYTES) + (size_t)e * 512 * D; bf16_t* wdn = (bf16_t*)(ws + WS_WDN + (size_t)layer * WDN_BYTES) + (size_t)e * D * 256;
    if (r < 128) {
        const int kt = r >> 3, gi = r & 7; const int up = gi >> 2, g4 = gi & 3;
        const float* src = e < NEXP ? (up ? a.in[27] : a.in[26]) + ((size_t)layer * NEXP + e) * D * DEXP : (up ? a.in[30] : a.in[29]) + (size_t)layer * D * DEXP;
        cvt_item(src, DEXP, 64 * g4, 64, kt * 64, wgu, D, 256 * (g4 >> 1) + 64 * (g4 & 1) + 128 * up, T, lane);
    } else {
        const int q = r - 128; const int kt = q >> 4, cg = q & 15;
        const float* src = e < NEXP ? a.in[28] + ((size_t)layer * NEXP + e) * DEXP * D : a.in[31] + (size_t)layer * DEXP * D;
        cvt_item(src, D, 64 * cg, 64, kt * 64, wdn, DEXP, 64 * cg, T, lane);
    }
}

__device__ __forceinline__ float row_rms_scale(const f32x4 (&v)[4]) {
    float s = 0.f;
#pragma unroll
    for (int j = 0; j < 4; ++j) s += (v[j].x * v[j].x + v[j].y * v[j].y) + (v[j].z * v[j].z + v[j].w * v[j].w);
    return rsqrtf(wave_sum(s) * (1.0f / D) + RMS_EPS);
}
__device__ __forceinline__ f32x4 ld4(const float* p) { return *(const f32x4*)p; }

struct RowPhase {
    const float* xin_lat; const float* xin_ctx;
    float* xout_lat; float* xout_ctx;
    bool xin16, xout16;
    int nrows;
    int ysrc; const bf16_t* y;
    const unsigned char* mo8; const int* tslot; const float* tgate; int sharedbase;
    const float* gpost; const float* modx; const float* modc; int gate_chunk;
    bool doH; bf16_t* H; const float* gpre; int sc_chunk, sh_chunk; const float* modxH; const float* modcH;
};
__device__ __forceinline__ void row_phase(const Frame& F, const RowPhase& P) {
    const int gw = F.vcu * NWAVES + F.wave, NGW = F.G * NWAVES, lane = F.lane;
    for (int row = gw; row < P.nrows; row += NGW) {
        const bool lat = row < NX; const int b = lat ? (row >> 11) : 0;
        const float* mod = lat ? P.modx + (size_t)b * ADA : P.modc;
        const float* xr = lat ? P.xin_lat + (size_t)row * D : P.xin_ctx + (size_t)(row - NX) * D;
        f32x4 x[4];
        if (P.xin16) { const bf16_t* xr16 = (lat ? (const bf16_t*)P.xin_lat + (size_t)row * D : (const bf16_t*)P.xin_ctx + (size_t)(row - NX) * D);
#pragma unroll
            for (int j = 0; j < 4; ++j) { const u32x2 w = *(const u32x2*)(xr16 + 4 * lane + 256 * j); x[j] = (f32x4){bflo(w.x), bfhi(w.x), bflo(w.y), bfhi(w.y)}; }
        } else {
#pragma unroll
            for (int j = 0; j < 4; ++j) x[j] = ld4(xr + 4 * lane + 256 * j);
        }
        if (P.ysrc) {
            f32x4 y[4];
            if (P.ysrc == 1) {
#pragma unroll
                for (int j = 0; j < 4; ++j) { const u32x2 w = __builtin_nontemporal_load((const u32x2*)(P.y + (size_t)row * D + 4 * lane + 256 * j)); y[j] = (f32x4){bflo(w.x), bfhi(w.x), bflo(w.y), bfhi(w.y)}; }
            } else {
#pragma unroll
                for (int j = 0; j < 4; ++j) { const int w = __builtin_nontemporal_load((const int*)(P.mo8 + (size_t)(P.sharedbase + row) * D + 4 * lane + 256 * j)); const f32x2 lo = __builtin_amdgcn_cvt_pk_f32_fp8(w, false), hi = __builtin_amdgcn_cvt_pk_f32_fp8(w, true); y[j] = (f32x4){lo.x, lo.y, hi.x, hi.y} * F8_INV; }
#pragma unroll
                for (int k = 0; k < TOPK; ++k) { const int sl = P.tslot[(size_t)row * 8 + k]; const float g = P.tgate[(size_t)row * 8 + k] * F8_INV;
#pragma unroll
                    for (int j = 0; j < 4; ++j) { const int w = __builtin_nontemporal_load((const int*)(P.mo8 + (size_t)sl * D + 4 * lane + 256 * j)); const f32x2 lo = __builtin_amdgcn_cvt_pk_f32_fp8(w, false), hi = __builtin_amdgcn_cvt_pk_f32_fp8(w, true);
                        y[j].x += g * lo.x; y[j].y += g * lo.y; y[j].z += g * hi.x; y[j].w += g * hi.y; } }
            }
            const float rs = row_rms_scale(y);
#pragma unroll
            for (int j = 0; j < 4; ++j) { const f32x4 gp = ld4(P.gpost + 4 * lane + 256 * j), gt = ld4(mod + P.gate_chunk * D + 4 * lane + 256 * j); x[j] = x[j] + gt * (y[j] * rs * gp); }
            if (P.xout16) { bf16_t* xo16 = lat ? (bf16_t*)P.xout_lat + (size_t)row * D : (bf16_t*)P.xout_ctx + (size_t)(row - NX) * D;
#pragma unroll
                for (int j = 0; j < 4; ++j) { u32x2 w; w.x = pk2(x[j].x, x[j].y); w.y = pk2(x[j].z, x[j].w); *(u32x2*)(xo16 + 4 * lane + 256 * j) = w; }
            } else { float* xo = lat ? P.xout_lat + (size_t)row * D : P.xout_ctx + (size_t)(row - NX) * D;
#pragma unroll
                for (int j = 0; j < 4; ++j) *(f32x4*)(xo + 4 * lane + 256 * j) = x[j]; }
        }
        if (P.doH) {
            const float rs = row_rms_scale(x); const float* modh = lat ? P.modxH + (size_t)b * ADA : P.modcH;
#pragma unroll
            for (int j = 0; j < 4; ++j) { const f32x4 gp = ld4(P.gpre + 4 * lane + 256 * j), sc = ld4(modh + P.sc_chunk * D + 4 * lane + 256 * j), sh = ld4(modh + P.sh_chunk * D + 4 * lane + 256 * j);
                const f32x4 h = x[j] * rs * gp * (sc + 1.0f) + sh; u32x2 w; w.x = pk2(h.x, h.y); w.y = pk2(h.z, h.w);
                *(u32x2*)(P.H + (size_t)row * D + 4 * lane + 256 * j) = w; }
        }
    }
}


constexpr int FILL_PER_WAVE_S = 3;
constexpr int F0_P2 = 208 * 8 * FILL_PER_WAVE_S, F0_P5 = 192 * 8 * FILL_PER_WAVE_S, F0_P7 = MOE_CVT_ITEMS - F0_P2 - F0_P5;
constexpr int F0_BULK = MOE_CVT_ITEMS - F0_P2 - F0_P5 - F0_P7;
static_assert(F0_BULK >= 0, "fill plan");
constexpr int F1_P12 = 128 * 8 * FILL_PER_WAVE_S;
__device__ __forceinline__ void cvt_moe_range(const Frame& F, const Args& a, int layer, int lo, int hi, int rank, int nranks) {
    LAS unsigned* T = (LAS unsigned*)F.lds + F.wave * (64 * 33);
    for (int it = lo + rank * NWAVES + F.wave; it < hi; it += nranks * NWAVES) cvt_moe_item(a, layer, it, F.ws, T, F.lane);
}
__device__ __forceinline__ void fill1_ranges(const Frame& F, int ntr0, int& s9, int& s10) {
    const int nu9 = (ntr0 + NT / 256) * 2, nu10 = (ntr0 + NT / 256) * 4;
    const int l9 = (nu9 % F.G) ? F.G - nu9 % F.G : 0, l10 = (nu10 % F.G) ? F.G - nu10 % F.G : 0;
    s9 = l9 * NWAVES * FILL_PER_WAVE_S; s10 = l10 * NWAVES * (FILL_PER_WAVE_S / 3);
    if (F.G != 256) { s9 = 0; s10 = 0; }
}

__device__ __forceinline__ void p0_ada(const Frame& F, const Args& a) {
    LAS float* sc = (LAS float*)F.lds;
    if ((int)blockIdx.x >= 192) return;
    for (int i = F.tid; i < 17 * D; i += NTHREADS) { const int r = i >> 10, k = i & 1023; const float v = r < 16 ? a.in[1][r * D + k] : a.in[3][k]; sc[i] = siluf_(v); }
    __syncthreads();
    const int item = blockIdx.x; const int layer = item / 96, cg = item % 96;
    const int cq = F.tid & 15, kl = F.tid >> 4;
    const float* W = a.in[4] + (size_t)layer * D * ADA + cg * 64 + cq * 4;
    f32x4 acc[17];
#pragma unroll
    for (int r = 0; r < 17; ++r) acc[r] = (f32x4){0.f, 0.f, 0.f, 0.f};
    for (int k0 = kl; k0 < D; k0 += 32 * 8) {
        f32x4 w[8];
#pragma unroll
        for (int j = 0; j < 8; ++j) w[j] = ld4(W + (size_t)(k0 + 32 * j) * ADA);
#pragma unroll
        for (int j = 0; j < 8; ++j) {
#pragma unroll
            for (int r = 0; r < 17; ++r) { const float s = sc[r * D + k0 + 32 * j]; acc[r] = acc[r] + w[j] * s; } }
    }
#pragma unroll
    for (int r = 0; r < 17; ++r) {
#pragma unroll
        for (int o = 16; o <= 32; o <<= 1) { acc[r].x += __shfl_xor(acc[r].x, o); acc[r].y += __shfl_xor(acc[r].y, o); acc[r].z += __shfl_xor(acc[r].z, o); acc[r].w += __shfl_xor(acc[r].w, o); } }
    __syncthreads();
    LAS f32x4* red = (LAS f32x4*)F.lds;
    if (F.lane < 16) {
#pragma unroll
        for (int r = 0; r < 17; ++r) red[(F.wave * 17 + r) * 16 + cq] = acc[r];
    }
    __syncthreads();
    for (int i = F.tid; i < 17 * 16; i += NTHREADS) { const int r = i >> 4, q = i & 15; f32x4 s = red[r * 16 + q];
#pragma unroll
        for (int w = 1; w < 8; ++w) s = s + red[(w * 17 + r) * 16 + q];
        const int col = cg * 64 + q * 4; s = s + ld4(a.in[5] + (size_t)layer * ADA + col);
        float* dst = r < 16 ? (float*)(F.ws + WS_MODX) + ((size_t)layer * 16 + r) * ADA + col : (float*)(F.ws + WS_MODC) + (size_t)layer * ADA + col;
        *(f32x4*)dst = s; }
    __syncthreads();
}

__device__ __forceinline__ void p0_convert(const Frame& F, const Args& a) {
    LAS unsigned* T = (LAS unsigned*)(F.lds + 70 * 1024) + F.wave * (64 * 33);
    const int gw = F.vcu * NWAVES + F.wave, NGW = F.G * NWAVES, lane = F.lane;
    bf16_t* win0 = (bf16_t*)(F.ws + WS_WIN0); bf16_t* wout0 = (bf16_t*)(F.ws + WS_WOUT0); bf16_t* wqkv1 = (bf16_t*)(F.ws + WS_WQKV1); bf16_t* wout1 = (bf16_t*)(F.ws + WS_WOUT1); bf16_t* wr = (bf16_t*)(F.ws + WS_WR);
    constexpr int I_IN = 16 * (4 + 4 + 8 + 8 + 1 + 16);
    constexpr int I_SQ = 16 * 16, I_QKV = 16 * 48, I_R = 16 * 4;
    constexpr int NIT = I_IN + I_SQ + I_QKV + I_SQ + 2 * I_R;
    const int nbulk0 = F.G == 256 ? F0_BULK : MOE_CVT_ITEMS;
    for (int it = gw; it < NIT + nbulk0; it += NGW) {
        int r = it;
        if (r < I_IN) {
            const int kt = r & 15, g = r >> 4; int col0, nc = 64, drow;
            if (g < 24) { col0 = 64 * g; drow = 64 * g; }
            else if (g == 24) { col0 = 1536; nc = 32; drow = 2560; }
            else { const int s = g - 25; const int isb = s >> 3, q = s & 7;
                col0 = 1568 + 512 * isb + 64 * q; drow = 1536 + 256 * (q >> 1) + 128 * isb + 64 * (q & 1); }
            cvt_item(a.in[10], AB_IN, col0, nc, kt * 64, win0, D, drow, T, lane); continue; }
        r -= I_IN;
        if (r < I_SQ) { cvt_matrix_item(a.in[11], D, 0, D, D, wout0, 0, r, T, lane); continue; } r -= I_SQ;
        if (r < I_QKV) { cvt_matrix_item(a.in[21], 3 * D, 0, 3 * D, D, wqkv1, 0, r, T, lane); continue; } r -= I_QKV;
        if (r < I_SQ) { cvt_matrix_item(a.in[22], D, 0, D, D, wout1, 0, r, T, lane); continue; } r -= I_SQ;
        if (r < 2 * I_R) { const int l = r / I_R; cvt_matrix_item(a.in[24] + (size_t)l * D * NEXP, NEXP, 0, NEXP, D, wr + (size_t)l * NEXP * D, 0, r % I_R, T, lane); continue; } r -= 2 * I_R;
        cvt_moe_item(a, 0, r, F.ws, T, lane);
    }
    { u32x4 z = (u32x4){0u, 0u, 0u, 0u}; const size_t n16 = (size_t)(AB_INP - AB_IN) * D * 2 / 16; u32x4* p = (u32x4*)(win0 + (size_t)AB_IN * D);
      for (size_t i = (size_t)blockIdx.x * NTHREADS + F.tid; i < n16; i += (size_t)F.G * NTHREADS) p[i] = z; }
    if (blockIdx.x == 0) { f32x2* rt = (f32x2*)(F.ws + WS_ROPE);
        for (int i = F.tid; i < 64 * 16; i += NTHREADS) { const int pos = i >> 4, f = i & 15; const float inv = powf(10000.0f, -(float)f / 16.0f); const float ang = (float)pos * inv; rt[i] = (f32x2){cosf(ang), sinf(ang)}; } }
}


__device__ __forceinline__ int gsw(int row, int ch) { return row * 128 + ((ch ^ (row & 7)) << 4); }
__device__ __forceinline__ int gla_row(int n, int p, int b, int d) {
    const bool isctx = n < 4; const int j = isctx ? n : n - 4; int pos = j * 64 + p;
    if (d) pos = (isctx ? CTXL : SEQ) - 1 - pos;
    return isctx ? NX + b * CTXL + pos : b * SEQ + pos;
}
struct GlaRaw { u32x4 q, k, v0, v1; f32x4 lr[4]; };
__device__ __forceinline__ void gla_load(GlaRaw& R, int n, int lane, int w, int b, int h, int d, const bf16_t* qb, const bf16_t* kb, const bf16_t* vb, const float* lr) {
    const int row = gla_row(n, lane, b, d);
    R.q = *(const u32x4*)(qb + (size_t)row * 256 + h * 64 + 8 * w);
    R.k = *(const u32x4*)(kb + (size_t)row * 256 + h * 64 + 8 * w);
    R.v0 = *(const u32x4*)(vb + (size_t)row * 512 + h * 128 + 8 * w);
    R.v1 = *(const u32x4*)(vb + (size_t)row * 512 + h * 128 + 64 + 8 * w);
#pragma unroll
    for (int i = 0; i < 4; ++i) R.lr[i] = *(const f32x4*)(lr + (size_t)row * 32 + d * 16 + 4 * i);
}
__device__ __forceinline__ void unpack8(const u32x4& w, float (&f)[8]) { f[0] = bflo(w.x); f[1] = bfhi(w.x); f[2] = bflo(w.y); f[3] = bfhi(w.y); f[4] = bflo(w.z); f[5] = bfhi(w.z); f[6] = bflo(w.w); f[7] = bfhi(w.w); }
constexpr int GPL_QE = 0, GPL_KE = 8192, GPL_OUT = 16384, GPL_BUF = 16384 + GI_BYTES + 256, GPL_DW = 2 * GPL_BUF, GPL_DB = GPL_DW + 4096, GPL_END = GPL_DB + 256;
static_assert(GPL_END <= RING_BYTES && (GPL_BUF % 16) == 0, "gla prep lds");
__device__ __forceinline__ void gla_prep_phase(const Frame& F, const Args& a) {
    LAS unsigned char* L = F.lds; const int lane = F.lane, w = F.wave, r16 = lane & 15, g4 = lane >> 4;
    const bf16_t* qb = (const bf16_t*)(F.ws + T_QB); const bf16_t* kb = (const bf16_t*)(F.ws + T_KB); const bf16_t* vb = (const bf16_t*)(F.ws + T_VB); const float* lrb = (const float*)(F.ws + T_LR);
    for (int cc = blockIdx.x; cc < 256; cc += F.G) {
        const int sq = cc & 127, b = sq >> 3, h = (sq >> 1) & 3, d = sq & 1;
        const float* dw = d ? a.in[14] : a.in[12]; const float* db = d ? a.in[15] : a.in[13];
        __syncthreads();
        for (int i = F.tid; i < 16 * 64; i += NTHREADS) ((LAS float*)(L + GPL_DW))[i] = dw[(i >> 6) * GLA_QK + h * 64 + (i & 63)];
        if (F.tid < 64) ((LAS float*)(L + GPL_DB))[F.tid] = db[h * 64 + F.tid];
        GlaRaw R; gla_load(R, cc >> 7, lane, w, b, h, d, qb, kb, vb, lrb);
        __syncthreads();
        for (int k = 0; k < 18; ++k) {
            const int n = (cc >> 7) + 2 * k;
            LAS unsigned char* PB = L + (k & 1) * GPL_BUF; LAS unsigned char* OUT = PB + GPL_OUT;
            {
                float z[8], q[8], kk[8], v0[8], v1[8];
                unpack8(R.q, q); unpack8(R.k, kk); unpack8(R.v0, v0); unpack8(R.v1, v1);
                const LAS float* DW = (const LAS float*)(L + GPL_DW); const LAS float* DB = (const LAS float*)(L + GPL_DB);
#pragma unroll
                for (int j = 0; j < 8; ++j) z[j] = DB[8 * w + j];
#pragma unroll
                for (int r = 0; r < 16; ++r) { const float x = R.lr[r >> 2][r & 3]; const f32x4 w0 = *(const LAS f32x4*)(DW + r * 64 + 8 * w), w1 = *(const LAS f32x4*)(DW + r * 64 + 8 * w + 4);
                    z[0] += x * w0.x; z[1] += x * w0.y; z[2] += x * w0.z; z[3] += x * w0.w; z[4] += x * w1.x; z[5] += x * w1.y; z[6] += x * w1.z; z[7] += x * w1.w; }
                float qe[8], ke[8], qi[8]; unsigned short ko[8]; float ld[8];
#pragma unroll
                for (int j = 0; j < 8; ++j) ld[j] = (fminf(z[j], 0.f) - __logf(1.0f + __expf(-fabsf(z[j])))) * (1.0f / 16.0f);
#pragma unroll
                for (int o = 1; o < 64; o <<= 1) { float t[8];
#pragma unroll
                    for (int j = 0; j < 8; ++j) t[j] = __shfl_up(ld[j], o);
#pragma unroll
                    for (int j = 0; j < 8; ++j) ld[j] += (lane >= o) ? t[j] : 0.f; }
                float decv = 0.f;
#pragma unroll
                for (int j = 0; j < 8; ++j) {
                    const float bm = __builtin_bit_cast(float, __builtin_amdgcn_readlane(__builtin_bit_cast(int, ld[j]), 31)), bl = __builtin_bit_cast(float, __builtin_amdgcn_readlane(__builtin_bit_cast(int, ld[j]), 63));
                    const float e1 = __expf(ld[j] - bm), e2 = __expf(bm - ld[j]);
                    qe[j] = q[j] * e1; ke[j] = kk[j] * e2; qi[j] = q[j] * __expf(ld[j]); ko[j] = (unsigned short)f2bf(kk[j] * __expf(bl - ld[j]));
                    decv = (lane == j) ? __expf(bl) : decv;
                }
                if (lane < 8) ((LAS float*)(OUT + GI_DEC))[8 * w + lane] = decv;
                *(LAS u32x4*)(PB + GPL_QE + gsw(lane, w)) = (u32x4){pk2(qe[0], qe[1]), pk2(qe[2], qe[3]), pk2(qe[4], qe[5]), pk2(qe[6], qe[7])};
                *(LAS u32x4*)(PB + GPL_KE + gsw(lane, w)) = (u32x4){pk2(ke[0], ke[1]), pk2(ke[2], ke[3]), pk2(ke[4], ke[5]), pk2(ke[6], ke[7])};
                *(LAS u32x4*)(OUT + GI_QIN + gsw(lane, w)) = (u32x4){pk2(qi[0], qi[1]), pk2(qi[2], qi[3]), pk2(qi[4], qi[5]), pk2(qi[6], qi[7])};
#pragma unroll
                for (int j = 0; j < 8; ++j) { const int rw = 8 * w + j;
                    *(LAS unsigned short*)(OUT + GI_KOT + gsw(rw, lane >> 3) + (lane & 7) * 2) = ko[j];
                    *(LAS unsigned short*)(OUT + GI_VT + gsw(rw, lane >> 3) + (lane & 7) * 2) = (unsigned short)f2bf(v0[j]);
                    *(LAS unsigned short*)(OUT + GI_VT + gsw(64 + rw, lane >> 3) + (lane & 7) * 2) = (unsigned short)f2bf(v1[j]); }
            }
            if (k + 1 < 18) gla_load(R, n + 2, lane, w, b, h, d, qb, kb, vb, lrb);
            lds_barrier();
#pragma unroll
            for (int i = 0; i < 2; ++i) { const int tI = 2 * w + i, st = tI >> 2, pt = tI & 3;
                f32x4 c = (f32x4){0.f, 0.f, 0.f, 0.f};
                if (st <= pt) {
#pragma unroll
                    for (int ks = 0; ks < 2; ++ks) { const bf16x8 af = *(const LAS bf16x8*)(PB + GPL_KE + gsw(16 * st + r16, 4 * ks + g4)), bfr = *(const LAS bf16x8*)(PB + GPL_QE + gsw(16 * pt + r16, 4 * ks + g4));
                        c = __builtin_amdgcn_mfma_f32_16x16x32_bf16(af, bfr, c, 0, 0, 0); }
                    const int p = 16 * pt + r16, s0 = 16 * st + 4 * g4;
#pragma unroll
                    for (int e = 0; e < 4; ++e) if (s0 + e > p) c[e] = 0.f;
                }
                u32x2 o; o.x = pk2(c[0], c[1]); o.y = pk2(c[2], c[3]);
                *(LAS u32x2*)(OUT + GI_A + gsw(16 * pt + r16, 2 * st + (g4 >> 1)) + (g4 & 1) * 8) = o; }
            lds_barrier();
            { unsigned char* rec = F.ws + T_GLA + (size_t)(sq * 36 + n) * GI_BYTES;
              for (int i = F.tid; i < GI_BYTES / 16; i += NTHREADS) *(u32x4*)(rec + i * 16) = *(const LAS u32x4*)(OUT + i * 16); }
        }
    }
    __syncthreads();
}
constexpr int GSL_IN = 33792  , GSL_ST = 3 * GSL_IN, GSL_END = GSL_ST + 2 * 8192;
static_assert(GSL_END <= RING_BYTES, "gla seq lds");
__device__ __forceinline__ void gla_seq_phase(const Frame& F, const Args& a) {
    LAS unsigned char* L = F.lds; const int lane = F.lane, w = F.wave, r16 = lane & 15, g4 = lane >> 4, tid = F.tid;
    for (int it = blockIdx.x; it < 256; it += F.G) {
        const int sq = it >> 1, vh = it & 1, b = sq >> 3, h = (sq >> 1) & 3, d = sq & 1;
        bf16_t* ob = (bf16_t*)(F.ws + (d ? T_OB : T_OF));
        const unsigned char* rec0 = F.ws + T_GLA + (size_t)(sq * 36) * GI_BYTES;
        __syncthreads();
        for (int i = tid; i < 2 * 8192 / 4; i += NTHREADS) ((LAS unsigned*)(L + GSL_ST))[i] = 0u;
        f32x4 Sacc[2] = {(f32x4){0.f, 0.f, 0.f, 0.f}, (f32x4){0.f, 0.f, 0.f, 0.f}};
#define GLA_DMA(n_) do { const unsigned char* r_ = rec0 + (size_t)(n_) * GI_BYTES; LAS unsigned char* d_ = L + ((n_) % 3) * GSL_IN; \
            __builtin_amdgcn_global_load_lds((const unsigned*)(r_ + GI_A + tid * 16), (LAS unsigned*)(d_ + w * 1024), 16, 0, 0); \
            __builtin_amdgcn_global_load_lds((const unsigned*)(r_ + GI_QIN + tid * 16), (LAS unsigned*)(d_ + 8192 + w * 1024), 16, 0, 0); \
            __builtin_amdgcn_global_load_lds((const unsigned*)(r_ + GI_KOT + tid * 16), (LAS unsigned*)(d_ + 16384 + w * 1024), 16, 0, 0); \
            __builtin_amdgcn_global_load_lds((const unsigned*)(r_ + GI_VT + vh * 8192 + tid * 16), (LAS unsigned*)(d_ + 24576 + w * 1024), 16, 0, 0); \
            __builtin_amdgcn_global_load_lds((const unsigned*)(r_ + GI_DEC + lane * 16), (LAS unsigned*)(d_ + 32768), 16, 0, 0); } while (0)
        GLA_DMA(0); GLA_DMA(1);
        for (int n = 0; n < 36; ++n) {
            LAS unsigned char* IN = L + (n % 3) * GSL_IN; LAS unsigned char* STr = L + GSL_ST + (n & 1) * 8192; LAS unsigned char* STw = L + GSL_ST + ((n + 1) & 1) * 8192;
            if (n == 0) asm volatile("s_waitcnt vmcnt(5)" ::: "memory"); else if (n < 35) asm volatile("s_waitcnt vmcnt(7)" ::: "memory"); else asm volatile("s_waitcnt vmcnt(2)" ::: "memory");
            lds_barrier();
            if (n + 2 < 36) GLA_DMA(n + 2);
#pragma unroll
            for (int i = 0; i < 2; ++i) { const int tI = 2 * w + i, vt = tI >> 2, pt = tI & 3;
                f32x4 c = (f32x4){0.f, 0.f, 0.f, 0.f};
#pragma unroll
                for (int ks = 0; ks < 2; ++ks) {
                    const bf16x8 a1 = *(const LAS bf16x8*)(IN + 24576 + gsw(16 * vt + r16, 4 * ks + g4)), b1 = *(const LAS bf16x8*)(IN + gsw(16 * pt + r16, 4 * ks + g4));
                    c = __builtin_amdgcn_mfma_f32_16x16x32_bf16(a1, b1, c, 0, 0, 0);
                    const bf16x8 a2 = *(const LAS bf16x8*)(STr + gsw(16 * vt + r16, 4 * ks + g4)), b2 = *(const LAS bf16x8*)(IN + 8192 + gsw(16 * pt + r16, 4 * ks + g4));
                    c = __builtin_amdgcn_mfma_f32_16x16x32_bf16(a2, b2, c, 0, 0, 0); }
                const int row = gla_row(n, 16 * pt + r16, b, d);
                u32x2 o; o.x = pk2(c[0], c[1]); o.y = pk2(c[2], c[3]);
                *(u32x2*)(ob + (size_t)row * 512 + h * 128 + vh * 64 + 16 * vt + 4 * g4) = o; }
#pragma unroll
            for (int i = 0; i < 2; ++i) { const int tI = 2 * w + i, ct = tI >> 2, vt = tI & 3;
                const f32x4 dc = *(const LAS f32x4*)(IN + 32768 + (16 * ct + 4 * g4) * 4);
                f32x4 c = Sacc[i] * dc;
#pragma unroll
                for (int ks = 0; ks < 2; ++ks) { const bf16x8 af = *(const LAS bf16x8*)(IN + 16384 + gsw(16 * ct + r16, 4 * ks + g4)), bfr = *(const LAS bf16x8*)(IN + 24576 + gsw(16 * vt + r16, 4 * ks + g4));
                    c = __builtin_amdgcn_mfma_f32_16x16x32_bf16(af, bfr, c, 0, 0, 0); }
                Sacc[i] = c;
                u32x2 o; o.x = pk2(c[0], c[1]); o.y = pk2(c[2], c[3]);
                *(LAS u32x2*)(STw + gsw(16 * vt + r16, 2 * ct + (g4 >> 1)) + (g4 & 1) * 8) = o; }
        }
#undef GLA_DMA
        asm volatile("s_waitcnt vmcnt(0)" ::: "memory");
    }
    __syncthreads();
}

__device__ __forceinline__ void finish_conv_phase(const Frame& F, const Args& a) {
    const int lane = F.lane; bf16_t* cat = (bf16_t*)(F.ws + T_CAT);
    {
        const bf16_t* of = (const bf16_t*)(F.ws + T_OF); const bf16_t* obk = (const bf16_t*)(F.ws + T_OB); const bf16_t* gb = (const bf16_t*)(F.ws + T_GB);
        const int gw = F.vcu * NWAVES + F.wave, NGW = F.G * NWAVES;
        float gg[8];
#pragma unroll
        for (int j = 0; j < 8; ++j) gg[j] = a.in[16][8 * lane + j];
        for (int rowa = gw; rowa < NT; rowa += 3 * NGW) {
            u32x4 rx[3], ry[3], rg[3];
#pragma unroll
            for (int r = 0; r < 3; ++r) { int row = rowa + r * NGW; row = row < NT ? row : rowa;
                rx[r] = *(const u32x4*)(of + (size_t)row * 512 + 8 * lane); ry[r] = *(const u32x4*)(obk + (size_t)row * 512 + 8 * lane); rg[r] = *(const u32x4*)(gb + (size_t)row * 512 + 8 * lane); }
#pragma unroll
            for (int r = 0; r < 3; ++r) { const int row = rowa + r * NGW;
                float x[8], y[8], g[8];
                unpack8(rx[r], x); unpack8(ry[r], y); unpack8(rg[r], g);
                float ss = 0.f;
#pragma unroll
                for (int j = 0; j < 8; ++j) { x[j] += y[j]; ss += x[j] * x[j]; }
                ss += __shfl_xor(ss, 1); ss += __shfl_xor(ss, 2); ss += __shfl_xor(ss, 4); ss += __shfl_xor(ss, 8);
                const float rs = rsqrtf(ss * (1.0f / 128.0f) + RMS_EPS);
#pragma unroll
                for (int j = 0; j < 8; ++j) x[j] = x[j] * rs * gg[j] * siluf_(g[j]);
                if (row < NT) *(u32x4*)(cat + (size_t)row * D + 8 * lane) = (u32x4){pk2(x[0], x[1]), pk2(x[2], x[3]), pk2(x[4], x[5]), pk2(x[6], x[7])};
            }
        }
    }
    {
        const bf16_t* ub = (const bf16_t*)(F.ws + T_UB); LAS float* tile = (LAS float*)F.lds;
        const int c = F.tid;
        float wv[CONV_W];
#pragma unroll
        for (int j = 0; j < CONV_W; ++j) wv[j] = a.in[17][j * CONV_CH + c];
        const float cb = a.in[18][c];
        float lg[8], lb[8];
#pragma unroll
        for (int i = 0; i < 8; ++i) { lg[i] = a.in[19][lane + 64 * i]; lb[i] = a.in[20][lane + 64 * i]; }
        for (int ti = blockIdx.x; ti < NT / 32; ti += F.G) {
            const int row0 = ti * 32; const bool lat = row0 < NX;
            const int t0 = lat ? (row0 & (SEQ - 1)) : ((row0 - NX) & (CTXL - 1)); const int len = lat ? SEQ : CTXL; const int sbase = row0 - t0;
            float in[62];
            unsigned short raw[62];
#pragma unroll
            for (int i = 0; i < 62; ++i) { int t = t0 - 15 + i; t = t < 0 ? 0 : (t >= len ? len - 1 : t); raw[i] = ub[(size_t)(sbase + t) * 512 + c]; }
#pragma unroll
            for (int i = 0; i < 62; ++i) { const int t = t0 - 15 + i; in[i] = (t >= 0 && t < len) ? bf2f(raw[i]) : 0.f; }
            __syncthreads();
#pragma unroll
            for (int t = 0; t < 32; ++t) { float s = cb;
#pragma unroll
                for (int j = 0; j < CONV_W; ++j) s += wv[j] * in[t + j];
                tile[t * 512 + c] = s; }
            __syncthreads();
#pragma unroll
            for (int q = 0; q < 4; ++q) { const int t = 4 * F.wave + q; float v[8]; float s = 0.f;
#pragma unroll
                for (int i = 0; i < 8; ++i) { v[i] = tile[t * 512 + lane + 64 * i]; s += v[i]; }
                const float mu = wave_sum(s) * (1.0f / 512.0f); float qq = 0.f;
#pragma unroll
                for (int i = 0; i < 8; ++i) { v[i] -= mu; qq += v[i] * v[i]; }
                const float rstd = rsqrtf(wave_sum(qq) * (1.0f / 512.0f) + LN_EPS);
#pragma unroll
                for (int i = 0; i < 8; ++i) { const float y = v[i] * rstd * lg[i] + lb[i]; cat[(size_t)(row0 + t) * D + 512 + lane + 64 * i] = (bf16_t)f2bf(siluf_(y)); } }
        }
        __syncthreads();
    }
}


constexpr int CW_TST = 20480;
constexpr int AUX_TST = AUX_OFF, AUX_TILEE = AUX_OFF + 1040, AUX_IDX = AUX_OFF + 1168;
constexpr int MOE_MAXU = 32, MOE_MAXIDX = 16;
static_assert(AUX_IDX + MOE_MAXIDX * 1024 <= MISC_OFF, "aux lds");

struct EpiRouter {
    static constexpr bool PERM = false, AFTER_DRAIN = true;
    const float* rbias; int* asg_e; int* asg_r; float* asg_g; unsigned* counts; int* lst;
    __device__ __forceinline__ void operator()(const f32x4 (&)[2][2][4][2], const Unit&, int, int, int, int) const {}
    __device__ __forceinline__ void fused(const f32x4 (&acc)[2][2][4][2], const Unit& u, int wr, int wc, int fr, int fq, LAS unsigned char* lds, int wid, int lane) const {
        LAS float* SC = (LAS float*)lds;
        LAS unsigned* lcnt = (LAS unsigned*)(lds + 66560); LAS unsigned* lbase = lcnt + 256;
        LAS int* selE = (LAS int*)(lbase + 256); LAS int* selR = selE + 2048;
        const int tid = wid * 64 + lane;
        if (tid < 256) lcnt[tid] = 0u;
        const f32x4 rb = *(const f32x4*)(rbias + 4 * lane);
        const float NINF = -__builtin_inff();
#pragma unroll
        for (int ai = 0; ai < 2; ++ai)
#pragma unroll
            for (int mm = 0; mm < 2; ++mm) {
                LDS_WAIT(); __builtin_amdgcn_s_barrier(); asm volatile("" ::: "memory");
#pragma unroll
                for (int mi = 0; mi < 2; ++mi) { const int lr = 32 * wr + 16 * mi + fr;
#pragma unroll
                    for (int bj = 0; bj < 2; ++bj)
#pragma unroll
                        for (int n = 0; n < 2; ++n) *(LAS f32x4*)(SC + lr * 260 + 128 * bj + 32 * wc + 16 * n + 4 * fq) = acc[ai][bj][2 * mm + mi][n]; }
                LDS_WAIT(); __builtin_amdgcn_s_barrier(); asm volatile("" ::: "memory");
                for (int q = 0; q < 8; ++q) {
                    const int lr = 8 * wid + q; const int rit = 128 * ai + 64 * (lr >> 5) + 16 * (2 * mm + ((lr >> 4) & 1)) + (lr & 15);
                    const f32x4 lg = *(const LAS f32x4*)(SC + lr * 260 + 4 * lane);
                    float s[4], cd[4];
#pragma unroll
                    for (int j = 0; j < 4; ++j) { s[j] = 1.0f / (1.0f + __expf(-lg[j])); cd[j] = s[j] + rb[j]; }
                    float m1 = fmaxf(cd[0], cd[1]), m2 = fminf(cd[0], cd[1]);
                    { const float x = cd[2]; const float n1 = fmaxf(m1, x); m2 = fmaxf(fminf(m1, x), m2); m1 = n1; }
                    { const float x = cd[3]; const float n1 = fmaxf(m1, x); m2 = fmaxf(fminf(m1, x), m2); m1 = n1; }
#pragma unroll
                    for (int o = 1; o < 8; o <<= 1) { const float a1 = __shfl_xor(m1, o), a2 = __shfl_xor(m2, o); const float n1 = fmaxf(m1, a1); m2 = fmaxf(fminf(m1, a1), fmaxf(m2, a2)); m1 = n1; }
                    const float gs = m1 + m2; const int mygrp = lane >> 3; int rank = 0;
#pragma unroll
                    for (int g = 0; g < 8; ++g) { const float og = __shfl(gs, 8 * g); rank += (og > gs || (og == gs && g < mygrp)) ? 1 : 0; }
                    if (rank >= 4) { cd[0] = NINF; cd[1] = NINF; cd[2] = NINF; cd[3] = NINF; }
                    int myE = 0; float myG = 0.f; float gsum = 0.f;
#pragma unroll
                    for (int k = 0; k < TOPK; ++k) {
                        float bv = cd[0]; int bi = 0;
                        if (cd[1] > bv) { bv = cd[1]; bi = 1; } if (cd[2] > bv) { bv = cd[2]; bi = 2; } if (cd[3] > bv) { bv = cd[3]; bi = 3; }
                        float v = bv; int ix = 4 * lane + bi;
#pragma unroll
                        for (int o = 32; o >= 1; o >>= 1) { const float ov = __shfl_xor(v, o); const int oi = __shfl_xor(ix, o); if (ov > v || (ov == v && oi < ix)) { v = ov; ix = oi; } }
                        const int sl = ix & 3; const float mys = sl == 0 ? s[0] : (sl == 1 ? s[1] : (sl == 2 ? s[2] : s[3]));
                        const float gv = __shfl(mys, ix >> 2);
                        gsum += gv;
                        if (lane == k) { myE = ix; myG = gv; }
                        if (lane == (ix >> 2)) { if (sl == 0) cd[0] = NINF; else if (sl == 1) cd[1] = NINF; else if (sl == 2) cd[2] = NINF; else cd[3] = NINF; }
                    }
                    if (lane < TOPK) { const unsigned r = __hip_atomic_fetch_add(&lcnt[myE], 1u, __ATOMIC_RELAXED, __HIP_MEMORY_SCOPE_WORKGROUP); selE[rit * 8 + lane] = myE; selR[rit * 8 + lane] = (int)r; asg_g[(size_t)(u.orow + rit) * 8 + lane] = myG / gsum * 2.5f; }
                }
            }
        LDS_WAIT(); __builtin_amdgcn_s_barrier(); asm volatile("" ::: "memory");
        if (tid < 256) { const unsigned c = lcnt[tid]; lbase[tid] = c ? atomicAdd(&counts[tid], c) : 0u; }
        LDS_WAIT(); __builtin_amdgcn_s_barrier(); asm volatile("" ::: "memory");
        for (int i = tid; i < 2048; i += NTHREADS) { const int e = selE[i]; const int r = (int)lbase[e] + selR[i]; asg_e[(size_t)u.orow * 8 + i] = e; asg_r[(size_t)u.orow * 8 + i] = r; lst[(size_t)e * LCAP + r] = u.orow + (i >> 3); }
    }
};

template <int NCOL>
__device__ __forceinline__ int moe_units_setup(const Frame& F, int layer, int ntok, int c, bool want_idx) {
    LAS int* tst = (LAS int*)(F.lds + AUX_TST); LAS int* tileE = (LAS int*)(F.lds + AUX_TILEE); LAS int* idxl = (LAS int*)(F.lds + AUX_IDX);
    const unsigned* counts = F.ctl + CW_CNT + layer * 256;
    __syncthreads();
    if (want_idx) {
        if (F.wave == 0) { int t4[4], s = 0;
#pragma unroll
            for (int j = 0; j < 4; ++j) { t4[j] = ((int)counts[4 * F.lane + j] + 255) >> 8; s += t4[j]; }
            int incl = s;
#pragma unroll
            for (int o = 1; o < 64; o <<= 1) { const int v = __shfl_up(incl, o); if (F.lane >= o) incl += v; }
            int base = incl - s;
#pragma unroll
            for (int j = 0; j < 4; ++j) { tst[4 * F.lane + j] = base; base += t4[j]; }
            if (F.lane == 63) tst[256] = incl; }
    } else for (int i = F.tid; i < 257; i += NTHREADS) tst[i] = (int)F.ctl[CW_TST + layer * 320 + i];
    __syncthreads();
    const int ntr = tst[256], nunits = (ntr + ntok / 256) * NCOL;
    int nu = c < nunits ? (nunits - c + F.G - 1) / F.G : 0; if (nu > MOE_MAXU) nu = MOE_MAXU; if (want_idx && nu > MOE_MAXIDX) nu = MOE_MAXIDX;
    if (F.tid < nu) { const int rt = (c + F.tid * F.G) / NCOL; int e;
        if (rt >= ntr) e = NEXP; else { int lo = 0, hi = 255; while (lo < hi) { const int mid = (lo + hi + 1) >> 1; if (tst[mid] <= rt) lo = mid; else hi = mid - 1; } e = lo; }
        tileE[F.tid] = e; }
    if (want_idx) {
        if (blockIdx.x == 0) for (int i = F.tid; i < 257; i += NTHREADS) F.ctl[CW_TST + layer * 320 + i] = (unsigned)tst[i];
        {
            const int* asg_e = (const int*)(F.ws + M_AE); const int* asg_r = (const int*)(F.ws + M_AR); int* tslot = (int*)(F.ws + M_TS);
            const int gt = blockIdx.x * NTHREADS + F.tid, gs = F.G * NTHREADS;
            for (int i = gt; i < ntok * 8; i += gs) tslot[i] = tst[asg_e[i]] * 256 + asg_r[i]; }
        __syncthreads();
        const int* lst = (const int*)(F.ws + M_LST);
        for (int i = F.tid; i < nu * 256; i += NTHREADS) { const int j = i >> 8, r = i & 255; const int rt = (c + j * F.G) / NCOL; const int e = tileE[j]; int tok;
            if (e >= NEXP) tok = (rt - ntr) * 256 + r;
            else { const int pos = (rt - tst[e]) * 256 + r; tok = pos < (int)counts[e] ? lst[(size_t)e * LCAP + pos] : 0; }
            idxl[i] = tok; }
    }
    __syncthreads();
    return nu;
}
struct SchedMoeGU {
    const char* A; const char* W; const LAS int* tileE; const LAS int* idxl; int nu, G, c;
    __device__ __forceinline__ bool next(int i, Unit& u) const {
        if (i >= nu) return false; const int un = c + i * G; const int rt = un >> 1, col = un & 1; const int e = tileE[i];
        u.a = i; u.b = e * 512 + col * 256; u.orow = rt * 256; u.ocol = col * 128; u.aux = e; return true; }
    __device__ __forceinline__ const char* a_base() const { return A; }
    __device__ __forceinline__ const char* b_ptr(const Unit& u) const { return W + (size_t)u.b * D * 2; }
    __device__ __forceinline__ void a_off(const Unit& u, const int (&R)[2], const int (&C)[2], unsigned (&o0)[2], unsigned (&o1)[2]) const {
#pragma unroll
        for (int i = 0; i < 2; ++i) { const int t0 = idxl[u.a * 256 + R[i]], t1 = idxl[u.a * 256 + 128 + R[i]]; o0[i] = (unsigned)t0 * (unsigned)(D * 2) + (unsigned)C[i] * 2u; o1[i] = (unsigned)t1 * (unsigned)(D * 2) + (unsigned)C[i] * 2u; }
    }
};
struct EpiGateUp {
    static constexpr bool PERM = true, AFTER_DRAIN = false;
    bf16_t* hid;
    __device__ __forceinline__ void operator()(const f32x4 (&acc)[2][2][4][2], const Unit& u, int wr, int wc, int fr, int fq) const {
        const int lane = fr + 16 * fq; const int srcb = ((lane >> 2) + 16 * (lane & 3)) << 2;
        const int row0 = u.orow + wr * 64 + (lane >> 2), col0 = u.ocol + wc * 32 + 8 * (lane & 3);
#pragma unroll
        for (int ai = 0; ai < 2; ++ai)
#pragma unroll
            for (int m = 0; m < 4; ++m) { float h[8];
#pragma unroll
                for (int n = 0; n < 2; ++n)
#pragma unroll
                    for (int e = 0; e < 4; ++e) { const float g = acc[ai][0][m][n][e], up = acc[ai][1][m][n][e]; h[4 * n + e] = g / (1.0f + __expf(-g)) * up; }
                u32x4 w; w.x = cvt_pk_bf16(h[0], h[1]); w.y = cvt_pk_bf16(h[2], h[3]); w.z = cvt_pk_bf16(h[4], h[5]); w.w = cvt_pk_bf16(h[6], h[7]);
                u32x4 t; t.x = (unsigned)__builtin_amdgcn_ds_bpermute(srcb, (int)w.x); t.y = (unsigned)__builtin_amdgcn_ds_bpermute(srcb, (int)w.y); t.z = (unsigned)__builtin_amdgcn_ds_bpermute(srcb, (int)w.z); t.w = (unsigned)__builtin_amdgcn_ds_bpermute(srcb, (int)w.w);
                *(u32x4*)(hid + (size_t)(row0 + ai * 128 + m * 16) * DEXP + col0) = t; }
    }
};
struct SchedMoeDN {
    const char* A; const char* W; const LAS int* tileE; int nu, G, c;
    __device__ __forceinline__ bool next(int i, Unit& u) const {
        if (i >= nu) return false; const int un = c + i * G; const int rt = un >> 2, col = un & 3; const int e = tileE[i];
        u.a = rt; u.b = e * 1024 + col * 256; u.orow = rt * 256; u.ocol = col * 256; u.aux = e; return true; }
    __device__ __forceinline__ const char* a_base() const { return A; }
    __device__ __forceinline__ const char* b_ptr(const Unit& u) const { return W + (size_t)u.b * DEXP * 2; }
    __device__ __forceinline__ void a_off(const Unit& u, const int (&R)[2], const int (&C)[2], unsigned (&o0)[2], unsigned (&o1)[2]) const {
#pragma unroll
        for (int i = 0; i < 2; ++i) { o0[i] = (unsigned)((u.a * 256 + R[i]) * DEXP + C[i]) * 2u; o1[i] = o0[i] + (unsigned)(128 * DEXP * 2); }
    }
};

constexpr int NA_RING = 9, NA_KR = 0, NA_VR = NA_RING * 64 * 128, NA_RPB = 2 * NA_RING * 64 * 128, NA_END = NA_RPB + 15 * 128;
constexpr int NA_KC = 0, NA_VC = 256 * 128;
static_assert(NA_END <= MISC_OFF, "na lds");
typedef short s16x4 __attribute__((ext_vector_type(4)));
__device__ __forceinline__ int na_voff(int row, int ch) { return row * 128 + ((((ch >> 1) ^ ((row >> 1) & 3)) << 5) | ((ch & 1) << 4)); }
__device__ __forceinline__ int na_koff(int row, int ch) { return row * 128 + ((ch ^ (row & 7)) << 4); }
template <bool CTX>
__device__ __forceinline__ void na_seg2(LAS unsigned char* L, const bf16x8 (&qf)[2], int r16, int g4, int r0, int band, const int (&boff)[2][4], int rbase,
                                        const int (&voff)[4], f32x4 (&O)[4], float& m_run, float& sum) {
    const float NINF = -__builtin_inff();
    float S[2][8][4]; float mx[2] = {NINF, NINF};
#pragma unroll
    for (int t = 0; t < 8; ++t) {
#pragma unroll
        for (int q = 0; q < 2; ++q) {
            f32x4 c = (f32x4){0.f, 0.f, 0.f, 0.f};
            int key, kbase;
            if (CTX) { key = 128 * q + 16 * t + r16; kbase = NA_KC; } else { key = ((r0 + ((8 * q + t) >> 1)) % NA_RING) * 64 + band + 16 * (t & 1) + r16; kbase = NA_KR; }
            const bf16x8 k0 = *(const LAS bf16x8*)(L + kbase + na_koff(key, g4)), k1 = *(const LAS bf16x8*)(L + kbase + na_koff(key, 4 + g4));
            c = __builtin_amdgcn_mfma_f32_16x16x32_bf16(k0, qf[0], c, 0, 0, 0); c = __builtin_amdgcn_mfma_f32_16x16x32_bf16(k1, qf[1], c, 0, 0, 0);
            if (CTX) {
#pragma unroll
                for (int e = 0; e < 4; ++e) S[q][t][e] = c[e];
            } else {
#pragma unroll
                for (int e = 0; e < 4; ++e) S[q][t][e] = c[e] + *(const LAS float*)(L + rbase + ((8 * q + t) >> 1) * 128 + boff[t & 1][e]);
            }
            mx[q] = fmaxf(mx[q], fmaxf(fmaxf(S[q][t][0], S[q][t][1]), fmaxf(S[q][t][2], S[q][t][3])));
        }
    }
    float ps[2]; f32x4 Oq[2][4];
#pragma unroll
    for (int q = 0; q < 2; ++q) { mx[q] = fmaxf(mx[q], __shfl_xor(mx[q], 16)); mx[q] = fmaxf(mx[q], __shfl_xor(mx[q], 32)); }
#pragma unroll
    for (int q = 0; q < 2; ++q) { float s = 0.f;
#pragma unroll
        for (int t = 0; t < 8; ++t)
#pragma unroll
            for (int e = 0; e < 4; ++e) { const float p = __builtin_amdgcn_exp2f(S[q][t][e] - mx[q]); S[q][t][e] = p; s += p; }
        ps[q] = s;
#pragma unroll
        for (int mt = 0; mt < 4; ++mt) Oq[q][mt] = (f32x4){0.f, 0.f, 0.f, 0.f}; }
#pragma unroll
    for (int q = 0; q < 2; ++q) { ps[q] += __shfl_xor(ps[q], 16); ps[q] += __shfl_xor(ps[q], 32); }
#pragma unroll
    for (int j = 0; j < 4; ++j) {
#pragma unroll
        for (int q = 0; q < 2; ++q) {
            bf16x8 pb; { const u32x4 ww = (u32x4){cvt_pk_bf16(S[q][2 * j][0], S[q][2 * j][1]), cvt_pk_bf16(S[q][2 * j][2], S[q][2 * j][3]), cvt_pk_bf16(S[q][2 * j + 1][0], S[q][2 * j + 1][1]), cvt_pk_bf16(S[q][2 * j + 1][2], S[q][2 * j + 1][3])}; pb = __builtin_bit_cast(bf16x8, ww); }
            int ub;
            if (CTX) ub = NA_VC + (128 * q + 32 * j) * 128; else ub = NA_VR + (((r0 + 4 * q + j) % NA_RING) * 64 + band) * 128;
#pragma unroll
            for (int mt = 0; mt < 4; ++mt) {
                const s16x4 a0 = __builtin_amdgcn_ds_read_tr16_b64_v4i16((LAS s16x4*)(L + ub + voff[mt]));
                const s16x4 a1 = __builtin_amdgcn_ds_read_tr16_b64_v4i16((LAS s16x4*)(L + ub + voff[mt] + 16 * 128));
                const bf16x8 av = (bf16x8){a0[0], a0[1], a0[2], a0[3], a1[0], a1[1], a1[2], a1[3]};
                Oq[q][mt] = __builtin_amdgcn_mfma_f32_16x16x32_bf16(av, pb, Oq[q][mt], 0, 0, 0);
            }
        }
    }
    const float m_new = fmaxf(m_run, fmaxf(mx[0], mx[1]));
    const float a_run = __builtin_amdgcn_exp2f(m_run - m_new), a0 = __builtin_amdgcn_exp2f(mx[0] - m_new), a1 = __builtin_amdgcn_exp2f(mx[1] - m_new);
    m_run = m_new; sum = sum * a_run + ps[0] * a0 + ps[1] * a1;
#pragma unroll
    for (int mt = 0; mt < 4; ++mt) O[mt] = O[mt] * a_run + Oq[0][mt] * a0 + Oq[1][mt] * a1;
}
__device__ __forceinline__ void na_phase(const Frame& F, const Args& a) {
    LAS unsigned char* L = F.lds; const int lane = F.lane, w = F.wave, r16 = lane & 15, g4 = lane >> 4;
    const bf16_t* qbuf = (const bf16_t*)(F.ws + T_QKV); const bf16_t* kbuf = qbuf + (size_t)NT * D; const bf16_t* vbuf = kbuf + (size_t)NT * D; bf16_t* cat = (bf16_t*)(F.ws + T_CAT);
    f32x2* mlbuf = (f32x2*)(F.ws + T_Y);
    const int rr = w >> 2, cb = w & 3; const int band = cb == 0 ? 0 : (cb == 1 ? 8 : (cb == 2 ? 24 : 32));
    const float NINF = -__builtin_inff();
    const int pkey = F.tid >> 3, pch = F.tid & 7;
    int boff[2][4], voff[4];
    { const int qc = 16 * cb + r16; int cs = qc - 8; cs = cs < 0 ? 0 : (cs > 48 ? 48 : cs);
#pragma unroll
      for (int hc = 0; hc < 2; ++hc)
#pragma unroll
          for (int e = 0; e < 4; ++e) { const int kc = band + 16 * hc + 4 * g4 + e; const bool ok = kc >= cs && kc < cs + 16; boff[hc][e] = (ok ? kc - qc + 15 : 31) * 4; }
      const int rl = 4 * g4 + (r16 >> 2), sw = (rl >> 1) & 3;
#pragma unroll
      for (int mt = 0; mt < 4; ++mt) voff[mt] = rl * 128 + ((mt ^ sw) << 5) + 8 * (r16 & 3); }
    for (int bh = blockIdx.x; bh < BATCH * NA_H; bh += F.G) {
        const int b = bh >> 4, h = bh & 15;
        __syncthreads();
        for (int i = F.tid; i < 256 * 8; i += NTHREADS) { const int key = i >> 3, ch = i & 7; const size_t g = (size_t)(NX + b * CTXL + key) * D + h * 64 + ch * 8;
            *(LAS u32x4*)(L + NA_VC + na_voff(key, ch)) = *(const u32x4*)(vbuf + g); *(LAS u32x4*)(L + NA_KC + na_koff(key, ch)) = *(const u32x4*)(kbuf + g); }
        __syncthreads();
        {
            bf16x8 qn[2];
            { const bf16_t* q0 = qbuf + (size_t)(b * SEQ + rr * 64 + 16 * cb + r16) * D + h * 64 + 8 * g4; qn[0] = *(const bf16x8*)q0; qn[1] = *(const bf16x8*)(q0 + 32); }
            for (int rp = 0; rp < 16; ++rp) {
                const int r = 2 * rp + rr; const int qrow = b * SEQ + r * 64 + 16 * cb + r16;
                bf16x8 qf[2]; qf[0] = qn[0]; qf[1] = qn[1];
                if (rp < 15) { const bf16_t* q1 = qbuf + (size_t)(qrow + 128) * D + h * 64 + 8 * g4; qn[0] = *(const bf16x8*)q1; qn[1] = *(const bf16x8*)(q1 + 32); }
                f32x4 O[4]; float m_run = NINF, sum = 0.f;
#pragma unroll
                for (int mt = 0; mt < 4; ++mt) O[mt] = (f32x4){0.f, 0.f, 0.f, 0.f};
                na_seg2<true>(L, qf, r16, g4, 0, band, boff, 0, voff, O, m_run, sum);
#pragma unroll
                for (int mt = 0; mt < 4; ++mt) { u32x2 o; o.x = pk2(O[mt][0], O[mt][1]); o.y = pk2(O[mt][2], O[mt][3]); *(u32x2*)(cat + (size_t)qrow * D + h * 64 + 16 * mt + 4 * g4) = o; }
                if (g4 == 0) mlbuf[(size_t)qrow * 16 + h] = (f32x2){m_run, sum};
            }
        }
        __syncthreads();
        asm volatile("s_waitcnt vmcnt(0)" ::: "memory");
        for (int i = F.tid; i < 15 * 32; i += NTHREADS) { const int ri = i >> 5, ci = i & 31; ((LAS float*)(L + NA_RPB))[i] = ci < 31 ? a.in[23][h * 465 + ri * 31 + ci] * 1.4426950408889634f : NINF; }
        for (int gr = 0; gr < 9; ++gr) { const size_t g = (size_t)(b * SEQ + gr * 64 + pkey) * D + h * 64 + pch * 8;
            *(LAS u32x4*)(L + NA_VR + na_voff(gr * 64 + pkey, pch)) = *(const u32x4*)(vbuf + g); *(LAS u32x4*)(L + NA_KR + na_koff(gr * 64 + pkey, pch)) = *(const u32x4*)(kbuf + g); }
        for (int rp = 0; rp < 16; ++rp) {
            int R0 = 2 * rp - 4; R0 = R0 < 0 ? 0 : (R0 > 24 ? 24 : R0);
            int R0n = 2 * rp - 2; R0n = R0n < 0 ? 0 : (R0n > 24 ? 24 : R0n);
            const bool newrows = (rp < 15) && (R0n != R0);
            u32x4 nv0 = (u32x4){0u, 0u, 0u, 0u}, nv1 = nv0, nk0 = nv0, nk1 = nv0;
            if (newrows) { const size_t g0 = (size_t)(b * SEQ + (R0 + 9) * 64 + pkey) * D + h * 64 + pch * 8; nv0 = *(const u32x4*)(vbuf + g0); nk0 = *(const u32x4*)(kbuf + g0);
                if (R0 + 10 < 32) { const size_t g1 = g0 + (size_t)64 * D; nv1 = *(const u32x4*)(vbuf + g1); nk1 = *(const u32x4*)(kbuf + g1); } }
            const int r = 2 * rp + rr; int r0 = r - 4; r0 = r0 < 0 ? 0 : (r0 > 24 ? 24 : r0);
            const int qrow = b * SEQ + r * 64 + 16 * cb + r16;
            bf16x8 qf[2];
#pragma unroll
            for (int ks = 0; ks < 2; ++ks) qf[ks] = *(const bf16x8*)(qbuf + (size_t)qrow * D + h * 64 + 32 * ks + 8 * g4);
            f32x4 O[4]; float m_run, sum;
#pragma unroll
            for (int mt = 0; mt < 4; ++mt) { const u32x2 o = *(const u32x2*)(cat + (size_t)qrow * D + h * 64 + 16 * mt + 4 * g4); O[mt] = (f32x4){bflo(o.x), bfhi(o.x), bflo(o.y), bfhi(o.y)}; }
            { const f32x2 ml = mlbuf[(size_t)qrow * 16 + h]; m_run = ml.x; sum = ml.y; }
            lds_barrier();
            const int rbase = NA_RPB + (r0 - r + 7) * 128;
            na_seg2<false>(L, qf, r16, g4, r0, band, boff, rbase, voff, O, m_run, sum);
            const float inv = 1.0f / sum;
#pragma unroll
            for (int mt = 0; mt < 4; ++mt) { u32x2 o; o.x = pk2(O[mt][0] * inv, O[mt][1] * inv); o.y = pk2(O[mt][2] * inv, O[mt][3] * inv);
                *(u32x2*)(cat + (size_t)qrow * D + h * 64 + 16 * mt + 4 * g4) = o; }
            if (newrows) {
                lds_barrier();
                *(LAS u32x4*)(L + NA_VR + na_voff(((R0 + 9) % NA_RING) * 64 + pkey, pch)) = nv0; *(LAS u32x4*)(L + NA_KR + na_koff(((R0 + 9) % NA_RING) * 64 + pkey, pch)) = nk0;
                *(LAS u32x4*)(L + NA_VR + na_voff(((R0 + 10) % NA_RING) * 64 + pkey, pch)) = nv1; *(LAS u32x4*)(L + NA_KR + na_koff(((R0 + 10) % NA_RING) * 64 + pkey, pch)) = nk1; }
        }
    }
    __syncthreads();
}

#if MK_ONE_LAUNCH
#define GRID_BAR() xcd_barrier(bar)
#else
#define GRID_BAR() do { } while (0)
#endif
#define IN(k) (lo <= (k) && (k) < hi && (k) <= MK_LAST_PHASE)
#define SEAM(k) do { if (IN(k) && IN((k) + 1)) GRID_BAR(); } while (0)
template <int LAYER>
__device__ __forceinline__ void layer_tail(const Frame& F, const Args& args, const int lo, const int hi, const XcdBarrier& bar) {
    unsigned char* ws = args.ws;
    const float* modx = (const float*)(ws + WS_MODX); const float* modc = (const float*)(ws + WS_MODC);
    float* xw = (float*)(ws + WS_XW); float* xwc = (float*)(ws + WS_XW + (size_t)NX * D * 2); bf16_t* Hb = (bf16_t*)(ws + WS_H);
    constexpr int mb = LAYER ? 16 : 7; constexpr int ntok = LAYER ? NX : NT;
    const float* lmodx = modx + (size_t)LAYER * 16 * ADA; const float* lmodc = modc + (size_t)LAYER * ADA;
    if (IN(LAYER ? 14 : 5)) REPEAT_IF(LAYER ? 14 : 5) { REP_BAR();
        SchedDense S{(const char*)(ws + T_CAT), (const char*)(ws + (LAYER ? WS_WOUT1 : WS_WOUT0)), D, ntok / 256, D / 256, 0, 1, 0, F.G, (int)blockIdx.x};
        EpiBf16 E{(bf16_t*)(ws + T_Y), D, 0, 0};
        pg8::gemm_phase<EpiBf16, SchedDense, true>(F.lds, D, S, E);
        if (LAYER == 0 && F.G == 256 && (int)blockIdx.x >= 64) cvt_moe_range(F, args, 0, F0_BULK + F0_P2, F0_BULK + F0_P2 + F0_P5, (int)blockIdx.x - 64, 192);
    }
    SEAM(LAYER ? 14 : 5);
    if (IN(LAYER ? 15 : 6)) REPEAT_IF(LAYER ? 15 : 6) { REP_BAR();
        RowPhase P{}; P.xin_lat = LAYER ? xw : args.in[0]; P.xin_ctx = LAYER ? xwc : args.in[2]; P.xin16 = LAYER != 0; P.xout_lat = xw; P.xout_ctx = xwc; P.xout16 = true; P.nrows = ntok; P.ysrc = 1; P.y = (const bf16_t*)(ws + T_Y);
        P.gpost = args.in[7] + LAYER * D; P.modx = lmodx; P.modc = lmodc; P.gate_chunk = 2;
        P.doH = true; P.H = Hb; P.gpre = args.in[8] + LAYER * D; P.sc_chunk = 4; P.sh_chunk = 3; P.modxH = lmodx; P.modcH = lmodc;
        row_phase(F, P);
    }
    SEAM(LAYER ? 15 : 6);
    if (IN(mb)) REPEAT_IF(mb) { REP_BAR();
        SchedDense S{(const char*)Hb, (const char*)(ws + WS_WR) + (size_t)LAYER * NEXP * D * 2, D, ntok / 256, 1, 0, 1, 0, F.G, (int)blockIdx.x};
        EpiRouter E{args.in[25] + LAYER * NEXP, (int*)(ws + M_AE), (int*)(ws + M_AR), (float*)(ws + M_AG), F.ctl + CW_CNT + LAYER * 256, (int*)(ws + M_LST)};
        pg8::gemm_phase<EpiRouter, SchedDense, false>(F.lds, D, S, E);
        if (F.G != 256) { } else if (LAYER == 0) { if ((int)blockIdx.x >= 144) cvt_moe_range(F, args, 0, F0_BULK + F0_P2 + F0_P5, MOE_CVT_ITEMS, (int)blockIdx.x - 144, 112); }
        else { if ((int)blockIdx.x >= 128) { const int ntr0 = (int)__hip_atomic_load(F.ctl + CW_TST + 256, __ATOMIC_RELAXED, __HIP_MEMORY_SCOPE_AGENT); int s9, s10; fill1_ranges(F, ntr0, s9, s10);
                cvt_moe_range(F, args, 1, s9 + s10, MOE_CVT_ITEMS - F1_P12, (int)blockIdx.x - 128, 128); } }
    }
    if (IN(mb) && IN(mb + 2)) GRID_BAR();
    if (IN(mb + 2)) REPEAT_IF(mb + 2) { REP_BAR();
        const int nj = moe_units_setup<2>(F, LAYER, ntok, F.vcu, true);
        SchedMoeGU S{(const char*)Hb, (const char*)(ws + WS_WGU + (size_t)LAYER * WGU_BYTES), (const LAS int*)(F.lds + AUX_TILEE), (const LAS int*)(F.lds + AUX_IDX), nj, F.G, F.vcu};
        EpiGateUp E{(bf16_t*)(ws + M_HID)};
        pg8::gemm_phase<EpiGateUp, SchedMoeGU, true>(F.lds, D, S, E);
        if (LAYER == 0) { const int ntr0 = ((const LAS int*)(F.lds + AUX_TST))[256]; int s9, s10; fill1_ranges(F, ntr0, s9, s10); const int nu = (ntr0 + NT / 256) * 2, hv = nu % F.G;
            if (hv && F.vcu >= hv) cvt_moe_range(F, args, 1, 0, s9, F.vcu - hv, F.G - hv); }
    }
    SEAM(mb + 2);
    if (IN(mb + 3)) REPEAT_IF(mb + 3) { REP_BAR();
        const int nj = moe_units_setup<4>(F, LAYER, ntok, F.vcu, false);
        SchedMoeDN S{(const char*)(ws + M_HID), (const char*)(ws + WS_WDN + (size_t)LAYER * WDN_BYTES), (const LAS int*)(F.lds + AUX_TILEE), nj, F.G, F.vcu};
        EpiF8 E{(unsigned char*)(ws + M_OUT)};
        pg8::gemm_phase<EpiF8, SchedMoeDN, true>(F.lds, DEXP, S, E);
        if (LAYER == 0) { const int ntr0 = ((const LAS int*)(F.lds + AUX_TST))[256]; int s9, s10; fill1_ranges(F, ntr0, s9, s10); const int nu = (ntr0 + NT / 256) * 4, hv = nu % F.G;
            if (hv && F.vcu >= hv) cvt_moe_range(F, args, 1, s9, s9 + s10, F.vcu - hv, F.G - hv); }
    }
    SEAM(mb + 3);
    if (IN(mb + 4)) REPEAT_IF(mb + 4) { REP_BAR();
        RowPhase P{}; P.xin_lat = xw; P.xin_ctx = xwc; P.xin16 = true; P.xout_lat = LAYER ? args.out : xw; P.xout_ctx = xwc; P.xout16 = LAYER == 0; P.nrows = ntok; P.ysrc = 2;
        P.mo8 = (const unsigned char*)(ws + M_OUT); P.tslot = (const int*)(ws + M_TS); P.tgate = (const float*)(ws + M_AG); P.sharedbase = (int)__hip_atomic_load(F.ctl + CW_TST + LAYER * 320 + 256, __ATOMIC_RELAXED, __HIP_MEMORY_SCOPE_AGENT) * 256;
        P.gpost = args.in[9] + LAYER * D; P.modx = lmodx; P.modc = lmodc; P.gate_chunk = 5;
        P.doH = LAYER == 0; P.H = Hb; P.gpre = args.in[6] + D; P.sc_chunk = 1; P.sh_chunk = 0; P.modxH = modx + (size_t)16 * ADA; P.modcH = modc + ADA;
        row_phase(F, P);
        if (LAYER == 0) {
            const int ntr0 = (int)__hip_atomic_load(F.ctl + CW_TST + 256, __ATOMIC_RELAXED, __HIP_MEMORY_SCOPE_AGENT); int s9, s10; fill1_ranges(F, ntr0, s9, s10);
            if (F.G != 256) cvt_moe_range(F, args, 1, 0, MOE_CVT_ITEMS, F.vcu, F.G);
        }
    }
    SEAM(mb + 4);
}

__global__ void __launch_bounds__(NTHREADS, 2) mk_fwd(Args args) {
    extern __shared__ __attribute__((aligned(16))) unsigned char lds_raw[];
    Frame F;
    F.lds = (LAS unsigned char*)lds_raw; F.MISC = (volatile LAS unsigned*)(F.lds + MISC_OFF);
    F.tid = threadIdx.x; F.lane = F.tid & 63; F.wave = __builtin_amdgcn_readfirstlane(F.tid >> 6);
    F.G = gridDim.x; { const int bx = blockIdx.x; F.vcu = (F.G % 8 == 0) ? (bx % 8) * (F.G / 8) + bx / 8 : bx; }
    F.ws = args.ws; F.ctl = (unsigned*)(args.ws + WS_CTL);
    for (int u = F.tid; u < (LDS_BYTES - MISC_OFF) / 4; u += NTHREADS) ((LAS unsigned*)(F.lds + MISC_OFF))[u] = 0u;
    __syncthreads();
    XcdBarrier bar; bar.bar = F.ctl + CW_BAR; bar.x = 0; bar.st = nullptr;
#if MK_ONE_LAUNCH
    bar = xcd_barrier_post(F.ctl + CW_BAR, F.MISC + 8);
#endif
    const int lo = args.ph_lo, hi = args.ph_hi;
    unsigned char* ws = args.ws;
    const float* modx = (const float*)(ws + WS_MODX); const float* modc = (const float*)(ws + WS_MODC);
    float* xw = (float*)(ws + WS_XW); bf16_t* Hb = (bf16_t*)(ws + WS_H);

    if (IN(0)) REPEAT_IF(0) { REP_BAR(); p0_ada(F, args); p0_convert(F, args); }
    SEAM(0);
    {
        if (IN(1)) REPEAT_IF(1) { REP_BAR();
            RowPhase P{}; P.xin_lat = args.in[0]; P.xin_ctx = args.in[2]; P.nrows = NT; P.ysrc = 0; P.modx = modx; P.modc = modc;
            P.doH = true; P.H = Hb; P.gpre = args.in[6]; P.sc_chunk = 1; P.sh_chunk = 0; P.modxH = modx; P.modcH = modc;
            row_phase(F, P);
        }
        SEAM(1);
        if (IN(2)) REPEAT_IF(2) { REP_BAR();
            SchedDense S{(const char*)Hb, (const char*)(ws + WS_WIN0), D, NT / 256, AB_INP / 256, 0, 1, 0, F.G, (int)blockIdx.x};
            EpiInproj E{(bf16_t*)(ws + T_QB), (bf16_t*)(ws + T_KB), (bf16_t*)(ws + T_VB), (bf16_t*)(ws + T_GB), (bf16_t*)(ws + T_UB), (float*)(ws + T_LR), (const f32x2*)(ws + WS_ROPE)};
            pg8::gemm_phase<EpiInproj, SchedDense, true>(F.lds, D, S, E);
            if (F.G == 256 && (int)blockIdx.x >= 48) cvt_moe_range(F, args, 0, F0_BULK, F0_BULK + F0_P2, (int)blockIdx.x - 48, 208);
        }
        SEAM(2);
        if (IN(3)) REPEAT_IF(3) { REP_BAR(); gla_prep_phase(F, args); }
        if (IN(3) && IN(22)) GRID_BAR();
        if (IN(22)) REPEAT_IF(22) { REP_BAR(); gla_seq_phase(F, args); }
        if (IN(22) && IN(4)) GRID_BAR();
        if (IN(4)) REPEAT_IF(4) { REP_BAR(); finish_conv_phase(F, args); }
        SEAM(4);

    }
    layer_tail<0>(F, args, lo, hi, bar);
    {
        if (IN(12)) REPEAT_IF(12) { REP_BAR();
            SchedDense S{(const char*)Hb, (const char*)(ws + WS_WQKV1), D, NX / 256, 12, NC / 256, 8, 4, F.G, (int)blockIdx.x};
            EpiBf16 E{(bf16_t*)(ws + T_QKV), D, D, (size_t)NT * D, 0.125f * 1.4426950408889634f};
            pg8::gemm_phase<EpiBf16, SchedDense, true>(F.lds, D, S, E);
            if (F.G == 256 && (int)blockIdx.x >= 128) cvt_moe_range(F, args, 1, MOE_CVT_ITEMS - F1_P12, MOE_CVT_ITEMS, (int)blockIdx.x - 128, 128);
        }
        SEAM(12);
        if (IN(13)) REPEAT_IF(13) { REP_BAR(); na_phase(F, args); }
        SEAM(13);

    }
    layer_tail<1>(F, args, lo, hi, bar);

#undef IN
#undef SEAM
}

extern "C" void kernel_launch(void* const* d_in, const int* in_sizes, int n_in, void* d_out, int out_size, void* d_ws, size_t ws_size, hipStream_t stream) {
    static int grid = 0;
    if (grid == 0) {
        if (n_in != 32 || out_size != NX * D || ws_size < WS_END) { fprintf(stderr, "kernel_launch: unexpected problem (n_in %d, out %d, ws %zu < %zu)\n", n_in, out_size, ws_size, (size_t)WS_END); grid = -1; return; }
        int dev = 0, cus = 0, per_cu = 0;
        if (hipGetDevice(&dev) != hipSuccess || hipDeviceGetAttribute(&cus, hipDeviceAttributeMultiprocessorCount, dev) != hipSuccess) { grid = -1; return; }
        if (hipFuncSetAttribute((const void*)mk_fwd, hipFuncAttributeMaxDynamicSharedMemorySize, LDS_BYTES) != hipSuccess) { fprintf(stderr, "kernel_launch: hipFuncSetAttribute failed\n"); grid = -1; return; }
        if (hipOccupancyMaxActiveBlocksPerMultiprocessor(&per_cu, (const void*)mk_fwd, NTHREADS, LDS_BYTES) != hipSuccess || per_cu < 1) fprintf(stderr, "kernel_launch: occupancy query says %d\n", per_cu);
        (void)hipGetLastError();
        grid = cus;
    }
    if (grid < 0) return;
    (void)hipMemsetAsync((char*)d_ws + WS_CTL, 0, CTL_BYTES, stream);
    Args a{};
    for (int i = 0; i < 32; ++i) a.in[i] = (const float*)d_in[i];
    a.out = (float*)d_out; a.ws = (unsigned char*)d_ws;
#if MK_ONE_LAUNCH
    a.ph_lo = 0; a.ph_hi = 64;
    hipLaunchKernelGGL(mk_fwd, dim3(grid), dim3(NTHREADS), LDS_BYTES, stream, a);
#else
    for (int p = 0; p <= 20; ++p) { if (p > MK_LAST_PHASE) break; a.ph_lo = p; a.ph_hi = p + 1; hipLaunchKernelGGL(mk_fwd, dim3(grid), dim3(NTHREADS), LDS_BYTES, stream, a); }
#endif
}
```
